# Optimizing an MI355X kernel written in HIP

```python
import math
import jax, jax.numpy as jnp
from jax import lax
import numpy as np

D_MODEL = 1024
BATCH = 32
SEQ = 256
DEPTH = 4
DEC_BATCH = 4
DEC_SEQ = 2048
PAST_LEN = 512

GRID_W = 64
HEAD_DIM = 64
NA_HEADS = 4
NA_WIN_ROWS = 8
NA_WIN_COLS = 16
NA_KEY_COLS = 2 * NA_WIN_COLS
SW_HEADS = 8
SW_KV_HEADS = 2
SW_WINDOW = 128
DA_HEADS = 4
DA_DIM = 32
DA_VDIM = 2 * DA_DIM
QBLK = 128
D_FF = 2816
CONV_W = 3
ROPE_BASE = 10000.0
EPS = 1e-6
NA_W = NA_HEADS * HEAD_DIM
SW_QW = SW_HEADS * HEAD_DIM
SW_KVW = SW_KV_HEADS * HEAD_DIM
DA_QW = DA_HEADS * 2 * DA_DIM
DA_VW = DA_HEADS * DA_VDIM
D_MIX = NA_W + SW_QW + DA_VW
D_IN = 3 * NA_W + SW_QW + 2 * SW_KVW + 2 * DA_QW + DA_VW

kernel_name = "hybrid_dit_natten_swa_diffattn_step"

F32 = jnp.float32


def rmsnorm(x, g):
    xf = x.astype(F32)
    y = xf * lax.rsqrt(jnp.mean(xf * xf, axis=-1, keepdims=True) + EPS)
    return (y * g.astype(F32)).astype(x.dtype)


def modulation(cvec, w_mod_l, b_mod_l):
    m = jax.nn.silu(cvec) @ w_mod_l + b_mod_l
    return jnp.split(m, 6, axis=-1)


def adaln(x, g, shift, scale):
    return rmsnorm(x, g) * (1 + scale) + shift


def axial_rope(T, dim):
    n = dim // 4
    inv = 1.0 / (ROPE_BASE ** (jnp.arange(n, dtype=F32) / n))
    t = jnp.arange(T)
    row = (t // GRID_W).astype(F32)
    col = (t % GRID_W).astype(F32)
    ang = jnp.concatenate([row[:, None] * inv, col[:, None] * inv], axis=-1)
    return jnp.cos(ang), jnp.sin(ang)


def apply_rope(x, cos, sin):
    shp = x.shape
    xf = x.reshape(shp[0], shp[1], -1, shp[-1]).astype(F32)
    x1, x2 = xf[..., 0::2], xf[..., 1::2]
    c = cos[None, :, None, :]
    s = sin[None, :, None, :]
    out = jnp.stack([x1 * c - x2 * s, x1 * s + x2 * c], axis=-1)
    return out.reshape(shp).astype(x.dtype)


def softmax_with_sink(s, sink_b):
    sc = jnp.broadcast_to(sink_b, s.shape[:-1] + (1,))
    p = jax.nn.softmax(jnp.concatenate([s, sc], axis=-1), axis=-1)
    return p[..., :-1]


def split_qkv(h, w_in_l, na_g, sw_g, da_g):
    B, T, _ = h.shape
    sizes = (NA_W, NA_W, NA_W, SW_QW, SW_KVW, SW_KVW, DA_QW, DA_QW, DA_VW)
    cuts = [int(i) for i in np.cumsum(sizes)[:-1]]
    p = jnp.split(h @ w_in_l, cuts, axis=-1)
    qa = rmsnorm(p[0].reshape(B, T, NA_HEADS, HEAD_DIM), na_g[0])
    ka = rmsnorm(p[1].reshape(B, T, NA_HEADS, HEAD_DIM), na_g[1])
    va = p[2].reshape(B, T, NA_HEADS, HEAD_DIM)
    qb = rmsnorm(p[3].reshape(B, T, SW_HEADS, HEAD_DIM), sw_g[0])
    kb = rmsnorm(p[4].reshape(B, T, SW_KV_HEADS, HEAD_DIM), sw_g[1])
    vb = p[5].reshape(B, T, SW_KV_HEADS, HEAD_DIM)
    qc = rmsnorm(p[6].reshape(B, T, DA_HEADS, 2, DA_DIM), da_g[0])
    kc = rmsnorm(p[7].reshape(B, T, DA_HEADS, 2, DA_DIM), da_g[1])
    vc = p[8].reshape(B, T, DA_HEADS, DA_VDIM)
    return qa, ka, va, qb, kb, vb, qc, kc, vc


def dense_attn(q, k, v, sink=None):
    B, T, HQ, D = q.shape
    HKV = k.shape[2]
    G = HQ // HKV
    DV = v.shape[-1]
    nb = T // QBLK
    qb = jnp.moveaxis(q.reshape(B, nb, QBLK, HKV, G, D), 1, 0)
    scale = D ** -0.5

    def one(qblk):
        s = jnp.einsum('bqhgd,bkhd->bhgqk', qblk, k).astype(F32) * scale
        if sink is None:
            p = jax.nn.softmax(s, axis=-1)
        else:
            p = softmax_with_sink(s, sink.reshape(HKV, G)[None, :, :, None, None].astype(F32))
        return jnp.einsum('bhgqk,bkhd->bqhgd', p.astype(v.dtype), v)

    o = lax.map(one, qb)
    return jnp.moveaxis(o, 0, 1).reshape(B, T, HQ, DV)


def diff_lambda(lp, lam_init):
    lpf = lp.astype(F32)
    return jnp.exp(jnp.sum(lpf[0] * lpf[1])) - jnp.exp(jnp.sum(lpf[2] * lpf[3])) + lam_init


def diff_attn(q, k, v, lam, subln_g, lam_init):
    o1 = dense_attn(q[..., 0, :], k[..., 0, :], v).astype(F32)
    o2 = dense_attn(q[..., 1, :], k[..., 1, :], v).astype(F32)
    o = rmsnorm(o1 - lam * o2, subln_g) * (1.0 - lam_init)
    return o.astype(v.dtype)


def neighborhood_attn(q, k, v, kc, vc, rpb):
    B, T, H, D = q.shape
    rows = T // GRID_W
    kr = min(NA_WIN_ROWS, rows)
    ncb = GRID_W // NA_WIN_COLS
    r = jnp.arange(rows)
    r0 = jnp.clip(r - kr // 2, 0, rows - kr)
    ridx = r0[:, None] + jnp.arange(kr)[None, :]
    roff = ridx - r[:, None] + (NA_WIN_ROWS - 1)
    cb = jnp.arange(ncb)
    c0 = jnp.clip(cb * NA_WIN_COLS - NA_WIN_COLS // 2, 0, GRID_W - NA_KEY_COLS)
    cidx = c0[:, None] + jnp.arange(NA_KEY_COLS)[None, :]
    qcol = cb[:, None] * NA_WIN_COLS + jnp.arange(NA_WIN_COLS)[None, :]
    qs = jnp.clip(qcol - NA_WIN_COLS // 2, 0, GRID_W - NA_WIN_COLS)
    kcol = cidx[:, None, :]
    cmask = (kcol >= qs[..., None]) & (kcol < qs[..., None] + NA_WIN_COLS)
    coff = jnp.clip(kcol - qcol[..., None], -(NA_WIN_COLS - 1), NA_WIN_COLS - 1) + (NA_WIN_COLS - 1)
    qg = q.reshape(B, rows, ncb, NA_WIN_COLS, H, D)
    gi = (ridx[:, None, :, None], cidx[None, :, None, :])
    kg = k.reshape(B, rows, GRID_W, H, D)[:, gi[0], gi[1]]
    vg = v.reshape(B, rows, GRID_W, H, D)[:, gi[0], gi[1]]
    scale = D ** -0.5
    s_loc = jnp.einsum('brcqhd,brcakhd->brchqak', qg, kg).astype(F32) * scale
    bias = rpb[:, roff[:, None, None, :, None], coff[None, :, :, None, :]]
    s_loc = s_loc + jnp.moveaxis(bias, 0, 2).astype(F32)
    s_loc = jnp.where(cmask[None, None, :, None, :, None, :], s_loc, -jnp.inf)
    nl = kr * NA_KEY_COLS
    s_loc = s_loc.reshape(B, rows, ncb, H, NA_WIN_COLS, nl)
    s_ctx = jnp.einsum('brcqhd,bphd->brchqp', qg, kc).astype(F32) * scale
    p = jax.nn.softmax(jnp.concatenate([s_loc, s_ctx], axis=-1), axis=-1).astype(v.dtype)
    p_loc = p[..., :nl].reshape(B, rows, ncb, H, NA_WIN_COLS, kr, NA_KEY_COLS)
    o = (jnp.einsum('brchqak,brcakhd->brcqhd', p_loc, vg)
         + jnp.einsum('brchqp,bphd->brcqhd', p[..., nl:], vc))
    return o.reshape(B, T, H, D)


def window_attn(q, k, v, kc, vc, sink):
    B, T, HQ, D = q.shape
    HKV = k.shape[2]
    G = HQ // HKV
    nb = T // QBLK
    qb = q.reshape(B, nb, QBLK, HKV, G, D)
    pad = ((0, 0), (QBLK, QBLK), (0, 0), (0, 0))
    kp = jnp.pad(k, pad).reshape(B, nb + 2, QBLK, HKV, D)
    vp = jnp.pad(v, pad).reshape(B, nb + 2, QBLK, HKV, D)
    kband = jnp.concatenate([kp[:, :-2], kp[:, 1:-1], kp[:, 2:]], axis=2)
    vband = jnp.concatenate([vp[:, :-2], vp[:, 1:-1], vp[:, 2:]], axis=2)
    qi = jnp.arange(QBLK)
    kj = jnp.arange(3 * QBLK)
    rel = kj[None, :] - QBLK - qi[:, None]
    kpos = jnp.arange(nb)[:, None] * QBLK - QBLK + kj[None, :]
    mask = (jnp.abs(rel) <= SW_WINDOW)[None] & ((kpos >= 0) & (kpos < T))[:, None, :]
    scale = D ** -0.5
    s_loc = jnp.einsum('bnqhgd,bnkhd->bnhgqk', qb, kband).astype(F32) * scale
    s_loc = jnp.where(mask[None, :, None, None], s_loc, -jnp.inf)
    s_ctx = jnp.einsum('bnqhgd,bphd->bnhgqp', qb, kc).astype(F32) * scale
    p = softmax_with_sink(jnp.concatenate([s_loc, s_ctx], axis=-1),
                          sink.reshape(HKV, G)[None, None, :, :, None, None].astype(F32)).astype(v.dtype)
    nl = 3 * QBLK
    o = (jnp.einsum('bnhgqk,bnkhd->bnqhgd', p[..., :nl], vband)
         + jnp.einsum('bnhgqp,bphd->bnqhgd', p[..., nl:], vc))
    return o.reshape(B, T, HQ, D)


def merge_heads(oa, ob, oc, w_out_l):
    B, T = oa.shape[:2]
    o = jnp.concatenate([oa.reshape(B, T, NA_W), ob.reshape(B, T, SW_QW), oc.reshape(B, T, DA_VW)], axis=-1)
    return o @ w_out_l


def conv_ffn(h, w_up_l, cw, cb, w_down_l):
    u = h @ w_up_l
    T = u.shape[1]
    half = CONV_W // 2
    up = jnp.pad(u, ((0, 0), (half, half), (0, 0)))
    y = cb
    for j in range(CONV_W):
        y = y + up[:, j:j + T] * cw[j]
    g, val = jnp.split(y, 2, axis=-1)
    return (jax.nn.silu(g) * val) @ w_down_l


def setup_inputs(seed: int = 0) -> dict:
    key = jax.random.key(seed)
    ks = jax.random.split(key, 27)
    n = jax.random.normal
    d = {}
    d["x_prompt"] = n(ks[0], (BATCH, SEQ, D_MODEL), F32)
    d["x_sample"] = n(ks[1], (DEC_BATCH, DEC_SEQ, D_MODEL), F32)
    d["cache_na_k"] = n(ks[2], (DEC_BATCH, DEPTH, PAST_LEN, NA_HEADS, HEAD_DIM), F32)
    d["cache_na_v"] = n(ks[3], (DEC_BATCH, DEPTH, PAST_LEN, NA_HEADS, HEAD_DIM), F32)
    d["cache_sw_k"] = n(ks[4], (DEC_BATCH, DEPTH, PAST_LEN, SW_KV_HEADS, HEAD_DIM), F32)
    d["cache_sw_v"] = n(ks[5], (DEC_BATCH, DEPTH, PAST_LEN, SW_KV_HEADS, HEAD_DIM), F32)
    d["cache_da_k"] = n(ks[6], (DEC_BATCH, DEPTH, PAST_LEN, DA_HEADS, 2, DA_DIM), F32)
    d["cache_da_v"] = n(ks[7], (DEC_BATCH, DEPTH, PAST_LEN, DA_HEADS, DA_VDIM), F32)
    d["c"] = n(ks[8], (DEC_BATCH, D_MODEL), F32)
    d["c_ctx"] = n(ks[9], (D_MODEL,), F32)
    d["g_attn"] = 1.0 + 0.1 * n(ks[10], (DEPTH, D_MODEL), F32)
    d["g_ffn"] = 1.0 + 0.1 * n(ks[11], (DEPTH, D_MODEL), F32)
    d["w_mod"] = 0.5 * D_MODEL ** -0.5 * n(ks[12], (DEPTH, D_MODEL, 6 * D_MODEL), F32)
    d["b_mod"] = 0.02 * n(ks[13], (DEPTH, 6 * D_MODEL), F32)
    d["w_in"] = D_MODEL ** -0.5 * n(ks[14], (DEPTH, D_MODEL, D_IN), F32)
    d["na_qk_g"] = 1.0 + 0.1 * n(ks[15], (DEPTH, 2, HEAD_DIM), F32)
    d["na_rpb"] = 0.2 * n(ks[16], (DEPTH, NA_HEADS, 2 * NA_WIN_ROWS - 1, 2 * NA_WIN_COLS - 1), F32)
    d["sw_qk_g"] = 1.0 + 0.1 * n(ks[17], (DEPTH, 2, HEAD_DIM), F32)
    d["sw_sink"] = 0.5 * n(ks[18], (DEPTH, SW_HEADS), F32)
    d["da_qk_g"] = 1.0 + 0.1 * n(ks[19], (DEPTH, 2, DA_DIM), F32)
    d["da_lambda"] = 0.1 * n(ks[20], (DEPTH, 4, DA_DIM), F32)
    d["da_subln_g"] = 1.0 + 0.1 * n(ks[21], (DEPTH, DA_VDIM), F32)
    d["w_out"] = D_MIX ** -0.5 * n(ks[22], (DEPTH, D_MIX, D_MODEL), F32)
    d["w_up"] = D_MODEL ** -0.5 * n(ks[23], (DEPTH, D_MODEL, 2 * D_FF), F32)
    d["conv_w"] = CONV_W ** -0.5 * n(ks[24], (DEPTH, CONV_W, 2 * D_FF), F32)
    d["conv_b"] = 0.02 * n(ks[25], (DEPTH, 2 * D_FF), F32)
    d["w_down"] = D_FF ** -0.5 * n(ks[26], (DEPTH, D_FF, D_MODEL), F32)
    return d


def reference(x_prompt, x_sample, cache_na_k, cache_na_v, cache_sw_k, cache_sw_v, cache_da_k, cache_da_v,
              c, c_ctx, g_attn, g_ffn, w_mod, b_mod, w_in, na_qk_g, na_rpb, sw_qk_g, sw_sink,
              da_qk_g, da_lambda, da_subln_g, w_out, w_up, conv_w, conv_b, w_down):
    T = x_sample.shape[1]
    cos_b, sin_b = axial_rope(T, HEAD_DIM)
    cos_c, sin_c = axial_rope(T, DA_DIM)
    xp = x_prompt
    xs = x_sample
    na_k_l, na_v_l, sw_k_l, sw_v_l, da_k_l, da_v_l = [], [], [], [], [], []
    for l in range(DEPTH):
        lam_init = 0.8 - 0.6 * math.exp(-0.3 * l)
        lam = diff_lambda(da_lambda[l], lam_init)
        m = modulation(c_ctx[None, None, :], w_mod[l], b_mod[l])
        h = adaln(xp, g_attn[l], m[0], m[1])
        qa, ka, va, qb, kb, vb, qc, kc, vc = split_qkv(h, w_in[l], na_qk_g[l], sw_qk_g[l], da_qk_g[l])
        oa = dense_attn(qa, ka, va)
        ob = dense_attn(qb, kb, vb, sw_sink[l])
        oc = diff_attn(qc, kc, vc, lam, da_subln_g[l], lam_init)
        xp = xp + m[2] * merge_heads(oa, ob, oc, w_out[l])
        h = adaln(xp, g_ffn[l], m[3], m[4])
        xp = xp + m[5] * conv_ffn(h, w_up[l], conv_w[l], conv_b[l], w_down[l])
        na_k_l.append(ka)
        na_v_l.append(va)
        sw_k_l.append(kb)
        sw_v_l.append(vb)
        da_k_l.append(kc)
        da_v_l.append(vc)
        m = modulation(c[:, None, :], w_mod[l], b_mod[l])
        h = adaln(xs, g_attn[l], m[0], m[1])
        qa, ka, va, qb, kb, vb, qc, kc, vc = split_qkv(h, w_in[l], na_qk_g[l], sw_qk_g[l], da_qk_g[l])
        qb = apply_rope(qb, cos_b, sin_b)
        kb = apply_rope(kb, cos_b, sin_b)
        qc = apply_rope(qc, cos_c, sin_c)
        kc = apply_rope(kc, cos_c, sin_c)
        oa = neighborhood_attn(qa, ka, va, cache_na_k[:, l], cache_na_v[:, l], na_rpb[l])
        ob = window_attn(qb, kb, vb, cache_sw_k[:, l], cache_sw_v[:, l], sw_sink[l])
        oc = diff_attn(qc, jnp.concatenate([kc, cache_da_k[:, l]], axis=1),
                       jnp.concatenate([vc, cache_da_v[:, l]], axis=1), lam, da_subln_g[l], lam_init)
        xs = xs + m[2] * merge_heads(oa, ob, oc, w_out[l])
        h = adaln(xs, g_ffn[l], m[3], m[4])
        xs = xs + m[5] * conv_ffn(h, w_up[l], conv_w[l], conv_b[l], w_down[l])
    return (xp, xs, jnp.stack(na_k_l, axis=1), jnp.stack(na_v_l, axis=1), jnp.stack(sw_k_l, axis=1),
            jnp.stack(sw_v_l, axis=1), jnp.stack(da_k_l, axis=1), jnp.stack(da_v_l, axis=1))
```

```cpp
#include <hip/hip_runtime.h>
#include <hip/hip_cooperative_groups.h>
#include <cstdio>
#include <cstdint>
namespace cg = cooperative_groups;

constexpr int DEPTH = 4, NCTX = 32, TCTX = 256, NLAT = 4, TLAT = 2048, PAST = 512;
constexpr int MCTX = 8192, MLAT = 8192, MTOT = 16384;
constexpr int DIN = 2304, DFF = 2816, DUP = 5632;
constexpr size_t OUT_X = 0, OUT_NAK = 16777216, OUT_NAV = 25165824, OUT_SWK = 33554432, OUT_SWV = 37748736, OUT_DAK = 41943040, OUT_DAV = 50331648, OUT_TOTAL = 58720256;
enum { I_XP = 0, I_XS, I_CNAK, I_CNAV, I_CSWK, I_CSWV, I_CDAK, I_CDAV, I_C, I_CCTX, I_GATTN, I_GFFN, I_WMOD, I_BMOD, I_WIN, I_NAG, I_RPB, I_SWG, I_SINK, I_DAG, I_LAMBDA, I_SUBG, I_WOUT, I_WUP, I_CONVW, I_CONVB, I_WDOWN, N_IN };
namespace nv {
constexpr int COL_QA = 0, COL_KA = 256, COL_VA = 512, COL_QB = 768, COL_KB = 1280, COL_VB = 1408, COL_QC = 1536, COL_KC = 1792, COL_VC = 2048;

__device__ __forceinline__ float wsum(float v) {
#pragma unroll
    for (int o = 1; o < 64; o <<= 1) v += __shfl_xor(v, o);
    return v;
}
__device__ __forceinline__ float wmax(float v) {
#pragma unroll
    for (int o = 1; o < 64; o <<= 1) v = fmaxf(v, __shfl_xor(v, o));
    return v;
}
__device__ __forceinline__ int row_b5(int row) { return row < MCTX ? 0 : 1 + ((row - MCTX) >> 11); }

__global__ void k_mod(const float* c, const float* c_ctx, const float* w_mod, const float* b_mod, float* mod) {
    const int total = DEPTH * 5 * 6144;
    for (int i = blockIdx.x * blockDim.x + threadIdx.x; i < total; i += gridDim.x * blockDim.x) {
        const int n = i % 6144, b5 = (i / 6144) % 5, l = i / (6144 * 5);
        const float* cv = b5 == 0 ? c_ctx : c + (b5 - 1) * 1024;
        const float* w = w_mod + (size_t)l * 1024 * 6144 + n;
        float acc = b_mod[l * 6144 + n];
        for (int k = 0; k < 1024; ++k) { const float v = cv[k]; acc += (v / (1.f + expf(-v))) * w[(size_t)k * 6144]; }
        mod[i] = acc;
    }
}
__global__ void k_adaln(const float* x, const float* g, const float* mod, int l, int which  , float* h) {
    const int lane = threadIdx.x & 63, wave = (blockIdx.x * blockDim.x + threadIdx.x) >> 6, nw = (gridDim.x * blockDim.x) >> 6;
    for (int row = wave; row < MTOT; row += nw) {
        const float* xr = x + (size_t)row * 1024; float v[16]; float s = 0.f;
#pragma unroll
        for (int j = 0; j < 16; ++j) { v[j] = xr[lane + 64 * j]; s += v[j] * v[j]; }
        s = wsum(s); const float rstd = 1.0f / sqrtf(s * (1.f / 1024.f) + 1e-6f);
        const float* m = mod + ((size_t)(l * 5 + row_b5(row)) * 6) * 1024; const float* shift = m + (which ? 3 : 0) * 1024; const float* scale = m + (which ? 4 : 1) * 1024;
#pragma unroll
        for (int j = 0; j < 16; ++j) { const int c = lane + 64 * j; h[(size_t)row * 1024 + c] = v[j] * rstd * g[l * 1024 + c] * (1.f + scale[c]) + shift[c]; }
    }
}
__global__ void __launch_bounds__(256) k_gemm(const float* A, int lda, const float* B, int ldb, float* C, int ldc, int M, int N, int K) {
    __shared__ float As[16][64 + 4]; __shared__ float Bs[16][64 + 4];
    const int tid = threadIdx.x, tx = tid & 15, ty = tid >> 4;
    const int ntn = N / 64, ntiles = (M / 64) * ntn;
    for (int tile = blockIdx.x; tile < ntiles; tile += gridDim.x) {
        const int m0 = (tile / ntn) * 64, n0 = (tile % ntn) * 64;
        float acc[4][4];
#pragma unroll
        for (int i = 0; i < 4; ++i)
#pragma unroll
            for (int j = 0; j < 4; ++j) acc[i][j] = 0.f;
        for (int k0 = 0; k0 < K; k0 += 16) {
#pragma unroll
            for (int i = 0; i < 4; ++i) { const int e = tid + 256 * i, r = e >> 4, kk = e & 15; As[kk][r] = A[(size_t)(m0 + r) * lda + k0 + kk]; }
#pragma unroll
            for (int i = 0; i < 4; ++i) { const int e = tid + 256 * i, kk = e >> 6, cc = e & 63; Bs[kk][cc] = B[(size_t)(k0 + kk) * ldb + n0 + cc]; }
            __syncthreads();
#pragma unroll
            for (int kk = 0; kk < 16; ++kk) {
                float a[4], b[4];
#pragma unroll
                for (int i = 0; i < 4; ++i) { a[i] = As[kk][ty * 4 + i]; b[i] = Bs[kk][tx * 4 + i]; }
#pragma unroll
                for (int i = 0; i < 4; ++i)
#pragma unroll
                    for (int j = 0; j < 4; ++j) acc[i][j] += a[i] * b[j];
            }
            __syncthreads();
        }
#pragma unroll
        for (int i = 0; i < 4; ++i)
#pragma unroll
            for (int j = 0; j < 4; ++j) C[(size_t)(m0 + ty * 4 + i) * ldc + n0 + tx * 4 + j] = acc[i][j];
    }
}
__device__ __forceinline__ float rope_inv(int i, int n) { return 1.0f / powf(10000.0f, (float)i / (float)n); }
__global__ void k_qknorm(float* P, int l, const float* na_g, const float* sw_g, const float* da_g, float* out) {
    const int lane = threadIdx.x & 63, wave = (blockIdx.x * blockDim.x + threadIdx.x) >> 6, nw = (gridDim.x * blockDim.x) >> 6;
    for (int row = wave; row < MTOT; row += nw) {
        float* p = P + (size_t)row * DIN;
        const bool lat = row >= MCTX; const int t = (row - MCTX) & 2047; const float grow = (float)(t >> 6), gcol = (float)(t & 63);
        for (int u = 0; u < 18; ++u) {
            int col; const float* g; bool rope;
            if (u < 4) { col = COL_QA + 64 * u; g = na_g + (l * 2 + 0) * 64; rope = false; }
            else if (u < 8) { col = COL_KA + 64 * (u - 4); g = na_g + (l * 2 + 1) * 64; rope = false; }
            else if (u < 16) { col = COL_QB + 64 * (u - 8); g = sw_g + (l * 2 + 0) * 64; rope = true; }
            else { col = COL_KB + 64 * (u - 16); g = sw_g + (l * 2 + 1) * 64; rope = true; }
            float v = p[col + lane]; const float ss = wsum(v * v); v = v * (1.0f / sqrtf(ss * (1.f / 64.f) + 1e-6f)) * g[lane];
            if (rope && lat) { const int i = lane >> 1; const float ang = (i < 16 ? grow : gcol) * rope_inv(i & 15, 16); const float cs = cosf(ang), sn = sinf(ang);
                const float o = __shfl_xor(v, 1); v = (lane & 1) ? (o * sn + v * cs) : (v * cs - o * sn); }
            p[col + lane] = v;
        }
        for (int u = 0; u < 8; ++u) {
            const int col = (u < 4 ? COL_QC : COL_KC) + 64 * (u & 3); const float* g = da_g + (l * 2 + (u < 4 ? 0 : 1)) * 32;
            float v = p[col + lane]; float ss = v * v;
#pragma unroll
            for (int o = 1; o < 32; o <<= 1) ss += __shfl_xor(ss, o);
            v = v * (1.0f / sqrtf(ss * (1.f / 32.f) + 1e-6f)) * g[lane & 31];
            if (lat) { const int i = (lane & 31) >> 1; const float ang = (i < 8 ? grow : gcol) * rope_inv(i & 7, 8); const float cs = cosf(ang), sn = sinf(ang);
                const float o = __shfl_xor(v, 1); v = (lane & 1) ? (o * sn + v * cs) : (v * cs - o * sn); }
            p[col + lane] = v;
        }
        if (!lat) {
            const int b = row >> 8, tt = row & 255; const size_t r4 = (size_t)(b * DEPTH + l) * 256 + tt;
            for (int j = 0; j < 4; ++j) { out[OUT_NAK + r4 * 256 + lane + 64 * j] = p[COL_KA + lane + 64 * j]; out[OUT_NAV + r4 * 256 + lane + 64 * j] = p[COL_VA + lane + 64 * j];
                out[OUT_DAK + r4 * 256 + lane + 64 * j] = p[COL_KC + lane + 64 * j]; out[OUT_DAV + r4 * 256 + lane + 64 * j] = p[COL_VC + lane + 64 * j]; }
            for (int j = 0; j < 2; ++j) { out[OUT_SWK + r4 * 128 + lane + 64 * j] = p[COL_KB + lane + 64 * j]; out[OUT_SWV + r4 * 128 + lane + 64 * j] = p[COL_VB + lane + 64 * j]; }
        }
    }
}
struct AttnP { const float* P; float* O; const float* cnak; const float* cnav; const float* cswk; const float* cswv; const float* cdak; const float* cdav;
               const float* rpb; const float* sink; const float* lam4; const float* subg; int l; int pad; };
constexpr int NV_MAXK = 2560;
__global__ void __launch_bounds__(256) k_attn(AttnP a) {
    __shared__ float sc[4][NV_MAXK]; __shared__ float qs_[4][64];
    const int lane = threadIdx.x & 63, wib = threadIdx.x >> 6, wave = blockIdx.x * 4 + wib, nw = gridDim.x * 4;
    float* S = sc[wib]; float* Q = qs_[wib];
    const int l = a.l;
    const float lam_init = 0.8f - 0.6f * expf(-0.3f * (float)l);
    for (int item = wave; item < MTOT * 16; item += nw) {
        const int row = item >> 4, slot = item & 15;
        const bool lat = row >= MCTX;
        const int b = lat ? ((row - MCTX) >> 11) : (row >> 8), t = lat ? ((row - MCTX) & 2047) : (row & 255);
        const int T = lat ? TLAT : TCTX; const int seq0 = lat ? MCTX + b * TLAT : b * TCTX;
        const int kind = slot < 4 ? 0 : (slot < 12 ? 1 : 2); const int h = kind == 0 ? slot : (kind == 1 ? slot - 4 : slot - 12);
        const int hk = kind == 1 ? (h >> 2) : h;
        const int ncomp = kind == 2 ? 2 : 1, dk = kind == 2 ? 32 : 64;
        const float scale = kind == 2 ? 0.17677669529663687f : 0.125f;
        const int qcolb = kind == 0 ? COL_QA : (kind == 1 ? COL_QB : COL_QC), kcolb = kind == 0 ? COL_KA : (kind == 1 ? COL_KB : COL_KC), vcolb = kind == 0 ? COL_VA : (kind == 1 ? COL_VB : COL_VC);
        const int HK = kind == 1 ? 2 : 4;
        const float* ck = kind == 0 ? a.cnak : (kind == 1 ? a.cswk : a.cdak); const float* cv = kind == 0 ? a.cnav : (kind == 1 ? a.cswv : a.cdav);
        int nloc, ncache = lat ? PAST : 0;
        const int qrow = t >> 6, qcol = t & 63;
        int r0 = 0, c0 = 0, qs = 0;
        if (!lat) nloc = 256;
        else if (kind == 0) { nloc = 256; r0 = min(max(qrow - 4, 0), 24); const int cb = qcol >> 4; c0 = min(max(cb * 16 - 8, 0), 32); qs = min(max(qcol - 8, 0), 48); }
        else if (kind == 1) { nloc = 384; }
        else nloc = TLAT;
        const int nk = nloc + ncache;
        float oacc[2] = {0.f, 0.f};
        for (int comp = 0; comp < ncomp; ++comp) {
            Q[lane] = a.P[(size_t)row * DIN + qcolb + h * 64 + lane];
            __builtin_amdgcn_s_waitcnt(0); __builtin_amdgcn_wave_barrier();
            float mx = -INFINITY;
            for (int j = lane; j < nk; j += 64) {
                const float* kp; bool valid = true; float bias = 0.f;
                if (j < nloc) {
                    int kt;
                    if (!lat) kt = j;
                    else if (kind == 0) { const int aa = j >> 5, kk = j & 31; const int krow = r0 + aa, kcol = c0 + kk; kt = krow * 64 + kcol; valid = (kcol >= qs) && (kcol < qs + 16);
                        const int coff = min(max(kcol - qcol, -15), 15) + 15; bias = a.rpb[((l * 4 + h) * 15 + (krow - qrow + 7)) * 31 + coff]; }
                    else if (kind == 1) { const int blk = t >> 7; kt = blk * 128 - 128 + j; valid = (kt >= 0) && (kt < T) && (abs(kt - t) <= 128); }
                    else kt = j;
                    kp = a.P + (size_t)(seq0 + (valid ? kt : 0)) * DIN + kcolb + hk * 64 + comp * 32;
                } else { const int p = j - nloc; kp = ck + ((((size_t)b * DEPTH + l) * PAST + p) * HK + hk) * 64 + comp * 32; }
                float s = 0.f;
                for (int d = 0; d < dk; ++d) s += Q[comp * 32 + d] * kp[d];
                s = valid ? s * scale + bias : -INFINITY;
                S[j] = s; mx = fmaxf(mx, s);
            }
            float sinkv = 0.f; bool has_sink = (kind == 1);
            if (has_sink) { sinkv = a.sink[l * 8 + h]; mx = fmaxf(mx, sinkv); }
            mx = wmax(mx);
            float sum = 0.f;
            __builtin_amdgcn_s_waitcnt(0); __builtin_amdgcn_wave_barrier();
            for (int j = lane; j < nk; j += 64) { const float e = expf(S[j] - mx); S[j] = e; sum += e; }
            sum = wsum(sum); if (has_sink) sum += expf(sinkv - mx);
            __builtin_amdgcn_s_waitcnt(0); __builtin_amdgcn_wave_barrier();
            float o = 0.f;
            for (int j = 0; j < nk; ++j) {
                const float pj = S[j]; if (pj == 0.f) continue;
                const float* vp;
                if (j < nloc) {
                    int kt;
                    if (!lat) kt = j;
                    else if (kind == 0) { const int aa = j >> 5, kk = j & 31; kt = (r0 + aa) * 64 + c0 + kk; }
                    else if (kind == 1) { kt = (t >> 7) * 128 - 128 + j; }
                    else kt = j;
                    vp = a.P + (size_t)(seq0 + kt) * DIN + vcolb + hk * 64;
                } else { const int p = j - nloc; vp = cv + ((((size_t)b * DEPTH + l) * PAST + p) * HK + hk) * 64; }
                o += pj * vp[lane];
            }
            oacc[comp] = o / sum;
            __builtin_amdgcn_s_waitcnt(0); __builtin_amdgcn_wave_barrier();
        }
        float res;
        if (kind == 2) { const float lam = a.lam4[l]; float v = oacc[0] - lam * oacc[1]; const float ss = wsum(v * v); res = v * (1.0f / sqrtf(ss * (1.f / 64.f) + 1e-6f)) * a.subg[l * 64 + lane] * (1.0f - lam_init); }
        else res = oacc[0];
        const int ocol = kind == 0 ? h * 64 : (kind == 1 ? 256 + h * 64 : 768 + h * 64);
        a.O[(size_t)row * 1024 + ocol + lane] = res;
    }
}
__global__ void k_lam(const float* da_lambda, float* lam4) {
    const int l = threadIdx.x; if (l >= DEPTH) return;
    const float* lp = da_lambda + l * 4 * 32; float s1 = 0.f, s2 = 0.f;
    for (int i = 0; i < 32; ++i) { s1 += lp[i] * lp[32 + i]; s2 += lp[64 + i] * lp[96 + i]; }
    lam4[l] = expf(s1) - expf(s2) + (0.8f - 0.6f * expf(-0.3f * (float)l));
}
__global__ void k_residual(float* x, const float* mod, int l, int which, const float* Y, int row0, int nrows) {
    const size_t total = (size_t)nrows * 1024;
    for (size_t i = (size_t)blockIdx.x * blockDim.x + threadIdx.x; i < total; i += (size_t)gridDim.x * blockDim.x) {
        const int row = row0 + (int)(i >> 10), c = (int)(i & 1023);
        const float* gate = mod + ((size_t)(l * 5 + row_b5(row)) * 6 + (which ? 5 : 2)) * 1024;
        x[(size_t)row * 1024 + c] += gate[c] * Y[i];
    }
}
__global__ void k_convact(const float* U, const float* cw, const float* cb, int l, float* ACT, int nrows, int T) {
    const size_t total = (size_t)nrows * DFF;
    for (size_t i = (size_t)blockIdx.x * blockDim.x + threadIdx.x; i < total; i += (size_t)gridDim.x * blockDim.x) {
        const int r = (int)(i / DFF), f = (int)(i % DFF); const int t = r % T;
        float y[2];
#pragma unroll
        for (int hh = 0; hh < 2; ++hh) { const int c = f + hh * DFF; float v = cb[l * DUP + c];
            if (t > 0) v += U[(size_t)(r - 1) * DUP + c] * cw[(l * 3 + 0) * DUP + c];
            v += U[(size_t)r * DUP + c] * cw[(l * 3 + 1) * DUP + c];
            if (t < T - 1) v += U[(size_t)(r + 1) * DUP + c] * cw[(l * 3 + 2) * DUP + c];
            y[hh] = v; }
        ACT[i] = (y[0] / (1.f + expf(-y[0]))) * y[1];
    }
}
__global__ void k_copyx(const float* xp, const float* xs, float* out) {
    for (size_t i = (size_t)blockIdx.x * blockDim.x + threadIdx.x; i < (size_t)MCTX * 1024; i += (size_t)gridDim.x * blockDim.x) { out[i] = xp[i]; out[(size_t)MCTX * 1024 + i] = xs[i]; }
}
}
extern "C" void kernel_launch(void* const* d_in, const int* in_sizes, int n_in, void* d_out, int out_size, void* d_ws, size_t ws_size, hipStream_t stream) {
    const float* in[N_IN]; for (int i = 0; i < N_IN; ++i) in[i] = (const float*)d_in[i];
    float* out = (float*)d_out; float* ws = (float*)d_ws;
    float* MODF = ws; float* LAM = ws + 131072 - 64; float* H = ws + 131072; float* P = H + (size_t)MTOT * 1024; float* Y = P + (size_t)MTOT * DIN;
    float* U = P; float* ACT = P + (size_t)4096 * DUP;
    nv::k_copyx<<<2048, 256, 0, stream>>>(in[I_XP], in[I_XS], out);
    nv::k_mod<<<480, 256, 0, stream>>>(in[I_C], in[I_CCTX], in[I_WMOD], in[I_BMOD], MODF);
    nv::k_lam<<<1, 64, 0, stream>>>(in[I_LAMBDA], LAM);
    for (int l = 0; l < DEPTH; ++l) {
        nv::k_adaln<<<2048, 256, 0, stream>>>(out, in[I_GATTN], MODF, l, 0, H);
        nv::k_gemm<<<4096, 256, 0, stream>>>(H, 1024, in[I_WIN] + (size_t)l * 1024 * DIN, DIN, P, DIN, MTOT, DIN, 1024);
        nv::k_qknorm<<<2048, 256, 0, stream>>>(P, l, in[I_NAG], in[I_SWG], in[I_DAG], out);
        nv::AttnP ap{}; ap.P = P; ap.O = H; ap.cnak = in[I_CNAK]; ap.cnav = in[I_CNAV]; ap.cswk = in[I_CSWK]; ap.cswv = in[I_CSWV]; ap.cdak = in[I_CDAK]; ap.cdav = in[I_CDAV]; ap.rpb = in[I_RPB]; ap.sink = in[I_SINK]; ap.lam4 = LAM; ap.subg = in[I_SUBG]; ap.l = l; ap.pad = 0;
        nv::k_attn<<<4096, 256, 0, stream>>>(ap);
        nv::k_gemm<<<4096, 256, 0, stream>>>(H, 1024, in[I_WOUT] + (size_t)l * 1024 * 1024, 1024, Y, 1024, MTOT, 1024, 1024);
        nv::k_residual<<<2048, 256, 0, stream>>>(out, MODF, l, 0, Y, 0, MTOT);
        nv::k_adaln<<<2048, 256, 0, stream>>>(out, in[I_GFFN], MODF, l, 1, H);
        for (int ch = 0; ch < 4; ++ch) {
            nv::k_gemm<<<4096, 256, 0, stream>>>(H + (size_t)ch * 4096 * 1024, 1024, in[I_WUP] + (size_t)l * 1024 * DUP, DUP, U, DUP, 4096, DUP, 1024);
            nv::k_convact<<<4096, 256, 0, stream>>>(U, in[I_CONVW], in[I_CONVB], l, ACT, 4096, ch < 2 ? TCTX : TLAT);
            nv::k_gemm<<<4096, 256, 0, stream>>>(ACT, DFF, in[I_WDOWN] + (size_t)l * DFF * 1024, 1024, Y, 1024, 4096, 1024, DFF);
            nv::k_residual<<<2048, 256, 0, stream>>>(out, MODF, l, 1, Y, ch * 4096, 4096);
        }
    }
}
```

```cpp
#include <hip/hip_runtime.h>
#include <hip/hip_cooperative_groups.h>
#include <cstdio>
#include <cstdint>
namespace cg = cooperative_groups;

constexpr int DEPTH = 4, NCTX = 32, TCTX = 256, NLAT = 4, TLAT = 2048, PAST = 512;
constexpr int MCTX = 8192, MLAT = 8192, MTOT = 16384;
constexpr int DIN = 2304, DFF = 2816, DUP = 5632;
constexpr size_t OUT_X = 0, OUT_NAK = 16777216, OUT_NAV = 25165824, OUT_SWK = 33554432, OUT_SWV = 37748736, OUT_DAK = 41943040, OUT_DAV = 50331648, OUT_TOTAL = 58720256;
enum { I_XP = 0, I_XS, I_CNAK, I_CNAV, I_CSWK, I_CSWV, I_CDAK, I_CDAV, I_C, I_CCTX, I_GATTN, I_GFFN, I_WMOD, I_BMOD, I_WIN, I_NAG, I_RPB, I_SWG, I_SINK, I_DAG, I_LAMBDA, I_SUBG, I_WOUT, I_WUP, I_CONVW, I_CONVB, I_WDOWN, N_IN };
#define LAS __attribute__((address_space(3)))
typedef unsigned short bf16_t;
typedef short bf16x8 __attribute__((ext_vector_type(8)));
typedef float f32x4 __attribute__((ext_vector_type(4)));
typedef float f32x2 __attribute__((ext_vector_type(2)));
typedef float f32x16 __attribute__((ext_vector_type(16)));
typedef unsigned u32x4 __attribute__((ext_vector_type(4)));
typedef unsigned u32x2 __attribute__((ext_vector_type(2)));
typedef __bf16 bf16x2_t __attribute__((ext_vector_type(2)));

constexpr float LOG2E = 1.4426950408889634f;
constexpr float QSCALE64 = 0.125f * LOG2E, QSCALE32 = 0.17677669529663687f * LOG2E;

__device__ __forceinline__ unsigned cvt_pk_bf16(float lo, float hi) { f32x2 v = {lo, hi}; bf16x2_t b = __builtin_convertvector(v, bf16x2_t); return __builtin_bit_cast(unsigned, b); }
__device__ __forceinline__ float bf16_to_f32(bf16_t v) { return __builtin_bit_cast(float, (unsigned)v << 16); }
__device__ __forceinline__ int row_b5(int row) { return row < MCTX ? 0 : 1 + ((row - MCTX) >> 11); }

constexpr size_t MiB = 1u << 20;
constexpr size_t WS_CTL = 0;
constexpr size_t WS_MOD = 1 * MiB;
constexpr size_t WS_GV = WS_MOD + 512 * 1024;
constexpr size_t WS_BIASIN = WS_GV + 256 * 1024;
constexpr size_t WS_BIASUP = WS_BIASIN + 256 * 1024;
constexpr size_t WS_LAM = WS_BIASUP + 512 * 1024;
constexpr int SM_LAM = 0, SM_GAINS = 64, SM_RPB = SM_GAINS + 1280, SM_SINK = SM_RPB + 7440, SM_SUBG = SM_SINK + 32, SM_END = SM_SUBG + 256;
constexpr size_t WS_ROPEB = 3 * MiB;
constexpr size_t WS_ROPEC = WS_ROPEB + 512 * 1024;
constexpr size_t WS_SSQ = 4 * MiB;
constexpr size_t WS_WIN = 5 * MiB;
constexpr size_t WS_WOUT = WS_WIN + 18 * MiB;
constexpr size_t WS_WUP = WS_WOUT + 8 * MiB;
constexpr size_t WS_WDOWN = WS_WUP + 44 * MiB;
constexpr size_t WS_KC = WS_WDOWN + 22 * MiB;
constexpr size_t WS_XA = WS_KC + 20 * MiB;
constexpr size_t WS_QKV = WS_XA + 32 * MiB;
constexpr size_t WS_O = WS_QKV + 72 * MiB;
constexpr size_t WS_ACT = WS_QKV;
constexpr size_t WS_U = WS_O + 32 * MiB;
constexpr size_t WS_END = WS_U + 88 * MiB;
constexpr size_t GS4 = 2097152, GS8 = 4194304, GS2 = 1048576;
constexpr size_t QO_QA = 0, QO_KA = QO_QA + 2 * GS4, QO_VTA = QO_KA + 2 * GS4, QO_QB = QO_VTA + 2 * GS4, QO_KB = QO_QB + 2 * GS8, QO_VTB = QO_KB + 2 * GS2,
                 QO_QC = QO_VTB + 2 * GS2, QO_KC = QO_QC + 2 * GS4, QO_VTC = QO_KC + 2 * GS4, QO_END = QO_VTC + 2 * GS4;
static_assert(QO_END * 2 == 72 * MiB, "qkv region");
constexpr size_t CO_KA = 0, CO_VTA = CO_KA + GS4, CO_KB = CO_VTA + GS4, CO_VTB = CO_KB + GS2, CO_KCC = CO_VTB + GS2, CO_VTCC = CO_KCC + GS4;

struct Args { const float* in[N_IN]; float* out; unsigned char* ws; };
__device__ __forceinline__ int opaque_tid() { int t = threadIdx.x; asm volatile("" : "+v"(t)); return t; }

namespace pg8 {
#define PG8_LAS __attribute__((address_space(3)))
constexpr int BM = 256, BK = 64, HALF = 128, HTB = HALF * BK * 2  , STAGE_BYTES = 8 * HTB, NXCD = 8, WGM = 8;
__host__ __device__ __forceinline__ int lds_byte(int r, int c) { const int st = (r >> 4) * 2 + (c >> 5), rr = r & 15, cc = c & 31, ob = rr * 64 + cc * 2; return st * 1024 + (ob ^ (((ob >> 9) & 1) << 5)); }
__host__ __device__ __forceinline__ void stage_rc(int b, int& R, int& C) { const int st = b / 1024, sb = b % 1024, swz = sb ^ (((sb >> 9) & 1) << 5); R = (st >> 1) * 16 + swz / 64; C = (st & 1) * 32 + (swz % 64) / 2; }
__host__ __device__ __forceinline__ int perm32(int rho) { const int n = rho >> 4, i = rho & 15; return 8 * (i >> 2) + 4 * n + (i & 3); }
struct Unit { int pm, pn; };
struct Gemm { const bf16_t* A; const bf16_t* Bt; int M, N, K; };
struct StaticOrder {
    int nM, nN, nwg, G, c;
    __host__ __device__ void init(int M, int N, int G_, int c_) { nM = M / BM; nN = N / BM; nwg = nM * nN; G = G_; c = c_; }
    __host__ __device__ bool next(int i, Unit& u) const {
        const long L = (long)i * G + c; if (L >= nwg) return false;
        int wgid = (int)L; { const int q = nwg / NXCD, r = nwg % NXCD, xcd = wgid % NXCD, off = wgid / NXCD; wgid = (xcd < r ? xcd * (q + 1) : r * (q + 1) + (xcd - r) * q) + off; }
        const int nig = WGM * nN, gid = wgid / nig, fm = gid * WGM, gsz = (nM - fm) < WGM ? (nM - fm) : WGM;
        u.pm = fm + ((wgid % nig) % gsz); u.pn = (wgid % nig) / gsz; return true;
    }
    __device__ __forceinline__ void a_ready(const Unit&) const {}
    __device__ __forceinline__ void done(const Unit&) const {}
};

template <class Epi, class Sched, bool ALIGN_EPI = false, bool SP2 = false>
__device__ __forceinline__ void gemm_phase(PG8_LAS unsigned char* lds, const Gemm g, const Sched& S, const Epi& E) {
    const int tid = opaque_tid(), wid = __builtin_amdgcn_readfirstlane(tid >> 6), lane = tid & 63, wr = wid >> 2, wc = wid & 3, fr = lane & 15, fq = lane >> 4;
    const int K = g.K, nt = K / BK;
    unsigned voffA[2], voffB[2];
#pragma unroll
    for (int i = 0; i < 2; ++i) { int R, C; stage_rc(tid * 16 + i * 8192, R, C); const int Rb = Epi::PERM ? ((R & ~31) + perm32(R & 31)) : R;
        voffA[i] = (unsigned)(R * K + C) * 2u; voffB[i] = (unsigned)(Rb * K + C) * 2u; }
    const size_t kstep = (size_t)(BK * 2);
    const size_t hstep = (size_t)HALF * K * 2;
    const size_t tstep = 2 * hstep;
    const unsigned ldsw = (unsigned)wid * 1024u;
    const int aoff = lds_byte(wr * 64 + fr, fq * 8), boff = lds_byte(wc * 32 + fr, fq * 8);
#define PG8_SA(b, h) (((b) * 2 + (h)) * HTB)
#define PG8_SB(b, h) ((4 + (b) * 2 + (h)) * HTB)
#define PG8_STAGE(bufoff, gbase, voff) do { _Pragma("unroll") for (int _i = 0; _i < 2; ++_i) \
        __builtin_amdgcn_global_load_lds((const unsigned*)((const char*)(gbase) + (voff)[_i]), (PG8_LAS unsigned*)(lds + (bufoff) + ldsw + _i * 8192), 16, 0, 0); } while (0)
#define PG8_LDA(dst, b, h) do { _Pragma("unroll") for (int m = 0; m < 4; ++m) _Pragma("unroll") for (int k = 0; k < 2; ++k) dst[m][k] = *(const PG8_LAS bf16x8*)(lds + PG8_SA(b, h) + aoff + m * 2048 + k * 1024); } while (0)
#define PG8_LDB(dst, b, h) do { _Pragma("unroll") for (int n = 0; n < 2; ++n) _Pragma("unroll") for (int k = 0; k < 2; ++k) dst[n][k] = *(const PG8_LAS bf16x8*)(lds + PG8_SB(b, h) + boff + n * 2048 + k * 1024); } while (0)
#define PG8_MMA(ai, bj, At, Bt) do { __builtin_amdgcn_s_setprio(1); _Pragma("unroll") for (int m = 0; m < 4; ++m) _Pragma("unroll") for (int n = 0; n < 2; ++n) _Pragma("unroll") for (int k = 0; k < 2; ++k) \
        acc[ai][bj][m][n] = __builtin_amdgcn_mfma_f32_16x16x32_bf16(Bt[n][k], At[m][k], acc[ai][bj][m][n], 0, 0, 0); __builtin_amdgcn_s_setprio(0); } while (0)
#define PG8_WAIT_V(n) asm volatile("s_waitcnt vmcnt(" #n ")" ::: "memory")
#define PG8_WAIT_L(n) asm volatile("s_waitcnt lgkmcnt(" #n ")" ::: "memory")
#define PG8_BAR __builtin_amdgcn_s_barrier()
#define PG8_SCHED __builtin_amdgcn_sched_barrier(0)
    Unit cur, nxt; int ui = 0;
    if (!S.next(0, cur)) return;
    f32x4 acc[2][2][4][2];
#pragma unroll
    for (int a = 0; a < 2; ++a)
#pragma unroll
        for (int b = 0; b < 2; ++b)
#pragma unroll
            for (int m = 0; m < 4; ++m)
#pragma unroll
                for (int n = 0; n < 2; ++n) acc[a][b][m][n] = (f32x4){0.f, 0.f, 0.f, 0.f};
    bf16x8 At[4][2], B0[2][2], B1[2][2];
    const char* cA = (const char*)g.A + (size_t)cur.pm * tstep; const char* cB = (const char*)g.Bt + (size_t)cur.pn * tstep;
    S.a_ready(cur);
    if constexpr (SP2) {
        PG8_STAGE(PG8_SB(0, 0), cB, voffB); PG8_STAGE(PG8_SB(0, 1), cB + hstep, voffB); PG8_STAGE(PG8_SA(0, 0), cA, voffA); PG8_STAGE(PG8_SA(0, 1), cA + hstep, voffA);
        if (wr == 1) PG8_BAR;
        PG8_WAIT_V(2); PG8_BAR;
        PG8_STAGE(PG8_SB(1, 0), cB + kstep, voffB); PG8_STAGE(PG8_SA(1, 0), cA + kstep, voffA); PG8_STAGE(PG8_SB(1, 1), cB + hstep + kstep, voffB);
        PG8_WAIT_V(6); PG8_BAR;
    } else {
        PG8_STAGE(PG8_SB(0, 0), cB, voffB); PG8_STAGE(PG8_SA(0, 0), cA, voffA); PG8_STAGE(PG8_SB(0, 1), cB + hstep, voffB); PG8_STAGE(PG8_SA(0, 1), cA + hstep, voffA);
        if (wr == 1) PG8_BAR;
        PG8_WAIT_V(4); PG8_BAR;
        PG8_STAGE(PG8_SB(1, 0), cB + kstep, voffB); PG8_STAGE(PG8_SA(1, 0), cA + kstep, voffA); PG8_STAGE(PG8_SB(1, 1), cB + hstep + kstep, voffB);
        PG8_WAIT_V(6); PG8_BAR;
    }
    for (;;) {
        const bool has_next = S.next(ui + 1, nxt);
        const char* nA = has_next ? (const char*)g.A + (size_t)nxt.pm * tstep : cA; const char* nB = has_next ? (const char*)g.Bt + (size_t)nxt.pn * tstep : cB;
        for (int t = 0; t < nt; t += 2) {
            const bool last = (t == nt - 2);
            const char* a1 = cA + (size_t)(t + 1) * kstep;
            const char* a2 = last ? nA : cA + (size_t)(t + 2) * kstep; const char* b2 = last ? nB : cB + (size_t)(t + 2) * kstep;
            const char* a3 = a2 + kstep; const char* b3 = b2 + kstep;
            if (last && has_next) S.a_ready(nxt);
            if constexpr (SP2) {
            PG8_LDB(B0, 0, 0); PG8_LDB(B1, 0, 1); PG8_SCHED; PG8_LDA(At, 0, 0); PG8_STAGE(PG8_SA(1, 1), a1 + hstep, voffA);
            PG8_WAIT_V(8); PG8_WAIT_L(0); PG8_BAR; PG8_MMA(0, 0, At, B0); PG8_MMA(0, 1, At, B1); PG8_BAR; PG8_SCHED;
            PG8_LDA(At, 0, 1); PG8_STAGE(PG8_SB(0, 0), b2, voffB); PG8_STAGE(PG8_SB(0, 1), b2 + hstep, voffB); PG8_STAGE(PG8_SA(0, 0), a2, voffA);
            PG8_WAIT_V(8); PG8_WAIT_L(0); PG8_BAR; PG8_MMA(1, 0, At, B0); PG8_MMA(1, 1, At, B1); PG8_BAR; PG8_SCHED;
            PG8_LDB(B0, 1, 0); PG8_LDB(B1, 1, 1); PG8_SCHED; PG8_LDA(At, 1, 0); PG8_STAGE(PG8_SA(0, 1), a2 + hstep, voffA);
            PG8_WAIT_V(8); PG8_WAIT_L(0); PG8_BAR; PG8_MMA(0, 0, At, B0); PG8_MMA(0, 1, At, B1); PG8_BAR; PG8_SCHED;
            PG8_LDA(At, 1, 1); PG8_STAGE(PG8_SB(1, 0), b3, voffB); PG8_STAGE(PG8_SB(1, 1), b3 + hstep, voffB); PG8_STAGE(PG8_SA(1, 0), a3, voffA);
            PG8_WAIT_V(8); PG8_WAIT_L(0); PG8_BAR; PG8_MMA(1, 0, At, B0); PG8_MMA(1, 1, At, B1); PG8_BAR; PG8_SCHED;
            } else {
            PG8_LDB(B0, 0, 0); PG8_SCHED; PG8_LDA(At, 0, 0); PG8_STAGE(PG8_SA(1, 1), a1 + hstep, voffA);
            PG8_WAIT_L(8); PG8_BAR; PG8_WAIT_L(0); PG8_MMA(0, 0, At, B0); PG8_BAR; PG8_SCHED;
            PG8_LDB(B1, 0, 1); PG8_STAGE(PG8_SB(0, 0), b2, voffB);
            PG8_BAR; PG8_WAIT_L(0); PG8_MMA(0, 1, At, B1); PG8_BAR;
            PG8_LDA(At, 0, 1); PG8_STAGE(PG8_SA(0, 0), a2, voffA);
            PG8_BAR; PG8_WAIT_L(0); PG8_MMA(1, 0, At, B0); PG8_BAR; PG8_SCHED;
            PG8_STAGE(PG8_SB(0, 1), b2 + hstep, voffB);
            PG8_WAIT_V(6); PG8_BAR; PG8_MMA(1, 1, At, B1); PG8_BAR;
            PG8_LDB(B0, 1, 0); PG8_SCHED; PG8_LDA(At, 1, 0); PG8_STAGE(PG8_SA(0, 1), a2 + hstep, voffA);
            PG8_WAIT_L(8); PG8_BAR; PG8_WAIT_L(0); PG8_MMA(0, 0, At, B0); PG8_BAR; PG8_SCHED;
            PG8_LDB(B1, 1, 1); PG8_STAGE(PG8_SB(1, 0), b3, voffB);
            PG8_BAR; PG8_WAIT_L(0); PG8_MMA(0, 1, At, B1); PG8_BAR;
            PG8_LDA(At, 1, 1); PG8_STAGE(PG8_SA(1, 0), a3, voffA);
            PG8_BAR; PG8_WAIT_L(0); PG8_MMA(1, 0, At, B0); PG8_BAR; PG8_SCHED;
            PG8_STAGE(PG8_SB(1, 1), b3 + hstep, voffB);
            PG8_WAIT_V(6); PG8_BAR; PG8_MMA(1, 1, At, B1); PG8_BAR;
            }
        }
        if constexpr (ALIGN_EPI) { if (wr == 0) PG8_BAR; }
        if constexpr (!Epi::AFTER_DRAIN) { E(acc, cur, wr, wc, fr, fq); S.done(cur); }
        if (!has_next) break;
#pragma unroll
        for (int a = 0; a < 2; ++a)
#pragma unroll
            for (int b = 0; b < 2; ++b)
#pragma unroll
                for (int m = 0; m < 4; ++m)
#pragma unroll
                    for (int n = 0; n < 2; ++n) acc[a][b][m][n] = (f32x4){0.f, 0.f, 0.f, 0.f};
        cur = nxt; cA = nA; cB = nB; ++ui;
        if constexpr (ALIGN_EPI) { if (wr == 1) PG8_BAR; }
    }
    PG8_WAIT_V(0);
    if constexpr (!ALIGN_EPI) { if (wr == 0) PG8_BAR; }
    PG8_BAR;
    if constexpr (Epi::AFTER_DRAIN) { E.fused(acc, cur, wr, wc, fr, fq, lds, wid, lane); S.done(cur); }
#undef PG8_SA
#undef PG8_SB
#undef PG8_STAGE
#undef PG8_LDA
#undef PG8_LDB
#undef PG8_MMA
#undef PG8_WAIT_V
#undef PG8_WAIT_L
#undef PG8_BAR
#undef PG8_SCHED
}

__device__ __forceinline__ float row_rstd(const float* ssq, int row) {
    const f32x4* p = (const f32x4*)(ssq + (size_t)row * 16); const f32x4 a = p[0], b = p[1], c = p[2], d = p[3];
    const float s = ((a[0] + a[1]) + (a[2] + a[3])) + ((b[0] + b[1]) + (b[2] + b[3])) + ((c[0] + c[1]) + (c[2] + c[3])) + ((d[0] + d[1]) + (d[2] + d[3]));
    return __builtin_amdgcn_rsqf(s * (1.0f / 1024.0f) + 1e-6f);
}

struct EpiIn {
    static constexpr bool PERM = false, AFTER_DRAIN = false;
    unsigned char* ws0; float* out; int l;
    __device__ __forceinline__ void operator()(const f32x4 (&acc)[2][2][4][2], const Unit& u, int wr, int wc, int fr_in, int fq_in) const {
        unsigned char* ws = ws0; asm volatile("" : "+s"(ws));
        int fr = fr_in, fq = fq_in; asm volatile("" : "+v"(fr), "+v"(fq));
        const float* ssq = (const float*)(ws + WS_SSQ); const float* bias = (const float*)(ws + WS_BIASIN) + (size_t)l * 5 * DIN;
        const float* gains = (const float*)(ws + WS_LAM) + SM_GAINS + l * 320; const float* nag = gains; const float* swg = gains + 128; const float* dag = gains + 256;
        const float* ropeB = (const float*)(ws + WS_ROPEB); const float* ropeC = (const float*)(ws + WS_ROPEC); bf16_t* qkv = (bf16_t*)(ws + WS_QKV);
        const int pm = u.pm, pn = u.pn;
        const int grp = pm >= 32 ? 1 : 0, b = grp ? ((pm - 32) >> 3) : pm, tbase = grp ? 256 * ((pm - 32) & 7) : 0, T = grp ? TLAT : TCTX, b5 = grp ? 1 + b : 0;
        int type, h;
        if (pn < 3) { type = pn; h = wc; } else if (pn < 5) { type = 3; h = 4 * (pn - 3) + wc; } else if (pn == 5) { type = wc < 2 ? 4 : 5; h = wc & 1; } else { type = pn; h = wc; }
        const bool isv = (type == 2 || type == 5 || type == 8), isq = (type == 0 || type == 3 || type == 6), is32 = (type == 6 || type == 7);
        const bool rope = grp && (type == 3 || type == 4 || type == 6 || type == 7);
        const int H = (type == 3) ? 8 : ((type == 4 || type == 5) ? 2 : 4);
        size_t dbase; const size_t gs = (type == 3) ? GS8 : ((type == 4 || type == 5) ? GS2 : GS4);
        switch (type) { case 0: dbase = QO_QA; break; case 1: dbase = QO_KA; break; case 2: dbase = QO_VTA; break; case 3: dbase = QO_QB; break; case 4: dbase = QO_KB; break; case 5: dbase = QO_VTB; break;
                        case 6: dbase = QO_QC; break; case 7: dbase = QO_KC; break; default: dbase = QO_VTC; break; }
        bf16_t* dst = qkv + dbase + grp * gs + (size_t)(b * H + h) * T * 64;
        float* fo = nullptr; int fow = 0, foc = 0;
        if (!grp) { switch (type) { case 1: fo = out + OUT_NAK; fow = 256; foc = 64 * wc; break; case 2: fo = out + OUT_NAV; fow = 256; foc = 64 * wc; break; case 4: fo = out + OUT_SWK; fow = 128; foc = 64 * h; break;
                        case 5: fo = out + OUT_SWV; fow = 128; foc = 64 * h; break; case 7: fo = out + OUT_DAK; fow = 256; foc = 64 * wc; break; case 8: fo = out + OUT_DAV; fow = 256; foc = 64 * wc; break; default: break; } }
        const float* gsrc = ((type == 0) ? nag : (type == 1) ? nag + 64 : (type == 3) ? swg : (type == 4) ? swg + 64 : (type == 6) ? dag : dag + 32) + 4 * fq;
        const float* bsrc = bias + b5 * DIN + pn * 256 + 64 * wc + 4 * fq;
        const float qs = isq ? (is32 ? QSCALE32 : QSCALE64) : 1.0f;
#pragma unroll
        for (int ai = 0; ai < 2; ++ai)
#pragma unroll
            for (int m = 0; m < 4; ++m) {
                const int lr = 128 * ai + 64 * wr + 16 * m + fr, row = 256 * pm + lr, t = tbase + lr;
                const float rstd = row_rstd(ssq, row);
                float r0 = 1.f, r1 = 1.f;
                if (!isv) {
                    float s0 = 0.f, s1 = 0.f;
#pragma unroll
                    for (int n = 0; n < 2; ++n) { const f32x4 a = acc[ai][0][m][n] * rstd + *(const f32x4*)(bsrc + 16 * n), c = acc[ai][1][m][n] * rstd + *(const f32x4*)(bsrc + 32 + 16 * n);
                        s0 += (a[0] * a[0] + a[1] * a[1]) + (a[2] * a[2] + a[3] * a[3]); s1 += (c[0] * c[0] + c[1] * c[1]) + (c[2] * c[2] + c[3] * c[3]); }
                    s0 += __shfl_xor(s0, 16); s0 += __shfl_xor(s0, 32); s1 += __shfl_xor(s1, 16); s1 += __shfl_xor(s1, 32);
                    if (is32) { r0 = __builtin_amdgcn_rsqf(s0 * (1.f / 32.f) + 1e-6f); r1 = __builtin_amdgcn_rsqf(s1 * (1.f / 32.f) + 1e-6f); }
                    else { r0 = r1 = __builtin_amdgcn_rsqf((s0 + s1) * (1.f / 64.f) + 1e-6f); }
                }
                float* fr_ = fo ? fo + ((size_t)(b * DEPTH + l) * 256 + t) * fow + foc + 4 * fq : nullptr;
#pragma unroll
                for (int bj = 0; bj < 2; ++bj)
#pragma unroll
                    for (int n = 0; n < 2; ++n) {
                        f32x4 x = acc[ai][bj][m][n] * rstd + *(const f32x4*)(bsrc + 32 * bj + 16 * n);
                        if (!isv) {
                            x = x * (bj ? r1 : r0) * *(const f32x4*)(gsrc + (is32 ? 0 : 32 * bj) + 16 * n);
                            if (rope) {
                                const f32x4 cs = is32 ? *(const f32x4*)(ropeC + ((size_t)t * 16 + 8 * n + 2 * fq) * 2) : *(const f32x4*)(ropeB + ((size_t)t * 32 + 16 * bj + 8 * n + 2 * fq) * 2);
                                x = (f32x4){x[0] * cs[0] - x[1] * cs[1], x[0] * cs[1] + x[1] * cs[0], x[2] * cs[2] - x[3] * cs[3], x[2] * cs[3] + x[3] * cs[2]};
                            }
                        }
                        if (fr_) *(f32x4*)(fr_ + 32 * bj + 16 * n) = x;
                        if (!isv) { const f32x4 y = x * qs; u32x2 w; w.x = cvt_pk_bf16(y[0], y[1]); w.y = cvt_pk_bf16(y[2], y[3]); *(u32x2*)(dst + (size_t)t * 64 + 4 * fq + 32 * bj + 16 * n) = w; }
                        else { const int d0 = 32 * bj + 16 * n + 4 * fq;
#pragma unroll
                            for (int e = 0; e < 4; ++e) dst[(size_t)(d0 + e) * T + t] = (bf16_t)(cvt_pk_bf16(x[e], 0.f) & 0xffffu); }
                    }
                asm volatile("" ::: "memory");
            }
    }
};

struct EpiRes {
    static constexpr bool PERM = false, AFTER_DRAIN = false;
    unsigned char* ws0; float* x; int l; int which;
    __device__ __forceinline__ void operator()(const f32x4 (&acc)[2][2][4][2], const Unit& u, int wr, int wc, int fr, int fq) const {
        unsigned char* ws = ws0; asm volatile("" : "+s"(ws));
        const float* gate = (const float*)(ws + WS_MOD) + (size_t)l * 5 * 6144 + (which ? 5 : 2) * 1024;
        const float* gvn = which ? (l < 3 ? (const float*)(ws + WS_GV) + (size_t)(l + 1) * 10240 : nullptr) : (const float*)(ws + WS_GV) + (size_t)l * 10240 + 1024;
        bf16_t* xa = (bf16_t*)(ws + WS_XA); float* ssq = (float*)(ws + WS_SSQ);
        const int pm = u.pm, pn = u.pn, b5 = pm >= 32 ? 1 + ((pm - 32) >> 3) : 0;
        const int col0 = 256 * pn + 32 * wc + 4 * fq;
        f32x4 gt[2][2], gn[2][2];
#pragma unroll
        for (int bj = 0; bj < 2; ++bj)
#pragma unroll
            for (int n = 0; n < 2; ++n) { gt[bj][n] = *(const f32x4*)(gate + (size_t)b5 * 6144 + col0 + 128 * bj + 16 * n); gn[bj][n] = gvn ? *(const f32x4*)(gvn + (size_t)b5 * 2048 + col0 + 128 * bj + 16 * n) : (f32x4){0.f, 0.f, 0.f, 0.f}; }
#pragma unroll
        for (int ai = 0; ai < 2; ++ai)
#pragma unroll
            for (int m = 0; m < 4; ++m) {
                const int row = 256 * pm + 128 * ai + 64 * wr + 16 * m + fr; float* xr = x + (size_t)row * 1024 + col0; float ss = 0.f;
#pragma unroll
                for (int bj = 0; bj < 2; ++bj)
#pragma unroll
                    for (int n = 0; n < 2; ++n) {
                        const f32x4 xo = *(const f32x4*)(xr + 128 * bj + 16 * n); const f32x4 xn = xo + gt[bj][n] * acc[ai][bj][m][n];
                        *(f32x4*)(xr + 128 * bj + 16 * n) = xn;
                        if (gvn) { ss += (xn[0] * xn[0] + xn[1] * xn[1]) + (xn[2] * xn[2] + xn[3] * xn[3]); const f32x4 y = xn * gn[bj][n]; u32x2 w; w.x = cvt_pk_bf16(y[0], y[1]); w.y = cvt_pk_bf16(y[2], y[3]);
                            *(u32x2*)(xa + (size_t)row * 1024 + col0 + 128 * bj + 16 * n) = w; }
                    }
                if (gvn) { ss += __shfl_xor(ss, 16); ss += __shfl_xor(ss, 32); if (fq == 0) ssq[(size_t)row * 16 + 4 * pn + wc] = ss; }
            }
    }
};

struct EpiUp {
    static constexpr bool PERM = true, AFTER_DRAIN = false;
    unsigned char* ws0; int l; int row_off;
    __device__ __forceinline__ void operator()(const f32x4 (&acc)[2][2][4][2], const Unit& u, int wr, int wc, int fr, int fq) const {
        unsigned char* ws = ws0; asm volatile("" : "+s"(ws));
        const float* ssq = (const float*)(ws + WS_SSQ); const float* bias = (const float*)(ws + WS_BIASUP) + (size_t)l * 5 * DUP; bf16_t* U = (bf16_t*)(ws + WS_U);
        const int pm = u.pm, pn = u.pn; const int grow0 = row_off + 256 * pm; const int b5 = row_b5(grow0);
        const int col0 = 256 * pn + 32 * wc + 8 * fq;
        f32x4 bv[2][2];
#pragma unroll
        for (int bj = 0; bj < 2; ++bj)
#pragma unroll
            for (int n = 0; n < 2; ++n) bv[bj][n] = *(const f32x4*)(bias + (size_t)b5 * DUP + col0 + 128 * bj + 4 * n);
#pragma unroll
        for (int ai = 0; ai < 2; ++ai)
#pragma unroll
            for (int m = 0; m < 4; ++m) {
                const int lr = 256 * pm + 128 * ai + 64 * wr + 16 * m + fr; const float rstd = row_rstd(ssq, row_off + lr);
#pragma unroll
                for (int bj = 0; bj < 2; ++bj) { const f32x4 v0 = acc[ai][bj][m][0] * rstd + bv[bj][0], v1 = acc[ai][bj][m][1] * rstd + bv[bj][1];
                    u32x4 w; w.x = cvt_pk_bf16(v0[0], v0[1]); w.y = cvt_pk_bf16(v0[2], v0[3]); w.z = cvt_pk_bf16(v1[0], v1[1]); w.w = cvt_pk_bf16(v1[2], v1[3]);
                    *(u32x4*)(U + (size_t)lr * DUP + col0 + 128 * bj) = w; }
            }
    }
};
}
namespace att {
typedef LAS unsigned char lds_u8;
constexpr int LDS_TILE = 16384;
constexpr int LDS_RPB = 2 * LDS_TILE;
constexpr int LDS_NEXT = LDS_RPB + 2048;
constexpr int NUNITS = 1024;

struct Ctx { unsigned char* ws; int l; };

__device__ __forceinline__ bf16x8 lds128(const lds_u8* p) { return *(const LAS bf16x8*)p; }
__device__ __forceinline__ int sigma32(int i) { return (i & 19) | ((i & 4) << 1) | ((i & 8) >> 1); }

template <int NDS>
__device__ __forceinline__ f32x16 qk_block(const lds_u8* Kt, int kb, int c0, const bf16x8* qf, int lane) {
    const int key = 32 * kb + sigma32(lane & 31), h = lane >> 5; const lds_u8* base = Kt + key * 128; const int sw = key & 7;
    f32x16 s = {0.f, 0.f, 0.f, 0.f, 0.f, 0.f, 0.f, 0.f, 0.f, 0.f, 0.f, 0.f, 0.f, 0.f, 0.f, 0.f};
#pragma unroll
    for (int ds = 0; ds < NDS; ++ds) { const bf16x8 a = lds128(base + (((c0 + 2 * ds + h) ^ sw) << 4)); s = __builtin_amdgcn_mfma_f32_32x32x16_bf16(a, qf[ds], s, 0, 0, 0); }
    return s;
}
__device__ __forceinline__ void softmax_pv(f32x16& s0, f32x16& s1, float& m, float& l, f32x16& o0, f32x16& o1, const lds_u8* Vt, int lane) {
    float mx = fmaxf(s0[0], s1[0]);
#pragma unroll
    for (int r = 1; r < 16; ++r) mx = fmaxf(mx, fmaxf(s0[r], s1[r]));
    mx = fmaxf(mx, __shfl_xor(mx, 32));
    const float mn = fmaxf(m, mx);
    if (__any(mn > m)) { const float al = __builtin_amdgcn_exp2f(m - mn); l *= al;
#pragma unroll
        for (int r = 0; r < 16; ++r) { o0[r] *= al; o1[r] *= al; }
        m = mn; }
    float ps = 0.f;
#pragma unroll
    for (int r = 0; r < 16; ++r) { s0[r] = __builtin_amdgcn_exp2f(s0[r] - m); s1[r] = __builtin_amdgcn_exp2f(s1[r] - m); ps += s0[r] + s1[r]; }
    l += ps;
    const int h = lane >> 5, d = lane & 31;
#pragma unroll
    for (int kb = 0; kb < 2; ++kb)
#pragma unroll
        for (int sp = 0; sp < 2; ++sp) {
            const f32x16& s = kb ? s1 : s0;
            u32x4 pw; pw.x = cvt_pk_bf16(s[8 * sp + 0], s[8 * sp + 1]); pw.y = cvt_pk_bf16(s[8 * sp + 2], s[8 * sp + 3]); pw.z = cvt_pk_bf16(s[8 * sp + 4], s[8 * sp + 5]); pw.w = cvt_pk_bf16(s[8 * sp + 6], s[8 * sp + 7]);
            const bf16x8 pf = __builtin_bit_cast(bf16x8, pw);
            const int chunk = 4 * kb + 2 * sp + h;
            const bf16x8 a0 = lds128(Vt + d * 128 + ((chunk ^ (d & 7)) << 4));
            const bf16x8 a1 = lds128(Vt + (d + 32) * 128 + ((chunk ^ (d & 7)) << 4));
            o0 = __builtin_amdgcn_mfma_f32_32x32x16_bf16(a0, pf, o0, 0, 0, 0);
            o1 = __builtin_amdgcn_mfma_f32_32x32x16_bf16(a1, pf, o1, 0, 0, 0);
        }
}
__device__ __forceinline__ int key_of(int kb, int r, int h) { return 32 * kb + 16 * (r >> 3) + 8 * h + 4 * ((r >> 2) & 1) + (r & 3); }

__device__ __forceinline__ void attn_phase(lds_u8* lds, const Ctx& C) {
    const int l = C.l;
    const float lam_init = l == 0 ? 0.2f : (l == 1 ? 0.35550906759f : (l == 2 ? 0.47071301835f : 0.55605820416f));
    for (;;) {
        __syncthreads();
        unsigned char* ws = C.ws; asm volatile("" : "+s"(ws));
        const int tid = opaque_tid();
        const int lane = tid & 63, w = __builtin_amdgcn_readfirstlane(tid >> 6), h5 = lane >> 5, ql = lane & 31;
        if (tid == 0) *(LAS unsigned*)(lds + LDS_NEXT) = atomicAdd((unsigned*)(ws + WS_CTL) + 64 * (1 + l), 1u);
        __syncthreads();
        const int idx = (int)*(LAS unsigned*)(lds + LDS_NEXT);
        if (idx >= NUNITS) break;
        const bf16_t* qkv = (const bf16_t*)(ws + WS_QKV); const bf16_t* kcb = (const bf16_t*)(ws + WS_KC); const float* sm = (const float*)(ws + WS_LAM);
        int fam, grp, b, h, qb;
        if (idx < 128) { fam = 2; grp = 1; b = idx >> 5; h = (idx >> 3) & 3; qb = idx & 7; }
        else if (idx < 256) { const int i = idx - 128; fam = 0; grp = 1; b = i >> 5; h = (i >> 3) & 3; qb = i & 7; }
        else if (idx < 512) { const int i = idx - 256; fam = 1; grp = 1; b = i >> 6; h = (i >> 3) & 7; qb = i & 7; }
        else if (idx < 640) { const int i = idx - 512; fam = 2; grp = 0; b = i >> 2; h = i & 3; qb = 0; }
        else if (idx < 768) { const int i = idx - 640; fam = 0; grp = 0; b = i >> 2; h = i & 3; qb = 0; }
        else { const int i = idx - 768; fam = 1; grp = 0; b = i >> 3; h = i & 7; qb = 0; }
        const int T = grp ? TLAT : TCTX, Hq = fam == 1 ? 8 : 4, Hkv = fam == 1 ? 2 : 4, hk = fam == 1 ? (h >> 2) : h;
        const size_t qo = fam == 0 ? QO_QA : (fam == 1 ? QO_QB : QO_QC), ko = fam == 0 ? QO_KA : (fam == 1 ? QO_KB : QO_KC), vo = fam == 0 ? QO_VTA : (fam == 1 ? QO_VTB : QO_VTC);
        const size_t gq = fam == 1 ? GS8 : GS4, gk = fam == 1 ? GS2 : GS4;
        const int q0 = qb * 256;
        const bf16_t* Qp = qkv + qo + grp * gq + ((size_t)(b * Hq + h) * T + q0 + 32 * w + ql) * 64;
        const unsigned kso = (unsigned)(ko + grp * gk + (size_t)(b * Hkv + hk) * T * 64), vso = (unsigned)(vo + grp * gk + (size_t)(b * Hkv + hk) * 64 * T);
        const size_t cko = fam == 0 ? CO_KA : (fam == 1 ? CO_KB : CO_KCC), cvo = fam == 0 ? CO_VTA : (fam == 1 ? CO_VTB : CO_VTCC);
        const unsigned kco = (unsigned)(cko + (size_t)((l * 4 + b) * Hkv + hk) * PAST * 64), vco = (unsigned)(cvo + (size_t)((l * 4 + b) * Hkv + hk) * 64 * PAST);
        int ta, tb;
        if (!grp) { ta = 0; tb = 4; }
        else if (fam == 0) { ta = max(4 * qb - 4, 0); tb = min(max(4 * qb - 1, 0), 24) + 8; }
        else if (fam == 1) { ta = max(q0 - 128, 0) >> 6; tb = min(q0 + 384, TLAT) >> 6; }
        else { ta = 0; tb = 32; }
        const int nself = tb - ta, ntile = nself + (grp ? 8 : 0);
        const int mode = !grp ? 0 : (fam == 0 ? 1 : (fam == 1 ? 2 : 0));
        if (mode == 1 && tid < 465) *(LAS float*)(lds + LDS_RPB + 4 * tid) = sm[SM_RPB + (l * 4 + h) * 465 + tid];
        bf16x8 qf[4];
#pragma unroll
        for (int ds = 0; ds < 4; ++ds) qf[ds] = *(const bf16x8*)(Qp + 16 * ds + 8 * h5);
        const int qw0 = q0 + 32 * w;
        const int qtok = qw0 + ql, qrow = qtok >> 6, qcol = qtok & 63;
        const int r0w = min(max((qw0 >> 6) - 4, 0), 24), qsl = min(max(qcol - 8, 0), 48);
        float m0 = -1e30f, l0 = 0.f, m1 = -1e30f, l1 = 0.f;
        f32x16 oa0 = {0.f, 0.f, 0.f, 0.f, 0.f, 0.f, 0.f, 0.f, 0.f, 0.f, 0.f, 0.f, 0.f, 0.f, 0.f, 0.f}, oa1 = oa0, ob0 = oa0, ob1 = oa0;
        const int lrow = tid >> 3, lch = tid & 7; const int lds_off = lrow * 128 + ((lch ^ (lrow & 7)) << 4);
        u32x4 kreg, vreg;
        auto gload = [&](int ti) {
            const bool self = ti < nself; const int tok0 = self ? 64 * (ta + ti) : 64 * (ti - nself); const int Tkv = self ? T : PAST;
            const bf16_t* kp = (self ? qkv : kcb) + (self ? kso : kco); const bf16_t* vp = (self ? qkv : kcb) + (self ? vso : vco);
            kreg = *(const u32x4*)(kp + (size_t)(tok0 + lrow) * 64 + lch * 8);
            vreg = *(const u32x4*)(vp + (size_t)lrow * Tkv + tok0 + lch * 8);
        };
        gload(0);
        *(LAS u32x4*)(lds + lds_off) = kreg; *(LAS u32x4*)(lds + 8192 + lds_off) = vreg;
        __syncthreads();
        for (int ti = 0; ti < ntile; ++ti) {
            const lds_u8* Kt = lds + (ti & 1) * LDS_TILE; const lds_u8* Vt = Kt + 8192;
            if (ti + 1 < ntile) gload(ti + 1);
            const bool self = ti < nself; const int tok0 = 64 * (ta + ti);
            bool rel = true, msk = false;
            if (self && mode == 1) { const int kr = ta + ti; rel = (kr >= r0w) && (kr <= r0w + 7); msk = true; }
            if (self && mode == 2) { rel = (tok0 + 63 >= qw0 - 128) && (tok0 <= qw0 + 31 + 128); msk = !((tok0 >= qw0 + 31 - 128) && (tok0 + 63 <= qw0 + 128)); }
            if (rel) {
                if (fam != 2) {
                    f32x16 s0 = qk_block<4>(Kt, 0, 0, qf, lane), s1 = qk_block<4>(Kt, 1, 0, qf, lane);
                    if (msk) {
                        if (mode == 1) {
                            const int kr = ta + ti; const LAS float* bt = (const LAS float*)(lds + LDS_RPB) + (kr - qrow + 7) * 31 + 15 - qcol;
#pragma unroll
                            for (int r = 0; r < 16; ++r) {
                                const int kc0 = key_of(0, r, h5), kc1 = kc0 + 32;
                                const bool v0 = (kc0 >= qsl) && (kc0 < qsl + 16), v1 = (kc1 >= qsl) && (kc1 < qsl + 16);
                                const float b0 = bt[v0 ? kc0 : qcol], b1 = bt[v1 ? kc1 : qcol];
                                s0[r] = v0 ? s0[r] + b0 : -INFINITY; s1[r] = v1 ? s1[r] + b1 : -INFINITY;
                            }
                        } else {
#pragma unroll
                            for (int r = 0; r < 16; ++r) {
                                const int k0 = tok0 + key_of(0, r, h5), k1 = k0 + 32;
                                if (abs(k0 - qtok) > 128) s0[r] = -INFINITY;
                                if (abs(k1 - qtok) > 128) s1[r] = -INFINITY;
                            }
                        }
                    }
                    softmax_pv(s0, s1, m0, l0, oa0, oa1, Vt, lane);
                } else {
                    { f32x16 s0 = qk_block<2>(Kt, 0, 0, qf, lane), s1 = qk_block<2>(Kt, 1, 0, qf, lane); softmax_pv(s0, s1, m0, l0, oa0, oa1, Vt, lane); }
                    { f32x16 s0 = qk_block<2>(Kt, 0, 4, qf + 2, lane), s1 = qk_block<2>(Kt, 1, 4, qf + 2, lane); softmax_pv(s0, s1, m1, l1, ob0, ob1, Vt, lane); }
                }
            }
            if (ti + 1 < ntile) { lds_u8* nb = lds + ((ti + 1) & 1) * LDS_TILE; *(LAS u32x4*)(nb + lds_off) = kreg; *(LAS u32x4*)(nb + 8192 + lds_off) = vreg; }
            __syncthreads();
        }
        const int grow = (grp ? MCTX + b * TLAT : b * TCTX) + qtok;
        const int ocol = (fam == 0 ? 0 : (fam == 1 ? 256 : 768)) + 64 * h;
        bf16_t* orow = (bf16_t*)(ws + WS_O) + (size_t)grow * 1024 + ocol + 4 * h5;
        float lt0 = l0 + __shfl_xor(l0, 32);
        if (fam == 1) lt0 += __builtin_amdgcn_exp2f(sm[SM_SINK + l * 8 + h] - m0);
        const float i0 = 1.0f / lt0;
        if (fam != 2) {
#pragma unroll
            for (int g = 0; g < 4; ++g) {
                u32x2 wa, wb; wa.x = cvt_pk_bf16(oa0[4 * g] * i0, oa0[4 * g + 1] * i0); wa.y = cvt_pk_bf16(oa0[4 * g + 2] * i0, oa0[4 * g + 3] * i0);
                wb.x = cvt_pk_bf16(oa1[4 * g] * i0, oa1[4 * g + 1] * i0); wb.y = cvt_pk_bf16(oa1[4 * g + 2] * i0, oa1[4 * g + 3] * i0);
                *(u32x2*)(orow + 8 * g) = wa; *(u32x2*)(orow + 32 + 8 * g) = wb;
            }
        } else {
            const float lt1 = l1 + __shfl_xor(l1, 32); const float i1 = 1.0f / lt1; const float lam = sm[SM_LAM + l];
            float ss = 0.f;
#pragma unroll
            for (int r = 0; r < 16; ++r) { oa0[r] = oa0[r] * i0 - lam * (ob0[r] * i1); oa1[r] = oa1[r] * i0 - lam * (ob1[r] * i1); ss += oa0[r] * oa0[r] + oa1[r] * oa1[r]; }
            ss += __shfl_xor(ss, 32);
            const float rn = __builtin_amdgcn_rsqf(ss * (1.f / 64.f) + 1e-6f) * (1.0f - lam_init);
            const float* sg = sm + SM_SUBG + l * 64 + 4 * h5;
#pragma unroll
            for (int g = 0; g < 4; ++g) {
                const f32x4 ga = *(const f32x4*)(sg + 8 * g), gb = *(const f32x4*)(sg + 32 + 8 * g);
                u32x2 wa, wb; wa.x = cvt_pk_bf16(oa0[4 * g] * rn * ga[0], oa0[4 * g + 1] * rn * ga[1]); wa.y = cvt_pk_bf16(oa0[4 * g + 2] * rn * ga[2], oa0[4 * g + 3] * rn * ga[3]);
                wb.x = cvt_pk_bf16(oa1[4 * g] * rn * gb[0], oa1[4 * g + 1] * rn * gb[1]); wb.y = cvt_pk_bf16(oa1[4 * g + 2] * rn * gb[2], oa1[4 * g + 3] * rn * gb[3]);
                *(u32x2*)(orow + 8 * g) = wa; *(u32x2*)(orow + 32 + 8 * g) = wb;
            }
        }
    }
}
}
namespace misc {
typedef LAS unsigned char lds_u8;
__device__ __forceinline__ float wave_sum(float v) {
#pragma unroll
    for (int o = 1; o < 64; o <<= 1) v += __shfl_xor(v, o);
    return v;
}
__device__ const double INVB[16] = {1.0, 0.5623413251903491, 0.31622776601683794, 0.1778279410038923, 0.1, 0.05623413251903491, 0.03162277660168379, 0.01778279410038923,
                                    0.01, 0.005623413251903491, 0.0031622776601683794, 0.001778279410038923, 0.001, 0.0005623413251903491, 0.00031622776601683794, 0.0001778279410038923};
__device__ const double INVC[8] = {1.0, 0.31622776601683794, 0.1, 0.03162277660168379, 0.01, 0.0031622776601683794, 0.001, 0.00031622776601683794};
__device__ __forceinline__ void sincos_d(double a, float& c, float& s) {
    const double k = rint(a * 0.6366197723675814);
    double r = fma(-k, 1.5707963267948966, a); r = fma(-k, 6.123233995736766e-17, r);
    const double r2 = r * r;
    const double sp = r * (1.0 + r2 * (-1.0 / 6.0 + r2 * (1.0 / 120.0 + r2 * (-1.0 / 5040.0 + r2 * (1.0 / 362880.0 + r2 * (-1.0 / 39916800.0 + r2 * (1.0 / 6227020800.0)))))));
    const double cp = 1.0 + r2 * (-0.5 + r2 * (1.0 / 24.0 + r2 * (-1.0 / 720.0 + r2 * (1.0 / 40320.0 + r2 * (-1.0 / 3628800.0 + r2 * (1.0 / 479001600.0 + r2 * (-1.0 / 87178291200.0)))))));
    const int q = ((int)k) & 3;
    const double cc = (q == 0) ? cp : (q == 1) ? -sp : (q == 2) ? -cp : sp;
    const double ss = (q == 0) ? sp : (q == 1) ? cp : (q == 2) ? -sp : -cp;
    c = (float)cc; s = (float)ss;
}
__device__ __forceinline__ void transpose_item(const float* W, int K, int N, bf16_t* WT, int k0, int n0, int dst0, LAS float* scr, int lane) {
#pragma unroll 8
    for (int i = 0; i < 32; ++i) { const int kk = 2 * i + (lane >> 5); scr[kk * 33 + (lane & 31)] = W[(size_t)(k0 + kk) * N + n0 + (lane & 31)]; }
    asm volatile("s_waitcnt lgkmcnt(0)" ::: "memory");
    const int c = lane & 7;
#pragma unroll
    for (int j = 0; j < 4; ++j) { const int n = (lane >> 3) + 8 * j; const LAS float* s = scr + (8 * c) * 33 + n;
        u32x4 o; o.x = cvt_pk_bf16(s[0 * 33], s[1 * 33]); o.y = cvt_pk_bf16(s[2 * 33], s[3 * 33]); o.z = cvt_pk_bf16(s[4 * 33], s[5 * 33]); o.w = cvt_pk_bf16(s[6 * 33], s[7 * 33]);
        *(u32x4*)(WT + (size_t)(dst0 + n) * K + k0 + 8 * c) = o; }
    asm volatile("s_waitcnt lgkmcnt(0)" ::: "memory");
}
__device__ __forceinline__ void gemv5_item(const float* W, int N, int n0, const LAS float* vec, LAS float* red, const float* add, float* out, int ostride, int tid) {
    const int col = tid & 31, kq = tid >> 5; float a0 = 0.f, a1 = 0.f, a2 = 0.f, a3 = 0.f, a4 = 0.f;
    const float* wp = W + (size_t)(kq * 64) * N + n0 + col; const LAS float* vp = vec + kq * 64;
#pragma unroll 8
    for (int k = 0; k < 64; ++k) { const float w = wp[(size_t)k * N]; a0 += vp[k] * w; a1 += vp[1024 + k] * w; a2 += vp[2048 + k] * w; a3 += vp[3072 + k] * w; a4 += vp[4096 + k] * w; }
    red[(kq * 5 + 0) * 32 + col] = a0; red[(kq * 5 + 1) * 32 + col] = a1; red[(kq * 5 + 2) * 32 + col] = a2; red[(kq * 5 + 3) * 32 + col] = a3; red[(kq * 5 + 4) * 32 + col] = a4;
    __syncthreads();
    if (tid < 160) { const int b = tid >> 5, c = tid & 31; float s = add ? add[n0 + c] : 0.f;
#pragma unroll
        for (int q = 0; q < 16; ++q) s += red[(q * 5 + b) * 32 + c];
        out[(size_t)b * ostride + n0 + c] = s; }
    __syncthreads();
}

__device__ __forceinline__ void phase_pro1(lds_u8* lds, const Args& a) {
    const int tid = opaque_tid(), lane = tid & 63, wave = __builtin_amdgcn_readfirstlane(tid >> 6), G = gridDim.x;
    unsigned char* ws = a.ws;
    { LAS float* vec = (LAS float*)lds; LAS float* red = (LAS float*)(lds + 20480);
      for (int i = tid; i < 5120; i += 512) { const int b5 = i >> 10, k = i & 1023; const float v = b5 == 0 ? a.in[I_CCTX][k] : a.in[I_C][(b5 - 1) * 1024 + k]; vec[i] = v / (1.f + __expf(-v)); }
      __syncthreads();
      float* mod = (float*)(ws + WS_MOD);
      for (int it = blockIdx.x; it < 4 * 192; it += G) { const int l = it / 192, n0 = (it % 192) * 32;
          gemv5_item(a.in[I_WMOD] + (size_t)l * 1024 * 6144, 6144, n0, vec, red, a.in[I_BMOD] + l * 6144, mod + (size_t)l * 5 * 6144, 6144, tid); }
      __syncthreads(); }
    { LAS float* scr = (LAS float*)(lds + wave * 16384);
      const int gw = blockIdx.x * 8 + wave, NGW = G * 8;
      constexpr int I_IN = 16 * 72, I_OUT = 16 * 32, I_UP = 16 * 176, I_DN = 44 * 32, I_L = I_IN + I_OUT + I_UP + I_DN;
      for (int it = gw; it < 4 * I_L; it += NGW) {
          const int l = it / I_L; int r = it % I_L;
          if (r < I_IN) { const int kb = r / 72, nb = r % 72, n0 = 32 * nb; const int tile = n0 >> 8, L = n0 & 255, wc = L >> 6, bj = (L >> 5) & 1; const int dst0 = 256 * tile + 128 * bj + 32 * wc;
              transpose_item(a.in[I_WIN] + (size_t)l * 1024 * DIN, 1024, DIN, (bf16_t*)(ws + WS_WIN) + (size_t)l * DIN * 1024, 64 * kb, n0, dst0, scr, lane); continue; }
          r -= I_IN;
          if (r < I_OUT) { const int kb = r / 32, nb = r % 32; transpose_item(a.in[I_WOUT] + (size_t)l * 1024 * 1024, 1024, 1024, (bf16_t*)(ws + WS_WOUT) + (size_t)l * 1024 * 1024, 64 * kb, 32 * nb, 32 * nb, scr, lane); continue; }
          r -= I_OUT;
          if (r < I_UP) { const int kb = r / 176, nb = r % 176; transpose_item(a.in[I_WUP] + (size_t)l * 1024 * DUP, 1024, DUP, (bf16_t*)(ws + WS_WUP) + (size_t)l * DUP * 1024, 64 * kb, 32 * nb, 32 * nb, scr, lane); continue; }
          r -= I_UP;
          { const int kb = r / 32, nb = r % 32; transpose_item(a.in[I_WDOWN] + (size_t)l * DFF * 1024, DFF, 1024, (bf16_t*)(ws + WS_WDOWN) + (size_t)l * 1024 * DFF, 64 * kb, 32 * nb, 32 * nb, scr, lane); }
      } }
    const int gtid = blockIdx.x * 512 + tid, NT = G * 512;
    { bf16_t* kc = (bf16_t*)(ws + WS_KC);
      for (int fam = 0; fam < 3; ++fam) {
          const int H = fam == 1 ? 2 : 4; const float* ck = a.in[fam == 0 ? I_CNAK : (fam == 1 ? I_CSWK : I_CDAK)]; const float* cv = a.in[fam == 0 ? I_CNAV : (fam == 1 ? I_CSWV : I_CDAV)];
          bf16_t* dk = kc + (fam == 0 ? CO_KA : (fam == 1 ? CO_KB : CO_KCC)); bf16_t* dv = kc + (fam == 0 ? CO_VTA : (fam == 1 ? CO_VTB : CO_VTCC));
          const int totk = 4 * 4 * 512 * H * 8;
          for (int i = gtid; i < totk; i += NT) { const int d8 = i & 7, hh = (i >> 3) % H, p = (i / (8 * H)) & 511, l = (i / (8 * H * 512)) & 3, b = i / (8 * H * 512 * 4);
              const float* s = ck + ((((size_t)b * 4 + l) * 512 + p) * H + hh) * 64 + d8 * 8; const f32x4 x = *(const f32x4*)s, y = *(const f32x4*)(s + 4);
              u32x4 o; o.x = cvt_pk_bf16(x[0], x[1]); o.y = cvt_pk_bf16(x[2], x[3]); o.z = cvt_pk_bf16(y[0], y[1]); o.w = cvt_pk_bf16(y[2], y[3]);
              *(u32x4*)(dk + ((((size_t)l * 4 + b) * H + hh) * 512 + p) * 64 + d8 * 8) = o; }
          const int totv = 4 * 4 * H * 64 * 64;
          for (int i = gtid; i < totv; i += NT) { const int d = i & 63, p8 = (i >> 6) & 63, hh = (i >> 12) % H, l = (i / (4096 * H)) & 3, b = i / (4096 * H * 4);
              const float* s = cv + ((((size_t)b * 4 + l) * 512 + p8 * 8) * H + hh) * 64 + d; float x[8];
#pragma unroll
              for (int j = 0; j < 8; ++j) x[j] = s[(size_t)j * H * 64];
              u32x4 o; o.x = cvt_pk_bf16(x[0], x[1]); o.y = cvt_pk_bf16(x[2], x[3]); o.z = cvt_pk_bf16(x[4], x[5]); o.w = cvt_pk_bf16(x[6], x[7]);
              *(u32x4*)(dv + ((((size_t)l * 4 + b) * H + hh) * 64 + d) * 512 + p8 * 8) = o; }
      } }
    { float* rb = (float*)(ws + WS_ROPEB); float* rc = (float*)(ws + WS_ROPEC);
      for (int i = gtid; i < 2048 * 32; i += NT) { const int t = i >> 5, j = i & 31; const double pos = (double)(j < 16 ? (t >> 6) : (t & 63)); float c, s; sincos_d(pos * INVB[j & 15], c, s); rb[2 * i] = c; rb[2 * i + 1] = s; }
      for (int i = gtid; i < 2048 * 16; i += NT) { const int t = i >> 4, j = i & 15; const double pos = (double)(j < 8 ? (t >> 6) : (t & 63)); float c, s; sincos_d(pos * INVC[j & 7], c, s); rc[2 * i] = c; rc[2 * i + 1] = s; } }
    { float* sm = (float*)(ws + WS_LAM);
      if (gtid < 4) { const int l = gtid; const float* lp = a.in[I_LAMBDA] + l * 128; float s1 = 0.f, s2 = 0.f;
          for (int i = 0; i < 32; ++i) { s1 += lp[i] * lp[32 + i]; s2 += lp[64 + i] * lp[96 + i]; }
          sm[SM_LAM + l] = expf(s1) - expf(s2) + (0.8f - 0.6f * expf(-0.3f * (float)l)); }
      for (int i = gtid; i < 1280; i += NT) { const int l = i / 320, r = i % 320; sm[SM_GAINS + i] = r < 128 ? a.in[I_NAG][l * 128 + r] : (r < 256 ? a.in[I_SWG][l * 128 + r - 128] : a.in[I_DAG][l * 64 + r - 256]); }
      for (int i = gtid; i < 7440; i += NT) sm[SM_RPB + i] = a.in[I_RPB][i] * LOG2E;
      for (int i = gtid; i < 32; i += NT) sm[SM_SINK + i] = a.in[I_SINK][i] * LOG2E;
      for (int i = gtid; i < 256; i += NT) sm[SM_SUBG + i] = a.in[I_SUBG][i]; }
}
__device__ __forceinline__ void phase_pro2(lds_u8* lds, const Args& a) {
    const int tid = opaque_tid(), G = gridDim.x; unsigned char* ws = a.ws;
    const float* mod = (const float*)(ws + WS_MOD);
    const int gtid = blockIdx.x * 512 + tid, NT = G * 512;
    { float* gv = (float*)(ws + WS_GV);
      for (int i = gtid; i < 4 * 5 * 2 * 1024; i += NT) { const int c = i & 1023, which = (i >> 10) & 1, b5 = (i >> 11) % 5, l = i / 10240;
          const float g = a.in[which ? I_GFFN : I_GATTN][l * 1024 + c]; const float sc = mod[((size_t)(l * 5 + b5) * 6 + (which ? 4 : 1)) * 1024 + c]; gv[i] = g * (1.f + sc); } }
    LAS float* vec = (LAS float*)lds; LAS float* red = (LAS float*)(lds + 20480);
    for (int it = blockIdx.x; it < 4 * (72 + 176); it += G) {
        const int l = it / 248, r = it % 248; const int which = r < 72 ? 0 : 1; const int n0 = 32 * (which ? r - 72 : r);
        __syncthreads();
        for (int i = tid; i < 5120; i += 512) { const int b5 = i >> 10, k = i & 1023; vec[i] = mod[((size_t)(l * 5 + b5) * 6 + (which ? 3 : 0)) * 1024 + k]; }
        __syncthreads();
        if (!which) gemv5_item(a.in[I_WIN] + (size_t)l * 1024 * DIN, DIN, n0, vec, red, nullptr, (float*)(ws + WS_BIASIN) + (size_t)l * 5 * DIN, DIN, tid);
        else gemv5_item(a.in[I_WUP] + (size_t)l * 1024 * DUP, DUP, n0, vec, red, nullptr, (float*)(ws + WS_BIASUP) + (size_t)l * 5 * DUP, DUP, tid);
    }
}
__device__ __forceinline__ void phase_make_xa(const Args& a, int l, int which, int first) {
    const int tid = opaque_tid(), lane = tid & 63, wave = tid >> 6; unsigned char* ws = a.ws;
    const float* gv = (const float*)(ws + WS_GV); bf16_t* xa = (bf16_t*)(ws + WS_XA); float* ssq = (float*)(ws + WS_SSQ);
    for (int row = blockIdx.x * 8 + wave; row < MTOT; row += gridDim.x * 8) {
        const float* src = first ? (row < MCTX ? a.in[I_XP] + (size_t)row * 1024 : a.in[I_XS] + (size_t)(row - MCTX) * 1024) : a.out + (size_t)row * 1024;
        const float* g = gv + ((size_t)(l * 5 + row_b5(row)) * 2 + which) * 1024;
        f32x4 v[4]; float s = 0.f;
#pragma unroll
        for (int j = 0; j < 4; ++j) { v[j] = *(const f32x4*)(src + 256 * j + 4 * lane); s += (v[j][0] * v[j][0] + v[j][1] * v[j][1]) + (v[j][2] * v[j][2] + v[j][3] * v[j][3]); }
        s = wave_sum(s);
#pragma unroll
        for (int j = 0; j < 4; ++j) { if (first) *(f32x4*)(a.out + (size_t)row * 1024 + 256 * j + 4 * lane) = v[j];
            const f32x4 y = v[j] * *(const f32x4*)(g + 256 * j + 4 * lane); u32x2 w; w.x = cvt_pk_bf16(y[0], y[1]); w.y = cvt_pk_bf16(y[2], y[3]); *(u32x2*)(xa + (size_t)row * 1024 + 256 * j + 4 * lane) = w; }
        if (lane < 16) ssq[(size_t)row * 16 + lane] = lane == 0 ? s : 0.f;
    }
}
__device__ __forceinline__ void phase_conv(const Args& a, int l, int half) {
    const int gtid = blockIdx.x * 512 + opaque_tid(), NT = gridDim.x * 512; unsigned char* ws = a.ws;
    const bf16_t* U = (const bf16_t*)(ws + WS_U); bf16_t* ACT = (bf16_t*)(ws + WS_ACT) + (size_t)half * 8192 * DFF;
    const int T = half ? TLAT : TCTX; const float* cw = a.in[I_CONVW] + (size_t)l * 3 * DUP; const float* cb = a.in[I_CONVB] + (size_t)l * DUP;
    constexpr int F8 = DFF / 8, RCH = 16, NCH = 8192 / RCH;
    for (int it = gtid; it < F8 * NCH; it += NT) {
        const int f = (it % F8) * 8, r0 = (it / F8) * RCH;
        float w[2][3][8], bb[2][8];
#pragma unroll
        for (int hh = 0; hh < 2; ++hh) {
#pragma unroll
            for (int j = 0; j < 3; ++j) { const f32x4 x = *(const f32x4*)(cw + j * DUP + hh * DFF + f), y = *(const f32x4*)(cw + j * DUP + hh * DFF + f + 4);
#pragma unroll
                for (int e = 0; e < 4; ++e) { w[hh][j][e] = x[e]; w[hh][j][4 + e] = y[e]; } }
            const f32x4 x = *(const f32x4*)(cb + hh * DFF + f), y = *(const f32x4*)(cb + hh * DFF + f + 4);
#pragma unroll
            for (int e = 0; e < 4; ++e) { bb[hh][e] = x[e]; bb[hh][4 + e] = y[e]; }
        }
        float up[2][8], uc[2][8], un[2][8];
        auto ld = [&](int r, float (&d)[2][8]) {
            const bool ok = (r >= 0) && (r < 8192) && ((r / T) == (r0 / T));
#pragma unroll
            for (int hh = 0; hh < 2; ++hh) { u32x4 q = {0u, 0u, 0u, 0u}; if (ok) q = *(const u32x4*)(U + (size_t)r * DUP + hh * DFF + f);
#pragma unroll
                for (int e = 0; e < 4; ++e) { d[hh][2 * e] = __builtin_bit_cast(float, q[e] << 16); d[hh][2 * e + 1] = __builtin_bit_cast(float, q[e] & 0xffff0000u); } }
        };
        ld(r0 - 1, up); ld(r0, uc);
        for (int r = r0; r < r0 + RCH; ++r) {
            ld(r + 1, un);
            float o[8];
#pragma unroll
            for (int e = 0; e < 8; ++e) { const float yg = bb[0][e] + w[0][0][e] * up[0][e] + w[0][1][e] * uc[0][e] + w[0][2][e] * un[0][e]; const float yv = bb[1][e] + w[1][0][e] * up[1][e] + w[1][1][e] * uc[1][e] + w[1][2][e] * un[1][e];
                o[e] = yg / (1.f + __expf(-yg)) * yv; }
            u32x4 q; q.x = cvt_pk_bf16(o[0], o[1]); q.y = cvt_pk_bf16(o[2], o[3]); q.z = cvt_pk_bf16(o[4], o[5]); q.w = cvt_pk_bf16(o[6], o[7]);
            *(u32x4*)(ACT + (size_t)r * DFF + f) = q;
#pragma unroll
            for (int hh = 0; hh < 2; ++hh)
#pragma unroll
                for (int e = 0; e < 8; ++e) { up[hh][e] = uc[hh][e]; uc[hh][e] = un[hh][e]; }
        }
    }
}
}
constexpr int LDS_BYTES = 147456;
enum Phase { PH_PRO1 = 0, PH_PRO2, PH_MAKEXA, PH_IN, PH_ATT, PH_OUT, PH_UP, PH_CONV, PH_DOWN };

__device__ __forceinline__ void run_phase(LAS unsigned char* lds, const Args& a, int ph, int l, int p1, int p2) {
    unsigned char* ws = a.ws; const int G = gridDim.x;
    switch (ph) {
    case PH_PRO1: misc::phase_pro1(lds, a); break;
    case PH_PRO2: misc::phase_pro2(lds, a); break;
    case PH_MAKEXA: misc::phase_make_xa(a, l, p1, p2); break;
    case PH_IN: {
        pg8::Gemm g{(const bf16_t*)(ws + WS_XA), (const bf16_t*)(ws + WS_WIN) + (size_t)l * DIN * 1024, MTOT, DIN, 1024}; pg8::StaticOrder S; S.init(MTOT, DIN, G, (int)blockIdx.x);
        pg8::EpiIn E{ws, a.out, l};
        pg8::gemm_phase<pg8::EpiIn, pg8::StaticOrder, true, true>(lds, g, S, E); } break;
    case PH_ATT: {
        att::Ctx C{ws, l};
        att::attn_phase(lds, C); } break;
    case PH_OUT: {
        pg8::Gemm g{(const bf16_t*)(ws + WS_O), (const bf16_t*)(ws + WS_WOUT) + (size_t)l * 1024 * 1024, MTOT, 1024, 1024}; pg8::StaticOrder S; S.init(MTOT, 1024, G, (int)blockIdx.x);
        pg8::EpiRes E{ws, a.out, l, 0};
        pg8::gemm_phase<pg8::EpiRes, pg8::StaticOrder, false, true>(lds, g, S, E); } break;
    case PH_UP: {
        pg8::Gemm g{(const bf16_t*)(ws + WS_XA) + (size_t)p1 * 8192 * 1024, (const bf16_t*)(ws + WS_WUP) + (size_t)l * DUP * 1024, 8192, DUP, 1024}; pg8::StaticOrder S; S.init(8192, DUP, G, (int)blockIdx.x);
        pg8::EpiUp E{ws, l, p1 * 8192};
        pg8::gemm_phase<pg8::EpiUp, pg8::StaticOrder, true, true>(lds, g, S, E); } break;
    case PH_CONV: misc::phase_conv(a, l, p1); break;
    case PH_DOWN: {
        pg8::Gemm g{(const bf16_t*)(ws + WS_ACT), (const bf16_t*)(ws + WS_WDOWN) + (size_t)l * 1024 * DFF, MTOT, 1024, DFF}; pg8::StaticOrder S; S.init(MTOT, 1024, G, (int)blockIdx.x);
        pg8::EpiRes E{ws, a.out, l, 1};
        pg8::gemm_phase<pg8::EpiRes, pg8::StaticOrder, false, true>(lds, g, S, E); } break;
    default: break;
    }
}
__global__ void __launch_bounds__(512, 2) mk_fwd(Args a) {
    extern __shared__ __attribute__((aligned(16))) unsigned char lds_raw[];
    LAS unsigned char* lds = (LAS unsigned char*)lds_raw;
    cg::grid_group grid = cg::this_grid();
#define GSYNC() grid.sync()
    run_phase(lds, a, PH_PRO1, 0, 0, 0); GSYNC();
    run_phase(lds, a, PH_PRO2, 0, 0, 0); GSYNC();
    run_phase(lds, a, PH_MAKEXA, 0, 0, 1); GSYNC();
#pragma unroll 1
    for (int l = 0; l < DEPTH; ++l) {
        run_phase(lds, a, PH_IN, l, 0, 0); GSYNC();
        run_phase(lds, a, PH_ATT, l, 0, 0); GSYNC();
        run_phase(lds, a, PH_OUT, l, 0, 0); GSYNC();
#pragma unroll 1
        for (int half = 0; half < 2; ++half) { run_phase(lds, a, PH_UP, l, half, 0); GSYNC(); run_phase(lds, a, PH_CONV, l, half, 0); GSYNC(); }
        run_phase(lds, a, PH_DOWN, l, 0, 0);
        if (l < DEPTH - 1) GSYNC();
    }
}

extern "C" void kernel_launch(void* const* d_in, const int* in_sizes, int n_in, void* d_out, int out_size, void* d_ws, size_t ws_size, hipStream_t stream) {
    static int grid = 0;
    if (grid == 0) {
        int dev = 0, cus = 0, per_cu = 0;
        (void)hipGetDevice(&dev); (void)hipDeviceGetAttribute(&cus, hipDeviceAttributeMultiprocessorCount, dev);
        (void)hipFuncSetAttribute((const void*)mk_fwd, hipFuncAttributeMaxDynamicSharedMemorySize, LDS_BYTES);
        (void)hipOccupancyMaxActiveBlocksPerMultiprocessor(&per_cu, (const void*)mk_fwd, 512, LDS_BYTES);
        if (per_cu < 1) fprintf(stderr, "kernel_launch: occupancy query reports %d blocks per CU\n", per_cu);
        grid = cus > 0 ? cus : 256;
        if (ws_size < WS_END) { fprintf(stderr, "kernel_launch: workspace too small (%zu < %zu)\n", ws_size, (size_t)WS_END); grid = -1; }
    }
    if (grid < 0) return;
    Args a{}; for (int i = 0; i < N_IN; ++i) a.in[i] = (const float*)d_in[i]; a.out = (float*)d_out; a.ws = (unsigned char*)d_ws;
    (void)hipMemsetAsync((unsigned char*)d_ws + WS_CTL, 0, 1 * MiB, stream);
    void* args[] = {&a};
    hipError_t e = hipLaunchCooperativeKernel((const void*)mk_fwd, dim3(grid), dim3(512), args, LDS_BYTES, stream);
    if (e != hipSuccess) fprintf(stderr, "cooperative launch failed: %s (grid %d)\n", hipGetErrorString(e), grid);
}
```

```cpp
#include <hip/hip_runtime.h>
#include <hip/hip_cooperative_groups.h>
#include <cstdio>
#include <cstdint>
namespace cg = cooperative_groups;

constexpr int DEPTH = 4, NCTX = 32, TCTX = 256, NLAT = 4, TLAT = 2048, PAST = 512;
constexpr int MCTX = 8192, MLAT = 8192, MTOT = 16384;
constexpr int DIN = 2304, DFF = 2816, DUP = 5632;
constexpr size_t OUT_X = 0, OUT_NAK = 16777216, OUT_NAV = 25165824, OUT_SWK = 33554432, OUT_SWV = 37748736, OUT_DAK = 41943040, OUT_DAV = 50331648, OUT_TOTAL = 58720256;
enum { I_XP = 0, I_XS, I_CNAK, I_CNAV, I_CSWK, I_CSWV, I_CDAK, I_CDAV, I_C, I_CCTX, I_GATTN, I_GFFN, I_WMOD, I_BMOD, I_WIN, I_NAG, I_RPB, I_SWG, I_SINK, I_DAG, I_LAMBDA, I_SUBG, I_WOUT, I_WUP, I_CONVW, I_CONVB, I_WDOWN, N_IN };
#define LAS __attribute__((address_space(3)))
typedef unsigned short bf16_t;
typedef short bf16x8 __attribute__((ext_vector_type(8)));
typedef float f32x4 __attribute__((ext_vector_type(4)));
typedef float f32x2 __attribute__((ext_vector_type(2)));
typedef float f32x16 __attribute__((ext_vector_type(16)));
typedef unsigned u32x4 __attribute__((ext_vector_type(4)));
typedef unsigned u32x2 __attribute__((ext_vector_type(2)));
typedef __bf16 bf16x2_t __attribute__((ext_vector_type(2)));

constexpr float LOG2E = 1.4426950408889634f;
constexpr float QSCALE64 = 0.125f * LOG2E, QSCALE32 = 0.17677669529663687f * LOG2E;

__device__ __forceinline__ unsigned cvt_pk_bf16(float lo, float hi) { f32x2 v = {lo, hi}; bf16x2_t b = __builtin_convertvector(v, bf16x2_t); return __builtin_bit_cast(unsigned, b); }
__device__ __forceinline__ float bf16_to_f32(bf16_t v) { return __builtin_bit_cast(float, (unsigned)v << 16); }
__device__ __forceinline__ int row_b5(int row) { return row < MCTX ? 0 : 1 + ((row - MCTX) >> 11); }

constexpr size_t MiB = 1u << 20;
constexpr size_t WS_CTL = 0;
constexpr size_t WS_MOD = 1 * MiB;
constexpr size_t WS_GV = WS_MOD + 512 * 1024;
constexpr size_t WS_BIASIN = WS_GV + 256 * 1024;
constexpr size_t WS_BIASUP = WS_BIASIN + 256 * 1024;
constexpr size_t WS_LAM = WS_BIASUP + 512 * 1024;
constexpr int SM_LAM = 0, SM_GAINS = 64, SM_RPB = SM_GAINS + 1280, SM_SINK = SM_RPB + 7440, SM_SUBG = SM_SINK + 32, SM_END = SM_SUBG + 256;
constexpr size_t WS_ROPEB = 3 * MiB;
constexpr size_t WS_ROPEC = WS_ROPEB + 512 * 1024;
constexpr size_t WS_SSQ = 4 * MiB;
constexpr size_t WS_WIN = 5 * MiB;
constexpr size_t WS_WOUT = WS_WIN + 18 * MiB;
constexpr size_t WS_WUP = WS_WOUT + 8 * MiB;
constexpr size_t WS_WDOWN = WS_WUP + 44 * MiB;
constexpr size_t WS_KC = WS_WDOWN + 22 * MiB;
constexpr size_t WS_XA = WS_KC + 20 * MiB;
constexpr size_t WS_QKV = WS_XA + 32 * MiB;
constexpr size_t WS_O = WS_QKV + 72 * MiB;
constexpr size_t WS_ACT = WS_QKV;
constexpr size_t WS_U = WS_O + 32 * MiB;
constexpr size_t WS_END = WS_U + 88 * MiB;
constexpr size_t GS4 = 2097152, GS8 = 4194304, GS2 = 1048576;
constexpr size_t QO_QA = 0, QO_KA = QO_QA + 2 * GS4, QO_VTA = QO_KA + 2 * GS4, QO_QB = QO_VTA + 2 * GS4, QO_KB = QO_QB + 2 * GS8, QO_VTB = QO_KB + 2 * GS2,
                 QO_QC = QO_VTB + 2 * GS2, QO_KC = QO_QC + 2 * GS4, QO_VTC = QO_KC + 2 * GS4, QO_END = QO_VTC + 2 * GS4;
static_assert(QO_END * 2 == 72 * MiB, "qkv region");
constexpr size_t CO_KA = 0, CO_VTA = CO_KA + GS4, CO_KB = CO_VTA + GS4, CO_VTB = CO_KB + GS2, CO_KCC = CO_VTB + GS2, CO_VTCC = CO_KCC + GS4;

struct Args { const float* in[N_IN]; float* out; unsigned char* ws; };
__device__ __forceinline__ int opaque_tid() { int t = threadIdx.x; asm volatile("" : "+v"(t)); return t; }

namespace pg8 {
#define PG8_LAS __attribute__((address_space(3)))
constexpr int BM = 256, BK = 64, HALF = 128, HTB = HALF * BK * 2  , STAGE_BYTES = 8 * HTB, NXCD = 8, WGM = 8;
__host__ __device__ __forceinline__ int lds_byte(int r, int c) { const int st = (r >> 4) * 2 + (c >> 5), rr = r & 15, cc = c & 31, ob = rr * 64 + cc * 2; return st * 1024 + (ob ^ (((ob >> 9) & 1) << 5)); }
__host__ __device__ __forceinline__ void stage_rc(int b, int& R, int& C) { const int st = b / 1024, sb = b % 1024, swz = sb ^ (((sb >> 9) & 1) << 5); R = (st >> 1) * 16 + swz / 64; C = (st & 1) * 32 + (swz % 64) / 2; }
__host__ __device__ __forceinline__ int perm32(int rho) { const int n = rho >> 4, i = rho & 15; return 8 * (i >> 2) + 4 * n + (i & 3); }
struct Unit { int pm, pn; };
struct Gemm { const bf16_t* A; const bf16_t* Bt; int M, N, K; };
struct StaticOrder {
    int nM, nN, nwg, G, c;
    __host__ __device__ void init(int M, int N, int G_, int c_) { nM = M / BM; nN = N / BM; nwg = nM * nN; G = G_; c = c_; }
    __host__ __device__ bool next(int i, Unit& u) const {
        const long L = (long)i * G + c; if (L >= nwg) return false;
        int wgid = (int)L; { const int q = nwg / NXCD, r = nwg % NXCD, xcd = wgid % NXCD, off = wgid / NXCD; wgid = (xcd < r ? xcd * (q + 1) : r * (q + 1) + (xcd - r) * q) + off; }
        const int nig = WGM * nN, gid = wgid / nig, fm = gid * WGM, gsz = (nM - fm) < WGM ? (nM - fm) : WGM;
        u.pm = fm + ((wgid % nig) % gsz); u.pn = (wgid % nig) / gsz; return true;
    }
    __device__ __forceinline__ void a_ready(const Unit&) const {}
    __device__ __forceinline__ void done(const Unit&) const {}
};

template <class Epi, class Sched, bool ALIGN_EPI = false, bool SP2 = false>
__device__ __forceinline__ void gemm_phase(PG8_LAS unsigned char* lds, const Gemm g, const Sched& S, const Epi& E) {
    const int tid = opaque_tid(), wid = __builtin_amdgcn_readfirstlane(tid >> 6), lane = tid & 63, wr = wid >> 2, wc = wid & 3, fr = lane & 15, fq = lane >> 4;
    const int K = g.K, nt = K / BK;
    unsigned voffA[2], voffB[2];
#pragma unroll
    for (int i = 0; i < 2; ++i) { int R, C; stage_rc(tid * 16 + i * 8192, R, C); const int Rb = Epi::PERM ? ((R & ~31) + perm32(R & 31)) : R;
        voffA[i] = (unsigned)(R * K + C) * 2u; voffB[i] = (unsigned)(Rb * K + C) * 2u; }
    const size_t kstep = (size_t)(BK * 2);
    const size_t hstep = (size_t)HALF * K * 2;
    const size_t tstep = 2 * hstep;
    const unsigned ldsw = (unsigned)wid * 1024u;
    const int aoff = lds_byte(wr * 64 + fr, fq * 8), boff = lds_byte(wc * 32 + fr, fq * 8);
#define PG8_SA(b, h) (((b) * 2 + (h)) * HTB)
#define PG8_SB(b, h) ((4 + (b) * 2 + (h)) * HTB)
#define PG8_STAGE(bufoff, gbase, voff) do { _Pragma("unroll") for (int _i = 0; _i < 2; ++_i) \
        __builtin_amdgcn_global_load_lds((const unsigned*)((const char*)(gbase) + (voff)[_i]), (PG8_LAS unsigned*)(lds + (bufoff) + ldsw + _i * 8192), 16, 0, 0); } while (0)
#define PG8_LDA(dst, b, h) do { _Pragma("unroll") for (int m = 0; m < 4; ++m) _Pragma("unroll") for (int k = 0; k < 2; ++k) dst[m][k] = *(const PG8_LAS bf16x8*)(lds + PG8_SA(b, h) + aoff + m * 2048 + k * 1024); } while (0)
#define PG8_LDB(dst, b, h) do { _Pragma("unroll") for (int n = 0; n < 2; ++n) _Pragma("unroll") for (int k = 0; k < 2; ++k) dst[n][k] = *(const PG8_LAS bf16x8*)(lds + PG8_SB(b, h) + boff + n * 2048 + k * 1024); } while (0)
#define PG8_MMA(ai, bj, At, Bt) do { __builtin_amdgcn_s_setprio(1); _Pragma("unroll") for (int m = 0; m < 4; ++m) _Pragma("unroll") for (int n = 0; n < 2; ++n) _Pragma("unroll") for (int k = 0; k < 2; ++k) \
        acc[ai][bj][m][n] = __builtin_amdgcn_mfma_f32_16x16x32_bf16(Bt[n][k], At[m][k], acc[ai][bj][m][n], 0, 0, 0); __builtin_amdgcn_s_setprio(0); } while (0)
#define PG8_WAIT_V(n) asm volatile("s_waitcnt vmcnt(" #n ")" ::: "memory")
#define PG8_WAIT_L(n) asm volatile("s_waitcnt lgkmcnt(" #n ")" ::: "memory")
#define PG8_BAR __builtin_amdgcn_s_barrier()
#define PG8_SCHED __builtin_amdgcn_sched_barrier(0)
    Unit cur, nxt; int ui = 0;
    if (!S.next(0, cur)) return;
    f32x4 acc[2][2][4][2];
#pragma unroll
    for (int a = 0; a < 2; ++a)
#pragma unroll
        for (int b = 0; b < 2; ++b)
#pragma unroll
            for (int m = 0; m < 4; ++m)
#pragma unroll
                for (int n = 0; n < 2; ++n) acc[a][b][m][n] = (f32x4){0.f, 0.f, 0.f, 0.f};
    bf16x8 At[4][2], B0[2][2], B1[2][2];
    const char* cA = (const char*)g.A + (size_t)cur.pm * tstep; const char* cB = (const char*)g.Bt + (size_t)cur.pn * tstep;
    S.a_ready(cur);
    if constexpr (SP2) {
        PG8_STAGE(PG8_SB(0, 0), cB, voffB); PG8_STAGE(PG8_SB(0, 1), cB + hstep, voffB); PG8_STAGE(PG8_SA(0, 0), cA, voffA); PG8_STAGE(PG8_SA(0, 1), cA + hstep, voffA);
        if (wr == 1) PG8_BAR;
        PG8_WAIT_V(2); PG8_BAR;
        PG8_STAGE(PG8_SB(1, 0), cB + kstep, voffB); PG8_STAGE(PG8_SA(1, 0), cA + kstep, voffA); PG8_STAGE(PG8_SB(1, 1), cB + hstep + kstep, voffB);
        PG8_WAIT_V(6); PG8_BAR;
    } else {
        PG8_STAGE(PG8_SB(0, 0), cB, voffB); PG8_STAGE(PG8_SA(0, 0), cA, voffA); PG8_STAGE(PG8_SB(0, 1), cB + hstep, voffB); PG8_STAGE(PG8_SA(0, 1), cA + hstep, voffA);
        if (wr == 1) PG8_BAR;
        PG8_WAIT_V(4); PG8_BAR;
        PG8_STAGE(PG8_SB(1, 0), cB + kstep, voffB); PG8_STAGE(PG8_SA(1, 0), cA + kstep, voffA); PG8_STAGE(PG8_SB(1, 1), cB + hstep + kstep, voffB);
        PG8_WAIT_V(6); PG8_BAR;
    }
    for (;;) {
        const bool has_next = S.next(ui + 1, nxt);
        const char* nA = has_next ? (const char*)g.A + (size_t)nxt.pm * tstep : cA; const char* nB = has_next ? (const char*)g.Bt + (size_t)nxt.pn * tstep : cB;
        for (int t = 0; t < nt; t += 2) {
            const bool last = (t == nt - 2);
            const char* a1 = cA + (size_t)(t + 1) * kstep;
            const char* a2 = last ? nA : cA + (size_t)(t + 2) * kstep; const char* b2 = last ? nB : cB + (size_t)(t + 2) * kstep;
            const char* a3 = a2 + kstep; const char* b3 = b2 + kstep;
            if (last && has_next) S.a_ready(nxt);
            if constexpr (SP2) {
            PG8_LDB(B0, 0, 0); PG8_LDB(B1, 0, 1); PG8_SCHED; PG8_LDA(At, 0, 0); PG8_STAGE(PG8_SA(1, 1), a1 + hstep, voffA);
            PG8_WAIT_V(8); PG8_WAIT_L(0); PG8_BAR; PG8_MMA(0, 0, At, B0); PG8_MMA(0, 1, At, B1); PG8_BAR; PG8_SCHED;
            PG8_LDA(At, 0, 1); PG8_STAGE(PG8_SB(0, 0), b2, voffB); PG8_STAGE(PG8_SB(0, 1), b2 + hstep, voffB); PG8_STAGE(PG8_SA(0, 0), a2, voffA);
            PG8_WAIT_V(8); PG8_WAIT_L(0); PG8_BAR; PG8_MMA(1, 0, At, B0); PG8_MMA(1, 1, At, B1); PG8_BAR; PG8_SCHED;
            PG8_LDB(B0, 1, 0); PG8_LDB(B1, 1, 1); PG8_SCHED; PG8_LDA(At, 1, 0); PG8_STAGE(PG8_SA(0, 1), a2 + hstep, voffA);
            PG8_WAIT_V(8); PG8_WAIT_L(0); PG8_BAR; PG8_MMA(0, 0, At, B0); PG8_MMA(0, 1, At, B1); PG8_BAR; PG8_SCHED;
            PG8_LDA(At, 1, 1); PG8_STAGE(PG8_SB(1, 0), b3, voffB); PG8_STAGE(PG8_SB(1, 1), b3 + hstep, voffB); PG8_STAGE(PG8_SA(1, 0), a3, voffA);
            PG8_WAIT_V(8); PG8_WAIT_L(0); PG8_BAR; PG8_MMA(1, 0, At, B0); PG8_MMA(1, 1, At, B1); PG8_BAR; PG8_SCHED;
            } else {
            PG8_LDB(B0, 0, 0); PG8_SCHED; PG8_LDA(At, 0, 0); PG8_STAGE(PG8_SA(1, 1), a1 + hstep, voffA);
            PG8_WAIT_L(8); PG8_BAR; PG8_WAIT_L(0); PG8_MMA(0, 0, At, B0); PG8_BAR; PG8_SCHED;
            PG8_LDB(B1, 0, 1); PG8_STAGE(PG8_SB(0, 0), b2, voffB);
            PG8_BAR; PG8_WAIT_L(0); PG8_MMA(0, 1, At, B1); PG8_BAR;
            PG8_LDA(At, 0, 1); PG8_STAGE(PG8_SA(0, 0), a2, voffA);
            PG8_BAR; PG8_WAIT_L(0); PG8_MMA(1, 0, At, B0); PG8_BAR; PG8_SCHED;
            PG8_STAGE(PG8_SB(0, 1), b2 + hstep, voffB);
            PG8_WAIT_V(6); PG8_BAR; PG8_MMA(1, 1, At, B1); PG8_BAR;
            PG8_LDB(B0, 1, 0); PG8_SCHED; PG8_LDA(At, 1, 0); PG8_STAGE(PG8_SA(0, 1), a2 + hstep, voffA);
            PG8_WAIT_L(8); PG8_BAR; PG8_WAIT_L(0); PG8_MMA(0, 0, At, B0); PG8_BAR; PG8_SCHED;
            PG8_LDB(B1, 1, 1); PG8_STAGE(PG8_SB(1, 0), b3, voffB);
            PG8_BAR; PG8_WAIT_L(0); PG8_MMA(0, 1, At, B1); PG8_BAR;
            PG8_LDA(At, 1, 1); PG8_STAGE(PG8_SA(1, 0), a3, voffA);
            PG8_BAR; PG8_WAIT_L(0); PG8_MMA(1, 0, At, B0); PG8_BAR; PG8_SCHED;
            PG8_STAGE(PG8_SB(1, 1), b3 + hstep, voffB);
            PG8_WAIT_V(6); PG8_BAR; PG8_MMA(1, 1, At, B1); PG8_BAR;
            }
        }
        if constexpr (ALIGN_EPI) { if (wr == 0) PG8_BAR; }
        if constexpr (!Epi::AFTER_DRAIN) { E(acc, cur, wr, wc, fr, fq); S.done(cur); }
        if (!has_next) break;
#pragma unroll
        for (int a = 0; a < 2; ++a)
#pragma unroll
            for (int b = 0; b < 2; ++b)
#pragma unroll
                for (int m = 0; m < 4; ++m)
#pragma unroll
                    for (int n = 0; n < 2; ++n) acc[a][b][m][n] = (f32x4){0.f, 0.f, 0.f, 0.f};
        cur = nxt; cA = nA; cB = nB; ++ui;
        if constexpr (ALIGN_EPI) { if (wr == 1) PG8_BAR; }
    }
    PG8_WAIT_V(0);
    if constexpr (!ALIGN_EPI) { if (wr == 0) PG8_BAR; }
    PG8_BAR;
    if constexpr (Epi::AFTER_DRAIN) { E.fused(acc, cur, wr, wc, fr, fq, lds, wid, lane); S.done(cur); }
#undef PG8_SA
#undef PG8_SB
#undef PG8_STAGE
#undef PG8_LDA
#undef PG8_LDB
#undef PG8_MMA
#undef PG8_WAIT_V
#undef PG8_WAIT_L
#undef PG8_BAR
#undef PG8_SCHED
}

__device__ __forceinline__ float row_rstd(const float* ssq, int row) {
    const f32x4* p = (const f32x4*)(ssq + (size_t)row * 16); const f32x4 a = p[0], b = p[1], c = p[2], d = p[3];
    const float s = ((a[0] + a[1]) + (a[2] + a[3])) + ((b[0] + b[1]) + (b[2] + b[3])) + ((c[0] + c[1]) + (c[2] + c[3])) + ((d[0] + d[1]) + (d[2] + d[3]));
    return __builtin_amdgcn_rsqf(s * (1.0f / 1024.0f) + 1e-6f);
}

struct EpiIn {
    static constexpr bool PERM = false, AFTER_DRAIN = false;
    unsigned char* ws0; float* out; int l;
    __device__ __forceinline__ void operator()(const f32x4 (&acc)[2][2][4][2], const Unit& u, int wr, int wc, int fr_in, int fq_in) const {
        unsigned char* ws = ws0; asm volatile("" : "+s"(ws));
        int fr = fr_in, fq = fq_in; asm volatile("" : "+v"(fr), "+v"(fq));
        const float* ssq = (const float*)(ws + WS_SSQ); const float* bias = (const float*)(ws + WS_BIASIN) + (size_t)l * 5 * DIN;
        const float* gains = (const float*)(ws + WS_LAM) + SM_GAINS + l * 320; const float* nag = gains; const float* swg = gains + 128; const float* dag = gains + 256;
        const float* ropeB = (const float*)(ws + WS_ROPEB); const float* ropeC = (const float*)(ws + WS_ROPEC); bf16_t* qkv = (bf16_t*)(ws + WS_QKV);
        const int pm = u.pm, pn = u.pn;
        const int grp = pm >= 32 ? 1 : 0, b = grp ? ((pm - 32) >> 3) : pm, tbase = grp ? 256 * ((pm - 32) & 7) : 0, T = grp ? TLAT : TCTX, b5 = grp ? 1 + b : 0;
        int type, h;
        if (pn < 3) { type = pn; h = wc; } else if (pn < 5) { type = 3; h = 4 * (pn - 3) + wc; } else if (pn == 5) { type = wc < 2 ? 4 : 5; h = wc & 1; } else { type = pn; h = wc; }
        const bool isv = (type == 2 || type == 5 || type == 8), isq = (type == 0 || type == 3 || type == 6), is32 = (type == 6 || type == 7);
        const bool rope = grp && (type == 3 || type == 4 || type == 6 || type == 7);
        const int H = (type == 3) ? 8 : ((type == 4 || type == 5) ? 2 : 4);
        size_t dbase; const size_t gs = (type == 3) ? GS8 : ((type == 4 || type == 5) ? GS2 : GS4);
        switch (type) { case 0: dbase = QO_QA; break; case 1: dbase = QO_KA; break; case 2: dbase = QO_VTA; break; case 3: dbase = QO_QB; break; case 4: dbase = QO_KB; break; case 5: dbase = QO_VTB; break;
                        case 6: dbase = QO_QC; break; case 7: dbase = QO_KC; break; default: dbase = QO_VTC; break; }
        bf16_t* dst = qkv + dbase + grp * gs + (size_t)(b * H + h) * T * 64;
        float* fo = nullptr; int fow = 0, foc = 0;
        if (!grp) { switch (type) { case 1: fo = out + OUT_NAK; fow = 256; foc = 64 * wc; break; case 2: fo = out + OUT_NAV; fow = 256; foc = 64 * wc; break; case 4: fo = out + OUT_SWK; fow = 128; foc = 64 * h; break;
                        case 5: fo = out + OUT_SWV; fow = 128; foc = 64 * h; break; case 7: fo = out + OUT_DAK; fow = 256; foc = 64 * wc; break; case 8: fo = out + OUT_DAV; fow = 256; foc = 64 * wc; break; default: break; } }
        const float* gsrc = ((type == 0) ? nag : (type == 1) ? nag + 64 : (type == 3) ? swg : (type == 4) ? swg + 64 : (type == 6) ? dag : dag + 32) + 4 * fq;
        const float* bsrc = bias + b5 * DIN + pn * 256 + 64 * wc + 4 * fq;
        const float qs = isq ? (is32 ? QSCALE32 : QSCALE64) : 1.0f;
#pragma unroll
        for (int ai = 0; ai < 2; ++ai)
#pragma unroll
            for (int m = 0; m < 4; ++m) {
                const int lr = 128 * ai + 64 * wr + 16 * m + fr, row = 256 * pm + lr, t = tbase + lr;
                const float rstd = row_rstd(ssq, row);
                float r0 = 1.f, r1 = 1.f;
                if (!isv) {
                    float s0 = 0.f, s1 = 0.f;
#pragma unroll
                    for (int n = 0; n < 2; ++n) { const f32x4 a = acc[ai][0][m][n] * rstd + *(const f32x4*)(bsrc + 16 * n), c = acc[ai][1][m][n] * rstd + *(const f32x4*)(bsrc + 32 + 16 * n);
                        s0 += (a[0] * a[0] + a[1] * a[1]) + (a[2] * a[2] + a[3] * a[3]); s1 += (c[0] * c[0] + c[1] * c[1]) + (c[2] * c[2] + c[3] * c[3]); }
                    s0 += __shfl_xor(s0, 16); s0 += __shfl_xor(s0, 32); s1 += __shfl_xor(s1, 16); s1 += __shfl_xor(s1, 32);
                    if (is32) { r0 = __builtin_amdgcn_rsqf(s0 * (1.f / 32.f) + 1e-6f); r1 = __builtin_amdgcn_rsqf(s1 * (1.f / 32.f) + 1e-6f); }
                    else { r0 = r1 = __builtin_amdgcn_rsqf((s0 + s1) * (1.f / 64.f) + 1e-6f); }
                }
                float* fr_ = fo ? fo + ((size_t)(b * DEPTH + l) * 256 + t) * fow + foc + 4 * fq : nullptr;
#pragma unroll
                for (int bj = 0; bj < 2; ++bj)
#pragma unroll
                    for (int n = 0; n < 2; ++n) {
                        f32x4 x = acc[ai][bj][m][n] * rstd + *(const f32x4*)(bsrc + 32 * bj + 16 * n);
                        if (!isv) {
                            x = x * (bj ? r1 : r0) * *(const f32x4*)(gsrc + (is32 ? 0 : 32 * bj) + 16 * n);
                            if (rope) {
                                const f32x4 cs = is32 ? *(const f32x4*)(ropeC + ((size_t)t * 16 + 8 * n + 2 * fq) * 2) : *(const f32x4*)(ropeB + ((size_t)t * 32 + 16 * bj + 8 * n + 2 * fq) * 2);
                                x = (f32x4){x[0] * cs[0] - x[1] * cs[1], x[0] * cs[1] + x[1] * cs[0], x[2] * cs[2] - x[3] * cs[3], x[2] * cs[3] + x[3] * cs[2]};
                            }
                        }
                        if (fr_) *(f32x4*)(fr_ + 32 * bj + 16 * n) = x;
                        if (!isv) { const f32x4 y = x * qs; u32x2 w; w.x = cvt_pk_bf16(y[0], y[1]); w.y = cvt_pk_bf16(y[2], y[3]); *(u32x2*)(dst + (size_t)t * 64 + 4 * fq + 32 * bj + 16 * n) = w; }
                        else { const int d0 = 32 * bj + 16 * n + 4 * fq;
#pragma unroll
                            for (int e = 0; e < 4; ++e) dst[(size_t)(d0 + e) * T + t] = (bf16_t)(cvt_pk_bf16(x[e], 0.f) & 0xffffu); }
                    }
                asm volatile("" ::: "memory");
            }
    }
};

struct EpiRes {
    static constexpr bool PERM = false, AFTER_DRAIN = false;
    unsigned char* ws0; float* x; int l; int which;
    __device__ __forceinline__ void operator()(const f32x4 (&acc)[2][2][4][2], const Unit& u, int wr, int wc, int fr, int fq) const {
        unsigned char* ws = ws0; asm volatile("" : "+s"(ws));
        const float* gate = (const float*)(ws + WS_MOD) + (size_t)l * 5 * 6144 + (which ? 5 : 2) * 1024;
        const float* gvn = which ? (l < 3 ? (const float*)(ws + WS_GV) + (size_t)(l + 1) * 10240 : nullptr) : (const float*)(ws + WS_GV) + (size_t)l * 10240 + 1024;
        bf16_t* xa = (bf16_t*)(ws + WS_XA); float* ssq = (float*)(ws + WS_SSQ);
        const int pm = u.pm, pn = u.pn, b5 = pm >= 32 ? 1 + ((pm - 32) >> 3) : 0;
        const int col0 = 256 * pn + 32 * wc + 4 * fq;
        f32x4 gt[2][2], gn[2][2];
#pragma unroll
        for (int bj = 0; bj < 2; ++bj)
#pragma unroll
            for (int n = 0; n < 2; ++n) { gt[bj][n] = *(const f32x4*)(gate + (size_t)b5 * 6144 + col0 + 128 * bj + 16 * n); gn[bj][n] = gvn ? *(const f32x4*)(gvn + (size_t)b5 * 2048 + col0 + 128 * bj + 16 * n) : (f32x4){0.f, 0.f, 0.f, 0.f}; }
#pragma unroll
        for (int ai = 0; ai < 2; ++ai)
#pragma unroll
            for (int m = 0; m < 4; ++m) {
                const int row = 256 * pm + 128 * ai + 64 * wr + 16 * m + fr; float* xr = x + (size_t)row * 1024 + col0; float ss = 0.f;
#pragma unroll
                for (int bj = 0; bj < 2; ++bj)
#pragma unroll
                    for (int n = 0; n < 2; ++n) {
                        const f32x4 xo = *(const f32x4*)(xr + 128 * bj + 16 * n); const f32x4 xn = xo + gt[bj][n] * acc[ai][bj][m][n];
                        *(f32x4*)(xr + 128 * bj + 16 * n) = xn;
                        if (gvn) { ss += (xn[0] * xn[0] + xn[1] * xn[1]) + (xn[2] * xn[2] + xn[3] * xn[3]); const f32x4 y = xn * gn[bj][n]; u32x2 w; w.x = cvt_pk_bf16(y[0], y[1]); w.y = cvt_pk_bf16(y[2], y[3]);
                            *(u32x2*)(xa + (size_t)row * 1024 + col0 + 128 * bj + 16 * n) = w; }
                    }
                if (gvn) { ss += __shfl_xor(ss, 16); ss += __shfl_xor(ss, 32); if (fq == 0) ssq[(size_t)row * 16 + 4 * pn + wc] = ss; }
            }
    }
};

struct EpiUp {
    static constexpr bool PERM = true, AFTER_DRAIN = false;
    unsigned char* ws0; int l; int row_off;
    __device__ __forceinline__ void operator()(const f32x4 (&acc)[2][2][4][2], const Unit& u, int wr, int wc, int fr, int fq) const {
        unsigned char* ws = ws0; asm volatile("" : "+s"(ws));
        const float* ssq = (const float*)(ws + WS_SSQ); const float* bias = (const float*)(ws + WS_BIASUP) + (size_t)l * 5 * DUP; bf16_t* U = (bf16_t*)(ws + WS_U);
        const int pm = u.pm, pn = u.pn; const int grow0 = row_off + 256 * pm; const int b5 = row_b5(grow0);
        const int col0 = 256 * pn + 32 * wc + 8 * fq;
        f32x4 bv[2][2];
#pragma unroll
        for (int bj = 0; bj < 2; ++bj)
#pragma unroll
            for (int n = 0; n < 2; ++n) bv[bj][n] = *(const f32x4*)(bias + (size_t)b5 * DUP + col0 + 128 * bj + 4 * n);
#pragma unroll
        for (int ai = 0; ai < 2; ++ai)
#pragma unroll
            for (int m = 0; m < 4; ++m) {
                const int lr = 256 * pm + 128 * ai + 64 * wr + 16 * m + fr; const float rstd = row_rstd(ssq, row_off + lr);
#pragma unroll
                for (int bj = 0; bj < 2; ++bj) { const f32x4 v0 = acc[ai][bj][m][0] * rstd + bv[bj][0], v1 = acc[ai][bj][m][1] * rstd + bv[bj][1];
                    u32x4 w; w.x = cvt_pk_bf16(v0[0], v0[1]); w.y = cvt_pk_bf16(v0[2], v0[3]); w.z = cvt_pk_bf16(v1[0], v1[1]); w.w = cvt_pk_bf16(v1[2], v1[3]);
                    *(u32x4*)(U + (size_t)lr * DUP + col0 + 128 * bj) = w; }
            }
    }
};
}
namespace att {
typedef LAS unsigned char lds_u8;
constexpr int LDS_TILE = 16384;
constexpr int LDS_RPB = 2 * LDS_TILE;
constexpr int LDS_NEXT = LDS_RPB + 2048;
constexpr int NUNITS = 1024;

struct Ctx { unsigned char* ws; int l; };

__device__ __forceinline__ bf16x8 lds128(const lds_u8* p) { return *(const LAS bf16x8*)p; }
__device__ __forceinline__ int sigma32(int i) { return (i & 19) | ((i & 4) << 1) | ((i & 8) >> 1); }

template <int NDS>
__device__ __forceinline__ f32x16 qk_block(const lds_u8* Kt, int kb, int c0, const bf16x8* qf, int lane) {
    const int key = 32 * kb + sigma32(lane & 31), h = lane >> 5; const lds_u8* base = Kt + key * 128; const int sw = key & 7;
    f32x16 s = {0.f, 0.f, 0.f, 0.f, 0.f, 0.f, 0.f, 0.f, 0.f, 0.f, 0.f, 0.f, 0.f, 0.f, 0.f, 0.f};
#pragma unroll
    for (int ds = 0; ds < NDS; ++ds) { const bf16x8 a = lds128(base + (((c0 + 2 * ds + h) ^ sw) << 4)); s = __builtin_amdgcn_mfma_f32_32x32x16_bf16(a, qf[ds], s, 0, 0, 0); }
    return s;
}
__device__ __forceinline__ void softmax_pv(f32x16& s0, f32x16& s1, float& m, float& l, f32x16& o0, f32x16& o1, const lds_u8* Vt, int lane) {
    float mx = fmaxf(s0[0], s1[0]);
#pragma unroll
    for (int r = 1; r < 16; ++r) mx = fmaxf(mx, fmaxf(s0[r], s1[r]));
    mx = fmaxf(mx, __shfl_xor(mx, 32));
    const float mn = fmaxf(m, mx);
    if (__any(mn > m)) { const float al = __builtin_amdgcn_exp2f(m - mn); l *= al;
#pragma unroll
        for (int r = 0; r < 16; ++r) { o0[r] *= al; o1[r] *= al; }
        m = mn; }
    float ps = 0.f;
#pragma unroll
    for (int r = 0; r < 16; ++r) { s0[r] = __builtin_amdgcn_exp2f(s0[r] - m); s1[r] = __builtin_amdgcn_exp2f(s1[r] - m); ps += s0[r] + s1[r]; }
    l += ps;
    const int h = lane >> 5, d = lane & 31;
#pragma unroll
    for (int kb = 0; kb < 2; ++kb)
#pragma unroll
        for (int sp = 0; sp < 2; ++sp) {
            const f32x16& s = kb ? s1 : s0;
            u32x4 pw; pw.x = cvt_pk_bf16(s[8 * sp + 0], s[8 * sp + 1]); pw.y = cvt_pk_bf16(s[8 * sp + 2], s[8 * sp + 3]); pw.z = cvt_pk_bf16(s[8 * sp + 4], s[8 * sp + 5]); pw.w = cvt_pk_bf16(s[8 * sp + 6], s[8 * sp + 7]);
            const bf16x8 pf = __builtin_bit_cast(bf16x8, pw);
            const int chunk = 4 * kb + 2 * sp + h;
            const bf16x8 a0 = lds128(Vt + d * 128 + ((chunk ^ (d & 7)) << 4));
            const bf16x8 a1 = lds128(Vt + (d + 32) * 128 + ((chunk ^ (d & 7)) << 4));
            o0 = __builtin_amdgcn_mfma_f32_32x32x16_bf16(a0, pf, o0, 0, 0, 0);
            o1 = __builtin_amdgcn_mfma_f32_32x32x16_bf16(a1, pf, o1, 0, 0, 0);
        }
}
__device__ __forceinline__ int key_of(int kb, int r, int h) { return 32 * kb + 16 * (r >> 3) + 8 * h + 4 * ((r >> 2) & 1) + (r & 3); }

__device__ __forceinline__ void attn_phase(lds_u8* lds, const Ctx& C) {
    const int l = C.l;
    const float lam_init = l == 0 ? 0.2f : (l == 1 ? 0.35550906759f : (l == 2 ? 0.47071301835f : 0.55605820416f));
    for (;;) {
        __syncthreads();
        unsigned char* ws = C.ws; asm volatile("" : "+s"(ws));
        const int tid = opaque_tid();
        const int lane = tid & 63, w = __builtin_amdgcn_readfirstlane(tid >> 6), h5 = lane >> 5, ql = lane & 31;
        if (tid == 0) *(LAS unsigned*)(lds + LDS_NEXT) = atomicAdd((unsigned*)(ws + WS_CTL) + 64 * (1 + l), 1u);
        __syncthreads();
        const int idx = (int)*(LAS unsigned*)(lds + LDS_NEXT);
        if (idx >= NUNITS) break;
        const bf16_t* qkv = (const bf16_t*)(ws + WS_QKV); const bf16_t* kcb = (const bf16_t*)(ws + WS_KC); const float* sm = (const float*)(ws + WS_LAM);
        int fam, grp, b, h, qb;
        if (idx < 128) { fam = 2; grp = 1; b = idx >> 5; h = (idx >> 3) & 3; qb = idx & 7; }
        else if (idx < 256) { const int i = idx - 128; fam = 0; grp = 1; b = i >> 5; h = (i >> 3) & 3; qb = i & 7; }
        else if (idx < 512) { const int i = idx - 256; fam = 1; grp = 1; b = i >> 6; h = (i >> 3) & 7; qb = i & 7; }
        else if (idx < 640) { const int i = idx - 512; fam = 2; grp = 0; b = i >> 2; h = i & 3; qb = 0; }
        else if (idx < 768) { const int i = idx - 640; fam = 0; grp = 0; b = i >> 2; h = i & 3; qb = 0; }
        else { const int i = idx - 768; fam = 1; grp = 0; b = i >> 3; h = i & 7; qb = 0; }
        const int T = grp ? TLAT : TCTX, Hq = fam == 1 ? 8 : 4, Hkv = fam == 1 ? 2 : 4, hk = fam == 1 ? (h >> 2) : h;
        const size_t qo = fam == 0 ? QO_QA : (fam == 1 ? QO_QB : QO_QC), ko = fam == 0 ? QO_KA : (fam == 1 ? QO_KB : QO_KC), vo = fam == 0 ? QO_VTA : (fam == 1 ? QO_VTB : QO_VTC);
        const size_t gq = fam == 1 ? GS8 : GS4, gk = fam == 1 ? GS2 : GS4;
        const int q0 = qb * 256;
        const bf16_t* Qp = qkv + qo + grp * gq + ((size_t)(b * Hq + h) * T + q0 + 32 * w + ql) * 64;
        const unsigned kso = (unsigned)(ko + grp * gk + (size_t)(b * Hkv + hk) * T * 64), vso = (unsigned)(vo + grp * gk + (size_t)(b * Hkv + hk) * 64 * T);
        const size_t cko = fam == 0 ? CO_KA : (fam == 1 ? CO_KB : CO_KCC), cvo = fam == 0 ? CO_VTA : (fam == 1 ? CO_VTB : CO_VTCC);
        const unsigned kco = (unsigned)(cko + (size_t)((l * 4 + b) * Hkv + hk) * PAST * 64), vco = (unsigned)(cvo + (size_t)((l * 4 + b) * Hkv + hk) * 64 * PAST);
        int ta, tb;
        if (!grp) { ta = 0; tb = 4; }
        else if (fam == 0) { ta = max(4 * qb - 4, 0); tb = min(max(4 * qb - 1, 0), 24) + 8; }
        else if (fam == 1) { ta = max(q0 - 128, 0) >> 6; tb = min(q0 + 384, TLAT) >> 6; }
        else { ta = 0; tb = 32; }
        const int nself = tb - ta, ntile = nself + (grp ? 8 : 0);
        const int mode = !grp ? 0 : (fam == 0 ? 1 : (fam == 1 ? 2 : 0));
        if (mode == 1 && tid < 465) *(LAS float*)(lds + LDS_RPB + 4 * tid) = sm[SM_RPB + (l * 4 + h) * 465 + tid];
        bf16x8 qf[4];
#pragma unroll
        for (int ds = 0; ds < 4; ++ds) qf[ds] = *(const bf16x8*)(Qp + 16 * ds + 8 * h5);
        const int qw0 = q0 + 32 * w;
        const int qtok = qw0 + ql, qrow = qtok >> 6, qcol = qtok & 63;
        const int r0w = min(max((qw0 >> 6) - 4, 0), 24), qsl = min(max(qcol - 8, 0), 48);
        float m0 = -1e30f, l0 = 0.f, m1 = -1e30f, l1 = 0.f;
        f32x16 oa0 = {0.f, 0.f, 0.f, 0.f, 0.f, 0.f, 0.f, 0.f, 0.f, 0.f, 0.f, 0.f, 0.f, 0.f, 0.f, 0.f}, oa1 = oa0, ob0 = oa0, ob1 = oa0;
        const int lrow = tid >> 3, lch = tid & 7; const int lds_off = lrow * 128 + ((lch ^ (lrow & 7)) << 4);
        u32x4 kreg, vreg;
        auto gload = [&](int ti) {
            const bool self = ti < nself; const int tok0 = self ? 64 * (ta + ti) : 64 * (ti - nself); const int Tkv = self ? T : PAST;
            const bf16_t* kp = (self ? qkv : kcb) + (self ? kso : kco); const bf16_t* vp = (self ? qkv : kcb) + (self ? vso : vco);
            kreg = *(const u32x4*)(kp + (size_t)(tok0 + lrow) * 64 + lch * 8);
            vreg = *(const u32x4*)(vp + (size_t)lrow * Tkv + tok0 + lch * 8);
        };
        gload(0);
        *(LAS u32x4*)(lds + lds_off) = kreg; *(LAS u32x4*)(lds + 8192 + lds_off) = vreg;
        __syncthreads();
        for (int ti = 0; ti < ntile; ++ti) {
            const lds_u8* Kt = lds + (ti & 1) * LDS_TILE; const lds_u8* Vt = Kt + 8192;
            if (ti + 1 < ntile) gload(ti + 1);
            const bool self = ti < nself; const int tok0 = 64 * (ta + ti);
            bool rel = true, msk = false;
            if (self && mode == 1) { const int kr = ta + ti; rel = (kr >= r0w) && (kr <= r0w + 7); msk = true; }
            if (self && mode == 2) { rel = (tok0 + 63 >= qw0 - 128) && (tok0 <= qw0 + 31 + 128); msk = !((tok0 >= qw0 + 31 - 128) && (tok0 + 63 <= qw0 + 128)); }
            if (rel) {
                if (fam != 2) {
                    f32x16 s0 = qk_block<4>(Kt, 0, 0, qf, lane), s1 = qk_block<4>(Kt, 1, 0, qf, lane);
                    if (msk) {
                        if (mode == 1) {
                            const int kr = ta + ti; const LAS float* bt = (const LAS float*)(lds + LDS_RPB) + (kr - qrow + 7) * 31 + 15 - qcol;
#pragma unroll
                            for (int r = 0; r < 16; ++r) {
                                const int kc0 = key_of(0, r, h5), kc1 = kc0 + 32;
                                const bool v0 = (kc0 >= qsl) && (kc0 < qsl + 16), v1 = (kc1 >= qsl) && (kc1 < qsl + 16);
                                const float b0 = bt[v0 ? kc0 : qcol], b1 = bt[v1 ? kc1 : qcol];
                                s0[r] = v0 ? s0[r] + b0 : -INFINITY; s1[r] = v1 ? s1[r] + b1 : -INFINITY;
                            }
                        } else {
#pragma unroll
                            for (int r = 0; r < 16; ++r) {
                                const int k0 = tok0 + key_of(0, r, h5), k1 = k0 + 32;
                                if (abs(k0 - qtok) > 128) s0[r] = -INFINITY;
                                if (abs(k1 - qtok) > 128) s1[r] = -INFINITY;
                            }
                        }
                    }
                    softmax_pv(s0, s1, m0, l0, oa0, oa1, Vt, lane);
                } else {
                    { f32x16 s0 = qk_block<2>(Kt, 0, 0, qf, lane), s1 = qk_block<2>(Kt, 1, 0, qf, lane); softmax_pv(s0, s1, m0, l0, oa0, oa1, Vt, lane); }
                    { f32x16 s0 = qk_block<2>(Kt, 0, 4, qf + 2, lane), s1 = qk_block<2>(Kt, 1, 4, qf + 2, lane); softmax_pv(s0, s1, m1, l1, ob0, ob1, Vt, lane); }
                }
            }
            if (ti + 1 < ntile) { lds_u8* nb = lds + ((ti + 1) & 1) * LDS_TILE; *(LAS u32x4*)(nb + lds_off) = kreg; *(LAS u32x4*)(nb + 8192 + lds_off) = vreg; }
            __syncthreads();
        }
        const int grow = (grp ? MCTX + b * TLAT : b * TCTX) + qtok;
        const int ocol = (fam == 0 ? 0 : (fam == 1 ? 256 : 768)) + 64 * h;
        bf16_t* orow = (bf16_t*)(ws + WS_O) + (size_t)grow * 1024 + ocol + 4 * h5;
        float lt0 = l0 + __shfl_xor(l0, 32);
        if (fam == 1) lt0 += __builtin_amdgcn_exp2f(sm[SM_SINK + l * 8 + h] - m0);
        const float i0 = 1.0f / lt0;
        if (fam != 2) {
#pragma unroll
            for (int g = 0; g < 4; ++g) {
                u32x2 wa, wb; wa.x = cvt_pk_bf16(oa0[4 * g] * i0, oa0[4 * g + 1] * i0); wa.y = cvt_pk_bf16(oa0[4 * g + 2] * i0, oa0[4 * g + 3] * i0);
                wb.x = cvt_pk_bf16(oa1[4 * g] * i0, oa1[4 * g + 1] * i0); wb.y = cvt_pk_bf16(oa1[4 * g + 2] * i0, oa1[4 * g + 3] * i0);
                *(u32x2*)(orow + 8 * g) = wa; *(u32x2*)(orow + 32 + 8 * g) = wb;
            }
        } else {
            const float lt1 = l1 + __shfl_xor(l1, 32); const float i1 = 1.0f / lt1; const float lam = sm[SM_LAM + l];
            float ss = 0.f;
#pragma unroll
            for (int r = 0; r < 16; ++r) { oa0[r] = oa0[r] * i0 - lam * (ob0[r] * i1); oa1[r] = oa1[r] * i0 - lam * (ob1[r] * i1); ss += oa0[r] * oa0[r] + oa1[r] * oa1[r]; }
            ss += __shfl_xor(ss, 32);
            const float rn = __builtin_amdgcn_rsqf(ss * (1.f / 64.f) + 1e-6f) * (1.0f - lam_init);
            const float* sg = sm + SM_SUBG + l * 64 + 4 * h5;
#pragma unroll
            for (int g = 0; g < 4; ++g) {
                const f32x4 ga = *(const f32x4*)(sg + 8 * g), gb = *(const f32x4*)(sg + 32 + 8 * g);
                u32x2 wa, wb; wa.x = cvt_pk_bf16(oa0[4 * g] * rn * ga[0], oa0[4 * g + 1] * rn * ga[1]); wa.y = cvt_pk_bf16(oa0[4 * g + 2] * rn * ga[2], oa0[4 * g + 3] * rn * ga[3]);
                wb.x = cvt_pk_bf16(oa1[4 * g] * rn * gb[0], oa1[4 * g + 1] * rn * gb[1]); wb.y = cvt_pk_bf16(oa1[4 * g + 2] * rn * gb[2], oa1[4 * g + 3] * rn * gb[3]);
                *(u32x2*)(orow + 8 * g) = wa; *(u32x2*)(orow + 32 + 8 * g) = wb;
            }
        }
    }
}
}
namespace misc {
typedef LAS unsigned char lds_u8;
__device__ __forceinline__ float wave_sum(float v) {
#pragma unroll
    for (int o = 1; o < 64; o <<= 1) v += __shfl_xor(v, o);
    return v;
}
__device__ const double INVB[16] = {1.0, 0.5623413251903491, 0.31622776601683794, 0.1778279410038923, 0.1, 0.05623413251903491, 0.03162277660168379, 0.01778279410038923,
                                    0.01, 0.005623413251903491, 0.0031622776601683794, 0.001778279410038923, 0.001, 0.0005623413251903491, 0.00031622776601683794, 0.0001778279410038923};
__device__ const double INVC[8] = {1.0, 0.31622776601683794, 0.1, 0.03162277660168379, 0.01, 0.0031622776601683794, 0.001, 0.00031622776601683794};
__device__ __forceinline__ void sincos_d(double a, float& c, float& s) {
    const double k = rint(a * 0.6366197723675814);
    double r = fma(-k, 1.5707963267948966, a); r = fma(-k, 6.123233995736766e-17, r);
    const double r2 = r * r;
    const double sp = r * (1.0 + r2 * (-1.0 / 6.0 + r2 * (1.0 / 120.0 + r2 * (-1.0 / 5040.0 + r2 * (1.0 / 362880.0 + r2 * (-1.0 / 39916800.0 + r2 * (1.0 / 6227020800.0)))))));
    const double cp = 1.0 + r2 * (-0.5 + r2 * (1.0 / 24.0 + r2 * (-1.0 / 720.0 + r2 * (1.0 / 40320.0 + r2 * (-1.0 / 3628800.0 + r2 * (1.0 / 479001600.0 + r2 * (-1.0 / 87178291200.0)))))));
    const int q = ((int)k) & 3;
    const double cc = (q == 0) ? cp : (q == 1) ? -sp : (q == 2) ? -cp : sp;
    const double ss = (q == 0) ? sp : (q == 1) ? cp : (q == 2) ? -sp : -cp;
    c = (float)cc; s = (float)ss;
}
__device__ __forceinline__ void transpose_item(const float* W, int K, int N, bf16_t* WT, int k0, int n0, int dst0, LAS float* scr, int lane) {
#pragma unroll 8
    for (int i = 0; i < 32; ++i) { const int kk = 2 * i + (lane >> 5); scr[kk * 33 + (lane & 31)] = W[(size_t)(k0 + kk) * N + n0 + (lane & 31)]; }
    asm volatile("s_waitcnt lgkmcnt(0)" ::: "memory");
    const int c = lane & 7;
#pragma unroll
    for (int j = 0; j < 4; ++j) { const int n = (lane >> 3) + 8 * j; const LAS float* s = scr + (8 * c) * 33 + n;
        u32x4 o; o.x = cvt_pk_bf16(s[0 * 33], s[1 * 33]); o.y = cvt_pk_bf16(s[2 * 33], s[3 * 33]); o.z = cvt_pk_bf16(s[4 * 33], s[5 * 33]); o.w = cvt_pk_bf16(s[6 * 33], s[7 * 33]);
        *(u32x4*)(WT + (size_t)(dst0 + n) * K + k0 + 8 * c) = o; }
    asm volatile("s_waitcnt lgkmcnt(0)" ::: "memory");
}
__device__ __forceinline__ void gemv5_item(const float* W, int N, int n0, const LAS float* vec, LAS float* red, const float* add, float* out, int ostride, int tid) {
    const int col = tid & 31, kq = tid >> 5; float a0 = 0.f, a1 = 0.f, a2 = 0.f, a3 = 0.f, a4 = 0.f;
    const float* wp = W + (size_t)(kq * 64) * N + n0 + col; const LAS float* vp = vec + kq * 64;
#pragma unroll 8
    for (int k = 0; k < 64; ++k) { const float w = wp[(size_t)k * N]; a0 += vp[k] * w; a1 += vp[1024 + k] * w; a2 += vp[2048 + k] * w; a3 += vp[3072 + k] * w; a4 += vp[4096 + k] * w; }
    red[(kq * 5 + 0) * 32 + col] = a0; red[(kq * 5 + 1) * 32 + col] = a1; red[(kq * 5 + 2) * 32 + col] = a2; red[(kq * 5 + 3) * 32 + col] = a3; red[(kq * 5 + 4) * 32 + col] = a4;
    __syncthreads();
    if (tid < 160) { const int b = tid >> 5, c = tid & 31; float s = add ? add[n0 + c] : 0.f;
#pragma unroll
        for (int q = 0; q < 16; ++q) s += red[(q * 5 + b) * 32 + c];
        out[(size_t)b * ostride + n0 + c] = s; }
    __syncthreads();
}

__device__ __forceinline__ void phase_pro1(lds_u8* lds, const Args& a) {
    const int tid = opaque_tid(), lane = tid & 63, wave = __builtin_amdgcn_readfirstlane(tid >> 6), G = gridDim.x;
    unsigned char* ws = a.ws;
    { LAS float* vec = (LAS float*)lds; LAS float* red = (LAS float*)(lds + 20480);
      for (int i = tid; i < 5120; i += 512) { const int b5 = i >> 10, k = i & 1023; const float v = b5 == 0 ? a.in[I_CCTX][k] : a.in[I_C][(b5 - 1) * 1024 + k]; vec[i] = v / (1.f + __expf(-v)); }
      __syncthreads();
      float* mod = (float*)(ws + WS_MOD);
      for (int it = blockIdx.x; it < 4 * 192; it += G) { const int l = it / 192, n0 = (it % 192) * 32;
          gemv5_item(a.in[I_WMOD] + (size_t)l * 1024 * 6144, 6144, n0, vec, red, a.in[I_BMOD] + l * 6144, mod + (size_t)l * 5 * 6144, 6144, tid); }
      __syncthreads(); }
    { LAS float* scr = (LAS float*)(lds + wave * 16384);
      const int gw = blockIdx.x * 8 + wave, NGW = G * 8;
      constexpr int I_IN = 16 * 72, I_OUT = 16 * 32, I_UP = 16 * 176, I_DN = 44 * 32, I_L = I_IN + I_OUT + I_UP + I_DN;
      for (int it = gw; it < 4 * I_L; it += NGW) {
          const int l = it / I_L; int r = it % I_L;
          if (r < I_IN) { const int kb = r / 72, nb = r % 72, n0 = 32 * nb; const int tile = n0 >> 8, L = n0 & 255, wc = L >> 6, bj = (L >> 5) & 1; const int dst0 = 256 * tile + 128 * bj + 32 * wc;
              transpose_item(a.in[I_WIN] + (size_t)l * 1024 * DIN, 1024, DIN, (bf16_t*)(ws + WS_WIN) + (size_t)l * DIN * 1024, 64 * kb, n0, dst0, scr, lane); continue; }
          r -= I_IN;
          if (r < I_OUT) { const int kb = r / 32, nb = r % 32; transpose_item(a.in[I_WOUT] + (size_t)l * 1024 * 1024, 1024, 1024, (bf16_t*)(ws + WS_WOUT) + (size_t)l * 1024 * 1024, 64 * kb, 32 * nb, 32 * nb, scr, lane); continue; }
          r -= I_OUT;
          if (r < I_UP) { const int kb = r / 176, nb = r % 176; transpose_item(a.in[I_WUP] + (size_t)l * 1024 * DUP, 1024, DUP, (bf16_t*)(ws + WS_WUP) + (size_t)l * DUP * 1024, 64 * kb, 32 * nb, 32 * nb, scr, lane); continue; }
          r -= I_UP;
          { const int kb = r / 32, nb = r % 32; transpose_item(a.in[I_WDOWN] + (size_t)l * DFF * 1024, DFF, 1024, (bf16_t*)(ws + WS_WDOWN) + (size_t)l * 1024 * DFF, 64 * kb, 32 * nb, 32 * nb, scr, lane); }
      } }
    const int gtid = blockIdx.x * 512 + tid, NT = G * 512;
    { bf16_t* kc = (bf16_t*)(ws + WS_KC);
      for (int fam = 0; fam < 3; ++fam) {
          const int H = fam == 1 ? 2 : 4; const float* ck = a.in[fam == 0 ? I_CNAK : (fam == 1 ? I_CSWK : I_CDAK)]; const float* cv = a.in[fam == 0 ? I_CNAV : (fam == 1 ? I_CSWV : I_CDAV)];
          bf16_t* dk = kc + (fam == 0 ? CO_KA : (fam == 1 ? CO_KB : CO_KCC)); bf16_t* dv = kc + (fam == 0 ? CO_VTA : (fam == 1 ? CO_VTB : CO_VTCC));
          const int totk = 4 * 4 * 512 * H * 8;
          for (int i = gtid; i < totk; i += NT) { const int d8 = i & 7, hh = (i >> 3) % H, p = (i / (8 * H)) & 511, l = (i / (8 * H * 512)) & 3, b = i / (8 * H * 512 * 4);
              const float* s = ck + ((((size_t)b * 4 + l) * 512 + p) * H + hh) * 64 + d8 * 8; const f32x4 x = *(const f32x4*)s, y = *(const f32x4*)(s + 4);
              u32x4 o; o.x = cvt_pk_bf16(x[0], x[1]); o.y = cvt_pk_bf16(x[2], x[3]); o.z = cvt_pk_bf16(y[0], y[1]); o.w = cvt_pk_bf16(y[2], y[3]);
              *(u32x4*)(dk + ((((size_t)l * 4 + b) * H + hh) * 512 + p) * 64 + d8 * 8) = o; }
          const int totv = 4 * 4 * H * 64 * 64;
          for (int i = gtid; i < totv; i += NT) { const int d = i & 63, p8 = (i >> 6) & 63, hh = (i >> 12) % H, l = (i / (4096 * H)) & 3, b = i / (4096 * H * 4);
              const float* s = cv + ((((size_t)b * 4 + l) * 512 + p8 * 8) * H + hh) * 64 + d; float x[8];
#pragma unroll
              for (int j = 0; j < 8; ++j) x[j] = s[(size_t)j * H * 64];
              u32x4 o; o.x = cvt_pk_bf16(x[0], x[1]); o.y = cvt_pk_bf16(x[2], x[3]); o.z = cvt_pk_bf16(x[4], x[5]); o.w = cvt_pk_bf16(x[6], x[7]);
              *(u32x4*)(dv + ((((size_t)l * 4 + b) * H + hh) * 64 + d) * 512 + p8 * 8) = o; }
      } }
    { float* rb = (float*)(ws + WS_ROPEB); float* rc = (float*)(ws + WS_ROPEC);
      for (int i = gtid; i < 2048 * 32; i += NT) { const int t = i >> 5, j = i & 31; const double pos = (double)(j < 16 ? (t >> 6) : (t & 63)); float c, s; sincos_d(pos * INVB[j & 15], c, s); rb[2 * i] = c; rb[2 * i + 1] = s; }
      for (int i = gtid; i < 2048 * 16; i += NT) { const int t = i >> 4, j = i & 15; const double pos = (double)(j < 8 ? (t >> 6) : (t & 63)); float c, s; sincos_d(pos * INVC[j & 7], c, s); rc[2 * i] = c; rc[2 * i + 1] = s; } }
    { float* sm = (float*)(ws + WS_LAM);
      if (gtid < 4) { const int l = gtid; const float* lp = a.in[I_LAMBDA] + l * 128; float s1 = 0.f, s2 = 0.f;
          for (int i = 0; i < 32; ++i) { s1 += lp[i] * lp[32 + i]; s2 += lp[64 + i] * lp[96 + i]; }
          sm[SM_LAM + l] = expf(s1) - expf(s2) + (0.8f - 0.6f * expf(-0.3f * (float)l)); }
      for (int i = gtid; i < 1280; i += NT) { const int l = i / 320, r = i % 320; sm[SM_GAINS + i] = r < 128 ? a.in[I_NAG][l * 128 + r] : (r < 256 ? a.in[I_SWG][l * 128 + r - 128] : a.in[I_DAG][l * 64 + r - 256]); }
      for (int i = gtid; i < 7440; i += NT) sm[SM_RPB + i] = a.in[I_RPB][i] * LOG2E;
      for (int i = gtid; i < 32; i += NT) sm[SM_SINK + i] = a.in[I_SINK][i] * LOG2E;
      for (int i = gtid; i < 256; i += NT) sm[SM_SUBG + i] = a.in[I_SUBG][i]; }
}
__device__ __forceinline__ void phase_pro2(lds_u8* lds, const Args& a) {
    const int tid = opaque_tid(), G = gridDim.x; unsigned char* ws = a.ws;
    const float* mod = (const float*)(ws + WS_MOD);
    const int gtid = blockIdx.x * 512 + tid, NT = G * 512;
    { float* gv = (float*)(ws + WS_GV);
      for (int i = gtid; i < 4 * 5 * 2 * 1024; i += NT) { const int c = i & 1023, which = (i >> 10) & 1, b5 = (i >> 11) % 5, l = i / 10240;
          const float g = a.in[which ? I_GFFN : I_GATTN][l * 1024 + c]; const float sc = mod[((size_t)(l * 5 + b5) * 6 + (which ? 4 : 1)) * 1024 + c]; gv[i] = g * (1.f + sc); } }
    LAS float* vec = (LAS float*)lds; LAS float* red = (LAS float*)(lds + 20480);
    for (int it = blockIdx.x; it < 4 * (72 + 176); it += G) {
        const int l = it / 248, r = it % 248; const int which = r < 72 ? 0 : 1; const int n0 = 32 * (which ? r - 72 : r);
        __syncthreads();
        for (int i = tid; i < 5120; i += 512) { const int b5 = i >> 10, k = i & 1023; vec[i] = mod[((size_t)(l * 5 + b5) * 6 + (which ? 3 : 0)) * 1024 + k]; }
        __syncthreads();
        if (!which) gemv5_item(a.in[I_WIN] + (size_t)l * 1024 * DIN, DIN, n0, vec, red, nullptr, (float*)(ws + WS_BIASIN) + (size_t)l * 5 * DIN, DIN, tid);
        else gemv5_item(a.in[I_WUP] + (size_t)l * 1024 * DUP, DUP, n0, vec, red, nullptr, (float*)(ws + WS_BIASUP) + (size_t)l * 5 * DUP, DUP, tid);
    }
}
__device__ __forceinline__ void phase_make_xa(const Args& a, int l, int which, int first) {
    const int tid = opaque_tid(), lane = tid & 63, wave = tid >> 6; unsigned char* ws = a.ws;
    const float* gv = (const float*)(ws + WS_GV); bf16_t* xa = (bf16_t*)(ws + WS_XA); float* ssq = (float*)(ws + WS_SSQ);
    for (int row = blockIdx.x * 8 + wave; row < MTOT; row += gridDim.x * 8) {
        const float* src = first ? (row < MCTX ? a.in[I_XP] + (size_t)row * 1024 : a.in[I_XS] + (size_t)(row - MCTX) * 1024) : a.out + (size_t)row * 1024;
        const float* g = gv + ((size_t)(l * 5 + row_b5(row)) * 2 + which) * 1024;
        f32x4 v[4]; float s = 0.f;
#pragma unroll
        for (int j = 0; j < 4; ++j) { v[j] = *(const f32x4*)(src + 256 * j + 4 * lane); s += (v[j][0] * v[j][0] + v[j][1] * v[j][1]) + (v[j][2] * v[j][2] + v[j][3] * v[j][3]); }
        s = wave_sum(s);
#pragma unroll
        for (int j = 0; j < 4; ++j) { if (first) *(f32x4*)(a.out + (size_t)row * 1024 + 256 * j + 4 * lane) = v[j];
            const f32x4 y = v[j] * *(const f32x4*)(g + 256 * j + 4 * lane); u32x2 w; w.x = cvt_pk_bf16(y[0], y[1]); w.y = cvt_pk_bf16(y[2], y[3]); *(u32x2*)(xa + (size_t)row * 1024 + 256 * j + 4 * lane) = w; }
        if (lane < 16) ssq[(size_t)row * 16 + lane] = lane == 0 ? s : 0.f;
    }
}
__device__ __forceinline__ void phase_conv(const Args& a, int l, int half) {
    const int gtid = blockIdx.x * 512 + opaque_tid(), NT = gridDim.x * 512; unsigned char* ws = a.ws;
    const bf16_t* U = (const bf16_t*)(ws + WS_U); bf16_t* ACT = (bf16_t*)(ws + WS_ACT) + (size_t)half * 8192 * DFF;
    const int T = half ? TLAT : TCTX; const float* cw = a.in[I_CONVW] + (size_t)l * 3 * DUP; const float* cb = a.in[I_CONVB] + (size_t)l * DUP;
    constexpr int F8 = DFF / 8, RCH = 16, NCH = 8192 / RCH;
    for (int it = gtid; it < F8 * NCH; it += NT) {
        const int f = (it % F8) * 8, r0 = (it / F8) * RCH;
        float w[2][3][8], bb[2][8];
#pragma unroll
        for (int hh = 0; hh < 2; ++hh) {
#pragma unroll
            for (int j = 0; j < 3; ++j) { const f32x4 x = *(const f32x4*)(cw + j * DUP + hh * DFF + f), y = *(const f32x4*)(cw + j * DUP + hh * DFF + f + 4);
#pragma unroll
                for (int e = 0; e < 4; ++e) { w[hh][j][e] = x[e]; w[hh][j][4 + e] = y[e]; } }
            const f32x4 x = *(const f32x4*)(cb + hh * DFF + f), y = *(const f32x4*)(cb + hh * DFF + f + 4);
#pragma unroll
            for (int e = 0; e < 4; ++e) { bb[hh][e] = x[e]; bb[hh][4 + e] = y[e]; }
        }
        float up[2][8], uc[2][8], un[2][8];
        auto ld = [&](int r, float (&d)[2][8]) {
            const bool ok = (r >= 0) && (r < 8192) && ((r / T) == (r0 / T));
#pragma unroll
            for (int hh = 0; hh < 2; ++hh) { u32x4 q = {0u, 0u, 0u, 0u}; if (ok) q = *(const u32x4*)(U + (size_t)r * DUP + hh * DFF + f);
#pragma unroll
                for (int e = 0; e < 4; ++e) { d[hh][2 * e] = __builtin_bit_cast(float, q[e] << 16); d[hh][2 * e + 1] = __builtin_bit_cast(float, q[e] & 0xffff0000u); } }
        };
        ld(r0 - 1, up); ld(r0, uc);
        for (int r = r0; r < r0 + RCH; ++r) {
            ld(r + 1, un);
            float o[8];
#pragma unroll
            for (int e = 0; e < 8; ++e) { const float yg = bb[0][e] + w[0][0][e] * up[0][e] + w[0][1][e] * uc[0][e] + w[0][2][e] * un[0][e]; const float yv = bb[1][e] + w[1][0][e] * up[1][e] + w[1][1][e] * uc[1][e] + w[1][2][e] * un[1][e];
                o[e] = yg / (1.f + __expf(-yg)) * yv; }
            u32x4 q; q.x = cvt_pk_bf16(o[0], o[1]); q.y = cvt_pk_bf16(o[2], o[3]); q.z = cvt_pk_bf16(o[4], o[5]); q.w = cvt_pk_bf16(o[6], o[7]);
            *(u32x4*)(ACT + (size_t)r * DFF + f) = q;
#pragma unroll
            for (int hh = 0; hh < 2; ++hh)
#pragma unroll
                for (int e = 0; e < 8; ++e) { up[hh][e] = uc[hh][e]; uc[hh][e] = un[hh][e]; }
        }
    }
}
}
constexpr int LDS_BYTES = 147456;
enum Phase { PH_PRO1 = 0, PH_PRO2, PH_MAKEXA, PH_IN, PH_ATT, PH_OUT, PH_UP, PH_CONV, PH_DOWN };

__device__ __forceinline__ void run_phase(LAS unsigned char* lds, const Args& a, int ph, int l, int p1, int p2) {
    unsigned char* ws = a.ws; const int G = gridDim.x;
    switch (ph) {
    case PH_PRO1: misc::phase_pro1(lds, a); break;
    case PH_PRO2: misc::phase_pro2(lds, a); break;
    case PH_MAKEXA: misc::phase_make_xa(a, l, p1, p2); break;
    case PH_IN: {
        pg8::Gemm g{(const bf16_t*)(ws + WS_XA), (const bf16_t*)(ws + WS_WIN) + (size_t)l * DIN * 1024, MTOT, DIN, 1024}; pg8::StaticOrder S; S.init(MTOT, DIN, G, (int)blockIdx.x);
        pg8::EpiIn E{ws, a.out, l};
        pg8::gemm_phase<pg8::EpiIn, pg8::StaticOrder, true, true>(lds, g, S, E); } break;
    case PH_ATT: {
        att::Ctx C{ws, l};
        att::attn_phase(lds, C); } break;
    case PH_OUT: {
        pg8::Gemm g{(const bf16_t*)(ws + WS_O), (const bf16_t*)(ws + WS_WOUT) + (size_t)l * 1024 * 1024, MTOT, 1024, 1024}; pg8::StaticOrder S; S.init(MTOT, 1024, G, (int)blockIdx.x);
        pg8::EpiRes E{ws, a.out, l, 0};
        pg8::gemm_phase<pg8::EpiRes, pg8::StaticOrder, false, true>(lds, g, S, E); } break;
    case PH_UP: {
        pg8::Gemm g{(const bf16_t*)(ws + WS_XA) + (size_t)p1 * 8192 * 1024, (const bf16_t*)(ws + WS_WUP) + (size_t)l * DUP * 1024, 8192, DUP, 1024}; pg8::StaticOrder S; S.init(8192, DUP, G, (int)blockIdx.x);
        pg8::EpiUp E{ws, l, p1 * 8192};
        pg8::gemm_phase<pg8::EpiUp, pg8::StaticOrder, true, true>(lds, g, S, E); } break;
    case PH_CONV: misc::phase_conv(a, l, p1); break;
    case PH_DOWN: {
        pg8::Gemm g{(const bf16_t*)(ws + WS_ACT), (const bf16_t*)(ws + WS_WDOWN) + (size_t)l * 1024 * DFF, MTOT, 1024, DFF}; pg8::StaticOrder S; S.init(MTOT, 1024, G, (int)blockIdx.x);
        pg8::EpiRes E{ws, a.out, l, 1};
        pg8::gemm_phase<pg8::EpiRes, pg8::StaticOrder, false, true>(lds, g, S, E); } break;
    default: break;
    }
}

#define XB_TMO      128
#define XB_XCNT(j)  (256  + 64 * (j))
#define XB_XSUB(j)  (1280 + 64 * (j))
#define XB_XGEN(j)  (2304 + 64 * (j))
#define XB_TOP      3328
#define XB_TOPGEN   3392
#define XCD_BAR_WORDS 3456
#define XB_SPIN_CAP (1u << 18)
__device__ __forceinline__ unsigned xb_ld(unsigned* p)              { return __hip_atomic_load(p, __ATOMIC_RELAXED, __HIP_MEMORY_SCOPE_AGENT); }
__device__ __forceinline__ unsigned xb_add(unsigned* p, unsigned v) { return __hip_atomic_fetch_add(p, v, __ATOMIC_RELAXED, __HIP_MEMORY_SCOPE_AGENT); }
__device__ __forceinline__ unsigned xb_xcc_id() { return (unsigned)__builtin_amdgcn_s_getreg((3 << 11) | 20) & 0xFu; }
#define XB_SPIN(cond, bar) do { unsigned _sp = 0; while (cond) { __builtin_amdgcn_s_sleep(1); \
    if ((++_sp & 255u) == 0u) { if (xb_ld(&(bar)[XB_TMO])) break; if (_sp > XB_SPIN_CAP) { atomicAdd(&(bar)[XB_TMO], 1u); break; } } } } while (0)
struct XcdBarrier { unsigned* bar; unsigned x; volatile LAS unsigned* st; };
__device__ __forceinline__ XcdBarrier xcd_barrier_post(unsigned* bar, volatile LAS unsigned* st) {
    XcdBarrier b; b.bar = bar; b.x = xb_xcc_id(); b.st = st;
    if (threadIdx.x == 0) (void)xb_add(&bar[XB_XCNT(b.x)], 1u);
    return b;
}
__device__ __forceinline__ void xcd_barrier_complete(unsigned* bar, unsigned x, unsigned& nloc, unsigned& nx) {
    const unsigned G = gridDim.x * gridDim.y * gridDim.z;
    unsigned sum, cnt, mine, sp = 0u;
    for (;;) {
        sum = 0u; cnt = 0u; mine = 0u;
#pragma unroll
        for (unsigned j = 0; j < 16; ++j) { const unsigned c = xb_ld(&bar[XB_XCNT(j)]); sum += c; cnt += (c > 0u) ? 1u : 0u; mine = (j == x) ? c : mine; }
        if (sum == G) break;
        __builtin_amdgcn_s_sleep(1);
        if ((++sp & 255u) == 0u) { if (xb_ld(&bar[XB_TMO])) break; if (sp > XB_SPIN_CAP) { atomicAdd(&bar[XB_TMO], 1u); break; } }
    }
    nloc = mine > 0u ? mine : 1u; nx = cnt > 0u ? cnt : 1u;
}
__device__ __forceinline__ void xcd_barrier(const XcdBarrier& b) {
    asm volatile("s_waitcnt vmcnt(0)" ::: "memory");
    __syncthreads();
    if (threadIdx.x == 0) {
        unsigned* bar = b.bar;
        __builtin_amdgcn_s_waitcnt(0);
        unsigned nloc = b.st[0], nx = b.st[1];
        if (nloc == 0u) { xcd_barrier_complete(bar, b.x, nloc, nx); b.st[0] = nloc; b.st[1] = nx; }
        const unsigned old = xb_add(&bar[XB_XSUB(b.x)], 1u);
        const unsigned gen = old / nloc;
        if (old + 1u == (gen + 1u) * nloc) {
            __builtin_amdgcn_fence(__ATOMIC_RELEASE, "agent");
            asm volatile("s_waitcnt vmcnt(0)" ::: "memory");
            const unsigned og = xb_add(&bar[XB_TOP], 1u);
            const unsigned tg = og / nx;
            if (og + 1u == (tg + 1u) * nx) xb_add(&bar[XB_TOPGEN], 1u);
            else XB_SPIN(xb_ld(&bar[XB_TOPGEN]) == tg, bar);
            __builtin_amdgcn_fence(__ATOMIC_ACQUIRE, "agent");
            xb_add(&bar[XB_XGEN(b.x)], 1u);
            asm volatile("s_waitcnt vmcnt(0)" ::: "memory");
        } else {
            XB_SPIN(xb_ld(&bar[XB_XGEN(b.x)]) == gen, bar);
            __builtin_amdgcn_fence(__ATOMIC_ACQUIRE, "agent");
            asm volatile("s_waitcnt vmcnt(0)" ::: "memory");
        }
    }
    __syncthreads();
}
constexpr int CW_BAR = 4096;
constexpr int LDS_BARST = 131072 + 256;
__global__ void __launch_bounds__(512, 2) mk_fwd(Args a) {
    extern __shared__ __attribute__((aligned(16))) unsigned char lds_raw[];
    LAS unsigned char* lds = (LAS unsigned char*)lds_raw;
    cg::grid_group grid = cg::this_grid();
    if (threadIdx.x < 2) ((volatile LAS unsigned*)(lds + LDS_BARST))[threadIdx.x] = 0u;
    __syncthreads();
    const XcdBarrier xbar = xcd_barrier_post((unsigned*)(a.ws + WS_CTL) + CW_BAR, (volatile LAS unsigned*)(lds + LDS_BARST));
#define GSYNC() xcd_barrier(xbar)
    run_phase(lds, a, PH_PRO1, 0, 0, 0); grid.sync();
    run_phase(lds, a, PH_PRO2, 0, 0, 0); GSYNC();
    run_phase(lds, a, PH_MAKEXA, 0, 0, 1); GSYNC();
#pragma unroll 1
    for (int l = 0; l < DEPTH; ++l) {
        run_phase(lds, a, PH_IN, l, 0, 0); GSYNC();
        run_phase(lds, a, PH_ATT, l, 0, 0); GSYNC();
        run_phase(lds, a, PH_OUT, l, 0, 0); GSYNC();
#pragma unroll 1
        for (int half = 0; half < 2; ++half) { run_phase(lds, a, PH_UP, l, half, 0); GSYNC(); run_phase(lds, a, PH_CONV, l, half, 0); GSYNC(); }
        run_phase(lds, a, PH_DOWN, l, 0, 0);
        if (l < DEPTH - 1) GSYNC();
    }
}

extern "C" void kernel_launch(void* const* d_in, const int* in_sizes, int n_in, void* d_out, int out_size, void* d_ws, size_t ws_size, hipStream_t stream) {
    static int grid = 0;
    if (grid == 0) {
        int dev = 0, cus = 0, per_cu = 0;
        (void)hipGetDevice(&dev); (void)hipDeviceGetAttribute(&cus, hipDeviceAttributeMultiprocessorCount, dev);
        (void)hipFuncSetAttribute((const void*)mk_fwd, hipFuncAttributeMaxDynamicSharedMemorySize, LDS_BYTES);
        (void)hipOccupancyMaxActiveBlocksPerMultiprocessor(&per_cu, (const void*)mk_fwd, 512, LDS_BYTES);
        if (per_cu < 1) fprintf(stderr, "kernel_launch: occupancy query reports %d blocks per CU\n", per_cu);
        grid = cus > 0 ? cus : 256;
        if (ws_size < WS_END) { fprintf(stderr, "kernel_launch: workspace too small (%zu < %zu)\n", ws_size, (size_t)WS_END); grid = -1; }
    }
    if (grid < 0) return;
    Args a{}; for (int i = 0; i < N_IN; ++i) a.in[i] = (const float*)d_in[i]; a.out = (float*)d_out; a.ws = (unsigned char*)d_ws;
    (void)hipMemsetAsync((unsigned char*)d_ws + WS_CTL, 0, 1 * MiB, stream);
    void* args[] = {&a};
    hipError_t e = hipLaunchCooperativeKernel((const void*)mk_fwd, dim3(grid), dim3(512), args, LDS_BYTES, stream);
    if (e != hipSuccess) fprintf(stderr, "cooperative launch failed: %s (grid %d)\n", hipGetErrorString(e), grid);
}
```

```cpp
#include <hip/hip_runtime.h>
#include <hip/hip_cooperative_groups.h>
#include <cstdio>
#include <cstdint>
namespace cg = cooperative_groups;

constexpr int DEPTH = 4, NCTX = 32, TCTX = 256, NLAT = 4, TLAT = 2048, PAST = 512;
constexpr int MCTX = 8192, MLAT = 8192, MTOT = 16384;
constexpr int DIN = 2304, DFF = 2816, DUP = 5632;
constexpr size_t OUT_X = 0, OUT_NAK = 16777216, OUT_NAV = 25165824, OUT_SWK = 33554432, OUT_SWV = 37748736, OUT_DAK = 41943040, OUT_DAV = 50331648, OUT_TOTAL = 58720256;
enum { I_XP = 0, I_XS, I_CNAK, I_CNAV, I_CSWK, I_CSWV, I_CDAK, I_CDAV, I_C, I_CCTX, I_GATTN, I_GFFN, I_WMOD, I_BMOD, I_WIN, I_NAG, I_RPB, I_SWG, I_SINK, I_DAG, I_LAMBDA, I_SUBG, I_WOUT, I_WUP, I_CONVW, I_CONVB, I_WDOWN, N_IN };
#define LAS __attribute__((address_space(3)))
typedef unsigned short bf16_t;
typedef short bf16x8 __attribute__((ext_vector_type(8)));
typedef float f32x4 __attribute__((ext_vector_type(4)));
typedef float f32x2 __attribute__((ext_vector_type(2)));
typedef float f32x16 __attribute__((ext_vector_type(16)));
typedef unsigned u32x4 __attribute__((ext_vector_type(4)));
typedef unsigned u32x2 __attribute__((ext_vector_type(2)));
typedef __bf16 bf16x2_t __attribute__((ext_vector_type(2)));

constexpr float LOG2E = 1.4426950408889634f;
constexpr float QSCALE64 = 0.125f * LOG2E, QSCALE32 = 0.17677669529663687f * LOG2E;

__device__ __forceinline__ unsigned cvt_pk_bf16(float lo, float hi) { f32x2 v = {lo, hi}; bf16x2_t b = __builtin_convertvector(v, bf16x2_t); return __builtin_bit_cast(unsigned, b); }
__device__ __forceinline__ float bf16_to_f32(bf16_t v) { return __builtin_bit_cast(float, (unsigned)v << 16); }
__device__ __forceinline__ int row_b5(int row) { return row < MCTX ? 0 : 1 + ((row - MCTX) >> 11); }

constexpr size_t MiB = 1u << 20;
constexpr size_t WS_CTL = 0;
constexpr size_t WS_MOD = 1 * MiB;
constexpr size_t WS_GV = WS_MOD + 512 * 1024;
constexpr size_t WS_BIASIN = WS_GV + 256 * 1024;
constexpr size_t WS_BIASUP = WS_BIASIN + 256 * 1024;
constexpr size_t WS_LAM = WS_BIASUP + 512 * 1024;
constexpr int SM_LAM = 0, SM_GAINS = 64, SM_RPB = SM_GAINS + 1280, SM_SINK = SM_RPB + 7440, SM_SUBG = SM_SINK + 32, SM_END = SM_SUBG + 256;
constexpr size_t WS_ROPEB = 3 * MiB;
constexpr size_t WS_ROPEC = WS_ROPEB + 512 * 1024;
constexpr size_t WS_SSQ = 4 * MiB;
constexpr size_t WS_CONV = 5 * MiB;
constexpr size_t WS_WIN = 6 * MiB;
constexpr size_t WS_WOUT = WS_WIN + 18 * MiB;
constexpr size_t WS_WUP = WS_WOUT + 8 * MiB;
constexpr size_t WS_WDOWN = WS_WUP + 44 * MiB;
constexpr size_t WS_KC = WS_WDOWN + 22 * MiB;
constexpr size_t WS_XA = WS_KC + 20 * MiB;
constexpr size_t WS_QKV = WS_XA + 32 * MiB + 1 * MiB;
constexpr size_t WS_O = WS_QKV + 72 * MiB;
constexpr size_t WS_ACT = WS_QKV;
constexpr size_t WS_END = WS_O + 32 * MiB;
constexpr size_t GS4 = 2097152, GS8 = 4194304, GS2 = 1048576;
constexpr size_t QO_QA = 0, QO_KA = QO_QA + 2 * GS4, QO_VTA = QO_KA + 2 * GS4, QO_QB = QO_VTA + 2 * GS4, QO_KB = QO_QB + 2 * GS8, QO_VTB = QO_KB + 2 * GS2,
                 QO_QC = QO_VTB + 2 * GS2, QO_KC = QO_QC + 2 * GS4, QO_VTC = QO_KC + 2 * GS4, QO_END = QO_VTC + 2 * GS4;
static_assert(QO_END * 2 == 72 * MiB, "qkv region");
constexpr size_t CO_KA = 0, CO_VTA = CO_KA + GS4, CO_KB = CO_VTA + GS4, CO_VTB = CO_KB + GS2, CO_KCC = CO_VTB + GS2, CO_VTCC = CO_KCC + GS4;

struct Args { const float* in[N_IN]; float* out; unsigned char* ws; };
__device__ __forceinline__ int opaque_tid() { int t = threadIdx.x; asm volatile("" : "+v"(t)); return t; }

namespace pg8 {
#define PG8_LAS __attribute__((address_space(3)))
constexpr int BM = 256, BK = 64, HALF = 128, HTB = HALF * BK * 2  , STAGE_BYTES = 8 * HTB, NXCD = 8, WGM = 8;
__host__ __device__ __forceinline__ int lds_byte(int r, int c) { const int st = (r >> 4) * 2 + (c >> 5), rr = r & 15, cc = c & 31, ob = rr * 64 + cc * 2; return st * 1024 + (ob ^ (((ob >> 9) & 1) << 5)); }
__host__ __device__ __forceinline__ void stage_rc(int b, int& R, int& C) { const int st = b / 1024, sb = b % 1024, swz = sb ^ (((sb >> 9) & 1) << 5); R = (st >> 1) * 16 + swz / 64; C = (st & 1) * 32 + (swz % 64) / 2; }
__host__ __device__ __forceinline__ int perm32(int rho) { const int n = rho >> 4, i = rho & 15; return 8 * (i >> 2) + 4 * n + (i & 3); }
struct Unit { int pm, pn; };
struct Gemm { const bf16_t* A; const bf16_t* Bt; int M, N, K; };
struct StaticOrder {
    int nM, nN, nwg, G, c;
    __host__ __device__ void init(int M, int N, int G_, int c_) { nM = M / BM; nN = N / BM; nwg = nM * nN; G = G_; c = c_; }
    __host__ __device__ bool next(int i, Unit& u) const {
        const long L = (long)i * G + c; if (L >= nwg) return false;
        int wgid = (int)L; { const int q = nwg / NXCD, r = nwg % NXCD, xcd = wgid % NXCD, off = wgid / NXCD; wgid = (xcd < r ? xcd * (q + 1) : r * (q + 1) + (xcd - r) * q) + off; }
        const int nig = WGM * nN, gid = wgid / nig, fm = gid * WGM, gsz = (nM - fm) < WGM ? (nM - fm) : WGM;
        u.pm = fm + ((wgid % nig) % gsz); u.pn = (wgid % nig) / gsz; return true;
    }
    __device__ __forceinline__ void a_ready(const Unit&) const {}
    __device__ __forceinline__ void done(const Unit&) const {}
    __device__ __forceinline__ int arow0(int pm) const { return BM * pm; }
};
struct UpOrder : StaticOrder {
    __device__ __forceinline__ void init_up(int G_, int c_) { nM = 68; nN = 22; nwg = nM * nN; G = G_; c = c_; }
    __device__ __forceinline__ int arow0(int pm) const { return pm < 32 ? BM * pm : MCTX + TLAT * ((pm - 32) / 9) + 254 * ((pm - 32) % 9) - 1; }
};

template <class Epi, class Sched, bool ALIGN_EPI = false, bool SP2 = false>
__device__ __forceinline__ void gemm_phase(PG8_LAS unsigned char* lds, const Gemm g, const Sched& S, const Epi& E) {
    const int tid = opaque_tid(), wid = __builtin_amdgcn_readfirstlane(tid >> 6), lane = tid & 63, wr = wid >> 2, wc = wid & 3, fr = lane & 15, fq = lane >> 4;
    const int K = g.K, nt = K / BK;
    unsigned voffA[2], voffB[2];
#pragma unroll
    for (int i = 0; i < 2; ++i) { int R, C; stage_rc(tid * 16 + i * 8192, R, C); const int Rb = Epi::PERM ? ((R & ~31) + perm32(R & 31)) : R;
        voffA[i] = (unsigned)(R * K + C) * 2u; voffB[i] = (unsigned)(Rb * K + C) * 2u; }
    const size_t kstep = (size_t)(BK * 2);
    const size_t hstep = (size_t)HALF * K * 2;
    const size_t tstep = 2 * hstep;
    const unsigned ldsw = (unsigned)wid * 1024u;
    const int aoff = lds_byte(wr * 64 + fr, fq * 8), boff = lds_byte(wc * 32 + fr, fq * 8);
#define PG8_SA(b, h) (((b) * 2 + (h)) * HTB)
#define PG8_SB(b, h) ((4 + (b) * 2 + (h)) * HTB)
#define PG8_STAGE(bufoff, gbase, voff) do { _Pragma("unroll") for (int _i = 0; _i < 2; ++_i) \
        __builtin_amdgcn_global_load_lds((const unsigned*)((const char*)(gbase) + (voff)[_i]), (PG8_LAS unsigned*)(lds + (bufoff) + ldsw + _i * 8192), 16, 0, 0); } while (0)
#define PG8_LDA(dst, b, h) do { _Pragma("unroll") for (int m = 0; m < 4; ++m) _Pragma("unroll") for (int k = 0; k < 2; ++k) dst[m][k] = *(const PG8_LAS bf16x8*)(lds + PG8_SA(b, h) + aoff + m * 2048 + k * 1024); } while (0)
#define PG8_LDB(dst, b, h) do { _Pragma("unroll") for (int n = 0; n < 2; ++n) _Pragma("unroll") for (int k = 0; k < 2; ++k) dst[n][k] = *(const PG8_LAS bf16x8*)(lds + PG8_SB(b, h) + boff + n * 2048 + k * 1024); } while (0)
#define PG8_MMA(ai, bj, At, Bt) do { __builtin_amdgcn_s_setprio(1); _Pragma("unroll") for (int m = 0; m < 4; ++m) _Pragma("unroll") for (int n = 0; n < 2; ++n) _Pragma("unroll") for (int k = 0; k < 2; ++k) \
        acc[ai][bj][m][n] = __builtin_amdgcn_mfma_f32_16x16x32_bf16(Bt[n][k], At[m][k], acc[ai][bj][m][n], 0, 0, 0); __builtin_amdgcn_s_setprio(0); } while (0)
#define PG8_WAIT_V(n) asm volatile("s_waitcnt vmcnt(" #n ")" ::: "memory")
#define PG8_WAIT_L(n) asm volatile("s_waitcnt lgkmcnt(" #n ")" ::: "memory")
#define PG8_BAR __builtin_amdgcn_s_barrier()
#define PG8_SCHED __builtin_amdgcn_sched_barrier(0)
    Unit cur, nxt; int ui = 0;
    if (!S.next(0, cur)) return;
    f32x4 acc[2][2][4][2];
#pragma unroll
    for (int a = 0; a < 2; ++a)
#pragma unroll
        for (int b = 0; b < 2; ++b)
#pragma unroll
            for (int m = 0; m < 4; ++m)
#pragma unroll
                for (int n = 0; n < 2; ++n) acc[a][b][m][n] = (f32x4){0.f, 0.f, 0.f, 0.f};
    bf16x8 At[4][2], B0[2][2], B1[2][2];
    const size_t rstep = (size_t)K * 2;
    const char* cA = (const char*)g.A + (size_t)S.arow0(cur.pm) * rstep; const char* cB = (const char*)g.Bt + (size_t)cur.pn * tstep;
    S.a_ready(cur);
    if constexpr (SP2) {
        PG8_STAGE(PG8_SB(0, 0), cB, voffB); PG8_STAGE(PG8_SB(0, 1), cB + hstep, voffB); PG8_STAGE(PG8_SA(0, 0), cA, voffA); PG8_STAGE(PG8_SA(0, 1), cA + hstep, voffA);
        if (wr == 1) PG8_BAR;
        PG8_WAIT_V(2); PG8_BAR;
        PG8_STAGE(PG8_SB(1, 0), cB + kstep, voffB); PG8_STAGE(PG8_SA(1, 0), cA + kstep, voffA); PG8_STAGE(PG8_SB(1, 1), cB + hstep + kstep, voffB);
        PG8_WAIT_V(6); PG8_BAR;
    } else {
        PG8_STAGE(PG8_SB(0, 0), cB, voffB); PG8_STAGE(PG8_SA(0, 0), cA, voffA); PG8_STAGE(PG8_SB(0, 1), cB + hstep, voffB); PG8_STAGE(PG8_SA(0, 1), cA + hstep, voffA);
        if (wr == 1) PG8_BAR;
        PG8_WAIT_V(4); PG8_BAR;
        PG8_STAGE(PG8_SB(1, 0), cB + kstep, voffB); PG8_STAGE(PG8_SA(1, 0), cA + kstep, voffA); PG8_STAGE(PG8_SB(1, 1), cB + hstep + kstep, voffB);
        PG8_WAIT_V(6); PG8_BAR;
    }
    for (;;) {
        const bool has_next = S.next(ui + 1, nxt);
        const char* nA = has_next ? (const char*)g.A + (size_t)S.arow0(nxt.pm) * rstep : cA; const char* nB = has_next ? (const char*)g.Bt + (size_t)nxt.pn * tstep : cB;
        for (int t = 0; t < nt; t += 2) {
            const bool last = (t == nt - 2);
            const char* a1 = cA + (size_t)(t + 1) * kstep;
            const char* a2 = last ? nA : cA + (size_t)(t + 2) * kstep; const char* b2 = last ? nB : cB + (size_t)(t + 2) * kstep;
            const char* a3 = a2 + kstep; const char* b3 = b2 + kstep;
            if (last && has_next) S.a_ready(nxt);
            if constexpr (SP2) {
            PG8_LDB(B0, 0, 0); PG8_LDB(B1, 0, 1); PG8_SCHED; PG8_LDA(At, 0, 0); PG8_STAGE(PG8_SA(1, 1), a1 + hstep, voffA);
            PG8_WAIT_V(8); PG8_WAIT_L(0); PG8_BAR; PG8_MMA(0, 0, At, B0); PG8_MMA(0, 1, At, B1); PG8_BAR; PG8_SCHED;
            PG8_LDA(At, 0, 1); PG8_STAGE(PG8_SB(0, 0), b2, voffB); PG8_STAGE(PG8_SB(0, 1), b2 + hstep, voffB); PG8_STAGE(PG8_SA(0, 0), a2, voffA);
            PG8_WAIT_V(8); PG8_WAIT_L(0); PG8_BAR; PG8_MMA(1, 0, At, B0); PG8_MMA(1, 1, At, B1); PG8_BAR; PG8_SCHED;
            PG8_LDB(B0, 1, 0); PG8_LDB(B1, 1, 1); PG8_SCHED; PG8_LDA(At, 1, 0); PG8_STAGE(PG8_SA(0, 1), a2 + hstep, voffA);
            PG8_WAIT_V(8); PG8_WAIT_L(0); PG8_BAR; PG8_MMA(0, 0, At, B0); PG8_MMA(0, 1, At, B1); PG8_BAR; PG8_SCHED;
            PG8_LDA(At, 1, 1); PG8_STAGE(PG8_SB(1, 0), b3, voffB); PG8_STAGE(PG8_SB(1, 1), b3 + hstep, voffB); PG8_STAGE(PG8_SA(1, 0), a3, voffA);
            PG8_WAIT_V(8); PG8_WAIT_L(0); PG8_BAR; PG8_MMA(1, 0, At, B0); PG8_MMA(1, 1, At, B1); PG8_BAR; PG8_SCHED;
            } else {
            PG8_LDB(B0, 0, 0); PG8_SCHED; PG8_LDA(At, 0, 0); PG8_STAGE(PG8_SA(1, 1), a1 + hstep, voffA);
            PG8_WAIT_L(8); PG8_BAR; PG8_WAIT_L(0); PG8_MMA(0, 0, At, B0); PG8_BAR; PG8_SCHED;
            PG8_LDB(B1, 0, 1); PG8_STAGE(PG8_SB(0, 0), b2, voffB);
            PG8_BAR; PG8_WAIT_L(0); PG8_MMA(0, 1, At, B1); PG8_BAR;
            PG8_LDA(At, 0, 1); PG8_STAGE(PG8_SA(0, 0), a2, voffA);
            PG8_BAR; PG8_WAIT_L(0); PG8_MMA(1, 0, At, B0); PG8_BAR; PG8_SCHED;
            PG8_STAGE(PG8_SB(0, 1), b2 + hstep, voffB);
            PG8_WAIT_V(6); PG8_BAR; PG8_MMA(1, 1, At, B1); PG8_BAR;
            PG8_LDB(B0, 1, 0); PG8_SCHED; PG8_LDA(At, 1, 0); PG8_STAGE(PG8_SA(0, 1), a2 + hstep, voffA);
            PG8_WAIT_L(8); PG8_BAR; PG8_WAIT_L(0); PG8_MMA(0, 0, At, B0); PG8_BAR; PG8_SCHED;
            PG8_LDB(B1, 1, 1); PG8_STAGE(PG8_SB(1, 0), b3, voffB);
            PG8_BAR; PG8_WAIT_L(0); PG8_MMA(0, 1, At, B1); PG8_BAR;
            PG8_LDA(At, 1, 1); PG8_STAGE(PG8_SA(1, 0), a3, voffA);
            PG8_BAR; PG8_WAIT_L(0); PG8_MMA(1, 0, At, B0); PG8_BAR; PG8_SCHED;
            PG8_STAGE(PG8_SB(1, 1), b3 + hstep, voffB);
            PG8_WAIT_V(6); PG8_BAR; PG8_MMA(1, 1, At, B1); PG8_BAR;
            }
        }
        if constexpr (ALIGN_EPI) { if (wr == 0) PG8_BAR; }
        if constexpr (!Epi::AFTER_DRAIN) { if constexpr (Epi::NEEDS_LDS) E(acc, cur, wr, wc, fr, fq, lds); else E(acc, cur, wr, wc, fr, fq); S.done(cur); }
        if (!has_next) break;
#pragma unroll
        for (int a = 0; a < 2; ++a)
#pragma unroll
            for (int b = 0; b < 2; ++b)
#pragma unroll
                for (int m = 0; m < 4; ++m)
#pragma unroll
                    for (int n = 0; n < 2; ++n) acc[a][b][m][n] = (f32x4){0.f, 0.f, 0.f, 0.f};
        cur = nxt; cA = nA; cB = nB; ++ui;
        if constexpr (ALIGN_EPI) { if (wr == 1) PG8_BAR; }
    }
    PG8_WAIT_V(0);
    if constexpr (!ALIGN_EPI) { if (wr == 0) PG8_BAR; }
    PG8_BAR;
    if constexpr (Epi::AFTER_DRAIN) { E.fused(acc, cur, wr, wc, fr, fq, lds, wid, lane); S.done(cur); }
#undef PG8_SA
#undef PG8_SB
#undef PG8_STAGE
#undef PG8_LDA
#undef PG8_LDB
#undef PG8_MMA
#undef PG8_WAIT_V
#undef PG8_WAIT_L
#undef PG8_BAR
#undef PG8_SCHED
}

__device__ __forceinline__ float row_rstd(const float* ssq, int row) {
    const f32x4* p = (const f32x4*)(ssq + (size_t)row * 16); const f32x4 a = p[0], b = p[1], c = p[2], d = p[3];
    const float s = ((a[0] + a[1]) + (a[2] + a[3])) + ((b[0] + b[1]) + (b[2] + b[3])) + ((c[0] + c[1]) + (c[2] + c[3])) + ((d[0] + d[1]) + (d[2] + d[3]));
    return __builtin_amdgcn_rsqf(s * (1.0f / 1024.0f) + 1e-6f);
}

struct EpiIn {
    static constexpr bool PERM = false, AFTER_DRAIN = false, NEEDS_LDS = false;
    unsigned char* ws0; float* out; int l;
    __device__ __forceinline__ void operator()(const f32x4 (&acc)[2][2][4][2], const Unit& u, int wr, int wc, int fr_in, int fq_in) const {
        unsigned char* ws = ws0; asm volatile("" : "+s"(ws));
        int fr = fr_in, fq = fq_in; asm volatile("" : "+v"(fr), "+v"(fq));
        const float* ssq = (const float*)(ws + WS_SSQ); const float* bias = (const float*)(ws + WS_BIASIN) + (size_t)l * 5 * DIN;
        const float* gains = (const float*)(ws + WS_LAM) + SM_GAINS + l * 320; const float* nag = gains; const float* swg = gains + 128; const float* dag = gains + 256;
        const float* ropeB = (const float*)(ws + WS_ROPEB); const float* ropeC = (const float*)(ws + WS_ROPEC); bf16_t* qkv = (bf16_t*)(ws + WS_QKV);
        const int pm = u.pm, pn = u.pn;
        const int grp = pm >= 32 ? 1 : 0, b = grp ? ((pm - 32) >> 3) : pm, tbase = grp ? 256 * ((pm - 32) & 7) : 0, T = grp ? TLAT : TCTX, b5 = grp ? 1 + b : 0;
        int type, h;
        if (pn < 3) { type = pn; h = wc; } else if (pn < 5) { type = 3; h = 4 * (pn - 3) + wc; } else if (pn == 5) { type = wc < 2 ? 4 : 5; h = wc & 1; } else { type = pn; h = wc; }
        const bool isv = (type == 2 || type == 5 || type == 8), isq = (type == 0 || type == 3 || type == 6), is32 = (type == 6 || type == 7);
        const bool rope = grp && (type == 3 || type == 4 || type == 6 || type == 7);
        const int H = (type == 3) ? 8 : ((type == 4 || type == 5) ? 2 : 4);
        size_t dbase; const size_t gs = (type == 3) ? GS8 : ((type == 4 || type == 5) ? GS2 : GS4);
        switch (type) { case 0: dbase = QO_QA; break; case 1: dbase = QO_KA; break; case 2: dbase = QO_VTA; break; case 3: dbase = QO_QB; break; case 4: dbase = QO_KB; break; case 5: dbase = QO_VTB; break;
                        case 6: dbase = QO_QC; break; case 7: dbase = QO_KC; break; default: dbase = QO_VTC; break; }
        bf16_t* dst = qkv + dbase + grp * gs + (size_t)(b * H + h) * T * 64;
        float* fo = nullptr; int fow = 0, foc = 0;
        if (!grp) { switch (type) { case 1: fo = out + OUT_NAK; fow = 256; foc = 64 * wc; break; case 2: fo = out + OUT_NAV; fow = 256; foc = 64 * wc; break; case 4: fo = out + OUT_SWK; fow = 128; foc = 64 * h; break;
                        case 5: fo = out + OUT_SWV; fow = 128; foc = 64 * h; break; case 7: fo = out + OUT_DAK; fow = 256; foc = 64 * wc; break; case 8: fo = out + OUT_DAV; fow = 256; foc = 64 * wc; break; default: break; } }
        const float* gsrc = ((type == 0) ? nag : (type == 1) ? nag + 64 : (type == 3) ? swg : (type == 4) ? swg + 64 : (type == 6) ? dag : dag + 32) + 4 * fq;
        const float* bsrc = bias + b5 * DIN + pn * 256 + 64 * wc + 4 * fq;
        const float qs = isq ? (is32 ? QSCALE32 : QSCALE64) : 1.0f;
#pragma unroll
        for (int ai = 0; ai < 2; ++ai)
#pragma unroll
            for (int m = 0; m < 4; ++m) {
                const int lr = 128 * ai + 64 * wr + 16 * m + fr, row = 256 * pm + lr, t = tbase + lr;
                const float rstd = row_rstd(ssq, row);
                float r0 = 1.f, r1 = 1.f;
                if (!isv) {
                    float s0 = 0.f, s1 = 0.f;
#pragma unroll
                    for (int n = 0; n < 2; ++n) { const f32x4 a = acc[ai][0][m][n] * rstd + *(const f32x4*)(bsrc + 16 * n), c = acc[ai][1][m][n] * rstd + *(const f32x4*)(bsrc + 32 + 16 * n);
                        s0 += (a[0] * a[0] + a[1] * a[1]) + (a[2] * a[2] + a[3] * a[3]); s1 += (c[0] * c[0] + c[1] * c[1]) + (c[2] * c[2] + c[3] * c[3]); }
                    s0 += __shfl_xor(s0, 16); s0 += __shfl_xor(s0, 32); s1 += __shfl_xor(s1, 16); s1 += __shfl_xor(s1, 32);
                    if (is32) { r0 = __builtin_amdgcn_rsqf(s0 * (1.f / 32.f) + 1e-6f); r1 = __builtin_amdgcn_rsqf(s1 * (1.f / 32.f) + 1e-6f); }
                    else { r0 = r1 = __builtin_amdgcn_rsqf((s0 + s1) * (1.f / 64.f) + 1e-6f); }
                }
                float* fr_ = fo ? fo + ((size_t)(b * DEPTH + l) * 256 + t) * fow + foc + 4 * fq : nullptr;
#pragma unroll
                for (int bj = 0; bj < 2; ++bj)
#pragma unroll
                    for (int n = 0; n < 2; ++n) {
                        f32x4 x = acc[ai][bj][m][n] * rstd + *(const f32x4*)(bsrc + 32 * bj + 16 * n);
                        if (!isv) {
                            x = x * (bj ? r1 : r0) * *(const f32x4*)(gsrc + (is32 ? 0 : 32 * bj) + 16 * n);
                            if (rope) {
                                const f32x4 cs = is32 ? *(const f32x4*)(ropeC + ((size_t)t * 16 + 8 * n + 2 * fq) * 2) : *(const f32x4*)(ropeB + ((size_t)t * 32 + 16 * bj + 8 * n + 2 * fq) * 2);
                                x = (f32x4){x[0] * cs[0] - x[1] * cs[1], x[0] * cs[1] + x[1] * cs[0], x[2] * cs[2] - x[3] * cs[3], x[2] * cs[3] + x[3] * cs[2]};
                            }
                        }
                        if (fr_) *(f32x4*)(fr_ + 32 * bj + 16 * n) = x;
                        if (!isv) { const f32x4 y = x * qs; u32x2 w; w.x = cvt_pk_bf16(y[0], y[1]); w.y = cvt_pk_bf16(y[2], y[3]); *(u32x2*)(dst + (size_t)t * 64 + 4 * fq + 32 * bj + 16 * n) = w; }
                        else { const int d0 = 32 * bj + 16 * n + 4 * fq;
#pragma unroll
                            for (int e = 0; e < 4; ++e) dst[(size_t)(d0 + e) * T + t] = (bf16_t)(cvt_pk_bf16(x[e], 0.f) & 0xffffu); }
                    }
                asm volatile("" ::: "memory");
            }
    }
};

struct EpiRes {
    static constexpr bool PERM = false, AFTER_DRAIN = false, NEEDS_LDS = false;
    unsigned char* ws0; float* x; int l; int which;
    __device__ __forceinline__ void operator()(const f32x4 (&acc)[2][2][4][2], const Unit& u, int wr, int wc, int fr, int fq) const {
        unsigned char* ws = ws0; asm volatile("" : "+s"(ws));
        const float* gate = (const float*)(ws + WS_MOD) + (size_t)l * 5 * 6144 + (which ? 5 : 2) * 1024;
        const float* gvn = which ? (l < 3 ? (const float*)(ws + WS_GV) + (size_t)(l + 1) * 10240 : nullptr) : (const float*)(ws + WS_GV) + (size_t)l * 10240 + 1024;
        bf16_t* xa = (bf16_t*)(ws + WS_XA); float* ssq = (float*)(ws + WS_SSQ);
        const int pm = u.pm, pn = u.pn, b5 = pm >= 32 ? 1 + ((pm - 32) >> 3) : 0;
        const int col0 = 256 * pn + 32 * wc + 4 * fq;
        f32x4 gt[2][2], gn[2][2];
#pragma unroll
        for (int bj = 0; bj < 2; ++bj)
#pragma unroll
            for (int n = 0; n < 2; ++n) { gt[bj][n] = *(const f32x4*)(gate + (size_t)b5 * 6144 + col0 + 128 * bj + 16 * n); gn[bj][n] = gvn ? *(const f32x4*)(gvn + (size_t)b5 * 2048 + col0 + 128 * bj + 16 * n) : (f32x4){0.f, 0.f, 0.f, 0.f}; }
#pragma unroll
        for (int ai = 0; ai < 2; ++ai)
#pragma unroll
            for (int m = 0; m < 4; ++m) {
                const int row = 256 * pm + 128 * ai + 64 * wr + 16 * m + fr; float* xr = x + (size_t)row * 1024 + col0; float ss = 0.f;
#pragma unroll
                for (int bj = 0; bj < 2; ++bj)
#pragma unroll
                    for (int n = 0; n < 2; ++n) {
                        const f32x4 xo = *(const f32x4*)(xr + 128 * bj + 16 * n); const f32x4 xn = xo + gt[bj][n] * acc[ai][bj][m][n];
                        *(f32x4*)(xr + 128 * bj + 16 * n) = xn;
                        if (gvn) { ss += (xn[0] * xn[0] + xn[1] * xn[1]) + (xn[2] * xn[2] + xn[3] * xn[3]); const f32x4 y = xn * gn[bj][n]; u32x2 w; w.x = cvt_pk_bf16(y[0], y[1]); w.y = cvt_pk_bf16(y[2], y[3]);
                            *(u32x2*)(xa + (size_t)row * 1024 + col0 + 128 * bj + 16 * n) = w; }
                    }
                if (gvn) { ss += __shfl_xor(ss, 16); ss += __shfl_xor(ss, 32); if (fq == 0) ssq[(size_t)row * 16 + 4 * pn + wc] = ss; }
            }
    }
};

#define DPPF(old, src, ctrl) __builtin_bit_cast(float, __builtin_amdgcn_update_dpp(__builtin_bit_cast(int, (float)(old)), __builtin_bit_cast(int, (float)(src)), (ctrl), 0xf, 0xf, false))
constexpr int LDS_EDGE = 131072 + 1024;
struct EpiUpConv {
    static constexpr bool PERM = false, AFTER_DRAIN = false, NEEDS_LDS = true;
    unsigned char* ws0; int l;
    __device__ __forceinline__ void operator()(f32x4 (&acc)[2][2][4][2], const Unit& u, int wr, int wc, int fr_in, int fq_in, PG8_LAS unsigned char* lds) const {
        unsigned char* ws = ws0; asm volatile("" : "+s"(ws));
        int fr = fr_in, fq = fq_in; asm volatile("" : "+v"(fr), "+v"(fq));
        const int pm = u.pm, pn = u.pn; const int grp = pm >= 32 ? 1 : 0, bq = grp ? (pm - 32) / 9 : 0, jq = grp ? (pm - 32) % 9 : 0;
        const int T = grp ? TLAT : TCTX, tofs = grp ? 254 * jq - 1 : 0, arow0 = grp ? MCTX + TLAT * bq + tofs : 256 * pm, b5 = grp ? 1 + bq : 0;
        const float* ssq = (const float*)(ws + WS_SSQ); const float* bias = (const float*)(ws + WS_BIASUP) + (size_t)(l * 5 + b5) * DUP; const float* cw = (const float*)(ws + WS_CONV) + (size_t)l * 4 * DUP;
        bf16_t* act = (bf16_t*)(ws + WS_ACT);
        const int fcol = 128 * pn + 32 * wc + 4 * fq;
#pragma unroll
        for (int ai = 0; ai < 2; ++ai)
#pragma unroll
            for (int m = 0; m < 4; ++m) {
                const int i = 128 * ai + 64 * wr + 16 * m + fr, t = tofs + i; const bool inseq = (t >= 0) && (t < T);
                const float rstd = row_rstd(ssq, min(arow0 + i, MTOT - 1));
#pragma unroll
                for (int bj = 0; bj < 2; ++bj)
#pragma unroll
                    for (int n = 0; n < 2; ++n) { const f32x4 v = acc[ai][bj][m][n] * rstd + *(const f32x4*)(bias + bj * DFF + fcol + 16 * n); acc[ai][bj][m][n] = inseq ? v : (f32x4){0.f, 0.f, 0.f, 0.f}; }
            }
        PG8_LAS float* E = (PG8_LAS float*)(lds + LDS_EDGE);
#pragma unroll
        for (int ai = 0; ai < 2; ++ai) { const int c = 2 * ai + wr;
#pragma unroll
            for (int bj = 0; bj < 2; ++bj)
#pragma unroll
                for (int n = 0; n < 2; ++n) { const int col = 128 * bj + 32 * wc + 16 * n + 4 * fq;
                    if (fr == 0) *(PG8_LAS f32x4*)(E + (c * 2 + 0) * 256 + col) = acc[ai][bj][0][n];
                    if (fr == 15) *(PG8_LAS f32x4*)(E + (c * 2 + 1) * 256 + col) = acc[ai][bj][3][n]; } }
        asm volatile("s_waitcnt lgkmcnt(0)" ::: "memory"); __builtin_amdgcn_s_barrier(); asm volatile("" ::: "memory");
#pragma unroll
        for (int ai = 0; ai < 2; ++ai) { const int c = 2 * ai + wr;
#pragma unroll
            for (int n = 0; n < 2; ++n) {
                f32x4 w0[2], w1[2], w2[2], cb[2], ep[2], en[2];
#pragma unroll
                for (int bj = 0; bj < 2; ++bj) { const float* p = cw + bj * DFF + fcol + 16 * n; w0[bj] = *(const f32x4*)p; w1[bj] = *(const f32x4*)(p + DUP); w2[bj] = *(const f32x4*)(p + 2 * DUP); cb[bj] = *(const f32x4*)(p + 3 * DUP);
                    const int col = 128 * bj + 32 * wc + 16 * n + 4 * fq;
                    ep[bj] = c > 0 ? *(const PG8_LAS f32x4*)(E + ((c - 1) * 2 + 1) * 256 + col) : (f32x4){0.f, 0.f, 0.f, 0.f};
                    en[bj] = c < 3 ? *(const PG8_LAS f32x4*)(E + ((c + 1) * 2 + 0) * 256 + col) : (f32x4){0.f, 0.f, 0.f, 0.f}; }
#pragma unroll
                for (int m = 0; m < 4; ++m) {
                    f32x4 y[2];
#pragma unroll
                    for (int bj = 0; bj < 2; ++bj) {
                        const f32x4 x = acc[ai][bj][m][n]; f32x4 pv, nx;
#pragma unroll
                        for (int e = 0; e < 4; ++e) {
                            const float po = m > 0 ? DPPF(acc[ai][bj][m > 0 ? m - 1 : 0][n][e], acc[ai][bj][m > 0 ? m - 1 : 0][n][e], 0x121) : ep[bj][e];
                            pv[e] = DPPF(po, x[e], 0x111);
                            const float no = m < 3 ? DPPF(acc[ai][bj][m < 3 ? m + 1 : 3][n][e], acc[ai][bj][m < 3 ? m + 1 : 3][n][e], 0x12F) : en[bj][e];
                            nx[e] = DPPF(no, x[e], 0x101);
                        }
                        y[bj] = cb[bj] + w0[bj] * pv + w1[bj] * x + w2[bj] * nx;
                    }
                    const int i = 128 * ai + 64 * wr + 16 * m + fr, t = tofs + i; const bool ok = grp ? ((i >= 1) && (i <= 254) && (t < T)) : true;
                    if (ok) { f32x4 a;
#pragma unroll
                        for (int e = 0; e < 4; ++e) a[e] = y[0][e] * __builtin_amdgcn_rcpf(1.0f + __expf(-y[0][e])) * y[1][e];
                        u32x2 w; w.x = cvt_pk_bf16(a[0], a[1]); w.y = cvt_pk_bf16(a[2], a[3]);
                        *(u32x2*)(act + (size_t)(arow0 + i) * DFF + fcol + 16 * n) = w; }
                }
            } }
    }
};
}
namespace att {
typedef LAS unsigned char lds_u8;
constexpr int LDS_TILE = 16384;
constexpr int LDS_RPB = 2 * LDS_TILE;
constexpr int LDS_NEXT = LDS_RPB + 2048;
constexpr int NUNITS = 1024;

struct Ctx { unsigned char* ws; int l; };

__device__ __forceinline__ bf16x8 lds128(const lds_u8* p) { return *(const LAS bf16x8*)p; }
__device__ __forceinline__ int sigma32(int i) { return (i & 19) | ((i & 4) << 1) | ((i & 8) >> 1); }

template <int NDS>
__device__ __forceinline__ f32x16 qk_block(const lds_u8* Kt, int kb, int c0, const bf16x8* qf, int lane) {
    const int key = 32 * kb + sigma32(lane & 31), h = lane >> 5; const lds_u8* base = Kt + key * 128; const int sw = key & 7;
    f32x16 s = {0.f, 0.f, 0.f, 0.f, 0.f, 0.f, 0.f, 0.f, 0.f, 0.f, 0.f, 0.f, 0.f, 0.f, 0.f, 0.f};
#pragma unroll
    for (int ds = 0; ds < NDS; ++ds) { const bf16x8 a = lds128(base + (((c0 + 2 * ds + h) ^ sw) << 4)); s = __builtin_amdgcn_mfma_f32_32x32x16_bf16(a, qf[ds], s, 0, 0, 0); }
    return s;
}
__device__ __forceinline__ void softmax_pv(f32x16& s0, f32x16& s1, float& m, float& l, f32x16& o0, f32x16& o1, const lds_u8* Vt, int lane) {
    float mx = fmaxf(s0[0], s1[0]);
#pragma unroll
    for (int r = 1; r < 16; ++r) mx = fmaxf(mx, fmaxf(s0[r], s1[r]));
    mx = fmaxf(mx, __shfl_xor(mx, 32));
    const float mn = fmaxf(m, mx);
    if (__any(mn > m)) { const float al = __builtin_amdgcn_exp2f(m - mn); l *= al;
#pragma unroll
        for (int r = 0; r < 16; ++r) { o0[r] *= al; o1[r] *= al; }
        m = mn; }
    float ps = 0.f;
#pragma unroll
    for (int r = 0; r < 16; ++r) { s0[r] = __builtin_amdgcn_exp2f(s0[r] - m); s1[r] = __builtin_amdgcn_exp2f(s1[r] - m); ps += s0[r] + s1[r]; }
    l += ps;
    const int h = lane >> 5, d = lane & 31;
#pragma unroll
    for (int kb = 0; kb < 2; ++kb)
#pragma unroll
        for (int sp = 0; sp < 2; ++sp) {
            const f32x16& s = kb ? s1 : s0;
            u32x4 pw; pw.x = cvt_pk_bf16(s[8 * sp + 0], s[8 * sp + 1]); pw.y = cvt_pk_bf16(s[8 * sp + 2], s[8 * sp + 3]); pw.z = cvt_pk_bf16(s[8 * sp + 4], s[8 * sp + 5]); pw.w = cvt_pk_bf16(s[8 * sp + 6], s[8 * sp + 7]);
            const bf16x8 pf = __builtin_bit_cast(bf16x8, pw);
            const int chunk = 4 * kb + 2 * sp + h;
            const bf16x8 a0 = lds128(Vt + d * 128 + ((chunk ^ (d & 7)) << 4));
            const bf16x8 a1 = lds128(Vt + (d + 32) * 128 + ((chunk ^ (d & 7)) << 4));
            o0 = __builtin_amdgcn_mfma_f32_32x32x16_bf16(a0, pf, o0, 0, 0, 0);
            o1 = __builtin_amdgcn_mfma_f32_32x32x16_bf16(a1, pf, o1, 0, 0, 0);
        }
}
__device__ __forceinline__ int key_of(int kb, int r, int h) { return 32 * kb + 16 * (r >> 3) + 8 * h + 4 * ((r >> 2) & 1) + (r & 3); }

__device__ __forceinline__ void attn_phase(lds_u8* lds, const Ctx& C) {
    const int l = C.l;
    const float lam_init = l == 0 ? 0.2f : (l == 1 ? 0.35550906759f : (l == 2 ? 0.47071301835f : 0.55605820416f));
    for (;;) {
        __syncthreads();
        unsigned char* ws = C.ws; asm volatile("" : "+s"(ws));
        const int tid = opaque_tid();
        const int lane = tid & 63, w = __builtin_amdgcn_readfirstlane(tid >> 6), h5 = lane >> 5, ql = lane & 31;
        if (tid == 0) *(LAS unsigned*)(lds + LDS_NEXT) = atomicAdd((unsigned*)(ws + WS_CTL) + 64 * (1 + l), 1u);
        __syncthreads();
        const int idx = (int)*(LAS unsigned*)(lds + LDS_NEXT);
        if (idx >= NUNITS) break;
        const bf16_t* qkv = (const bf16_t*)(ws + WS_QKV); const bf16_t* kcb = (const bf16_t*)(ws + WS_KC); const float* sm = (const float*)(ws + WS_LAM);
        int fam, grp, b, h, qb;
        if (idx < 128) { fam = 2; grp = 1; b = idx >> 5; h = (idx >> 3) & 3; qb = idx & 7; }
        else if (idx < 256) { const int i = idx - 128; fam = 0; grp = 1; b = i >> 5; h = (i >> 3) & 3; qb = i & 7; }
        else if (idx < 512) { const int i = idx - 256; fam = 1; grp = 1; b = i >> 6; h = (i >> 3) & 7; qb = i & 7; }
        else if (idx < 640) { const int i = idx - 512; fam = 2; grp = 0; b = i >> 2; h = i & 3; qb = 0; }
        else if (idx < 768) { const int i = idx - 640; fam = 0; grp = 0; b = i >> 2; h = i & 3; qb = 0; }
        else { const int i = idx - 768; fam = 1; grp = 0; b = i >> 3; h = i & 7; qb = 0; }
        const int T = grp ? TLAT : TCTX, Hq = fam == 1 ? 8 : 4, Hkv = fam == 1 ? 2 : 4, hk = fam == 1 ? (h >> 2) : h;
        const size_t qo = fam == 0 ? QO_QA : (fam == 1 ? QO_QB : QO_QC), ko = fam == 0 ? QO_KA : (fam == 1 ? QO_KB : QO_KC), vo = fam == 0 ? QO_VTA : (fam == 1 ? QO_VTB : QO_VTC);
        const size_t gq = fam == 1 ? GS8 : GS4, gk = fam == 1 ? GS2 : GS4;
        const int q0 = qb * 256;
        const bf16_t* Qp = qkv + qo + grp * gq + ((size_t)(b * Hq + h) * T + q0 + 32 * w + ql) * 64;
        const unsigned kso = (unsigned)(ko + grp * gk + (size_t)(b * Hkv + hk) * T * 64), vso = (unsigned)(vo + grp * gk + (size_t)(b * Hkv + hk) * 64 * T);
        const size_t cko = fam == 0 ? CO_KA : (fam == 1 ? CO_KB : CO_KCC), cvo = fam == 0 ? CO_VTA : (fam == 1 ? CO_VTB : CO_VTCC);
        const unsigned kco = (unsigned)(cko + (size_t)((l * 4 + b) * Hkv + hk) * PAST * 64), vco = (unsigned)(cvo + (size_t)((l * 4 + b) * Hkv + hk) * 64 * PAST);
        int ta, tb;
        if (!grp) { ta = 0; tb = 4; }
        else if (fam == 0) { ta = max(4 * qb - 4, 0); tb = min(max(4 * qb - 1, 0), 24) + 8; }
        else if (fam == 1) { ta = max(q0 - 128, 0) >> 6; tb = min(q0 + 384, TLAT) >> 6; }
        else { ta = 0; tb = 32; }
        const int nself = tb - ta, ntile = nself + (grp ? 8 : 0);
        const int mode = !grp ? 0 : (fam == 0 ? 1 : (fam == 1 ? 2 : 0));
        if (mode == 1 && tid < 465) *(LAS float*)(lds + LDS_RPB + 4 * tid) = sm[SM_RPB + (l * 4 + h) * 465 + tid];
        bf16x8 qf[4];
#pragma unroll
        for (int ds = 0; ds < 4; ++ds) qf[ds] = *(const bf16x8*)(Qp + 16 * ds + 8 * h5);
        const int qw0 = q0 + 32 * w;
        const int qtok = qw0 + ql, qrow = qtok >> 6, qcol = qtok & 63;
        const int r0w = min(max((qw0 >> 6) - 4, 0), 24), qsl = min(max(qcol - 8, 0), 48);
        float m0 = -1e30f, l0 = 0.f, m1 = -1e30f, l1 = 0.f;
        f32x16 oa0 = {0.f, 0.f, 0.f, 0.f, 0.f, 0.f, 0.f, 0.f, 0.f, 0.f, 0.f, 0.f, 0.f, 0.f, 0.f, 0.f}, oa1 = oa0, ob0 = oa0, ob1 = oa0;
        const int lrow = tid >> 3, lch = tid & 7; const int lds_off = lrow * 128 + ((lch ^ (lrow & 7)) << 4);
        u32x4 kreg, vreg;
        auto gload = [&](int ti) {
            const bool self = ti < nself; const int tok0 = self ? 64 * (ta + ti) : 64 * (ti - nself); const int Tkv = self ? T : PAST;
            const bf16_t* kp = (self ? qkv : kcb) + (self ? kso : kco); const bf16_t* vp = (self ? qkv : kcb) + (self ? vso : vco);
            kreg = *(const u32x4*)(kp + (size_t)(tok0 + lrow) * 64 + lch * 8);
            vreg = *(const u32x4*)(vp + (size_t)lrow * Tkv + tok0 + lch * 8);
        };
        gload(0);
        *(LAS u32x4*)(lds + lds_off) = kreg; *(LAS u32x4*)(lds + 8192 + lds_off) = vreg;
        __syncthreads();
        for (int ti = 0; ti < ntile; ++ti) {
            const lds_u8* Kt = lds + (ti & 1) * LDS_TILE; const lds_u8* Vt = Kt + 8192;
            if (ti + 1 < ntile) gload(ti + 1);
            const bool self = ti < nself; const int tok0 = 64 * (ta + ti);
            bool rel = true, msk = false;
            if (self && mode == 1) { const int kr = ta + ti; rel = (kr >= r0w) && (kr <= r0w + 7); msk = true; }
            if (self && mode == 2) { rel = (tok0 + 63 >= qw0 - 128) && (tok0 <= qw0 + 31 + 128); msk = !((tok0 >= qw0 + 31 - 128) && (tok0 + 63 <= qw0 + 128)); }
            if (rel) {
                if (fam != 2) {
                    f32x16 s0 = qk_block<4>(Kt, 0, 0, qf, lane), s1 = qk_block<4>(Kt, 1, 0, qf, lane);
                    if (msk) {
                        if (mode == 1) {
                            const int kr = ta + ti; const LAS float* bt = (const LAS float*)(lds + LDS_RPB) + (kr - qrow + 7) * 31 + 15 - qcol;
#pragma unroll
                            for (int r = 0; r < 16; ++r) {
                                const int kc0 = key_of(0, r, h5), kc1 = kc0 + 32;
                                const bool v0 = (kc0 >= qsl) && (kc0 < qsl + 16), v1 = (kc1 >= qsl) && (kc1 < qsl + 16);
                                const float b0 = bt[v0 ? kc0 : qcol], b1 = bt[v1 ? kc1 : qcol];
                                s0[r] = v0 ? s0[r] + b0 : -INFINITY; s1[r] = v1 ? s1[r] + b1 : -INFINITY;
                            }
                        } else {
#pragma unroll
                            for (int r = 0; r < 16; ++r) {
                                const int k0 = tok0 + key_of(0, r, h5), k1 = k0 + 32;
                                if (abs(k0 - qtok) > 128) s0[r] = -INFINITY;
                                if (abs(k1 - qtok) > 128) s1[r] = -INFINITY;
                            }
                        }
                    }
                    softmax_pv(s0, s1, m0, l0, oa0, oa1, Vt, lane);
                } else {
                    { f32x16 s0 = qk_block<2>(Kt, 0, 0, qf, lane), s1 = qk_block<2>(Kt, 1, 0, qf, lane); softmax_pv(s0, s1, m0, l0, oa0, oa1, Vt, lane); }
                    { f32x16 s0 = qk_block<2>(Kt, 0, 4, qf + 2, lane), s1 = qk_block<2>(Kt, 1, 4, qf + 2, lane); softmax_pv(s0, s1, m1, l1, ob0, ob1, Vt, lane); }
                }
            }
            if (ti + 1 < ntile) { lds_u8* nb = lds + ((ti + 1) & 1) * LDS_TILE; *(LAS u32x4*)(nb + lds_off) = kreg; *(LAS u32x4*)(nb + 8192 + lds_off) = vreg; }
            __syncthreads();
        }
        const int grow = (grp ? MCTX + b * TLAT : b * TCTX) + qtok;
        const int ocol = (fam == 0 ? 0 : (fam == 1 ? 256 : 768)) + 64 * h;
        bf16_t* orow = (bf16_t*)(ws + WS_O) + (size_t)grow * 1024 + ocol + 4 * h5;
        float lt0 = l0 + __shfl_xor(l0, 32);
        if (fam == 1) lt0 += __builtin_amdgcn_exp2f(sm[SM_SINK + l * 8 + h] - m0);
        const float i0 = 1.0f / lt0;
        if (fam != 2) {
#pragma unroll
            for (int g = 0; g < 4; ++g) {
                u32x2 wa, wb; wa.x = cvt_pk_bf16(oa0[4 * g] * i0, oa0[4 * g + 1] * i0); wa.y = cvt_pk_bf16(oa0[4 * g + 2] * i0, oa0[4 * g + 3] * i0);
                wb.x = cvt_pk_bf16(oa1[4 * g] * i0, oa1[4 * g + 1] * i0); wb.y = cvt_pk_bf16(oa1[4 * g + 2] * i0, oa1[4 * g + 3] * i0);
                *(u32x2*)(orow + 8 * g) = wa; *(u32x2*)(orow + 32 + 8 * g) = wb;
            }
        } else {
            const float lt1 = l1 + __shfl_xor(l1, 32); const float i1 = 1.0f / lt1; const float lam = sm[SM_LAM + l];
            float ss = 0.f;
#pragma unroll
            for (int r = 0; r < 16; ++r) { oa0[r] = oa0[r] * i0 - lam * (ob0[r] * i1); oa1[r] = oa1[r] * i0 - lam * (ob1[r] * i1); ss += oa0[r] * oa0[r] + oa1[r] * oa1[r]; }
            ss += __shfl_xor(ss, 32);
            const float rn = __builtin_amdgcn_rsqf(ss * (1.f / 64.f) + 1e-6f) * (1.0f - lam_init);
            const float* sg = sm + SM_SUBG + l * 64 + 4 * h5;
#pragma unroll
            for (int g = 0; g < 4; ++g) {
                const f32x4 ga = *(const f32x4*)(sg + 8 * g), gb = *(const f32x4*)(sg + 32 + 8 * g);
                u32x2 wa, wb; wa.x = cvt_pk_bf16(oa0[4 * g] * rn * ga[0], oa0[4 * g + 1] * rn * ga[1]); wa.y = cvt_pk_bf16(oa0[4 * g + 2] * rn * ga[2], oa0[4 * g + 3] * rn * ga[3]);
                wb.x = cvt_pk_bf16(oa1[4 * g] * rn * gb[0], oa1[4 * g + 1] * rn * gb[1]); wb.y = cvt_pk_bf16(oa1[4 * g + 2] * rn * gb[2], oa1[4 * g + 3] * rn * gb[3]);
                *(u32x2*)(orow + 8 * g) = wa; *(u32x2*)(orow + 32 + 8 * g) = wb;
            }
        }
    }
}
}
namespace misc {
typedef LAS unsigned char lds_u8;
__device__ __forceinline__ float wave_sum(float v) {
#pragma unroll
    for (int o = 1; o < 64; o <<= 1) v += __shfl_xor(v, o);
    return v;
}
__device__ const double INVB[16] = {1.0, 0.5623413251903491, 0.31622776601683794, 0.1778279410038923, 0.1, 0.05623413251903491, 0.03162277660168379, 0.01778279410038923,
                                    0.01, 0.005623413251903491, 0.0031622776601683794, 0.001778279410038923, 0.001, 0.0005623413251903491, 0.00031622776601683794, 0.0001778279410038923};
__device__ const double INVC[8] = {1.0, 0.31622776601683794, 0.1, 0.03162277660168379, 0.01, 0.0031622776601683794, 0.001, 0.00031622776601683794};
__device__ __forceinline__ void sincos_d(double a, float& c, float& s) {
    const double k = rint(a * 0.6366197723675814);
    double r = fma(-k, 1.5707963267948966, a); r = fma(-k, 6.123233995736766e-17, r);
    const double r2 = r * r;
    const double sp = r * (1.0 + r2 * (-1.0 / 6.0 + r2 * (1.0 / 120.0 + r2 * (-1.0 / 5040.0 + r2 * (1.0 / 362880.0 + r2 * (-1.0 / 39916800.0 + r2 * (1.0 / 6227020800.0)))))));
    const double cp = 1.0 + r2 * (-0.5 + r2 * (1.0 / 24.0 + r2 * (-1.0 / 720.0 + r2 * (1.0 / 40320.0 + r2 * (-1.0 / 3628800.0 + r2 * (1.0 / 479001600.0 + r2 * (-1.0 / 87178291200.0)))))));
    const int q = ((int)k) & 3;
    const double cc = (q == 0) ? cp : (q == 1) ? -sp : (q == 2) ? -cp : sp;
    const double ss = (q == 0) ? sp : (q == 1) ? cp : (q == 2) ? -sp : -cp;
    c = (float)cc; s = (float)ss;
}
__device__ __forceinline__ void transpose_item(const float* W, int K, int N, bf16_t* WT, int k0, int n0, int dst0, LAS float* scr, int lane) {
#pragma unroll 8
    for (int i = 0; i < 32; ++i) { const int kk = 2 * i + (lane >> 5); scr[kk * 33 + (lane & 31)] = W[(size_t)(k0 + kk) * N + n0 + (lane & 31)]; }
    asm volatile("s_waitcnt lgkmcnt(0)" ::: "memory");
    const int c = lane & 7;
#pragma unroll
    for (int j = 0; j < 4; ++j) { const int n = (lane >> 3) + 8 * j; const LAS float* s = scr + (8 * c) * 33 + n;
        u32x4 o; o.x = cvt_pk_bf16(s[0 * 33], s[1 * 33]); o.y = cvt_pk_bf16(s[2 * 33], s[3 * 33]); o.z = cvt_pk_bf16(s[4 * 33], s[5 * 33]); o.w = cvt_pk_bf16(s[6 * 33], s[7 * 33]);
        *(u32x4*)(WT + (size_t)(dst0 + n) * K + k0 + 8 * c) = o; }
    asm volatile("s_waitcnt lgkmcnt(0)" ::: "memory");
}
__device__ __forceinline__ void gemv5_item(const float* W, int N, int n0, const LAS float* vec, LAS float* red, const float* add, float* out, int ostride, int tid) {
    const int col = tid & 31, kq = tid >> 5; float a0 = 0.f, a1 = 0.f, a2 = 0.f, a3 = 0.f, a4 = 0.f;
    const float* wp = W + (size_t)(kq * 64) * N + n0 + col; const LAS float* vp = vec + kq * 64;
#pragma unroll 8
    for (int k = 0; k < 64; ++k) { const float w = wp[(size_t)k * N]; a0 += vp[k] * w; a1 += vp[1024 + k] * w; a2 += vp[2048 + k] * w; a3 += vp[3072 + k] * w; a4 += vp[4096 + k] * w; }
    red[(kq * 5 + 0) * 32 + col] = a0; red[(kq * 5 + 1) * 32 + col] = a1; red[(kq * 5 + 2) * 32 + col] = a2; red[(kq * 5 + 3) * 32 + col] = a3; red[(kq * 5 + 4) * 32 + col] = a4;
    __syncthreads();
    if (tid < 160) { const int b = tid >> 5, c = tid & 31; float s = add ? add[n0 + c] : 0.f;
#pragma unroll
        for (int q = 0; q < 16; ++q) s += red[(q * 5 + b) * 32 + c];
        out[(size_t)b * ostride + n0 + c] = s; }
    __syncthreads();
}

__device__ __forceinline__ void phase_pro1(lds_u8* lds, const Args& a) {
    const int tid = opaque_tid(), lane = tid & 63, wave = __builtin_amdgcn_readfirstlane(tid >> 6), G = gridDim.x;
    unsigned char* ws = a.ws;
    { LAS float* vec = (LAS float*)lds; LAS float* red = (LAS float*)(lds + 20480);
      for (int i = tid; i < 5120; i += 512) { const int b5 = i >> 10, k = i & 1023; const float v = b5 == 0 ? a.in[I_CCTX][k] : a.in[I_C][(b5 - 1) * 1024 + k]; vec[i] = v / (1.f + __expf(-v)); }
      __syncthreads();
      float* mod = (float*)(ws + WS_MOD);
      for (int it = blockIdx.x; it < 4 * 192; it += G) { const int l = it / 192, n0 = (it % 192) * 32;
          gemv5_item(a.in[I_WMOD] + (size_t)l * 1024 * 6144, 6144, n0, vec, red, a.in[I_BMOD] + l * 6144, mod + (size_t)l * 5 * 6144, 6144, tid); }
      __syncthreads(); }
    { LAS float* scr = (LAS float*)(lds + wave * 16384);
      const int gw = blockIdx.x * 8 + wave, NGW = G * 8;
      constexpr int I_IN = 16 * 72, I_OUT = 16 * 32, I_UP = 16 * 176, I_DN = 44 * 32, I_L = I_IN + I_OUT + I_UP + I_DN;
      for (int it = gw; it < 4 * I_L; it += NGW) {
          const int l = it / I_L; int r = it % I_L;
          if (r < I_IN) { const int kb = r / 72, nb = r % 72, n0 = 32 * nb; const int tile = n0 >> 8, L = n0 & 255, wc = L >> 6, bj = (L >> 5) & 1; const int dst0 = 256 * tile + 128 * bj + 32 * wc;
              transpose_item(a.in[I_WIN] + (size_t)l * 1024 * DIN, 1024, DIN, (bf16_t*)(ws + WS_WIN) + (size_t)l * DIN * 1024, 64 * kb, n0, dst0, scr, lane); continue; }
          r -= I_IN;
          if (r < I_OUT) { const int kb = r / 32, nb = r % 32; transpose_item(a.in[I_WOUT] + (size_t)l * 1024 * 1024, 1024, 1024, (bf16_t*)(ws + WS_WOUT) + (size_t)l * 1024 * 1024, 64 * kb, 32 * nb, 32 * nb, scr, lane); continue; }
          r -= I_OUT;
          if (r < I_UP) { const int kb = r / 176, nb = r % 176, n0 = 32 * nb; const int nn = n0 < DFF ? n0 : n0 - DFF; const int dst0 = 256 * (nn >> 7) + (n0 < DFF ? 0 : 128) + (nn & 127);
              transpose_item(a.in[I_WUP] + (size_t)l * 1024 * DUP, 1024, DUP, (bf16_t*)(ws + WS_WUP) + (size_t)l * DUP * 1024, 64 * kb, n0, dst0, scr, lane); continue; }
          r -= I_UP;
          { const int kb = r / 32, nb = r % 32; transpose_item(a.in[I_WDOWN] + (size_t)l * DFF * 1024, DFF, 1024, (bf16_t*)(ws + WS_WDOWN) + (size_t)l * 1024 * DFF, 64 * kb, 32 * nb, 32 * nb, scr, lane); }
      } }
    const int gtid = blockIdx.x * 512 + tid, NT = G * 512;
    { bf16_t* kc = (bf16_t*)(ws + WS_KC);
      for (int fam = 0; fam < 3; ++fam) {
          const int H = fam == 1 ? 2 : 4; const float* ck = a.in[fam == 0 ? I_CNAK : (fam == 1 ? I_CSWK : I_CDAK)]; const float* cv = a.in[fam == 0 ? I_CNAV : (fam == 1 ? I_CSWV : I_CDAV)];
          bf16_t* dk = kc + (fam == 0 ? CO_KA : (fam == 1 ? CO_KB : CO_KCC)); bf16_t* dv = kc + (fam == 0 ? CO_VTA : (fam == 1 ? CO_VTB : CO_VTCC));
          const int totk = 4 * 4 * 512 * H * 8;
          for (int i = gtid; i < totk; i += NT) { const int d8 = i & 7, hh = (i >> 3) % H, p = (i / (8 * H)) & 511, l = (i / (8 * H * 512)) & 3, b = i / (8 * H * 512 * 4);
              const float* s = ck + ((((size_t)b * 4 + l) * 512 + p) * H + hh) * 64 + d8 * 8; const f32x4 x = *(const f32x4*)s, y = *(const f32x4*)(s + 4);
              u32x4 o; o.x = cvt_pk_bf16(x[0], x[1]); o.y = cvt_pk_bf16(x[2], x[3]); o.z = cvt_pk_bf16(y[0], y[1]); o.w = cvt_pk_bf16(y[2], y[3]);
              *(u32x4*)(dk + ((((size_t)l * 4 + b) * H + hh) * 512 + p) * 64 + d8 * 8) = o; }
          const int totv = 4 * 4 * H * 64 * 64;
          for (int i = gtid; i < totv; i += NT) { const int d = i & 63, p8 = (i >> 6) & 63, hh = (i >> 12) % H, l = (i / (4096 * H)) & 3, b = i / (4096 * H * 4);
              const float* s = cv + ((((size_t)b * 4 + l) * 512 + p8 * 8) * H + hh) * 64 + d; float x[8];
#pragma unroll
              for (int j = 0; j < 8; ++j) x[j] = s[(size_t)j * H * 64];
              u32x4 o; o.x = cvt_pk_bf16(x[0], x[1]); o.y = cvt_pk_bf16(x[2], x[3]); o.z = cvt_pk_bf16(x[4], x[5]); o.w = cvt_pk_bf16(x[6], x[7]);
              *(u32x4*)(dv + ((((size_t)l * 4 + b) * H + hh) * 64 + d) * 512 + p8 * 8) = o; }
      } }
    { float* rb = (float*)(ws + WS_ROPEB); float* rc = (float*)(ws + WS_ROPEC);
      for (int i = gtid; i < 2048 * 32; i += NT) { const int t = i >> 5, j = i & 31; const double pos = (double)(j < 16 ? (t >> 6) : (t & 63)); float c, s; sincos_d(pos * INVB[j & 15], c, s); rb[2 * i] = c; rb[2 * i + 1] = s; }
      for (int i = gtid; i < 2048 * 16; i += NT) { const int t = i >> 4, j = i & 15; const double pos = (double)(j < 8 ? (t >> 6) : (t & 63)); float c, s; sincos_d(pos * INVC[j & 7], c, s); rc[2 * i] = c; rc[2 * i + 1] = s; } }
    { float* sm = (float*)(ws + WS_LAM);
      if (gtid < 4) { const int l = gtid; const float* lp = a.in[I_LAMBDA] + l * 128; float s1 = 0.f, s2 = 0.f;
          for (int i = 0; i < 32; ++i) { s1 += lp[i] * lp[32 + i]; s2 += lp[64 + i] * lp[96 + i]; }
          sm[SM_LAM + l] = expf(s1) - expf(s2) + (0.8f - 0.6f * expf(-0.3f * (float)l)); }
      for (int i = gtid; i < 1280; i += NT) { const int l = i / 320, r = i % 320; sm[SM_GAINS + i] = r < 128 ? a.in[I_NAG][l * 128 + r] : (r < 256 ? a.in[I_SWG][l * 128 + r - 128] : a.in[I_DAG][l * 64 + r - 256]); }
      for (int i = gtid; i < 7440; i += NT) sm[SM_RPB + i] = a.in[I_RPB][i] * LOG2E;
      for (int i = gtid; i < 32; i += NT) sm[SM_SINK + i] = a.in[I_SINK][i] * LOG2E;
      for (int i = gtid; i < 256; i += NT) sm[SM_SUBG + i] = a.in[I_SUBG][i];
      float* cv = (float*)(ws + WS_CONV);
      for (int i = gtid; i < 4 * 4 * DUP; i += NT) { const int c = i % DUP, j = (i / DUP) & 3, l = i / (4 * DUP); cv[i] = j < 3 ? a.in[I_CONVW][(size_t)(l * 3 + j) * DUP + c] : a.in[I_CONVB][(size_t)l * DUP + c]; } }
}
__device__ __forceinline__ void phase_pro2(lds_u8* lds, const Args& a) {
    const int tid = opaque_tid(), G = gridDim.x; unsigned char* ws = a.ws;
    const float* mod = (const float*)(ws + WS_MOD);
    const int gtid = blockIdx.x * 512 + tid, NT = G * 512;
    { float* gv = (float*)(ws + WS_GV);
      for (int i = gtid; i < 4 * 5 * 2 * 1024; i += NT) { const int c = i & 1023, which = (i >> 10) & 1, b5 = (i >> 11) % 5, l = i / 10240;
          const float g = a.in[which ? I_GFFN : I_GATTN][l * 1024 + c]; const float sc = mod[((size_t)(l * 5 + b5) * 6 + (which ? 4 : 1)) * 1024 + c]; gv[i] = g * (1.f + sc); } }
    LAS float* vec = (LAS float*)lds; LAS float* red = (LAS float*)(lds + 20480);
    for (int it = blockIdx.x; it < 4 * (72 + 176); it += G) {
        const int l = it / 248, r = it % 248; const int which = r < 72 ? 0 : 1; const int n0 = 32 * (which ? r - 72 : r);
        __syncthreads();
        for (int i = tid; i < 5120; i += 512) { const int b5 = i >> 10, k = i & 1023; vec[i] = mod[((size_t)(l * 5 + b5) * 6 + (which ? 3 : 0)) * 1024 + k]; }
        __syncthreads();
        if (!which) gemv5_item(a.in[I_WIN] + (size_t)l * 1024 * DIN, DIN, n0, vec, red, nullptr, (float*)(ws + WS_BIASIN) + (size_t)l * 5 * DIN, DIN, tid);
        else gemv5_item(a.in[I_WUP] + (size_t)l * 1024 * DUP, DUP, n0, vec, red, nullptr, (float*)(ws + WS_BIASUP) + (size_t)l * 5 * DUP, DUP, tid);
    }
}
__device__ __forceinline__ void phase_make_xa(const Args& a, int l, int which, int first) {
    const int tid = opaque_tid(), lane = tid & 63, wave = tid >> 6; unsigned char* ws = a.ws;
    const float* gv = (const float*)(ws + WS_GV); bf16_t* xa = (bf16_t*)(ws + WS_XA); float* ssq = (float*)(ws + WS_SSQ);
    for (int row = blockIdx.x * 8 + wave; row < MTOT; row += gridDim.x * 8) {
        const float* src = first ? (row < MCTX ? a.in[I_XP] + (size_t)row * 1024 : a.in[I_XS] + (size_t)(row - MCTX) * 1024) : a.out + (size_t)row * 1024;
        const float* g = gv + ((size_t)(l * 5 + row_b5(row)) * 2 + which) * 1024;
        f32x4 v[4]; float s = 0.f;
#pragma unroll
        for (int j = 0; j < 4; ++j) { v[j] = *(const f32x4*)(src + 256 * j + 4 * lane); s += (v[j][0] * v[j][0] + v[j][1] * v[j][1]) + (v[j][2] * v[j][2] + v[j][3] * v[j][3]); }
        s = wave_sum(s);
#pragma unroll
        for (int j = 0; j < 4; ++j) { if (first) *(f32x4*)(a.out + (size_t)row * 1024 + 256 * j + 4 * lane) = v[j];
            const f32x4 y = v[j] * *(const f32x4*)(g + 256 * j + 4 * lane); u32x2 w; w.x = cvt_pk_bf16(y[0], y[1]); w.y = cvt_pk_bf16(y[2], y[3]); *(u32x2*)(xa + (size_t)row * 1024 + 256 * j + 4 * lane) = w; }
        if (lane < 16) ssq[(size_t)row * 16 + lane] = lane == 0 ? s : 0.f;
    }
}
}
constexpr int LDS_BYTES = 147456;
enum Phase { PH_PRO1 = 0, PH_PRO2, PH_MAKEXA, PH_IN, PH_ATT, PH_OUT, PH_UP, PH_CONV, PH_DOWN };

__device__ __forceinline__ void run_phase(LAS unsigned char* lds, const Args& a, int ph, int l, int p1, int p2) {
    unsigned char* ws = a.ws; const int G = gridDim.x;
    switch (ph) {
    case PH_PRO1: misc::phase_pro1(lds, a); break;
    case PH_PRO2: misc::phase_pro2(lds, a); break;
    case PH_MAKEXA: misc::phase_make_xa(a, l, p1, p2); break;
    case PH_IN: {
        pg8::Gemm g{(const bf16_t*)(ws + WS_XA), (const bf16_t*)(ws + WS_WIN) + (size_t)l * DIN * 1024, MTOT, DIN, 1024}; pg8::StaticOrder S; S.init(MTOT, DIN, G, (int)blockIdx.x);
        pg8::EpiIn E{ws, a.out, l};
        pg8::gemm_phase<pg8::EpiIn, pg8::StaticOrder, true, true>(lds, g, S, E); } break;
    case PH_ATT: {
        att::Ctx C{ws, l};
        att::attn_phase(lds, C); } break;
    case PH_OUT: {
        pg8::Gemm g{(const bf16_t*)(ws + WS_O), (const bf16_t*)(ws + WS_WOUT) + (size_t)l * 1024 * 1024, MTOT, 1024, 1024}; pg8::StaticOrder S; S.init(MTOT, 1024, G, (int)blockIdx.x);
        pg8::EpiRes E{ws, a.out, l, 0};
        pg8::gemm_phase<pg8::EpiRes, pg8::StaticOrder, false, true>(lds, g, S, E); } break;
    case PH_UP: {
        pg8::Gemm g{(const bf16_t*)(ws + WS_XA), (const bf16_t*)(ws + WS_WUP) + (size_t)l * DUP * 1024, MTOT, DUP, 1024}; pg8::UpOrder S; S.init_up(G, (int)blockIdx.x);
        pg8::EpiUpConv E{ws, l};
        pg8::gemm_phase<pg8::EpiUpConv, pg8::UpOrder, true, true>(lds, g, S, E); } break;
    case PH_DOWN: {
        pg8::Gemm g{(const bf16_t*)(ws + WS_ACT), (const bf16_t*)(ws + WS_WDOWN) + (size_t)l * 1024 * DFF, MTOT, 1024, DFF}; pg8::StaticOrder S; S.init(MTOT, 1024, G, (int)blockIdx.x);
        pg8::EpiRes E{ws, a.out, l, 1};
        pg8::gemm_phase<pg8::EpiRes, pg8::StaticOrder, false, true>(lds, g, S, E); } break;
    default: break;
    }
}

#define XB_TMO      128
#define XB_XCNT(j)  (256  + 64 * (j))
#define XB_XSUB(j)  (1280 + 64 * (j))
#define XB_XGEN(j)  (2304 + 64 * (j))
#define XB_TOP      3328
#define XB_TOPGEN   3392
#define XCD_BAR_WORDS 3456
#define XB_SPIN_CAP (1u << 18)
__device__ __forceinline__ unsigned xb_ld(unsigned* p)              { return __hip_atomic_load(p, __ATOMIC_RELAXED, __HIP_MEMORY_SCOPE_AGENT); }
__device__ __forceinline__ unsigned xb_add(unsigned* p, unsigned v) { return __hip_atomic_fetch_add(p, v, __ATOMIC_RELAXED, __HIP_MEMORY_SCOPE_AGENT); }
__device__ __forceinline__ unsigned xb_xcc_id() { return (unsigned)__builtin_amdgcn_s_getreg((3 << 11) | 20) & 0xFu; }
#define XB_SPIN(cond, bar) do { unsigned _sp = 0; while (cond) { __builtin_amdgcn_s_sleep(1); \
    if ((++_sp & 255u) == 0u) { if (xb_ld(&(bar)[XB_TMO])) break; if (_sp > XB_SPIN_CAP) { atomicAdd(&(bar)[XB_TMO], 1u); break; } } } } while (0)
struct XcdBarrier { unsigned* bar; unsigned x; volatile LAS unsigned* st; };
__device__ __forceinline__ XcdBarrier xcd_barrier_post(unsigned* bar, volatile LAS unsigned* st) {
    XcdBarrier b; b.bar = bar; b.x = xb_xcc_id(); b.st = st;
    if (threadIdx.x == 0) (void)xb_add(&bar[XB_XCNT(b.x)], 1u);
    return b;
}
__device__ __forceinline__ void xcd_barrier_complete(unsigned* bar, unsigned x, unsigned& nloc, unsigned& nx) {
    const unsigned G = gridDim.x * gridDim.y * gridDim.z;
    unsigned sum, cnt, mine, sp = 0u;
    for (;;) {
        sum = 0u; cnt = 0u; mine = 0u;
#pragma unroll
        for (unsigned j = 0; j < 16; ++j) { const unsigned c = xb_ld(&bar[XB_XCNT(j)]); sum += c; cnt += (c > 0u) ? 1u : 0u; mine = (j == x) ? c : mine; }
        if (sum == G) break;
        __builtin_amdgcn_s_sleep(1);
        if ((++sp & 255u) == 0u) { if (xb_ld(&bar[XB_TMO])) break; if (sp > XB_SPIN_CAP) { atomicAdd(&bar[XB_TMO], 1u); break; } }
    }
    nloc = mine > 0u ? mine : 1u; nx = cnt > 0u ? cnt : 1u;
}
__device__ __forceinline__ void xcd_barrier(const XcdBarrier& b) {
    asm volatile("s_waitcnt vmcnt(0)" ::: "memory");
    __syncthreads();
    if (threadIdx.x == 0) {
        unsigned* bar = b.bar;
        __builtin_amdgcn_s_waitcnt(0);
        unsigned nloc = b.st[0], nx = b.st[1];
        if (nloc == 0u) { xcd_barrier_complete(bar, b.x, nloc, nx); b.st[0] = nloc; b.st[1] = nx; }
        const unsigned old = xb_add(&bar[XB_XSUB(b.x)], 1u);
        const unsigned gen = old / nloc;
        if (old + 1u == (gen + 1u) * nloc) {
            __builtin_amdgcn_fence(__ATOMIC_RELEASE, "agent");
            asm volatile("s_waitcnt vmcnt(0)" ::: "memory");
            const unsigned og = xb_add(&bar[XB_TOP], 1u);
            const unsigned tg = og / nx;
            if (og + 1u == (tg + 1u) * nx) xb_add(&bar[XB_TOPGEN], 1u);
            else XB_SPIN(xb_ld(&bar[XB_TOPGEN]) == tg, bar);
            __builtin_amdgcn_fence(__ATOMIC_ACQUIRE, "agent");
            xb_add(&bar[XB_XGEN(b.x)], 1u);
            asm volatile("s_waitcnt vmcnt(0)" ::: "memory");
        } else {
            XB_SPIN(xb_ld(&bar[XB_XGEN(b.x)]) == gen, bar);
            __builtin_amdgcn_fence(__ATOMIC_ACQUIRE, "agent");
            asm volatile("s_waitcnt vmcnt(0)" ::: "memory");
        }
    }
    __syncthreads();
}
constexpr int CW_BAR = 4096;
constexpr int LDS_BARST = 131072 + 256;
__global__ void __launch_bounds__(512, 2) mk_fwd(Args a) {
    extern __shared__ __attribute__((aligned(16))) unsigned char lds_raw[];
    LAS unsigned char* lds = (LAS unsigned char*)lds_raw;
    cg::grid_group grid = cg::this_grid();
    if (threadIdx.x < 2) ((volatile LAS unsigned*)(lds + LDS_BARST))[threadIdx.x] = 0u;
    __syncthreads();
    const XcdBarrier xbar = xcd_barrier_post((unsigned*)(a.ws + WS_CTL) + CW_BAR, (volatile LAS unsigned*)(lds + LDS_BARST));
#define GSYNC() xcd_barrier(xbar)
    run_phase(lds, a, PH_PRO1, 0, 0, 0); grid.sync();
    run_phase(lds, a, PH_PRO2, 0, 0, 0); GSYNC();
    run_phase(lds, a, PH_MAKEXA, 0, 0, 1); GSYNC();
#pragma unroll 1
    for (int l = 0; l < DEPTH; ++l) {
        run_phase(lds, a, PH_IN, l, 0, 0); GSYNC();
        run_phase(lds, a, PH_ATT, l, 0, 0); GSYNC();
        run_phase(lds, a, PH_OUT, l, 0, 0); GSYNC();
        run_phase(lds, a, PH_UP, l, 0, 0); GSYNC();
        run_phase(lds, a, PH_DOWN, l, 0, 0);
        if (l < DEPTH - 1) GSYNC();
    }
}

extern "C" void kernel_launch(void* const* d_in, const int* in_sizes, int n_in, void* d_out, int out_size, void* d_ws, size_t ws_size, hipStream_t stream) {
    static int grid = 0;
    if (grid == 0) {
        int dev = 0, cus = 0, per_cu = 0;
        (void)hipGetDevice(&dev); (void)hipDeviceGetAttribute(&cus, hipDeviceAttributeMultiprocessorCount, dev);
        (void)hipFuncSetAttribute((const void*)mk_fwd, hipFuncAttributeMaxDynamicSharedMemorySize, LDS_BYTES);
        (void)hipOccupancyMaxActiveBlocksPerMultiprocessor(&per_cu, (const void*)mk_fwd, 512, LDS_BYTES);
        if (per_cu < 1) fprintf(stderr, "kernel_launch: occupancy query reports %d blocks per CU\n", per_cu);
        grid = cus > 0 ? cus : 256;
        if (ws_size < WS_END) { fprintf(stderr, "kernel_launch: workspace too small (%zu < %zu)\n", ws_size, (size_t)WS_END); grid = -1; }
    }
    if (grid < 0) return;
    Args a{}; for (int i = 0; i < N_IN; ++i) a.in[i] = (const float*)d_in[i]; a.out = (float*)d_out; a.ws = (unsigned char*)d_ws;
    (void)hipMemsetAsync((unsigned char*)d_ws + WS_CTL, 0, 1 * MiB, stream);
    void* args[] = {&a};
    hipError_t e = hipLaunchCooperativeKernel((const void*)mk_fwd, dim3(grid), dim3(512), args, LDS_BYTES, stream);
    if (e != hipSuccess) fprintf(stderr, "cooperative launch failed: %s (grid %d)\n", hipGetErrorString(e), grid);
}
```

```cpp
#include <hip/hip_runtime.h>
#include <hip/hip_cooperative_groups.h>
#include <cstdio>
#include <cstdint>
namespace cg = cooperative_groups;

constexpr int DEPTH = 4, NCTX = 32, TCTX = 256, NLAT = 4, TLAT = 2048, PAST = 512;
constexpr int MCTX = 8192, MLAT = 8192, MTOT = 16384;
constexpr int DIN = 2304, DFF = 2816, DUP = 5632;
constexpr size_t OUT_X = 0, OUT_NAK = 16777216, OUT_NAV = 25165824, OUT_SWK = 33554432, OUT_SWV = 37748736, OUT_DAK = 41943040, OUT_DAV = 50331648, OUT_TOTAL = 58720256;
enum { I_XP = 0, I_XS, I_CNAK, I_CNAV, I_CSWK, I_CSWV, I_CDAK, I_CDAV, I_C, I_CCTX, I_GATTN, I_GFFN, I_WMOD, I_BMOD, I_WIN, I_NAG, I_RPB, I_SWG, I_SINK, I_DAG, I_LAMBDA, I_SUBG, I_WOUT, I_WUP, I_CONVW, I_CONVB, I_WDOWN, N_IN };
#define LAS __attribute__((address_space(3)))
typedef unsigned short bf16_t;
typedef short bf16x8 __attribute__((ext_vector_type(8)));
typedef float f32x4 __attribute__((ext_vector_type(4)));
typedef float f32x2 __attribute__((ext_vector_type(2)));
typedef float f32x16 __attribute__((ext_vector_type(16)));
typedef unsigned u32x4 __attribute__((ext_vector_type(4)));
typedef unsigned u32x2 __attribute__((ext_vector_type(2)));
typedef __bf16 bf16x2_t __attribute__((ext_vector_type(2)));

constexpr float LOG2E = 1.4426950408889634f;
constexpr float QSCALE64 = 0.125f * LOG2E, QSCALE32 = 0.17677669529663687f * LOG2E;

__device__ __forceinline__ unsigned cvt_pk_bf16(float lo, float hi) { f32x2 v = {lo, hi}; bf16x2_t b = __builtin_convertvector(v, bf16x2_t); return __builtin_bit_cast(unsigned, b); }
__device__ __forceinline__ float bf16_to_f32(bf16_t v) { return __builtin_bit_cast(float, (unsigned)v << 16); }
__device__ __forceinline__ int row_b5(int row) { return row < MCTX ? 0 : 1 + ((row - MCTX) >> 11); }

constexpr size_t MiB = 1u << 20;
constexpr size_t WS_CTL = 0;
constexpr size_t WS_MOD = 1 * MiB;
constexpr size_t WS_GV = WS_MOD + 512 * 1024;
constexpr size_t WS_BIASIN = WS_GV + 256 * 1024;
constexpr size_t WS_BIASUP = WS_BIASIN + 256 * 1024;
constexpr size_t WS_LAM = WS_BIASUP + 512 * 1024;
constexpr int SM_LAM = 0, SM_GAINS = 64, SM_RPB = SM_GAINS + 1280, SM_SINK = SM_RPB + 7440, SM_SUBG = SM_SINK + 32, SM_END = SM_SUBG + 256;
constexpr size_t WS_ROPEB = 3 * MiB;
constexpr size_t WS_ROPEC = WS_ROPEB + 512 * 1024;
constexpr size_t WS_SSQ = 4 * MiB;
constexpr size_t WS_CONV = 5 * MiB;
constexpr size_t WS_WIN = 6 * MiB;
constexpr size_t WS_WOUT = WS_WIN + 18 * MiB;
constexpr size_t WS_WUP = WS_WOUT + 8 * MiB;
constexpr size_t WS_WDOWN = WS_WUP + 44 * MiB;
constexpr size_t WS_KC = WS_WDOWN + 22 * MiB;
constexpr size_t WS_XA = WS_KC + 20 * MiB;
constexpr size_t WS_QKV = WS_XA + 32 * MiB + 1 * MiB;
constexpr size_t WS_O = WS_QKV + 72 * MiB;
constexpr size_t WS_ACT = WS_QKV;
constexpr size_t WS_END = WS_O + 32 * MiB;
constexpr size_t GS4 = 2097152, GS8 = 4194304, GS2 = 1048576;
constexpr size_t QO_QA = 0, QO_KA = QO_QA + 2 * GS4, QO_VTA = QO_KA + 2 * GS4, QO_QB = QO_VTA + 2 * GS4, QO_KB = QO_QB + 2 * GS8, QO_VTB = QO_KB + 2 * GS2,
                 QO_QC = QO_VTB + 2 * GS2, QO_KC = QO_QC + 2 * GS4, QO_VTC = QO_KC + 2 * GS4, QO_END = QO_VTC + 2 * GS4;
static_assert(QO_END * 2 == 72 * MiB, "qkv region");
constexpr size_t CO_KA = 0, CO_VTA = CO_KA + GS4, CO_KB = CO_VTA + GS4, CO_VTB = CO_KB + GS2, CO_KCC = CO_VTB + GS2, CO_VTCC = CO_KCC + GS4;

struct Args { const float* in[N_IN]; float* out; unsigned char* ws; };
__device__ __forceinline__ int opaque_tid() { int t = threadIdx.x; asm volatile("" : "+v"(t)); return t; }

namespace pg8 {
#define PG8_LAS __attribute__((address_space(3)))
constexpr int BM = 256, BK = 64, HALF = 128, HTB = HALF * BK * 2  , STAGE_BYTES = 8 * HTB, NXCD = 8, WGM = 8;
__host__ __device__ __forceinline__ int lds_byte(int r, int c) { const int st = (r >> 4) * 2 + (c >> 5), rr = r & 15, cc = c & 31, ob = rr * 64 + cc * 2; return st * 1024 + (ob ^ (((ob >> 9) & 1) << 5)); }
__host__ __device__ __forceinline__ void stage_rc(int b, int& R, int& C) { const int st = b / 1024, sb = b % 1024, swz = sb ^ (((sb >> 9) & 1) << 5); R = (st >> 1) * 16 + swz / 64; C = (st & 1) * 32 + (swz % 64) / 2; }
__host__ __device__ __forceinline__ int perm32(int rho) { const int n = rho >> 4, i = rho & 15; return 8 * (i >> 2) + 4 * n + (i & 3); }
struct Unit { int pm, pn; };
struct Gemm { const bf16_t* A; const bf16_t* Bt; int M, N, K; };
struct StaticOrder {
    int nM, nN, nwg, G, c;
    __host__ __device__ void init(int M, int N, int G_, int c_) { nM = M / BM; nN = N / BM; nwg = nM * nN; G = G_; c = c_; }
    __host__ __device__ bool next(int i, Unit& u) const {
        const long L = (long)i * G + c; if (L >= nwg) return false;
        int wgid = (int)L; { const int q = nwg / NXCD, r = nwg % NXCD, xcd = wgid % NXCD, off = wgid / NXCD; wgid = (xcd < r ? xcd * (q + 1) : r * (q + 1) + (xcd - r) * q) + off; }
        const int nig = WGM * nN, gid = wgid / nig, fm = gid * WGM, gsz = (nM - fm) < WGM ? (nM - fm) : WGM;
        u.pm = fm + ((wgid % nig) % gsz); u.pn = (wgid % nig) / gsz; return true;
    }
    __device__ __forceinline__ void a_ready(const Unit&) const {}
    __device__ __forceinline__ void done(const Unit&) const {}
    __device__ __forceinline__ int arow0(int pm) const { return BM * pm; }
};
struct UpOrder : StaticOrder {
    __device__ __forceinline__ void init_up(int G_, int c_) { nM = 68; nN = 22; nwg = nM * nN; G = G_; c = c_; }
    __device__ __forceinline__ int arow0(int pm) const { return pm < 32 ? BM * pm : MCTX + TLAT * ((pm - 32) / 9) + 254 * ((pm - 32) % 9) - 1; }
};

template <class Epi, class Sched, bool ALIGN_EPI = false, bool SP2 = false>
__device__ __forceinline__ void gemm_phase(PG8_LAS unsigned char* lds, const Gemm g, const Sched& S, const Epi& E) {
    const int tid = opaque_tid(), wid = __builtin_amdgcn_readfirstlane(tid >> 6), lane = tid & 63, wr = wid >> 2, wc = wid & 3, fr = lane & 15, fq = lane >> 4;
    const int K = g.K, nt = K / BK;
    unsigned voffA[2], voffB[2];
#pragma unroll
    for (int i = 0; i < 2; ++i) { int R, C; stage_rc(tid * 16 + i * 8192, R, C); const int Rb = Epi::PERM ? ((R & ~31) + perm32(R & 31)) : R;
        voffA[i] = (unsigned)(R * K + C) * 2u; voffB[i] = (unsigned)(Rb * K + C) * 2u; }
    const size_t kstep = (size_t)(BK * 2);
    const size_t hstep = (size_t)HALF * K * 2;
    const size_t tstep = 2 * hstep;
    const unsigned ldsw = (unsigned)wid * 1024u;
    const int aoff = lds_byte(wr * 64 + fr, fq * 8), boff = lds_byte(wc * 32 + fr, fq * 8);
#define PG8_SA(b, h) (((b) * 2 + (h)) * HTB)
#define PG8_SB(b, h) ((4 + (b) * 2 + (h)) * HTB)
#define PG8_STAGE(bufoff, gbase, voff) do { _Pragma("unroll") for (int _i = 0; _i < 2; ++_i) \
        __builtin_amdgcn_global_load_lds((const unsigned*)((const char*)(gbase) + (voff)[_i]), (PG8_LAS unsigned*)(lds + (bufoff) + ldsw + _i * 8192), 16, 0, 0); } while (0)
#define PG8_LDA(dst, b, h) do { _Pragma("unroll") for (int m = 0; m < 4; ++m) _Pragma("unroll") for (int k = 0; k < 2; ++k) dst[m][k] = *(const PG8_LAS bf16x8*)(lds + PG8_SA(b, h) + aoff + m * 2048 + k * 1024); } while (0)
#define PG8_LDB(dst, b, h) do { _Pragma("unroll") for (int n = 0; n < 2; ++n) _Pragma("unroll") for (int k = 0; k < 2; ++k) dst[n][k] = *(const PG8_LAS bf16x8*)(lds + PG8_SB(b, h) + boff + n * 2048 + k * 1024); } while (0)
#define PG8_MMA(ai, bj, At, Bt) do { __builtin_amdgcn_s_setprio(1); _Pragma("unroll") for (int m = 0; m < 4; ++m) _Pragma("unroll") for (int n = 0; n < 2; ++n) _Pragma("unroll") for (int k = 0; k < 2; ++k) \
        acc[ai][bj][m][n] = __builtin_amdgcn_mfma_f32_16x16x32_bf16(Bt[n][k], At[m][k], acc[ai][bj][m][n], 0, 0, 0); __builtin_amdgcn_s_setprio(0); } while (0)
#define PG8_WAIT_V(n) asm volatile("s_waitcnt vmcnt(" #n ")" ::: "memory")
#define PG8_WAIT_L(n) asm volatile("s_waitcnt lgkmcnt(" #n ")" ::: "memory")
#define PG8_BAR __builtin_amdgcn_s_barrier()
#define PG8_SCHED __builtin_amdgcn_sched_barrier(0)
    Unit cur, nxt; int ui = 0;
    if (!S.next(0, cur)) return;
    f32x4 acc[2][2][4][2];
#pragma unroll
    for (int a = 0; a < 2; ++a)
#pragma unroll
        for (int b = 0; b < 2; ++b)
#pragma unroll
            for (int m = 0; m < 4; ++m)
#pragma unroll
                for (int n = 0; n < 2; ++n) acc[a][b][m][n] = (f32x4){0.f, 0.f, 0.f, 0.f};
    bf16x8 At[4][2], B0[2][2], B1[2][2];
    const size_t rstep = (size_t)K * 2;
    const char* cA = (const char*)g.A + (size_t)S.arow0(cur.pm) * rstep; const char* cB = (const char*)g.Bt + (size_t)cur.pn * tstep;
    S.a_ready(cur);
    if constexpr (SP2) {
        PG8_STAGE(PG8_SB(0, 0), cB, voffB); PG8_STAGE(PG8_SB(0, 1), cB + hstep, voffB); PG8_STAGE(PG8_SA(0, 0), cA, voffA); PG8_STAGE(PG8_SA(0, 1), cA + hstep, voffA);
        if (wr == 1) PG8_BAR;
        PG8_WAIT_V(2); PG8_BAR;
        PG8_STAGE(PG8_SB(1, 0), cB + kstep, voffB); PG8_STAGE(PG8_SA(1, 0), cA + kstep, voffA); PG8_STAGE(PG8_SB(1, 1), cB + hstep + kstep, voffB);
        PG8_WAIT_V(6); PG8_BAR;
    } else {
        PG8_STAGE(PG8_SB(0, 0), cB, voffB); PG8_STAGE(PG8_SA(0, 0), cA, voffA); PG8_STAGE(PG8_SB(0, 1), cB + hstep, voffB); PG8_STAGE(PG8_SA(0, 1), cA + hstep, voffA);
        if (wr == 1) PG8_BAR;
        PG8_WAIT_V(4); PG8_BAR;
        PG8_STAGE(PG8_SB(1, 0), cB + kstep, voffB); PG8_STAGE(PG8_SA(1, 0), cA + kstep, voffA); PG8_STAGE(PG8_SB(1, 1), cB + hstep + kstep, voffB);
        PG8_WAIT_V(6); PG8_BAR;
    }
    for (;;) {
        const bool has_next = S.next(ui + 1, nxt);
        const char* nA = has_next ? (const char*)g.A + (size_t)S.arow0(nxt.pm) * rstep : cA; const char* nB = has_next ? (const char*)g.Bt + (size_t)nxt.pn * tstep : cB;
        for (int t = 0; t < nt; t += 2) {
            const bool last = (t == nt - 2);
            const char* a1 = cA + (size_t)(t + 1) * kstep;
            const char* a2 = last ? nA : cA + (size_t)(t + 2) * kstep; const char* b2 = last ? nB : cB + (size_t)(t + 2) * kstep;
            const char* a3 = a2 + kstep; const char* b3 = b2 + kstep;
            if (last && has_next) S.a_ready(nxt);
            if constexpr (SP2) {
            PG8_LDB(B0, 0, 0); PG8_LDB(B1, 0, 1); PG8_SCHED; PG8_LDA(At, 0, 0); PG8_STAGE(PG8_SA(1, 1), a1 + hstep, voffA);
            PG8_WAIT_V(8); PG8_WAIT_L(0); PG8_BAR; PG8_MMA(0, 0, At, B0); PG8_MMA(0, 1, At, B1); PG8_BAR; PG8_SCHED;
            PG8_LDA(At, 0, 1); PG8_STAGE(PG8_SB(0, 0), b2, voffB); PG8_STAGE(PG8_SB(0, 1), b2 + hstep, voffB); PG8_STAGE(PG8_SA(0, 0), a2, voffA);
            PG8_WAIT_V(8); PG8_WAIT_L(0); PG8_BAR; PG8_MMA(1, 0, At, B0); PG8_MMA(1, 1, At, B1); PG8_BAR; PG8_SCHED;
            PG8_LDB(B0, 1, 0); PG8_LDB(B1, 1, 1); PG8_SCHED; PG8_LDA(At, 1, 0); PG8_STAGE(PG8_SA(0, 1), a2 + hstep, voffA);
            PG8_WAIT_V(8); PG8_WAIT_L(0); PG8_BAR; PG8_MMA(0, 0, At, B0); PG8_MMA(0, 1, At, B1); PG8_BAR; PG8_SCHED;
            PG8_LDA(At, 1, 1); PG8_STAGE(PG8_SB(1, 0), b3, voffB); PG8_STAGE(PG8_SB(1, 1), b3 + hstep, voffB); PG8_STAGE(PG8_SA(1, 0), a3, voffA);
            PG8_WAIT_V(8); PG8_WAIT_L(0); PG8_BAR; PG8_MMA(1, 0, At, B0); PG8_MMA(1, 1, At, B1); PG8_BAR; PG8_SCHED;
            } else {
            PG8_LDB(B0, 0, 0); PG8_SCHED; PG8_LDA(At, 0, 0); PG8_STAGE(PG8_SA(1, 1), a1 + hstep, voffA);
            PG8_WAIT_L(8); PG8_BAR; PG8_WAIT_L(0); PG8_MMA(0, 0, At, B0); PG8_BAR; PG8_SCHED;
            PG8_LDB(B1, 0, 1); PG8_STAGE(PG8_SB(0, 0), b2, voffB);
            PG8_BAR; PG8_WAIT_L(0); PG8_MMA(0, 1, At, B1); PG8_BAR;
            PG8_LDA(At, 0, 1); PG8_STAGE(PG8_SA(0, 0), a2, voffA);
            PG8_BAR; PG8_WAIT_L(0); PG8_MMA(1, 0, At, B0); PG8_BAR; PG8_SCHED;
            PG8_STAGE(PG8_SB(0, 1), b2 + hstep, voffB);
            PG8_WAIT_V(6); PG8_BAR; PG8_MMA(1, 1, At, B1); PG8_BAR;
            PG8_LDB(B0, 1, 0); PG8_SCHED; PG8_LDA(At, 1, 0); PG8_STAGE(PG8_SA(0, 1), a2 + hstep, voffA);
            PG8_WAIT_L(8); PG8_BAR; PG8_WAIT_L(0); PG8_MMA(0, 0, At, B0); PG8_BAR; PG8_SCHED;
            PG8_LDB(B1, 1, 1); PG8_STAGE(PG8_SB(1, 0), b3, voffB);
            PG8_BAR; PG8_WAIT_L(0); PG8_MMA(0, 1, At, B1); PG8_BAR;
            PG8_LDA(At, 1, 1); PG8_STAGE(PG8_SA(1, 0), a3, voffA);
            PG8_BAR; PG8_WAIT_L(0); PG8_MMA(1, 0, At, B0); PG8_BAR; PG8_SCHED;
            PG8_STAGE(PG8_SB(1, 1), b3 + hstep, voffB);
            PG8_WAIT_V(6); PG8_BAR; PG8_MMA(1, 1, At, B1); PG8_BAR;
            }
        }
        if constexpr (ALIGN_EPI) { if (wr == 0) PG8_BAR; }
        if constexpr (!Epi::AFTER_DRAIN) { if constexpr (Epi::NEEDS_LDS) E(acc, cur, wr, wc, fr, fq, lds); else E(acc, cur, wr, wc, fr, fq); S.done(cur); }
        if (!has_next) break;
#pragma unroll
        for (int a = 0; a < 2; ++a)
#pragma unroll
            for (int b = 0; b < 2; ++b)
#pragma unroll
                for (int m = 0; m < 4; ++m)
#pragma unroll
                    for (int n = 0; n < 2; ++n) acc[a][b][m][n] = (f32x4){0.f, 0.f, 0.f, 0.f};
        cur = nxt; cA = nA; cB = nB; ++ui;
        if constexpr (ALIGN_EPI) { if (wr == 1) PG8_BAR; }
    }
    PG8_WAIT_V(0);
    if constexpr (!ALIGN_EPI) { if (wr == 0) PG8_BAR; }
    PG8_BAR;
    if constexpr (Epi::AFTER_DRAIN) { E.fused(acc, cur, wr, wc, fr, fq, lds, wid, lane); S.done(cur); }
#undef PG8_SA
#undef PG8_SB
#undef PG8_STAGE
#undef PG8_LDA
#undef PG8_LDB
#undef PG8_MMA
#undef PG8_WAIT_V
#undef PG8_WAIT_L
#undef PG8_BAR
#undef PG8_SCHED
}

__device__ __forceinline__ float row_rstd(const float* ssq, int row) {
    const f32x4* p = (const f32x4*)(ssq + (size_t)row * 16); const f32x4 a = p[0], b = p[1], c = p[2], d = p[3];
    const float s = ((a[0] + a[1]) + (a[2] + a[3])) + ((b[0] + b[1]) + (b[2] + b[3])) + ((c[0] + c[1]) + (c[2] + c[3])) + ((d[0] + d[1]) + (d[2] + d[3]));
    return __builtin_amdgcn_rsqf(s * (1.0f / 1024.0f) + 1e-6f);
}


constexpr int LDS_EDGE = 131072 + 1024;
constexpr int LDS_RSTD = LDS_EDGE + 8192;
__device__ __forceinline__ void rstd_table(PG8_LAS unsigned char* lds, const float* ssq, int arow0, int wr, int wc, int fr, int fq) {
    const int tid = (wr * 4 + wc) * 64 + fq * 16 + fr, r = tid >> 1, hf = tid & 1;
    const f32x4* p = (const f32x4*)(ssq + (size_t)min(arow0 + r, MTOT - 1) * 16 + 8 * hf); const f32x4 a = p[0], b = p[1];
    float s = ((a[0] + a[1]) + (a[2] + a[3])) + ((b[0] + b[1]) + (b[2] + b[3])); s += __shfl_xor(s, 1);
    if (!hf) ((PG8_LAS float*)(lds + LDS_RSTD))[r] = __builtin_amdgcn_rsqf(s * (1.0f / 1024.0f) + 1e-6f);
}
#define EPI_BARRIER() do { asm volatile("s_waitcnt lgkmcnt(0)" ::: "memory"); __builtin_amdgcn_s_barrier(); asm volatile("" ::: "memory"); } while (0)

struct EpiIn {
    static constexpr bool PERM = false, AFTER_DRAIN = false, NEEDS_LDS = true;
    unsigned char* ws0; float* out; int l;
    __device__ __forceinline__ void operator()(const f32x4 (&acc)[2][2][4][2], const Unit& u, int wr, int wc, int fr_in, int fq_in, PG8_LAS unsigned char* lds) const {
        unsigned char* ws = ws0; asm volatile("" : "+s"(ws));
        int fr = fr_in, fq = fq_in; asm volatile("" : "+v"(fr), "+v"(fq));
        const float* ssq = (const float*)(ws + WS_SSQ); const float* bias = (const float*)(ws + WS_BIASIN) + (size_t)l * 5 * DIN;
        const float* gains = (const float*)(ws + WS_LAM) + SM_GAINS + l * 320; const float* nag = gains; const float* swg = gains + 128; const float* dag = gains + 256;
        const float* ropeB = (const float*)(ws + WS_ROPEB); const float* ropeC = (const float*)(ws + WS_ROPEC); bf16_t* qkv = (bf16_t*)(ws + WS_QKV);
        const int pm = u.pm, pn = u.pn;
        const int grp = pm >= 32 ? 1 : 0, b = grp ? ((pm - 32) >> 3) : pm, tbase = grp ? 256 * ((pm - 32) & 7) : 0, T = grp ? TLAT : TCTX, b5 = grp ? 1 + b : 0;
        int type, h;
        if (pn < 3) { type = pn; h = wc; } else if (pn < 5) { type = 3; h = 4 * (pn - 3) + wc; } else if (pn == 5) { type = wc < 2 ? 4 : 5; h = wc & 1; } else { type = pn; h = wc; }
        const bool isv = (type == 2 || type == 5 || type == 8), isq = (type == 0 || type == 3 || type == 6), is32 = (type == 6 || type == 7);
        const bool rope = grp && (type == 3 || type == 4 || type == 6 || type == 7);
        const int H = (type == 3) ? 8 : ((type == 4 || type == 5) ? 2 : 4);
        size_t dbase; const size_t gs = (type == 3) ? GS8 : ((type == 4 || type == 5) ? GS2 : GS4);
        switch (type) { case 0: dbase = QO_QA; break; case 1: dbase = QO_KA; break; case 2: dbase = QO_VTA; break; case 3: dbase = QO_QB; break; case 4: dbase = QO_KB; break; case 5: dbase = QO_VTB; break;
                        case 6: dbase = QO_QC; break; case 7: dbase = QO_KC; break; default: dbase = QO_VTC; break; }
        bf16_t* dst = qkv + dbase + grp * gs + (size_t)(b * H + h) * T * 64;
        float* fo = nullptr; int fow = 0, foc = 0;
        if (!grp) { switch (type) { case 1: fo = out + OUT_NAK; fow = 256; foc = 64 * wc; break; case 2: fo = out + OUT_NAV; fow = 256; foc = 64 * wc; break; case 4: fo = out + OUT_SWK; fow = 128; foc = 64 * h; break;
                        case 5: fo = out + OUT_SWV; fow = 128; foc = 64 * h; break; case 7: fo = out + OUT_DAK; fow = 256; foc = 64 * wc; break; case 8: fo = out + OUT_DAV; fow = 256; foc = 64 * wc; break; default: break; } }
        const float* gsrc = ((type == 0) ? nag : (type == 1) ? nag + 64 : (type == 3) ? swg : (type == 4) ? swg + 64 : (type == 6) ? dag : dag + 32) + 4 * fq;
        const float* bsrc = bias + b5 * DIN + pn * 256 + 64 * wc + 4 * fq;
        rstd_table(lds, ssq, 256 * pm, wr, wc, fr, fq);
        f32x4 bv[2][2], gv[2][2];
#pragma unroll
        for (int bj = 0; bj < 2; ++bj)
#pragma unroll
            for (int n = 0; n < 2; ++n) { bv[bj][n] = *(const f32x4*)(bsrc + 32 * bj + 16 * n); gv[bj][n] = isv ? (f32x4){1.f, 1.f, 1.f, 1.f} : *(const f32x4*)(gsrc + (is32 ? 0 : 32 * bj) + 16 * n); }
        EPI_BARRIER();
        const PG8_LAS float* RS = (const PG8_LAS float*)(lds + LDS_RSTD);
        const float qs = isq ? (is32 ? QSCALE32 : QSCALE64) : 1.0f;
#pragma unroll
        for (int ai = 0; ai < 2; ++ai)
#pragma unroll
            for (int m = 0; m < 4; ++m) {
                const int lr = 128 * ai + 64 * wr + 16 * m + fr, row = 256 * pm + lr, t = tbase + lr;
                const float rstd = RS[lr];
                float r0 = 1.f, r1 = 1.f;
                if (!isv) {
                    float s0 = 0.f, s1 = 0.f;
#pragma unroll
                    for (int n = 0; n < 2; ++n) { const f32x4 a = acc[ai][0][m][n] * rstd + bv[0][n], c = acc[ai][1][m][n] * rstd + bv[1][n];
                        s0 += (a[0] * a[0] + a[1] * a[1]) + (a[2] * a[2] + a[3] * a[3]); s1 += (c[0] * c[0] + c[1] * c[1]) + (c[2] * c[2] + c[3] * c[3]); }
                    s0 += __shfl_xor(s0, 16); s0 += __shfl_xor(s0, 32); s1 += __shfl_xor(s1, 16); s1 += __shfl_xor(s1, 32);
                    if (is32) { r0 = __builtin_amdgcn_rsqf(s0 * (1.f / 32.f) + 1e-6f); r1 = __builtin_amdgcn_rsqf(s1 * (1.f / 32.f) + 1e-6f); }
                    else { r0 = r1 = __builtin_amdgcn_rsqf((s0 + s1) * (1.f / 64.f) + 1e-6f); }
                }
                float* fr_ = fo ? fo + ((size_t)(b * DEPTH + l) * 256 + t) * fow + foc + 4 * fq : nullptr;
#pragma unroll
                for (int bj = 0; bj < 2; ++bj)
#pragma unroll
                    for (int n = 0; n < 2; ++n) {
                        f32x4 x = acc[ai][bj][m][n] * rstd + bv[bj][n];
                        if (!isv) {
                            x = x * (bj ? r1 : r0) * gv[bj][n];
                            if (rope) {
                                const f32x4 cs = is32 ? *(const f32x4*)(ropeC + ((size_t)t * 16 + 8 * n + 2 * fq) * 2) : *(const f32x4*)(ropeB + ((size_t)t * 32 + 16 * bj + 8 * n + 2 * fq) * 2);
                                x = (f32x4){x[0] * cs[0] - x[1] * cs[1], x[0] * cs[1] + x[1] * cs[0], x[2] * cs[2] - x[3] * cs[3], x[2] * cs[3] + x[3] * cs[2]};
                            }
                        }
                        if (fr_) *(f32x4*)(fr_ + 32 * bj + 16 * n) = x;
                        if (!isv) { const f32x4 y = x * qs; u32x2 w; w.x = cvt_pk_bf16(y[0], y[1]); w.y = cvt_pk_bf16(y[2], y[3]); *(u32x2*)(dst + (size_t)t * 64 + 4 * fq + 32 * bj + 16 * n) = w; }
                        else { const int d0 = 32 * bj + 16 * n + 4 * fq;
#pragma unroll
                            for (int e = 0; e < 4; ++e) dst[(size_t)(d0 + e) * T + t] = (bf16_t)(cvt_pk_bf16(x[e], 0.f) & 0xffffu); }
                    }
            }
    }
};

struct EpiRes {
    static constexpr bool PERM = false, AFTER_DRAIN = false, NEEDS_LDS = false;
    unsigned char* ws0; float* x; int l; int which;
    __device__ __forceinline__ void operator()(const f32x4 (&acc)[2][2][4][2], const Unit& u, int wr, int wc, int fr, int fq) const {
        unsigned char* ws = ws0; asm volatile("" : "+s"(ws));
        const float* gate = (const float*)(ws + WS_MOD) + (size_t)l * 5 * 6144 + (which ? 5 : 2) * 1024;
        const float* gvn = which ? (l < 3 ? (const float*)(ws + WS_GV) + (size_t)(l + 1) * 10240 : nullptr) : (const float*)(ws + WS_GV) + (size_t)l * 10240 + 1024;
        bf16_t* xa = (bf16_t*)(ws + WS_XA); float* ssq = (float*)(ws + WS_SSQ);
        const int pm = u.pm, pn = u.pn, b5 = pm >= 32 ? 1 + ((pm - 32) >> 3) : 0;
        const int col0 = 256 * pn + 32 * wc + 4 * fq;
        f32x4 gt[2][2], gn[2][2];
#pragma unroll
        for (int bj = 0; bj < 2; ++bj)
#pragma unroll
            for (int n = 0; n < 2; ++n) { gt[bj][n] = *(const f32x4*)(gate + (size_t)b5 * 6144 + col0 + 128 * bj + 16 * n); gn[bj][n] = gvn ? *(const f32x4*)(gvn + (size_t)b5 * 2048 + col0 + 128 * bj + 16 * n) : (f32x4){0.f, 0.f, 0.f, 0.f}; }
#pragma unroll
        for (int ai = 0; ai < 2; ++ai)
#pragma unroll
            for (int m = 0; m < 4; ++m) {
                const int row = 256 * pm + 128 * ai + 64 * wr + 16 * m + fr; float* xr = x + (size_t)row * 1024 + col0; float ss = 0.f;
#pragma unroll
                for (int bj = 0; bj < 2; ++bj)
#pragma unroll
                    for (int n = 0; n < 2; ++n) {
                        const f32x4 xo = *(const f32x4*)(xr + 128 * bj + 16 * n); const f32x4 xn = xo + gt[bj][n] * acc[ai][bj][m][n];
                        *(f32x4*)(xr + 128 * bj + 16 * n) = xn;
                        if (gvn) { ss += (xn[0] * xn[0] + xn[1] * xn[1]) + (xn[2] * xn[2] + xn[3] * xn[3]); const f32x4 y = xn * gn[bj][n]; u32x2 w; w.x = cvt_pk_bf16(y[0], y[1]); w.y = cvt_pk_bf16(y[2], y[3]);
                            *(u32x2*)(xa + (size_t)row * 1024 + col0 + 128 * bj + 16 * n) = w; }
                    }
                if (gvn) { ss += __shfl_xor(ss, 16); ss += __shfl_xor(ss, 32); if (fq == 0) ssq[(size_t)row * 16 + 4 * pn + wc] = ss; }
            }
    }
};

#define DPPF(old, src, ctrl) __builtin_bit_cast(float, __builtin_amdgcn_update_dpp(__builtin_bit_cast(int, (float)(old)), __builtin_bit_cast(int, (float)(src)), (ctrl), 0xf, 0xf, false))
struct EpiUpConv {
    static constexpr bool PERM = false, AFTER_DRAIN = false, NEEDS_LDS = true;
    unsigned char* ws0; int l;
    __device__ __forceinline__ void operator()(f32x4 (&acc)[2][2][4][2], const Unit& u, int wr, int wc, int fr_in, int fq_in, PG8_LAS unsigned char* lds) const {
        unsigned char* ws = ws0; asm volatile("" : "+s"(ws));
        int fr = fr_in, fq = fq_in; asm volatile("" : "+v"(fr), "+v"(fq));
        const int pm = u.pm, pn = u.pn; const int grp = pm >= 32 ? 1 : 0, bq = grp ? (pm - 32) / 9 : 0, jq = grp ? (pm - 32) % 9 : 0;
        const int T = grp ? TLAT : TCTX, tofs = grp ? 254 * jq - 1 : 0, arow0 = grp ? MCTX + TLAT * bq + tofs : 256 * pm, b5 = grp ? 1 + bq : 0;
        const float* ssq = (const float*)(ws + WS_SSQ); const float* bias = (const float*)(ws + WS_BIASUP) + (size_t)(l * 5 + b5) * DUP; const float* cw = (const float*)(ws + WS_CONV) + (size_t)l * 4 * DUP;
        bf16_t* act = (bf16_t*)(ws + WS_ACT);
        const int fcol = 128 * pn + 32 * wc + 4 * fq;
        rstd_table(lds, ssq, arow0, wr, wc, fr, fq);
        f32x4 bv[2][2];
#pragma unroll
        for (int bj = 0; bj < 2; ++bj)
#pragma unroll
            for (int n = 0; n < 2; ++n) bv[bj][n] = *(const f32x4*)(bias + bj * DFF + fcol + 16 * n);
        EPI_BARRIER();
        const PG8_LAS float* RS = (const PG8_LAS float*)(lds + LDS_RSTD);
#pragma unroll
        for (int ai = 0; ai < 2; ++ai)
#pragma unroll
            for (int m = 0; m < 4; ++m) {
                const int i = 128 * ai + 64 * wr + 16 * m + fr, t = tofs + i; const bool inseq = (t >= 0) && (t < T);
                const float rstd = RS[i];
#pragma unroll
                for (int bj = 0; bj < 2; ++bj)
#pragma unroll
                    for (int n = 0; n < 2; ++n) { const f32x4 v = acc[ai][bj][m][n] * rstd + bv[bj][n]; acc[ai][bj][m][n] = inseq ? v : (f32x4){0.f, 0.f, 0.f, 0.f}; }
            }
        PG8_LAS float* E = (PG8_LAS float*)(lds + LDS_EDGE);
#pragma unroll
        for (int ai = 0; ai < 2; ++ai) { const int c = 2 * ai + wr;
#pragma unroll
            for (int bj = 0; bj < 2; ++bj)
#pragma unroll
                for (int n = 0; n < 2; ++n) { const int col = 128 * bj + 32 * wc + 16 * n + 4 * fq;
                    if (fr == 0) *(PG8_LAS f32x4*)(E + (c * 2 + 0) * 256 + col) = acc[ai][bj][0][n];
                    if (fr == 15) *(PG8_LAS f32x4*)(E + (c * 2 + 1) * 256 + col) = acc[ai][bj][3][n]; } }
        asm volatile("s_waitcnt lgkmcnt(0)" ::: "memory"); __builtin_amdgcn_s_barrier(); asm volatile("" ::: "memory");
#pragma unroll
        for (int n = 0; n < 2; ++n) {
            f32x4 w0[2], w1[2], w2[2], cb[2];
#pragma unroll
            for (int bj = 0; bj < 2; ++bj) { const float* p = cw + bj * DFF + fcol + 16 * n; w0[bj] = *(const f32x4*)p; w1[bj] = *(const f32x4*)(p + DUP); w2[bj] = *(const f32x4*)(p + 2 * DUP); cb[bj] = *(const f32x4*)(p + 3 * DUP); }
#pragma unroll
            for (int ai = 0; ai < 2; ++ai) { const int c = 2 * ai + wr;
                f32x4 ep[2], en[2];
#pragma unroll
                for (int bj = 0; bj < 2; ++bj) { const int col = 128 * bj + 32 * wc + 16 * n + 4 * fq;
                    ep[bj] = c > 0 ? *(const PG8_LAS f32x4*)(E + ((c - 1) * 2 + 1) * 256 + col) : (f32x4){0.f, 0.f, 0.f, 0.f};
                    en[bj] = c < 3 ? *(const PG8_LAS f32x4*)(E + ((c + 1) * 2 + 0) * 256 + col) : (f32x4){0.f, 0.f, 0.f, 0.f}; }
#pragma unroll
                for (int m = 0; m < 4; ++m) {
                    f32x4 y[2];
#pragma unroll
                    for (int bj = 0; bj < 2; ++bj) {
                        const f32x4 x = acc[ai][bj][m][n]; f32x4 pv, nx;
#pragma unroll
                        for (int e = 0; e < 4; ++e) {
                            const float po = m > 0 ? DPPF(acc[ai][bj][m > 0 ? m - 1 : 0][n][e], acc[ai][bj][m > 0 ? m - 1 : 0][n][e], 0x121) : ep[bj][e];
                            pv[e] = DPPF(po, x[e], 0x111);
                            const float no = m < 3 ? DPPF(acc[ai][bj][m < 3 ? m + 1 : 3][n][e], acc[ai][bj][m < 3 ? m + 1 : 3][n][e], 0x12F) : en[bj][e];
                            nx[e] = DPPF(no, x[e], 0x101);
                        }
                        y[bj] = cb[bj] + w0[bj] * pv + w1[bj] * x + w2[bj] * nx;
                    }
                    const int i = 128 * ai + 64 * wr + 16 * m + fr, t = tofs + i; const bool ok = grp ? ((i >= 1) && (i <= 254) && (t < T)) : true;
                    if (ok) { f32x4 a;
#pragma unroll
                        for (int e = 0; e < 4; ++e) a[e] = y[0][e] * __builtin_amdgcn_rcpf(1.0f + __expf(-y[0][e])) * y[1][e];
                        u32x2 w; w.x = cvt_pk_bf16(a[0], a[1]); w.y = cvt_pk_bf16(a[2], a[3]);
                        *(u32x2*)(act + (size_t)(arow0 + i) * DFF + fcol + 16 * n) = w; }
                }
            } }
    }
};
}
namespace att {
typedef LAS unsigned char lds_u8;
constexpr int LDS_TILE = 16384;
constexpr int LDS_RPB = 2 * LDS_TILE;
constexpr int LDS_NEXT = LDS_RPB + 2048;
constexpr int NUNITS = 1024;

struct Ctx { unsigned char* ws; int l; int rep; };

__device__ __forceinline__ bf16x8 lds128(const lds_u8* p) { return *(const LAS bf16x8*)p; }
__device__ __forceinline__ int sigma32(int i) { return (i & 19) | ((i & 4) << 1) | ((i & 8) >> 1); }

template <int NDS>
__device__ __forceinline__ f32x16 qk_block(const lds_u8* Kt, int kb, int c0, const bf16x8* qf, int lane) {
    const int key = 32 * kb + sigma32(lane & 31), h = lane >> 5; const lds_u8* base = Kt + key * 128; const int sw = key & 7;
    f32x16 s = {0.f, 0.f, 0.f, 0.f, 0.f, 0.f, 0.f, 0.f, 0.f, 0.f, 0.f, 0.f, 0.f, 0.f, 0.f, 0.f};
#pragma unroll
    for (int ds = 0; ds < NDS; ++ds) { const bf16x8 a = lds128(base + (((c0 + 2 * ds + h) ^ sw) << 4)); s = __builtin_amdgcn_mfma_f32_32x32x16_bf16(a, qf[ds], s, 0, 0, 0); }
    return s;
}
__device__ __forceinline__ void softmax_pv(f32x16& s0, f32x16& s1, float& m, float& l, f32x16& o0, f32x16& o1, const lds_u8* Vt, int lane) {
    float mx = fmaxf(s0[0], s1[0]);
#pragma unroll
    for (int r = 1; r < 16; ++r) mx = fmaxf(mx, fmaxf(s0[r], s1[r]));
    mx = fmaxf(mx, __shfl_xor(mx, 32));
    const float mn = fmaxf(m, mx);
    if (__any(mn > m)) { const float al = __builtin_amdgcn_exp2f(m - mn); l *= al;
#pragma unroll
        for (int r = 0; r < 16; ++r) { o0[r] *= al; o1[r] *= al; }
        m = mn; }
    float ps = 0.f;
#pragma unroll
    for (int r = 0; r < 16; ++r) { s0[r] = __builtin_amdgcn_exp2f(s0[r] - m); s1[r] = __builtin_amdgcn_exp2f(s1[r] - m); ps += s0[r] + s1[r]; }
    l += ps;
    const int h = lane >> 5, d = lane & 31;
#pragma unroll
    for (int kb = 0; kb < 2; ++kb)
#pragma unroll
        for (int sp = 0; sp < 2; ++sp) {
            const f32x16& s = kb ? s1 : s0;
            u32x4 pw; pw.x = cvt_pk_bf16(s[8 * sp + 0], s[8 * sp + 1]); pw.y = cvt_pk_bf16(s[8 * sp + 2], s[8 * sp + 3]); pw.z = cvt_pk_bf16(s[8 * sp + 4], s[8 * sp + 5]); pw.w = cvt_pk_bf16(s[8 * sp + 6], s[8 * sp + 7]);
            const bf16x8 pf = __builtin_bit_cast(bf16x8, pw);
            const int chunk = 4 * kb + 2 * sp + h;
            const bf16x8 a0 = lds128(Vt + d * 128 + ((chunk ^ (d & 7)) << 4));
            const bf16x8 a1 = lds128(Vt + (d + 32) * 128 + ((chunk ^ (d & 7)) << 4));
            o0 = __builtin_amdgcn_mfma_f32_32x32x16_bf16(a0, pf, o0, 0, 0, 0);
            o1 = __builtin_amdgcn_mfma_f32_32x32x16_bf16(a1, pf, o1, 0, 0, 0);
        }
}
__device__ __forceinline__ int key_of(int kb, int r, int h) { return 32 * kb + 16 * (r >> 3) + 8 * h + 4 * ((r >> 2) & 1) + (r & 3); }

__device__ __forceinline__ void attn_phase(lds_u8* lds, const Ctx& C) {
    const int l = C.l;
    const float lam_init = l == 0 ? 0.2f : (l == 1 ? 0.35550906759f : (l == 2 ? 0.47071301835f : 0.55605820416f));
    for (;;) {
        __syncthreads();
        unsigned char* ws = C.ws; asm volatile("" : "+s"(ws));
        const int tid = opaque_tid();
        const int lane = tid & 63, w = __builtin_amdgcn_readfirstlane(tid >> 6), h5 = lane >> 5, ql = lane & 31;
        if (tid == 0) *(LAS unsigned*)(lds + LDS_NEXT) = atomicAdd((unsigned*)(ws + WS_CTL) + 64 * (1 + l) + C.rep, 1u);
        __syncthreads();
        const int idx = (int)*(LAS unsigned*)(lds + LDS_NEXT);
        if (idx >= NUNITS) break;
        const bf16_t* qkv = (const bf16_t*)(ws + WS_QKV); const bf16_t* kcb = (const bf16_t*)(ws + WS_KC); const float* sm = (const float*)(ws + WS_LAM);
        int fam, grp, b, h, qb;
        if (idx < 128) { fam = 2; grp = 1; b = idx >> 5; h = (idx >> 3) & 3; qb = idx & 7; }
        else if (idx < 256) { const int i = idx - 128; fam = 0; grp = 1; b = i >> 5; h = (i >> 3) & 3; qb = i & 7; }
        else if (idx < 512) { const int i = idx - 256; fam = 1; grp = 1; b = i >> 6; h = (i >> 3) & 7; qb = i & 7; }
        else if (idx < 640) { const int i = idx - 512; fam = 2; grp = 0; b = i >> 2; h = i & 3; qb = 0; }
        else if (idx < 768) { const int i = idx - 640; fam = 0; grp = 0; b = i >> 2; h = i & 3; qb = 0; }
        else { const int i = idx - 768; fam = 1; grp = 0; b = i >> 3; h = i & 7; qb = 0; }
        const int T = grp ? TLAT : TCTX, Hq = fam == 1 ? 8 : 4, Hkv = fam == 1 ? 2 : 4, hk = fam == 1 ? (h >> 2) : h;
        const size_t qo = fam == 0 ? QO_QA : (fam == 1 ? QO_QB : QO_QC), ko = fam == 0 ? QO_KA : (fam == 1 ? QO_KB : QO_KC), vo = fam == 0 ? QO_VTA : (fam == 1 ? QO_VTB : QO_VTC);
        const size_t gq = fam == 1 ? GS8 : GS4, gk = fam == 1 ? GS2 : GS4;
        const int q0 = qb * 256;
        const bf16_t* Qp = qkv + qo + grp * gq + ((size_t)(b * Hq + h) * T + q0 + 32 * w + ql) * 64;
        const unsigned kso = (unsigned)(ko + grp * gk + (size_t)(b * Hkv + hk) * T * 64), vso = (unsigned)(vo + grp * gk + (size_t)(b * Hkv + hk) * 64 * T);
        const size_t cko = fam == 0 ? CO_KA : (fam == 1 ? CO_KB : CO_KCC), cvo = fam == 0 ? CO_VTA : (fam == 1 ? CO_VTB : CO_VTCC);
        const unsigned kco = (unsigned)(cko + (size_t)((l * 4 + b) * Hkv + hk) * PAST * 64), vco = (unsigned)(cvo + (size_t)((l * 4 + b) * Hkv + hk) * 64 * PAST);
        int ta, tb;
        if (!grp) { ta = 0; tb = 4; }
        else if (fam == 0) { ta = max(4 * qb - 4, 0); tb = min(max(4 * qb - 1, 0), 24) + 8; }
        else if (fam == 1) { ta = max(q0 - 128, 0) >> 6; tb = min(q0 + 384, TLAT) >> 6; }
        else { ta = 0; tb = 32; }
        const int nself = tb - ta, ntile = nself + (grp ? 8 : 0);
        const int mode = !grp ? 0 : (fam == 0 ? 1 : (fam == 1 ? 2 : 0));
        if (mode == 1 && tid < 465) *(LAS float*)(lds + LDS_RPB + 4 * tid) = sm[SM_RPB + (l * 4 + h) * 465 + tid];
        bf16x8 qf[4];
#pragma unroll
        for (int ds = 0; ds < 4; ++ds) qf[ds] = *(const bf16x8*)(Qp + 16 * ds + 8 * h5);
        const int qw0 = q0 + 32 * w;
        const int qtok = qw0 + ql, qrow = qtok >> 6, qcol = qtok & 63;
        const int r0w = min(max((qw0 >> 6) - 4, 0), 24), qsl = min(max(qcol - 8, 0), 48);
        float m0 = -1e30f, l0 = 0.f, m1 = -1e30f, l1 = 0.f;
        f32x16 oa0 = {0.f, 0.f, 0.f, 0.f, 0.f, 0.f, 0.f, 0.f, 0.f, 0.f, 0.f, 0.f, 0.f, 0.f, 0.f, 0.f}, oa1 = oa0, ob0 = oa0, ob1 = oa0;
        const int lrow = tid >> 3, lch = tid & 7; const int lds_off = lrow * 128 + ((lch ^ (lrow & 7)) << 4);
        u32x4 kreg, vreg;
        auto gload = [&](int ti) {
            const bool self = ti < nself; const int tok0 = self ? 64 * (ta + ti) : 64 * (ti - nself); const int Tkv = self ? T : PAST;
            const bf16_t* kp = (self ? qkv : kcb) + (self ? kso : kco); const bf16_t* vp = (self ? qkv : kcb) + (self ? vso : vco);
            kreg = *(const u32x4*)(kp + (size_t)(tok0 + lrow) * 64 + lch * 8);
            vreg = *(const u32x4*)(vp + (size_t)lrow * Tkv + tok0 + lch * 8);
        };
        gload(0);
        *(LAS u32x4*)(lds + lds_off) = kreg; *(LAS u32x4*)(lds + 8192 + lds_off) = vreg;
        __syncthreads();
        for (int ti = 0; ti < ntile; ++ti) {
            const lds_u8* Kt = lds + (ti & 1) * LDS_TILE; const lds_u8* Vt = Kt + 8192;
            if (ti + 1 < ntile) gload(ti + 1);
            const bool self = ti < nself; const int tok0 = 64 * (ta + ti);
            bool rel = true, msk = false;
            if (self && mode == 1) { const int kr = ta + ti; rel = (kr >= r0w) && (kr <= r0w + 7); msk = true; }
            if (self && mode == 2) { rel = (tok0 + 63 >= qw0 - 128) && (tok0 <= qw0 + 31 + 128); msk = !((tok0 >= qw0 + 31 - 128) && (tok0 + 63 <= qw0 + 128)); }
            if (rel) {
                if (fam != 2) {
                    f32x16 s0 = qk_block<4>(Kt, 0, 0, qf, lane), s1 = qk_block<4>(Kt, 1, 0, qf, lane);
                    if (msk) {
                        if (mode == 1) {
                            const int kr = ta + ti; const LAS float* bt = (const LAS float*)(lds + LDS_RPB) + (kr - qrow + 7) * 31 + 15 - qcol;
#pragma unroll
                            for (int r = 0; r < 16; ++r) {
                                const int kc0 = key_of(0, r, h5), kc1 = kc0 + 32;
                                const bool v0 = (kc0 >= qsl) && (kc0 < qsl + 16), v1 = (kc1 >= qsl) && (kc1 < qsl + 16);
                                const float b0 = bt[v0 ? kc0 : qcol], b1 = bt[v1 ? kc1 : qcol];
                                s0[r] = v0 ? s0[r] + b0 : -INFINITY; s1[r] = v1 ? s1[r] + b1 : -INFINITY;
                            }
                        } else {
#pragma unroll
                            for (int r = 0; r < 16; ++r) {
                                const int k0 = tok0 + key_of(0, r, h5), k1 = k0 + 32;
                                if (abs(k0 - qtok) > 128) s0[r] = -INFINITY;
                                if (abs(k1 - qtok) > 128) s1[r] = -INFINITY;
                            }
                        }
                    }
                    softmax_pv(s0, s1, m0, l0, oa0, oa1, Vt, lane);
                } else {
                    { f32x16 s0 = qk_block<2>(Kt, 0, 0, qf, lane), s1 = qk_block<2>(Kt, 1, 0, qf, lane); softmax_pv(s0, s1, m0, l0, oa0, oa1, Vt, lane); }
                    { f32x16 s0 = qk_block<2>(Kt, 0, 4, qf + 2, lane), s1 = qk_block<2>(Kt, 1, 4, qf + 2, lane); softmax_pv(s0, s1, m1, l1, ob0, ob1, Vt, lane); }
                }
            }
            if (ti + 1 < ntile) { lds_u8* nb = lds + ((ti + 1) & 1) * LDS_TILE; *(LAS u32x4*)(nb + lds_off) = kreg; *(LAS u32x4*)(nb + 8192 + lds_off) = vreg; }
            __syncthreads();
        }
        const int grow = (grp ? MCTX + b * TLAT : b * TCTX) + qtok;
        const int ocol = (fam == 0 ? 0 : (fam == 1 ? 256 : 768)) + 64 * h;
        bf16_t* orow = (bf16_t*)(ws + WS_O) + (size_t)grow * 1024 + ocol + 4 * h5;
        float lt0 = l0 + __shfl_xor(l0, 32);
        if (fam == 1) lt0 += __builtin_amdgcn_exp2f(sm[SM_SINK + l * 8 + h] - m0);
        const float i0 = 1.0f / lt0;
        if (fam != 2) {
#pragma unroll
            for (int g = 0; g < 4; ++g) {
                u32x2 wa, wb; wa.x = cvt_pk_bf16(oa0[4 * g] * i0, oa0[4 * g + 1] * i0); wa.y = cvt_pk_bf16(oa0[4 * g + 2] * i0, oa0[4 * g + 3] * i0);
                wb.x = cvt_pk_bf16(oa1[4 * g] * i0, oa1[4 * g + 1] * i0); wb.y = cvt_pk_bf16(oa1[4 * g + 2] * i0, oa1[4 * g + 3] * i0);
                *(u32x2*)(orow + 8 * g) = wa; *(u32x2*)(orow + 32 + 8 * g) = wb;
            }
        } else {
            const float lt1 = l1 + __shfl_xor(l1, 32); const float i1 = 1.0f / lt1; const float lam = sm[SM_LAM + l];
            float ss = 0.f;
#pragma unroll
            for (int r = 0; r < 16; ++r) { oa0[r] = oa0[r] * i0 - lam * (ob0[r] * i1); oa1[r] = oa1[r] * i0 - lam * (ob1[r] * i1); ss += oa0[r] * oa0[r] + oa1[r] * oa1[r]; }
            ss += __shfl_xor(ss, 32);
            const float rn = __builtin_amdgcn_rsqf(ss * (1.f / 64.f) + 1e-6f) * (1.0f - lam_init);
            const float* sg = sm + SM_SUBG + l * 64 + 4 * h5;
#pragma unroll
            for (int g = 0; g < 4; ++g) {
                const f32x4 ga = *(const f32x4*)(sg + 8 * g), gb = *(const f32x4*)(sg + 32 + 8 * g);
                u32x2 wa, wb; wa.x = cvt_pk_bf16(oa0[4 * g] * rn * ga[0], oa0[4 * g + 1] * rn * ga[1]); wa.y = cvt_pk_bf16(oa0[4 * g + 2] * rn * ga[2], oa0[4 * g + 3] * rn * ga[3]);
                wb.x = cvt_pk_bf16(oa1[4 * g] * rn * gb[0], oa1[4 * g + 1] * rn * gb[1]); wb.y = cvt_pk_bf16(oa1[4 * g + 2] * rn * gb[2], oa1[4 * g + 3] * rn * gb[3]);
                *(u32x2*)(orow + 8 * g) = wa; *(u32x2*)(orow + 32 + 8 * g) = wb;
            }
        }
    }
}
}
namespace misc {
typedef LAS unsigned char lds_u8;
__device__ __forceinline__ float wave_sum(float v) {
#pragma unroll
    for (int o = 1; o < 64; o <<= 1) v += __shfl_xor(v, o);
    return v;
}
__device__ const double INVB[16] = {1.0, 0.5623413251903491, 0.31622776601683794, 0.1778279410038923, 0.1, 0.05623413251903491, 0.03162277660168379, 0.01778279410038923,
                                    0.01, 0.005623413251903491, 0.0031622776601683794, 0.001778279410038923, 0.001, 0.0005623413251903491, 0.00031622776601683794, 0.0001778279410038923};
__device__ const double INVC[8] = {1.0, 0.31622776601683794, 0.1, 0.03162277660168379, 0.01, 0.0031622776601683794, 0.001, 0.00031622776601683794};
__device__ __forceinline__ void sincos_d(double a, float& c, float& s) {
    const double k = rint(a * 0.6366197723675814);
    double r = fma(-k, 1.5707963267948966, a); r = fma(-k, 6.123233995736766e-17, r);
    const double r2 = r * r;
    const double sp = r * (1.0 + r2 * (-1.0 / 6.0 + r2 * (1.0 / 120.0 + r2 * (-1.0 / 5040.0 + r2 * (1.0 / 362880.0 + r2 * (-1.0 / 39916800.0 + r2 * (1.0 / 6227020800.0)))))));
    const double cp = 1.0 + r2 * (-0.5 + r2 * (1.0 / 24.0 + r2 * (-1.0 / 720.0 + r2 * (1.0 / 40320.0 + r2 * (-1.0 / 3628800.0 + r2 * (1.0 / 479001600.0 + r2 * (-1.0 / 87178291200.0)))))));
    const int q = ((int)k) & 3;
    const double cc = (q == 0) ? cp : (q == 1) ? -sp : (q == 2) ? -cp : sp;
    const double ss = (q == 0) ? sp : (q == 1) ? cp : (q == 2) ? -sp : -cp;
    c = (float)cc; s = (float)ss;
}
__device__ __forceinline__ void transpose_item(const float* W, int K, int N, bf16_t* WT, int k0, int n0, int dst0, LAS float* scr, int lane) {
#pragma unroll 8
    for (int i = 0; i < 32; ++i) { const int kk = 2 * i + (lane >> 5); scr[kk * 33 + (lane & 31)] = W[(size_t)(k0 + kk) * N + n0 + (lane & 31)]; }
    asm volatile("s_waitcnt lgkmcnt(0)" ::: "memory");
    const int c = lane & 7;
#pragma unroll
    for (int j = 0; j < 4; ++j) { const int n = (lane >> 3) + 8 * j; const LAS float* s = scr + (8 * c) * 33 + n;
        u32x4 o; o.x = cvt_pk_bf16(s[0 * 33], s[1 * 33]); o.y = cvt_pk_bf16(s[2 * 33], s[3 * 33]); o.z = cvt_pk_bf16(s[4 * 33], s[5 * 33]); o.w = cvt_pk_bf16(s[6 * 33], s[7 * 33]);
        *(u32x4*)(WT + (size_t)(dst0 + n) * K + k0 + 8 * c) = o; }
    asm volatile("s_waitcnt lgkmcnt(0)" ::: "memory");
}
__device__ __forceinline__ void gemv5_item(const float* W, int N, int n0, const LAS float* vec, LAS float* red, const float* add, float* out, int ostride, int tid) {
    const int col = tid & 31, kq = tid >> 5; float a0 = 0.f, a1 = 0.f, a2 = 0.f, a3 = 0.f, a4 = 0.f;
    const float* wp = W + (size_t)(kq * 64) * N + n0 + col; const LAS float* vp = vec + kq * 64;
#pragma unroll 8
    for (int k = 0; k < 64; ++k) { const float w = wp[(size_t)k * N]; a0 += vp[k] * w; a1 += vp[1024 + k] * w; a2 += vp[2048 + k] * w; a3 += vp[3072 + k] * w; a4 += vp[4096 + k] * w; }
    red[(kq * 5 + 0) * 32 + col] = a0; red[(kq * 5 + 1) * 32 + col] = a1; red[(kq * 5 + 2) * 32 + col] = a2; red[(kq * 5 + 3) * 32 + col] = a3; red[(kq * 5 + 4) * 32 + col] = a4;
    __syncthreads();
    if (tid < 160) { const int b = tid >> 5, c = tid & 31; float s = add ? add[n0 + c] : 0.f;
#pragma unroll
        for (int q = 0; q < 16; ++q) s += red[(q * 5 + b) * 32 + c];
        out[(size_t)b * ostride + n0 + c] = s; }
    __syncthreads();
}

__device__ __forceinline__ void phase_pro1(lds_u8* lds, const Args& a) {
    const int tid = opaque_tid(), lane = tid & 63, wave = __builtin_amdgcn_readfirstlane(tid >> 6), G = gridDim.x;
    unsigned char* ws = a.ws;
    { LAS float* vec = (LAS float*)lds; LAS float* red = (LAS float*)(lds + 20480);
      for (int i = tid; i < 5120; i += 512) { const int b5 = i >> 10, k = i & 1023; const float v = b5 == 0 ? a.in[I_CCTX][k] : a.in[I_C][(b5 - 1) * 1024 + k]; vec[i] = v / (1.f + __expf(-v)); }
      __syncthreads();
      float* mod = (float*)(ws + WS_MOD);
      for (int it = blockIdx.x; it < 4 * 192; it += G) { const int l = it / 192, n0 = (it % 192) * 32;
          gemv5_item(a.in[I_WMOD] + (size_t)l * 1024 * 6144, 6144, n0, vec, red, a.in[I_BMOD] + l * 6144, mod + (size_t)l * 5 * 6144, 6144, tid); }
      __syncthreads(); }
    { LAS float* scr = (LAS float*)(lds + wave * 16384);
      const int gw = blockIdx.x * 8 + wave, NGW = G * 8;
      constexpr int I_IN = 16 * 72, I_OUT = 16 * 32, I_UP = 16 * 176, I_DN = 44 * 32, I_L = I_IN + I_OUT + I_UP + I_DN;
      for (int it = gw; it < 4 * I_L; it += NGW) {
          const int l = it / I_L; int r = it % I_L;
          if (r < I_IN) { const int kb = r / 72, nb = r % 72, n0 = 32 * nb; const int tile = n0 >> 8, L = n0 & 255, wc = L >> 6, bj = (L >> 5) & 1; const int dst0 = 256 * tile + 128 * bj + 32 * wc;
              transpose_item(a.in[I_WIN] + (size_t)l * 1024 * DIN, 1024, DIN, (bf16_t*)(ws + WS_WIN) + (size_t)l * DIN * 1024, 64 * kb, n0, dst0, scr, lane); continue; }
          r -= I_IN;
          if (r < I_OUT) { const int kb = r / 32, nb = r % 32; transpose_item(a.in[I_WOUT] + (size_t)l * 1024 * 1024, 1024, 1024, (bf16_t*)(ws + WS_WOUT) + (size_t)l * 1024 * 1024, 64 * kb, 32 * nb, 32 * nb, scr, lane); continue; }
          r -= I_OUT;
          if (r < I_UP) { const int kb = r / 176, nb = r % 176, n0 = 32 * nb; const int nn = n0 < DFF ? n0 : n0 - DFF; const int dst0 = 256 * (nn >> 7) + (n0 < DFF ? 0 : 128) + (nn & 127);
              transpose_item(a.in[I_WUP] + (size_t)l * 1024 * DUP, 1024, DUP, (bf16_t*)(ws + WS_WUP) + (size_t)l * DUP * 1024, 64 * kb, n0, dst0, scr, lane); continue; }
          r -= I_UP;
          { const int kb = r / 32, nb = r % 32; transpose_item(a.in[I_WDOWN] + (size_t)l * DFF * 1024, DFF, 1024, (bf16_t*)(ws + WS_WDOWN) + (size_t)l * 1024 * DFF, 64 * kb, 32 * nb, 32 * nb, scr, lane); }
      } }
    const int gtid = blockIdx.x * 512 + tid, NT = G * 512;
    { bf16_t* kc = (bf16_t*)(ws + WS_KC);
      for (int fam = 0; fam < 3; ++fam) {
          const int H = fam == 1 ? 2 : 4; const float* ck = a.in[fam == 0 ? I_CNAK : (fam == 1 ? I_CSWK : I_CDAK)]; const float* cv = a.in[fam == 0 ? I_CNAV : (fam == 1 ? I_CSWV : I_CDAV)];
          bf16_t* dk = kc + (fam == 0 ? CO_KA : (fam == 1 ? CO_KB : CO_KCC)); bf16_t* dv = kc + (fam == 0 ? CO_VTA : (fam == 1 ? CO_VTB : CO_VTCC));
          const int totk = 4 * 4 * 512 * H * 8;
          for (int i = gtid; i < totk; i += NT) { const int d8 = i & 7, hh = (i >> 3) % H, p = (i / (8 * H)) & 511, l = (i / (8 * H * 512)) & 3, b = i / (8 * H * 512 * 4);
              const float* s = ck + ((((size_t)b * 4 + l) * 512 + p) * H + hh) * 64 + d8 * 8; const f32x4 x = *(const f32x4*)s, y = *(const f32x4*)(s + 4);
              u32x4 o; o.x = cvt_pk_bf16(x[0], x[1]); o.y = cvt_pk_bf16(x[2], x[3]); o.z = cvt_pk_bf16(y[0], y[1]); o.w = cvt_pk_bf16(y[2], y[3]);
              *(u32x4*)(dk + ((((size_t)l * 4 + b) * H + hh) * 512 + p) * 64 + d8 * 8) = o; }
          const int totv = 4 * 4 * H * 64 * 64;
          for (int i = gtid; i < totv; i += NT) { const int d = i & 63, p8 = (i >> 6) & 63, hh = (i >> 12) % H, l = (i / (4096 * H)) & 3, b = i / (4096 * H * 4);
              const float* s = cv + ((((size_t)b * 4 + l) * 512 + p8 * 8) * H + hh) * 64 + d; float x[8];
#pragma unroll
              for (int j = 0; j < 8; ++j) x[j] = s[(size_t)j * H * 64];
              u32x4 o; o.x = cvt_pk_bf16(x[0], x[1]); o.y = cvt_pk_bf16(x[2], x[3]); o.z = cvt_pk_bf16(x[4], x[5]); o.w = cvt_pk_bf16(x[6], x[7]);
              *(u32x4*)(dv + ((((size_t)l * 4 + b) * H + hh) * 64 + d) * 512 + p8 * 8) = o; }
      } }
    { float* rb = (float*)(ws + WS_ROPEB); float* rc = (float*)(ws + WS_ROPEC);
      for (int i = gtid; i < 2048 * 32; i += NT) { const int t = i >> 5, j = i & 31; const double pos = (double)(j < 16 ? (t >> 6) : (t & 63)); float c, s; sincos_d(pos * INVB[j & 15], c, s); rb[2 * i] = c; rb[2 * i + 1] = s; }
      for (int i = gtid; i < 2048 * 16; i += NT) { const int t = i >> 4, j = i & 15; const double pos = (double)(j < 8 ? (t >> 6) : (t & 63)); float c, s; sincos_d(pos * INVC[j & 7], c, s); rc[2 * i] = c; rc[2 * i + 1] = s; } }
    { float* sm = (float*)(ws + WS_LAM);
      if (gtid < 4) { const int l = gtid; const float* lp = a.in[I_LAMBDA] + l * 128; float s1 = 0.f, s2 = 0.f;
          for (int i = 0; i < 32; ++i) { s1 += lp[i] * lp[32 + i]; s2 += lp[64 + i] * lp[96 + i]; }
          sm[SM_LAM + l] = expf(s1) - expf(s2) + (0.8f - 0.6f * expf(-0.3f * (float)l)); }
      for (int i = gtid; i < 1280; i += NT) { const int l = i / 320, r = i % 320; sm[SM_GAINS + i] = r < 128 ? a.in[I_NAG][l * 128 + r] : (r < 256 ? a.in[I_SWG][l * 128 + r - 128] : a.in[I_DAG][l * 64 + r - 256]); }
      for (int i = gtid; i < 7440; i += NT) sm[SM_RPB + i] = a.in[I_RPB][i] * LOG2E;
      for (int i = gtid; i < 32; i += NT) sm[SM_SINK + i] = a.in[I_SINK][i] * LOG2E;
      for (int i = gtid; i < 256; i += NT) sm[SM_SUBG + i] = a.in[I_SUBG][i];
      float* cv = (float*)(ws + WS_CONV);
      for (int i = gtid; i < 4 * 4 * DUP; i += NT) { const int c = i % DUP, j = (i / DUP) & 3, l = i / (4 * DUP); cv[i] = j < 3 ? a.in[I_CONVW][(size_t)(l * 3 + j) * DUP + c] : a.in[I_CONVB][(size_t)l * DUP + c]; } }
}
__device__ __forceinline__ void phase_pro2(lds_u8* lds, const Args& a) {
    const int tid = opaque_tid(), G = gridDim.x; unsigned char* ws = a.ws;
    const float* mod = (const float*)(ws + WS_MOD);
    const int gtid = blockIdx.x * 512 + tid, NT = G * 512;
    { float* gv = (float*)(ws + WS_GV);
      for (int i = gtid; i < 4 * 5 * 2 * 1024; i += NT) { const int c = i & 1023, which = (i >> 10) & 1, b5 = (i >> 11) % 5, l = i / 10240;
          const float g = a.in[which ? I_GFFN : I_GATTN][l * 1024 + c]; const float sc = mod[((size_t)(l * 5 + b5) * 6 + (which ? 4 : 1)) * 1024 + c]; gv[i] = g * (1.f + sc); } }
    LAS float* vec = (LAS float*)lds; LAS float* red = (LAS float*)(lds + 20480);
    for (int it = blockIdx.x; it < 4 * (72 + 176); it += G) {
        const int l = it / 248, r = it % 248; const int which = r < 72 ? 0 : 1; const int n0 = 32 * (which ? r - 72 : r);
        __syncthreads();
        for (int i = tid; i < 5120; i += 512) { const int b5 = i >> 10, k = i & 1023; vec[i] = mod[((size_t)(l * 5 + b5) * 6 + (which ? 3 : 0)) * 1024 + k]; }
        __syncthreads();
        if (!which) gemv5_item(a.in[I_WIN] + (size_t)l * 1024 * DIN, DIN, n0, vec, red, nullptr, (float*)(ws + WS_BIASIN) + (size_t)l * 5 * DIN, DIN, tid);
        else gemv5_item(a.in[I_WUP] + (size_t)l * 1024 * DUP, DUP, n0, vec, red, nullptr, (float*)(ws + WS_BIASUP) + (size_t)l * 5 * DUP, DUP, tid);
    }
}
__device__ __forceinline__ void phase_make_xa(const Args& a, int l, int which, int first) {
    const int tid = opaque_tid(), lane = tid & 63, wave = tid >> 6; unsigned char* ws = a.ws;
    const float* gv = (const float*)(ws + WS_GV); bf16_t* xa = (bf16_t*)(ws + WS_XA); float* ssq = (float*)(ws + WS_SSQ);
    for (int row = blockIdx.x * 8 + wave; row < MTOT; row += gridDim.x * 8) {
        const float* src = first ? (row < MCTX ? a.in[I_XP] + (size_t)row * 1024 : a.in[I_XS] + (size_t)(row - MCTX) * 1024) : a.out + (size_t)row * 1024;
        const float* g = gv + ((size_t)(l * 5 + row_b5(row)) * 2 + which) * 1024;
        f32x4 v[4]; float s = 0.f;
#pragma unroll
        for (int j = 0; j < 4; ++j) { v[j] = *(const f32x4*)(src + 256 * j + 4 * lane); s += (v[j][0] * v[j][0] + v[j][1] * v[j][1]) + (v[j][2] * v[j][2] + v[j][3] * v[j][3]); }
        s = wave_sum(s);
#pragma unroll
        for (int j = 0; j < 4; ++j) { if (first) *(f32x4*)(a.out + (size_t)row * 1024 + 256 * j + 4 * lane) = v[j];
            const f32x4 y = v[j] * *(const f32x4*)(g + 256 * j + 4 * lane); u32x2 w; w.x = cvt_pk_bf16(y[0], y[1]); w.y = cvt_pk_bf16(y[2], y[3]); *(u32x2*)(xa + (size_t)row * 1024 + 256 * j + 4 * lane) = w; }
        if (lane < 16) ssq[(size_t)row * 16 + lane] = lane == 0 ? s : 0.f;
    }
}
}
constexpr int LDS_BYTES = 147456;
enum Phase { PH_PRO1 = 0, PH_PRO2, PH_MAKEXA, PH_IN, PH_ATT, PH_OUT, PH_UP, PH_CONV, PH_DOWN };

__device__ __forceinline__ void run_phase(LAS unsigned char* lds, const Args& a, int ph, int l, int p1, int p2) {
    unsigned char* ws = a.ws; const int G = gridDim.x;
    switch (ph) {
    case PH_PRO1: misc::phase_pro1(lds, a); break;
    case PH_PRO2: misc::phase_pro2(lds, a); break;
    case PH_MAKEXA: misc::phase_make_xa(a, l, p1, p2); break;
    case PH_IN: {
        pg8::Gemm g{(const bf16_t*)(ws + WS_XA), (const bf16_t*)(ws + WS_WIN) + (size_t)l * DIN * 1024, MTOT, DIN, 1024}; pg8::StaticOrder S; S.init(MTOT, DIN, G, (int)blockIdx.x);
        pg8::EpiIn E{ws, a.out, l};
        pg8::gemm_phase<pg8::EpiIn, pg8::StaticOrder, true, true>(lds, g, S, E); } break;
    case PH_ATT: {
        att::Ctx C{ws, l, p1};
        att::attn_phase(lds, C); } break;
    case PH_OUT: {
        pg8::Gemm g{(const bf16_t*)(ws + WS_O), (const bf16_t*)(ws + WS_WOUT) + (size_t)l * 1024 * 1024, MTOT, 1024, 1024}; pg8::StaticOrder S; S.init(MTOT, 1024, G, (int)blockIdx.x);
        pg8::EpiRes E{ws, a.out, l, 0};
        pg8::gemm_phase<pg8::EpiRes, pg8::StaticOrder, false, true>(lds, g, S, E); } break;
    case PH_UP: {
        pg8::Gemm g{(const bf16_t*)(ws + WS_XA), (const bf16_t*)(ws + WS_WUP) + (size_t)l * DUP * 1024, MTOT, DUP, 1024}; pg8::UpOrder S; S.init_up(G, (int)blockIdx.x);
        pg8::EpiUpConv E{ws, l};
        pg8::gemm_phase<pg8::EpiUpConv, pg8::UpOrder, true, true>(lds, g, S, E); } break;
    case PH_DOWN: {
        pg8::Gemm g{(const bf16_t*)(ws + WS_ACT), (const bf16_t*)(ws + WS_WDOWN) + (size_t)l * 1024 * DFF, MTOT, 1024, DFF}; pg8::StaticOrder S; S.init(MTOT, 1024, G, (int)blockIdx.x);
        pg8::EpiRes E{ws, a.out, l, 1};
        pg8::gemm_phase<pg8::EpiRes, pg8::StaticOrder, false, true>(lds, g, S, E); } break;
    default: break;
    }
}

#define XB_TMO      128
#define XB_XCNT(j)  (256  + 64 * (j))
#define XB_XSUB(j)  (1280 + 64 * (j))
#define XB_XGEN(j)  (2304 + 64 * (j))
#define XB_TOP      3328
#define XB_TOPGEN   3392
#define XCD_BAR_WORDS 3456
#define XB_SPIN_CAP (1u << 18)
__device__ __forceinline__ unsigned xb_ld(unsigned* p)              { return __hip_atomic_load(p, __ATOMIC_RELAXED, __HIP_MEMORY_SCOPE_AGENT); }
__device__ __forceinline__ unsigned xb_add(unsigned* p, unsigned v) { return __hip_atomic_fetch_add(p, v, __ATOMIC_RELAXED, __HIP_MEMORY_SCOPE_AGENT); }
__device__ __forceinline__ unsigned xb_xcc_id() { return (unsigned)__builtin_amdgcn_s_getreg((3 << 11) | 20) & 0xFu; }
#define XB_SPIN(cond, bar) do { unsigned _sp = 0; while (cond) { __builtin_amdgcn_s_sleep(1); \
    if ((++_sp & 255u) == 0u) { if (xb_ld(&(bar)[XB_TMO])) break; if (_sp > XB_SPIN_CAP) { atomicAdd(&(bar)[XB_TMO], 1u); break; } } } } while (0)
struct XcdBarrier { unsigned* bar; unsigned x; volatile LAS unsigned* st; };
__device__ __forceinline__ XcdBarrier xcd_barrier_post(unsigned* bar, volatile LAS unsigned* st) {
    XcdBarrier b; b.bar = bar; b.x = xb_xcc_id(); b.st = st;
    if (threadIdx.x == 0) (void)xb_add(&bar[XB_XCNT(b.x)], 1u);
    return b;
}
__device__ __forceinline__ void xcd_barrier_complete(unsigned* bar, unsigned x, unsigned& nloc, unsigned& nx) {
    const unsigned G = gridDim.x * gridDim.y * gridDim.z;
    unsigned sum, cnt, mine, sp = 0u;
    for (;;) {
        sum = 0u; cnt = 0u; mine = 0u;
#pragma unroll
        for (unsigned j = 0; j < 16; ++j) { const unsigned c = xb_ld(&bar[XB_XCNT(j)]); sum += c; cnt += (c > 0u) ? 1u : 0u; mine = (j == x) ? c : mine; }
        if (sum == G) break;
        __builtin_amdgcn_s_sleep(1);
        if ((++sp & 255u) == 0u) { if (xb_ld(&bar[XB_TMO])) break; if (sp > XB_SPIN_CAP) { atomicAdd(&bar[XB_TMO], 1u); break; } }
    }
    nloc = mine > 0u ? mine : 1u; nx = cnt > 0u ? cnt : 1u;
}
__device__ __forceinline__ void xcd_barrier(const XcdBarrier& b) {
    asm volatile("s_waitcnt vmcnt(0)" ::: "memory");
    __syncthreads();
    if (threadIdx.x == 0) {
        unsigned* bar = b.bar;
        __builtin_amdgcn_s_waitcnt(0);
        unsigned nloc = b.st[0], nx = b.st[1];
        if (nloc == 0u) { xcd_barrier_complete(bar, b.x, nloc, nx); b.st[0] = nloc; b.st[1] = nx; }
        const unsigned old = xb_add(&bar[XB_XSUB(b.x)], 1u);
        const unsigned gen = old / nloc;
        if (old + 1u == (gen + 1u) * nloc) {
            __builtin_amdgcn_fence(__ATOMIC_RELEASE, "agent");
            asm volatile("s_waitcnt vmcnt(0)" ::: "memory");
            const unsigned og = xb_add(&bar[XB_TOP], 1u);
            const unsigned tg = og / nx;
            if (og + 1u == (tg + 1u) * nx) xb_add(&bar[XB_TOPGEN], 1u);
            else XB_SPIN(xb_ld(&bar[XB_TOPGEN]) == tg, bar);
            __builtin_amdgcn_fence(__ATOMIC_ACQUIRE, "agent");
            xb_add(&bar[XB_XGEN(b.x)], 1u);
            asm volatile("s_waitcnt vmcnt(0)" ::: "memory");
        } else {
            XB_SPIN(xb_ld(&bar[XB_XGEN(b.x)]) == gen, bar);
            __builtin_amdgcn_fence(__ATOMIC_ACQUIRE, "agent");
            asm volatile("s_waitcnt vmcnt(0)" ::: "memory");
        }
    }
    __syncthreads();
}
constexpr int CW_BAR = 4096;
constexpr int LDS_BARST = 131072 + 256;
__global__ void __launch_bounds__(512, 2) mk_fwd(Args a) {
    extern __shared__ __attribute__((aligned(16))) unsigned char lds_raw[];
    LAS unsigned char* lds = (LAS unsigned char*)lds_raw;
    cg::grid_group grid = cg::this_grid();
    if (threadIdx.x < 2) ((volatile LAS unsigned*)(lds + LDS_BARST))[threadIdx.x] = 0u;
    __syncthreads();
    const XcdBarrier xbar = xcd_barrier_post((unsigned*)(a.ws + WS_CTL) + CW_BAR, (volatile LAS unsigned*)(lds + LDS_BARST));
#define GSYNC() xcd_barrier(xbar)
    run_phase(lds, a, PH_PRO1, 0, 0, 0); grid.sync();
#ifndef REP_PRO
#define REP_PRO 1
#endif
#ifndef REP_IN
#define REP_IN 1
#endif
#ifndef REP_ATT
#define REP_ATT 1
#endif
#ifndef REP_UP
#define REP_UP 1
#endif
#pragma unroll 1
    for (int rep = 1; rep < REP_PRO; ++rep) { run_phase(lds, a, PH_PRO1, 0, 0, 0); GSYNC(); }
#pragma unroll 1
    for (int rep = 0; rep < REP_PRO; ++rep) { run_phase(lds, a, PH_PRO2, 0, 0, 0); GSYNC(); run_phase(lds, a, PH_MAKEXA, 0, 0, 1); GSYNC(); }
#pragma unroll 1
    for (int l = 0; l < DEPTH; ++l) {
#pragma unroll 1
        for (int rep = 0; rep < REP_IN; ++rep) { run_phase(lds, a, PH_IN, l, 0, 0); GSYNC(); }
#pragma unroll 1
        for (int rep = 0; rep < REP_ATT; ++rep) { run_phase(lds, a, PH_ATT, l, rep, 0); GSYNC(); }
        run_phase(lds, a, PH_OUT, l, 0, 0); GSYNC();
#pragma unroll 1
        for (int rep = 0; rep < REP_UP; ++rep) { run_phase(lds, a, PH_UP, l, 0, 0); GSYNC(); }
        run_phase(lds, a, PH_DOWN, l, 0, 0);
        if (l < DEPTH - 1) GSYNC();
    }
}

extern "C" void kernel_launch(void* const* d_in, const int* in_sizes, int n_in, void* d_out, int out_size, void* d_ws, size_t ws_size, hipStream_t stream) {
    static int grid = 0;
    if (grid == 0) {
        int dev = 0, cus = 0, per_cu = 0;
        (void)hipGetDevice(&dev); (void)hipDeviceGetAttribute(&cus, hipDeviceAttributeMultiprocessorCount, dev);
        (void)hipFuncSetAttribute((const void*)mk_fwd, hipFuncAttributeMaxDynamicSharedMemorySize, LDS_BYTES);
        (void)hipOccupancyMaxActiveBlocksPerMultiprocessor(&per_cu, (const void*)mk_fwd, 512, LDS_BYTES);
        if (per_cu < 1) fprintf(stderr, "kernel_launch: occupancy query reports %d blocks per CU\n", per_cu);
        grid = cus > 0 ? cus : 256;
        if (ws_size < WS_END) { fprintf(stderr, "kernel_launch: workspace too small (%zu < %zu)\n", ws_size, (size_t)WS_END); grid = -1; }
    }
    if (grid < 0) return;
    Args a{}; for (int i = 0; i < N_IN; ++i) a.in[i] = (const float*)d_in[i]; a.out = (float*)d_out; a.ws = (unsigned char*)d_ws;
    (void)hipMemsetAsync((unsigned char*)d_ws + WS_CTL, 0, 1 * MiB, stream);
    void* args[] = {&a};
    hipError_t e = hipLaunchCooperativeKernel((const void*)mk_fwd, dim3(grid), dim3(512), args, LDS_BYTES, stream);
    if (e != hipSuccess) fprintf(stderr, "cooperative launch failed: %s (grid %d)\n", hipGetErrorString(e), grid);
}
```

```cpp
#include <hip/hip_runtime.h>
#include <hip/hip_cooperative_groups.h>
#include <cstdio>
#include <cstdint>
namespace cg = cooperative_groups;

constexpr int DEPTH = 4, NCTX = 32, TCTX = 256, NLAT = 4, TLAT = 2048, PAST = 512;
constexpr int MCTX = 8192, MLAT = 8192, MTOT = 16384;
constexpr int DIN = 2304, DFF = 2816, DUP = 5632;
constexpr size_t OUT_X = 0, OUT_NAK = 16777216, OUT_NAV = 25165824, OUT_SWK = 33554432, OUT_SWV = 37748736, OUT_DAK = 41943040, OUT_DAV = 50331648, OUT_TOTAL = 58720256;
enum { I_XP = 0, I_XS, I_CNAK, I_CNAV, I_CSWK, I_CSWV, I_CDAK, I_CDAV, I_C, I_CCTX, I_GATTN, I_GFFN, I_WMOD, I_BMOD, I_WIN, I_NAG, I_RPB, I_SWG, I_SINK, I_DAG, I_LAMBDA, I_SUBG, I_WOUT, I_WUP, I_CONVW, I_CONVB, I_WDOWN, N_IN };
#define LAS __attribute__((address_space(3)))
#define GAS __attribute__((address_space(1)))
typedef unsigned short bf16_t;
typedef short bf16x8 __attribute__((ext_vector_type(8)));
typedef float f32x4 __attribute__((ext_vector_type(4)));
typedef float f32x2 __attribute__((ext_vector_type(2)));
typedef float f32x16 __attribute__((ext_vector_type(16)));
typedef unsigned u32x4 __attribute__((ext_vector_type(4)));
typedef unsigned u32x2 __attribute__((ext_vector_type(2)));
typedef __bf16 bf16x2_t __attribute__((ext_vector_type(2)));

constexpr float LOG2E = 1.4426950408889634f;
constexpr float QSCALE64 = 0.125f * LOG2E, QSCALE32 = 0.17677669529663687f * LOG2E;

__device__ __forceinline__ unsigned cvt_pk_bf16(float lo, float hi) { f32x2 v = {lo, hi}; bf16x2_t b = __builtin_convertvector(v, bf16x2_t); return __builtin_bit_cast(unsigned, b); }
__device__ __forceinline__ float bf16_to_f32(bf16_t v) { return __builtin_bit_cast(float, (unsigned)v << 16); }
__device__ __forceinline__ int row_b5(int row) { return row < MCTX ? 0 : 1 + ((row - MCTX) >> 11); }

constexpr size_t MiB = 1u << 20;
constexpr size_t WS_CTL = 0;
constexpr size_t WS_MOD = 1 * MiB;
constexpr size_t WS_GV = WS_MOD + 512 * 1024;
constexpr size_t WS_BIASIN = WS_GV + 256 * 1024;
constexpr size_t WS_BIASUP = WS_BIASIN + 256 * 1024;
constexpr size_t WS_LAM = WS_BIASUP + 512 * 1024;
constexpr int SM_LAM = 0, SM_GAINS = 64, SM_RPB = SM_GAINS + 1280, SM_SINK = SM_RPB + 7440, SM_SUBG = SM_SINK + 32, SM_END = SM_SUBG + 256;
constexpr size_t WS_ROPEB = 3 * MiB;
constexpr size_t WS_ROPEC = WS_ROPEB + 512 * 1024;
constexpr size_t WS_SSQ = 4 * MiB;
constexpr size_t WS_CONV = 5 * MiB;
constexpr size_t WS_WIN = 6 * MiB;
constexpr size_t WS_WOUT = WS_WIN + 18 * MiB;
constexpr size_t WS_WUP = WS_WOUT + 8 * MiB;
constexpr size_t WS_WDOWN = WS_WUP + 44 * MiB;
constexpr size_t WS_KC = WS_WDOWN + 22 * MiB;
constexpr size_t WS_XA = WS_KC + 20 * MiB;
constexpr size_t WS_QKV = WS_XA + 32 * MiB + 1 * MiB;
constexpr size_t WS_O = WS_QKV + 72 * MiB;
constexpr size_t WS_ACT = WS_QKV;
constexpr size_t WS_END = WS_O + 32 * MiB;
constexpr size_t GS4 = 2097152, GS8 = 4194304, GS2 = 1048576;
constexpr size_t QO_QA = 0, QO_KA = QO_QA + 2 * GS4, QO_VTA = QO_KA + 2 * GS4, QO_QB = QO_VTA + 2 * GS4, QO_KB = QO_QB + 2 * GS8, QO_VTB = QO_KB + 2 * GS2,
                 QO_QC = QO_VTB + 2 * GS2, QO_KC = QO_QC + 2 * GS4, QO_VTC = QO_KC + 2 * GS4, QO_END = QO_VTC + 2 * GS4;
static_assert(QO_END * 2 == 72 * MiB, "qkv region");
constexpr size_t CO_KA = 0, CO_VTA = CO_KA + GS4, CO_KB = CO_VTA + GS4, CO_VTB = CO_KB + GS2, CO_KCC = CO_VTB + GS2, CO_VTCC = CO_KCC + GS4;

struct Args { const float* in[N_IN]; float* out; unsigned char* ws; };
__device__ __forceinline__ int opaque_tid() { int t = threadIdx.x; asm volatile("" : "+v"(t)); return t; }

namespace pg8 {
#define PG8_LAS __attribute__((address_space(3)))
constexpr int BM = 256, BK = 64, HALF = 128, HTB = HALF * BK * 2  , STAGE_BYTES = 8 * HTB, NXCD = 8, WGM = 8;
__host__ __device__ __forceinline__ int lds_byte(int r, int c) { const int st = (r >> 4) * 2 + (c >> 5), rr = r & 15, cc = c & 31, ob = rr * 64 + cc * 2; return st * 1024 + (ob ^ (((ob >> 9) & 1) << 5)); }
__host__ __device__ __forceinline__ void stage_rc(int b, int& R, int& C) { const int st = b / 1024, sb = b % 1024, swz = sb ^ (((sb >> 9) & 1) << 5); R = (st >> 1) * 16 + swz / 64; C = (st & 1) * 32 + (swz % 64) / 2; }
__host__ __device__ __forceinline__ int perm32(int rho) { const int n = rho >> 4, i = rho & 15; return 8 * (i >> 2) + 4 * n + (i & 3); }
struct Unit { int pm, pn; };
struct Gemm { const bf16_t* A; const bf16_t* Bt; int M, N, K; };
struct StaticOrder {
    int nM, nN, nwg, G, c;
    __host__ __device__ void init(int M, int N, int G_, int c_) { nM = M / BM; nN = N / BM; nwg = nM * nN; G = G_; c = c_; }
    __host__ __device__ bool next(int i, Unit& u) const {
        const long L = (long)i * G + c; if (L >= nwg) return false;
        int wgid = (int)L; { const int q = nwg / NXCD, r = nwg % NXCD, xcd = wgid % NXCD, off = wgid / NXCD; wgid = (xcd < r ? xcd * (q + 1) : r * (q + 1) + (xcd - r) * q) + off; }
        const int nig = WGM * nN, gid = wgid / nig, fm = gid * WGM, gsz = (nM - fm) < WGM ? (nM - fm) : WGM;
        u.pm = fm + ((wgid % nig) % gsz); u.pn = (wgid % nig) / gsz; return true;
    }
    __device__ __forceinline__ void a_ready(const Unit&) const {}
    __device__ __forceinline__ void done(const Unit&) const {}
    __device__ __forceinline__ int arow0(int pm) const { return BM * pm; }
};
struct UpOrder : StaticOrder {
    __device__ __forceinline__ void init_up(int G_, int c_) { nM = 68; nN = 22; nwg = nM * nN; G = G_; c = c_; }
    __device__ __forceinline__ int arow0(int pm) const { return pm < 32 ? BM * pm : MCTX + TLAT * ((pm - 32) / 9) + 254 * ((pm - 32) % 9) - 1; }
};

template <class Epi, class Sched, bool ALIGN_EPI = false, bool SP2 = false>
__device__ __forceinline__ void gemm_phase(PG8_LAS unsigned char* lds, const Gemm g, const Sched& S, const Epi& E) {
    const int tid = opaque_tid(), wid = __builtin_amdgcn_readfirstlane(tid >> 6), lane = tid & 63, wr = wid >> 2, wc = wid & 3, fr = lane & 15, fq = lane >> 4;
    const int K = g.K, nt = K / BK;
    unsigned voffA[2], voffB[2];
#pragma unroll
    for (int i = 0; i < 2; ++i) { int R, C; stage_rc(tid * 16 + i * 8192, R, C); const int Rb = Epi::PERM ? ((R & ~31) + perm32(R & 31)) : R;
        voffA[i] = (unsigned)(R * K + C) * 2u; voffB[i] = (unsigned)(Rb * K + C) * 2u; }
    const size_t kstep = (size_t)(BK * 2);
    const size_t hstep = (size_t)HALF * K * 2;
    const size_t tstep = 2 * hstep;
    const unsigned ldsw = (unsigned)wid * 1024u;
    const int aoff = lds_byte(wr * 64 + fr, fq * 8), boff = lds_byte(wc * 32 + fr, fq * 8);
#define PG8_SA(b, h) (((b) * 2 + (h)) * HTB)
#define PG8_SB(b, h) ((4 + (b) * 2 + (h)) * HTB)
#define PG8_STAGE(bufoff, gbase, voff) do { _Pragma("unroll") for (int _i = 0; _i < 2; ++_i) \
        __builtin_amdgcn_global_load_lds((const unsigned*)((const char*)(gbase) + (voff)[_i]), (PG8_LAS unsigned*)(lds + (bufoff) + ldsw + _i * 8192), 16, 0, 0); } while (0)
#define PG8_LDA(dst, b, h) do { _Pragma("unroll") for (int m = 0; m < 4; ++m) _Pragma("unroll") for (int k = 0; k < 2; ++k) dst[m][k] = *(const PG8_LAS bf16x8*)(lds + PG8_SA(b, h) + aoff + m * 2048 + k * 1024); } while (0)
#define PG8_LDB(dst, b, h) do { _Pragma("unroll") for (int n = 0; n < 2; ++n) _Pragma("unroll") for (int k = 0; k < 2; ++k) dst[n][k] = *(const PG8_LAS bf16x8*)(lds + PG8_SB(b, h) + boff + n * 2048 + k * 1024); } while (0)
#define PG8_MMA(ai, bj, At, Bt) do { __builtin_amdgcn_s_setprio(1); _Pragma("unroll") for (int m = 0; m < 4; ++m) _Pragma("unroll") for (int n = 0; n < 2; ++n) _Pragma("unroll") for (int k = 0; k < 2; ++k) \
        acc[ai][bj][m][n] = __builtin_amdgcn_mfma_f32_16x16x32_bf16(Bt[n][k], At[m][k], acc[ai][bj][m][n], 0, 0, 0); __builtin_amdgcn_s_setprio(0); } while (0)
#define PG8_WAIT_V(n) asm volatile("s_waitcnt vmcnt(" #n ")" ::: "memory")
#define PG8_WAIT_L(n) asm volatile("s_waitcnt lgkmcnt(" #n ")" ::: "memory")
#define PG8_BAR __builtin_amdgcn_s_barrier()
#define PG8_SCHED __builtin_amdgcn_sched_barrier(0)
    Unit cur, nxt; int ui = 0;
    if (!S.next(0, cur)) return;
    f32x4 acc[2][2][4][2];
#pragma unroll
    for (int a = 0; a < 2; ++a)
#pragma unroll
        for (int b = 0; b < 2; ++b)
#pragma unroll
            for (int m = 0; m < 4; ++m)
#pragma unroll
                for (int n = 0; n < 2; ++n) acc[a][b][m][n] = (f32x4){0.f, 0.f, 0.f, 0.f};
    bf16x8 At[4][2], B0[2][2], B1[2][2];
    const size_t rstep = (size_t)K * 2;
    const char* cA = (const char*)g.A + (size_t)S.arow0(cur.pm) * rstep; const char* cB = (const char*)g.Bt + (size_t)cur.pn * tstep;
    S.a_ready(cur);
    if constexpr (SP2) {
        PG8_STAGE(PG8_SB(0, 0), cB, voffB); PG8_STAGE(PG8_SB(0, 1), cB + hstep, voffB); PG8_STAGE(PG8_SA(0, 0), cA, voffA); PG8_STAGE(PG8_SA(0, 1), cA + hstep, voffA);
        if (wr == 1) PG8_BAR;
        PG8_WAIT_V(2); PG8_BAR;
        PG8_STAGE(PG8_SB(1, 0), cB + kstep, voffB); PG8_STAGE(PG8_SA(1, 0), cA + kstep, voffA); PG8_STAGE(PG8_SB(1, 1), cB + hstep + kstep, voffB);
        PG8_WAIT_V(6); PG8_BAR;
    } else {
        PG8_STAGE(PG8_SB(0, 0), cB, voffB); PG8_STAGE(PG8_SA(0, 0), cA, voffA); PG8_STAGE(PG8_SB(0, 1), cB + hstep, voffB); PG8_STAGE(PG8_SA(0, 1), cA + hstep, voffA);
        if (wr == 1) PG8_BAR;
        PG8_WAIT_V(4); PG8_BAR;
        PG8_STAGE(PG8_SB(1, 0), cB + kstep, voffB); PG8_STAGE(PG8_SA(1, 0), cA + kstep, voffA); PG8_STAGE(PG8_SB(1, 1), cB + hstep + kstep, voffB);
        PG8_WAIT_V(6); PG8_BAR;
    }
    for (;;) {
        const bool has_next = S.next(ui + 1, nxt);
        const char* nA = has_next ? (const char*)g.A + (size_t)S.arow0(nxt.pm) * rstep : cA; const char* nB = has_next ? (const char*)g.Bt + (size_t)nxt.pn * tstep : cB;
        for (int t = 0; t < nt; t += 2) {
            const bool last = (t == nt - 2);
            const char* a1 = cA + (size_t)(t + 1) * kstep;
            const char* a2 = last ? nA : cA + (size_t)(t + 2) * kstep; const char* b2 = last ? nB : cB + (size_t)(t + 2) * kstep;
            const char* a3 = a2 + kstep; const char* b3 = b2 + kstep;
            if (last && has_next) S.a_ready(nxt);
            if constexpr (SP2) {
            PG8_LDB(B0, 0, 0); PG8_LDB(B1, 0, 1); PG8_SCHED; PG8_LDA(At, 0, 0); PG8_STAGE(PG8_SA(1, 1), a1 + hstep, voffA);
            PG8_WAIT_V(8); PG8_WAIT_L(0); PG8_BAR; PG8_MMA(0, 0, At, B0); PG8_MMA(0, 1, At, B1); PG8_BAR; PG8_SCHED;
            PG8_LDA(At, 0, 1); PG8_STAGE(PG8_SB(0, 0), b2, voffB); PG8_STAGE(PG8_SB(0, 1), b2 + hstep, voffB); PG8_STAGE(PG8_SA(0, 0), a2, voffA);
            PG8_WAIT_V(8); PG8_WAIT_L(0); PG8_BAR; PG8_MMA(1, 0, At, B0); PG8_MMA(1, 1, At, B1); PG8_BAR; PG8_SCHED;
            PG8_LDB(B0, 1, 0); PG8_LDB(B1, 1, 1); PG8_SCHED; PG8_LDA(At, 1, 0); PG8_STAGE(PG8_SA(0, 1), a2 + hstep, voffA);
            PG8_WAIT_V(8); PG8_WAIT_L(0); PG8_BAR; PG8_MMA(0, 0, At, B0); PG8_MMA(0, 1, At, B1); PG8_BAR; PG8_SCHED;
            PG8_LDA(At, 1, 1); PG8_STAGE(PG8_SB(1, 0), b3, voffB); PG8_STAGE(PG8_SB(1, 1), b3 + hstep, voffB); PG8_STAGE(PG8_SA(1, 0), a3, voffA);
            PG8_WAIT_V(8); PG8_WAIT_L(0); PG8_BAR; PG8_MMA(1, 0, At, B0); PG8_MMA(1, 1, At, B1); PG8_BAR; PG8_SCHED;
            } else {
            PG8_LDB(B0, 0, 0); PG8_SCHED; PG8_LDA(At, 0, 0); PG8_STAGE(PG8_SA(1, 1), a1 + hstep, voffA);
            PG8_WAIT_L(8); PG8_BAR; PG8_WAIT_L(0); PG8_MMA(0, 0, At, B0); PG8_BAR; PG8_SCHED;
            PG8_LDB(B1, 0, 1); PG8_STAGE(PG8_SB(0, 0), b2, voffB);
            PG8_BAR; PG8_WAIT_L(0); PG8_MMA(0, 1, At, B1); PG8_BAR;
            PG8_LDA(At, 0, 1); PG8_STAGE(PG8_SA(0, 0), a2, voffA);
            PG8_BAR; PG8_WAIT_L(0); PG8_MMA(1, 0, At, B0); PG8_BAR; PG8_SCHED;
            PG8_STAGE(PG8_SB(0, 1), b2 + hstep, voffB);
            PG8_WAIT_V(6); PG8_BAR; PG8_MMA(1, 1, At, B1); PG8_BAR;
            PG8_LDB(B0, 1, 0); PG8_SCHED; PG8_LDA(At, 1, 0); PG8_STAGE(PG8_SA(0, 1), a2 + hstep, voffA);
            PG8_WAIT_L(8); PG8_BAR; PG8_WAIT_L(0); PG8_MMA(0, 0, At, B0); PG8_BAR; PG8_SCHED;
            PG8_LDB(B1, 1, 1); PG8_STAGE(PG8_SB(1, 0), b3, voffB);
            PG8_BAR; PG8_WAIT_L(0); PG8_MMA(0, 1, At, B1); PG8_BAR;
            PG8_LDA(At, 1, 1); PG8_STAGE(PG8_SA(1, 0), a3, voffA);
            PG8_BAR; PG8_WAIT_L(0); PG8_MMA(1, 0, At, B0); PG8_BAR; PG8_SCHED;
            PG8_STAGE(PG8_SB(1, 1), b3 + hstep, voffB);
            PG8_WAIT_V(6); PG8_BAR; PG8_MMA(1, 1, At, B1); PG8_BAR;
            }
        }
        if constexpr (ALIGN_EPI) { if (wr == 0) PG8_BAR; }
        if constexpr (!Epi::AFTER_DRAIN) { if constexpr (Epi::NEEDS_LDS) E(acc, cur, wr, wc, fr, fq, lds); else E(acc, cur, wr, wc, fr, fq); S.done(cur); }
        if (!has_next) break;
#pragma unroll
        for (int a = 0; a < 2; ++a)
#pragma unroll
            for (int b = 0; b < 2; ++b)
#pragma unroll
                for (int m = 0; m < 4; ++m)
#pragma unroll
                    for (int n = 0; n < 2; ++n) acc[a][b][m][n] = (f32x4){0.f, 0.f, 0.f, 0.f};
        cur = nxt; cA = nA; cB = nB; ++ui;
        if constexpr (ALIGN_EPI) { if (wr == 1) PG8_BAR; }
    }
    PG8_WAIT_V(0);
    if constexpr (!ALIGN_EPI) { if (wr == 0) PG8_BAR; }
    PG8_BAR;
    if constexpr (Epi::AFTER_DRAIN) { E.fused(acc, cur, wr, wc, fr, fq, lds, wid, lane); S.done(cur); }
#undef PG8_SA
#undef PG8_SB
#undef PG8_STAGE
#undef PG8_LDA
#undef PG8_LDB
#undef PG8_MMA
#undef PG8_WAIT_V
#undef PG8_WAIT_L
#undef PG8_BAR
#undef PG8_SCHED
}

__device__ __forceinline__ float row_rstd(const GAS float* ssq, int row) {
    const GAS f32x4* p = (const GAS f32x4*)(ssq + (size_t)row * 16); const f32x4 a = p[0], b = p[1], c = p[2], d = p[3];
    const float s = ((a[0] + a[1]) + (a[2] + a[3])) + ((b[0] + b[1]) + (b[2] + b[3])) + ((c[0] + c[1]) + (c[2] + c[3])) + ((d[0] + d[1]) + (d[2] + d[3]));
    return __builtin_amdgcn_rsqf(s * (1.0f / 1024.0f) + 1e-6f);
}


constexpr int LDS_EDGE = 131072 + 1024;
constexpr int LDS_RSTD = LDS_EDGE + 8192;
__device__ __forceinline__ void rstd_table(PG8_LAS unsigned char* lds, const GAS float* ssq, int arow0, int wr, int wc, int fr, int fq) {
    const int tid = (wr * 4 + wc) * 64 + fq * 16 + fr, r = tid >> 1, hf = tid & 1;
    const GAS f32x4* p = (const GAS f32x4*)(ssq + (size_t)min(arow0 + r, MTOT - 1) * 16 + 8 * hf); const f32x4 a = p[0], b = p[1];
    float s = ((a[0] + a[1]) + (a[2] + a[3])) + ((b[0] + b[1]) + (b[2] + b[3])); s += __shfl_xor(s, 1);
    if (!hf) ((PG8_LAS float*)(lds + LDS_RSTD))[r] = __builtin_amdgcn_rsqf(s * (1.0f / 1024.0f) + 1e-6f);
}
#define EPI_BARRIER() do { asm volatile("s_waitcnt lgkmcnt(0)" ::: "memory"); __builtin_amdgcn_s_barrier(); asm volatile("" ::: "memory"); } while (0)

struct EpiIn {
    static constexpr bool PERM = false, AFTER_DRAIN = false, NEEDS_LDS = true;
    unsigned char* ws0; float* out; int l;
    __device__ __forceinline__ void operator()(const f32x4 (&acc)[2][2][4][2], const Unit& u, int wr, int wc, int fr_in, int fq_in, PG8_LAS unsigned char* lds) const {
        unsigned char* ws_ = ws0; asm volatile("" : "+s"(ws_));
        GAS unsigned char* ws = (GAS unsigned char*)ws_; GAS float* outg = (GAS float*)out;
        int fr = fr_in, fq = fq_in; asm volatile("" : "+v"(fr), "+v"(fq));
        const GAS float* ssq = (const GAS float*)(ws + WS_SSQ); const GAS float* bias = (const GAS float*)(ws + WS_BIASIN) + (size_t)l * 5 * DIN;
        const GAS float* gains = (const GAS float*)(ws + WS_LAM) + SM_GAINS + l * 320; const GAS float* nag = gains; const GAS float* swg = gains + 128; const GAS float* dag = gains + 256;
        const GAS float* ropeB = (const GAS float*)(ws + WS_ROPEB); const GAS float* ropeC = (const GAS float*)(ws + WS_ROPEC); GAS bf16_t* qkv = (GAS bf16_t*)(ws + WS_QKV);
        const int pm = u.pm, pn = u.pn;
        const int grp = pm >= 32 ? 1 : 0, b = grp ? ((pm - 32) >> 3) : pm, tbase = grp ? 256 * ((pm - 32) & 7) : 0, T = grp ? TLAT : TCTX, b5 = grp ? 1 + b : 0;
        int type, h;
        if (pn < 3) { type = pn; h = wc; } else if (pn < 5) { type = 3; h = 4 * (pn - 3) + wc; } else if (pn == 5) { type = wc < 2 ? 4 : 5; h = wc & 1; } else { type = pn; h = wc; }
        const bool isv = (type == 2 || type == 5 || type == 8), isq = (type == 0 || type == 3 || type == 6), is32 = (type == 6 || type == 7);
        const bool rope = grp && (type == 3 || type == 4 || type == 6 || type == 7);
        const int H = (type == 3) ? 8 : ((type == 4 || type == 5) ? 2 : 4);
        size_t dbase; const size_t gs = (type == 3) ? GS8 : ((type == 4 || type == 5) ? GS2 : GS4);
        switch (type) { case 0: dbase = QO_QA; break; case 1: dbase = QO_KA; break; case 2: dbase = QO_VTA; break; case 3: dbase = QO_QB; break; case 4: dbase = QO_KB; break; case 5: dbase = QO_VTB; break;
                        case 6: dbase = QO_QC; break; case 7: dbase = QO_KC; break; default: dbase = QO_VTC; break; }
        GAS bf16_t* dst = qkv + dbase + grp * gs + (size_t)(b * H + h) * T * 64;
        GAS float* fo = nullptr; int fow = 0, foc = 0;
        if (!grp) { switch (type) { case 1: fo = outg + OUT_NAK; fow = 256; foc = 64 * wc; break; case 2: fo = outg + OUT_NAV; fow = 256; foc = 64 * wc; break; case 4: fo = outg + OUT_SWK; fow = 128; foc = 64 * h; break;
                        case 5: fo = outg + OUT_SWV; fow = 128; foc = 64 * h; break; case 7: fo = outg + OUT_DAK; fow = 256; foc = 64 * wc; break; case 8: fo = outg + OUT_DAV; fow = 256; foc = 64 * wc; break; default: break; } }
        const GAS float* gsrc = ((type == 0) ? nag : (type == 1) ? nag + 64 : (type == 3) ? swg : (type == 4) ? swg + 64 : (type == 6) ? dag : dag + 32) + 4 * fq;
        const GAS float* bsrc = bias + b5 * DIN + pn * 256 + 64 * wc + 4 * fq;
        rstd_table(lds, ssq, 256 * pm, wr, wc, fr, fq);
        f32x4 bv[2][2], gv[2][2];
#pragma unroll
        for (int bj = 0; bj < 2; ++bj)
#pragma unroll
            for (int n = 0; n < 2; ++n) { bv[bj][n] = *(const GAS f32x4*)(bsrc + 32 * bj + 16 * n); gv[bj][n] = isv ? (f32x4){1.f, 1.f, 1.f, 1.f} : *(const GAS f32x4*)(gsrc + (is32 ? 0 : 32 * bj) + 16 * n); }
        EPI_BARRIER();
        const PG8_LAS float* RS = (const PG8_LAS float*)(lds + LDS_RSTD);
        const float qs = isq ? (is32 ? QSCALE32 : QSCALE64) : 1.0f;
#pragma unroll
        for (int ai = 0; ai < 2; ++ai)
#pragma unroll
            for (int m = 0; m < 4; ++m) {
                const int lr = 128 * ai + 64 * wr + 16 * m + fr, row = 256 * pm + lr, t = tbase + lr;
                const float rstd = RS[lr];
                float r0 = 1.f, r1 = 1.f;
                if (!isv) {
                    float s0 = 0.f, s1 = 0.f;
#pragma unroll
                    for (int n = 0; n < 2; ++n) { const f32x4 a = acc[ai][0][m][n] * rstd + bv[0][n], c = acc[ai][1][m][n] * rstd + bv[1][n];
                        s0 += (a[0] * a[0] + a[1] * a[1]) + (a[2] * a[2] + a[3] * a[3]); s1 += (c[0] * c[0] + c[1] * c[1]) + (c[2] * c[2] + c[3] * c[3]); }
                    s0 += __shfl_xor(s0, 16); s0 += __shfl_xor(s0, 32); s1 += __shfl_xor(s1, 16); s1 += __shfl_xor(s1, 32);
                    if (is32) { r0 = __builtin_amdgcn_rsqf(s0 * (1.f / 32.f) + 1e-6f); r1 = __builtin_amdgcn_rsqf(s1 * (1.f / 32.f) + 1e-6f); }
                    else { r0 = r1 = __builtin_amdgcn_rsqf((s0 + s1) * (1.f / 64.f) + 1e-6f); }
                }
                GAS float* fr_ = fo ? fo + ((size_t)(b * DEPTH + l) * 256 + t) * fow + foc + 4 * fq : nullptr;
#pragma unroll
                for (int bj = 0; bj < 2; ++bj)
#pragma unroll
                    for (int n = 0; n < 2; ++n) {
                        f32x4 x = acc[ai][bj][m][n] * rstd + bv[bj][n];
                        if (!isv) {
                            x = x * (bj ? r1 : r0) * gv[bj][n];
                            if (rope) {
                                const f32x4 cs = is32 ? *(const GAS f32x4*)(ropeC + ((size_t)t * 16 + 8 * n + 2 * fq) * 2) : *(const GAS f32x4*)(ropeB + ((size_t)t * 32 + 16 * bj + 8 * n + 2 * fq) * 2);
                                x = (f32x4){x[0] * cs[0] - x[1] * cs[1], x[0] * cs[1] + x[1] * cs[0], x[2] * cs[2] - x[3] * cs[3], x[2] * cs[3] + x[3] * cs[2]};
                            }
                        }
                        if (fr_) *(GAS f32x4*)(fr_ + 32 * bj + 16 * n) = x;
                        if (!isv) { const f32x4 y = x * qs; u32x2 w; w.x = cvt_pk_bf16(y[0], y[1]); w.y = cvt_pk_bf16(y[2], y[3]); *(GAS u32x2*)(dst + (size_t)t * 64 + 4 * fq + 32 * bj + 16 * n) = w; }
                        else { const int d0 = 32 * bj + 16 * n + 4 * fq;
#pragma unroll
                            for (int e = 0; e < 4; ++e) dst[(size_t)(d0 + e) * T + t] = (bf16_t)(cvt_pk_bf16(x[e], 0.f) & 0xffffu); }
                    }
            }
    }
};

struct EpiRes {
    static constexpr bool PERM = false, AFTER_DRAIN = false, NEEDS_LDS = false;
    unsigned char* ws0; float* x; int l; int which;
    __device__ __forceinline__ void operator()(const f32x4 (&acc)[2][2][4][2], const Unit& u, int wr, int wc, int fr, int fq) const {
        unsigned char* ws_ = ws0; asm volatile("" : "+s"(ws_)); GAS unsigned char* ws = (GAS unsigned char*)ws_; GAS float* xg = (GAS float*)x;
        const GAS float* gate = (const GAS float*)(ws + WS_MOD) + (size_t)l * 5 * 6144 + (which ? 5 : 2) * 1024;
        const GAS float* gvn = which ? (l < 3 ? (const GAS float*)(ws + WS_GV) + (size_t)(l + 1) * 10240 : nullptr) : (const GAS float*)(ws + WS_GV) + (size_t)l * 10240 + 1024;
        GAS bf16_t* xa = (GAS bf16_t*)(ws + WS_XA); GAS float* ssq = (GAS float*)(ws + WS_SSQ);
        const int pm = u.pm, pn = u.pn, b5 = pm >= 32 ? 1 + ((pm - 32) >> 3) : 0;
        const int col0 = 256 * pn + 32 * wc + 4 * fq;
        f32x4 gt[2][2], gn[2][2];
#pragma unroll
        for (int bj = 0; bj < 2; ++bj)
#pragma unroll
            for (int n = 0; n < 2; ++n) { gt[bj][n] = *(const GAS f32x4*)(gate + (size_t)b5 * 6144 + col0 + 128 * bj + 16 * n); gn[bj][n] = gvn ? *(const GAS f32x4*)(gvn + (size_t)b5 * 2048 + col0 + 128 * bj + 16 * n) : (f32x4){0.f, 0.f, 0.f, 0.f}; }
#pragma unroll
        for (int ai = 0; ai < 2; ++ai)
#pragma unroll
            for (int m = 0; m < 4; ++m) {
                const int row = 256 * pm + 128 * ai + 64 * wr + 16 * m + fr; GAS float* xr = xg + (size_t)row * 1024 + col0; float ss = 0.f;
#pragma unroll
                for (int bj = 0; bj < 2; ++bj)
#pragma unroll
                    for (int n = 0; n < 2; ++n) {
                        const f32x4 xo = *(const GAS f32x4*)(xr + 128 * bj + 16 * n); const f32x4 xn = xo + gt[bj][n] * acc[ai][bj][m][n];
                        *(GAS f32x4*)(xr + 128 * bj + 16 * n) = xn;
                        if (gvn) { ss += (xn[0] * xn[0] + xn[1] * xn[1]) + (xn[2] * xn[2] + xn[3] * xn[3]); const f32x4 y = xn * gn[bj][n]; u32x2 w; w.x = cvt_pk_bf16(y[0], y[1]); w.y = cvt_pk_bf16(y[2], y[3]);
                            *(GAS u32x2*)(xa + (size_t)row * 1024 + col0 + 128 * bj + 16 * n) = w; }
                    }
                if (gvn) { ss += __shfl_xor(ss, 16); ss += __shfl_xor(ss, 32); if (fq == 0) ssq[(size_t)row * 16 + 4 * pn + wc] = ss; }
            }
    }
};

#define DPPF(old, src, ctrl) __builtin_bit_cast(float, __builtin_amdgcn_update_dpp(__builtin_bit_cast(int, (float)(old)), __builtin_bit_cast(int, (float)(src)), (ctrl), 0xf, 0xf, false))
struct EpiUpConv {
    static constexpr bool PERM = false, AFTER_DRAIN = false, NEEDS_LDS = true;
    unsigned char* ws0; int l;
    __device__ __forceinline__ void operator()(f32x4 (&acc)[2][2][4][2], const Unit& u, int wr, int wc, int fr_in, int fq_in, PG8_LAS unsigned char* lds) const {
        unsigned char* ws_ = ws0; asm volatile("" : "+s"(ws_)); GAS unsigned char* ws = (GAS unsigned char*)ws_;
        int fr = fr_in, fq = fq_in; asm volatile("" : "+v"(fr), "+v"(fq));
        const int pm = u.pm, pn = u.pn; const int grp = pm >= 32 ? 1 : 0, bq = grp ? (pm - 32) / 9 : 0, jq = grp ? (pm - 32) % 9 : 0;
        const int T = grp ? TLAT : TCTX, tofs = grp ? 254 * jq - 1 : 0, arow0 = grp ? MCTX + TLAT * bq + tofs : 256 * pm, b5 = grp ? 1 + bq : 0;
        const GAS float* ssq = (const GAS float*)(ws + WS_SSQ); const GAS float* bias = (const GAS float*)(ws + WS_BIASUP) + (size_t)(l * 5 + b5) * DUP; const GAS float* cw = (const GAS float*)(ws + WS_CONV) + (size_t)l * 4 * DUP;
        GAS bf16_t* act = (GAS bf16_t*)(ws + WS_ACT);
        const int fcol = 128 * pn + 32 * wc + 4 * fq;
        rstd_table(lds, ssq, arow0, wr, wc, fr, fq);
        f32x4 bv[2][2];
#pragma unroll
        for (int bj = 0; bj < 2; ++bj)
#pragma unroll
            for (int n = 0; n < 2; ++n) bv[bj][n] = *(const GAS f32x4*)(bias + bj * DFF + fcol + 16 * n);
        EPI_BARRIER();
        const PG8_LAS float* RS = (const PG8_LAS float*)(lds + LDS_RSTD);
#pragma unroll
        for (int ai = 0; ai < 2; ++ai)
#pragma unroll
            for (int m = 0; m < 4; ++m) {
                const int i = 128 * ai + 64 * wr + 16 * m + fr, t = tofs + i; const bool inseq = (t >= 0) && (t < T);
                const float rstd = RS[i];
#pragma unroll
                for (int bj = 0; bj < 2; ++bj)
#pragma unroll
                    for (int n = 0; n < 2; ++n) { const f32x4 v = acc[ai][bj][m][n] * rstd + bv[bj][n]; acc[ai][bj][m][n] = inseq ? v : (f32x4){0.f, 0.f, 0.f, 0.f}; }
            }
        PG8_LAS float* E = (PG8_LAS float*)(lds + LDS_EDGE);
#pragma unroll
        for (int ai = 0; ai < 2; ++ai) { const int c = 2 * ai + wr;
#pragma unroll
            for (int bj = 0; bj < 2; ++bj)
#pragma unroll
                for (int n = 0; n < 2; ++n) { const int col = 128 * bj + 32 * wc + 16 * n + 4 * fq;
                    if (fr == 0) *(PG8_LAS f32x4*)(E + (c * 2 + 0) * 256 + col) = acc[ai][bj][0][n];
                    if (fr == 15) *(PG8_LAS f32x4*)(E + (c * 2 + 1) * 256 + col) = acc[ai][bj][3][n]; } }
        asm volatile("s_waitcnt lgkmcnt(0)" ::: "memory"); __builtin_amdgcn_s_barrier(); asm volatile("" ::: "memory");
#pragma unroll
        for (int n = 0; n < 2; ++n) {
            f32x4 w0[2], w1[2], w2[2], cb[2];
#pragma unroll
            for (int bj = 0; bj < 2; ++bj) { const GAS float* p = cw + bj * DFF + fcol + 16 * n; w0[bj] = *(const GAS f32x4*)p; w1[bj] = *(const GAS f32x4*)(p + DUP); w2[bj] = *(const GAS f32x4*)(p + 2 * DUP); cb[bj] = *(const GAS f32x4*)(p + 3 * DUP); }
#pragma unroll
            for (int ai = 0; ai < 2; ++ai) { const int c = 2 * ai + wr;
                f32x4 ep[2], en[2];
#pragma unroll
                for (int bj = 0; bj < 2; ++bj) { const int col = 128 * bj + 32 * wc + 16 * n + 4 * fq;
                    ep[bj] = c > 0 ? *(const PG8_LAS f32x4*)(E + ((c - 1) * 2 + 1) * 256 + col) : (f32x4){0.f, 0.f, 0.f, 0.f};
                    en[bj] = c < 3 ? *(const PG8_LAS f32x4*)(E + ((c + 1) * 2 + 0) * 256 + col) : (f32x4){0.f, 0.f, 0.f, 0.f}; }
#pragma unroll
                for (int m = 0; m < 4; ++m) {
                    f32x4 y[2];
#pragma unroll
                    for (int bj = 0; bj < 2; ++bj) {
                        const f32x4 x = acc[ai][bj][m][n]; f32x4 pv, nx;
#pragma unroll
                        for (int e = 0; e < 4; ++e) {
                            const float po = m > 0 ? DPPF(acc[ai][bj][m > 0 ? m - 1 : 0][n][e], acc[ai][bj][m > 0 ? m - 1 : 0][n][e], 0x121) : ep[bj][e];
                            pv[e] = DPPF(po, x[e], 0x111);
                            const float no = m < 3 ? DPPF(acc[ai][bj][m < 3 ? m + 1 : 3][n][e], acc[ai][bj][m < 3 ? m + 1 : 3][n][e], 0x12F) : en[bj][e];
                            nx[e] = DPPF(no, x[e], 0x101);
                        }
                        y[bj] = cb[bj] + w0[bj] * pv + w1[bj] * x + w2[bj] * nx;
                    }
                    const int i = 128 * ai + 64 * wr + 16 * m + fr, t = tofs + i; const bool ok = grp ? ((i >= 1) && (i <= 254) && (t < T)) : true;
                    if (ok) { f32x4 a;
#pragma unroll
                        for (int e = 0; e < 4; ++e) a[e] = y[0][e] * __builtin_amdgcn_rcpf(1.0f + __expf(-y[0][e])) * y[1][e];
                        u32x2 w; w.x = cvt_pk_bf16(a[0], a[1]); w.y = cvt_pk_bf16(a[2], a[3]);
                        *(GAS u32x2*)(act + (size_t)(arow0 + i) * DFF + fcol + 16 * n) = w; }
                }
            } }
    }
};
}
namespace att {
typedef LAS unsigned char lds_u8;
constexpr int LDS_TILE = 16384;
constexpr int LDS_RPB = 2 * LDS_TILE;
constexpr int LDS_NEXT = LDS_RPB + 2048;
constexpr int NUNITS = 1024;

struct Ctx { unsigned char* ws; int l; int rep; };

__device__ __forceinline__ bf16x8 lds128(const lds_u8* p) { return *(const LAS bf16x8*)p; }
__device__ __forceinline__ float xmax32(float v) { const auto rr = __builtin_amdgcn_permlane32_swap(__float_as_uint(v), __float_as_uint(v), false, false); return fmaxf(__uint_as_float(rr[0]), __uint_as_float(rr[1])); }
__device__ __forceinline__ float xsum32(float v) { const auto rr = __builtin_amdgcn_permlane32_swap(__float_as_uint(v), __float_as_uint(v), false, false); return __uint_as_float(rr[0]) + __uint_as_float(rr[1]); }
__device__ __forceinline__ float max3f(float a, float b, float c) { float r; asm("v_max3_f32 %0, %1, %2, %3" : "=v"(r) : "v"(a), "v"(b), "v"(c)); return r; }
__device__ __forceinline__ int sigma32(int i) { return (i & 19) | ((i & 4) << 1) | ((i & 8) >> 1); }
__device__ __forceinline__ int key_of(int kb, int r, int h) { return 32 * kb + 16 * (r >> 3) + 8 * h + 4 * ((r >> 2) & 1) + (r & 3); }

template <int NDS>
__device__ __forceinline__ void qk_tile(f32x16& s0, f32x16& s1, const lds_u8* Kt, int c0, const bf16x8* qf, int lane) {
    const int k0 = sigma32(lane & 31), h = lane >> 5; const lds_u8* b0 = Kt + k0 * 128; const lds_u8* b1 = b0 + 32 * 128; const int sw = k0 & 7;
    bf16x8 a0[NDS], a1[NDS];
#pragma unroll
    for (int ds = 0; ds < NDS; ++ds) { const int off = ((c0 + 2 * ds + h) ^ sw) << 4; a0[ds] = lds128(b0 + off); a1[ds] = lds128(b1 + off); }
    const f32x16 z = {0.f, 0.f, 0.f, 0.f, 0.f, 0.f, 0.f, 0.f, 0.f, 0.f, 0.f, 0.f, 0.f, 0.f, 0.f, 0.f};
    s0 = z; s1 = z;
#pragma unroll
    for (int ds = 0; ds < NDS; ++ds) { s0 = __builtin_amdgcn_mfma_f32_32x32x16_bf16(a0[ds], qf[ds], s0, 0, 0, 0); s1 = __builtin_amdgcn_mfma_f32_32x32x16_bf16(a1[ds], qf[ds], s1, 0, 0, 0); }
}
__device__ __forceinline__ void softmax_pv(f32x16& s0, f32x16& s1, float& m, float& l, f32x16& o0, f32x16& o1, const lds_u8* Vt, int lane) {
    float mx = max3f(s0[0], s1[0], s0[1]), my = max3f(s1[1], s0[2], s1[2]);
#pragma unroll
    for (int r = 3; r < 15; r += 2) { mx = max3f(mx, s0[r], s1[r]); my = max3f(my, s0[r + 1], s1[r + 1]); }
    mx = max3f(mx, s0[15], s1[15]); mx = fmaxf(mx, my);
    mx = xmax32(mx);
    const float mn = fmaxf(m, mx);
    if (__any(mn > m)) { const float al = __builtin_amdgcn_exp2f(m - mn); l *= al;
#pragma unroll
        for (int r = 0; r < 16; ++r) { o0[r] *= al; o1[r] *= al; }
        m = mn; }
    const int h = lane >> 5, d = lane & 31; const lds_u8* v0 = Vt + d * 128; const lds_u8* v1 = v0 + 32 * 128; const int sw = d & 7;
    bf16x8 va[4], vb[4];
#pragma unroll
    for (int c = 0; c < 4; ++c) { const int off = ((2 * c + h) ^ sw) << 4; va[c] = lds128(v0 + off); vb[c] = lds128(v1 + off); }
    float ps = 0.f, pt = 0.f;
#pragma unroll
    for (int r = 0; r < 16; ++r) { s0[r] = __builtin_amdgcn_exp2f(s0[r] - m); s1[r] = __builtin_amdgcn_exp2f(s1[r] - m); ps += s0[r]; pt += s1[r]; }
    l += ps + pt;
#pragma unroll
    for (int c = 0; c < 4; ++c) {
        const f32x16& s = (c >> 1) ? s1 : s0; const int b = 8 * (c & 1);
        u32x4 pw; pw.x = cvt_pk_bf16(s[b + 0], s[b + 1]); pw.y = cvt_pk_bf16(s[b + 2], s[b + 3]); pw.z = cvt_pk_bf16(s[b + 4], s[b + 5]); pw.w = cvt_pk_bf16(s[b + 6], s[b + 7]);
        const bf16x8 pf = __builtin_bit_cast(bf16x8, pw);
        o0 = __builtin_amdgcn_mfma_f32_32x32x16_bf16(va[c], pf, o0, 0, 0, 0);
        o1 = __builtin_amdgcn_mfma_f32_32x32x16_bf16(vb[c], pf, o1, 0, 0, 0);
    }
}

struct UnitGeo {
    const GAS bf16_t* qkv; const GAS bf16_t* kcb; unsigned kso, vso, kco, vco; int T, ta, nself, ntile, q0, grp, fam, b, h;
};
template <int MODE>
__device__ __forceinline__ void unit_loop(lds_u8* lds, const UnitGeo& U, const GAS float* sm, GAS bf16_t* Obase, int l, int tid) {
    const int lane = tid & 63, w = __builtin_amdgcn_readfirstlane(tid >> 6), h5 = lane >> 5, ql = lane & 31;
    const int T = U.T, q0 = U.q0, nself = U.nself, ntile = U.ntile, ta = U.ta;
    const int Hq = U.fam == 1 ? 8 : 4;
    const size_t qo = U.fam == 0 ? QO_QA : (U.fam == 1 ? QO_QB : QO_QC); const size_t gq = U.fam == 1 ? GS8 : GS4;
    const GAS bf16_t* Qp = U.qkv + qo + U.grp * gq + ((size_t)(U.b * Hq + U.h) * T + q0 + 32 * w + ql) * 64;
    bf16x8 qf[4];
#pragma unroll
    for (int ds = 0; ds < 4; ++ds) qf[ds] = *(const GAS bf16x8*)(Qp + 16 * ds + 8 * h5);
    const int qw0 = q0 + 32 * w, qtok = qw0 + ql, qrow = qtok >> 6, qcol = qtok & 63;
    const int r0w = min(max((qw0 >> 6) - 4, 0), 24), qsl = min(max(qcol - 8, 0), 48);
    float m0 = -1e30f, l0 = 0.f, m1 = -1e30f, l1 = 0.f;
    const f32x16 z = {0.f, 0.f, 0.f, 0.f, 0.f, 0.f, 0.f, 0.f, 0.f, 0.f, 0.f, 0.f, 0.f, 0.f, 0.f, 0.f};
    f32x16 oa0 = z, oa1 = z, ob0 = z, ob1 = z;
    const int lrow = tid >> 3, lch = tid & 7; const int lds_off = lrow * 128 + ((lch ^ (lrow & 7)) << 4);
    u32x4 kreg, vreg, kreg2, vreg2;
    auto gload = [&](int ti, u32x4& kr, u32x4& vr) {
        const bool self = ti < nself; const int tok0 = self ? 64 * (ta + ti) : 64 * (ti - nself); const int Tkv = self ? T : PAST;
        const GAS bf16_t* kp = (self ? U.qkv : U.kcb) + (self ? U.kso : U.kco); const GAS bf16_t* vp = (self ? U.qkv : U.kcb) + (self ? U.vso : U.vco);
        kr = *(const GAS u32x4*)(kp + (size_t)(tok0 + lrow) * 64 + lch * 8);
        vr = *(const GAS u32x4*)(vp + (size_t)lrow * Tkv + tok0 + lch * 8);
    };
    gload(0, kreg, vreg);
    gload(1, kreg2, vreg2);
    *(LAS u32x4*)(lds + lds_off) = kreg; *(LAS u32x4*)(lds + 8192 + lds_off) = vreg;
    kreg = kreg2; vreg = vreg2;
    __syncthreads();
    for (int ti = 0; ti < ntile; ++ti) {
        const lds_u8* Kt = lds + (ti & 1) * LDS_TILE; const lds_u8* Vt = Kt + 8192;
        if (ti + 2 < ntile) gload(ti + 2, kreg2, vreg2);
        const bool self = ti < nself; const int tok0 = 64 * (ta + ti);
        bool rel = true, msk = false;
        if (MODE == 1 && self) { const int kr = ta + ti; rel = (kr >= r0w) && (kr <= r0w + 7); msk = true; }
        if (MODE == 2 && self) { rel = (tok0 + 63 >= qw0 - 128) && (tok0 <= qw0 + 31 + 128); msk = !((tok0 >= qw0 + 31 - 128) && (tok0 + 63 <= qw0 + 128)); }
        if (rel) {
            if (MODE != 3) {
                f32x16 s0, s1; qk_tile<4>(s0, s1, Kt, 0, qf, lane);
                if (MODE == 1 && msk) {
                    const int kr = ta + ti; const LAS float* bt = (const LAS float*)(lds + LDS_RPB) + (kr - qrow + 7) * 31 + 15 - qcol;
                    float b0[16], b1[16];
#pragma unroll
                    for (int r = 0; r < 16; ++r) { const int kc0 = key_of(0, r, h5); b0[r] = bt[min(max(kc0, qsl), qsl + 15)]; b1[r] = bt[min(max(kc0 + 32, qsl), qsl + 15)]; }
#pragma unroll
                    for (int r = 0; r < 16; ++r) { const int kc0 = key_of(0, r, h5), kc1 = kc0 + 32;
                        s0[r] = ((kc0 >= qsl) && (kc0 < qsl + 16)) ? s0[r] + b0[r] : -INFINITY; s1[r] = ((kc1 >= qsl) && (kc1 < qsl + 16)) ? s1[r] + b1[r] : -INFINITY; }
                }
                if (MODE == 2 && msk) {
#pragma unroll
                    for (int r = 0; r < 16; ++r) { const int k0 = tok0 + key_of(0, r, h5), k1 = k0 + 32;
                        s0[r] = (abs(k0 - qtok) > 128) ? -INFINITY : s0[r]; s1[r] = (abs(k1 - qtok) > 128) ? -INFINITY : s1[r]; }
                }
                softmax_pv(s0, s1, m0, l0, oa0, oa1, Vt, lane);
            } else {
                { f32x16 s0, s1; qk_tile<2>(s0, s1, Kt, 0, qf, lane); softmax_pv(s0, s1, m0, l0, oa0, oa1, Vt, lane); }
                { f32x16 s0, s1; qk_tile<2>(s0, s1, Kt, 4, qf + 2, lane); softmax_pv(s0, s1, m1, l1, ob0, ob1, Vt, lane); }
            }
        }
        if (ti + 1 < ntile) { lds_u8* nb = lds + ((ti + 1) & 1) * LDS_TILE; *(LAS u32x4*)(nb + lds_off) = kreg; *(LAS u32x4*)(nb + 8192 + lds_off) = vreg; kreg = kreg2; vreg = vreg2; }
        __syncthreads();
    }
    GAS bf16_t* orow = Obase + (size_t)qtok * 1024 + 4 * h5;
    float lt0 = xsum32(l0);
    if (U.fam == 1) lt0 += __builtin_amdgcn_exp2f(sm[SM_SINK + l * 8 + U.h] - m0);
    const float i0 = 1.0f / lt0;
    if (MODE != 3) {
#pragma unroll
        for (int g = 0; g < 4; ++g) {
            u32x2 wa, wb; wa.x = cvt_pk_bf16(oa0[4 * g] * i0, oa0[4 * g + 1] * i0); wa.y = cvt_pk_bf16(oa0[4 * g + 2] * i0, oa0[4 * g + 3] * i0);
            wb.x = cvt_pk_bf16(oa1[4 * g] * i0, oa1[4 * g + 1] * i0); wb.y = cvt_pk_bf16(oa1[4 * g + 2] * i0, oa1[4 * g + 3] * i0);
            *(GAS u32x2*)(orow + 8 * g) = wa; *(GAS u32x2*)(orow + 32 + 8 * g) = wb;
        }
    } else {
        const float lam_init = l == 0 ? 0.2f : (l == 1 ? 0.35550906759f : (l == 2 ? 0.47071301835f : 0.55605820416f));
        const float lt1 = xsum32(l1); const float i1 = 1.0f / lt1; const float lam = sm[SM_LAM + l];
        float ss = 0.f;
#pragma unroll
        for (int r = 0; r < 16; ++r) { oa0[r] = oa0[r] * i0 - lam * (ob0[r] * i1); oa1[r] = oa1[r] * i0 - lam * (ob1[r] * i1); ss += oa0[r] * oa0[r] + oa1[r] * oa1[r]; }
        ss = xsum32(ss);
        const float rn = __builtin_amdgcn_rsqf(ss * (1.f / 64.f) + 1e-6f) * (1.0f - lam_init);
        const GAS float* sg = sm + SM_SUBG + l * 64 + 4 * h5;
#pragma unroll
        for (int g = 0; g < 4; ++g) {
            const f32x4 ga = *(const GAS f32x4*)(sg + 8 * g), gb = *(const GAS f32x4*)(sg + 32 + 8 * g);
            u32x2 wa, wb; wa.x = cvt_pk_bf16(oa0[4 * g] * rn * ga[0], oa0[4 * g + 1] * rn * ga[1]); wa.y = cvt_pk_bf16(oa0[4 * g + 2] * rn * ga[2], oa0[4 * g + 3] * rn * ga[3]);
            wb.x = cvt_pk_bf16(oa1[4 * g] * rn * gb[0], oa1[4 * g + 1] * rn * gb[1]); wb.y = cvt_pk_bf16(oa1[4 * g + 2] * rn * gb[2], oa1[4 * g + 3] * rn * gb[3]);
            *(GAS u32x2*)(orow + 8 * g) = wa; *(GAS u32x2*)(orow + 32 + 8 * g) = wb;
        }
    }
}

__device__ __forceinline__ void attn_phase(lds_u8* lds, const Ctx& C) {
    const int l = C.l;
    for (;;) {
        __syncthreads();
        unsigned char* ws_ = C.ws; asm volatile("" : "+s"(ws_)); GAS unsigned char* ws = (GAS unsigned char*)ws_;
        const int tid = opaque_tid();
        if (tid == 0) *(LAS unsigned*)(lds + LDS_NEXT) = __hip_atomic_fetch_add((GAS unsigned*)(ws + WS_CTL) + 64 * (1 + l) + C.rep, 1u, __ATOMIC_RELAXED, __HIP_MEMORY_SCOPE_AGENT);
        __syncthreads();
        const int idx = (int)*(LAS unsigned*)(lds + LDS_NEXT);
        if (idx >= NUNITS) break;
        const GAS float* sm = (const GAS float*)(ws + WS_LAM);
        UnitGeo U; U.qkv = (const GAS bf16_t*)(ws + WS_QKV); U.kcb = (const GAS bf16_t*)(ws + WS_KC);
        int fam, grp, b, h, qb;
        if (idx < 128) { fam = 2; grp = 1; b = idx >> 5; h = (idx >> 3) & 3; qb = idx & 7; }
        else if (idx < 256) { const int i = idx - 128; fam = 0; grp = 1; b = i >> 5; h = (i >> 3) & 3; qb = i & 7; }
        else if (idx < 512) { const int i = idx - 256; fam = 1; grp = 1; b = i >> 6; h = (i >> 3) & 7; qb = i & 7; }
        else if (idx < 640) { const int i = idx - 512; fam = 2; grp = 0; b = i >> 2; h = i & 3; qb = 0; }
        else if (idx < 768) { const int i = idx - 640; fam = 0; grp = 0; b = i >> 2; h = i & 3; qb = 0; }
        else { const int i = idx - 768; fam = 1; grp = 0; b = i >> 3; h = i & 7; qb = 0; }
        const int T = grp ? TLAT : TCTX, Hkv = fam == 1 ? 2 : 4, hk = fam == 1 ? (h >> 2) : h;
        const size_t ko = fam == 0 ? QO_KA : (fam == 1 ? QO_KB : QO_KC), vo = fam == 0 ? QO_VTA : (fam == 1 ? QO_VTB : QO_VTC); const size_t gk = fam == 1 ? GS2 : GS4;
        const int q0 = qb * 256;
        U.kso = (unsigned)(ko + grp * gk + (size_t)(b * Hkv + hk) * T * 64); U.vso = (unsigned)(vo + grp * gk + (size_t)(b * Hkv + hk) * 64 * T);
        const size_t cko = fam == 0 ? CO_KA : (fam == 1 ? CO_KB : CO_KCC), cvo = fam == 0 ? CO_VTA : (fam == 1 ? CO_VTB : CO_VTCC);
        U.kco = (unsigned)(cko + (size_t)((l * 4 + b) * Hkv + hk) * PAST * 64); U.vco = (unsigned)(cvo + (size_t)((l * 4 + b) * Hkv + hk) * 64 * PAST);
        int ta, tb;
        if (!grp) { ta = 0; tb = 4; }
        else if (fam == 0) { ta = max(4 * qb - 4, 0); tb = min(max(4 * qb - 1, 0), 24) + 8; }
        else if (fam == 1) { ta = max(q0 - 128, 0) >> 6; tb = min(q0 + 384, TLAT) >> 6; }
        else { ta = 0; tb = 32; }
        U.T = T; U.ta = ta; U.nself = tb - ta; U.ntile = U.nself + (grp ? 8 : 0); U.q0 = q0; U.grp = grp; U.fam = fam; U.b = b; U.h = h;
        GAS bf16_t* Obase = (GAS bf16_t*)(ws + WS_O) + (size_t)((grp ? MCTX + b * TLAT : b * TCTX)) * 1024 + (fam == 0 ? 0 : (fam == 1 ? 256 : 768)) + 64 * h;
        if (fam == 2) unit_loop<3>(lds, U, sm, Obase, l, tid);
        else if (!grp) unit_loop<0>(lds, U, sm, Obase, l, tid);
        else if (fam == 0) { if (tid < 465) *(LAS float*)(lds + LDS_RPB + 4 * tid) = sm[SM_RPB + (l * 4 + h) * 465 + tid]; unit_loop<1>(lds, U, sm, Obase, l, tid); }
        else unit_loop<2>(lds, U, sm, Obase, l, tid);
    }
}
}
namespace misc {
typedef LAS unsigned char lds_u8;
__device__ __forceinline__ float wave_sum(float v) {
#pragma unroll
    for (int o = 1; o < 64; o <<= 1) v += __shfl_xor(v, o);
    return v;
}
__device__ const double INVB[16] = {1.0, 0.5623413251903491, 0.31622776601683794, 0.1778279410038923, 0.1, 0.05623413251903491, 0.03162277660168379, 0.01778279410038923,
                                    0.01, 0.005623413251903491, 0.0031622776601683794, 0.001778279410038923, 0.001, 0.0005623413251903491, 0.00031622776601683794, 0.0001778279410038923};
__device__ const double INVC[8] = {1.0, 0.31622776601683794, 0.1, 0.03162277660168379, 0.01, 0.0031622776601683794, 0.001, 0.00031622776601683794};
__device__ __forceinline__ void sincos_d(double a, float& c, float& s) {
    const double k = rint(a * 0.6366197723675814);
    double r = fma(-k, 1.5707963267948966, a); r = fma(-k, 6.123233995736766e-17, r);
    const double r2 = r * r;
    const double sp = r * (1.0 + r2 * (-1.0 / 6.0 + r2 * (1.0 / 120.0 + r2 * (-1.0 / 5040.0 + r2 * (1.0 / 362880.0 + r2 * (-1.0 / 39916800.0 + r2 * (1.0 / 6227020800.0)))))));
    const double cp = 1.0 + r2 * (-0.5 + r2 * (1.0 / 24.0 + r2 * (-1.0 / 720.0 + r2 * (1.0 / 40320.0 + r2 * (-1.0 / 3628800.0 + r2 * (1.0 / 479001600.0 + r2 * (-1.0 / 87178291200.0)))))));
    const int q = ((int)k) & 3;
    const double cc = (q == 0) ? cp : (q == 1) ? -sp : (q == 2) ? -cp : sp;
    const double ss = (q == 0) ? sp : (q == 1) ? cp : (q == 2) ? -sp : -cp;
    c = (float)cc; s = (float)ss;
}
__device__ __forceinline__ void transpose_item(const float* W, int K, int N, bf16_t* WT, int k0, int n0, int dst0, LAS float* scr, int lane) {
#pragma unroll 8
    for (int i = 0; i < 32; ++i) { const int kk = 2 * i + (lane >> 5); scr[kk * 33 + (lane & 31)] = W[(size_t)(k0 + kk) * N + n0 + (lane & 31)]; }
    asm volatile("s_waitcnt lgkmcnt(0)" ::: "memory");
    const int c = lane & 7;
#pragma unroll
    for (int j = 0; j < 4; ++j) { const int n = (lane >> 3) + 8 * j; const LAS float* s = scr + (8 * c) * 33 + n;
        u32x4 o; o.x = cvt_pk_bf16(s[0 * 33], s[1 * 33]); o.y = cvt_pk_bf16(s[2 * 33], s[3 * 33]); o.z = cvt_pk_bf16(s[4 * 33], s[5 * 33]); o.w = cvt_pk_bf16(s[6 * 33], s[7 * 33]);
        *(u32x4*)(WT + (size_t)(dst0 + n) * K + k0 + 8 * c) = o; }
    asm volatile("s_waitcnt lgkmcnt(0)" ::: "memory");
}
__device__ __forceinline__ void gemv5_item(const float* W, int N, int n0, const LAS float* vec, LAS float* red, const float* add, float* out, int ostride, int tid) {
    const int col = tid & 31, kq = tid >> 5; float a0 = 0.f, a1 = 0.f, a2 = 0.f, a3 = 0.f, a4 = 0.f;
    const float* wp = W + (size_t)(kq * 64) * N + n0 + col; const LAS float* vp = vec + kq * 64;
#pragma unroll 8
    for (int k = 0; k < 64; ++k) { const float w = wp[(size_t)k * N]; a0 += vp[k] * w; a1 += vp[1024 + k] * w; a2 += vp[2048 + k] * w; a3 += vp[3072 + k] * w; a4 += vp[4096 + k] * w; }
    red[(kq * 5 + 0) * 32 + col] = a0; red[(kq * 5 + 1) * 32 + col] = a1; red[(kq * 5 + 2) * 32 + col] = a2; red[(kq * 5 + 3) * 32 + col] = a3; red[(kq * 5 + 4) * 32 + col] = a4;
    __syncthreads();
    if (tid < 160) { const int b = tid >> 5, c = tid & 31; float s = add ? add[n0 + c] : 0.f;
#pragma unroll
        for (int q = 0; q < 16; ++q) s += red[(q * 5 + b) * 32 + c];
        out[(size_t)b * ostride + n0 + c] = s; }
    __syncthreads();
}

__device__ __forceinline__ void phase_pro1(lds_u8* lds, const Args& a) {
    const int tid = opaque_tid(), lane = tid & 63, wave = __builtin_amdgcn_readfirstlane(tid >> 6), G = gridDim.x;
    unsigned char* ws = a.ws;
    { LAS float* vec = (LAS float*)lds; LAS float* red = (LAS float*)(lds + 20480);
      for (int i = tid; i < 5120; i += 512) { const int b5 = i >> 10, k = i & 1023; const float v = b5 == 0 ? a.in[I_CCTX][k] : a.in[I_C][(b5 - 1) * 1024 + k]; vec[i] = v / (1.f + __expf(-v)); }
      __syncthreads();
      float* mod = (float*)(ws + WS_MOD);
      for (int it = blockIdx.x; it < 4 * 192; it += G) { const int l = it / 192, n0 = (it % 192) * 32;
          gemv5_item(a.in[I_WMOD] + (size_t)l * 1024 * 6144, 6144, n0, vec, red, a.in[I_BMOD] + l * 6144, mod + (size_t)l * 5 * 6144, 6144, tid); }
      __syncthreads(); }
    { LAS float* scr = (LAS float*)(lds + wave * 16384);
      const int gw = blockIdx.x * 8 + wave, NGW = G * 8;
      constexpr int I_IN = 16 * 72, I_OUT = 16 * 32, I_UP = 16 * 176, I_DN = 44 * 32, I_L = I_IN + I_OUT + I_UP + I_DN;
      for (int it = gw; it < 4 * I_L; it += NGW) {
          const int l = it / I_L; int r = it % I_L;
          if (r < I_IN) { const int kb = r / 72, nb = r % 72, n0 = 32 * nb; const int tile = n0 >> 8, L = n0 & 255, wc = L >> 6, bj = (L >> 5) & 1; const int dst0 = 256 * tile + 128 * bj + 32 * wc;
              transpose_item(a.in[I_WIN] + (size_t)l * 1024 * DIN, 1024, DIN, (bf16_t*)(ws + WS_WIN) + (size_t)l * DIN * 1024, 64 * kb, n0, dst0, scr, lane); continue; }
          r -= I_IN;
          if (r < I_OUT) { const int kb = r / 32, nb = r % 32; transpose_item(a.in[I_WOUT] + (size_t)l * 1024 * 1024, 1024, 1024, (bf16_t*)(ws + WS_WOUT) + (size_t)l * 1024 * 1024, 64 * kb, 32 * nb, 32 * nb, scr, lane); continue; }
          r -= I_OUT;
          if (r < I_UP) { const int kb = r / 176, nb = r % 176, n0 = 32 * nb; const int nn = n0 < DFF ? n0 : n0 - DFF; const int dst0 = 256 * (nn >> 7) + (n0 < DFF ? 0 : 128) + (nn & 127);
              transpose_item(a.in[I_WUP] + (size_t)l * 1024 * DUP, 1024, DUP, (bf16_t*)(ws + WS_WUP) + (size_t)l * DUP * 1024, 64 * kb, n0, dst0, scr, lane); continue; }
          r -= I_UP;
          { const int kb = r / 32, nb = r % 32; transpose_item(a.in[I_WDOWN] + (size_t)l * DFF * 1024, DFF, 1024, (bf16_t*)(ws + WS_WDOWN) + (size_t)l * 1024 * DFF, 64 * kb, 32 * nb, 32 * nb, scr, lane); }
      } }
    const int gtid = blockIdx.x * 512 + tid, NT = G * 512;
    { bf16_t* kc = (bf16_t*)(ws + WS_KC);
      for (int fam = 0; fam < 3; ++fam) {
          const int H = fam == 1 ? 2 : 4; const float* ck = a.in[fam == 0 ? I_CNAK : (fam == 1 ? I_CSWK : I_CDAK)]; const float* cv = a.in[fam == 0 ? I_CNAV : (fam == 1 ? I_CSWV : I_CDAV)];
          bf16_t* dk = kc + (fam == 0 ? CO_KA : (fam == 1 ? CO_KB : CO_KCC)); bf16_t* dv = kc + (fam == 0 ? CO_VTA : (fam == 1 ? CO_VTB : CO_VTCC));
          const int totk = 4 * 4 * 512 * H * 8;
          for (int i = gtid; i < totk; i += NT) { const int d8 = i & 7, hh = (i >> 3) % H, p = (i / (8 * H)) & 511, l = (i / (8 * H * 512)) & 3, b = i / (8 * H * 512 * 4);
              const float* s = ck + ((((size_t)b * 4 + l) * 512 + p) * H + hh) * 64 + d8 * 8; const f32x4 x = *(const f32x4*)s, y = *(const f32x4*)(s + 4);
              u32x4 o; o.x = cvt_pk_bf16(x[0], x[1]); o.y = cvt_pk_bf16(x[2], x[3]); o.z = cvt_pk_bf16(y[0], y[1]); o.w = cvt_pk_bf16(y[2], y[3]);
              *(u32x4*)(dk + ((((size_t)l * 4 + b) * H + hh) * 512 + p) * 64 + d8 * 8) = o; }
          const int totv = 4 * 4 * H * 64 * 64;
          for (int i = gtid; i < totv; i += NT) { const int d = i & 63, p8 = (i >> 6) & 63, hh = (i >> 12) % H, l = (i / (4096 * H)) & 3, b = i / (4096 * H * 4);
              const float* s = cv + ((((size_t)b * 4 + l) * 512 + p8 * 8) * H + hh) * 64 + d; float x[8];
#pragma unroll
              for (int j = 0; j < 8; ++j) x[j] = s[(size_t)j * H * 64];
              u32x4 o; o.x = cvt_pk_bf16(x[0], x[1]); o.y = cvt_pk_bf16(x[2], x[3]); o.z = cvt_pk_bf16(x[4], x[5]); o.w = cvt_pk_bf16(x[6], x[7]);
              *(u32x4*)(dv + ((((size_t)l * 4 + b) * H + hh) * 64 + d) * 512 + p8 * 8) = o; }
      } }
    { float* rb = (float*)(ws + WS_ROPEB); float* rc = (float*)(ws + WS_ROPEC);
      for (int i = gtid; i < 2048 * 32; i += NT) { const int t = i >> 5, j = i & 31; const double pos = (double)(j < 16 ? (t >> 6) : (t & 63)); float c, s; sincos_d(pos * INVB[j & 15], c, s); rb[2 * i] = c; rb[2 * i + 1] = s; }
      for (int i = gtid; i < 2048 * 16; i += NT) { const int t = i >> 4, j = i & 15; const double pos = (double)(j < 8 ? (t >> 6) : (t & 63)); float c, s; sincos_d(pos * INVC[j & 7], c, s); rc[2 * i] = c; rc[2 * i + 1] = s; } }
    { float* sm = (float*)(ws + WS_LAM);
      if (gtid < 4) { const int l = gtid; const float* lp = a.in[I_LAMBDA] + l * 128; float s1 = 0.f, s2 = 0.f;
          for (int i = 0; i < 32; ++i) { s1 += lp[i] * lp[32 + i]; s2 += lp[64 + i] * lp[96 + i]; }
          sm[SM_LAM + l] = expf(s1) - expf(s2) + (0.8f - 0.6f * expf(-0.3f * (float)l)); }
      for (int i = gtid; i < 1280; i += NT) { const int l = i / 320, r = i % 320; sm[SM_GAINS + i] = r < 128 ? a.in[I_NAG][l * 128 + r] : (r < 256 ? a.in[I_SWG][l * 128 + r - 128] : a.in[I_DAG][l * 64 + r - 256]); }
      for (int i = gtid; i < 7440; i += NT) sm[SM_RPB + i] = a.in[I_RPB][i] * LOG2E;
      for (int i = gtid; i < 32; i += NT) sm[SM_SINK + i] = a.in[I_SINK][i] * LOG2E;
      for (int i = gtid; i < 256; i += NT) sm[SM_SUBG + i] = a.in[I_SUBG][i];
      float* cv = (float*)(ws + WS_CONV);
      for (int i = gtid; i < 4 * 4 * DUP; i += NT) { const int c = i % DUP, j = (i / DUP) & 3, l = i / (4 * DUP); cv[i] = j < 3 ? a.in[I_CONVW][(size_t)(l * 3 + j) * DUP + c] : a.in[I_CONVB][(size_t)l * DUP + c]; } }
}
__device__ __forceinline__ void phase_pro2(lds_u8* lds, const Args& a) {
    const int tid = opaque_tid(), G = gridDim.x; unsigned char* ws = a.ws;
    const float* mod = (const float*)(ws + WS_MOD);
    const int gtid = blockIdx.x * 512 + tid, NT = G * 512;
    { float* gv = (float*)(ws + WS_GV);
      for (int i = gtid; i < 4 * 5 * 2 * 1024; i += NT) { const int c = i & 1023, which = (i >> 10) & 1, b5 = (i >> 11) % 5, l = i / 10240;
          const float g = a.in[which ? I_GFFN : I_GATTN][l * 1024 + c]; const float sc = mod[((size_t)(l * 5 + b5) * 6 + (which ? 4 : 1)) * 1024 + c]; gv[i] = g * (1.f + sc); } }
    LAS float* vec = (LAS float*)lds; LAS float* red = (LAS float*)(lds + 20480);
    for (int it = blockIdx.x; it < 4 * (72 + 176); it += G) {
        const int l = it / 248, r = it % 248; const int which = r < 72 ? 0 : 1; const int n0 = 32 * (which ? r - 72 : r);
        __syncthreads();
        for (int i = tid; i < 5120; i += 512) { const int b5 = i >> 10, k = i & 1023; vec[i] = mod[((size_t)(l * 5 + b5) * 6 + (which ? 3 : 0)) * 1024 + k]; }
        __syncthreads();
        if (!which) gemv5_item(a.in[I_WIN] + (size_t)l * 1024 * DIN, DIN, n0, vec, red, nullptr, (float*)(ws + WS_BIASIN) + (size_t)l * 5 * DIN, DIN, tid);
        else gemv5_item(a.in[I_WUP] + (size_t)l * 1024 * DUP, DUP, n0, vec, red, nullptr, (float*)(ws + WS_BIASUP) + (size_t)l * 5 * DUP, DUP, tid);
    }
}
__device__ __forceinline__ void phase_make_xa(const Args& a, int l, int which, int first) {
    const int tid = opaque_tid(), lane = tid & 63, wave = tid >> 6; unsigned char* ws = a.ws;
    const float* gv = (const float*)(ws + WS_GV); bf16_t* xa = (bf16_t*)(ws + WS_XA); float* ssq = (float*)(ws + WS_SSQ);
    for (int row = blockIdx.x * 8 + wave; row < MTOT; row += gridDim.x * 8) {
        const float* src = first ? (row < MCTX ? a.in[I_XP] + (size_t)row * 1024 : a.in[I_XS] + (size_t)(row - MCTX) * 1024) : a.out + (size_t)row * 1024;
        const float* g = gv + ((size_t)(l * 5 + row_b5(row)) * 2 + which) * 1024;
        f32x4 v[4]; float s = 0.f;
#pragma unroll
        for (int j = 0; j < 4; ++j) { v[j] = *(const f32x4*)(src + 256 * j + 4 * lane); s += (v[j][0] * v[j][0] + v[j][1] * v[j][1]) + (v[j][2] * v[j][2] + v[j][3] * v[j][3]); }
        s = wave_sum(s);
#pragma unroll
        for (int j = 0; j < 4; ++j) { if (first) *(f32x4*)(a.out + (size_t)row * 1024 + 256 * j + 4 * lane) = v[j];
            const f32x4 y = v[j] * *(const f32x4*)(g + 256 * j + 4 * lane); u32x2 w; w.x = cvt_pk_bf16(y[0], y[1]); w.y = cvt_pk_bf16(y[2], y[3]); *(u32x2*)(xa + (size_t)row * 1024 + 256 * j + 4 * lane) = w; }
        if (lane < 16) ssq[(size_t)row * 16 + lane] = lane == 0 ? s : 0.f;
    }
}
}
constexpr int LDS_BYTES = 147456;
enum Phase { PH_PRO1 = 0, PH_PRO2, PH_MAKEXA, PH_IN, PH_ATT, PH_OUT, PH_UP, PH_CONV, PH_DOWN };

__device__ __forceinline__ void run_phase(LAS unsigned char* lds, const Args& a, int ph, int l, int p1, int p2) {
    unsigned char* ws = a.ws; const int G = gridDim.x;
    switch (ph) {
    case PH_PRO1: misc::phase_pro1(lds, a); break;
    case PH_PRO2: misc::phase_pro2(lds, a); break;
    case PH_MAKEXA: misc::phase_make_xa(a, l, p1, p2); break;
    case PH_IN: {
        pg8::Gemm g{(const bf16_t*)(ws + WS_XA), (const bf16_t*)(ws + WS_WIN) + (size_t)l * DIN * 1024, MTOT, DIN, 1024}; pg8::StaticOrder S; S.init(MTOT, DIN, G, (int)blockIdx.x);
        pg8::EpiIn E{ws, a.out, l};
        pg8::gemm_phase<pg8::EpiIn, pg8::StaticOrder, true, true>(lds, g, S, E); } break;
    case PH_ATT: {
        att::Ctx C{ws, l, p1};
        att::attn_phase(lds, C); } break;
    case PH_OUT: {
        pg8::Gemm g{(const bf16_t*)(ws + WS_O), (const bf16_t*)(ws + WS_WOUT) + (size_t)l * 1024 * 1024, MTOT, 1024, 1024}; pg8::StaticOrder S; S.init(MTOT, 1024, G, (int)blockIdx.x);
        pg8::EpiRes E{ws, a.out, l, 0};
        pg8::gemm_phase<pg8::EpiRes, pg8::StaticOrder, false, true>(lds, g, S, E); } break;
    case PH_UP: {
        pg8::Gemm g{(const bf16_t*)(ws + WS_XA), (const bf16_t*)(ws + WS_WUP) + (size_t)l * DUP * 1024, MTOT, DUP, 1024}; pg8::UpOrder S; S.init_up(G, (int)blockIdx.x);
        pg8::EpiUpConv E{ws, l};
        pg8::gemm_phase<pg8::EpiUpConv, pg8::UpOrder, true, true>(lds, g, S, E); } break;
    case PH_DOWN: {
        pg8::Gemm g{(const bf16_t*)(ws + WS_ACT), (const bf16_t*)(ws + WS_WDOWN) + (size_t)l * 1024 * DFF, MTOT, 1024, DFF}; pg8::StaticOrder S; S.init(MTOT, 1024, G, (int)blockIdx.x);
        pg8::EpiRes E{ws, a.out, l, 1};
        pg8::gemm_phase<pg8::EpiRes, pg8::StaticOrder, false, true>(lds, g, S, E); } break;
    default: break;
    }
}

#define XB_TMO      128
#define XB_XCNT(j)  (256  + 64 * (j))
#define XB_XSUB(j)  (1280 + 64 * (j))
#define XB_XGEN(j)  (2304 + 64 * (j))
#define XB_TOP      3328
#define XB_TOPGEN   3392
#define XCD_BAR_WORDS 3456
#define XB_SPIN_CAP (1u << 18)
__device__ __forceinline__ unsigned xb_ld(unsigned* p)              { return __hip_atomic_load(p, __ATOMIC_RELAXED, __HIP_MEMORY_SCOPE_AGENT); }
__device__ __forceinline__ unsigned xb_add(unsigned* p, unsigned v) { return __hip_atomic_fetch_add(p, v, __ATOMIC_RELAXED, __HIP_MEMORY_SCOPE_AGENT); }
__device__ __forceinline__ unsigned xb_xcc_id() { return (unsigned)__builtin_amdgcn_s_getreg((3 << 11) | 20) & 0xFu; }
#define XB_SPIN(cond, bar) do { unsigned _sp = 0; while (cond) { __builtin_amdgcn_s_sleep(1); \
    if ((++_sp & 255u) == 0u) { if (xb_ld(&(bar)[XB_TMO])) break; if (_sp > XB_SPIN_CAP) { atomicAdd(&(bar)[XB_TMO], 1u); break; } } } } while (0)
struct XcdBarrier { unsigned* bar; unsigned x; volatile LAS unsigned* st; };
__device__ __forceinline__ XcdBarrier xcd_barrier_post(unsigned* bar, volatile LAS unsigned* st) {
    XcdBarrier b; b.bar = bar; b.x = xb_xcc_id(); b.st = st;
    if (threadIdx.x == 0) (void)xb_add(&bar[XB_XCNT(b.x)], 1u);
    return b;
}
__device__ __forceinline__ void xcd_barrier_complete(unsigned* bar, unsigned x, unsigned& nloc, unsigned& nx) {
    const unsigned G = gridDim.x * gridDim.y * gridDim.z;
    unsigned sum, cnt, mine, sp = 0u;
    for (;;) {
        sum = 0u; cnt = 0u; mine = 0u;
#pragma unroll
        for (unsigned j = 0; j < 16; ++j) { const unsigned c = xb_ld(&bar[XB_XCNT(j)]); sum += c; cnt += (c > 0u) ? 1u : 0u; mine = (j == x) ? c : mine; }
        if (sum == G) break;
        __builtin_amdgcn_s_sleep(1);
        if ((++sp & 255u) == 0u) { if (xb_ld(&bar[XB_TMO])) break; if (sp > XB_SPIN_CAP) { atomicAdd(&bar[XB_TMO], 1u); break; } }
    }
    nloc = mine > 0u ? mine : 1u; nx = cnt > 0u ? cnt : 1u;
}
__device__ __forceinline__ void xcd_barrier(const XcdBarrier& b) {
    asm volatile("s_waitcnt vmcnt(0)" ::: "memory");
    __syncthreads();
    if (threadIdx.x == 0) {
        unsigned* bar = b.bar;
        __builtin_amdgcn_s_waitcnt(0);
        unsigned nloc = b.st[0], nx = b.st[1];
        if (nloc == 0u) { xcd_barrier_complete(bar, b.x, nloc, nx); b.st[0] = nloc; b.st[1] = nx; }
        const unsigned old = xb_add(&bar[XB_XSUB(b.x)], 1u);
        const unsigned gen = old / nloc;
        if (old + 1u == (gen + 1u) * nloc) {
            __builtin_amdgcn_fence(__ATOMIC_RELEASE, "agent");
            asm volatile("s_waitcnt vmcnt(0)" ::: "memory");
            const unsigned og = xb_add(&bar[XB_TOP], 1u);
            const unsigned tg = og / nx;
            if (og + 1u == (tg + 1u) * nx) xb_add(&bar[XB_TOPGEN], 1u);
            else XB_SPIN(xb_ld(&bar[XB_TOPGEN]) == tg, bar);
            __builtin_amdgcn_fence(__ATOMIC_ACQUIRE, "agent");
            xb_add(&bar[XB_XGEN(b.x)], 1u);
            asm volatile("s_waitcnt vmcnt(0)" ::: "memory");
        } else {
            XB_SPIN(xb_ld(&bar[XB_XGEN(b.x)]) == gen, bar);
            __builtin_amdgcn_fence(__ATOMIC_ACQUIRE, "agent");
            asm volatile("s_waitcnt vmcnt(0)" ::: "memory");
        }
    }
    __syncthreads();
}
constexpr int CW_BAR = 4096;
constexpr int LDS_BARST = 131072 + 256;
__global__ void __launch_bounds__(512, 2) mk_fwd(Args a) {
    extern __shared__ __attribute__((aligned(16))) unsigned char lds_raw[];
    LAS unsigned char* lds = (LAS unsigned char*)lds_raw;
    cg::grid_group grid = cg::this_grid();
    if (threadIdx.x < 2) ((volatile LAS unsigned*)(lds + LDS_BARST))[threadIdx.x] = 0u;
    __syncthreads();
    const XcdBarrier xbar = xcd_barrier_post((unsigned*)(a.ws + WS_CTL) + CW_BAR, (volatile LAS unsigned*)(lds + LDS_BARST));
#define GSYNC() xcd_barrier(xbar)
    run_phase(lds, a, PH_PRO1, 0, 0, 0); grid.sync();
#ifndef REP_PRO
#define REP_PRO 1
#endif
#ifndef REP_IN
#define REP_IN 1
#endif
#ifndef REP_ATT
#define REP_ATT 1
#endif
#ifndef REP_UP
#define REP_UP 1
#endif
#pragma unroll 1
    for (int rep = 1; rep < REP_PRO; ++rep) { run_phase(lds, a, PH_PRO1, 0, 0, 0); GSYNC(); }
#pragma unroll 1
    for (int rep = 0; rep < REP_PRO; ++rep) { run_phase(lds, a, PH_PRO2, 0, 0, 0); GSYNC(); run_phase(lds, a, PH_MAKEXA, 0, 0, 1); GSYNC(); }
#pragma unroll 1
    for (int l = 0; l < DEPTH; ++l) {
#pragma unroll 1
        for (int rep = 0; rep < REP_IN; ++rep) { run_phase(lds, a, PH_IN, l, 0, 0); GSYNC(); }
#pragma unroll 1
        for (int rep = 0; rep < REP_ATT; ++rep) { run_phase(lds, a, PH_ATT, l, rep, 0); GSYNC(); }
        run_phase(lds, a, PH_OUT, l, 0, 0); GSYNC();
#pragma unroll 1
        for (int rep = 0; rep < REP_UP; ++rep) { run_phase(lds, a, PH_UP, l, 0, 0); GSYNC(); }
        run_phase(lds, a, PH_DOWN, l, 0, 0);
        if (l < DEPTH - 1) GSYNC();
    }
}

extern "C" void kernel_launch(void* const* d_in, const int* in_sizes, int n_in, void* d_out, int out_size, void* d_ws, size_t ws_size, hipStream_t stream) {
    static int grid = 0;
    if (grid == 0) {
        int dev = 0, cus = 0, per_cu = 0;
        (void)hipGetDevice(&dev); (void)hipDeviceGetAttribute(&cus, hipDeviceAttributeMultiprocessorCount, dev);
        (void)hipFuncSetAttribute((const void*)mk_fwd, hipFuncAttributeMaxDynamicSharedMemorySize, LDS_BYTES);
        (void)hipOccupancyMaxActiveBlocksPerMultiprocessor(&per_cu, (const void*)mk_fwd, 512, LDS_BYTES);
        if (per_cu < 1) fprintf(stderr, "kernel_launch: occupancy query reports %d blocks per CU\n", per_cu);
        grid = cus > 0 ? cus : 256;
        if (ws_size < WS_END) { fprintf(stderr, "kernel_launch: workspace too small (%zu < %zu)\n", ws_size, (size_t)WS_END); grid = -1; }
    }
    if (grid < 0) return;
    Args a{}; for (int i = 0; i < N_IN; ++i) a.in[i] = (const float*)d_in[i]; a.out = (float*)d_out; a.ws = (unsigned char*)d_ws;
    (void)hipMemsetAsync((unsigned char*)d_ws + WS_CTL, 0, 1 * MiB, stream);
    void* args[] = {&a};
    hipError_t e = hipLaunchCooperativeKernel((const void*)mk_fwd, dim3(grid), dim3(512), args, LDS_BYTES, stream);
    if (e != hipSuccess) fprintf(stderr, "cooperative launch failed: %s (grid %d)\n", hipGetErrorString(e), grid);
}
```

```cpp
#include <hip/hip_runtime.h>
#include <hip/hip_cooperative_groups.h>
#include <cstdio>
#include <cstdint>
namespace cg = cooperative_groups;

constexpr int DEPTH = 4, NCTX = 32, TCTX = 256, NLAT = 4, TLAT = 2048, PAST = 512;
constexpr int MCTX = 8192, MLAT = 8192, MTOT = 16384;
constexpr int DIN = 2304, DFF = 2816, DUP = 5632;
constexpr size_t OUT_X = 0, OUT_NAK = 16777216, OUT_NAV = 25165824, OUT_SWK = 33554432, OUT_SWV = 37748736, OUT_DAK = 41943040, OUT_DAV = 50331648, OUT_TOTAL = 58720256;
enum { I_XP = 0, I_XS, I_CNAK, I_CNAV, I_CSWK, I_CSWV, I_CDAK, I_CDAV, I_C, I_CCTX, I_GATTN, I_GFFN, I_WMOD, I_BMOD, I_WIN, I_NAG, I_RPB, I_SWG, I_SINK, I_DAG, I_LAMBDA, I_SUBG, I_WOUT, I_WUP, I_CONVW, I_CONVB, I_WDOWN, N_IN };
#define FILL_UPFRONT 1
#define LAS __attribute__((address_space(3)))
#define GAS __attribute__((address_space(1)))
typedef unsigned short bf16_t;
typedef short bf16x8 __attribute__((ext_vector_type(8)));
typedef float f32x4 __attribute__((ext_vector_type(4)));
typedef float f32x2 __attribute__((ext_vector_type(2)));
typedef float f32x16 __attribute__((ext_vector_type(16)));
typedef unsigned u32x4 __attribute__((ext_vector_type(4)));
typedef unsigned u32x2 __attribute__((ext_vector_type(2)));
typedef __bf16 bf16x2_t __attribute__((ext_vector_type(2)));

constexpr float LOG2E = 1.4426950408889634f;
constexpr float QSCALE64 = 0.125f * LOG2E, QSCALE32 = 0.17677669529663687f * LOG2E;

__device__ __forceinline__ unsigned cvt_pk_bf16(float lo, float hi) { f32x2 v = {lo, hi}; bf16x2_t b = __builtin_convertvector(v, bf16x2_t); return __builtin_bit_cast(unsigned, b); }
__device__ __forceinline__ float bf16_to_f32(bf16_t v) { return __builtin_bit_cast(float, (unsigned)v << 16); }
__device__ __forceinline__ int row_b5(int row) { return row < MCTX ? 0 : 1 + ((row - MCTX) >> 11); }

constexpr size_t MiB = 1u << 20;
constexpr size_t WS_CTL = 0;
constexpr size_t WS_MOD = 1 * MiB;
constexpr size_t WS_GV = WS_MOD + 512 * 1024;
constexpr size_t WS_BIASIN = WS_GV + 256 * 1024;
constexpr size_t WS_BIASUP = WS_BIASIN + 256 * 1024;
constexpr size_t WS_LAM = WS_BIASUP + 512 * 1024;
constexpr int SM_LAM = 0, SM_GAINS = 64, SM_RPB = SM_GAINS + 1280, SM_SINK = SM_RPB + 7440, SM_SUBG = SM_SINK + 32, SM_END = SM_SUBG + 256;
constexpr size_t WS_ROPEB = 3 * MiB;
constexpr size_t WS_ROPEC = WS_ROPEB + 512 * 1024;
constexpr size_t WS_SSQ = 4 * MiB;
constexpr size_t WS_CONV = 5 * MiB;
constexpr size_t WS_WIN = 6 * MiB;
constexpr size_t WS_WOUT = WS_WIN + 18 * MiB;
constexpr size_t WS_WUP = WS_WOUT + 8 * MiB;
constexpr size_t WS_WDOWN = WS_WUP + 44 * MiB;
constexpr size_t WS_KC = WS_WDOWN + 22 * MiB;
constexpr size_t WS_XA = WS_KC + 20 * MiB;
constexpr size_t WS_QKV = WS_XA + 32 * MiB + 1 * MiB;
constexpr size_t WS_O = WS_QKV + 72 * MiB;
constexpr size_t WS_ACT = WS_QKV;
constexpr size_t WS_END = WS_O + 32 * MiB;
constexpr size_t GS4 = 2097152, GS8 = 4194304, GS2 = 1048576;
constexpr size_t QO_QA = 0, QO_KA = QO_QA + 2 * GS4, QO_VTA = QO_KA + 2 * GS4, QO_QB = QO_VTA + 2 * GS4, QO_KB = QO_QB + 2 * GS8, QO_VTB = QO_KB + 2 * GS2,
                 QO_QC = QO_VTB + 2 * GS2, QO_KC = QO_QC + 2 * GS4, QO_VTC = QO_KC + 2 * GS4, QO_END = QO_VTC + 2 * GS4;
static_assert(QO_END * 2 == 72 * MiB, "qkv region");
constexpr size_t CO_KA = 0, CO_VTA = CO_KA + GS4, CO_KB = CO_VTA + GS4, CO_VTB = CO_KB + GS2, CO_KCC = CO_VTB + GS2, CO_VTCC = CO_KCC + GS4;

struct Args { const float* in[N_IN]; float* out; unsigned char* ws; };
__device__ __forceinline__ int opaque_tid() { int t = threadIdx.x; asm volatile("" : "+v"(t)); return t; }

namespace pg8 {
#define PG8_LAS __attribute__((address_space(3)))
constexpr int BM = 256, BK = 64, HALF = 128, HTB = HALF * BK * 2  , STAGE_BYTES = 8 * HTB, NXCD = 8, WGM = 8;
__host__ __device__ __forceinline__ int lds_byte(int r, int c) { const int st = (r >> 4) * 2 + (c >> 5), rr = r & 15, cc = c & 31, ob = rr * 64 + cc * 2; return st * 1024 + (ob ^ (((ob >> 9) & 1) << 5)); }
__host__ __device__ __forceinline__ void stage_rc(int b, int& R, int& C) { const int st = b / 1024, sb = b % 1024, swz = sb ^ (((sb >> 9) & 1) << 5); R = (st >> 1) * 16 + swz / 64; C = (st & 1) * 32 + (swz % 64) / 2; }
__host__ __device__ __forceinline__ int perm32(int rho) { const int n = rho >> 4, i = rho & 15; return 8 * (i >> 2) + 4 * n + (i & 3); }
struct Unit { int pm, pn; };
struct Gemm { const bf16_t* A; const bf16_t* Bt; int M, N, K; };
struct StaticOrder {
    int nM, nN, nwg, G, c;
    __host__ __device__ void init(int M, int N, int G_, int c_) { nM = M / BM; nN = N / BM; nwg = nM * nN; G = G_; c = c_; }
    __host__ __device__ bool next(int i, Unit& u) const {
        const long L = (long)i * G + c; if (L >= nwg) return false;
        int wgid = (int)L; { const int q = nwg / NXCD, r = nwg % NXCD, xcd = wgid % NXCD, off = wgid / NXCD; wgid = (xcd < r ? xcd * (q + 1) : r * (q + 1) + (xcd - r) * q) + off; }
        const int nig = WGM * nN, gid = wgid / nig, fm = gid * WGM, gsz = (nM - fm) < WGM ? (nM - fm) : WGM;
        u.pm = fm + ((wgid % nig) % gsz); u.pn = (wgid % nig) / gsz; return true;
    }
    __device__ __forceinline__ void a_ready(const Unit&) const {}
    __device__ __forceinline__ void done(const Unit&) const {}
    __device__ __forceinline__ int arow0(int pm) const { return BM * pm; }
};
struct UpOrder : StaticOrder {
    __device__ __forceinline__ void init_up(int G_, int c_) { nM = 68; nN = 22; nwg = nM * nN; G = G_; c = c_; }
    __device__ __forceinline__ int arow0(int pm) const { return pm < 32 ? BM * pm : MCTX + TLAT * ((pm - 32) / 9) + 254 * ((pm - 32) % 9) - 1; }
};

template <class Epi, class Sched, bool ALIGN_EPI = false, bool SP2 = false>
__device__ __forceinline__ void gemm_phase(PG8_LAS unsigned char* lds, const Gemm g, const Sched& S, const Epi& E) {
    const int tid = opaque_tid(), wid = __builtin_amdgcn_readfirstlane(tid >> 6), lane = tid & 63, wr = wid >> 2, wc = wid & 3, fr = lane & 15, fq = lane >> 4;
    const int K = g.K, nt = K / BK;
    unsigned voffA[2], voffB[2];
#pragma unroll
    for (int i = 0; i < 2; ++i) { int R, C; stage_rc(tid * 16 + i * 8192, R, C); const int Rb = Epi::PERM ? ((R & ~31) + perm32(R & 31)) : R;
        voffA[i] = (unsigned)(R * K + C) * 2u; voffB[i] = (unsigned)(Rb * K + C) * 2u; }
    const size_t kstep = (size_t)(BK * 2);
    const size_t hstep = (size_t)HALF * K * 2;
    const size_t tstep = 2 * hstep;
    const unsigned ldsw = (unsigned)wid * 1024u;
    const int aoff = lds_byte(wr * 64 + fr, fq * 8), boff = lds_byte(wc * 32 + fr, fq * 8);
#define PG8_SA(b, h) (((b) * 2 + (h)) * HTB)
#define PG8_SB(b, h) ((4 + (b) * 2 + (h)) * HTB)
#define PG8_STAGE(bufoff, gbase, voff) do { _Pragma("unroll") for (int _i = 0; _i < 2; ++_i) \
        __builtin_amdgcn_global_load_lds((const unsigned*)((const char*)(gbase) + (voff)[_i]), (PG8_LAS unsigned*)(lds + (bufoff) + ldsw + _i * 8192), 16, 0, 0); } while (0)
#define PG8_LDA(dst, b, h) do { _Pragma("unroll") for (int m = 0; m < 4; ++m) _Pragma("unroll") for (int k = 0; k < 2; ++k) dst[m][k] = *(const PG8_LAS bf16x8*)(lds + PG8_SA(b, h) + aoff + m * 2048 + k * 1024); } while (0)
#define PG8_LDB(dst, b, h) do { _Pragma("unroll") for (int n = 0; n < 2; ++n) _Pragma("unroll") for (int k = 0; k < 2; ++k) dst[n][k] = *(const PG8_LAS bf16x8*)(lds + PG8_SB(b, h) + boff + n * 2048 + k * 1024); } while (0)
#define PG8_MMA(ai, bj, At, Bt) do { __builtin_amdgcn_s_setprio(1); _Pragma("unroll") for (int m = 0; m < 4; ++m) _Pragma("unroll") for (int n = 0; n < 2; ++n) _Pragma("unroll") for (int k = 0; k < 2; ++k) \
        acc[ai][bj][m][n] = __builtin_amdgcn_mfma_f32_16x16x32_bf16(Bt[n][k], At[m][k], acc[ai][bj][m][n], 0, 0, 0); __builtin_amdgcn_s_setprio(0); } while (0)
#define PG8_WAIT_V(n) asm volatile("s_waitcnt vmcnt(" #n ")" ::: "memory")
#define PG8_WAIT_L(n) asm volatile("s_waitcnt lgkmcnt(" #n ")" ::: "memory")
#define PG8_BAR __builtin_amdgcn_s_barrier()
#define PG8_SCHED __builtin_amdgcn_sched_barrier(0)
    Unit cur, nxt; int ui = 0;
    if (!S.next(0, cur)) return;
    f32x4 acc[2][2][4][2];
#pragma unroll
    for (int a = 0; a < 2; ++a)
#pragma unroll
        for (int b = 0; b < 2; ++b)
#pragma unroll
            for (int m = 0; m < 4; ++m)
#pragma unroll
                for (int n = 0; n < 2; ++n) acc[a][b][m][n] = (f32x4){0.f, 0.f, 0.f, 0.f};
    bf16x8 At[4][2], B0[2][2], B1[2][2];
    const size_t rstep = (size_t)K * 2;
    const char* cA = (const char*)g.A + (size_t)S.arow0(cur.pm) * rstep; const char* cB = (const char*)g.Bt + (size_t)cur.pn * tstep;
    S.a_ready(cur);
    if constexpr (SP2) {
        PG8_STAGE(PG8_SB(0, 0), cB, voffB); PG8_STAGE(PG8_SB(0, 1), cB + hstep, voffB); PG8_STAGE(PG8_SA(0, 0), cA, voffA); PG8_STAGE(PG8_SA(0, 1), cA + hstep, voffA);
        if (wr == 1) PG8_BAR;
        PG8_WAIT_V(2); PG8_BAR;
        PG8_STAGE(PG8_SB(1, 0), cB + kstep, voffB); PG8_STAGE(PG8_SA(1, 0), cA + kstep, voffA); PG8_STAGE(PG8_SB(1, 1), cB + hstep + kstep, voffB);
        PG8_WAIT_V(6); PG8_BAR;
    } else {
        PG8_STAGE(PG8_SB(0, 0), cB, voffB); PG8_STAGE(PG8_SA(0, 0), cA, voffA); PG8_STAGE(PG8_SB(0, 1), cB + hstep, voffB); PG8_STAGE(PG8_SA(0, 1), cA + hstep, voffA);
        if (wr == 1) PG8_BAR;
        PG8_WAIT_V(4); PG8_BAR;
        PG8_STAGE(PG8_SB(1, 0), cB + kstep, voffB); PG8_STAGE(PG8_SA(1, 0), cA + kstep, voffA); PG8_STAGE(PG8_SB(1, 1), cB + hstep + kstep, voffB);
        PG8_WAIT_V(6); PG8_BAR;
    }
    for (;;) {
        const bool has_next = S.next(ui + 1, nxt);
        const char* nA = has_next ? (const char*)g.A + (size_t)S.arow0(nxt.pm) * rstep : cA; const char* nB = has_next ? (const char*)g.Bt + (size_t)nxt.pn * tstep : cB;
        for (int t = 0; t < nt; t += 2) {
            const bool last = (t == nt - 2);
            const char* a1 = cA + (size_t)(t + 1) * kstep;
            const char* a2 = last ? nA : cA + (size_t)(t + 2) * kstep; const char* b2 = last ? nB : cB + (size_t)(t + 2) * kstep;
            const char* a3 = a2 + kstep; const char* b3 = b2 + kstep;
            if (last && has_next) S.a_ready(nxt);
            if constexpr (SP2) {
            PG8_LDB(B0, 0, 0); PG8_LDB(B1, 0, 1); PG8_SCHED; PG8_LDA(At, 0, 0); PG8_STAGE(PG8_SA(1, 1), a1 + hstep, voffA);
            PG8_WAIT_V(8); PG8_WAIT_L(0); PG8_BAR; PG8_MMA(0, 0, At, B0); PG8_MMA(0, 1, At, B1); PG8_BAR; PG8_SCHED;
            PG8_LDA(At, 0, 1); PG8_STAGE(PG8_SB(0, 0), b2, voffB); PG8_STAGE(PG8_SB(0, 1), b2 + hstep, voffB); PG8_STAGE(PG8_SA(0, 0), a2, voffA);
            PG8_WAIT_V(8); PG8_WAIT_L(0); PG8_BAR; PG8_MMA(1, 0, At, B0); PG8_MMA(1, 1, At, B1); PG8_BAR; PG8_SCHED;
            PG8_LDB(B0, 1, 0); PG8_LDB(B1, 1, 1); PG8_SCHED; PG8_LDA(At, 1, 0); PG8_STAGE(PG8_SA(0, 1), a2 + hstep, voffA);
            PG8_WAIT_V(8); PG8_WAIT_L(0); PG8_BAR; PG8_MMA(0, 0, At, B0); PG8_MMA(0, 1, At, B1); PG8_BAR; PG8_SCHED;
            PG8_LDA(At, 1, 1); PG8_STAGE(PG8_SB(1, 0), b3, voffB); PG8_STAGE(PG8_SB(1, 1), b3 + hstep, voffB); PG8_STAGE(PG8_SA(1, 0), a3, voffA);
            PG8_WAIT_V(8); PG8_WAIT_L(0); PG8_BAR; PG8_MMA(1, 0, At, B0); PG8_MMA(1, 1, At, B1); PG8_BAR; PG8_SCHED;
            } else {
            PG8_LDB(B0, 0, 0); PG8_SCHED; PG8_LDA(At, 0, 0); PG8_STAGE(PG8_SA(1, 1), a1 + hstep, voffA);
            PG8_WAIT_L(8); PG8_BAR; PG8_WAIT_L(0); PG8_MMA(0, 0, At, B0); PG8_BAR; PG8_SCHED;
            PG8_LDB(B1, 0, 1); PG8_STAGE(PG8_SB(0, 0), b2, voffB);
            PG8_BAR; PG8_WAIT_L(0); PG8_MMA(0, 1, At, B1); PG8_BAR;
            PG8_LDA(At, 0, 1); PG8_STAGE(PG8_SA(0, 0), a2, voffA);
            PG8_BAR; PG8_WAIT_L(0); PG8_MMA(1, 0, At, B0); PG8_BAR; PG8_SCHED;
            PG8_STAGE(PG8_SB(0, 1), b2 + hstep, voffB);
            PG8_WAIT_V(6); PG8_BAR; PG8_MMA(1, 1, At, B1); PG8_BAR;
            PG8_LDB(B0, 1, 0); PG8_SCHED; PG8_LDA(At, 1, 0); PG8_STAGE(PG8_SA(0, 1), a2 + hstep, voffA);
            PG8_WAIT_L(8); PG8_BAR; PG8_WAIT_L(0); PG8_MMA(0, 0, At, B0); PG8_BAR; PG8_SCHED;
            PG8_LDB(B1, 1, 1); PG8_STAGE(PG8_SB(1, 0), b3, voffB);
            PG8_BAR; PG8_WAIT_L(0); PG8_MMA(0, 1, At, B1); PG8_BAR;
            PG8_LDA(At, 1, 1); PG8_STAGE(PG8_SA(1, 0), a3, voffA);
            PG8_BAR; PG8_WAIT_L(0); PG8_MMA(1, 0, At, B0); PG8_BAR; PG8_SCHED;
            PG8_STAGE(PG8_SB(1, 1), b3 + hstep, voffB);
            PG8_WAIT_V(6); PG8_BAR; PG8_MMA(1, 1, At, B1); PG8_BAR;
            }
        }
        if constexpr (ALIGN_EPI) { if (wr == 0) PG8_BAR; }
        if constexpr (!Epi::AFTER_DRAIN) { if constexpr (Epi::NEEDS_LDS) E(acc, cur, wr, wc, fr, fq, lds); else E(acc, cur, wr, wc, fr, fq); S.done(cur); }
        if (!has_next) break;
#pragma unroll
        for (int a = 0; a < 2; ++a)
#pragma unroll
            for (int b = 0; b < 2; ++b)
#pragma unroll
                for (int m = 0; m < 4; ++m)
#pragma unroll
                    for (int n = 0; n < 2; ++n) acc[a][b][m][n] = (f32x4){0.f, 0.f, 0.f, 0.f};
        cur = nxt; cA = nA; cB = nB; ++ui;
        if constexpr (ALIGN_EPI) { if (wr == 1) PG8_BAR; }
    }
    PG8_WAIT_V(0);
    if constexpr (!ALIGN_EPI) { if (wr == 0) PG8_BAR; }
    PG8_BAR;
    if constexpr (Epi::AFTER_DRAIN) { E.fused(acc, cur, wr, wc, fr, fq, lds, wid, lane); S.done(cur); }
#undef PG8_SA
#undef PG8_SB
#undef PG8_STAGE
#undef PG8_LDA
#undef PG8_LDB
#undef PG8_MMA
#undef PG8_WAIT_V
#undef PG8_WAIT_L
#undef PG8_BAR
#undef PG8_SCHED
}

__device__ __forceinline__ float row_rstd(const GAS float* ssq, int row) {
    const GAS f32x4* p = (const GAS f32x4*)(ssq + (size_t)row * 16); const f32x4 a = p[0], b = p[1], c = p[2], d = p[3];
    const float s = ((a[0] + a[1]) + (a[2] + a[3])) + ((b[0] + b[1]) + (b[2] + b[3])) + ((c[0] + c[1]) + (c[2] + c[3])) + ((d[0] + d[1]) + (d[2] + d[3]));
    return __builtin_amdgcn_rsqf(s * (1.0f / 1024.0f) + 1e-6f);
}


constexpr int LDS_EDGE = 131072 + 1024;
constexpr int LDS_RSTD = LDS_EDGE + 8192;
__device__ __forceinline__ void rstd_table(PG8_LAS unsigned char* lds, const GAS float* ssq, int arow0, int wr, int wc, int fr, int fq) {
    const int tid = (wr * 4 + wc) * 64 + fq * 16 + fr, r = tid >> 1, hf = tid & 1;
    const GAS f32x4* p = (const GAS f32x4*)(ssq + (size_t)min(arow0 + r, MTOT - 1) * 16 + 8 * hf); const f32x4 a = p[0], b = p[1];
    float s = ((a[0] + a[1]) + (a[2] + a[3])) + ((b[0] + b[1]) + (b[2] + b[3])); s += __shfl_xor(s, 1);
    if (!hf) ((PG8_LAS float*)(lds + LDS_RSTD))[r] = __builtin_amdgcn_rsqf(s * (1.0f / 1024.0f) + 1e-6f);
}
__device__ __forceinline__ float xsum_fq(float v) {
    auto a = __builtin_amdgcn_permlane16_swap(__float_as_uint(v), __float_as_uint(v), false, false); v = __uint_as_float(a[0]) + __uint_as_float(a[1]);
    auto b = __builtin_amdgcn_permlane32_swap(__float_as_uint(v), __float_as_uint(v), false, false); return __uint_as_float(b[0]) + __uint_as_float(b[1]);
}
#define EPI_BARRIER() do { asm volatile("s_waitcnt lgkmcnt(0)" ::: "memory"); __builtin_amdgcn_s_barrier(); asm volatile("" ::: "memory"); } while (0)

struct EpiIn {
    static constexpr bool PERM = false, AFTER_DRAIN = false, NEEDS_LDS = true;
    unsigned char* ws0; float* out; int l;
    __device__ __forceinline__ void operator()(const f32x4 (&acc)[2][2][4][2], const Unit& u, int wr, int wc, int fr_in, int fq_in, PG8_LAS unsigned char* lds) const {
        unsigned char* ws_ = ws0; asm volatile("" : "+s"(ws_));
        GAS unsigned char* ws = (GAS unsigned char*)ws_; GAS float* outg = (GAS float*)out;
        int fr = fr_in, fq = fq_in; asm volatile("" : "+v"(fr), "+v"(fq));
        const GAS float* ssq = (const GAS float*)(ws + WS_SSQ); const GAS float* bias = (const GAS float*)(ws + WS_BIASIN) + (size_t)l * 5 * DIN;
        const GAS float* gains = (const GAS float*)(ws + WS_LAM) + SM_GAINS + l * 320; const GAS float* nag = gains; const GAS float* swg = gains + 128; const GAS float* dag = gains + 256;
        const GAS float* ropeB = (const GAS float*)(ws + WS_ROPEB); const GAS float* ropeC = (const GAS float*)(ws + WS_ROPEC); GAS bf16_t* qkv = (GAS bf16_t*)(ws + WS_QKV);
        const int pm = u.pm, pn = u.pn;
        const int grp = pm >= 32 ? 1 : 0, b = grp ? ((pm - 32) >> 3) : pm, tbase = grp ? 256 * ((pm - 32) & 7) : 0, T = grp ? TLAT : TCTX, b5 = grp ? 1 + b : 0;
        int type, h;
        if (pn < 3) { type = pn; h = wc; } else if (pn < 5) { type = 3; h = 4 * (pn - 3) + wc; } else if (pn == 5) { type = wc < 2 ? 4 : 5; h = wc & 1; } else { type = pn; h = wc; }
        const bool isv = (type == 2 || type == 5 || type == 8), isq = (type == 0 || type == 3 || type == 6), is32 = (type == 6 || type == 7);
        const bool rope = grp && (type == 3 || type == 4 || type == 6 || type == 7);
        const int H = (type == 3) ? 8 : ((type == 4 || type == 5) ? 2 : 4);
        size_t dbase; const size_t gs = (type == 3) ? GS8 : ((type == 4 || type == 5) ? GS2 : GS4);
        switch (type) { case 0: dbase = QO_QA; break; case 1: dbase = QO_KA; break; case 2: dbase = QO_VTA; break; case 3: dbase = QO_QB; break; case 4: dbase = QO_KB; break; case 5: dbase = QO_VTB; break;
                        case 6: dbase = QO_QC; break; case 7: dbase = QO_KC; break; default: dbase = QO_VTC; break; }
        GAS bf16_t* dst = qkv + dbase + grp * gs + (size_t)(b * H + h) * T * 64;
        GAS float* fo = nullptr; int fow = 0, foc = 0;
        if (!grp) { switch (type) { case 1: fo = outg + OUT_NAK; fow = 256; foc = 64 * wc; break; case 2: fo = outg + OUT_NAV; fow = 256; foc = 64 * wc; break; case 4: fo = outg + OUT_SWK; fow = 128; foc = 64 * h; break;
                        case 5: fo = outg + OUT_SWV; fow = 128; foc = 64 * h; break; case 7: fo = outg + OUT_DAK; fow = 256; foc = 64 * wc; break; case 8: fo = outg + OUT_DAV; fow = 256; foc = 64 * wc; break; default: break; } }
        const GAS float* gsrc = ((type == 0) ? nag : (type == 1) ? nag + 64 : (type == 3) ? swg : (type == 4) ? swg + 64 : (type == 6) ? dag : dag + 32) + 4 * fq;
        const GAS float* bsrc = bias + b5 * DIN + pn * 256 + 64 * wc + 4 * fq;
        rstd_table(lds, ssq, 256 * pm, wr, wc, fr, fq);
        f32x4 bv[2][2], gv[2][2];
#pragma unroll
        for (int bj = 0; bj < 2; ++bj)
#pragma unroll
            for (int n = 0; n < 2; ++n) { bv[bj][n] = *(const GAS f32x4*)(bsrc + 32 * bj + 16 * n); gv[bj][n] = isv ? (f32x4){1.f, 1.f, 1.f, 1.f} : *(const GAS f32x4*)(gsrc + (is32 ? 0 : 32 * bj) + 16 * n); }
        EPI_BARRIER();
        const PG8_LAS float* RS = (const PG8_LAS float*)(lds + LDS_RSTD);
        const float qs = isq ? (is32 ? QSCALE32 : QSCALE64) : 1.0f;
#pragma unroll
        for (int ai = 0; ai < 2; ++ai)
#pragma unroll
            for (int m = 0; m < 4; ++m) {
                const int lr = 128 * ai + 64 * wr + 16 * m + fr, row = 256 * pm + lr, t = tbase + lr;
                const float rstd = RS[lr];
                float r0 = 1.f, r1 = 1.f;
                if (!isv) {
                    float s0 = 0.f, s1 = 0.f;
#pragma unroll
                    for (int n = 0; n < 2; ++n) { const f32x4 a = acc[ai][0][m][n] * rstd + bv[0][n], c = acc[ai][1][m][n] * rstd + bv[1][n];
                        s0 += (a[0] * a[0] + a[1] * a[1]) + (a[2] * a[2] + a[3] * a[3]); s1 += (c[0] * c[0] + c[1] * c[1]) + (c[2] * c[2] + c[3] * c[3]); }
                    s0 = xsum_fq(s0); s1 = xsum_fq(s1);
                    if (is32) { r0 = __builtin_amdgcn_rsqf(s0 * (1.f / 32.f) + 1e-6f); r1 = __builtin_amdgcn_rsqf(s1 * (1.f / 32.f) + 1e-6f); }
                    else { r0 = r1 = __builtin_amdgcn_rsqf((s0 + s1) * (1.f / 64.f) + 1e-6f); }
                }
                GAS float* fr_ = fo ? fo + ((size_t)(b * DEPTH + l) * 256 + t) * fow + foc + 4 * fq : nullptr;
#pragma unroll
                for (int bj = 0; bj < 2; ++bj)
#pragma unroll
                    for (int n = 0; n < 2; ++n) {
                        f32x4 x = acc[ai][bj][m][n] * rstd + bv[bj][n];
                        if (!isv) {
                            x = x * (bj ? r1 : r0) * gv[bj][n];
                            if (rope) {
                                const f32x4 cs = is32 ? *(const GAS f32x4*)(ropeC + ((size_t)t * 16 + 8 * n + 2 * fq) * 2) : *(const GAS f32x4*)(ropeB + ((size_t)t * 32 + 16 * bj + 8 * n + 2 * fq) * 2);
                                x = (f32x4){x[0] * cs[0] - x[1] * cs[1], x[0] * cs[1] + x[1] * cs[0], x[2] * cs[2] - x[3] * cs[3], x[2] * cs[3] + x[3] * cs[2]};
                            }
                        }
                        if (fr_) *(GAS f32x4*)(fr_ + 32 * bj + 16 * n) = x;
                        if (!isv) { const f32x4 y = x * qs; u32x2 w; w.x = cvt_pk_bf16(y[0], y[1]); w.y = cvt_pk_bf16(y[2], y[3]); *(GAS u32x2*)(dst + (size_t)t * 64 + 4 * fq + 32 * bj + 16 * n) = w; }
                        else { const int d0 = 32 * bj + 16 * n + 4 * fq;
#pragma unroll
                            for (int e = 0; e < 4; ++e) dst[(size_t)(d0 + e) * T + t] = (bf16_t)(cvt_pk_bf16(x[e], 0.f) & 0xffffu); }
                    }
            }
    }
};

struct EpiRes {
    static constexpr bool PERM = false, AFTER_DRAIN = false, NEEDS_LDS = false;
    unsigned char* ws0; float* x; int l; int which;
    __device__ __forceinline__ void operator()(const f32x4 (&acc)[2][2][4][2], const Unit& u, int wr, int wc, int fr, int fq) const {
        unsigned char* ws_ = ws0; asm volatile("" : "+s"(ws_)); GAS unsigned char* ws = (GAS unsigned char*)ws_; GAS float* xg = (GAS float*)x;
        const GAS float* gate = (const GAS float*)(ws + WS_MOD) + (size_t)l * 5 * 6144 + (which ? 5 : 2) * 1024;
        const GAS float* gvn = which ? (l < 3 ? (const GAS float*)(ws + WS_GV) + (size_t)(l + 1) * 10240 : nullptr) : (const GAS float*)(ws + WS_GV) + (size_t)l * 10240 + 1024;
        GAS bf16_t* xa = (GAS bf16_t*)(ws + WS_XA); GAS float* ssq = (GAS float*)(ws + WS_SSQ);
        const int pm = u.pm, pn = u.pn, b5 = pm >= 32 ? 1 + ((pm - 32) >> 3) : 0;
        const int col0 = 256 * pn + 32 * wc + 4 * fq;
        f32x4 gt[2][2], gn[2][2];
#pragma unroll
        for (int bj = 0; bj < 2; ++bj)
#pragma unroll
            for (int n = 0; n < 2; ++n) { gt[bj][n] = *(const GAS f32x4*)(gate + (size_t)b5 * 6144 + col0 + 128 * bj + 16 * n); gn[bj][n] = gvn ? *(const GAS f32x4*)(gvn + (size_t)b5 * 2048 + col0 + 128 * bj + 16 * n) : (f32x4){0.f, 0.f, 0.f, 0.f}; }
        GAS float* xbase = xg + (size_t)(256 * pm + 64 * wr + fr) * 1024 + col0;
        constexpr int XD = 2;
        f32x4 xb[XD][2][2];
#pragma unroll
        for (int it = 0; it < XD; ++it)
#pragma unroll
            for (int bj = 0; bj < 2; ++bj)
#pragma unroll
                for (int n = 0; n < 2; ++n) xb[it][bj][n] = *(const GAS f32x4*)(xbase + (size_t)(16 * it) * 1024 + 128 * bj + 16 * n);
#pragma unroll
        for (int it = 0; it < 8; ++it) {
            const int ai = it >> 2, m = it & 3; const int lrow = 128 * ai + 16 * m; GAS float* xr = xbase + (size_t)lrow * 1024; const int row = 256 * pm + 64 * wr + fr + lrow; float ss = 0.f;
            f32x4 xn[2][2];
#pragma unroll
            for (int bj = 0; bj < 2; ++bj)
#pragma unroll
                for (int n = 0; n < 2; ++n) xn[bj][n] = xb[it % XD][bj][n] + gt[bj][n] * acc[ai][bj][m][n];
            if (it + XD < 8) {
#pragma unroll
                for (int bj = 0; bj < 2; ++bj)
#pragma unroll
                    for (int n = 0; n < 2; ++n) xb[it % XD][bj][n] = *(const GAS f32x4*)(xbase + (size_t)(128 * ((it + XD) >> 2) + 16 * ((it + XD) & 3)) * 1024 + 128 * bj + 16 * n);
            }
#pragma unroll
            for (int bj = 0; bj < 2; ++bj)
#pragma unroll
                for (int n = 0; n < 2; ++n) {
                    *(GAS f32x4*)(xr + 128 * bj + 16 * n) = xn[bj][n];
                    if (gvn) { const f32x4 v = xn[bj][n]; ss += (v[0] * v[0] + v[1] * v[1]) + (v[2] * v[2] + v[3] * v[3]); const f32x4 y = v * gn[bj][n]; u32x2 w; w.x = cvt_pk_bf16(y[0], y[1]); w.y = cvt_pk_bf16(y[2], y[3]);
                        *(GAS u32x2*)(xa + (size_t)row * 1024 + col0 + 128 * bj + 16 * n) = w; }
                }
            if (gvn) { ss = xsum_fq(ss); if (fq == 0) ssq[(size_t)row * 16 + 4 * pn + wc] = ss; }
        }
    }
};

#define DPPF(old, src, ctrl) __builtin_bit_cast(float, __builtin_amdgcn_update_dpp(__builtin_bit_cast(int, (float)(old)), __builtin_bit_cast(int, (float)(src)), (ctrl), 0xf, 0xf, false))
struct EpiUpConv {
    static constexpr bool PERM = false, AFTER_DRAIN = false, NEEDS_LDS = true;
    unsigned char* ws0; int l;
    __device__ __forceinline__ void operator()(f32x4 (&acc)[2][2][4][2], const Unit& u, int wr, int wc, int fr_in, int fq_in, PG8_LAS unsigned char* lds) const {
        unsigned char* ws_ = ws0; asm volatile("" : "+s"(ws_)); GAS unsigned char* ws = (GAS unsigned char*)ws_;
        int fr = fr_in, fq = fq_in; asm volatile("" : "+v"(fr), "+v"(fq));
        const int pm = u.pm, pn = u.pn; const int grp = pm >= 32 ? 1 : 0, bq = grp ? (pm - 32) / 9 : 0, jq = grp ? (pm - 32) % 9 : 0;
        const int T = grp ? TLAT : TCTX, tofs = grp ? 254 * jq - 1 : 0, arow0 = grp ? MCTX + TLAT * bq + tofs : 256 * pm, b5 = grp ? 1 + bq : 0;
        const GAS float* ssq = (const GAS float*)(ws + WS_SSQ); const GAS float* bias = (const GAS float*)(ws + WS_BIASUP) + (size_t)(l * 5 + b5) * DUP; const GAS float* cw = (const GAS float*)(ws + WS_CONV) + (size_t)l * 4 * DUP;
        GAS bf16_t* act = (GAS bf16_t*)(ws + WS_ACT);
        const int fcol = 128 * pn + 32 * wc + 4 * fq;
        rstd_table(lds, ssq, arow0, wr, wc, fr, fq);
        f32x4 bv[2][2];
#pragma unroll
        for (int bj = 0; bj < 2; ++bj)
#pragma unroll
            for (int n = 0; n < 2; ++n) bv[bj][n] = *(const GAS f32x4*)(bias + bj * DFF + fcol + 16 * n);
        EPI_BARRIER();
        const PG8_LAS float* RS = (const PG8_LAS float*)(lds + LDS_RSTD);
#pragma unroll
        for (int ai = 0; ai < 2; ++ai)
#pragma unroll
            for (int m = 0; m < 4; ++m) {
                const int i = 128 * ai + 64 * wr + 16 * m + fr, t = tofs + i; const bool inseq = (t >= 0) && (t < T);
                const float rstd = RS[i];
#pragma unroll
                for (int bj = 0; bj < 2; ++bj)
#pragma unroll
                    for (int n = 0; n < 2; ++n) { const f32x4 v = acc[ai][bj][m][n] * rstd + bv[bj][n]; acc[ai][bj][m][n] = inseq ? v : (f32x4){0.f, 0.f, 0.f, 0.f}; }
            }
        PG8_LAS float* E = (PG8_LAS float*)(lds + LDS_EDGE);
#pragma unroll
        for (int ai = 0; ai < 2; ++ai) { const int c = 2 * ai + wr;
#pragma unroll
            for (int bj = 0; bj < 2; ++bj)
#pragma unroll
                for (int n = 0; n < 2; ++n) { const int col = 128 * bj + 32 * wc + 16 * n + 4 * fq;
                    if (fr == 0) *(PG8_LAS f32x4*)(E + (c * 2 + 0) * 256 + col) = acc[ai][bj][0][n];
                    if (fr == 15) *(PG8_LAS f32x4*)(E + (c * 2 + 1) * 256 + col) = acc[ai][bj][3][n]; } }
        asm volatile("s_waitcnt lgkmcnt(0)" ::: "memory"); __builtin_amdgcn_s_barrier(); asm volatile("" ::: "memory");
#pragma unroll
        for (int n = 0; n < 2; ++n) {
            f32x4 w0[2], w1[2], w2[2], cb[2];
#pragma unroll
            for (int bj = 0; bj < 2; ++bj) { const GAS float* p = cw + bj * DFF + fcol + 16 * n; w0[bj] = *(const GAS f32x4*)p; w1[bj] = *(const GAS f32x4*)(p + DUP); w2[bj] = *(const GAS f32x4*)(p + 2 * DUP); cb[bj] = *(const GAS f32x4*)(p + 3 * DUP); }
#pragma unroll
            for (int ai = 0; ai < 2; ++ai) { const int c = 2 * ai + wr;
                f32x4 ep[2], en[2];
#pragma unroll
                for (int bj = 0; bj < 2; ++bj) { const int col = 128 * bj + 32 * wc + 16 * n + 4 * fq;
                    ep[bj] = c > 0 ? *(const PG8_LAS f32x4*)(E + ((c - 1) * 2 + 1) * 256 + col) : (f32x4){0.f, 0.f, 0.f, 0.f};
                    en[bj] = c < 3 ? *(const PG8_LAS f32x4*)(E + ((c + 1) * 2 + 0) * 256 + col) : (f32x4){0.f, 0.f, 0.f, 0.f}; }
#pragma unroll
                for (int m = 0; m < 4; ++m) {
                    f32x4 y[2];
#pragma unroll
                    for (int bj = 0; bj < 2; ++bj) {
                        const f32x4 x = acc[ai][bj][m][n]; f32x4 pv, nx;
#pragma unroll
                        for (int e = 0; e < 4; ++e) {
                            const float po = m > 0 ? DPPF(acc[ai][bj][m > 0 ? m - 1 : 0][n][e], acc[ai][bj][m > 0 ? m - 1 : 0][n][e], 0x121) : ep[bj][e];
                            pv[e] = DPPF(po, x[e], 0x111);
                            const float no = m < 3 ? DPPF(acc[ai][bj][m < 3 ? m + 1 : 3][n][e], acc[ai][bj][m < 3 ? m + 1 : 3][n][e], 0x12F) : en[bj][e];
                            nx[e] = DPPF(no, x[e], 0x101);
                        }
                        y[bj] = cb[bj] + w0[bj] * pv + w1[bj] * x + w2[bj] * nx;
                    }
                    const int i = 128 * ai + 64 * wr + 16 * m + fr, t = tofs + i; const bool ok = grp ? ((i >= 1) && (i <= 254) && (t < T)) : true;
                    if (ok) { f32x4 a;
#pragma unroll
                        for (int e = 0; e < 4; ++e) a[e] = y[0][e] * __builtin_amdgcn_rcpf(1.0f + __expf(-y[0][e])) * y[1][e];
                        u32x2 w; w.x = cvt_pk_bf16(a[0], a[1]); w.y = cvt_pk_bf16(a[2], a[3]);
                        *(GAS u32x2*)(act + (size_t)(arow0 + i) * DFF + fcol + 16 * n) = w; }
                }
            } }
    }
};
}
namespace att {
typedef LAS unsigned char lds_u8;
constexpr int LDS_TILE = 16384;
constexpr int LDS_RPB = 2 * LDS_TILE;
constexpr int LDS_NEXT = LDS_RPB + 2048;
constexpr int NUNITS = 1024;

struct Ctx { unsigned char* ws; int l; int rep; };

__device__ __forceinline__ bf16x8 lds128(const lds_u8* p) { return *(const LAS bf16x8*)p; }
__device__ __forceinline__ float xmax32(float v) { const auto rr = __builtin_amdgcn_permlane32_swap(__float_as_uint(v), __float_as_uint(v), false, false); return fmaxf(__uint_as_float(rr[0]), __uint_as_float(rr[1])); }
__device__ __forceinline__ float xsum32(float v) { const auto rr = __builtin_amdgcn_permlane32_swap(__float_as_uint(v), __float_as_uint(v), false, false); return __uint_as_float(rr[0]) + __uint_as_float(rr[1]); }
__device__ __forceinline__ float max3f(float a, float b, float c) { float r; asm("v_max3_f32 %0, %1, %2, %3" : "=v"(r) : "v"(a), "v"(b), "v"(c)); return r; }
__device__ __forceinline__ int sigma32(int i) { return (i & 19) | ((i & 4) << 1) | ((i & 8) >> 1); }
__device__ __forceinline__ int key_of(int kb, int r, int h) { return 32 * kb + 16 * (r >> 3) + 8 * h + 4 * ((r >> 2) & 1) + (r & 3); }

template <int NDS>
__device__ __forceinline__ void qk_tile(f32x16& s0, f32x16& s1, const lds_u8* Kt, int c0, const bf16x8* qf, int lane) {
    const int k0 = sigma32(lane & 31), h = lane >> 5; const lds_u8* b0 = Kt + k0 * 128; const lds_u8* b1 = b0 + 32 * 128; const int sw = k0 & 7;
    bf16x8 a0[NDS], a1[NDS];
#pragma unroll
    for (int ds = 0; ds < NDS; ++ds) { const int off = ((c0 + 2 * ds + h) ^ sw) << 4; a0[ds] = lds128(b0 + off); a1[ds] = lds128(b1 + off); }
    const f32x16 z = {0.f, 0.f, 0.f, 0.f, 0.f, 0.f, 0.f, 0.f, 0.f, 0.f, 0.f, 0.f, 0.f, 0.f, 0.f, 0.f};
    s0 = z; s1 = z;
#pragma unroll
    for (int ds = 0; ds < NDS; ++ds) { s0 = __builtin_amdgcn_mfma_f32_32x32x16_bf16(a0[ds], qf[ds], s0, 0, 0, 0); s1 = __builtin_amdgcn_mfma_f32_32x32x16_bf16(a1[ds], qf[ds], s1, 0, 0, 0); }
}
__device__ __forceinline__ void softmax_pv(f32x16& s0, f32x16& s1, float& m, float& l, f32x16& o0, f32x16& o1, const lds_u8* Vt, int lane) {
    float mx = max3f(s0[0], s1[0], s0[1]), my = max3f(s1[1], s0[2], s1[2]);
#pragma unroll
    for (int r = 3; r < 15; r += 2) { mx = max3f(mx, s0[r], s1[r]); my = max3f(my, s0[r + 1], s1[r + 1]); }
    mx = max3f(mx, s0[15], s1[15]); mx = fmaxf(mx, my);
    mx = xmax32(mx);
    const float mn = fmaxf(m, mx);
    if (__any(mn > m)) { const float al = __builtin_amdgcn_exp2f(m - mn); l *= al;
#pragma unroll
        for (int r = 0; r < 16; ++r) { o0[r] *= al; o1[r] *= al; }
        m = mn; }
    const int h = lane >> 5, d = lane & 31; const lds_u8* v0 = Vt + d * 128; const lds_u8* v1 = v0 + 32 * 128; const int sw = d & 7;
    bf16x8 va[4], vb[4];
#pragma unroll
    for (int c = 0; c < 4; ++c) { const int off = ((2 * c + h) ^ sw) << 4; va[c] = lds128(v0 + off); vb[c] = lds128(v1 + off); }
    float ps = 0.f, pt = 0.f;
#pragma unroll
    for (int r = 0; r < 16; ++r) { s0[r] = __builtin_amdgcn_exp2f(s0[r] - m); s1[r] = __builtin_amdgcn_exp2f(s1[r] - m); ps += s0[r]; pt += s1[r]; }
    l += ps + pt;
#pragma unroll
    for (int c = 0; c < 4; ++c) {
        const f32x16& s = (c >> 1) ? s1 : s0; const int b = 8 * (c & 1);
        u32x4 pw; pw.x = cvt_pk_bf16(s[b + 0], s[b + 1]); pw.y = cvt_pk_bf16(s[b + 2], s[b + 3]); pw.z = cvt_pk_bf16(s[b + 4], s[b + 5]); pw.w = cvt_pk_bf16(s[b + 6], s[b + 7]);
        const bf16x8 pf = __builtin_bit_cast(bf16x8, pw);
        o0 = __builtin_amdgcn_mfma_f32_32x32x16_bf16(va[c], pf, o0, 0, 0, 0);
        o1 = __builtin_amdgcn_mfma_f32_32x32x16_bf16(vb[c], pf, o1, 0, 0, 0);
    }
}

__device__ __forceinline__ void softmax_only(f32x16& s0, f32x16& s1, float& m, float& l, f32x16& o0, f32x16& o1, u32x4 (&pw)[4]) {
    float mx = max3f(s0[0], s1[0], s0[1]), my = max3f(s1[1], s0[2], s1[2]);
#pragma unroll
    for (int r = 3; r < 15; r += 2) { mx = max3f(mx, s0[r], s1[r]); my = max3f(my, s0[r + 1], s1[r + 1]); }
    mx = max3f(mx, s0[15], s1[15]); mx = fmaxf(mx, my);
    mx = xmax32(mx);
    const float mn = fmaxf(m, mx);
    if (__any(mn > m)) { const float al = __builtin_amdgcn_exp2f(m - mn); l *= al;
#pragma unroll
        for (int r = 0; r < 16; ++r) { o0[r] *= al; o1[r] *= al; }
        m = mn; }
    float ps = 0.f, pt = 0.f;
#pragma unroll
    for (int r = 0; r < 16; ++r) { s0[r] = __builtin_amdgcn_exp2f(s0[r] - m); s1[r] = __builtin_amdgcn_exp2f(s1[r] - m); ps += s0[r]; pt += s1[r]; }
    l += ps + pt;
#pragma unroll
    for (int c = 0; c < 4; ++c) { const f32x16& s = (c >> 1) ? s1 : s0; const int b = 8 * (c & 1);
        pw[c].x = cvt_pk_bf16(s[b + 0], s[b + 1]); pw[c].y = cvt_pk_bf16(s[b + 2], s[b + 3]); pw[c].z = cvt_pk_bf16(s[b + 4], s[b + 5]); pw[c].w = cvt_pk_bf16(s[b + 6], s[b + 7]); }
}
__device__ __forceinline__ void pv_only(f32x16& o0, f32x16& o1, const bf16x8 (&va)[4], const bf16x8 (&vb)[4], const u32x4 (&pw)[4]) {
#pragma unroll
    for (int c = 0; c < 4; ++c) { const bf16x8 pf = __builtin_bit_cast(bf16x8, pw[c]);
        o0 = __builtin_amdgcn_mfma_f32_32x32x16_bf16(va[c], pf, o0, 0, 0, 0); o1 = __builtin_amdgcn_mfma_f32_32x32x16_bf16(vb[c], pf, o1, 0, 0, 0); }
}
struct UnitGeo {
    const GAS bf16_t* qkv; const GAS bf16_t* kcb; unsigned kso, vso, kco, vco; int T, ta, nself, ntile, q0, grp, fam, b, h;
};
template <int MODE>
__device__ __forceinline__ void unit_loop(lds_u8* lds, const UnitGeo& U, const GAS float* sm, GAS bf16_t* Obase, int l, int tid) {
    const int lane = tid & 63, w = __builtin_amdgcn_readfirstlane(tid >> 6), h5 = lane >> 5, ql = lane & 31;
    const int T = U.T, q0 = U.q0, nself = U.nself, ntile = U.ntile, ta = U.ta;
    const int Hq = U.fam == 1 ? 8 : 4;
    const size_t qo = U.fam == 0 ? QO_QA : (U.fam == 1 ? QO_QB : QO_QC); const size_t gq = U.fam == 1 ? GS8 : GS4;
    const GAS bf16_t* Qp = U.qkv + qo + U.grp * gq + ((size_t)(U.b * Hq + U.h) * T + q0 + 32 * w + ql) * 64;
    bf16x8 qf[4];
#pragma unroll
    for (int ds = 0; ds < 4; ++ds) qf[ds] = *(const GAS bf16x8*)(Qp + 16 * ds + 8 * h5);
    const int qw0 = q0 + 32 * w, qtok = qw0 + ql, qrow = qtok >> 6, qcol = qtok & 63;
    const int r0w = min(max((qw0 >> 6) - 4, 0), 24), qsl = min(max(qcol - 8, 0), 48);
    float m0 = -1e30f, l0 = 0.f, m1 = -1e30f, l1 = 0.f;
    const f32x16 z = {0.f, 0.f, 0.f, 0.f, 0.f, 0.f, 0.f, 0.f, 0.f, 0.f, 0.f, 0.f, 0.f, 0.f, 0.f, 0.f};
    f32x16 oa0 = z, oa1 = z, ob0 = z, ob1 = z;
    const int lrow = tid >> 3, lch = tid & 7; const int lds_off = lrow * 128 + ((lch ^ (lrow & 7)) << 4);
    constexpr bool D2 = true;
    u32x4 kreg, vreg, kreg2, vreg2;
    auto gload = [&](int ti, u32x4& kr, u32x4& vr) {
        const bool self = ti < nself; const int tok0 = self ? 64 * (ta + ti) : 64 * (ti - nself); const int Tkv = self ? T : PAST;
        const GAS bf16_t* kp = (self ? U.qkv : U.kcb) + (self ? U.kso : U.kco); const GAS bf16_t* vp = (self ? U.qkv : U.kcb) + (self ? U.vso : U.vco);
        kr = *(const GAS u32x4*)(kp + (size_t)(tok0 + lrow) * 64 + lch * 8);
        vr = *(const GAS u32x4*)(vp + (size_t)lrow * Tkv + tok0 + lch * 8);
    };
    gload(0, kreg, vreg);
    if (D2) gload(1, kreg2, vreg2);
    *(LAS u32x4*)(lds + lds_off) = kreg; *(LAS u32x4*)(lds + 8192 + lds_off) = vreg;
    if (D2) { kreg = kreg2; vreg = vreg2; }
    __syncthreads();
    for (int ti = 0; ti < ntile; ++ti) {
        const lds_u8* Kt = lds + (ti & 1) * LDS_TILE; const lds_u8* Vt = Kt + 8192;
        if (D2) { if (ti + 2 < ntile) gload(ti + 2, kreg2, vreg2); } else { if (ti + 1 < ntile) gload(ti + 1, kreg, vreg); }
        const bool self = ti < nself; const int tok0 = 64 * (ta + ti);
        bool rel = true, msk = false;
        if (MODE == 1 && self) { const int kr = ta + ti; rel = (kr >= r0w) && (kr <= r0w + 7); msk = true; }
        if (MODE == 2 && self) { rel = (tok0 + 63 >= qw0 - 128) && (tok0 <= qw0 + 31 + 128); msk = !((tok0 >= qw0 + 31 - 128) && (tok0 + 63 <= qw0 + 128)); }
        if (rel) {
            if (MODE != 3) {
                f32x16 s0, s1; qk_tile<4>(s0, s1, Kt, 0, qf, lane);
                if (MODE == 1 && msk) {
                    const int kr = ta + ti; const LAS float* bt = (const LAS float*)(lds + LDS_RPB) + (kr - qrow + 7) * 31 + 15 - qcol;
                    float b0[16], b1[16];
#pragma unroll
                    for (int r = 0; r < 16; ++r) { const int kc0 = key_of(0, r, h5); b0[r] = bt[min(max(kc0, qsl), qsl + 15)]; b1[r] = bt[min(max(kc0 + 32, qsl), qsl + 15)]; }
#pragma unroll
                    for (int r = 0; r < 16; ++r) { const int kc0 = key_of(0, r, h5), kc1 = kc0 + 32;
                        s0[r] = ((kc0 >= qsl) && (kc0 < qsl + 16)) ? s0[r] + b0[r] : -INFINITY; s1[r] = ((kc1 >= qsl) && (kc1 < qsl + 16)) ? s1[r] + b1[r] : -INFINITY; }
                }
                if (MODE == 2 && msk) {
#pragma unroll
                    for (int r = 0; r < 16; ++r) { const int k0 = tok0 + key_of(0, r, h5), k1 = k0 + 32;
                        s0[r] = (abs(k0 - qtok) > 128) ? -INFINITY : s0[r]; s1[r] = (abs(k1 - qtok) > 128) ? -INFINITY : s1[r]; }
                }
                softmax_pv(s0, s1, m0, l0, oa0, oa1, Vt, lane);
            } else {
                { f32x16 s0, s1; qk_tile<2>(s0, s1, Kt, 0, qf, lane); softmax_pv(s0, s1, m0, l0, oa0, oa1, Vt, lane); }
                { f32x16 s0, s1; qk_tile<2>(s0, s1, Kt, 4, qf + 2, lane); softmax_pv(s0, s1, m1, l1, ob0, ob1, Vt, lane); }
            }
        }
        if (ti + 1 < ntile) { lds_u8* nb = lds + ((ti + 1) & 1) * LDS_TILE; *(LAS u32x4*)(nb + lds_off) = kreg; *(LAS u32x4*)(nb + 8192 + lds_off) = vreg; if (D2) { kreg = kreg2; vreg = vreg2; } }
        __syncthreads();
    }
    GAS bf16_t* orow = Obase + (size_t)qtok * 1024 + 4 * h5;
    float lt0 = xsum32(l0);
    if (U.fam == 1) lt0 += __builtin_amdgcn_exp2f(sm[SM_SINK + l * 8 + U.h] - m0);
    const float i0 = 1.0f / lt0;
    if (MODE != 3) {
#pragma unroll
        for (int g = 0; g < 4; ++g) {
            u32x2 wa, wb; wa.x = cvt_pk_bf16(oa0[4 * g] * i0, oa0[4 * g + 1] * i0); wa.y = cvt_pk_bf16(oa0[4 * g + 2] * i0, oa0[4 * g + 3] * i0);
            wb.x = cvt_pk_bf16(oa1[4 * g] * i0, oa1[4 * g + 1] * i0); wb.y = cvt_pk_bf16(oa1[4 * g + 2] * i0, oa1[4 * g + 3] * i0);
            *(GAS u32x2*)(orow + 8 * g) = wa; *(GAS u32x2*)(orow + 32 + 8 * g) = wb;
        }
    } else {
        const float lam_init = l == 0 ? 0.2f : (l == 1 ? 0.35550906759f : (l == 2 ? 0.47071301835f : 0.55605820416f));
        const float lt1 = xsum32(l1); const float i1 = 1.0f / lt1; const float lam = sm[SM_LAM + l];
        float ss = 0.f;
#pragma unroll
        for (int r = 0; r < 16; ++r) { oa0[r] = oa0[r] * i0 - lam * (ob0[r] * i1); oa1[r] = oa1[r] * i0 - lam * (ob1[r] * i1); ss += oa0[r] * oa0[r] + oa1[r] * oa1[r]; }
        ss = xsum32(ss);
        const float rn = __builtin_amdgcn_rsqf(ss * (1.f / 64.f) + 1e-6f) * (1.0f - lam_init);
        const GAS float* sg = sm + SM_SUBG + l * 64 + 4 * h5;
#pragma unroll
        for (int g = 0; g < 4; ++g) {
            const f32x4 ga = *(const GAS f32x4*)(sg + 8 * g), gb = *(const GAS f32x4*)(sg + 32 + 8 * g);
            u32x2 wa, wb; wa.x = cvt_pk_bf16(oa0[4 * g] * rn * ga[0], oa0[4 * g + 1] * rn * ga[1]); wa.y = cvt_pk_bf16(oa0[4 * g + 2] * rn * ga[2], oa0[4 * g + 3] * rn * ga[3]);
            wb.x = cvt_pk_bf16(oa1[4 * g] * rn * gb[0], oa1[4 * g + 1] * rn * gb[1]); wb.y = cvt_pk_bf16(oa1[4 * g + 2] * rn * gb[2], oa1[4 * g + 3] * rn * gb[3]);
            *(GAS u32x2*)(orow + 8 * g) = wa; *(GAS u32x2*)(orow + 32 + 8 * g) = wb;
        }
    }
}

__device__ __forceinline__ void attn_phase(lds_u8* lds, const Ctx& C) {
    const int l = C.l;
    for (;;) {
        __syncthreads();
        unsigned char* ws_ = C.ws; asm volatile("" : "+s"(ws_)); GAS unsigned char* ws = (GAS unsigned char*)ws_;
        const int tid = opaque_tid();
        if (tid == 0) *(LAS unsigned*)(lds + LDS_NEXT) = __hip_atomic_fetch_add((GAS unsigned*)(ws + WS_CTL) + 64 * (1 + l) + C.rep, 1u, __ATOMIC_RELAXED, __HIP_MEMORY_SCOPE_AGENT);
        __syncthreads();
        const int idx = (int)*(LAS unsigned*)(lds + LDS_NEXT);
        if (idx >= NUNITS) break;
        const GAS float* sm = (const GAS float*)(ws + WS_LAM);
        UnitGeo U; U.qkv = (const GAS bf16_t*)(ws + WS_QKV); U.kcb = (const GAS bf16_t*)(ws + WS_KC);
        int fam, grp, b, h, qb;
        if (idx < 128) { fam = 2; grp = 1; b = idx >> 5; h = (idx >> 3) & 3; qb = idx & 7; }
        else if (idx < 256) { const int i = idx - 128; fam = 0; grp = 1; b = i >> 5; h = (i >> 3) & 3; qb = i & 7; }
        else if (idx < 512) { const int i = idx - 256; fam = 1; grp = 1; b = i >> 6; h = (i >> 3) & 7; qb = i & 7; }
        else if (idx < 640) { const int i = idx - 512; fam = 2; grp = 0; b = i >> 2; h = i & 3; qb = 0; }
        else if (idx < 768) { const int i = idx - 640; fam = 0; grp = 0; b = i >> 2; h = i & 3; qb = 0; }
        else { const int i = idx - 768; fam = 1; grp = 0; b = i >> 3; h = i & 7; qb = 0; }
        const int T = grp ? TLAT : TCTX, Hkv = fam == 1 ? 2 : 4, hk = fam == 1 ? (h >> 2) : h;
        const size_t ko = fam == 0 ? QO_KA : (fam == 1 ? QO_KB : QO_KC), vo = fam == 0 ? QO_VTA : (fam == 1 ? QO_VTB : QO_VTC); const size_t gk = fam == 1 ? GS2 : GS4;
        const int q0 = qb * 256;
        U.kso = (unsigned)(ko + grp * gk + (size_t)(b * Hkv + hk) * T * 64); U.vso = (unsigned)(vo + grp * gk + (size_t)(b * Hkv + hk) * 64 * T);
        const size_t cko = fam == 0 ? CO_KA : (fam == 1 ? CO_KB : CO_KCC), cvo = fam == 0 ? CO_VTA : (fam == 1 ? CO_VTB : CO_VTCC);
        U.kco = (unsigned)(cko + (size_t)((l * 4 + b) * Hkv + hk) * PAST * 64); U.vco = (unsigned)(cvo + (size_t)((l * 4 + b) * Hkv + hk) * 64 * PAST);
        int ta, tb;
        if (!grp) { ta = 0; tb = 4; }
        else if (fam == 0) { ta = max(4 * qb - 4, 0); tb = min(max(4 * qb - 1, 0), 24) + 8; }
        else if (fam == 1) { ta = max(q0 - 128, 0) >> 6; tb = min(q0 + 384, TLAT) >> 6; }
        else { ta = 0; tb = 32; }
        U.T = T; U.ta = ta; U.nself = tb - ta; U.ntile = U.nself + (grp ? 8 : 0); U.q0 = q0; U.grp = grp; U.fam = fam; U.b = b; U.h = h;
        GAS bf16_t* Obase = (GAS bf16_t*)(ws + WS_O) + (size_t)((grp ? MCTX + b * TLAT : b * TCTX)) * 1024 + (fam == 0 ? 0 : (fam == 1 ? 256 : 768)) + 64 * h;
        if (fam == 2) unit_loop<3>(lds, U, sm, Obase, l, tid);
        else if (!grp) unit_loop<0>(lds, U, sm, Obase, l, tid);
        else if (fam == 0) { if (tid < 465) *(LAS float*)(lds + LDS_RPB + 4 * tid) = sm[SM_RPB + (l * 4 + h) * 465 + tid]; unit_loop<1>(lds, U, sm, Obase, l, tid); }
        else unit_loop<2>(lds, U, sm, Obase, l, tid);
    }
}
}
namespace misc {
typedef LAS unsigned char lds_u8;
__device__ __forceinline__ float wave_sum(float v) {
#pragma unroll
    for (int o = 1; o < 64; o <<= 1) v += __shfl_xor(v, o);
    return v;
}
__device__ const double INVB[16] = {1.0, 0.5623413251903491, 0.31622776601683794, 0.1778279410038923, 0.1, 0.05623413251903491, 0.03162277660168379, 0.01778279410038923,
                                    0.01, 0.005623413251903491, 0.0031622776601683794, 0.001778279410038923, 0.001, 0.0005623413251903491, 0.00031622776601683794, 0.0001778279410038923};
__device__ const double INVC[8] = {1.0, 0.31622776601683794, 0.1, 0.03162277660168379, 0.01, 0.0031622776601683794, 0.001, 0.00031622776601683794};
__device__ __forceinline__ void sincos_d(double a, float& c, float& s) {
    const double k = rint(a * 0.6366197723675814);
    double r = fma(-k, 1.5707963267948966, a); r = fma(-k, 6.123233995736766e-17, r);
    const double r2 = r * r;
    const double sp = r * (1.0 + r2 * (-1.0 / 6.0 + r2 * (1.0 / 120.0 + r2 * (-1.0 / 5040.0 + r2 * (1.0 / 362880.0 + r2 * (-1.0 / 39916800.0 + r2 * (1.0 / 6227020800.0)))))));
    const double cp = 1.0 + r2 * (-0.5 + r2 * (1.0 / 24.0 + r2 * (-1.0 / 720.0 + r2 * (1.0 / 40320.0 + r2 * (-1.0 / 3628800.0 + r2 * (1.0 / 479001600.0 + r2 * (-1.0 / 87178291200.0)))))));
    const int q = ((int)k) & 3;
    const double cc = (q == 0) ? cp : (q == 1) ? -sp : (q == 2) ? -cp : sp;
    const double ss = (q == 0) ? sp : (q == 1) ? cp : (q == 2) ? -sp : -cp;
    c = (float)cc; s = (float)ss;
}
__device__ __forceinline__ void transpose_item(const float* W, int K, int N, bf16_t* WT, int k0, int n0, int dst0, LAS float* scr, int lane) {
    const int kr = lane >> 3, c4 = (lane & 7) * 4; f32x4 v[8];
#pragma unroll
    for (int i = 0; i < 8; ++i) v[i] = *(const f32x4*)(W + (size_t)(k0 + 8 * i + kr) * N + n0 + c4);
#pragma unroll
    for (int i = 0; i < 8; ++i) { LAS float* d = scr + (8 * i + kr) * 33 + c4; d[0] = v[i][0]; d[1] = v[i][1]; d[2] = v[i][2]; d[3] = v[i][3]; }
    asm volatile("s_waitcnt lgkmcnt(0)" ::: "memory");
    const int c = lane & 7;
#pragma unroll
    for (int j = 0; j < 4; ++j) { const int n = (lane >> 3) + 8 * j; const LAS float* s = scr + (8 * c) * 33 + n;
        u32x4 o; o.x = cvt_pk_bf16(s[0 * 33], s[1 * 33]); o.y = cvt_pk_bf16(s[2 * 33], s[3 * 33]); o.z = cvt_pk_bf16(s[4 * 33], s[5 * 33]); o.w = cvt_pk_bf16(s[6 * 33], s[7 * 33]);
        *(u32x4*)(WT + (size_t)(dst0 + n) * K + k0 + 8 * c) = o; }
    asm volatile("s_waitcnt lgkmcnt(0)" ::: "memory");
}
__device__ __forceinline__ void gemv5_item(const float* W, int N, int n0, const LAS float* vec, LAS float* red, const float* add, float* out, int ostride, int tid) {
    const int c2 = (tid & 31) * 2, kq = tid >> 5; f32x2 a0 = {0.f, 0.f}, a1 = a0, a2 = a0, a3 = a0, a4 = a0;
    const float* wp = W + (size_t)(kq * 64) * N + n0 + c2; const LAS float* vp = vec + kq * 64;
#pragma unroll 16
    for (int k = 0; k < 64; ++k) { const f32x2 w = *(const f32x2*)(wp + (size_t)k * N); a0 += w * vp[k]; a1 += w * vp[1024 + k]; a2 += w * vp[2048 + k]; a3 += w * vp[3072 + k]; a4 += w * vp[4096 + k]; }
    *(LAS f32x2*)(red + (kq * 5 + 0) * 64 + c2) = a0; *(LAS f32x2*)(red + (kq * 5 + 1) * 64 + c2) = a1; *(LAS f32x2*)(red + (kq * 5 + 2) * 64 + c2) = a2; *(LAS f32x2*)(red + (kq * 5 + 3) * 64 + c2) = a3; *(LAS f32x2*)(red + (kq * 5 + 4) * 64 + c2) = a4;
    __syncthreads();
    if (tid < 320) { const int b = tid >> 6, c = tid & 63; float s = add ? add[n0 + c] : 0.f;
#pragma unroll
        for (int q = 0; q < 16; ++q) s += red[(q * 5 + b) * 64 + c];
        out[(size_t)b * ostride + n0 + c] = s; }
    __syncthreads();
}

__device__ __forceinline__ void phase_tables(const Args& a) {
    const int gtid = blockIdx.x * 512 + opaque_tid(), NT = gridDim.x * 512; unsigned char* ws = a.ws;
    float* sm = (float*)(ws + WS_LAM);
    if (gtid < 4) { const int l = gtid; const float* lp = a.in[I_LAMBDA] + l * 128; float s1 = 0.f, s2 = 0.f;
        for (int i = 0; i < 32; ++i) { s1 += lp[i] * lp[32 + i]; s2 += lp[64 + i] * lp[96 + i]; }
        sm[SM_LAM + l] = expf(s1) - expf(s2) + (0.8f - 0.6f * expf(-0.3f * (float)l)); }
    for (int i = gtid; i < 1280; i += NT) { const int l = i / 320, r = i % 320; sm[SM_GAINS + i] = r < 128 ? a.in[I_NAG][l * 128 + r] : (r < 256 ? a.in[I_SWG][l * 128 + r - 128] : a.in[I_DAG][l * 64 + r - 256]); }
    for (int i = gtid; i < 7440; i += NT) sm[SM_RPB + i] = a.in[I_RPB][i] * LOG2E;
    for (int i = gtid; i < 32; i += NT) sm[SM_SINK + i] = a.in[I_SINK][i] * LOG2E;
    for (int i = gtid; i < 256; i += NT) sm[SM_SUBG + i] = a.in[I_SUBG][i];
    float* cv = (float*)(ws + WS_CONV);
    for (int i = gtid; i < 4 * 4 * DUP; i += NT) { const int c = i % DUP, j = (i / DUP) & 3, l = i / (4 * DUP); cv[i] = j < 3 ? a.in[I_CONVW][(size_t)(l * 3 + j) * DUP + c] : a.in[I_CONVB][(size_t)l * DUP + c]; }
    float* rb = (float*)(ws + WS_ROPEB); float* rc = (float*)(ws + WS_ROPEC);
    for (int i = gtid; i < 2048 * 32; i += NT) { const int t = i >> 5, j = i & 31; const double pos = (double)(j < 16 ? (t >> 6) : (t & 63)); float c, s; sincos_d(pos * INVB[j & 15], c, s); rb[2 * i] = c; rb[2 * i + 1] = s; }
    for (int i = gtid; i < 2048 * 16; i += NT) { const int t = i >> 4, j = i & 15; const double pos = (double)(j < 8 ? (t >> 6) : (t & 63)); float c, s; sincos_d(pos * INVC[j & 7], c, s); rc[2 * i] = c; rc[2 * i + 1] = s; }
}
constexpr int N_TR_IN = 144, N_TR_OUT = 64, N_TR_UP = 352, N_TR_DN = 176, N_MOD = 96, N_BIAS_IN = 36, N_BIAS_UP = 88, N_CACHE = 640;
__device__ __forceinline__ void fl_tr(lds_u8* lds, const Args& a, int l, int which, int bi, int tid) {
    const int lane = tid & 63, wave = __builtin_amdgcn_readfirstlane(tid >> 6); LAS float* scr = (LAS float*)(lds + wave * 16384); unsigned char* ws = a.ws; const int r = bi * 8 + wave;
    if (which == 0) { const int kb = r / 72, nb = r % 72, n0 = 32 * nb; const int tile = n0 >> 8, L = n0 & 255, wc = L >> 6, bj = (L >> 5) & 1; const int dst0 = 256 * tile + 128 * bj + 32 * wc;
        transpose_item(a.in[I_WIN] + (size_t)l * 1024 * DIN, 1024, DIN, (bf16_t*)(ws + WS_WIN) + (size_t)l * DIN * 1024, 64 * kb, n0, dst0, scr, lane); }
    else if (which == 1) { const int kb = r / 32, nb = r % 32; transpose_item(a.in[I_WOUT] + (size_t)l * 1024 * 1024, 1024, 1024, (bf16_t*)(ws + WS_WOUT) + (size_t)l * 1024 * 1024, 64 * kb, 32 * nb, 32 * nb, scr, lane); }
    else if (which == 2) { const int kb = r / 176, nb = r % 176, n0 = 32 * nb; const int nn = n0 < DFF ? n0 : n0 - DFF; const int dst0 = 256 * (nn >> 7) + (n0 < DFF ? 0 : 128) + (nn & 127);
        transpose_item(a.in[I_WUP] + (size_t)l * 1024 * DUP, 1024, DUP, (bf16_t*)(ws + WS_WUP) + (size_t)l * DUP * 1024, 64 * kb, n0, dst0, scr, lane); }
    else { const int kb = r / 32, nb = r % 32; transpose_item(a.in[I_WDOWN] + (size_t)l * DFF * 1024, DFF, 1024, (bf16_t*)(ws + WS_WDOWN) + (size_t)l * 1024 * DFF, 64 * kb, 32 * nb, 32 * nb, scr, lane); }
}
__device__ __forceinline__ void fl_mod(lds_u8* lds, const Args& a, int l, int g, int tid) {
    LAS float* vec = (LAS float*)lds; LAS float* red = (LAS float*)(lds + 20480);
    for (int i = tid; i < 5120; i += 512) { const int b5 = i >> 10, k = i & 1023; const float v = b5 == 0 ? a.in[I_CCTX][k] : a.in[I_C][(b5 - 1) * 1024 + k]; vec[i] = v / (1.f + __expf(-v)); }
    __syncthreads();
    gemv5_item(a.in[I_WMOD] + (size_t)l * 1024 * 6144, 6144, 64 * g, vec, red, a.in[I_BMOD] + l * 6144, (float*)(a.ws + WS_MOD) + (size_t)l * 5 * 6144, 6144, tid);
}
__device__ __forceinline__ void fl_bias(lds_u8* lds, const Args& a, int l, int which, int g, int tid) {
    LAS float* vec = (LAS float*)lds; LAS float* red = (LAS float*)(lds + 20480); const float* mod = (const float*)(a.ws + WS_MOD);
    for (int i = tid; i < 5120; i += 512) { const int b5 = i >> 10, k = i & 1023; vec[i] = mod[((size_t)(l * 5 + b5) * 6 + (which ? 3 : 0)) * 1024 + k]; }
    __syncthreads();
    if (!which) gemv5_item(a.in[I_WIN] + (size_t)l * 1024 * DIN, DIN, 64 * g, vec, red, nullptr, (float*)(a.ws + WS_BIASIN) + (size_t)l * 5 * DIN, DIN, tid);
    else gemv5_item(a.in[I_WUP] + (size_t)l * 1024 * DUP, DUP, 64 * g, vec, red, nullptr, (float*)(a.ws + WS_BIASUP) + (size_t)l * 5 * DUP, DUP, tid);
}
__device__ __forceinline__ void fl_gv(const Args& a, int l, int tid) {
    const float* mod = (const float*)(a.ws + WS_MOD); float* gv = (float*)(a.ws + WS_GV) + (size_t)l * 10240;
    for (int i = tid; i < 10240; i += 512) { const int c = i & 1023, which = (i >> 10) & 1, b5 = i >> 11;
        gv[i] = a.in[which ? I_GFFN : I_GATTN][l * 1024 + c] * (1.f + mod[((size_t)(l * 5 + b5) * 6 + (which ? 4 : 1)) * 1024 + c]); }
}
__device__ __forceinline__ void fl_cache(const Args& a, int l, int ci, int tid) {
    bf16_t* kc = (bf16_t*)(a.ws + WS_KC); int i = ci * 512 + tid;
    if (i < 163840) { const int fam = i < 65536 ? 0 : (i < 98304 ? 1 : 2); i -= fam == 0 ? 0 : (fam == 1 ? 65536 : 98304); const int H = fam == 1 ? 2 : 4;
        const float* ck = a.in[fam == 0 ? I_CNAK : (fam == 1 ? I_CSWK : I_CDAK)]; bf16_t* dk = kc + (fam == 0 ? CO_KA : (fam == 1 ? CO_KB : CO_KCC));
        const int d8 = i & 7, hh = (i >> 3) % H, p = (i / (8 * H)) & 511, b = i / (8 * H * 512);
        const float* s = ck + ((((size_t)b * 4 + l) * 512 + p) * H + hh) * 64 + d8 * 8; const f32x4 x = *(const f32x4*)s, y = *(const f32x4*)(s + 4);
        u32x4 o; o.x = cvt_pk_bf16(x[0], x[1]); o.y = cvt_pk_bf16(x[2], x[3]); o.z = cvt_pk_bf16(y[0], y[1]); o.w = cvt_pk_bf16(y[2], y[3]);
        *(u32x4*)(dk + ((((size_t)l * 4 + b) * H + hh) * 512 + p) * 64 + d8 * 8) = o; }
    else { i -= 163840; const int fam = i < 65536 ? 0 : (i < 98304 ? 1 : 2); i -= fam == 0 ? 0 : (fam == 1 ? 65536 : 98304); const int H = fam == 1 ? 2 : 4;
        const float* cv = a.in[fam == 0 ? I_CNAV : (fam == 1 ? I_CSWV : I_CDAV)]; bf16_t* dv = kc + (fam == 0 ? CO_VTA : (fam == 1 ? CO_VTB : CO_VTCC));
        const int d = i & 63, p8 = (i >> 6) & 63, hh = (i >> 12) % H, b = i / (4096 * H);
        const float* s = cv + ((((size_t)b * 4 + l) * 512 + p8 * 8) * H + hh) * 64 + d; float x[8];
#pragma unroll
        for (int j = 0; j < 8; ++j) x[j] = s[(size_t)j * H * 64];
        u32x4 o; o.x = cvt_pk_bf16(x[0], x[1]); o.y = cvt_pk_bf16(x[2], x[3]); o.z = cvt_pk_bf16(x[4], x[5]); o.w = cvt_pk_bf16(x[6], x[7]);
        *(u32x4*)(dv + ((((size_t)l * 4 + b) * H + hh) * 64 + d) * 512 + p8 * 8) = o; }
}
enum { SLOT_PROA = 0, SLOT_PROB = 1, SLOT_IN = 2, SLOT_UP = 3 };
__device__ __forceinline__ void fill_run(lds_u8* lds, const Args& a, int slot, int l, int rep = 0) {
    const int tid = opaque_tid();
    unsigned* counter = (unsigned*)(a.ws + WS_CTL) + 64 * (16 + 4 * slot + l) + rep;
    LAS unsigned* nxt = (LAS unsigned*)(lds + 131072 + 512);
    for (;;) {
        __syncthreads();
        if (tid == 0) *nxt = __hip_atomic_fetch_add(counter, 1u, __ATOMIC_RELAXED, __HIP_MEMORY_SCOPE_AGENT);
        __syncthreads();
        int i = (int)*nxt;
        if (slot == SLOT_PROA) {
            if (i < N_MOD) { fl_mod(lds, a, 0, i, tid); continue; } i -= N_MOD;
            if (i < N_TR_IN) { fl_tr(lds, a, 0, 0, i, tid); continue; }
            break;
        } else if (slot == SLOT_PROB) {
            if (i < 1) { fl_gv(a, 0, tid); continue; } i -= 1;
            if (i < N_BIAS_IN) { fl_bias(lds, a, 0, 0, i, tid); continue; }
            break;
        } else if (slot == SLOT_IN) {
            if (l == 0) { if (i < N_BIAS_UP) { fl_bias(lds, a, 0, 1, i, tid); continue; } i -= N_BIAS_UP; }
            if (l < 3) { if (i < N_MOD) { fl_mod(lds, a, l + 1, i, tid); continue; } i -= N_MOD; }
            if (i < N_CACHE) { fl_cache(a, l, i, tid); continue; } i -= N_CACHE;
            if (i < N_TR_OUT) { fl_tr(lds, a, l, 1, i, tid); continue; } i -= N_TR_OUT;
            if (i < N_TR_UP) { fl_tr(lds, a, l, 2, i, tid); continue; } i -= N_TR_UP;
            if (i < N_TR_DN) { fl_tr(lds, a, l, 3, i, tid); continue; } i -= N_TR_DN;
            if (l < 3) { if (i < N_TR_IN) { fl_tr(lds, a, l + 1, 0, i, tid); continue; } }
            break;
        } else {
            if (l >= 3) break;
            if (i < 1) { fl_gv(a, l + 1, tid); continue; } i -= 1;
            if (i < N_BIAS_IN) { fl_bias(lds, a, l + 1, 0, i, tid); continue; } i -= N_BIAS_IN;
            if (i < N_BIAS_UP) { fl_bias(lds, a, l + 1, 1, i, tid); continue; }
            break;
        }
    }
}
__device__ __forceinline__ void phase_make_xa(const Args& a, int l, int which, int first) {
    const int tid = opaque_tid(), lane = tid & 63, wave = tid >> 6; unsigned char* ws = a.ws;
    const float* mod = (const float*)(ws + WS_MOD); bf16_t* xa = (bf16_t*)(ws + WS_XA); float* ssq = (float*)(ws + WS_SSQ);
    const float* gsrc = a.in[which ? I_GFFN : I_GATTN] + l * 1024;
    for (int row = blockIdx.x * 8 + wave; row < MTOT; row += gridDim.x * 8) {
        const float* src = first ? (row < MCTX ? a.in[I_XP] + (size_t)row * 1024 : a.in[I_XS] + (size_t)(row - MCTX) * 1024) : a.out + (size_t)row * 1024;
        const float* sc = mod + ((size_t)(l * 5 + row_b5(row)) * 6 + (which ? 4 : 1)) * 1024;
        f32x4 v[4]; float s = 0.f;
#pragma unroll
        for (int j = 0; j < 4; ++j) { v[j] = *(const f32x4*)(src + 256 * j + 4 * lane); s += (v[j][0] * v[j][0] + v[j][1] * v[j][1]) + (v[j][2] * v[j][2] + v[j][3] * v[j][3]); }
        s = wave_sum(s);
#pragma unroll
        for (int j = 0; j < 4; ++j) { if (first) *(f32x4*)(a.out + (size_t)row * 1024 + 256 * j + 4 * lane) = v[j];
            const f32x4 g = *(const f32x4*)(gsrc + 256 * j + 4 * lane) * (*(const f32x4*)(sc + 256 * j + 4 * lane) + 1.0f);
            const f32x4 y = v[j] * g; u32x2 w; w.x = cvt_pk_bf16(y[0], y[1]); w.y = cvt_pk_bf16(y[2], y[3]); *(u32x2*)(xa + (size_t)row * 1024 + 256 * j + 4 * lane) = w; }
        if (lane < 16) ssq[(size_t)row * 16 + lane] = lane == 0 ? s : 0.f;
    }
}
}
constexpr int LDS_BYTES = 147456;
enum Phase { PH_MAKEXA = 2, PH_IN, PH_ATT, PH_OUT, PH_UP, PH_CONV, PH_DOWN };

__device__ __forceinline__ void run_phase(LAS unsigned char* lds, const Args& a, int ph, int l, int p1, int p2) {
    unsigned char* ws = a.ws; const int G = gridDim.x;
    switch (ph) {
    case PH_MAKEXA: misc::phase_make_xa(a, l, p1, p2); break;
    case PH_IN: {
        pg8::Gemm g{(const bf16_t*)(ws + WS_XA), (const bf16_t*)(ws + WS_WIN) + (size_t)l * DIN * 1024, MTOT, DIN, 1024}; pg8::StaticOrder S; S.init(MTOT, DIN, G, (int)blockIdx.x);
        pg8::EpiIn E{ws, a.out, l};
        pg8::gemm_phase<pg8::EpiIn, pg8::StaticOrder, true, true>(lds, g, S, E); } break;
    case PH_ATT: {
        att::Ctx C{ws, l, p1};
        att::attn_phase(lds, C); } break;
    case PH_OUT: {
        pg8::Gemm g{(const bf16_t*)(ws + WS_O), (const bf16_t*)(ws + WS_WOUT) + (size_t)l * 1024 * 1024, MTOT, 1024, 1024}; pg8::StaticOrder S; S.init(MTOT, 1024, G, (int)blockIdx.x);
        pg8::EpiRes E{ws, a.out, l, 0};
        pg8::gemm_phase<pg8::EpiRes, pg8::StaticOrder, false, true>(lds, g, S, E); } break;
    case PH_UP: {
        pg8::Gemm g{(const bf16_t*)(ws + WS_XA), (const bf16_t*)(ws + WS_WUP) + (size_t)l * DUP * 1024, MTOT, DUP, 1024}; pg8::UpOrder S; S.init_up(G, (int)blockIdx.x);
        pg8::EpiUpConv E{ws, l};
        pg8::gemm_phase<pg8::EpiUpConv, pg8::UpOrder, true, true>(lds, g, S, E); } break;
    case PH_DOWN: {
        pg8::Gemm g{(const bf16_t*)(ws + WS_ACT), (const bf16_t*)(ws + WS_WDOWN) + (size_t)l * 1024 * DFF, MTOT, 1024, DFF}; pg8::StaticOrder S; S.init(MTOT, 1024, G, (int)blockIdx.x);
        pg8::EpiRes E{ws, a.out, l, 1};
        pg8::gemm_phase<pg8::EpiRes, pg8::StaticOrder, false, true>(lds, g, S, E); } break;
    default: break;
    }
}

#define XB_TMO      128
#define XB_XCNT(j)  (256  + 64 * (j))
#define XB_XSUB(j)  (1280 + 64 * (j))
#define XB_XGEN(j)  (2304 + 64 * (j))
#define XB_TOP      3328
#define XB_TOPGEN   3392
#define XCD_BAR_WORDS 3456
#define XB_SPIN_CAP (1u << 18)
__device__ __forceinline__ unsigned xb_ld(unsigned* p)              { return __hip_atomic_load(p, __ATOMIC_RELAXED, __HIP_MEMORY_SCOPE_AGENT); }
__device__ __forceinline__ unsigned xb_add(unsigned* p, unsigned v) { return __hip_atomic_fetch_add(p, v, __ATOMIC_RELAXED, __HIP_MEMORY_SCOPE_AGENT); }
__device__ __forceinline__ unsigned xb_xcc_id() { return (unsigned)__builtin_amdgcn_s_getreg((3 << 11) | 20) & 0xFu; }
#define XB_SPIN(cond, bar) do { unsigned _sp = 0; while (cond) { __builtin_amdgcn_s_sleep(1); \
    if ((++_sp & 255u) == 0u) { if (xb_ld(&(bar)[XB_TMO])) break; if (_sp > XB_SPIN_CAP) { atomicAdd(&(bar)[XB_TMO], 1u); break; } } } } while (0)
struct XcdBarrier { unsigned* bar; unsigned x; volatile LAS unsigned* st; };
__device__ __forceinline__ XcdBarrier xcd_barrier_post(unsigned* bar, volatile LAS unsigned* st) {
    XcdBarrier b; b.bar = bar; b.x = xb_xcc_id(); b.st = st;
    if (threadIdx.x == 0) (void)xb_add(&bar[XB_XCNT(b.x)], 1u);
    return b;
}
__device__ __forceinline__ void xcd_barrier_complete(unsigned* bar, unsigned x, unsigned& nloc, unsigned& nx) {
    const unsigned G = gridDim.x * gridDim.y * gridDim.z;
    unsigned sum, cnt, mine, sp = 0u;
    for (;;) {
        sum = 0u; cnt = 0u; mine = 0u;
#pragma unroll
        for (unsigned j = 0; j < 16; ++j) { const unsigned c = xb_ld(&bar[XB_XCNT(j)]); sum += c; cnt += (c > 0u) ? 1u : 0u; mine = (j == x) ? c : mine; }
        if (sum == G) break;
        __builtin_amdgcn_s_sleep(1);
        if ((++sp & 255u) == 0u) { if (xb_ld(&bar[XB_TMO])) break; if (sp > XB_SPIN_CAP) { atomicAdd(&bar[XB_TMO], 1u); break; } }
    }
    nloc = mine > 0u ? mine : 1u; nx = cnt > 0u ? cnt : 1u;
}
__device__ __forceinline__ void xcd_barrier(const XcdBarrier& b) {
    asm volatile("s_waitcnt vmcnt(0)" ::: "memory");
    __syncthreads();
    if (threadIdx.x == 0) {
        unsigned* bar = b.bar;
        __builtin_amdgcn_s_waitcnt(0);
        unsigned nloc = b.st[0], nx = b.st[1];
        if (nloc == 0u) { xcd_barrier_complete(bar, b.x, nloc, nx); b.st[0] = nloc; b.st[1] = nx; }
        const unsigned old = xb_add(&bar[XB_XSUB(b.x)], 1u);
        const unsigned gen = old / nloc;
        if (old + 1u == (gen + 1u) * nloc) {
            __builtin_amdgcn_fence(__ATOMIC_RELEASE, "agent");
            asm volatile("s_waitcnt vmcnt(0)" ::: "memory");
            const unsigned og = xb_add(&bar[XB_TOP], 1u);
            const unsigned tg = og / nx;
            if (og + 1u == (tg + 1u) * nx) xb_add(&bar[XB_TOPGEN], 1u);
            else XB_SPIN(xb_ld(&bar[XB_TOPGEN]) == tg, bar);
            __builtin_amdgcn_fence(__ATOMIC_ACQUIRE, "agent");
            xb_add(&bar[XB_XGEN(b.x)], 1u);
            asm volatile("s_waitcnt vmcnt(0)" ::: "memory");
        } else {
            XB_SPIN(xb_ld(&bar[XB_XGEN(b.x)]) == gen, bar);
            __builtin_amdgcn_fence(__ATOMIC_ACQUIRE, "agent");
            asm volatile("s_waitcnt vmcnt(0)" ::: "memory");
        }
    }
    __syncthreads();
}
constexpr int CW_BAR = 4096;
constexpr int LDS_BARST = 131072 + 256;
__global__ void __launch_bounds__(512, 2) mk_fwd(Args a) {
    extern __shared__ __attribute__((aligned(16))) unsigned char lds_raw[];
    LAS unsigned char* lds = (LAS unsigned char*)lds_raw;
    cg::grid_group grid = cg::this_grid();
    if (threadIdx.x < 2) ((volatile LAS unsigned*)(lds + LDS_BARST))[threadIdx.x] = 0u;
    __syncthreads();
    const XcdBarrier xbar = xcd_barrier_post((unsigned*)(a.ws + WS_CTL) + CW_BAR, (volatile LAS unsigned*)(lds + LDS_BARST));
#define GSYNC() xcd_barrier(xbar)
    misc::phase_tables(a); misc::fill_run(lds, a, misc::SLOT_PROA, 0); grid.sync();
#ifdef FILL_UPFRONT
    misc::fill_run(lds, a, misc::SLOT_PROB, 0);
#pragma unroll 1
    for (int l = 0; l < DEPTH; ++l) misc::fill_run(lds, a, misc::SLOT_IN, l);
    GSYNC();
#pragma unroll 1
    for (int l = 0; l < DEPTH - 1; ++l) misc::fill_run(lds, a, misc::SLOT_UP, l);
    run_phase(lds, a, PH_MAKEXA, 0, 0, 1); GSYNC();
#else
    misc::fill_run(lds, a, misc::SLOT_PROB, 0); run_phase(lds, a, PH_MAKEXA, 0, 0, 1); GSYNC();
#endif
#ifndef REP_IN
#define REP_IN 1
#endif
#ifndef REP_ATT
#define REP_ATT 1
#endif
#ifndef REP_UP
#define REP_UP 1
#endif
#pragma unroll 1
    for (int l = 0; l < DEPTH; ++l) {
#pragma unroll 1
        for (int rep = 0; rep < REP_IN; ++rep) { run_phase(lds, a, PH_IN, l, 0, 0); if (rep == 0) {
#ifndef FILL_UPFRONT
            misc::fill_run(lds, a, misc::SLOT_IN, l);
#endif
#ifdef REP_FILL
            misc::fill_run(lds, a, misc::SLOT_IN, l, 1);
#endif
        } GSYNC(); }
#pragma unroll 1
        for (int rep = 0; rep < REP_ATT; ++rep) { run_phase(lds, a, PH_ATT, l, rep, 0); GSYNC(); }
        run_phase(lds, a, PH_OUT, l, 0, 0); GSYNC();
#pragma unroll 1
        for (int rep = 0; rep < REP_UP; ++rep) { run_phase(lds, a, PH_UP, l, 0, 0); if (rep == 0) {
#ifndef FILL_UPFRONT
            misc::fill_run(lds, a, misc::SLOT_UP, l);
#endif
#ifdef REP_FILL
            misc::fill_run(lds, a, misc::SLOT_UP, l, 1);
#endif
        } GSYNC(); }
        run_phase(lds, a, PH_DOWN, l, 0, 0);
        if (l < DEPTH - 1) GSYNC();
    }
}

extern "C" void kernel_launch(void* const* d_in, const int* in_sizes, int n_in, void* d_out, int out_size, void* d_ws, size_t ws_size, hipStream_t stream) {
    static int grid = 0;
    if (grid == 0) {
        int dev = 0, cus = 0, per_cu = 0;
        (void)hipGetDevice(&dev); (void)hipDeviceGetAttribute(&cus, hipDeviceAttributeMultiprocessorCount, dev);
        (void)hipFuncSetAttribute((const void*)mk_fwd, hipFuncAttributeMaxDynamicSharedMemorySize, LDS_BYTES);
        (void)hipOccupancyMaxActiveBlocksPerMultiprocessor(&per_cu, (const void*)mk_fwd, 512, LDS_BYTES);
        if (per_cu < 1) fprintf(stderr, "kernel_launch: occupancy query reports %d blocks per CU\n", per_cu);
        grid = cus > 0 ? cus : 256;
        if (ws_size < WS_END) { fprintf(stderr, "kernel_launch: workspace too small (%zu < %zu)\n", ws_size, (size_t)WS_END); grid = -1; }
    }
    if (grid < 0) return;
    Args a{}; for (int i = 0; i < N_IN; ++i) a.in[i] = (const float*)d_in[i]; a.out = (float*)d_out; a.ws = (unsigned char*)d_ws;
    (void)hipMemsetAsync((unsigned char*)d_ws + WS_CTL, 0, 1 * MiB, stream);
    void* args[] = {&a};
    hipError_t e = hipLaunchCooperativeKernel((const void*)mk_fwd, dim3(grid), dim3(512), args, LDS_BYTES, stream);
    if (e != hipSuccess) fprintf(stderr, "cooperative launch failed: %s (grid %d)\n", hipGetErrorString(e), grid);
}
```

```cpp
#include <hip/hip_runtime.h>
#include <hip/hip_cooperative_groups.h>
#include <cstdio>
#include <cstdint>
namespace cg = cooperative_groups;

constexpr int DEPTH = 4, NCTX = 32, TCTX = 256, NLAT = 4, TLAT = 2048, PAST = 512;
constexpr int MCTX = 8192, MLAT = 8192, MTOT = 16384;
constexpr int DIN = 2304, DFF = 2816, DUP = 5632;
constexpr size_t OUT_X = 0, OUT_NAK = 16777216, OUT_NAV = 25165824, OUT_SWK = 33554432, OUT_SWV = 37748736, OUT_DAK = 41943040, OUT_DAV = 50331648, OUT_TOTAL = 58720256;
enum { I_XP = 0, I_XS, I_CNAK, I_CNAV, I_CSWK, I_CSWV, I_CDAK, I_CDAV, I_C, I_CCTX, I_GATTN, I_GFFN, I_WMOD, I_BMOD, I_WIN, I_NAG, I_RPB, I_SWG, I_SINK, I_DAG, I_LAMBDA, I_SUBG, I_WOUT, I_WUP, I_CONVW, I_CONVB, I_WDOWN, N_IN };
#define LAS __attribute__((address_space(3)))
#define GAS __attribute__((address_space(1)))
typedef unsigned short bf16_t;
typedef short bf16x8 __attribute__((ext_vector_type(8)));
typedef float f32x4 __attribute__((ext_vector_type(4)));
typedef float f32x2 __attribute__((ext_vector_type(2)));
typedef float f32x16 __attribute__((ext_vector_type(16)));
typedef unsigned u32x4 __attribute__((ext_vector_type(4)));
typedef unsigned u32x2 __attribute__((ext_vector_type(2)));
typedef __bf16 bf16x2_t __attribute__((ext_vector_type(2)));

constexpr float LOG2E = 1.4426950408889634f;
constexpr float QSCALE64 = 0.125f * LOG2E, QSCALE32 = 0.17677669529663687f * LOG2E;

__device__ __forceinline__ unsigned cvt_pk_bf16(float lo, float hi) { f32x2 v = {lo, hi}; bf16x2_t b = __builtin_convertvector(v, bf16x2_t); return __builtin_bit_cast(unsigned, b); }
__device__ __forceinline__ float bf16_to_f32(bf16_t v) { return __builtin_bit_cast(float, (unsigned)v << 16); }
__device__ __forceinline__ int row_b5(int row) { return row < MCTX ? 0 : 1 + ((row - MCTX) >> 11); }

constexpr size_t MiB = 1u << 20;
constexpr size_t WS_CTL = 0;
constexpr size_t WS_MOD = 1 * MiB;
constexpr size_t WS_GV = WS_MOD + 512 * 1024;
constexpr size_t WS_BIASIN = WS_GV + 256 * 1024;
constexpr size_t WS_BIASUP = WS_BIASIN + 256 * 1024;
constexpr size_t WS_LAM = WS_BIASUP + 512 * 1024;
constexpr int SM_LAM = 0, SM_GAINS = 64, SM_RPB = SM_GAINS + 1280, SM_SINK = SM_RPB + 7440, SM_SUBG = SM_SINK + 32, SM_END = SM_SUBG + 256;
constexpr size_t WS_ROPEB = 3 * MiB;
constexpr size_t WS_ROPEC = WS_ROPEB + 512 * 1024;
constexpr size_t WS_SSQ = 4 * MiB;
constexpr size_t WS_CONV = 5 * MiB;
constexpr size_t WS_WIN = 6 * MiB;
constexpr size_t WS_WOUT = WS_WIN + 18 * MiB;
constexpr size_t WS_WUP = WS_WOUT + 8 * MiB;
constexpr size_t WS_WDOWN = WS_WUP + 44 * MiB;
constexpr size_t WS_KC = WS_WDOWN + 22 * MiB;
constexpr size_t WS_XA = WS_KC + 20 * MiB;
constexpr size_t WS_QKV = WS_XA + 32 * MiB + 1 * MiB;
constexpr size_t WS_O = WS_QKV + 72 * MiB;
constexpr size_t WS_ACT = WS_QKV;
constexpr size_t WS_END = WS_O + 32 * MiB;
constexpr size_t GS4 = 2097152, GS8 = 4194304, GS2 = 1048576;
constexpr size_t QO_QA = 0, QO_KA = QO_QA + 2 * GS4, QO_VTA = QO_KA + 2 * GS4, QO_QB = QO_VTA + 2 * GS4, QO_KB = QO_QB + 2 * GS8, QO_VTB = QO_KB + 2 * GS2,
                 QO_QC = QO_VTB + 2 * GS2, QO_KC = QO_QC + 2 * GS4, QO_VTC = QO_KC + 2 * GS4, QO_END = QO_VTC + 2 * GS4;
static_assert(QO_END * 2 == 72 * MiB, "qkv region");
constexpr size_t CO_KA = 0, CO_VTA = CO_KA + GS4, CO_KB = CO_VTA + GS4, CO_VTB = CO_KB + GS2, CO_KCC = CO_VTB + GS2, CO_VTCC = CO_KCC + GS4;

struct Args { const float* in[N_IN]; float* out; unsigned char* ws; };
__device__ __forceinline__ int opaque_tid() { int t = threadIdx.x; asm volatile("" : "+v"(t)); return t; }

namespace pg8 {
#define PG8_LAS __attribute__((address_space(3)))
constexpr int BM = 256, BK = 64, HALF = 128, HTB = HALF * BK * 2  , STAGE_BYTES = 8 * HTB, NXCD = 8, WGM = 8;
__host__ __device__ __forceinline__ int lds_byte(int r, int c) { const int st = (r >> 4) * 2 + (c >> 5), rr = r & 15, cc = c & 31, ob = rr * 64 + cc * 2; return st * 1024 + (ob ^ (((ob >> 9) & 1) << 5)); }
__host__ __device__ __forceinline__ void stage_rc(int b, int& R, int& C) { const int st = b / 1024, sb = b % 1024, swz = sb ^ (((sb >> 9) & 1) << 5); R = (st >> 1) * 16 + swz / 64; C = (st & 1) * 32 + (swz % 64) / 2; }
__host__ __device__ __forceinline__ int perm32(int rho) { const int n = rho >> 4, i = rho & 15; return 8 * (i >> 2) + 4 * n + (i & 3); }
struct Unit { int pm, pn; };
struct Gemm { const bf16_t* A; const bf16_t* Bt; int M, N, K; volatile unsigned long long* ts = nullptr; };
struct StaticOrder {
    int nM, nN, nwg, G, c;
    __host__ __device__ void init(int M, int N, int G_, int c_) { nM = M / BM; nN = N / BM; nwg = nM * nN; G = G_; c = c_; }
    __host__ __device__ bool next(int i, Unit& u) const {
        const long L = (long)i * G + c; if (L >= nwg) return false;
        int wgid = (int)L; { const int q = nwg / NXCD, r = nwg % NXCD, xcd = wgid % NXCD, off = wgid / NXCD; wgid = (xcd < r ? xcd * (q + 1) : r * (q + 1) + (xcd - r) * q) + off; }
        const int nig = WGM * nN, gid = wgid / nig, fm = gid * WGM, gsz = (nM - fm) < WGM ? (nM - fm) : WGM;
        u.pm = fm + ((wgid % nig) % gsz); u.pn = (wgid % nig) / gsz; return true;
    }
    __device__ __forceinline__ void a_ready(const Unit&) const {}
    __device__ __forceinline__ void done(const Unit&) const {}
    __device__ __forceinline__ int arow0(int pm) const { return BM * pm; }
};
struct OneUnit {
    int pm;
    __device__ __forceinline__ bool next(int i, Unit& u) const { if (i > 0) return false; u.pm = pm; u.pn = 0; return true; }
    __device__ __forceinline__ void a_ready(const Unit&) const {}
    __device__ __forceinline__ void done(const Unit&) const {}
    __device__ __forceinline__ int arow0(int pm_) const { return BM * pm_; }
};
struct UpOrder : StaticOrder {
    __device__ __forceinline__ void init_up(int G_, int c_) { nM = 68; nN = 22; nwg = nM * nN; G = G_; c = c_; }
    __device__ __forceinline__ int arow0(int pm) const { return pm < 32 ? BM * pm : MCTX + TLAT * ((pm - 32) / 9) + 254 * ((pm - 32) % 9) - 1; }
};

template <class Epi, class Sched, bool ALIGN_EPI = false, bool SP2 = false>
__device__ __forceinline__ void gemm_phase(PG8_LAS unsigned char* lds, const Gemm g, const Sched& S, const Epi& E) {
    const int tid = opaque_tid(), wid = __builtin_amdgcn_readfirstlane(tid >> 6), lane = tid & 63, wr = wid >> 2, wc = wid & 3, fr = lane & 15, fq = lane >> 4;
    const int K = g.K, nt = K / BK;
    unsigned voffA[2], voffB[2];
#pragma unroll
    for (int i = 0; i < 2; ++i) { int R, C; stage_rc(tid * 16 + i * 8192, R, C); const int Rb = Epi::PERM ? ((R & ~31) + perm32(R & 31)) : R;
        voffA[i] = (unsigned)(R * K + C) * 2u; voffB[i] = (unsigned)(Rb * K + C) * 2u; }
    const size_t kstep = (size_t)(BK * 2);
    const size_t hstep = (size_t)HALF * K * 2;
    const size_t tstep = 2 * hstep;
    const unsigned ldsw = (unsigned)wid * 1024u;
    const int aoff = lds_byte(wr * 64 + fr, fq * 8), boff = lds_byte(wc * 32 + fr, fq * 8);
#define PG8_SA(b, h) (((b) * 2 + (h)) * HTB)
#define PG8_SB(b, h) ((4 + (b) * 2 + (h)) * HTB)
#define PG8_STAGE(bufoff, gbase, voff) do { _Pragma("unroll") for (int _i = 0; _i < 2; ++_i) \
        __builtin_amdgcn_global_load_lds((const unsigned*)((const char*)(gbase) + (voff)[_i]), (PG8_LAS unsigned*)(lds + (bufoff) + ldsw + _i * 8192), 16, 0, 0); } while (0)
#define PG8_LDA(dst, b, h) do { _Pragma("unroll") for (int m = 0; m < 4; ++m) _Pragma("unroll") for (int k = 0; k < 2; ++k) dst[m][k] = *(const PG8_LAS bf16x8*)(lds + PG8_SA(b, h) + aoff + m * 2048 + k * 1024); } while (0)
#define PG8_LDB(dst, b, h) do { _Pragma("unroll") for (int n = 0; n < 2; ++n) _Pragma("unroll") for (int k = 0; k < 2; ++k) dst[n][k] = *(const PG8_LAS bf16x8*)(lds + PG8_SB(b, h) + boff + n * 2048 + k * 1024); } while (0)
#define PG8_MMA(ai, bj, At, Bt) do { __builtin_amdgcn_s_setprio(1); _Pragma("unroll") for (int m = 0; m < 4; ++m) _Pragma("unroll") for (int n = 0; n < 2; ++n) _Pragma("unroll") for (int k = 0; k < 2; ++k) \
        acc[ai][bj][m][n] = __builtin_amdgcn_mfma_f32_16x16x32_bf16(Bt[n][k], At[m][k], acc[ai][bj][m][n], 0, 0, 0); __builtin_amdgcn_s_setprio(0); } while (0)
#define PG8_WAIT_V(n) asm volatile("s_waitcnt vmcnt(" #n ")" ::: "memory")
#define PG8_WAIT_L(n) asm volatile("s_waitcnt lgkmcnt(" #n ")" ::: "memory")
#define PG8_BAR __builtin_amdgcn_s_barrier()
#define PG8_SCHED __builtin_amdgcn_sched_barrier(0)
    Unit cur, nxt; int ui = 0;
    if (!S.next(0, cur)) return;
    f32x4 acc[2][2][4][2];
#pragma unroll
    for (int a = 0; a < 2; ++a)
#pragma unroll
        for (int b = 0; b < 2; ++b)
#pragma unroll
            for (int m = 0; m < 4; ++m)
#pragma unroll
                for (int n = 0; n < 2; ++n) acc[a][b][m][n] = (f32x4){0.f, 0.f, 0.f, 0.f};
    bf16x8 At[4][2], B0[2][2], B1[2][2];
    const size_t rstep = (size_t)K * 2;
    const char* cA = (const char*)g.A + (size_t)S.arow0(cur.pm) * rstep; const char* cB = (const char*)g.Bt + (size_t)cur.pn * tstep;
    S.a_ready(cur);
    if constexpr (SP2) {
        PG8_STAGE(PG8_SB(0, 0), cB, voffB); PG8_STAGE(PG8_SB(0, 1), cB + hstep, voffB); PG8_STAGE(PG8_SA(0, 0), cA, voffA); PG8_STAGE(PG8_SA(0, 1), cA + hstep, voffA);
        if (wr == 1) PG8_BAR;
        PG8_WAIT_V(2); PG8_BAR;
        PG8_STAGE(PG8_SB(1, 0), cB + kstep, voffB); PG8_STAGE(PG8_SA(1, 0), cA + kstep, voffA); PG8_STAGE(PG8_SB(1, 1), cB + hstep + kstep, voffB);
        PG8_WAIT_V(6); PG8_BAR;
    } else {
        PG8_STAGE(PG8_SB(0, 0), cB, voffB); PG8_STAGE(PG8_SA(0, 0), cA, voffA); PG8_STAGE(PG8_SB(0, 1), cB + hstep, voffB); PG8_STAGE(PG8_SA(0, 1), cA + hstep, voffA);
        if (wr == 1) PG8_BAR;
        PG8_WAIT_V(4); PG8_BAR;
        PG8_STAGE(PG8_SB(1, 0), cB + kstep, voffB); PG8_STAGE(PG8_SA(1, 0), cA + kstep, voffA); PG8_STAGE(PG8_SB(1, 1), cB + hstep + kstep, voffB);
        PG8_WAIT_V(6); PG8_BAR;
    }
    for (;;) {
        const bool has_next = S.next(ui + 1, nxt);
        const char* nA = has_next ? (const char*)g.A + (size_t)S.arow0(nxt.pm) * rstep : cA; const char* nB = has_next ? (const char*)g.Bt + (size_t)nxt.pn * tstep : cB;
        for (int t = 0; t < nt; t += 2) {
            const bool last = (t == nt - 2);
            const char* a1 = cA + (size_t)(t + 1) * kstep;
            const char* a2 = last ? nA : cA + (size_t)(t + 2) * kstep; const char* b2 = last ? nB : cB + (size_t)(t + 2) * kstep;
            const char* a3 = a2 + kstep; const char* b3 = b2 + kstep;
            if (last && has_next) S.a_ready(nxt);
            if constexpr (SP2) {
            PG8_LDB(B0, 0, 0); PG8_LDB(B1, 0, 1); PG8_SCHED; PG8_LDA(At, 0, 0); PG8_STAGE(PG8_SA(1, 1), a1 + hstep, voffA);
            PG8_WAIT_V(8); PG8_WAIT_L(0); PG8_BAR; PG8_MMA(0, 0, At, B0); PG8_MMA(0, 1, At, B1); PG8_BAR; PG8_SCHED;
            PG8_LDA(At, 0, 1); PG8_STAGE(PG8_SB(0, 0), b2, voffB); PG8_STAGE(PG8_SB(0, 1), b2 + hstep, voffB); PG8_STAGE(PG8_SA(0, 0), a2, voffA);
            PG8_WAIT_V(8); PG8_WAIT_L(0); PG8_BAR; PG8_MMA(1, 0, At, B0); PG8_MMA(1, 1, At, B1); PG8_BAR; PG8_SCHED;
            PG8_LDB(B0, 1, 0); PG8_LDB(B1, 1, 1); PG8_SCHED; PG8_LDA(At, 1, 0); PG8_STAGE(PG8_SA(0, 1), a2 + hstep, voffA);
            PG8_WAIT_V(8); PG8_WAIT_L(0); PG8_BAR; PG8_MMA(0, 0, At, B0); PG8_MMA(0, 1, At, B1); PG8_BAR; PG8_SCHED;
            PG8_LDA(At, 1, 1); PG8_STAGE(PG8_SB(1, 0), b3, voffB); PG8_STAGE(PG8_SB(1, 1), b3 + hstep, voffB); PG8_STAGE(PG8_SA(1, 0), a3, voffA);
            PG8_WAIT_V(8); PG8_WAIT_L(0); PG8_BAR; PG8_MMA(1, 0, At, B0); PG8_MMA(1, 1, At, B1); PG8_BAR; PG8_SCHED;
            } else {
            PG8_LDB(B0, 0, 0); PG8_SCHED; PG8_LDA(At, 0, 0); PG8_STAGE(PG8_SA(1, 1), a1 + hstep, voffA);
            PG8_WAIT_L(8); PG8_BAR; PG8_WAIT_L(0); PG8_MMA(0, 0, At, B0); PG8_BAR; PG8_SCHED;
            PG8_LDB(B1, 0, 1); PG8_STAGE(PG8_SB(0, 0), b2, voffB);
            PG8_BAR; PG8_WAIT_L(0); PG8_MMA(0, 1, At, B1); PG8_BAR;
            PG8_LDA(At, 0, 1); PG8_STAGE(PG8_SA(0, 0), a2, voffA);
            PG8_BAR; PG8_WAIT_L(0); PG8_MMA(1, 0, At, B0); PG8_BAR; PG8_SCHED;
            PG8_STAGE(PG8_SB(0, 1), b2 + hstep, voffB);
            PG8_WAIT_V(6); PG8_BAR; PG8_MMA(1, 1, At, B1); PG8_BAR;
            PG8_LDB(B0, 1, 0); PG8_SCHED; PG8_LDA(At, 1, 0); PG8_STAGE(PG8_SA(0, 1), a2 + hstep, voffA);
            PG8_WAIT_L(8); PG8_BAR; PG8_WAIT_L(0); PG8_MMA(0, 0, At, B0); PG8_BAR; PG8_SCHED;
            PG8_LDB(B1, 1, 1); PG8_STAGE(PG8_SB(1, 0), b3, voffB);
            PG8_BAR; PG8_WAIT_L(0); PG8_MMA(0, 1, At, B1); PG8_BAR;
            PG8_LDA(At, 1, 1); PG8_STAGE(PG8_SA(1, 0), a3, voffA);
            PG8_BAR; PG8_WAIT_L(0); PG8_MMA(1, 0, At, B0); PG8_BAR; PG8_SCHED;
            PG8_STAGE(PG8_SB(1, 1), b3 + hstep, voffB);
            PG8_WAIT_V(6); PG8_BAR; PG8_MMA(1, 1, At, B1); PG8_BAR;
            }
        }
        if constexpr (ALIGN_EPI) { if (wr == 0) PG8_BAR; }
#ifdef TS_GEMM
        if (g.ts && tid == 0) g.ts[30 + 2 * ui] = __builtin_amdgcn_s_memrealtime();
#endif
        if constexpr (!Epi::AFTER_DRAIN) { if constexpr (Epi::NEEDS_LDS) E(acc, cur, wr, wc, fr, fq, lds); else E(acc, cur, wr, wc, fr, fq); S.done(cur); }
#ifdef TS_GEMM
        if (g.ts && tid == 0) g.ts[31 + 2 * ui] = __builtin_amdgcn_s_memrealtime();
#endif
        if (!has_next) break;
#pragma unroll
        for (int a = 0; a < 2; ++a)
#pragma unroll
            for (int b = 0; b < 2; ++b)
#pragma unroll
                for (int m = 0; m < 4; ++m)
#pragma unroll
                    for (int n = 0; n < 2; ++n) acc[a][b][m][n] = (f32x4){0.f, 0.f, 0.f, 0.f};
        cur = nxt; cA = nA; cB = nB; ++ui;
        if constexpr (ALIGN_EPI) { if (wr == 1) PG8_BAR; }
    }
    PG8_WAIT_V(0);
    if constexpr (!ALIGN_EPI) { if (wr == 0) PG8_BAR; }
    PG8_BAR;
    if constexpr (Epi::AFTER_DRAIN) { E.fused(acc, cur, wr, wc, fr, fq, lds, wid, lane); S.done(cur); }
#undef PG8_SA
#undef PG8_SB
#undef PG8_STAGE
#undef PG8_LDA
#undef PG8_LDB
#undef PG8_MMA
#undef PG8_WAIT_V
#undef PG8_WAIT_L
#undef PG8_BAR
#undef PG8_SCHED
}

constexpr int LDS_EDGE = 131072 + 1024;
constexpr int LDS_RSTD = LDS_EDGE + 8192;
__device__ __forceinline__ void rstd_table(PG8_LAS unsigned char* lds, const GAS float* ssq, int arow0, int wr, int wc, int fr, int fq) {
    const int tid = (wr * 4 + wc) * 64 + fq * 16 + fr, r = tid >> 1, hf = tid & 1;
    const f32x2 a = *(const GAS f32x2*)(ssq + (size_t)min(arow0 + r, MTOT - 1) * 4 + 2 * hf);
    float s = a[0] + a[1]; s += __shfl_xor(s, 1);
    if (!hf) ((PG8_LAS float*)(lds + LDS_RSTD))[r] = __builtin_amdgcn_rsqf(s * (1.0f / 1024.0f) + 1e-6f);
}
__device__ __forceinline__ float xsum_fq(float v) {
    auto a = __builtin_amdgcn_permlane16_swap(__float_as_uint(v), __float_as_uint(v), false, false); v = __uint_as_float(a[0]) + __uint_as_float(a[1]);
    auto b = __builtin_amdgcn_permlane32_swap(__float_as_uint(v), __float_as_uint(v), false, false); return __uint_as_float(b[0]) + __uint_as_float(b[1]);
}
__device__ __forceinline__ float wave_sum_dpp(float v) {
    v += __builtin_bit_cast(float, __builtin_amdgcn_mov_dpp(__builtin_bit_cast(int, v), 0xB1, 0xf, 0xf, true));
    v += __builtin_bit_cast(float, __builtin_amdgcn_mov_dpp(__builtin_bit_cast(int, v), 0x4E, 0xf, 0xf, true));
    v += __builtin_bit_cast(float, __builtin_amdgcn_mov_dpp(__builtin_bit_cast(int, v), 0x124, 0xf, 0xf, true));
    v += __builtin_bit_cast(float, __builtin_amdgcn_mov_dpp(__builtin_bit_cast(int, v), 0x128, 0xf, 0xf, true));
    return xsum_fq(v);
}
#define EPI_BARRIER() do { asm volatile("s_waitcnt lgkmcnt(0)" ::: "memory"); __builtin_amdgcn_s_barrier(); asm volatile("" ::: "memory"); } while (0)

struct EpiIn {
    static constexpr bool PERM = false, AFTER_DRAIN = false, NEEDS_LDS = true;
    unsigned char* ws0; float* out; int l; int pn_off;
    __device__ __forceinline__ void operator()(const f32x4 (&acc)[2][2][4][2], const Unit& u, int wr, int wc, int fr_in, int fq_in, PG8_LAS unsigned char* lds) const {
        unsigned char* ws_ = ws0; asm volatile("" : "+s"(ws_));
        GAS unsigned char* ws = (GAS unsigned char*)ws_; GAS float* outg = (GAS float*)out;
        int fr = fr_in, fq = fq_in; asm volatile("" : "+v"(fr), "+v"(fq));
        const GAS float* ssq = (const GAS float*)(ws + WS_SSQ); const GAS float* bias = (const GAS float*)(ws + WS_BIASIN) + (size_t)l * 5 * DIN;
        const GAS float* gains = (const GAS float*)(ws + WS_LAM) + SM_GAINS + l * 320; const GAS float* nag = gains; const GAS float* swg = gains + 128; const GAS float* dag = gains + 256;
        const GAS float* ropeB = (const GAS float*)(ws + WS_ROPEB); const GAS float* ropeC = (const GAS float*)(ws + WS_ROPEC); GAS bf16_t* qkv = (GAS bf16_t*)(ws + WS_QKV);
        const int pm = u.pm, pn = u.pn + pn_off;
        const int grp = pm >= 32 ? 1 : 0, b = grp ? ((pm - 32) >> 3) : pm, tbase = grp ? 256 * ((pm - 32) & 7) : 0, T = grp ? TLAT : TCTX, b5 = grp ? 1 + b : 0;
        int type, h;
        if (pn < 3) { type = pn; h = wc; } else if (pn < 5) { type = 3; h = 4 * (pn - 3) + wc; } else if (pn == 5) { type = wc < 2 ? 4 : 5; h = wc & 1; } else { type = pn; h = wc; }
        const bool isv = (type == 2 || type == 5 || type == 8), isq = (type == 0 || type == 3 || type == 6), is32 = (type == 6 || type == 7);
        const bool rope = grp && (type == 3 || type == 4 || type == 6 || type == 7);
        const int H = (type == 3) ? 8 : ((type == 4 || type == 5) ? 2 : 4);
        size_t dbase; const size_t gs = (type == 3) ? GS8 : ((type == 4 || type == 5) ? GS2 : GS4);
        switch (type) { case 0: dbase = QO_QA; break; case 1: dbase = QO_KA; break; case 2: dbase = QO_VTA; break; case 3: dbase = QO_QB; break; case 4: dbase = QO_KB; break; case 5: dbase = QO_VTB; break;
                        case 6: dbase = QO_QC; break; case 7: dbase = QO_KC; break; default: dbase = QO_VTC; break; }
        GAS bf16_t* dst = qkv + dbase + grp * gs + (size_t)(b * H + h) * T * 64;
        GAS float* fo = nullptr; int fow = 0, foc = 0;
        if (!grp) { switch (type) { case 1: fo = outg + OUT_NAK; fow = 256; foc = 64 * wc; break; case 2: fo = outg + OUT_NAV; fow = 256; foc = 64 * wc; break; case 4: fo = outg + OUT_SWK; fow = 128; foc = 64 * h; break;
                        case 5: fo = outg + OUT_SWV; fow = 128; foc = 64 * h; break; case 7: fo = outg + OUT_DAK; fow = 256; foc = 64 * wc; break; case 8: fo = outg + OUT_DAV; fow = 256; foc = 64 * wc; break; default: break; } }
        const GAS float* gsrc = ((type == 0) ? nag : (type == 1) ? nag + 64 : (type == 3) ? swg : (type == 4) ? swg + 64 : (type == 6) ? dag : dag + 32) + 4 * fq;
        const GAS float* bsrc = bias + b5 * DIN + pn * 256 + 64 * wc + 4 * fq;
        rstd_table(lds, ssq, 256 * pm, wr, wc, fr, fq);
        f32x4 bv[2][2], gv[2][2];
#pragma unroll
        for (int bj = 0; bj < 2; ++bj)
#pragma unroll
            for (int n = 0; n < 2; ++n) { bv[bj][n] = *(const GAS f32x4*)(bsrc + 32 * bj + 16 * n); gv[bj][n] = isv ? (f32x4){1.f, 1.f, 1.f, 1.f} : *(const GAS f32x4*)(gsrc + (is32 ? 0 : 32 * bj) + 16 * n); }
        EPI_BARRIER();
        const PG8_LAS float* RS = (const PG8_LAS float*)(lds + LDS_RSTD);
        const float qs = isq ? (is32 ? QSCALE32 : QSCALE64) : 1.0f;
#pragma unroll
        for (int ai = 0; ai < 2; ++ai)
#pragma unroll
            for (int m = 0; m < 4; ++m) {
                const int lr = 128 * ai + 64 * wr + 16 * m + fr, row = 256 * pm + lr, t = tbase + lr;
                const float rstd = RS[lr];
                float r0 = 1.f, r1 = 1.f;
                if (!isv) {
                    float s0 = 0.f, s1 = 0.f;
#pragma unroll
                    for (int n = 0; n < 2; ++n) { const f32x4 a = acc[ai][0][m][n] * rstd + bv[0][n], c = acc[ai][1][m][n] * rstd + bv[1][n];
                        s0 += (a[0] * a[0] + a[1] * a[1]) + (a[2] * a[2] + a[3] * a[3]); s1 += (c[0] * c[0] + c[1] * c[1]) + (c[2] * c[2] + c[3] * c[3]); }
                    s0 = xsum_fq(s0); s1 = xsum_fq(s1);
                    if (is32) { r0 = __builtin_amdgcn_rsqf(s0 * (1.f / 32.f) + 1e-6f); r1 = __builtin_amdgcn_rsqf(s1 * (1.f / 32.f) + 1e-6f); }
                    else { r0 = r1 = __builtin_amdgcn_rsqf((s0 + s1) * (1.f / 64.f) + 1e-6f); }
                }
                GAS float* fr_ = fo ? fo + ((size_t)(b * DEPTH + l) * 256 + t) * fow + foc + 4 * fq : nullptr;
#pragma unroll
                for (int bj = 0; bj < 2; ++bj)
#pragma unroll
                    for (int n = 0; n < 2; ++n) {
                        f32x4 x = acc[ai][bj][m][n] * rstd + bv[bj][n];
                        if (!isv) {
                            x = x * (bj ? r1 : r0) * gv[bj][n];
                            if (rope) {
                                const f32x4 cs = is32 ? *(const GAS f32x4*)(ropeC + ((size_t)t * 16 + 8 * n + 2 * fq) * 2) : *(const GAS f32x4*)(ropeB + ((size_t)t * 32 + 16 * bj + 8 * n + 2 * fq) * 2);
                                x = (f32x4){x[0] * cs[0] - x[1] * cs[1], x[0] * cs[1] + x[1] * cs[0], x[2] * cs[2] - x[3] * cs[3], x[2] * cs[3] + x[3] * cs[2]};
                            }
                        }
                        if (fr_) *(GAS f32x4*)(fr_ + 32 * bj + 16 * n) = x;
                        if (!isv) { const f32x4 y = x * qs; u32x2 w; w.x = cvt_pk_bf16(y[0], y[1]); w.y = cvt_pk_bf16(y[2], y[3]); *(GAS u32x2*)(dst + (size_t)t * 64 + 4 * fq + 32 * bj + 16 * n) = w; }
                        else {
                            const int d0 = 32 * bj + 16 * n + 4 * fq, q = fr & 3;
                            const unsigned A = cvt_pk_bf16(x[0], x[1]), B = cvt_pk_bf16(x[2], x[3]);
                            const unsigned pA = (unsigned)__builtin_amdgcn_mov_dpp((int)A, 0x4E, 0xf, 0xf, true), pB = (unsigned)__builtin_amdgcn_mov_dpp((int)B, 0x4E, 0xf, 0xf, true);
                            const unsigned n0 = q < 2 ? A : pB, n1 = q < 2 ? pA : B;
                            const unsigned p0 = (unsigned)__builtin_amdgcn_mov_dpp((int)n0, 0xB1, 0xf, 0xf, true), p1 = (unsigned)__builtin_amdgcn_mov_dpp((int)n1, 0xB1, 0xf, 0xf, true);
                            const unsigned sel = (q & 1) ? 0x03020706u : 0x05040100u;
                            u32x2 w; w.x = __builtin_amdgcn_perm(p0, n0, sel); w.y = __builtin_amdgcn_perm(p1, n1, sel);
                            *(GAS u32x2*)(dst + (size_t)(d0 + q) * T + (t - q)) = w; }
                    }
            }
    }
};

struct EpiRes {
    static constexpr bool PERM = false, AFTER_DRAIN = true, NEEDS_LDS = false;
    unsigned char* ws0; float* x; int l; int which;
    __device__ __forceinline__ void fused(const f32x4 (&acc)[2][2][4][2], const Unit& u, int wr, int wc, int fr, int fq, PG8_LAS unsigned char* lds, int wid, int lane) const {
        GAS unsigned char* ws = (GAS unsigned char*)ws0; GAS float* xg = (GAS float*)x;
        const int pm = u.pm, pn = u.pn, b5 = pm >= 32 ? 1 + ((pm - 32) >> 3) : 0;
        const GAS float* gate = (const GAS float*)(ws + WS_MOD) + (size_t)(l * 5 + b5) * 6144 + (which ? 5 : 2) * 1024 + 256 * pn + 4 * lane;
        const bool hasn = which ? (l < 3) : true;
        const GAS float* gvn = (const GAS float*)(ws + WS_GV) + (size_t)(which ? l + 1 : l) * 10240 + (size_t)b5 * 2048 + (which ? 0 : 1024) + 256 * pn + 4 * lane;
        GAS bf16_t* xa = (GAS bf16_t*)(ws + WS_XA); GAS float* ssq = (GAS float*)(ws + WS_SSQ);
        const f32x4 g4 = *(const GAS f32x4*)gate; const f32x4 n4 = hasn ? *(const GAS f32x4*)gvn : (f32x4){0.f, 0.f, 0.f, 0.f};
#pragma unroll
        for (int ai = 0; ai < 2; ++ai) {
#pragma unroll
            for (int m = 0; m < 4; ++m) { const int row = 64 * wr + 16 * m + fr;
#pragma unroll
                for (int bj = 0; bj < 2; ++bj)
#pragma unroll
                    for (int n = 0; n < 2; ++n) *(PG8_LAS f32x4*)(lds + row * 1024 + (((32 * bj + 8 * wc + 4 * n + fq) ^ (row & 15)) << 4)) = acc[ai][bj][m][n]; }
            EPI_BARRIER();
            const int grow0 = 256 * pm + 128 * ai + 16 * wid; GAS float* xr = xg + (size_t)grow0 * 1024 + 256 * pn + 4 * lane;
#pragma unroll
            for (int k0 = 0; k0 < 16; k0 += 8) {
                f32x4 xv[8];
#pragma unroll
                for (int k = 0; k < 8; ++k) xv[k] = *(const GAS f32x4*)(xr + (size_t)(k0 + k) * 1024);
#pragma unroll
                for (int k = 0; k < 8; ++k) { const int row = 16 * wid + k0 + k;
                    const f32x4 a4 = *(const PG8_LAS f32x4*)(lds + row * 1024 + ((lane ^ (row & 15)) << 4));
                    const f32x4 y = xv[k] + g4 * a4;
                    *(GAS f32x4*)(xr + (size_t)(k0 + k) * 1024) = y;
                    if (hasn) { float ss = (y[0] * y[0] + y[1] * y[1]) + (y[2] * y[2] + y[3] * y[3]);
                        ss = wave_sum_dpp(ss);
                        const f32x4 z = y * n4; u32x2 w; w.x = cvt_pk_bf16(z[0], z[1]); w.y = cvt_pk_bf16(z[2], z[3]);
                        *(GAS u32x2*)(xa + (size_t)(grow0 + k0 + k) * 1024 + 256 * pn + 4 * lane) = w;
                        if (lane == 0) ssq[(size_t)(grow0 + k0 + k) * 4 + pn] = ss; }
                }
            }
            EPI_BARRIER();
        }
    }
};

#define DPPF(old, src, ctrl) __builtin_bit_cast(float, __builtin_amdgcn_update_dpp(__builtin_bit_cast(int, (float)(old)), __builtin_bit_cast(int, (float)(src)), (ctrl), 0xf, 0xf, false))
struct EpiUpConv {
    static constexpr bool PERM = false, AFTER_DRAIN = false, NEEDS_LDS = true;
    unsigned char* ws0; int l;
    __device__ __forceinline__ void operator()(f32x4 (&acc)[2][2][4][2], const Unit& u, int wr, int wc, int fr_in, int fq_in, PG8_LAS unsigned char* lds) const {
        unsigned char* ws_ = ws0; asm volatile("" : "+s"(ws_)); GAS unsigned char* ws = (GAS unsigned char*)ws_;
        int fr = fr_in, fq = fq_in; asm volatile("" : "+v"(fr), "+v"(fq));
        const int pm = u.pm, pn = u.pn; const int grp = pm >= 32 ? 1 : 0, bq = grp ? (pm - 32) / 9 : 0, jq = grp ? (pm - 32) % 9 : 0;
        const int T = grp ? TLAT : TCTX, tofs = grp ? 254 * jq - 1 : 0, arow0 = grp ? MCTX + TLAT * bq + tofs : 256 * pm, b5 = grp ? 1 + bq : 0;
        const GAS float* ssq = (const GAS float*)(ws + WS_SSQ); const GAS float* bias = (const GAS float*)(ws + WS_BIASUP) + (size_t)(l * 5 + b5) * DUP; const GAS float* cw = (const GAS float*)(ws + WS_CONV) + (size_t)l * 4 * DUP;
        GAS bf16_t* act = (GAS bf16_t*)(ws + WS_ACT);
        const int fcol = 128 * pn + 32 * wc + 4 * fq;
        rstd_table(lds, ssq, arow0, wr, wc, fr, fq);
        f32x4 bv[2][2];
#pragma unroll
        for (int bj = 0; bj < 2; ++bj)
#pragma unroll
            for (int n = 0; n < 2; ++n) bv[bj][n] = *(const GAS f32x4*)(bias + bj * DFF + fcol + 16 * n);
        EPI_BARRIER();
        const PG8_LAS float* RS = (const PG8_LAS float*)(lds + LDS_RSTD);
#pragma unroll
        for (int ai = 0; ai < 2; ++ai)
#pragma unroll
            for (int m = 0; m < 4; ++m) {
                const int i = 128 * ai + 64 * wr + 16 * m + fr, t = tofs + i; const bool inseq = (t >= 0) && (t < T);
                const float rstd = RS[i];
#pragma unroll
                for (int bj = 0; bj < 2; ++bj)
#pragma unroll
                    for (int n = 0; n < 2; ++n) { const f32x4 v = acc[ai][bj][m][n] * rstd + bv[bj][n]; acc[ai][bj][m][n] = inseq ? v : (f32x4){0.f, 0.f, 0.f, 0.f}; }
            }
        PG8_LAS float* E = (PG8_LAS float*)(lds + LDS_EDGE);
#pragma unroll
        for (int ai = 0; ai < 2; ++ai) { const int c = 2 * ai + wr;
#pragma unroll
            for (int bj = 0; bj < 2; ++bj)
#pragma unroll
                for (int n = 0; n < 2; ++n) { const int col = 128 * bj + 32 * wc + 16 * n + 4 * fq;
                    if (fr == 0) *(PG8_LAS f32x4*)(E + (c * 2 + 0) * 256 + col) = acc[ai][bj][0][n];
                    if (fr == 15) *(PG8_LAS f32x4*)(E + (c * 2 + 1) * 256 + col) = acc[ai][bj][3][n]; } }
        asm volatile("s_waitcnt lgkmcnt(0)" ::: "memory"); __builtin_amdgcn_s_barrier(); asm volatile("" ::: "memory");
#pragma unroll
        for (int n = 0; n < 2; ++n) {
            f32x4 w0[2], w1[2], w2[2], cb[2];
#pragma unroll
            for (int bj = 0; bj < 2; ++bj) { const GAS float* p = cw + bj * DFF + fcol + 16 * n; w0[bj] = *(const GAS f32x4*)p; w1[bj] = *(const GAS f32x4*)(p + DUP); w2[bj] = *(const GAS f32x4*)(p + 2 * DUP); cb[bj] = *(const GAS f32x4*)(p + 3 * DUP); }
#pragma unroll
            for (int ai = 0; ai < 2; ++ai) { const int c = 2 * ai + wr;
                f32x4 ep[2], en[2];
#pragma unroll
                for (int bj = 0; bj < 2; ++bj) { const int col = 128 * bj + 32 * wc + 16 * n + 4 * fq;
                    ep[bj] = c > 0 ? *(const PG8_LAS f32x4*)(E + ((c - 1) * 2 + 1) * 256 + col) : (f32x4){0.f, 0.f, 0.f, 0.f};
                    en[bj] = c < 3 ? *(const PG8_LAS f32x4*)(E + ((c + 1) * 2 + 0) * 256 + col) : (f32x4){0.f, 0.f, 0.f, 0.f}; }
#pragma unroll
                for (int m = 0; m < 4; ++m) {
                    f32x4 y[2];
#pragma unroll
                    for (int bj = 0; bj < 2; ++bj) {
                        const f32x4 x = acc[ai][bj][m][n]; f32x4 pv, nx;
#pragma unroll
                        for (int e = 0; e < 4; ++e) {
                            const float po = m > 0 ? DPPF(acc[ai][bj][m > 0 ? m - 1 : 0][n][e], acc[ai][bj][m > 0 ? m - 1 : 0][n][e], 0x121) : ep[bj][e];
                            pv[e] = DPPF(po, x[e], 0x111);
                            const float no = m < 3 ? DPPF(acc[ai][bj][m < 3 ? m + 1 : 3][n][e], acc[ai][bj][m < 3 ? m + 1 : 3][n][e], 0x12F) : en[bj][e];
                            nx[e] = DPPF(no, x[e], 0x101);
                        }
                        y[bj] = cb[bj] + w0[bj] * pv + w1[bj] * x + w2[bj] * nx;
                    }
                    const int i = 128 * ai + 64 * wr + 16 * m + fr, t = tofs + i; const bool ok = grp ? ((i >= 1) && (i <= 254) && (t < T)) : true;
                    if (ok) { f32x4 a;
#pragma unroll
                        for (int e = 0; e < 4; ++e) a[e] = y[0][e] * __builtin_amdgcn_rcpf(1.0f + __expf(-y[0][e])) * y[1][e];
                        u32x2 w; w.x = cvt_pk_bf16(a[0], a[1]); w.y = cvt_pk_bf16(a[2], a[3]);
                        *(GAS u32x2*)(act + (size_t)(arow0 + i) * DFF + fcol + 16 * n) = w; }
                }
            } }
    }
};
}
namespace att {
typedef LAS unsigned char lds_u8;
constexpr int LDS_TILE = 16384;
constexpr int LDS_RPB = 2 * LDS_TILE;
constexpr int LDS_NEXT = LDS_RPB + 2048;
constexpr int NGEMM = 64;
constexpr int NUNITS = 1024 + NGEMM;
constexpr float RESC_THR = 0.0f;

struct Ctx { unsigned char* ws; float* out; int l; int rep; };

__device__ __forceinline__ bf16x8 lds128(const lds_u8* p) { return *(const LAS bf16x8*)p; }
__device__ __forceinline__ float xmax32(float v) { const auto rr = __builtin_amdgcn_permlane32_swap(__float_as_uint(v), __float_as_uint(v), false, false); return fmaxf(__uint_as_float(rr[0]), __uint_as_float(rr[1])); }
__device__ __forceinline__ float xsum32(float v) { const auto rr = __builtin_amdgcn_permlane32_swap(__float_as_uint(v), __float_as_uint(v), false, false); return __uint_as_float(rr[0]) + __uint_as_float(rr[1]); }
__device__ __forceinline__ float max3f(float a, float b, float c) { float r; asm("v_max3_f32 %0, %1, %2, %3" : "=v"(r) : "v"(a), "v"(b), "v"(c)); return r; }
__device__ __forceinline__ int sigma32(int i) { return (i & 19) | ((i & 4) << 1) | ((i & 8) >> 1); }
__device__ __forceinline__ int key_of(int kb, int r, int h) { return 32 * kb + 16 * (r >> 3) + 8 * h + 4 * ((r >> 2) & 1) + (r & 3); }

template <int NDS>
__device__ __forceinline__ void qk_tile(f32x16& s0, f32x16& s1, const lds_u8* Kt, int c0, const bf16x8* qf, const f32x16& negm, int lane) {
    const int k0 = sigma32(lane & 31), h = lane >> 5; const lds_u8* b0 = Kt + k0 * 128; const lds_u8* b1 = b0 + 32 * 128; const int sw = (k0 >> 1) & 7;
    bf16x8 a0[NDS], a1[NDS];
#pragma unroll
    for (int ds = 0; ds < NDS; ++ds) { const int off = ((c0 + 2 * ds + h) ^ sw) << 4; a0[ds] = lds128(b0 + off); a1[ds] = lds128(b1 + off); }
    s0 = __builtin_amdgcn_mfma_f32_32x32x16_bf16(a0[0], qf[0], negm, 0, 0, 0); s1 = __builtin_amdgcn_mfma_f32_32x32x16_bf16(a1[0], qf[0], negm, 0, 0, 0);
#pragma unroll
    for (int ds = 1; ds < NDS; ++ds) { s0 = __builtin_amdgcn_mfma_f32_32x32x16_bf16(a0[ds], qf[ds], s0, 0, 0, 0); s1 = __builtin_amdgcn_mfma_f32_32x32x16_bf16(a1[ds], qf[ds], s1, 0, 0, 0); }
}
__device__ __forceinline__ void softmax_pv(f32x16& s0, f32x16& s1, float& m, float& l, f32x16& negm, f32x16& o0, f32x16& o1, const lds_u8* Vt, int lane) {
    float mx = max3f(s0[0], s1[0], s0[1]), my = max3f(s1[1], s0[2], s1[2]);
#pragma unroll
    for (int r = 3; r < 15; r += 2) { mx = max3f(mx, s0[r], s1[r]); my = max3f(my, s0[r + 1], s1[r + 1]); }
    mx = max3f(mx, s0[15], s1[15]); mx = fmaxf(mx, my);
    mx = xmax32(mx);
    if (__any(mx > 0.f)) {
        const float dl = fmaxf(mx, 0.f); m += dl; const float al = __builtin_amdgcn_exp2f(-dl); l *= al;
#pragma unroll
        for (int r = 0; r < 16; ++r) { o0[r] *= al; o1[r] *= al; s0[r] -= dl; s1[r] -= dl; negm[r] = -m; }
    }
    const int h = lane >> 5, d = lane & 31; const lds_u8* v0 = Vt + d * 128; const lds_u8* v1 = v0 + 32 * 128; const int sw = (d >> 1) & 7;
    bf16x8 va[4], vb[4];
#pragma unroll
    for (int c = 0; c < 4; ++c) { const int off = ((2 * c + h) ^ sw) << 4; va[c] = lds128(v0 + off); vb[c] = lds128(v1 + off); }
    f32x2 ps = {0.f, 0.f}, pt = {0.f, 0.f};
#pragma unroll
    for (int r = 0; r < 16; r += 2) { s0[r] = __builtin_amdgcn_exp2f(s0[r]); s0[r + 1] = __builtin_amdgcn_exp2f(s0[r + 1]); s1[r] = __builtin_amdgcn_exp2f(s1[r]); s1[r + 1] = __builtin_amdgcn_exp2f(s1[r + 1]);
        ps += (f32x2){s0[r], s0[r + 1]}; pt += (f32x2){s1[r], s1[r + 1]}; }
    ps += pt; l += ps[0] + ps[1];
#pragma unroll
    for (int c = 0; c < 4; ++c) {
        const f32x16& s = (c >> 1) ? s1 : s0; const int b = 8 * (c & 1);
        u32x4 pw; pw.x = cvt_pk_bf16(s[b + 0], s[b + 1]); pw.y = cvt_pk_bf16(s[b + 2], s[b + 3]); pw.z = cvt_pk_bf16(s[b + 4], s[b + 5]); pw.w = cvt_pk_bf16(s[b + 6], s[b + 7]);
        const bf16x8 pf = __builtin_bit_cast(bf16x8, pw);
        o0 = __builtin_amdgcn_mfma_f32_32x32x16_bf16(va[c], pf, o0, 0, 0, 0);
        o1 = __builtin_amdgcn_mfma_f32_32x32x16_bf16(vb[c], pf, o1, 0, 0, 0);
    }
}
__device__ __forceinline__ void softmax_pv_abs(f32x16& s0, f32x16& s1, float& m, float& l, f32x16& o0, f32x16& o1, const lds_u8* Vt, int lane) {
    float mx = max3f(s0[0], s1[0], s0[1]), my = max3f(s1[1], s0[2], s1[2]);
#pragma unroll
    for (int r = 3; r < 15; r += 2) { mx = max3f(mx, s0[r], s1[r]); my = max3f(my, s0[r + 1], s1[r + 1]); }
    mx = max3f(mx, s0[15], s1[15]); mx = fmaxf(mx, my);
    mx = xmax32(mx);
    if (__any(mx > m)) { const float mn = fmaxf(m, mx); const float al = __builtin_amdgcn_exp2f(m - mn); l *= al;
#pragma unroll
        for (int r = 0; r < 16; ++r) { o0[r] *= al; o1[r] *= al; }
        m = mn; }
    const int h = lane >> 5, d = lane & 31; const lds_u8* v0 = Vt + d * 128; const lds_u8* v1 = v0 + 32 * 128; const int sw = (d >> 1) & 7;
    bf16x8 va[4], vb[4];
#pragma unroll
    for (int c = 0; c < 4; ++c) { const int off = ((2 * c + h) ^ sw) << 4; va[c] = lds128(v0 + off); vb[c] = lds128(v1 + off); }
    f32x2 ps = {0.f, 0.f}, pt = {0.f, 0.f};
#pragma unroll
    for (int r = 0; r < 16; r += 2) { s0[r] = __builtin_amdgcn_exp2f(s0[r] - m); s0[r + 1] = __builtin_amdgcn_exp2f(s0[r + 1] - m); s1[r] = __builtin_amdgcn_exp2f(s1[r] - m); s1[r + 1] = __builtin_amdgcn_exp2f(s1[r + 1] - m);
        ps += (f32x2){s0[r], s0[r + 1]}; pt += (f32x2){s1[r], s1[r + 1]}; }
    ps += pt; l += ps[0] + ps[1];
#pragma unroll
    for (int c = 0; c < 4; ++c) {
        const f32x16& s = (c >> 1) ? s1 : s0; const int b = 8 * (c & 1);
        u32x4 pw; pw.x = cvt_pk_bf16(s[b + 0], s[b + 1]); pw.y = cvt_pk_bf16(s[b + 2], s[b + 3]); pw.z = cvt_pk_bf16(s[b + 4], s[b + 5]); pw.w = cvt_pk_bf16(s[b + 6], s[b + 7]);
        const bf16x8 pf = __builtin_bit_cast(bf16x8, pw);
        o0 = __builtin_amdgcn_mfma_f32_32x32x16_bf16(va[c], pf, o0, 0, 0, 0);
        o1 = __builtin_amdgcn_mfma_f32_32x32x16_bf16(vb[c], pf, o1, 0, 0, 0);
    }
}
struct UnitGeo {
    const GAS bf16_t* qkv; const GAS bf16_t* kcb; unsigned kso, vso, kco, vco; int T, ta, nself, ntile, q0, grp, fam, b, h;
};
template <int MODE>
__device__ __forceinline__ void unit_loop(lds_u8* lds, const UnitGeo& U, const GAS float* sm, GAS bf16_t* Obase, int l, int tid) {
    const int lane = tid & 63, w = __builtin_amdgcn_readfirstlane(tid >> 6), h5 = lane >> 5, ql = lane & 31;
    const int T = U.T, q0 = U.q0, nself = U.nself, ntile = U.ntile, ta = U.ta;
    const int Hq = U.fam == 1 ? 8 : 4;
    const size_t qo = U.fam == 0 ? QO_QA : (U.fam == 1 ? QO_QB : QO_QC); const size_t gq = U.fam == 1 ? GS8 : GS4;
    const int qw0 = q0 + 32 * w, qtok = qw0 + ql, qrow = qtok >> 6, qcol = qtok & 63;
    const GAS bf16_t* Qp = U.qkv + qo + U.grp * gq + ((size_t)(U.b * Hq + U.h) * T + qtok) * 64;
    bf16x8 qf[4];
#pragma unroll
    for (int ds = 0; ds < 4; ++ds) qf[ds] = *(const GAS bf16x8*)(Qp + 16 * ds + 8 * h5);
    const int r0w = min(max((qw0 >> 6) - 4, 0), 24), qsl = min(max(qcol - 8, 0), 48);
    constexpr float M_INIT = -1024.0f;
    float m0 = M_INIT, l0 = 0.f, m1 = M_INIT, l1 = 0.f;
    const f32x16 z = {0.f, 0.f, 0.f, 0.f, 0.f, 0.f, 0.f, 0.f, 0.f, 0.f, 0.f, 0.f, 0.f, 0.f, 0.f, 0.f};
    f32x16 oa0 = z, oa1 = z, ob0 = z, ob1 = z;
    f32x16 ng0;
#pragma unroll
    for (int r = 0; r < 16; ++r) ng0[r] = -M_INIT;
    const int lrow = tid >> 3, lch = tid & 7; const int lds_off = lrow * 128 + ((lch ^ ((lrow >> 1) & 7)) << 4);
    u32x4 rA[2], rB[2];
    auto gload = [&](int ti_, u32x4& kr, u32x4& vr) {
        const int ti = min(ti_, ntile - 1);
        const bool self = ti < nself; const int tok0 = self ? 64 * (ta + ti) : 64 * (ti - nself); const int Tkv = self ? T : PAST;
        const GAS bf16_t* kp = (self ? U.qkv : U.kcb) + (self ? U.kso : U.kco); const GAS bf16_t* vp = (self ? U.qkv : U.kcb) + (self ? U.vso : U.vco);
        kr = *(const GAS u32x4*)(kp + (size_t)(tok0 + lrow) * 64 + lch * 8);
        vr = *(const GAS u32x4*)(vp + (size_t)lrow * Tkv + tok0 + lch * 8);
    };
    auto tile = [&](int ti, const lds_u8* Kt) {
        const lds_u8* Vt = Kt + 8192;
        const bool self = ti < nself; const int tok0 = 64 * (ta + ti);
        bool rel = true, msk = false;
        if (MODE == 1 && self) { const int kr = ta + ti; rel = (kr >= r0w) && (kr <= r0w + 7); msk = true; }
        if (MODE == 2 && self) { rel = (tok0 + 63 >= qw0 - 128) && (tok0 <= qw0 + 31 + 128); msk = !((tok0 >= qw0 + 31 - 128) && (tok0 + 63 <= qw0 + 128)); }
        if (rel) {
            if (MODE != 3) {
                f32x16 s0, s1; qk_tile<4>(s0, s1, Kt, 0, qf, ng0, lane);
                if (MODE == 1 && msk) {
                    const int kr = ta + ti; const LAS float* bt = (const LAS float*)(lds + LDS_RPB) + (kr - qrow + 7) * 31 + 15 - qcol;
                    float b0[16], b1[16];
#pragma unroll
                    for (int r = 0; r < 16; ++r) { const int kc0 = key_of(0, r, h5); b0[r] = bt[min(max(kc0, qsl), qsl + 15)]; b1[r] = bt[min(max(kc0 + 32, qsl), qsl + 15)]; }
#pragma unroll
                    for (int r = 0; r < 16; ++r) { const int kc0 = key_of(0, r, h5), kc1 = kc0 + 32;
                        s0[r] = ((kc0 >= qsl) && (kc0 < qsl + 16)) ? s0[r] + b0[r] : -INFINITY; s1[r] = ((kc1 >= qsl) && (kc1 < qsl + 16)) ? s1[r] + b1[r] : -INFINITY; }
                }
                if (MODE == 2 && msk) {
#pragma unroll
                    for (int r = 0; r < 16; ++r) { const int k0 = tok0 + key_of(0, r, h5), k1 = k0 + 32;
                        s0[r] = (abs(k0 - qtok) > 128) ? -INFINITY : s0[r]; s1[r] = (abs(k1 - qtok) > 128) ? -INFINITY : s1[r]; }
                }
                softmax_pv(s0, s1, m0, l0, ng0, oa0, oa1, Vt, lane);
            } else {
                { f32x16 s0, s1; qk_tile<2>(s0, s1, Kt, 0, qf, z, lane); softmax_pv_abs(s0, s1, m0, l0, oa0, oa1, Vt, lane); }
                { f32x16 s0, s1; qk_tile<2>(s0, s1, Kt, 4, qf + 2, z, lane); softmax_pv_abs(s0, s1, m1, l1, ob0, ob1, Vt, lane); }
            }
        }
    };
    auto step = [&](int ti, u32x4 (&W)[2], u32x4 (&L)[2]) {
        gload(ti + 2, L[0], L[1]);
        __builtin_amdgcn_sched_barrier(0);
        tile(ti, lds + (ti & 1) * LDS_TILE);
        if (ti + 1 < ntile) { lds_u8* nb = lds + ((ti + 1) & 1) * LDS_TILE; *(LAS u32x4*)(nb + lds_off) = W[0]; *(LAS u32x4*)(nb + 8192 + lds_off) = W[1]; }
        __syncthreads();
    };
    gload(0, rB[0], rB[1]);
    gload(1, rA[0], rA[1]);
    *(LAS u32x4*)(lds + lds_off) = rB[0]; *(LAS u32x4*)(lds + 8192 + lds_off) = rB[1];
    __syncthreads();
    for (int ti = 0; ti < ntile; ti += 2) {
        step(ti, rA, rB);
        if (ti + 1 < ntile) step(ti + 1, rB, rA);
    }
    GAS bf16_t* orow = Obase + (size_t)qtok * 1024 + 4 * h5;
    float lt0 = xsum32(l0);
    if (U.fam == 1) lt0 += __builtin_amdgcn_exp2f(sm[SM_SINK + l * 8 + U.h] - m0);
    const float i0 = 1.0f / lt0;
    if (MODE != 3) {
#pragma unroll
        for (int g = 0; g < 4; ++g) {
            u32x2 wa, wb; wa.x = cvt_pk_bf16(oa0[4 * g] * i0, oa0[4 * g + 1] * i0); wa.y = cvt_pk_bf16(oa0[4 * g + 2] * i0, oa0[4 * g + 3] * i0);
            wb.x = cvt_pk_bf16(oa1[4 * g] * i0, oa1[4 * g + 1] * i0); wb.y = cvt_pk_bf16(oa1[4 * g + 2] * i0, oa1[4 * g + 3] * i0);
            *(GAS u32x2*)(orow + 8 * g) = wa; *(GAS u32x2*)(orow + 32 + 8 * g) = wb;
        }
    } else {
        const float lam_init = l == 0 ? 0.2f : (l == 1 ? 0.35550906759f : (l == 2 ? 0.47071301835f : 0.55605820416f));
        const float lt1 = xsum32(l1); const float i1 = 1.0f / lt1; const float lam = sm[SM_LAM + l];
        float ss = 0.f;
#pragma unroll
        for (int r = 0; r < 16; ++r) { oa0[r] = oa0[r] * i0 - lam * (ob0[r] * i1); oa1[r] = oa1[r] * i0 - lam * (ob1[r] * i1); ss += oa0[r] * oa0[r] + oa1[r] * oa1[r]; }
        ss = xsum32(ss);
        const float rn = __builtin_amdgcn_rsqf(ss * (1.f / 64.f) + 1e-6f) * (1.0f - lam_init);
        const GAS float* sg = sm + SM_SUBG + l * 64 + 4 * h5;
#pragma unroll
        for (int g = 0; g < 4; ++g) {
            const f32x4 ga = *(const GAS f32x4*)(sg + 8 * g), gb = *(const GAS f32x4*)(sg + 32 + 8 * g);
            u32x2 wa, wb; wa.x = cvt_pk_bf16(oa0[4 * g] * rn * ga[0], oa0[4 * g + 1] * rn * ga[1]); wa.y = cvt_pk_bf16(oa0[4 * g + 2] * rn * ga[2], oa0[4 * g + 3] * rn * ga[3]);
            wb.x = cvt_pk_bf16(oa1[4 * g] * rn * gb[0], oa1[4 * g + 1] * rn * gb[1]); wb.y = cvt_pk_bf16(oa1[4 * g + 2] * rn * gb[2], oa1[4 * g + 3] * rn * gb[3]);
            *(GAS u32x2*)(orow + 8 * g) = wa; *(GAS u32x2*)(orow + 32 + 8 * g) = wb;
        }
    }
}

__device__ __forceinline__ void attn_phase(lds_u8* lds, const Ctx& C) {
    const int l = C.l;
    for (;;) {
        __syncthreads();
        unsigned char* ws_ = C.ws; asm volatile("" : "+s"(ws_)); GAS unsigned char* ws = (GAS unsigned char*)ws_;
        const int tid = opaque_tid();
        if (tid == 0) *(LAS unsigned*)(lds + LDS_NEXT) = __hip_atomic_fetch_add((GAS unsigned*)(ws + WS_CTL) + 64 * (1 + l) + C.rep, 1u, __ATOMIC_RELAXED, __HIP_MEMORY_SCOPE_AGENT);
        __syncthreads();
        const int idx = (int)*(LAS unsigned*)(lds + LDS_NEXT);
#ifdef ATT_PROBE_LIMIT
        if (idx >= (C.rep ? ATT_PROBE_LIMIT : NUNITS)) break;
#else
        if (idx >= NUNITS) break;
#endif
        const GAS float* sm = (const GAS float*)(ws + WS_LAM);
        GAS unsigned* qa_done = (GAS unsigned*)(ws + WS_CTL) + 64 * (8 + l);
        if (idx < NGEMM) {
            pg8::Gemm g{(const bf16_t*)(ws_ + WS_XA), (const bf16_t*)(ws_ + WS_WIN) + (size_t)l * DIN * 1024, MTOT, 256, 1024}; pg8::OneUnit S1{idx};
            pg8::EpiIn E{ws_, C.out, l, 0};
            pg8::gemm_phase<pg8::EpiIn, pg8::OneUnit, true, true>(lds, g, S1, E);
            asm volatile("s_waitcnt vmcnt(0)" ::: "memory");
            __syncthreads();
            if (tid == 0) { __builtin_amdgcn_fence(__ATOMIC_RELEASE, "agent"); asm volatile("s_waitcnt vmcnt(0)" ::: "memory"); __hip_atomic_fetch_add(qa_done, 1u, __ATOMIC_RELAXED, __HIP_MEMORY_SCOPE_AGENT); }
            continue;
        }
        UnitGeo U; U.qkv = (const GAS bf16_t*)(ws + WS_QKV); U.kcb = (const GAS bf16_t*)(ws + WS_KC);
        int fam, grp, b, h, qb; const int iu = idx - NGEMM;
        if (iu < 128) { fam = 2; grp = 1; b = iu >> 5; h = (iu >> 3) & 3; qb = iu & 7; }
        else if (iu < 384) { const int i = iu - 128; fam = 1; grp = 1; b = i >> 6; h = (i >> 3) & 7; qb = i & 7; }
        else if (iu < 512) { const int i = iu - 384; fam = 2; grp = 0; b = i >> 2; h = i & 3; qb = 0; }
        else if (iu < 768) { const int i = iu - 512; fam = 1; grp = 0; b = i >> 3; h = i & 7; qb = 0; }
        else if (iu < 896) { const int i = iu - 768; fam = 0; grp = 1; b = i >> 5; h = (i >> 3) & 3; qb = i & 7; }
        else { const int i = iu - 896; fam = 0; grp = 0; b = i >> 2; h = i & 3; qb = 0; }
        const int q0 = qb * 256;
        if (fam == 0) {
            if (tid == 0) { unsigned sp = 0; while (__hip_atomic_load(qa_done, __ATOMIC_RELAXED, __HIP_MEMORY_SCOPE_AGENT) < (unsigned)NGEMM * (C.rep + 1) && ++sp < (1u << 22)) __builtin_amdgcn_s_sleep(2);
                __builtin_amdgcn_fence(__ATOMIC_ACQUIRE, "agent"); asm volatile("s_waitcnt vmcnt(0)" ::: "memory"); }
            __syncthreads();
        }
        const int T = grp ? TLAT : TCTX, Hkv = fam == 1 ? 2 : 4, hk = fam == 1 ? (h >> 2) : h;
        const size_t ko = fam == 0 ? QO_KA : (fam == 1 ? QO_KB : QO_KC), vo = fam == 0 ? QO_VTA : (fam == 1 ? QO_VTB : QO_VTC); const size_t gk = fam == 1 ? GS2 : GS4;
        U.kso = (unsigned)(ko + grp * gk + (size_t)(b * Hkv + hk) * T * 64); U.vso = (unsigned)(vo + grp * gk + (size_t)(b * Hkv + hk) * 64 * T);
        const size_t cko = fam == 0 ? CO_KA : (fam == 1 ? CO_KB : CO_KCC), cvo = fam == 0 ? CO_VTA : (fam == 1 ? CO_VTB : CO_VTCC);
        U.kco = (unsigned)(cko + (size_t)((l * 4 + b) * Hkv + hk) * PAST * 64); U.vco = (unsigned)(cvo + (size_t)((l * 4 + b) * Hkv + hk) * 64 * PAST);
        int ta, tb;
        if (!grp) { ta = 0; tb = 4; }
        else if (fam == 0) { ta = max(4 * qb - 4, 0); tb = min(max(4 * qb - 1, 0), 24) + 8; }
        else if (fam == 1) { ta = max(q0 - 128, 0) >> 6; tb = min(q0 + 384, TLAT) >> 6; }
        else { ta = 0; tb = 32; }
        U.T = T; U.ta = ta; U.nself = tb - ta; U.ntile = U.nself + (grp ? 8 : 0); U.q0 = q0; U.grp = grp; U.fam = fam; U.b = b; U.h = h;
        GAS bf16_t* Obase = (GAS bf16_t*)(ws + WS_O) + (size_t)((grp ? MCTX + b * TLAT : b * TCTX)) * 1024 + (fam == 0 ? 0 : (fam == 1 ? 256 : 768)) + 64 * h;
        if (fam == 2) unit_loop<3>(lds, U, sm, Obase, l, tid);
        else if (!grp) unit_loop<0>(lds, U, sm, Obase, l, tid);
        else if (fam == 0) { if (tid < 465) *(LAS float*)(lds + LDS_RPB + 4 * tid) = sm[SM_RPB + (l * 4 + h) * 465 + tid]; unit_loop<1>(lds, U, sm, Obase, l, tid); }
        else unit_loop<2>(lds, U, sm, Obase, l, tid);
    }
}
}
namespace misc {
typedef LAS unsigned char lds_u8;
__device__ __forceinline__ float wave_sum(float v) {
#pragma unroll
    for (int o = 1; o < 64; o <<= 1) v += __shfl_xor(v, o);
    return v;
}
__device__ const double INVB[16] = {1.0, 0.5623413251903491, 0.31622776601683794, 0.1778279410038923, 0.1, 0.05623413251903491, 0.03162277660168379, 0.01778279410038923,
                                    0.01, 0.005623413251903491, 0.0031622776601683794, 0.001778279410038923, 0.001, 0.0005623413251903491, 0.00031622776601683794, 0.0001778279410038923};
__device__ const double INVC[8] = {1.0, 0.31622776601683794, 0.1, 0.03162277660168379, 0.01, 0.0031622776601683794, 0.001, 0.00031622776601683794};
__device__ __forceinline__ void sincos_d(double a, float& c, float& s) {
    const double k = rint(a * 0.6366197723675814);
    double r = fma(-k, 1.5707963267948966, a); r = fma(-k, 6.123233995736766e-17, r);
    const double r2 = r * r;
    const double sp = r * (1.0 + r2 * (-1.0 / 6.0 + r2 * (1.0 / 120.0 + r2 * (-1.0 / 5040.0 + r2 * (1.0 / 362880.0 + r2 * (-1.0 / 39916800.0 + r2 * (1.0 / 6227020800.0)))))));
    const double cp = 1.0 + r2 * (-0.5 + r2 * (1.0 / 24.0 + r2 * (-1.0 / 720.0 + r2 * (1.0 / 40320.0 + r2 * (-1.0 / 3628800.0 + r2 * (1.0 / 479001600.0 + r2 * (-1.0 / 87178291200.0)))))));
    const int q = ((int)k) & 3;
    const double cc = (q == 0) ? cp : (q == 1) ? -sp : (q == 2) ? -cp : sp;
    const double ss = (q == 0) ? sp : (q == 1) ? cp : (q == 2) ? -sp : -cp;
    c = (float)cc; s = (float)ss;
}
__device__ __forceinline__ void transpose_item(const float* W, int K, int N, bf16_t* WT, int k0, int n0, int dst0, LAS float* scr, int lane) {
    const int kr = lane >> 3, c4 = (lane & 7) * 4; f32x4 v[8];
#pragma unroll
    for (int i = 0; i < 8; ++i) v[i] = *(const f32x4*)(W + (size_t)(k0 + 8 * i + kr) * N + n0 + c4);
#pragma unroll
    for (int i = 0; i < 8; ++i) { LAS float* d = scr + (8 * i + kr) * 33 + c4; d[0] = v[i][0]; d[1] = v[i][1]; d[2] = v[i][2]; d[3] = v[i][3]; }
    asm volatile("s_waitcnt lgkmcnt(0)" ::: "memory");
    const int c = lane & 7;
#pragma unroll
    for (int j = 0; j < 4; ++j) { const int n = (lane >> 3) + 8 * j; const LAS float* s = scr + (8 * c) * 33 + n;
        u32x4 o; o.x = cvt_pk_bf16(s[0 * 33], s[1 * 33]); o.y = cvt_pk_bf16(s[2 * 33], s[3 * 33]); o.z = cvt_pk_bf16(s[4 * 33], s[5 * 33]); o.w = cvt_pk_bf16(s[6 * 33], s[7 * 33]);
        *(u32x4*)(WT + (size_t)(dst0 + n) * K + k0 + 8 * c) = o; }
    asm volatile("s_waitcnt lgkmcnt(0)" ::: "memory");
}
__device__ __forceinline__ void gemv5_item(const float* W, int N, int n0, const LAS float* vec, LAS float* red, const float* add, float* out, int ostride, int tid) {
    const int c2 = (tid & 31) * 2, kq = tid >> 5; f32x2 a0 = {0.f, 0.f}, a1 = a0, a2 = a0, a3 = a0, a4 = a0;
    const float* wp = W + (size_t)(kq * 64) * N + n0 + c2; const LAS float* vp = vec + kq * 64;
#pragma unroll 16
    for (int k = 0; k < 64; ++k) { const f32x2 w = *(const f32x2*)(wp + (size_t)k * N); a0 += w * vp[k]; a1 += w * vp[1024 + k]; a2 += w * vp[2048 + k]; a3 += w * vp[3072 + k]; a4 += w * vp[4096 + k]; }
    *(LAS f32x2*)(red + (kq * 5 + 0) * 64 + c2) = a0; *(LAS f32x2*)(red + (kq * 5 + 1) * 64 + c2) = a1; *(LAS f32x2*)(red + (kq * 5 + 2) * 64 + c2) = a2; *(LAS f32x2*)(red + (kq * 5 + 3) * 64 + c2) = a3; *(LAS f32x2*)(red + (kq * 5 + 4) * 64 + c2) = a4;
    __syncthreads();
    if (tid < 320) { const int b = tid >> 6, c = tid & 63; float s = add ? add[n0 + c] : 0.f;
#pragma unroll
        for (int q = 0; q < 16; ++q) s += red[(q * 5 + b) * 64 + c];
        out[(size_t)b * ostride + n0 + c] = s; }
    __syncthreads();
}

__device__ __forceinline__ void phase_tables(const Args& a) {
    const int gtid = blockIdx.x * 512 + opaque_tid(), NT = gridDim.x * 512; unsigned char* ws = a.ws;
    float* sm = (float*)(ws + WS_LAM);
    if (gtid < 4) { const int l = gtid; const float* lp = a.in[I_LAMBDA] + l * 128; float s1 = 0.f, s2 = 0.f;
        for (int i = 0; i < 32; ++i) { s1 += lp[i] * lp[32 + i]; s2 += lp[64 + i] * lp[96 + i]; }
        sm[SM_LAM + l] = expf(s1) - expf(s2) + (0.8f - 0.6f * expf(-0.3f * (float)l)); }
    for (int i = gtid; i < 1280; i += NT) { const int l = i / 320, r = i % 320; sm[SM_GAINS + i] = r < 128 ? a.in[I_NAG][l * 128 + r] : (r < 256 ? a.in[I_SWG][l * 128 + r - 128] : a.in[I_DAG][l * 64 + r - 256]); }
    for (int i = gtid; i < 7440; i += NT) sm[SM_RPB + i] = a.in[I_RPB][i] * LOG2E;
    for (int i = gtid; i < 32; i += NT) sm[SM_SINK + i] = a.in[I_SINK][i] * LOG2E;
    for (int i = gtid; i < 256; i += NT) sm[SM_SUBG + i] = a.in[I_SUBG][i];
    float* cv = (float*)(ws + WS_CONV);
    for (int i = gtid; i < 4 * 4 * DUP; i += NT) { const int c = i % DUP, j = (i / DUP) & 3, l = i / (4 * DUP); cv[i] = j < 3 ? a.in[I_CONVW][(size_t)(l * 3 + j) * DUP + c] : a.in[I_CONVB][(size_t)l * DUP + c]; }
    float* rb = (float*)(ws + WS_ROPEB); float* rc = (float*)(ws + WS_ROPEC);
    for (int i = gtid; i < 2048 * 32; i += NT) { const int t = i >> 5, j = i & 31; const double pos = (double)(j < 16 ? (t >> 6) : (t & 63)); float c, s; sincos_d(pos * INVB[j & 15], c, s); rb[2 * i] = c; rb[2 * i + 1] = s; }
    for (int i = gtid; i < 2048 * 16; i += NT) { const int t = i >> 4, j = i & 15; const double pos = (double)(j < 8 ? (t >> 6) : (t & 63)); float c, s; sincos_d(pos * INVC[j & 7], c, s); rc[2 * i] = c; rc[2 * i + 1] = s; }
}
constexpr int N_TR_IN = 144, N_TR_OUT = 64, N_TR_UP = 352, N_TR_DN = 176, N_MOD = 96, N_BIAS_IN = 36, N_BIAS_UP = 88, N_CACHE = 640;
__device__ __forceinline__ void fl_tr(lds_u8* lds, const Args& a, int l, int which, int bi, int tid) {
    const int lane = tid & 63, wave = __builtin_amdgcn_readfirstlane(tid >> 6); LAS float* scr = (LAS float*)(lds + wave * 16384); unsigned char* ws = a.ws; const int r = bi * 8 + wave;
    if (which == 0) { const int kb = r / 72, nb = r % 72, n0 = 32 * nb; const int tile = n0 >> 8, L = n0 & 255, wc = L >> 6, bj = (L >> 5) & 1; const int dst0 = 256 * tile + 128 * bj + 32 * wc;
        transpose_item(a.in[I_WIN] + (size_t)l * 1024 * DIN, 1024, DIN, (bf16_t*)(ws + WS_WIN) + (size_t)l * DIN * 1024, 64 * kb, n0, dst0, scr, lane); }
    else if (which == 1) { const int kb = r / 32, nb = r % 32; transpose_item(a.in[I_WOUT] + (size_t)l * 1024 * 1024, 1024, 1024, (bf16_t*)(ws + WS_WOUT) + (size_t)l * 1024 * 1024, 64 * kb, 32 * nb, 32 * nb, scr, lane); }
    else if (which == 2) { const int kb = r / 176, nb = r % 176, n0 = 32 * nb; const int nn = n0 < DFF ? n0 : n0 - DFF; const int dst0 = 256 * (nn >> 7) + (n0 < DFF ? 0 : 128) + (nn & 127);
        transpose_item(a.in[I_WUP] + (size_t)l * 1024 * DUP, 1024, DUP, (bf16_t*)(ws + WS_WUP) + (size_t)l * DUP * 1024, 64 * kb, n0, dst0, scr, lane); }
    else { const int kb = r / 32, nb = r % 32; transpose_item(a.in[I_WDOWN] + (size_t)l * DFF * 1024, DFF, 1024, (bf16_t*)(ws + WS_WDOWN) + (size_t)l * 1024 * DFF, 64 * kb, 32 * nb, 32 * nb, scr, lane); }
}
__device__ __forceinline__ void fl_mod(lds_u8* lds, const Args& a, int l, int g, int tid) {
    LAS float* vec = (LAS float*)lds; LAS float* red = (LAS float*)(lds + 20480);
    for (int i = tid; i < 5120; i += 512) { const int b5 = i >> 10, k = i & 1023; const float v = b5 == 0 ? a.in[I_CCTX][k] : a.in[I_C][(b5 - 1) * 1024 + k]; vec[i] = v / (1.f + __expf(-v)); }
    __syncthreads();
    gemv5_item(a.in[I_WMOD] + (size_t)l * 1024 * 6144, 6144, 64 * g, vec, red, a.in[I_BMOD] + l * 6144, (float*)(a.ws + WS_MOD) + (size_t)l * 5 * 6144, 6144, tid);
}
__device__ __forceinline__ void fl_bias(lds_u8* lds, const Args& a, int l, int which, int g, int tid) {
    LAS float* vec = (LAS float*)lds; LAS float* red = (LAS float*)(lds + 20480); const float* mod = (const float*)(a.ws + WS_MOD);
    for (int i = tid; i < 5120; i += 512) { const int b5 = i >> 10, k = i & 1023; vec[i] = mod[((size_t)(l * 5 + b5) * 6 + (which ? 3 : 0)) * 1024 + k]; }
    __syncthreads();
    if (!which) gemv5_item(a.in[I_WIN] + (size_t)l * 1024 * DIN, DIN, 64 * g, vec, red, nullptr, (float*)(a.ws + WS_BIASIN) + (size_t)l * 5 * DIN, DIN, tid);
    else gemv5_item(a.in[I_WUP] + (size_t)l * 1024 * DUP, DUP, 64 * g, vec, red, nullptr, (float*)(a.ws + WS_BIASUP) + (size_t)l * 5 * DUP, DUP, tid);
}
__device__ __forceinline__ void fl_gv(const Args& a, int l, int tid) {
    const float* mod = (const float*)(a.ws + WS_MOD); float* gv = (float*)(a.ws + WS_GV) + (size_t)l * 10240;
    for (int i = tid; i < 10240; i += 512) { const int c = i & 1023, which = (i >> 10) & 1, b5 = i >> 11;
        gv[i] = a.in[which ? I_GFFN : I_GATTN][l * 1024 + c] * (1.f + mod[((size_t)(l * 5 + b5) * 6 + (which ? 4 : 1)) * 1024 + c]); }
}
__device__ __forceinline__ void fl_cache(const Args& a, int l, int ci, int tid) {
    bf16_t* kc = (bf16_t*)(a.ws + WS_KC); int i = ci * 512 + tid;
    if (i < 163840) { const int fam = i < 65536 ? 0 : (i < 98304 ? 1 : 2); i -= fam == 0 ? 0 : (fam == 1 ? 65536 : 98304); const int H = fam == 1 ? 2 : 4;
        const float* ck = a.in[fam == 0 ? I_CNAK : (fam == 1 ? I_CSWK : I_CDAK)]; bf16_t* dk = kc + (fam == 0 ? CO_KA : (fam == 1 ? CO_KB : CO_KCC));
        const int d8 = i & 7, hh = (i >> 3) % H, p = (i / (8 * H)) & 511, b = i / (8 * H * 512);
        const float* s = ck + ((((size_t)b * 4 + l) * 512 + p) * H + hh) * 64 + d8 * 8; const f32x4 x = *(const f32x4*)s, y = *(const f32x4*)(s + 4);
        u32x4 o; o.x = cvt_pk_bf16(x[0], x[1]); o.y = cvt_pk_bf16(x[2], x[3]); o.z = cvt_pk_bf16(y[0], y[1]); o.w = cvt_pk_bf16(y[2], y[3]);
        *(u32x4*)(dk + ((((size_t)l * 4 + b) * H + hh) * 512 + p) * 64 + d8 * 8) = o; }
    else { i -= 163840; const int fam = i < 65536 ? 0 : (i < 98304 ? 1 : 2); i -= fam == 0 ? 0 : (fam == 1 ? 65536 : 98304); const int H = fam == 1 ? 2 : 4;
        const float* cv = a.in[fam == 0 ? I_CNAV : (fam == 1 ? I_CSWV : I_CDAV)]; bf16_t* dv = kc + (fam == 0 ? CO_VTA : (fam == 1 ? CO_VTB : CO_VTCC));
        const int d = i & 63, p8 = (i >> 6) & 63, hh = (i >> 12) % H, b = i / (4096 * H);
        const float* s = cv + ((((size_t)b * 4 + l) * 512 + p8 * 8) * H + hh) * 64 + d; float x[8];
#pragma unroll
        for (int j = 0; j < 8; ++j) x[j] = s[(size_t)j * H * 64];
        u32x4 o; o.x = cvt_pk_bf16(x[0], x[1]); o.y = cvt_pk_bf16(x[2], x[3]); o.z = cvt_pk_bf16(x[4], x[5]); o.w = cvt_pk_bf16(x[6], x[7]);
        *(u32x4*)(dv + ((((size_t)l * 4 + b) * H + hh) * 64 + d) * 512 + p8 * 8) = o; }
}
enum { SLOT_PROA = 0, SLOT_PROB = 1, SLOT_IN = 2, SLOT_UP = 3 };
__device__ __forceinline__ void fill_run(lds_u8* lds, const Args& a, int slot, int l, int rep = 0) {
    const int tid = opaque_tid();
    unsigned* counter = (unsigned*)(a.ws + WS_CTL) + 64 * (16 + 4 * slot + l) + rep;
    LAS unsigned* nxt = (LAS unsigned*)(lds + 131072 + 512);
    for (;;) {
        __syncthreads();
        if (tid == 0) *nxt = __hip_atomic_fetch_add(counter, 1u, __ATOMIC_RELAXED, __HIP_MEMORY_SCOPE_AGENT);
        __syncthreads();
        int i = (int)*nxt;
        if (slot == SLOT_PROA) {
            if (i < N_MOD) { fl_mod(lds, a, 0, i, tid); continue; } i -= N_MOD;
            if (i < N_TR_IN) { fl_tr(lds, a, 0, 0, i, tid); continue; }
            break;
        } else if (slot == SLOT_PROB) {
            if (i < 1) { fl_gv(a, 0, tid); continue; } i -= 1;
            if (i < N_BIAS_IN) { fl_bias(lds, a, 0, 0, i, tid); continue; }
            break;
        } else if (slot == SLOT_IN) {
            if (l == 0) { if (i < N_BIAS_UP) { fl_bias(lds, a, 0, 1, i, tid); continue; } i -= N_BIAS_UP; }
            if (l < 3) { if (i < N_MOD) { fl_mod(lds, a, l + 1, i, tid); continue; } i -= N_MOD; }
            if (i < N_CACHE) { fl_cache(a, l, i, tid); continue; } i -= N_CACHE;
            if (i < N_TR_OUT) { fl_tr(lds, a, l, 1, i, tid); continue; } i -= N_TR_OUT;
            if (i < N_TR_UP) { fl_tr(lds, a, l, 2, i, tid); continue; } i -= N_TR_UP;
            if (i < N_TR_DN) { fl_tr(lds, a, l, 3, i, tid); continue; } i -= N_TR_DN;
            if (l < 3) { if (i < N_TR_IN) { fl_tr(lds, a, l + 1, 0, i, tid); continue; } }
            break;
        } else {
            if (l >= 3) break;
            if (i < 1) { fl_gv(a, l + 1, tid); continue; } i -= 1;
            if (i < N_BIAS_IN) { fl_bias(lds, a, l + 1, 0, i, tid); continue; } i -= N_BIAS_IN;
            if (i < N_BIAS_UP) { fl_bias(lds, a, l + 1, 1, i, tid); continue; }
            break;
        }
    }
}
__device__ __forceinline__ void phase_make_xa(const Args& a, int l, int which, int first) {
    const int tid = opaque_tid(), lane = tid & 63, wave = tid >> 6; unsigned char* ws = a.ws;
    const float* mod = (const float*)(ws + WS_MOD); bf16_t* xa = (bf16_t*)(ws + WS_XA); float* ssq = (float*)(ws + WS_SSQ);
    const float* gsrc = a.in[which ? I_GFFN : I_GATTN] + l * 1024;
    for (int row = blockIdx.x * 8 + wave; row < MTOT; row += gridDim.x * 8) {
        const float* src = first ? (row < MCTX ? a.in[I_XP] + (size_t)row * 1024 : a.in[I_XS] + (size_t)(row - MCTX) * 1024) : a.out + (size_t)row * 1024;
        const float* sc = mod + ((size_t)(l * 5 + row_b5(row)) * 6 + (which ? 4 : 1)) * 1024;
        f32x4 v[4]; float s = 0.f;
#pragma unroll
        for (int j = 0; j < 4; ++j) { v[j] = *(const f32x4*)(src + 256 * j + 4 * lane); s += (v[j][0] * v[j][0] + v[j][1] * v[j][1]) + (v[j][2] * v[j][2] + v[j][3] * v[j][3]); }
        s = wave_sum(s);
#pragma unroll
        for (int j = 0; j < 4; ++j) { if (first) *(f32x4*)(a.out + (size_t)row * 1024 + 256 * j + 4 * lane) = v[j];
            const f32x4 g = *(const f32x4*)(gsrc + 256 * j + 4 * lane) * (*(const f32x4*)(sc + 256 * j + 4 * lane) + 1.0f);
            const f32x4 y = v[j] * g; u32x2 w; w.x = cvt_pk_bf16(y[0], y[1]); w.y = cvt_pk_bf16(y[2], y[3]); *(u32x2*)(xa + (size_t)row * 1024 + 256 * j + 4 * lane) = w; }
        if (lane < 4) ssq[(size_t)row * 4 + lane] = lane == 0 ? s : 0.f;
    }
}
}
constexpr int LDS_BYTES = 147456;
enum Phase { PH_MAKEXA = 2, PH_IN, PH_ATT, PH_OUT, PH_UP, PH_CONV, PH_DOWN };

__device__ __forceinline__ void run_phase(LAS unsigned char* lds, const Args& a, int ph, int l, int p1, int p2) {
    unsigned char* ws = a.ws; const int G = gridDim.x;
    switch (ph) {
    case PH_MAKEXA: misc::phase_make_xa(a, l, p1, p2); break;
    case PH_IN: {
        pg8::Gemm g{(const bf16_t*)(ws + WS_XA), (const bf16_t*)(ws + WS_WIN) + (size_t)l * DIN * 1024 + (size_t)256 * 1024, MTOT, DIN - 256, 1024}; pg8::StaticOrder S; S.init(MTOT, DIN - 256, G, (int)blockIdx.x);
#ifdef TS_GEMM
        if (l == 1 && blockIdx.x == TS_BLOCK && TS_PHASE == ph) g.ts = (volatile unsigned long long*)(ws + WS_CTL + 512 * 1024);
#endif
        pg8::EpiIn E{ws, a.out, l, 1};
        pg8::gemm_phase<pg8::EpiIn, pg8::StaticOrder, true, true>(lds, g, S, E); } break;
    case PH_ATT: {
        att::Ctx C{ws, a.out, l, p1};
        att::attn_phase(lds, C); } break;
    case PH_OUT: {
        pg8::Gemm g{(const bf16_t*)(ws + WS_O), (const bf16_t*)(ws + WS_WOUT) + (size_t)l * 1024 * 1024, MTOT, 1024, 1024}; pg8::StaticOrder S; S.init(MTOT, 1024, G, (int)blockIdx.x);
#ifdef TS_GEMM
        if (l == 1 && blockIdx.x == TS_BLOCK && TS_PHASE == ph) g.ts = (volatile unsigned long long*)(ws + WS_CTL + 512 * 1024);
#endif
        pg8::EpiRes E{ws, a.out, l, 0};
        pg8::gemm_phase<pg8::EpiRes, pg8::StaticOrder, false, true>(lds, g, S, E); } break;
    case PH_UP: {
        pg8::Gemm g{(const bf16_t*)(ws + WS_XA), (const bf16_t*)(ws + WS_WUP) + (size_t)l * DUP * 1024, MTOT, DUP, 1024}; pg8::UpOrder S; S.init_up(G, (int)blockIdx.x);
#ifdef TS_GEMM
        if (l == 1 && blockIdx.x == TS_BLOCK && TS_PHASE == ph) g.ts = (volatile unsigned long long*)(ws + WS_CTL + 512 * 1024);
#endif
        pg8::EpiUpConv E{ws, l};
        pg8::gemm_phase<pg8::EpiUpConv, pg8::UpOrder, true, true>(lds, g, S, E); } break;
    case PH_DOWN: {
        pg8::Gemm g{(const bf16_t*)(ws + WS_ACT), (const bf16_t*)(ws + WS_WDOWN) + (size_t)l * 1024 * DFF, MTOT, 1024, DFF}; pg8::StaticOrder S; S.init(MTOT, 1024, G, (int)blockIdx.x);
#ifdef TS_GEMM
        if (l == 1 && blockIdx.x == TS_BLOCK && TS_PHASE == ph) g.ts = (volatile unsigned long long*)(ws + WS_CTL + 512 * 1024);
#endif
        pg8::EpiRes E{ws, a.out, l, 1};
        pg8::gemm_phase<pg8::EpiRes, pg8::StaticOrder, false, true>(lds, g, S, E); } break;
    default: break;
    }
}

#define XB_TMO      128
#define XB_XCNT(j)  (256  + 64 * (j))
#define XB_XSUB(j)  (1280 + 64 * (j))
#define XB_XGEN(j)  (2304 + 64 * (j))
#define XB_TOP      3328
#define XB_TOPGEN   3392
#define XCD_BAR_WORDS 3456
#define XB_SPIN_CAP (1u << 18)
__device__ __forceinline__ unsigned xb_ld(unsigned* p)              { return __hip_atomic_load(p, __ATOMIC_RELAXED, __HIP_MEMORY_SCOPE_AGENT); }
__device__ __forceinline__ unsigned xb_add(unsigned* p, unsigned v) { return __hip_atomic_fetch_add(p, v, __ATOMIC_RELAXED, __HIP_MEMORY_SCOPE_AGENT); }
__device__ __forceinline__ unsigned xb_xcc_id() { return (unsigned)__builtin_amdgcn_s_getreg((3 << 11) | 20) & 0xFu; }
#define XB_SPIN(cond, bar) do { unsigned _sp = 0; while (cond) { __builtin_amdgcn_s_sleep(1); \
    if ((++_sp & 255u) == 0u) { if (xb_ld(&(bar)[XB_TMO])) break; if (_sp > XB_SPIN_CAP) { atomicAdd(&(bar)[XB_TMO], 1u); break; } } } } while (0)
struct XcdBarrier { unsigned* bar; unsigned x; volatile LAS unsigned* st; };
__device__ __forceinline__ XcdBarrier xcd_barrier_post(unsigned* bar, volatile LAS unsigned* st) {
    XcdBarrier b; b.bar = bar; b.x = xb_xcc_id(); b.st = st;
    if (threadIdx.x == 0) (void)xb_add(&bar[XB_XCNT(b.x)], 1u);
    return b;
}
__device__ __forceinline__ void xcd_barrier_complete(unsigned* bar, unsigned x, unsigned& nloc, unsigned& nx) {
    const unsigned G = gridDim.x * gridDim.y * gridDim.z;
    unsigned sum, cnt, mine, sp = 0u;
    for (;;) {
        sum = 0u; cnt = 0u; mine = 0u;
#pragma unroll
        for (unsigned j = 0; j < 16; ++j) { const unsigned c = xb_ld(&bar[XB_XCNT(j)]); sum += c; cnt += (c > 0u) ? 1u : 0u; mine = (j == x) ? c : mine; }
        if (sum == G) break;
        __builtin_amdgcn_s_sleep(1);
        if ((++sp & 255u) == 0u) { if (xb_ld(&bar[XB_TMO])) break; if (sp > XB_SPIN_CAP) { atomicAdd(&bar[XB_TMO], 1u); break; } }
    }
    nloc = mine > 0u ? mine : 1u; nx = cnt > 0u ? cnt : 1u;
}
__device__ __forceinline__ void xcd_barrier(const XcdBarrier& b) {
    asm volatile("s_waitcnt vmcnt(0)" ::: "memory");
    __syncthreads();
    if (threadIdx.x == 0) {
        unsigned* bar = b.bar;
        __builtin_amdgcn_s_waitcnt(0);
        unsigned nloc = b.st[0], nx = b.st[1];
        if (nloc == 0u) { xcd_barrier_complete(bar, b.x, nloc, nx); b.st[0] = nloc; b.st[1] = nx; }
        const unsigned old = xb_add(&bar[XB_XSUB(b.x)], 1u);
        const unsigned gen = old / nloc;
        if (old + 1u == (gen + 1u) * nloc) {
            __builtin_amdgcn_fence(__ATOMIC_RELEASE, "agent");
            asm volatile("s_waitcnt vmcnt(0)" ::: "memory");
            const unsigned og = xb_add(&bar[XB_TOP], 1u);
            const unsigned tg = og / nx;
            if (og + 1u == (tg + 1u) * nx) xb_add(&bar[XB_TOPGEN], 1u);
            else XB_SPIN(xb_ld(&bar[XB_TOPGEN]) == tg, bar);
            __builtin_amdgcn_fence(__ATOMIC_ACQUIRE, "agent");
            xb_add(&bar[XB_XGEN(b.x)], 1u);
            asm volatile("s_waitcnt vmcnt(0)" ::: "memory");
        } else {
            XB_SPIN(xb_ld(&bar[XB_XGEN(b.x)]) == gen, bar);
            __builtin_amdgcn_fence(__ATOMIC_ACQUIRE, "agent");
            asm volatile("s_waitcnt vmcnt(0)" ::: "memory");
        }
    }
    __syncthreads();
}
constexpr int CW_BAR = 4096;
constexpr int LDS_BARST = LDS_BYTES - 64;
__global__ void __launch_bounds__(512, 2) mk_fwd(Args a) {
    extern __shared__ __attribute__((aligned(16))) unsigned char lds_raw[];
    LAS unsigned char* lds = (LAS unsigned char*)lds_raw;
    cg::grid_group grid = cg::this_grid();
    if (threadIdx.x < 2) ((volatile LAS unsigned*)(lds + LDS_BARST))[threadIdx.x] = 0u;
    __syncthreads();
    const XcdBarrier xbar = xcd_barrier_post((unsigned*)(a.ws + WS_CTL) + CW_BAR, (volatile LAS unsigned*)(lds + LDS_BARST));
#define GSYNC() xcd_barrier(xbar)
#ifdef TS_A
#define TSB ((volatile unsigned long long*)(a.ws + WS_CTL + 512 * 1024))
#define STAMP(k) do { if (blockIdx.x == TS_BLOCK && threadIdx.x == 0) TSB[k] = __builtin_amdgcn_s_memrealtime(); } while (0)
#else
#define STAMP(k) do {} while (0)
#endif
    STAMP(0);
    misc::phase_tables(a); misc::fill_run(lds, a, misc::SLOT_PROA, 0); grid.sync(); STAMP(1);
    misc::fill_run(lds, a, misc::SLOT_PROB, 0);
#pragma unroll 1
    for (int l = 0; l < DEPTH; ++l) misc::fill_run(lds, a, misc::SLOT_IN, l);
    GSYNC();
#pragma unroll 1
    for (int l = 0; l < DEPTH - 1; ++l) misc::fill_run(lds, a, misc::SLOT_UP, l);
    run_phase(lds, a, PH_MAKEXA, 0, 0, 1); GSYNC();
#ifndef REP_IN
#define REP_IN 1
#endif
#ifndef REP_ATT
#define REP_ATT 1
#endif
#ifndef REP_UP
#define REP_UP 1
#endif
    STAMP(2);
#pragma unroll 1
    for (int l = 0; l < DEPTH; ++l) {
        if (l == 1) STAMP(10);
#pragma unroll 1
        for (int rep = 0; rep < REP_IN; ++rep) { run_phase(lds, a, PH_IN, l, 0, 0); if (l == 1) STAMP(11); GSYNC(); }
        if (l == 1) STAMP(12);
#pragma unroll 1
        for (int rep = 0; rep < REP_ATT; ++rep) { run_phase(lds, a, PH_ATT, l, rep, 0); if (l == 1) STAMP(13); GSYNC(); }
        if (l == 1) STAMP(14);
        run_phase(lds, a, PH_OUT, l, 0, 0); if (l == 1) STAMP(15); GSYNC();
        if (l == 1) STAMP(16);
#pragma unroll 1
        for (int rep = 0; rep < REP_UP; ++rep) { run_phase(lds, a, PH_UP, l, 0, 0); if (l == 1) STAMP(17); GSYNC(); }
        if (l == 1) STAMP(18);
        run_phase(lds, a, PH_DOWN, l, 0, 0); if (l == 1) STAMP(19);
        if (l < DEPTH - 1) GSYNC();
        if (l == 1) STAMP(20);
    }
#ifdef TS_A
    GSYNC();
    if (blockIdx.x == TS_BLOCK) {
        const float T_us = (float)(TSB[TS_B] - TSB[TS_A]) * 0.01f; const float dl = sqrtf(T_us * (float)(TS_SCALE) * 8.0f);
        for (int i = threadIdx.x; i < (1 << 20); i += 512) a.out[OUT_NAV + i] *= (1.0f + dl);
    }
#endif
}

extern "C" void kernel_launch(void* const* d_in, const int* in_sizes, int n_in, void* d_out, int out_size, void* d_ws, size_t ws_size, hipStream_t stream) {
    static int grid = 0;
    if (grid == 0) {
        int dev = 0, cus = 0, per_cu = 0;
        (void)hipGetDevice(&dev); (void)hipDeviceGetAttribute(&cus, hipDeviceAttributeMultiprocessorCount, dev);
        (void)hipFuncSetAttribute((const void*)mk_fwd, hipFuncAttributeMaxDynamicSharedMemorySize, LDS_BYTES);
        (void)hipOccupancyMaxActiveBlocksPerMultiprocessor(&per_cu, (const void*)mk_fwd, 512, LDS_BYTES);
        if (per_cu < 1) fprintf(stderr, "kernel_launch: occupancy query reports %d blocks per CU\n", per_cu);
        grid = cus > 0 ? cus : 256;
        if (ws_size < WS_END) { fprintf(stderr, "kernel_launch: workspace too small (%zu < %zu)\n", ws_size, (size_t)WS_END); grid = -1; }
    }
    if (grid < 0) return;
    Args a{}; for (int i = 0; i < N_IN; ++i) a.in[i] = (const float*)d_in[i]; a.out = (float*)d_out; a.ws = (unsigned char*)d_ws;
    (void)hipMemsetAsync((unsigned char*)d_ws + WS_CTL, 0, 1 * MiB, stream);
    void* args[] = {&a};
    hipError_t e = hipLaunchCooperativeKernel((const void*)mk_fwd, dim3(grid), dim3(512), args, LDS_BYTES, stream);
    if (e != hipSuccess) fprintf(stderr, "cooperative launch failed: %s (grid %d)\n", hipGetErrorString(e), grid);
}
```

```cpp
#include <hip/hip_runtime.h>
#include <hip/hip_cooperative_groups.h>
#include <cstdio>
#include <cstdint>
namespace cg = cooperative_groups;

constexpr int DEPTH = 4, NCTX = 32, TCTX = 256, NLAT = 4, TLAT = 2048, PAST = 512;
constexpr int MCTX = 8192, MLAT = 8192, MTOT = 16384;
constexpr int DIN = 2304, DFF = 2816, DUP = 5632;
constexpr size_t OUT_X = 0, OUT_NAK = 16777216, OUT_NAV = 25165824, OUT_SWK = 33554432, OUT_SWV = 37748736, OUT_DAK = 41943040, OUT_DAV = 50331648, OUT_TOTAL = 58720256;
enum { I_XP = 0, I_XS, I_CNAK, I_CNAV, I_CSWK, I_CSWV, I_CDAK, I_CDAV, I_C, I_CCTX, I_GATTN, I_GFFN, I_WMOD, I_BMOD, I_WIN, I_NAG, I_RPB, I_SWG, I_SINK, I_DAG, I_LAMBDA, I_SUBG, I_WOUT, I_WUP, I_CONVW, I_CONVB, I_WDOWN, N_IN };
#define LAS __attribute__((address_space(3)))
#define GAS __attribute__((address_space(1)))
typedef unsigned short bf16_t;
typedef short bf16x8 __attribute__((ext_vector_type(8)));
typedef float f32x4 __attribute__((ext_vector_type(4)));
typedef float f32x2 __attribute__((ext_vector_type(2)));
typedef float f32x16 __attribute__((ext_vector_type(16)));
typedef unsigned u32x4 __attribute__((ext_vector_type(4)));
typedef unsigned u32x2 __attribute__((ext_vector_type(2)));
typedef __bf16 bf16x2_t __attribute__((ext_vector_type(2)));

constexpr float LOG2E = 1.4426950408889634f;
constexpr float QSCALE64 = 0.125f * LOG2E, QSCALE32 = 0.17677669529663687f * LOG2E;

__device__ __forceinline__ unsigned cvt_pk_bf16(float lo, float hi) { f32x2 v = {lo, hi}; bf16x2_t b = __builtin_convertvector(v, bf16x2_t); return __builtin_bit_cast(unsigned, b); }
__device__ __forceinline__ float bf16_to_f32(bf16_t v) { return __builtin_bit_cast(float, (unsigned)v << 16); }
__device__ __forceinline__ int row_b5(int row) { return row < MCTX ? 0 : 1 + ((row - MCTX) >> 11); }

constexpr size_t MiB = 1u << 20;
constexpr size_t WS_CTL = 0;
constexpr size_t WS_MOD = 1 * MiB;
constexpr size_t WS_GV = WS_MOD + 512 * 1024;
constexpr size_t WS_BIASIN = WS_GV + 256 * 1024;
constexpr size_t WS_BIASUP = WS_BIASIN + 256 * 1024;
constexpr size_t WS_LAM = WS_BIASUP + 512 * 1024;
constexpr int SM_LAM = 0, SM_GAINS = 64, SM_RPB = SM_GAINS + 1280, SM_SINK = SM_RPB + 7440, SM_SUBG = SM_SINK + 32, SM_END = SM_SUBG + 256;
constexpr size_t WS_ROPEB = 3 * MiB;
constexpr size_t WS_ROPEC = WS_ROPEB + 512 * 1024;
constexpr size_t WS_SSQ = 4 * MiB;
constexpr size_t WS_CONV = 5 * MiB;
constexpr size_t WS_WIN = 6 * MiB;
constexpr size_t WS_WOUT = WS_WIN + 18 * MiB;
constexpr size_t WS_WUP = WS_WOUT + 8 * MiB;
constexpr size_t WS_WDOWN = WS_WUP + 44 * MiB;
constexpr size_t WS_KC = WS_WDOWN + 22 * MiB;
constexpr size_t WS_XA = WS_KC + 20 * MiB;
constexpr size_t WS_QKV = WS_XA + 32 * MiB + 1 * MiB;
constexpr size_t WS_O = WS_QKV + 72 * MiB;
constexpr size_t WS_ACT = WS_QKV;
constexpr size_t WS_END = WS_O + 32 * MiB;
constexpr size_t GS4 = 2097152, GS8 = 4194304, GS2 = 1048576;
constexpr size_t QO_QA = 0, QO_KA = QO_QA + 2 * GS4, QO_VTA = QO_KA + 2 * GS4, QO_QB = QO_VTA + 2 * GS4, QO_KB = QO_QB + 2 * GS8, QO_VTB = QO_KB + 2 * GS2,
                 QO_QC = QO_VTB + 2 * GS2, QO_KC = QO_QC + 2 * GS4, QO_VTC = QO_KC + 2 * GS4, QO_END = QO_VTC + 2 * GS4;
static_assert(QO_END * 2 == 72 * MiB, "qkv region");
constexpr size_t CO_KA = 0, CO_VTA = CO_KA + GS4, CO_KB = CO_VTA + GS4, CO_VTB = CO_KB + GS2, CO_KCC = CO_VTB + GS2, CO_VTCC = CO_KCC + GS4;

struct Args { const float* in[N_IN]; float* out; unsigned char* ws; };
__device__ __forceinline__ int opaque_tid() { int t = threadIdx.x; asm volatile("" : "+v"(t)); return t; }

namespace pg8 {
#define PG8_LAS __attribute__((address_space(3)))
constexpr int BM = 256, BK = 64, HALF = 128, HTB = HALF * BK * 2  , STAGE_BYTES = 8 * HTB, NXCD = 8, WGM = 8;
__host__ __device__ __forceinline__ int lds_byte(int r, int c) { const int st = (r >> 4) * 2 + (c >> 5), rr = r & 15, cc = c & 31, ob = rr * 64 + cc * 2; return st * 1024 + (ob ^ (((ob >> 9) & 1) << 5)); }
__host__ __device__ __forceinline__ void stage_rc(int b, int& R, int& C) { const int st = b / 1024, sb = b % 1024, swz = sb ^ (((sb >> 9) & 1) << 5); R = (st >> 1) * 16 + swz / 64; C = (st & 1) * 32 + (swz % 64) / 2; }
__host__ __device__ __forceinline__ int perm32(int rho) { const int n = rho >> 4, i = rho & 15; return 8 * (i >> 2) + 4 * n + (i & 3); }
struct Unit { int pm, pn; };
struct Gemm { const bf16_t* A; const bf16_t* Bt; int M, N, K; volatile unsigned long long* ts = nullptr; };
struct StaticOrder {
    int nM, nN, nwg, G, c;
    __host__ __device__ void init(int M, int N, int G_, int c_) { nM = M / BM; nN = N / BM; nwg = nM * nN; G = G_; c = c_; }
    __host__ __device__ bool next(int i, Unit& u) const {
        const long L = (long)i * G + c; if (L >= nwg) return false;
        int wgid = (int)L; { const int q = nwg / NXCD, r = nwg % NXCD, xcd = wgid % NXCD, off = wgid / NXCD; wgid = (xcd < r ? xcd * (q + 1) : r * (q + 1) + (xcd - r) * q) + off; }
        const int nig = WGM * nN, gid = wgid / nig, fm = gid * WGM, gsz = (nM - fm) < WGM ? (nM - fm) : WGM;
        u.pm = fm + ((wgid % nig) % gsz); u.pn = (wgid % nig) / gsz; return true;
    }
    __device__ __forceinline__ void a_ready(const Unit&) const {}
    __device__ __forceinline__ void done(const Unit&) const {}
    __device__ __forceinline__ int arow0(int pm) const { return BM * pm; }
};
struct OneUnit {
    int pm;
    __device__ __forceinline__ bool next(int i, Unit& u) const { if (i > 0) return false; u.pm = pm; u.pn = 0; return true; }
    __device__ __forceinline__ void a_ready(const Unit&) const {}
    __device__ __forceinline__ void done(const Unit&) const {}
    __device__ __forceinline__ int arow0(int pm_) const { return BM * pm_; }
};
struct UpOrder : StaticOrder {
    __device__ __forceinline__ void init_up(int G_, int c_) { nM = 68; nN = 22; nwg = nM * nN; G = G_; c = c_; }
    __device__ __forceinline__ int arow0(int pm) const { return pm < 32 ? BM * pm : MCTX + TLAT * ((pm - 32) / 9) + 254 * ((pm - 32) % 9) - 1; }
};

template <class Epi, class Sched, bool ALIGN_EPI = false, bool SP2 = false>
__device__ __forceinline__ void gemm_phase(PG8_LAS unsigned char* lds, const Gemm g, const Sched& S, const Epi& E) {
    const int tid = opaque_tid(), wid = __builtin_amdgcn_readfirstlane(tid >> 6), lane = tid & 63, wr = wid >> 2, wc = wid & 3, fr = lane & 15, fq = lane >> 4;
    const int K = g.K, nt = K / BK;
    unsigned voffA[2], voffB[2];
#pragma unroll
    for (int i = 0; i < 2; ++i) { int R, C; stage_rc(tid * 16 + i * 8192, R, C); const int Rb = Epi::PERM ? ((R & ~31) + perm32(R & 31)) : R;
        voffA[i] = (unsigned)(R * K + C) * 2u; voffB[i] = (unsigned)(Rb * K + C) * 2u; }
    const size_t kstep = (size_t)(BK * 2);
    const size_t hstep = (size_t)HALF * K * 2;
    const size_t tstep = 2 * hstep;
    const unsigned ldsw = (unsigned)wid * 1024u;
    const int aoff = lds_byte(wr * 64 + fr, fq * 8), boff = lds_byte(wc * 32 + fr, fq * 8);
#define PG8_SA(b, h) (((b) * 2 + (h)) * HTB)
#define PG8_SB(b, h) ((4 + (b) * 2 + (h)) * HTB)
#define PG8_STAGE(bufoff, gbase, voff) do { _Pragma("unroll") for (int _i = 0; _i < 2; ++_i) \
        __builtin_amdgcn_global_load_lds((const unsigned*)((const char*)(gbase) + (voff)[_i]), (PG8_LAS unsigned*)(lds + (bufoff) + ldsw + _i * 8192), 16, 0, 0); } while (0)
#define PG8_LDA(dst, b, h) do { _Pragma("unroll") for (int m = 0; m < 4; ++m) _Pragma("unroll") for (int k = 0; k < 2; ++k) dst[m][k] = *(const PG8_LAS bf16x8*)(lds + PG8_SA(b, h) + aoff + m * 2048 + k * 1024); } while (0)
#define PG8_LDB(dst, b, h) do { _Pragma("unroll") for (int n = 0; n < 2; ++n) _Pragma("unroll") for (int k = 0; k < 2; ++k) dst[n][k] = *(const PG8_LAS bf16x8*)(lds + PG8_SB(b, h) + boff + n * 2048 + k * 1024); } while (0)
#define PG8_MMA(ai, bj, At, Bt) do { __builtin_amdgcn_s_setprio(1); _Pragma("unroll") for (int m = 0; m < 4; ++m) _Pragma("unroll") for (int n = 0; n < 2; ++n) _Pragma("unroll") for (int k = 0; k < 2; ++k) \
        acc[ai][bj][m][n] = __builtin_amdgcn_mfma_f32_16x16x32_bf16(Bt[n][k], At[m][k], acc[ai][bj][m][n], 0, 0, 0); __builtin_amdgcn_s_setprio(0); } while (0)
#define PG8_WAIT_V(n) asm volatile("s_waitcnt vmcnt(" #n ")" ::: "memory")
#define PG8_WAIT_L(n) asm volatile("s_waitcnt lgkmcnt(" #n ")" ::: "memory")
#define PG8_BAR __builtin_amdgcn_s_barrier()
#define PG8_SCHED __builtin_amdgcn_sched_barrier(0)
    Unit cur, nxt; int ui = 0;
    if (!S.next(0, cur)) return;
    f32x4 acc[2][2][4][2];
#pragma unroll
    for (int a = 0; a < 2; ++a)
#pragma unroll
        for (int b = 0; b < 2; ++b)
#pragma unroll
            for (int m = 0; m < 4; ++m)
#pragma unroll
                for (int n = 0; n < 2; ++n) acc[a][b][m][n] = (f32x4){0.f, 0.f, 0.f, 0.f};
    bf16x8 At[4][2], B0[2][2], B1[2][2];
    const size_t rstep = (size_t)K * 2;
    const char* cA = (const char*)g.A + (size_t)S.arow0(cur.pm) * rstep; const char* cB = (const char*)g.Bt + (size_t)cur.pn * tstep;
    S.a_ready(cur);
#ifdef SKEW_A
    { const int d = (cur.pn & 3) * SKEW_A + (cur.pm & 7) * SKEW_B; for (int i = 0; i < d; ++i) __builtin_amdgcn_s_sleep(16); }
#endif
    if constexpr (SP2) {
        PG8_STAGE(PG8_SB(0, 0), cB, voffB); PG8_STAGE(PG8_SB(0, 1), cB + hstep, voffB); PG8_STAGE(PG8_SA(0, 0), cA, voffA); PG8_STAGE(PG8_SA(0, 1), cA + hstep, voffA);
        if (wr == 1) PG8_BAR;
        PG8_WAIT_V(2); PG8_BAR;
        PG8_STAGE(PG8_SB(1, 0), cB + kstep, voffB); PG8_STAGE(PG8_SA(1, 0), cA + kstep, voffA); PG8_STAGE(PG8_SB(1, 1), cB + hstep + kstep, voffB);
        PG8_WAIT_V(6); PG8_BAR;
    } else {
        PG8_STAGE(PG8_SB(0, 0), cB, voffB); PG8_STAGE(PG8_SA(0, 0), cA, voffA); PG8_STAGE(PG8_SB(0, 1), cB + hstep, voffB); PG8_STAGE(PG8_SA(0, 1), cA + hstep, voffA);
        if (wr == 1) PG8_BAR;
        PG8_WAIT_V(4); PG8_BAR;
        PG8_STAGE(PG8_SB(1, 0), cB + kstep, voffB); PG8_STAGE(PG8_SA(1, 0), cA + kstep, voffA); PG8_STAGE(PG8_SB(1, 1), cB + hstep + kstep, voffB);
        PG8_WAIT_V(6); PG8_BAR;
    }
    for (;;) {
        const bool has_next = S.next(ui + 1, nxt);
        const char* nA = has_next ? (const char*)g.A + (size_t)S.arow0(nxt.pm) * rstep : cA; const char* nB = has_next ? (const char*)g.Bt + (size_t)nxt.pn * tstep : cB;
        for (int t = 0; t < nt; t += 2) {
            const bool last = (t == nt - 2);
#ifdef TS_GEMM
            if (g.ts && tid == 0 && ui == 0) g.ts[40 + (t >> 1)] = __builtin_amdgcn_s_memrealtime();
#endif
            const char* a1 = cA + (size_t)(t + 1) * kstep;
            const char* a2 = last ? nA : cA + (size_t)(t + 2) * kstep; const char* b2 = last ? nB : cB + (size_t)(t + 2) * kstep;
            const char* a3 = a2 + kstep; const char* b3 = b2 + kstep;
            if (last && has_next) S.a_ready(nxt);
            if constexpr (SP2) {
            PG8_LDB(B0, 0, 0); PG8_LDB(B1, 0, 1); PG8_SCHED; PG8_LDA(At, 0, 0); PG8_STAGE(PG8_SA(1, 1), a1 + hstep, voffA);
            PG8_WAIT_V(8); PG8_WAIT_L(0); PG8_BAR; PG8_MMA(0, 0, At, B0); PG8_MMA(0, 1, At, B1); PG8_BAR; PG8_SCHED;
            PG8_LDA(At, 0, 1); PG8_STAGE(PG8_SB(0, 0), b2, voffB); PG8_STAGE(PG8_SB(0, 1), b2 + hstep, voffB); PG8_STAGE(PG8_SA(0, 0), a2, voffA);
            PG8_WAIT_V(8); PG8_WAIT_L(0); PG8_BAR; PG8_MMA(1, 0, At, B0); PG8_MMA(1, 1, At, B1); PG8_BAR; PG8_SCHED;
            PG8_LDB(B0, 1, 0); PG8_LDB(B1, 1, 1); PG8_SCHED; PG8_LDA(At, 1, 0); PG8_STAGE(PG8_SA(0, 1), a2 + hstep, voffA);
            PG8_WAIT_V(8); PG8_WAIT_L(0); PG8_BAR; PG8_MMA(0, 0, At, B0); PG8_MMA(0, 1, At, B1); PG8_BAR; PG8_SCHED;
            PG8_LDA(At, 1, 1); PG8_STAGE(PG8_SB(1, 0), b3, voffB); PG8_STAGE(PG8_SB(1, 1), b3 + hstep, voffB); PG8_STAGE(PG8_SA(1, 0), a3, voffA);
            PG8_WAIT_V(8); PG8_WAIT_L(0); PG8_BAR; PG8_MMA(1, 0, At, B0); PG8_MMA(1, 1, At, B1); PG8_BAR; PG8_SCHED;
            } else {
            PG8_LDB(B0, 0, 0); PG8_SCHED; PG8_LDA(At, 0, 0); PG8_STAGE(PG8_SA(1, 1), a1 + hstep, voffA);
            PG8_WAIT_L(8); PG8_BAR; PG8_WAIT_L(0); PG8_MMA(0, 0, At, B0); PG8_BAR; PG8_SCHED;
            PG8_LDB(B1, 0, 1); PG8_STAGE(PG8_SB(0, 0), b2, voffB);
            PG8_BAR; PG8_WAIT_L(0); PG8_MMA(0, 1, At, B1); PG8_BAR;
            PG8_LDA(At, 0, 1); PG8_STAGE(PG8_SA(0, 0), a2, voffA);
            PG8_BAR; PG8_WAIT_L(0); PG8_MMA(1, 0, At, B0); PG8_BAR; PG8_SCHED;
            PG8_STAGE(PG8_SB(0, 1), b2 + hstep, voffB);
            PG8_WAIT_V(6); PG8_BAR; PG8_MMA(1, 1, At, B1); PG8_BAR;
            PG8_LDB(B0, 1, 0); PG8_SCHED; PG8_LDA(At, 1, 0); PG8_STAGE(PG8_SA(0, 1), a2 + hstep, voffA);
            PG8_WAIT_L(8); PG8_BAR; PG8_WAIT_L(0); PG8_MMA(0, 0, At, B0); PG8_BAR; PG8_SCHED;
            PG8_LDB(B1, 1, 1); PG8_STAGE(PG8_SB(1, 0), b3, voffB);
            PG8_BAR; PG8_WAIT_L(0); PG8_MMA(0, 1, At, B1); PG8_BAR;
            PG8_LDA(At, 1, 1); PG8_STAGE(PG8_SA(1, 0), a3, voffA);
            PG8_BAR; PG8_WAIT_L(0); PG8_MMA(1, 0, At, B0); PG8_BAR; PG8_SCHED;
            PG8_STAGE(PG8_SB(1, 1), b3 + hstep, voffB);
            PG8_WAIT_V(6); PG8_BAR; PG8_MMA(1, 1, At, B1); PG8_BAR;
            }
        }
        if constexpr (ALIGN_EPI) { if (wr == 0) PG8_BAR; }
#ifdef TS_GEMM
        if (g.ts && tid == 0) g.ts[30 + 2 * ui] = __builtin_amdgcn_s_memrealtime();
#endif
        if constexpr (!Epi::AFTER_DRAIN) { if constexpr (Epi::NEEDS_LDS) E(acc, cur, wr, wc, fr, fq, lds); else E(acc, cur, wr, wc, fr, fq); S.done(cur); }
#ifdef TS_GEMM
        if (g.ts && tid == 0) g.ts[31 + 2 * ui] = __builtin_amdgcn_s_memrealtime();
#endif
        if (!has_next) break;
#pragma unroll
        for (int a = 0; a < 2; ++a)
#pragma unroll
            for (int b = 0; b < 2; ++b)
#pragma unroll
                for (int m = 0; m < 4; ++m)
#pragma unroll
                    for (int n = 0; n < 2; ++n) acc[a][b][m][n] = (f32x4){0.f, 0.f, 0.f, 0.f};
        cur = nxt; cA = nA; cB = nB; ++ui;
        if constexpr (ALIGN_EPI) { if (wr == 1) PG8_BAR; }
    }
    PG8_WAIT_V(0);
    if constexpr (!ALIGN_EPI) { if (wr == 0) PG8_BAR; }
    PG8_BAR;
    if constexpr (Epi::AFTER_DRAIN) { E.fused(acc, cur, wr, wc, fr, fq, lds, wid, lane); S.done(cur); }
#undef PG8_SA
#undef PG8_SB
#undef PG8_STAGE
#undef PG8_LDA
#undef PG8_LDB
#undef PG8_MMA
#undef PG8_WAIT_V
#undef PG8_WAIT_L
#undef PG8_BAR
#undef PG8_SCHED
}

constexpr int LDS_EDGE = 131072 + 1024;
constexpr int LDS_RSTD = LDS_EDGE + 8192;
__device__ __forceinline__ void rstd_table(PG8_LAS unsigned char* lds, const GAS float* ssq, int arow0, int wr, int wc, int fr, int fq) {
    const int tid = (wr * 4 + wc) * 64 + fq * 16 + fr, r = tid >> 1, hf = tid & 1;
    const f32x2 a = *(const GAS f32x2*)(ssq + (size_t)min(arow0 + r, MTOT - 1) * 4 + 2 * hf);
    float s = a[0] + a[1]; s += __shfl_xor(s, 1);
    if (!hf) ((PG8_LAS float*)(lds + LDS_RSTD))[r] = __builtin_amdgcn_rsqf(s * (1.0f / 1024.0f) + 1e-6f);
}
__device__ __forceinline__ float xsum_fq(float v) {
    auto a = __builtin_amdgcn_permlane16_swap(__float_as_uint(v), __float_as_uint(v), false, false); v = __uint_as_float(a[0]) + __uint_as_float(a[1]);
    auto b = __builtin_amdgcn_permlane32_swap(__float_as_uint(v), __float_as_uint(v), false, false); return __uint_as_float(b[0]) + __uint_as_float(b[1]);
}
__device__ __forceinline__ float wave_sum_dpp(float v) {
    v += __builtin_bit_cast(float, __builtin_amdgcn_mov_dpp(__builtin_bit_cast(int, v), 0xB1, 0xf, 0xf, true));
    v += __builtin_bit_cast(float, __builtin_amdgcn_mov_dpp(__builtin_bit_cast(int, v), 0x4E, 0xf, 0xf, true));
    v += __builtin_bit_cast(float, __builtin_amdgcn_mov_dpp(__builtin_bit_cast(int, v), 0x124, 0xf, 0xf, true));
    v += __builtin_bit_cast(float, __builtin_amdgcn_mov_dpp(__builtin_bit_cast(int, v), 0x128, 0xf, 0xf, true));
    return xsum_fq(v);
}
#define EPI_BARRIER() do { asm volatile("s_waitcnt lgkmcnt(0)" ::: "memory"); __builtin_amdgcn_s_barrier(); asm volatile("" ::: "memory"); } while (0)

struct EpiIn {
    static constexpr bool PERM = false, AFTER_DRAIN = false, NEEDS_LDS = true;
    unsigned char* ws0; float* out; int l; int pn_off;
    __device__ __forceinline__ void operator()(const f32x4 (&acc)[2][2][4][2], const Unit& u, int wr, int wc, int fr_in, int fq_in, PG8_LAS unsigned char* lds) const {
        unsigned char* ws_ = ws0; asm volatile("" : "+s"(ws_));
        GAS unsigned char* ws = (GAS unsigned char*)ws_; GAS float* outg = (GAS float*)out;
        int fr = fr_in, fq = fq_in; asm volatile("" : "+v"(fr), "+v"(fq));
        const GAS float* ssq = (const GAS float*)(ws + WS_SSQ); const GAS float* bias = (const GAS float*)(ws + WS_BIASIN) + (size_t)l * 5 * DIN;
        const GAS float* gains = (const GAS float*)(ws + WS_LAM) + SM_GAINS + l * 320; const GAS float* nag = gains; const GAS float* swg = gains + 128; const GAS float* dag = gains + 256;
        const GAS float* ropeB = (const GAS float*)(ws + WS_ROPEB); const GAS float* ropeC = (const GAS float*)(ws + WS_ROPEC); GAS bf16_t* qkv = (GAS bf16_t*)(ws + WS_QKV);
        const int pm = u.pm, pn = u.pn + pn_off;
        const int grp = pm >= 32 ? 1 : 0, b = grp ? ((pm - 32) >> 3) : pm, tbase = grp ? 256 * ((pm - 32) & 7) : 0, T = grp ? TLAT : TCTX, b5 = grp ? 1 + b : 0;
        int type, h;
        if (pn < 3) { type = pn; h = wc; } else if (pn < 5) { type = 3; h = 4 * (pn - 3) + wc; } else if (pn == 5) { type = wc < 2 ? 4 : 5; h = wc & 1; } else { type = pn; h = wc; }
        const bool isv = (type == 2 || type == 5 || type == 8), isq = (type == 0 || type == 3 || type == 6), is32 = (type == 6 || type == 7);
        const bool rope = grp && (type == 3 || type == 4 || type == 6 || type == 7);
        const int H = (type == 3) ? 8 : ((type == 4 || type == 5) ? 2 : 4);
        size_t dbase; const size_t gs = (type == 3) ? GS8 : ((type == 4 || type == 5) ? GS2 : GS4);
        switch (type) { case 0: dbase = QO_QA; break; case 1: dbase = QO_KA; break; case 2: dbase = QO_VTA; break; case 3: dbase = QO_QB; break; case 4: dbase = QO_KB; break; case 5: dbase = QO_VTB; break;
                        case 6: dbase = QO_QC; break; case 7: dbase = QO_KC; break; default: dbase = QO_VTC; break; }
        GAS bf16_t* dst = qkv + dbase + grp * gs + (size_t)(b * H + h) * T * 64;
        GAS float* fo = nullptr; int fow = 0, foc = 0;
        if (!grp) { switch (type) { case 1: fo = outg + OUT_NAK; fow = 256; foc = 64 * wc; break; case 2: fo = outg + OUT_NAV; fow = 256; foc = 64 * wc; break; case 4: fo = outg + OUT_SWK; fow = 128; foc = 64 * h; break;
                        case 5: fo = outg + OUT_SWV; fow = 128; foc = 64 * h; break; case 7: fo = outg + OUT_DAK; fow = 256; foc = 64 * wc; break; case 8: fo = outg + OUT_DAV; fow = 256; foc = 64 * wc; break; default: break; } }
        const GAS float* gsrc = ((type == 0) ? nag : (type == 1) ? nag + 64 : (type == 3) ? swg : (type == 4) ? swg + 64 : (type == 6) ? dag : dag + 32) + 4 * fq;
        const GAS float* bsrc = bias + b5 * DIN + pn * 256 + 64 * wc + 4 * fq;
        rstd_table(lds, ssq, 256 * pm, wr, wc, fr, fq);
        f32x4 bv[2][2], gv[2][2];
#pragma unroll
        for (int bj = 0; bj < 2; ++bj)
#pragma unroll
            for (int n = 0; n < 2; ++n) { bv[bj][n] = *(const GAS f32x4*)(bsrc + 32 * bj + 16 * n); gv[bj][n] = isv ? (f32x4){1.f, 1.f, 1.f, 1.f} : *(const GAS f32x4*)(gsrc + (is32 ? 0 : 32 * bj) + 16 * n); }
        EPI_BARRIER();
        const PG8_LAS float* RS = (const PG8_LAS float*)(lds + LDS_RSTD);
        const float qs = isq ? (is32 ? QSCALE32 : QSCALE64) : 1.0f;
#pragma unroll
        for (int ai = 0; ai < 2; ++ai)
#pragma unroll
            for (int m = 0; m < 4; ++m) {
                const int lr = 128 * ai + 64 * wr + 16 * m + fr, row = 256 * pm + lr, t = tbase + lr;
                const float rstd = RS[lr];
                float r0 = 1.f, r1 = 1.f;
                if (!isv) {
                    float s0 = 0.f, s1 = 0.f;
#pragma unroll
                    for (int n = 0; n < 2; ++n) { const f32x4 a = acc[ai][0][m][n] * rstd + bv[0][n], c = acc[ai][1][m][n] * rstd + bv[1][n];
                        s0 += (a[0] * a[0] + a[1] * a[1]) + (a[2] * a[2] + a[3] * a[3]); s1 += (c[0] * c[0] + c[1] * c[1]) + (c[2] * c[2] + c[3] * c[3]); }
                    s0 = xsum_fq(s0); s1 = xsum_fq(s1);
                    if (is32) { r0 = __builtin_amdgcn_rsqf(s0 * (1.f / 32.f) + 1e-6f); r1 = __builtin_amdgcn_rsqf(s1 * (1.f / 32.f) + 1e-6f); }
                    else { r0 = r1 = __builtin_amdgcn_rsqf((s0 + s1) * (1.f / 64.f) + 1e-6f); }
                }
                GAS float* fr_ = fo ? fo + ((size_t)(b * DEPTH + l) * 256 + t) * fow + foc + 4 * fq : nullptr;
#pragma unroll
                for (int bj = 0; bj < 2; ++bj)
#pragma unroll
                    for (int n = 0; n < 2; ++n) {
                        f32x4 x = acc[ai][bj][m][n] * rstd + bv[bj][n];
                        if (!isv) {
                            x = x * (bj ? r1 : r0) * gv[bj][n];
                            if (rope) {
                                const f32x4 cs = is32 ? *(const GAS f32x4*)(ropeC + ((size_t)t * 16 + 8 * n + 2 * fq) * 2) : *(const GAS f32x4*)(ropeB + ((size_t)t * 32 + 16 * bj + 8 * n + 2 * fq) * 2);
                                x = (f32x4){x[0] * cs[0] - x[1] * cs[1], x[0] * cs[1] + x[1] * cs[0], x[2] * cs[2] - x[3] * cs[3], x[2] * cs[3] + x[3] * cs[2]};
                            }
                        }
                        if (fr_) *(GAS f32x4*)(fr_ + 32 * bj + 16 * n) = x;
                        if (!isv) { const f32x4 y = x * qs; u32x2 w; w.x = cvt_pk_bf16(y[0], y[1]); w.y = cvt_pk_bf16(y[2], y[3]); *(GAS u32x2*)(dst + (size_t)t * 64 + 4 * fq + 32 * bj + 16 * n) = w; }
                        else {
                            const int d0 = 32 * bj + 16 * n + 4 * fq, q = fr & 3;
                            const unsigned A = cvt_pk_bf16(x[0], x[1]), B = cvt_pk_bf16(x[2], x[3]);
                            const unsigned pA = (unsigned)__builtin_amdgcn_mov_dpp((int)A, 0x4E, 0xf, 0xf, true), pB = (unsigned)__builtin_amdgcn_mov_dpp((int)B, 0x4E, 0xf, 0xf, true);
                            const unsigned n0 = q < 2 ? A : pB, n1 = q < 2 ? pA : B;
                            const unsigned p0 = (unsigned)__builtin_amdgcn_mov_dpp((int)n0, 0xB1, 0xf, 0xf, true), p1 = (unsigned)__builtin_amdgcn_mov_dpp((int)n1, 0xB1, 0xf, 0xf, true);
                            const unsigned sel = (q & 1) ? 0x03020706u : 0x05040100u;
                            u32x2 w; w.x = __builtin_amdgcn_perm(p0, n0, sel); w.y = __builtin_amdgcn_perm(p1, n1, sel);
                            *(GAS u32x2*)(dst + (size_t)(d0 + q) * T + (t - q)) = w; }
                    }
            }
    }
};

struct EpiRes {
    static constexpr bool PERM = false, AFTER_DRAIN = true, NEEDS_LDS = false;
    unsigned char* ws0; float* x; int l; int which;
    const float* xin_p; const float* xin_s;
    __device__ __forceinline__ void fused(const f32x4 (&acc)[2][2][4][2], const Unit& u, int wr, int wc, int fr, int fq, PG8_LAS unsigned char* lds, int wid, int lane) const {
        GAS unsigned char* ws = (GAS unsigned char*)ws0; GAS float* xg = (GAS float*)x;
        const int pm = u.pm, pn = u.pn, b5 = pm >= 32 ? 1 + ((pm - 32) >> 3) : 0;
        const GAS float* xin = xin_p ? (const GAS float*)(pm >= 32 ? xin_s : xin_p) : nullptr;
        const GAS float* gate = (const GAS float*)(ws + WS_MOD) + (size_t)(l * 5 + b5) * 6144 + (which ? 5 : 2) * 1024 + 256 * pn + 4 * lane;
        const bool hasn = which ? (l < 3) : true;
        const GAS float* gvn = (const GAS float*)(ws + WS_GV) + (size_t)(which ? l + 1 : l) * 10240 + (size_t)b5 * 2048 + (which ? 0 : 1024) + 256 * pn + 4 * lane;
        GAS bf16_t* xa = (GAS bf16_t*)(ws + WS_XA); GAS float* ssq = (GAS float*)(ws + WS_SSQ);
#ifndef X_NO_SC1
        const __amdgpu_buffer_rsrc_t xrsrc = __builtin_amdgcn_make_buffer_rsrc((void*)x, 0, (int)(MTOT * 1024 * 4), 0x00020000);
#endif
        const f32x4 g4 = *(const GAS f32x4*)gate; const f32x4 n4 = hasn ? *(const GAS f32x4*)gvn : (f32x4){0.f, 0.f, 0.f, 0.f};
#pragma unroll
        for (int ai = 0; ai < 2; ++ai) {
#pragma unroll
            for (int m = 0; m < 4; ++m) { const int row = 64 * wr + 16 * m + fr;
#pragma unroll
                for (int bj = 0; bj < 2; ++bj)
#pragma unroll
                    for (int n = 0; n < 2; ++n) *(PG8_LAS f32x4*)(lds + row * 1024 + (((32 * bj + 8 * wc + 4 * n + fq) ^ (row & 15)) << 4)) = acc[ai][bj][m][n]; }
            EPI_BARRIER();
            const int grow0 = 256 * pm + 128 * ai + 16 * wid; GAS float* xr = xg + (size_t)grow0 * 1024 + 256 * pn + 4 * lane;
#pragma unroll
            for (int k0 = 0; k0 < 16; k0 += 8) {
                f32x4 xv[8];
#pragma unroll
                for (int k = 0; k < 8; ++k) xv[k] = __builtin_nontemporal_load((const GAS f32x4*)((xin ? xin + (size_t)(grow0 - (grow0 >= MCTX ? MCTX : 0)) * 1024 + 256 * pn + 4 * lane : xr) + (size_t)(k0 + k) * 1024));
#pragma unroll
                for (int k = 0; k < 8; ++k) { const int row = 16 * wid + k0 + k;
                    const f32x4 a4 = *(const PG8_LAS f32x4*)(lds + row * 1024 + ((lane ^ (row & 15)) << 4));
                    const f32x4 y = xv[k] + g4 * a4;
#ifndef X_NO_SC1
                    __builtin_amdgcn_raw_buffer_store_b128(__builtin_bit_cast(u32x4, y), xrsrc, (int)(((size_t)(grow0 + k0 + k) * 1024 + 256 * pn + 4 * lane) * 4), 0, 16);
#else
                    __builtin_nontemporal_store(y, (GAS f32x4*)(xr + (size_t)(k0 + k) * 1024));
#endif
                    if (hasn) { float ss = (y[0] * y[0] + y[1] * y[1]) + (y[2] * y[2] + y[3] * y[3]);
                        ss = wave_sum_dpp(ss);
                        const f32x4 z = y * n4; u32x2 w; w.x = cvt_pk_bf16(z[0], z[1]); w.y = cvt_pk_bf16(z[2], z[3]);
                        *(GAS u32x2*)(xa + (size_t)(grow0 + k0 + k) * 1024 + 256 * pn + 4 * lane) = w;
                        if (lane == 0) ssq[(size_t)(grow0 + k0 + k) * 4 + pn] = ss; }
                }
            }
            EPI_BARRIER();
        }
    }
};

#define DPPF(old, src, ctrl) __builtin_bit_cast(float, __builtin_amdgcn_update_dpp(__builtin_bit_cast(int, (float)(old)), __builtin_bit_cast(int, (float)(src)), (ctrl), 0xf, 0xf, false))
struct EpiUpConv {
    static constexpr bool PERM = false, AFTER_DRAIN = false, NEEDS_LDS = true;
    unsigned char* ws0; int l;
    __device__ __forceinline__ void operator()(f32x4 (&acc)[2][2][4][2], const Unit& u, int wr, int wc, int fr_in, int fq_in, PG8_LAS unsigned char* lds) const {
        unsigned char* ws_ = ws0; asm volatile("" : "+s"(ws_)); GAS unsigned char* ws = (GAS unsigned char*)ws_;
        int fr = fr_in, fq = fq_in; asm volatile("" : "+v"(fr), "+v"(fq));
        const int pm = u.pm, pn = u.pn; const int grp = pm >= 32 ? 1 : 0, bq = grp ? (pm - 32) / 9 : 0, jq = grp ? (pm - 32) % 9 : 0;
        const int T = grp ? TLAT : TCTX, tofs = grp ? 254 * jq - 1 : 0, arow0 = grp ? MCTX + TLAT * bq + tofs : 256 * pm, b5 = grp ? 1 + bq : 0;
        const GAS float* ssq = (const GAS float*)(ws + WS_SSQ); const GAS float* bias = (const GAS float*)(ws + WS_BIASUP) + (size_t)(l * 5 + b5) * DUP; const GAS float* cw = (const GAS float*)(ws + WS_CONV) + (size_t)l * 4 * DUP;
        GAS bf16_t* act = (GAS bf16_t*)(ws + WS_ACT);
        const int fcol = 128 * pn + 32 * wc + 4 * fq;
        rstd_table(lds, ssq, arow0, wr, wc, fr, fq);
        f32x4 bv[2][2];
#pragma unroll
        for (int bj = 0; bj < 2; ++bj)
#pragma unroll
            for (int n = 0; n < 2; ++n) bv[bj][n] = *(const GAS f32x4*)(bias + bj * DFF + fcol + 16 * n);
        EPI_BARRIER();
        const PG8_LAS float* RS = (const PG8_LAS float*)(lds + LDS_RSTD);
#pragma unroll
        for (int ai = 0; ai < 2; ++ai)
#pragma unroll
            for (int m = 0; m < 4; ++m) {
                const int i = 128 * ai + 64 * wr + 16 * m + fr, t = tofs + i; const bool inseq = (t >= 0) && (t < T);
                const float rstd = RS[i];
#pragma unroll
                for (int bj = 0; bj < 2; ++bj)
#pragma unroll
                    for (int n = 0; n < 2; ++n) { const f32x4 v = acc[ai][bj][m][n] * rstd + bv[bj][n]; acc[ai][bj][m][n] = inseq ? v : (f32x4){0.f, 0.f, 0.f, 0.f}; }
            }
        PG8_LAS float* E = (PG8_LAS float*)(lds + LDS_EDGE);
#pragma unroll
        for (int ai = 0; ai < 2; ++ai) { const int c = 2 * ai + wr;
#pragma unroll
            for (int bj = 0; bj < 2; ++bj)
#pragma unroll
                for (int n = 0; n < 2; ++n) { const int col = 128 * bj + 32 * wc + 16 * n + 4 * fq;
                    if (fr == 0) *(PG8_LAS f32x4*)(E + (c * 2 + 0) * 256 + col) = acc[ai][bj][0][n];
                    if (fr == 15) *(PG8_LAS f32x4*)(E + (c * 2 + 1) * 256 + col) = acc[ai][bj][3][n]; } }
        asm volatile("s_waitcnt lgkmcnt(0)" ::: "memory"); __builtin_amdgcn_s_barrier(); asm volatile("" ::: "memory");
#pragma unroll
        for (int n = 0; n < 2; ++n) {
            f32x4 w0[2], w1[2], w2[2], cb[2];
#pragma unroll
            for (int bj = 0; bj < 2; ++bj) { const GAS float* p = cw + bj * DFF + fcol + 16 * n; w0[bj] = *(const GAS f32x4*)p; w1[bj] = *(const GAS f32x4*)(p + DUP); w2[bj] = *(const GAS f32x4*)(p + 2 * DUP); cb[bj] = *(const GAS f32x4*)(p + 3 * DUP); }
#pragma unroll
            for (int ai = 0; ai < 2; ++ai) { const int c = 2 * ai + wr;
                f32x4 ep[2], en[2];
#pragma unroll
                for (int bj = 0; bj < 2; ++bj) { const int col = 128 * bj + 32 * wc + 16 * n + 4 * fq;
                    ep[bj] = c > 0 ? *(const PG8_LAS f32x4*)(E + ((c - 1) * 2 + 1) * 256 + col) : (f32x4){0.f, 0.f, 0.f, 0.f};
                    en[bj] = c < 3 ? *(const PG8_LAS f32x4*)(E + ((c + 1) * 2 + 0) * 256 + col) : (f32x4){0.f, 0.f, 0.f, 0.f}; }
#pragma unroll
                for (int m = 0; m < 4; ++m) {
                    f32x4 y[2];
#pragma unroll
                    for (int bj = 0; bj < 2; ++bj) {
                        const f32x4 x = acc[ai][bj][m][n]; f32x4 pv, nx;
#pragma unroll
                        for (int e = 0; e < 4; ++e) {
                            const float po = m > 0 ? DPPF(acc[ai][bj][m > 0 ? m - 1 : 0][n][e], acc[ai][bj][m > 0 ? m - 1 : 0][n][e], 0x121) : ep[bj][e];
                            pv[e] = DPPF(po, x[e], 0x111);
                            const float no = m < 3 ? DPPF(acc[ai][bj][m < 3 ? m + 1 : 3][n][e], acc[ai][bj][m < 3 ? m + 1 : 3][n][e], 0x12F) : en[bj][e];
                            nx[e] = DPPF(no, x[e], 0x101);
                        }
                        y[bj] = cb[bj] + w0[bj] * pv + w1[bj] * x + w2[bj] * nx;
                    }
                    const int i = 128 * ai + 64 * wr + 16 * m + fr, t = tofs + i; const bool ok = grp ? ((i >= 1) && (i <= 254) && (t < T)) : true;
                    if (ok) { f32x4 a;
#pragma unroll
                        for (int e = 0; e < 4; ++e) a[e] = y[0][e] * __builtin_amdgcn_rcpf(1.0f + __expf(-y[0][e])) * y[1][e];
                        u32x2 w; w.x = cvt_pk_bf16(a[0], a[1]); w.y = cvt_pk_bf16(a[2], a[3]);
                        *(GAS u32x2*)(act + (size_t)(arow0 + i) * DFF + fcol + 16 * n) = w; }
                }
            } }
    }
};
}
namespace att {
typedef LAS unsigned char lds_u8;
constexpr int LDS_TILE = 16384;
constexpr int LDS_RPB = 2 * LDS_TILE;
constexpr int LDS_NEXT = LDS_RPB + 2048;
constexpr int NGEMM = 64;
constexpr int NUNITS = 1024 + NGEMM;
constexpr float RESC_THR = 0.0f;

struct Ctx { unsigned char* ws; float* out; int l; int rep; };

__device__ __forceinline__ bf16x8 lds128(const lds_u8* p) { return *(const LAS bf16x8*)p; }
__device__ __forceinline__ float xmax32(float v) { const auto rr = __builtin_amdgcn_permlane32_swap(__float_as_uint(v), __float_as_uint(v), false, false); return fmaxf(__uint_as_float(rr[0]), __uint_as_float(rr[1])); }
__device__ __forceinline__ float xsum32(float v) { const auto rr = __builtin_amdgcn_permlane32_swap(__float_as_uint(v), __float_as_uint(v), false, false); return __uint_as_float(rr[0]) + __uint_as_float(rr[1]); }
__device__ __forceinline__ float max3f(float a, float b, float c) { float r; asm("v_max3_f32 %0, %1, %2, %3" : "=v"(r) : "v"(a), "v"(b), "v"(c)); return r; }
__device__ __forceinline__ int sigma32(int i) { return (i & 19) | ((i & 4) << 1) | ((i & 8) >> 1); }
__device__ __forceinline__ int key_of(int kb, int r, int h) { return 32 * kb + 16 * (r >> 3) + 8 * h + 4 * ((r >> 2) & 1) + (r & 3); }

template <int NDS>
__device__ __forceinline__ void qk_tile(f32x16& s0, f32x16& s1, const lds_u8* Kt, int c0, const bf16x8* qf, const f32x16& negm, int lane) {
    const int k0 = sigma32(lane & 31), h = lane >> 5; const lds_u8* b0 = Kt + k0 * 128; const lds_u8* b1 = b0 + 32 * 128; const int sw = (k0 >> 1) & 7;
    bf16x8 a0[NDS], a1[NDS];
#pragma unroll
    for (int ds = 0; ds < NDS; ++ds) { const int off = ((c0 + 2 * ds + h) ^ sw) << 4; a0[ds] = lds128(b0 + off); a1[ds] = lds128(b1 + off); }
    s0 = __builtin_amdgcn_mfma_f32_32x32x16_bf16(a0[0], qf[0], negm, 0, 0, 0); s1 = __builtin_amdgcn_mfma_f32_32x32x16_bf16(a1[0], qf[0], negm, 0, 0, 0);
#pragma unroll
    for (int ds = 1; ds < NDS; ++ds) { s0 = __builtin_amdgcn_mfma_f32_32x32x16_bf16(a0[ds], qf[ds], s0, 0, 0, 0); s1 = __builtin_amdgcn_mfma_f32_32x32x16_bf16(a1[ds], qf[ds], s1, 0, 0, 0); }
}
__device__ __forceinline__ void softmax_pv(f32x16& s0, f32x16& s1, float& m, float& l, f32x16& negm, f32x16& o0, f32x16& o1, const lds_u8* Vt, int lane) {
    float mx = max3f(s0[0], s1[0], s0[1]), my = max3f(s1[1], s0[2], s1[2]);
#pragma unroll
    for (int r = 3; r < 15; r += 2) { mx = max3f(mx, s0[r], s1[r]); my = max3f(my, s0[r + 1], s1[r + 1]); }
    mx = max3f(mx, s0[15], s1[15]); mx = fmaxf(mx, my);
    mx = xmax32(mx);
    if (__any(mx > 0.f)) {
        const float dl = fmaxf(mx, 0.f); m += dl; const float al = __builtin_amdgcn_exp2f(-dl); l *= al;
#pragma unroll
        for (int r = 0; r < 16; ++r) { o0[r] *= al; o1[r] *= al; s0[r] -= dl; s1[r] -= dl; negm[r] = -m; }
    }
    const int h = lane >> 5, d = lane & 31; const lds_u8* v0 = Vt + d * 128; const lds_u8* v1 = v0 + 32 * 128; const int sw = (d >> 1) & 7;
    bf16x8 va[4], vb[4];
#pragma unroll
    for (int c = 0; c < 4; ++c) { const int off = ((2 * c + h) ^ sw) << 4; va[c] = lds128(v0 + off); vb[c] = lds128(v1 + off); }
    f32x2 ps = {0.f, 0.f}, pt = {0.f, 0.f};
#pragma unroll
    for (int r = 0; r < 16; r += 2) { s0[r] = __builtin_amdgcn_exp2f(s0[r]); s0[r + 1] = __builtin_amdgcn_exp2f(s0[r + 1]); s1[r] = __builtin_amdgcn_exp2f(s1[r]); s1[r + 1] = __builtin_amdgcn_exp2f(s1[r + 1]);
        ps += (f32x2){s0[r], s0[r + 1]}; pt += (f32x2){s1[r], s1[r + 1]}; }
    ps += pt; l += ps[0] + ps[1];
#pragma unroll
    for (int c = 0; c < 4; ++c) {
        const f32x16& s = (c >> 1) ? s1 : s0; const int b = 8 * (c & 1);
        u32x4 pw; pw.x = cvt_pk_bf16(s[b + 0], s[b + 1]); pw.y = cvt_pk_bf16(s[b + 2], s[b + 3]); pw.z = cvt_pk_bf16(s[b + 4], s[b + 5]); pw.w = cvt_pk_bf16(s[b + 6], s[b + 7]);
        const bf16x8 pf = __builtin_bit_cast(bf16x8, pw);
        o0 = __builtin_amdgcn_mfma_f32_32x32x16_bf16(va[c], pf, o0, 0, 0, 0);
        o1 = __builtin_amdgcn_mfma_f32_32x32x16_bf16(vb[c], pf, o1, 0, 0, 0);
    }
}
__device__ __forceinline__ void softmax_pv_abs(f32x16& s0, f32x16& s1, float& m, float& l, f32x16& o0, f32x16& o1, const lds_u8* Vt, int lane) {
    float mx = max3f(s0[0], s1[0], s0[1]), my = max3f(s1[1], s0[2], s1[2]);
#pragma unroll
    for (int r = 3; r < 15; r += 2) { mx = max3f(mx, s0[r], s1[r]); my = max3f(my, s0[r + 1], s1[r + 1]); }
    mx = max3f(mx, s0[15], s1[15]); mx = fmaxf(mx, my);
    mx = xmax32(mx);
    if (__any(mx > m)) { const float mn = fmaxf(m, mx); const float al = __builtin_amdgcn_exp2f(m - mn); l *= al;
#pragma unroll
        for (int r = 0; r < 16; ++r) { o0[r] *= al; o1[r] *= al; }
        m = mn; }
    const int h = lane >> 5, d = lane & 31; const lds_u8* v0 = Vt + d * 128; const lds_u8* v1 = v0 + 32 * 128; const int sw = (d >> 1) & 7;
    bf16x8 va[4], vb[4];
#pragma unroll
    for (int c = 0; c < 4; ++c) { const int off = ((2 * c + h) ^ sw) << 4; va[c] = lds128(v0 + off); vb[c] = lds128(v1 + off); }
    f32x2 ps = {0.f, 0.f}, pt = {0.f, 0.f};
#pragma unroll
    for (int r = 0; r < 16; r += 2) { s0[r] = __builtin_amdgcn_exp2f(s0[r] - m); s0[r + 1] = __builtin_amdgcn_exp2f(s0[r + 1] - m); s1[r] = __builtin_amdgcn_exp2f(s1[r] - m); s1[r + 1] = __builtin_amdgcn_exp2f(s1[r + 1] - m);
        ps += (f32x2){s0[r], s0[r + 1]}; pt += (f32x2){s1[r], s1[r + 1]}; }
    ps += pt; l += ps[0] + ps[1];
#pragma unroll
    for (int c = 0; c < 4; ++c) {
        const f32x16& s = (c >> 1) ? s1 : s0; const int b = 8 * (c & 1);
        u32x4 pw; pw.x = cvt_pk_bf16(s[b + 0], s[b + 1]); pw.y = cvt_pk_bf16(s[b + 2], s[b + 3]); pw.z = cvt_pk_bf16(s[b + 4], s[b + 5]); pw.w = cvt_pk_bf16(s[b + 6], s[b + 7]);
        const bf16x8 pf = __builtin_bit_cast(bf16x8, pw);
        o0 = __builtin_amdgcn_mfma_f32_32x32x16_bf16(va[c], pf, o0, 0, 0, 0);
        o1 = __builtin_amdgcn_mfma_f32_32x32x16_bf16(vb[c], pf, o1, 0, 0, 0);
    }
}
struct UnitGeo {
    const GAS bf16_t* qkv; const GAS bf16_t* kcb; unsigned kso, vso, kco, vco; int T, ta, nself, ntile, q0, grp, fam, b, h;
};
template <int MODE>
__device__ __forceinline__ void unit_loop(lds_u8* lds, const UnitGeo& U, const GAS float* sm, GAS bf16_t* Obase, int orow0, int ocol, int l, int tid) {
    const int lane = tid & 63, w = __builtin_amdgcn_readfirstlane(tid >> 6), h5 = lane >> 5, ql = lane & 31;
    const int T = U.T, q0 = U.q0, nself = U.nself, ntile = U.ntile, ta = U.ta;
    const int Hq = U.fam == 1 ? 8 : 4;
    const size_t qo = U.fam == 0 ? QO_QA : (U.fam == 1 ? QO_QB : QO_QC); const size_t gq = U.fam == 1 ? GS8 : GS4;
    const int qw0 = q0 + 32 * w, qtok = qw0 + ql, qrow = qtok >> 6, qcol = qtok & 63;
    const GAS bf16_t* Qp = U.qkv + qo + U.grp * gq + ((size_t)(U.b * Hq + U.h) * T + qtok) * 64;
    bf16x8 qf[4];
#pragma unroll
    for (int ds = 0; ds < 4; ++ds) qf[ds] = *(const GAS bf16x8*)(Qp + 16 * ds + 8 * h5);
    const int r0w = min(max((qw0 >> 6) - 4, 0), 24), qsl = min(max(qcol - 8, 0), 48);
    constexpr float M_INIT = -1024.0f;
    float m0 = M_INIT, l0 = 0.f, m1 = M_INIT, l1 = 0.f;
    const f32x16 z = {0.f, 0.f, 0.f, 0.f, 0.f, 0.f, 0.f, 0.f, 0.f, 0.f, 0.f, 0.f, 0.f, 0.f, 0.f, 0.f};
    f32x16 oa0 = z, oa1 = z, ob0 = z, ob1 = z;
    f32x16 ng0;
#pragma unroll
    for (int r = 0; r < 16; ++r) ng0[r] = -M_INIT;
    const int lrow = tid >> 3, lch = tid & 7; const int lds_off = lrow * 128 + ((lch ^ ((lrow >> 1) & 7)) << 4);
    u32x4 rA[2], rB[2];
    auto gload = [&](int ti_, u32x4& kr, u32x4& vr) {
        const int ti = min(ti_, ntile - 1);
        const bool self = ti < nself; const int tok0 = self ? 64 * (ta + ti) : 64 * (ti - nself); const int Tkv = self ? T : PAST;
        const GAS bf16_t* kp = (self ? U.qkv : U.kcb) + (self ? U.kso : U.kco); const GAS bf16_t* vp = (self ? U.qkv : U.kcb) + (self ? U.vso : U.vco);
        kr = *(const GAS u32x4*)(kp + (size_t)(tok0 + lrow) * 64 + lch * 8);
        vr = *(const GAS u32x4*)(vp + (size_t)lrow * Tkv + tok0 + lch * 8);
    };
    auto tile = [&](int ti, const lds_u8* Kt) {
        const lds_u8* Vt = Kt + 8192;
        const bool self = ti < nself; const int tok0 = 64 * (ta + ti);
        bool rel = true, msk = false;
        if (MODE == 1 && self) { const int kr = ta + ti; rel = (kr >= r0w) && (kr <= r0w + 7); msk = true; }
        if (MODE == 2 && self) { rel = (tok0 + 63 >= qw0 - 128) && (tok0 <= qw0 + 31 + 128); msk = !((tok0 >= qw0 + 31 - 128) && (tok0 + 63 <= qw0 + 128)); }
        if (rel) {
            if (MODE != 3) {
                f32x16 s0, s1; qk_tile<4>(s0, s1, Kt, 0, qf, ng0, lane);
                if (MODE == 1 && msk) {
                    const int kr = ta + ti; const LAS float* bt = (const LAS float*)(lds + LDS_RPB) + (kr - qrow + 7) * 31 + 15 - qcol;
                    float b0[16], b1[16];
#pragma unroll
                    for (int r = 0; r < 16; ++r) { const int kc0 = key_of(0, r, h5); b0[r] = bt[min(max(kc0, qsl), qsl + 15)]; b1[r] = bt[min(max(kc0 + 32, qsl), qsl + 15)]; }
#pragma unroll
                    for (int r = 0; r < 16; ++r) { const int kc0 = key_of(0, r, h5), kc1 = kc0 + 32;
                        s0[r] = ((kc0 >= qsl) && (kc0 < qsl + 16)) ? s0[r] + b0[r] : -INFINITY; s1[r] = ((kc1 >= qsl) && (kc1 < qsl + 16)) ? s1[r] + b1[r] : -INFINITY; }
                }
                if (MODE == 2 && msk) {
#pragma unroll
                    for (int r = 0; r < 16; ++r) { const int k0 = tok0 + key_of(0, r, h5), k1 = k0 + 32;
                        s0[r] = (abs(k0 - qtok) > 128) ? -INFINITY : s0[r]; s1[r] = (abs(k1 - qtok) > 128) ? -INFINITY : s1[r]; }
                }
                softmax_pv(s0, s1, m0, l0, ng0, oa0, oa1, Vt, lane);
            } else {
                { f32x16 s0, s1; qk_tile<2>(s0, s1, Kt, 0, qf, z, lane); softmax_pv_abs(s0, s1, m0, l0, oa0, oa1, Vt, lane); }
                { f32x16 s0, s1; qk_tile<2>(s0, s1, Kt, 4, qf + 2, z, lane); softmax_pv_abs(s0, s1, m1, l1, ob0, ob1, Vt, lane); }
            }
        }
    };
    auto step = [&](int ti, u32x4 (&W)[2], u32x4 (&L)[2]) {
        gload(ti + 2, L[0], L[1]);
        __builtin_amdgcn_sched_barrier(0);
        tile(ti, lds + (ti & 1) * LDS_TILE);
        if (ti + 1 < ntile) { lds_u8* nb = lds + ((ti + 1) & 1) * LDS_TILE; *(LAS u32x4*)(nb + lds_off) = W[0]; *(LAS u32x4*)(nb + 8192 + lds_off) = W[1]; }
        __syncthreads();
    };
    gload(0, rB[0], rB[1]);
    gload(1, rA[0], rA[1]);
    *(LAS u32x4*)(lds + lds_off) = rB[0]; *(LAS u32x4*)(lds + 8192 + lds_off) = rB[1];
    __syncthreads();
    for (int ti = 0; ti < ntile; ti += 2) {
        step(ti, rA, rB);
        if (ti + 1 < ntile) step(ti + 1, rB, rA);
    }
    GAS bf16_t* orow = Obase + (size_t)(orow0 + qtok) * 1024 + ocol + 4 * h5;
    float lt0 = xsum32(l0);
    if (U.fam == 1) lt0 += __builtin_amdgcn_exp2f(sm[SM_SINK + l * 8 + U.h] - m0);
    const float i0 = 1.0f / lt0;
    if (MODE != 3) {
#pragma unroll
        for (int g = 0; g < 4; ++g) {
            u32x2 wa, wb; wa.x = cvt_pk_bf16(oa0[4 * g] * i0, oa0[4 * g + 1] * i0); wa.y = cvt_pk_bf16(oa0[4 * g + 2] * i0, oa0[4 * g + 3] * i0);
            wb.x = cvt_pk_bf16(oa1[4 * g] * i0, oa1[4 * g + 1] * i0); wb.y = cvt_pk_bf16(oa1[4 * g + 2] * i0, oa1[4 * g + 3] * i0);
            *(GAS u32x2*)(orow + 8 * g) = wa; *(GAS u32x2*)(orow + 32 + 8 * g) = wb;
        }
    } else {
        const float lam_init = l == 0 ? 0.2f : (l == 1 ? 0.35550906759f : (l == 2 ? 0.47071301835f : 0.55605820416f));
        const float lt1 = xsum32(l1); const float i1 = 1.0f / lt1; const float lam = sm[SM_LAM + l];
        float ss = 0.f;
#pragma unroll
        for (int r = 0; r < 16; ++r) { oa0[r] = oa0[r] * i0 - lam * (ob0[r] * i1); oa1[r] = oa1[r] * i0 - lam * (ob1[r] * i1); ss += oa0[r] * oa0[r] + oa1[r] * oa1[r]; }
        ss = xsum32(ss);
        const float rn = __builtin_amdgcn_rsqf(ss * (1.f / 64.f) + 1e-6f) * (1.0f - lam_init);
        const GAS float* sg = sm + SM_SUBG + l * 64 + 4 * h5;
#pragma unroll
        for (int g = 0; g < 4; ++g) {
            const f32x4 ga = *(const GAS f32x4*)(sg + 8 * g), gb = *(const GAS f32x4*)(sg + 32 + 8 * g);
            u32x2 wa, wb; wa.x = cvt_pk_bf16(oa0[4 * g] * rn * ga[0], oa0[4 * g + 1] * rn * ga[1]); wa.y = cvt_pk_bf16(oa0[4 * g + 2] * rn * ga[2], oa0[4 * g + 3] * rn * ga[3]);
            wb.x = cvt_pk_bf16(oa1[4 * g] * rn * gb[0], oa1[4 * g + 1] * rn * gb[1]); wb.y = cvt_pk_bf16(oa1[4 * g + 2] * rn * gb[2], oa1[4 * g + 3] * rn * gb[3]);
            *(GAS u32x2*)(orow + 8 * g) = wa; *(GAS u32x2*)(orow + 32 + 8 * g) = wb;
        }
    }
}

__device__ __forceinline__ void attn_phase(lds_u8* lds, const Ctx& C) {
    const int l = C.l;
    for (;;) {
        __syncthreads();
        unsigned char* ws_ = C.ws; asm volatile("" : "+s"(ws_)); GAS unsigned char* ws = (GAS unsigned char*)ws_;
        const int tid = opaque_tid();
        if (tid == 0) *(LAS unsigned*)(lds + LDS_NEXT) = __hip_atomic_fetch_add((GAS unsigned*)(ws + WS_CTL) + 64 * (1 + l) + C.rep, 1u, __ATOMIC_RELAXED, __HIP_MEMORY_SCOPE_AGENT);
        __syncthreads();
        const int idx = (int)*(LAS unsigned*)(lds + LDS_NEXT);
#ifdef ATT_PROBE_LIMIT
        if (idx >= (C.rep ? ATT_PROBE_LIMIT : NUNITS)) break;
#else
        if (idx >= NUNITS) break;
#endif
        const GAS float* sm = (const GAS float*)(ws + WS_LAM);
        GAS unsigned* qa_done = (GAS unsigned*)(ws + WS_CTL) + 64 * (8 + l);
        if (idx < NGEMM) {
            pg8::Gemm g{(const bf16_t*)(ws_ + WS_XA), (const bf16_t*)(ws_ + WS_WIN) + (size_t)l * DIN * 1024, MTOT, 256, 1024}; pg8::OneUnit S1{idx};
            pg8::EpiIn E{ws_, C.out, l, 0};
            pg8::gemm_phase<pg8::EpiIn, pg8::OneUnit, true, true>(lds, g, S1, E);
            asm volatile("s_waitcnt vmcnt(0)" ::: "memory");
            __syncthreads();
            if (tid == 0) { __builtin_amdgcn_fence(__ATOMIC_RELEASE, "agent"); asm volatile("s_waitcnt vmcnt(0)" ::: "memory"); __hip_atomic_fetch_add(qa_done, 1u, __ATOMIC_RELAXED, __HIP_MEMORY_SCOPE_AGENT); }
            continue;
        }
        UnitGeo U; U.qkv = (const GAS bf16_t*)(ws + WS_QKV); U.kcb = (const GAS bf16_t*)(ws + WS_KC);
        int fam, grp, b, h, qb; const int iu = idx - NGEMM;
        if (iu < 128) { fam = 2; grp = 1; b = iu >> 5; h = (iu >> 3) & 3; qb = iu & 7; }
        else if (iu < 384) { const int i = iu - 128; fam = 1; grp = 1; b = i >> 6; h = (i >> 3) & 7; qb = i & 7; }
        else if (iu < 512) { const int i = iu - 384; fam = 2; grp = 0; b = i >> 2; h = i & 3; qb = 0; }
        else if (iu < 768) { const int i = iu - 512; fam = 1; grp = 0; b = i >> 3; h = i & 7; qb = 0; }
        else if (iu < 896) { const int i = iu - 768; fam = 0; grp = 1; b = i >> 5; h = (i >> 3) & 3; qb = i & 7; }
        else { const int i = iu - 896; fam = 0; grp = 0; b = i >> 2; h = i & 3; qb = 0; }
        const int q0 = qb * 256;
        if (fam == 0) {
            if (tid == 0) { unsigned sp = 0; while (__hip_atomic_load(qa_done, __ATOMIC_RELAXED, __HIP_MEMORY_SCOPE_AGENT) < (unsigned)NGEMM * (C.rep + 1) && ++sp < (1u << 22)) __builtin_amdgcn_s_sleep(2);
                __builtin_amdgcn_fence(__ATOMIC_ACQUIRE, "agent"); asm volatile("s_waitcnt vmcnt(0)" ::: "memory"); }
            __syncthreads();
        }
        const int T = grp ? TLAT : TCTX, Hkv = fam == 1 ? 2 : 4, hk = fam == 1 ? (h >> 2) : h;
        const size_t ko = fam == 0 ? QO_KA : (fam == 1 ? QO_KB : QO_KC), vo = fam == 0 ? QO_VTA : (fam == 1 ? QO_VTB : QO_VTC); const size_t gk = fam == 1 ? GS2 : GS4;
        U.kso = (unsigned)(ko + grp * gk + (size_t)(b * Hkv + hk) * T * 64); U.vso = (unsigned)(vo + grp * gk + (size_t)(b * Hkv + hk) * 64 * T);
        const size_t cko = fam == 0 ? CO_KA : (fam == 1 ? CO_KB : CO_KCC), cvo = fam == 0 ? CO_VTA : (fam == 1 ? CO_VTB : CO_VTCC);
        U.kco = (unsigned)(cko + (size_t)((l * 4 + b) * Hkv + hk) * PAST * 64); U.vco = (unsigned)(cvo + (size_t)((l * 4 + b) * Hkv + hk) * 64 * PAST);
        int ta, tb;
        if (!grp) { ta = 0; tb = 4; }
        else if (fam == 0) { ta = max(4 * qb - 4, 0); tb = min(max(4 * qb - 1, 0), 24) + 8; }
        else if (fam == 1) { ta = max(q0 - 128, 0) >> 6; tb = min(q0 + 384, TLAT) >> 6; }
        else { ta = 0; tb = 32; }
        U.T = T; U.ta = ta; U.nself = tb - ta; U.ntile = U.nself + (grp ? 8 : 0); U.q0 = q0; U.grp = grp; U.fam = fam; U.b = b; U.h = h;
        GAS bf16_t* Obase = (GAS bf16_t*)(ws + WS_O); const int orow0 = grp ? MCTX + b * TLAT : b * TCTX, ocol = (fam == 0 ? 0 : (fam == 1 ? 256 : 768)) + 64 * h;
        if (fam == 2) unit_loop<3>(lds, U, sm, Obase, orow0, ocol, l, tid);
        else if (!grp) unit_loop<0>(lds, U, sm, Obase, orow0, ocol, l, tid);
        else if (fam == 0) { if (tid < 465) *(LAS float*)(lds + LDS_RPB + 4 * tid) = sm[SM_RPB + (l * 4 + h) * 465 + tid]; unit_loop<1>(lds, U, sm, Obase, orow0, ocol, l, tid); }
        else unit_loop<2>(lds, U, sm, Obase, orow0, ocol, l, tid);
    }
}
}
namespace misc {
typedef LAS unsigned char lds_u8;
__device__ __forceinline__ float wave_sum(float v) {
#pragma unroll
    for (int o = 1; o < 64; o <<= 1) v += __shfl_xor(v, o);
    return v;
}
__device__ const double INVB[16] = {1.0, 0.5623413251903491, 0.31622776601683794, 0.1778279410038923, 0.1, 0.05623413251903491, 0.03162277660168379, 0.01778279410038923,
                                    0.01, 0.005623413251903491, 0.0031622776601683794, 0.001778279410038923, 0.001, 0.0005623413251903491, 0.00031622776601683794, 0.0001778279410038923};
__device__ const double INVC[8] = {1.0, 0.31622776601683794, 0.1, 0.03162277660168379, 0.01, 0.0031622776601683794, 0.001, 0.00031622776601683794};
__device__ __forceinline__ void sincos_d(double a, float& c, float& s) {
    const double k = rint(a * 0.6366197723675814);
    double r = fma(-k, 1.5707963267948966, a); r = fma(-k, 6.123233995736766e-17, r);
    const double r2 = r * r;
    const double sp = r * (1.0 + r2 * (-1.0 / 6.0 + r2 * (1.0 / 120.0 + r2 * (-1.0 / 5040.0 + r2 * (1.0 / 362880.0 + r2 * (-1.0 / 39916800.0 + r2 * (1.0 / 6227020800.0)))))));
    const double cp = 1.0 + r2 * (-0.5 + r2 * (1.0 / 24.0 + r2 * (-1.0 / 720.0 + r2 * (1.0 / 40320.0 + r2 * (-1.0 / 3628800.0 + r2 * (1.0 / 479001600.0 + r2 * (-1.0 / 87178291200.0)))))));
    const int q = ((int)k) & 3;
    const double cc = (q == 0) ? cp : (q == 1) ? -sp : (q == 2) ? -cp : sp;
    const double ss = (q == 0) ? sp : (q == 1) ? cp : (q == 2) ? -sp : -cp;
    c = (float)cc; s = (float)ss;
}
__device__ __forceinline__ void transpose_item(const float* W, int K, int N, bf16_t* WT, int k0, int n0, int dst0, LAS float* scr, int lane) {
    const int kr = lane >> 3, c4 = (lane & 7) * 4; f32x4 v[8];
#pragma unroll
    for (int i = 0; i < 8; ++i) v[i] = *(const f32x4*)(W + (size_t)(k0 + 8 * i + kr) * N + n0 + c4);
#pragma unroll
    for (int i = 0; i < 8; ++i) { LAS float* d = scr + (8 * i + kr) * 33 + c4; d[0] = v[i][0]; d[1] = v[i][1]; d[2] = v[i][2]; d[3] = v[i][3]; }
    asm volatile("s_waitcnt lgkmcnt(0)" ::: "memory");
    const int c = lane & 7;
#pragma unroll
    for (int j = 0; j < 4; ++j) { const int n = (lane >> 3) + 8 * j; const LAS float* s = scr + (8 * c) * 33 + n;
        u32x4 o; o.x = cvt_pk_bf16(s[0 * 33], s[1 * 33]); o.y = cvt_pk_bf16(s[2 * 33], s[3 * 33]); o.z = cvt_pk_bf16(s[4 * 33], s[5 * 33]); o.w = cvt_pk_bf16(s[6 * 33], s[7 * 33]);
        *(u32x4*)(WT + (size_t)(dst0 + n) * K + k0 + 8 * c) = o; }
    asm volatile("s_waitcnt lgkmcnt(0)" ::: "memory");
}
__device__ __forceinline__ void gemv5_item(const float* W, int N, int n0, const LAS float* vec, LAS float* red, const float* add, float* out, int ostride, int tid) {
    const int c2 = (tid & 31) * 2, kq = tid >> 5; f32x2 a0 = {0.f, 0.f}, a1 = a0, a2 = a0, a3 = a0, a4 = a0;
    const float* wp = W + (size_t)(kq * 64) * N + n0 + c2; const LAS float* vp = vec + kq * 64;
#pragma unroll 16
    for (int k = 0; k < 64; ++k) { const f32x2 w = *(const f32x2*)(wp + (size_t)k * N); a0 += w * vp[k]; a1 += w * vp[1024 + k]; a2 += w * vp[2048 + k]; a3 += w * vp[3072 + k]; a4 += w * vp[4096 + k]; }
    *(LAS f32x2*)(red + (kq * 5 + 0) * 64 + c2) = a0; *(LAS f32x2*)(red + (kq * 5 + 1) * 64 + c2) = a1; *(LAS f32x2*)(red + (kq * 5 + 2) * 64 + c2) = a2; *(LAS f32x2*)(red + (kq * 5 + 3) * 64 + c2) = a3; *(LAS f32x2*)(red + (kq * 5 + 4) * 64 + c2) = a4;
    __syncthreads();
    if (tid < 320) { const int b = tid >> 6, c = tid & 63; float s = add ? add[n0 + c] : 0.f;
#pragma unroll
        for (int q = 0; q < 16; ++q) s += red[(q * 5 + b) * 64 + c];
        out[(size_t)b * ostride + n0 + c] = s; }
    __syncthreads();
}

__device__ __forceinline__ void phase_tables(const Args& a) {
    const int gtid = blockIdx.x * 512 + opaque_tid(), NT = gridDim.x * 512; unsigned char* ws = a.ws;
    float* sm = (float*)(ws + WS_LAM);
    if (gtid < 4) { const int l = gtid; const float* lp = a.in[I_LAMBDA] + l * 128; float s1 = 0.f, s2 = 0.f;
        for (int i = 0; i < 32; ++i) { s1 += lp[i] * lp[32 + i]; s2 += lp[64 + i] * lp[96 + i]; }
        sm[SM_LAM + l] = expf(s1) - expf(s2) + (0.8f - 0.6f * expf(-0.3f * (float)l)); }
    for (int i = gtid; i < 1280; i += NT) { const int l = i / 320, r = i % 320; sm[SM_GAINS + i] = r < 128 ? a.in[I_NAG][l * 128 + r] : (r < 256 ? a.in[I_SWG][l * 128 + r - 128] : a.in[I_DAG][l * 64 + r - 256]); }
    for (int i = gtid; i < 7440; i += NT) sm[SM_RPB + i] = a.in[I_RPB][i] * LOG2E;
    for (int i = gtid; i < 32; i += NT) sm[SM_SINK + i] = a.in[I_SINK][i] * LOG2E;
    for (int i = gtid; i < 256; i += NT) sm[SM_SUBG + i] = a.in[I_SUBG][i];
    float* cv = (float*)(ws + WS_CONV);
    for (int i = gtid; i < 4 * 4 * DUP; i += NT) { const int c = i % DUP, j = (i / DUP) & 3, l = i / (4 * DUP); cv[i] = j < 3 ? a.in[I_CONVW][(size_t)(l * 3 + j) * DUP + c] : a.in[I_CONVB][(size_t)l * DUP + c]; }
    float* rb = (float*)(ws + WS_ROPEB); float* rc = (float*)(ws + WS_ROPEC);
    for (int i = gtid; i < 2048 * 32; i += NT) { const int t = i >> 5, j = i & 31; const double pos = (double)(j < 16 ? (t >> 6) : (t & 63)); float c, s; sincos_d(pos * INVB[j & 15], c, s); rb[2 * i] = c; rb[2 * i + 1] = s; }
    for (int i = gtid; i < 2048 * 16; i += NT) { const int t = i >> 4, j = i & 15; const double pos = (double)(j < 8 ? (t >> 6) : (t & 63)); float c, s; sincos_d(pos * INVC[j & 7], c, s); rc[2 * i] = c; rc[2 * i + 1] = s; }
}
constexpr int N_TR_IN = 144, N_TR_OUT = 64, N_TR_UP = 352, N_TR_DN = 176, N_MOD = 96, N_BIAS_IN = 36, N_BIAS_UP = 88, N_CACHE = 640;
__device__ __forceinline__ void fl_tr(lds_u8* lds, const Args& a, int l, int which, int bi, int tid) {
    const int lane = tid & 63, wave = __builtin_amdgcn_readfirstlane(tid >> 6); LAS float* scr = (LAS float*)(lds + wave * 16384); unsigned char* ws = a.ws; const int r = bi * 8 + wave;
    if (which == 0) { const int kb = r / 72, nb = r % 72, n0 = 32 * nb; const int tile = n0 >> 8, L = n0 & 255, wc = L >> 6, bj = (L >> 5) & 1; const int dst0 = 256 * tile + 128 * bj + 32 * wc;
        transpose_item(a.in[I_WIN] + (size_t)l * 1024 * DIN, 1024, DIN, (bf16_t*)(ws + WS_WIN) + (size_t)l * DIN * 1024, 64 * kb, n0, dst0, scr, lane); }
    else if (which == 1) { const int kb = r / 32, nb = r % 32; transpose_item(a.in[I_WOUT] + (size_t)l * 1024 * 1024, 1024, 1024, (bf16_t*)(ws + WS_WOUT) + (size_t)l * 1024 * 1024, 64 * kb, 32 * nb, 32 * nb, scr, lane); }
    else if (which == 2) { const int kb = r / 176, nb = r % 176, n0 = 32 * nb; const int nn = n0 < DFF ? n0 : n0 - DFF; const int dst0 = 256 * (nn >> 7) + (n0 < DFF ? 0 : 128) + (nn & 127);
        transpose_item(a.in[I_WUP] + (size_t)l * 1024 * DUP, 1024, DUP, (bf16_t*)(ws + WS_WUP) + (size_t)l * DUP * 1024, 64 * kb, n0, dst0, scr, lane); }
    else { const int kb = r / 32, nb = r % 32; transpose_item(a.in[I_WDOWN] + (size_t)l * DFF * 1024, DFF, 1024, (bf16_t*)(ws + WS_WDOWN) + (size_t)l * 1024 * DFF, 64 * kb, 32 * nb, 32 * nb, scr, lane); }
}
__device__ __forceinline__ void fl_mod(lds_u8* lds, const Args& a, int l, int g, int tid) {
    LAS float* vec = (LAS float*)lds; LAS float* red = (LAS float*)(lds + 20480);
    for (int i = tid; i < 5120; i += 512) { const int b5 = i >> 10, k = i & 1023; const float v = b5 == 0 ? a.in[I_CCTX][k] : a.in[I_C][(b5 - 1) * 1024 + k]; vec[i] = v / (1.f + __expf(-v)); }
    __syncthreads();
    gemv5_item(a.in[I_WMOD] + (size_t)l * 1024 * 6144, 6144, 64 * g, vec, red, a.in[I_BMOD] + l * 6144, (float*)(a.ws + WS_MOD) + (size_t)l * 5 * 6144, 6144, tid);
}
__device__ __forceinline__ void fl_bias(lds_u8* lds, const Args& a, int l, int which, int g, int tid) {
    LAS float* vec = (LAS float*)lds; LAS float* red = (LAS float*)(lds + 20480); const float* mod = (const float*)(a.ws + WS_MOD);
    for (int i = tid; i < 5120; i += 512) { const int b5 = i >> 10, k = i & 1023; vec[i] = mod[((size_t)(l * 5 + b5) * 6 + (which ? 3 : 0)) * 1024 + k]; }
    __syncthreads();
    if (!which) gemv5_item(a.in[I_WIN] + (size_t)l * 1024 * DIN, DIN, 64 * g, vec, red, nullptr, (float*)(a.ws + WS_BIASIN) + (size_t)l * 5 * DIN, DIN, tid);
    else gemv5_item(a.in[I_WUP] + (size_t)l * 1024 * DUP, DUP, 64 * g, vec, red, nullptr, (float*)(a.ws + WS_BIASUP) + (size_t)l * 5 * DUP, DUP, tid);
}
__device__ __forceinline__ void fl_gv(const Args& a, int l, int tid) {
    const float* mod = (const float*)(a.ws + WS_MOD); float* gv = (float*)(a.ws + WS_GV) + (size_t)l * 10240;
    for (int i = tid; i < 10240; i += 512) { const int c = i & 1023, which = (i >> 10) & 1, b5 = i >> 11;
        gv[i] = a.in[which ? I_GFFN : I_GATTN][l * 1024 + c] * (1.f + mod[((size_t)(l * 5 + b5) * 6 + (which ? 4 : 1)) * 1024 + c]); }
}
__device__ __forceinline__ void fl_cache(const Args& a, int l, int ci, int tid) {
    bf16_t* kc = (bf16_t*)(a.ws + WS_KC); int i = ci * 512 + tid;
    if (i < 163840) { const int fam = i < 65536 ? 0 : (i < 98304 ? 1 : 2); i -= fam == 0 ? 0 : (fam == 1 ? 65536 : 98304); const int H = fam == 1 ? 2 : 4;
        const float* ck = a.in[fam == 0 ? I_CNAK : (fam == 1 ? I_CSWK : I_CDAK)]; bf16_t* dk = kc + (fam == 0 ? CO_KA : (fam == 1 ? CO_KB : CO_KCC));
        const int d8 = i & 7, hh = (i >> 3) % H, p = (i / (8 * H)) & 511, b = i / (8 * H * 512);
        const float* s = ck + ((((size_t)b * 4 + l) * 512 + p) * H + hh) * 64 + d8 * 8; const f32x4 x = *(const f32x4*)s, y = *(const f32x4*)(s + 4);
        u32x4 o; o.x = cvt_pk_bf16(x[0], x[1]); o.y = cvt_pk_bf16(x[2], x[3]); o.z = cvt_pk_bf16(y[0], y[1]); o.w = cvt_pk_bf16(y[2], y[3]);
        *(u32x4*)(dk + ((((size_t)l * 4 + b) * H + hh) * 512 + p) * 64 + d8 * 8) = o; }
    else { i -= 163840; const int fam = i < 65536 ? 0 : (i < 98304 ? 1 : 2); i -= fam == 0 ? 0 : (fam == 1 ? 65536 : 98304); const int H = fam == 1 ? 2 : 4;
        const float* cv = a.in[fam == 0 ? I_CNAV : (fam == 1 ? I_CSWV : I_CDAV)]; bf16_t* dv = kc + (fam == 0 ? CO_VTA : (fam == 1 ? CO_VTB : CO_VTCC));
        const int d = i & 63, p8 = (i >> 6) & 63, hh = (i >> 12) % H, b = i / (4096 * H);
        const float* s = cv + ((((size_t)b * 4 + l) * 512 + p8 * 8) * H + hh) * 64 + d; float x[8];
#pragma unroll
        for (int j = 0; j < 8; ++j) x[j] = s[(size_t)j * H * 64];
        u32x4 o; o.x = cvt_pk_bf16(x[0], x[1]); o.y = cvt_pk_bf16(x[2], x[3]); o.z = cvt_pk_bf16(x[4], x[5]); o.w = cvt_pk_bf16(x[6], x[7]);
        *(u32x4*)(dv + ((((size_t)l * 4 + b) * H + hh) * 64 + d) * 512 + p8 * 8) = o; }
}
enum { SLOT_PROA = 0, SLOT_PROB = 1, SLOT_IN = 2, SLOT_UP = 3 };
__device__ __forceinline__ void fill_run(lds_u8* lds, const Args& a, int slot, int l, int rep = 0) {
    const int tid = opaque_tid();
    unsigned* counter = (unsigned*)(a.ws + WS_CTL) + 64 * (16 + 4 * slot + l) + rep;
    LAS unsigned* nxt = (LAS unsigned*)(lds + 131072 + 512);
    for (;;) {
        __syncthreads();
        if (tid == 0) *nxt = __hip_atomic_fetch_add(counter, 1u, __ATOMIC_RELAXED, __HIP_MEMORY_SCOPE_AGENT);
        __syncthreads();
        int i = (int)*nxt;
        if (slot == SLOT_PROA) {
            if (i < N_MOD) { fl_mod(lds, a, 0, i, tid); continue; } i -= N_MOD;
            if (i < N_TR_IN) { fl_tr(lds, a, 0, 0, i, tid); continue; }
            break;
        } else if (slot == SLOT_PROB) {
            if (i < 1) { fl_gv(a, 0, tid); continue; } i -= 1;
            if (i < N_BIAS_IN) { fl_bias(lds, a, 0, 0, i, tid); continue; }
            break;
        } else if (slot == SLOT_IN) {
            if (l == 0) { if (i < N_BIAS_UP) { fl_bias(lds, a, 0, 1, i, tid); continue; } i -= N_BIAS_UP; }
            if (l < 3) { if (i < N_MOD) { fl_mod(lds, a, l + 1, i, tid); continue; } i -= N_MOD; }
            if (i < N_CACHE) { fl_cache(a, l, i, tid); continue; } i -= N_CACHE;
            if (i < N_TR_OUT) { fl_tr(lds, a, l, 1, i, tid); continue; } i -= N_TR_OUT;
            if (i < N_TR_UP) { fl_tr(lds, a, l, 2, i, tid); continue; } i -= N_TR_UP;
            if (i < N_TR_DN) { fl_tr(lds, a, l, 3, i, tid); continue; } i -= N_TR_DN;
            if (l < 3) { if (i < N_TR_IN) { fl_tr(lds, a, l + 1, 0, i, tid); continue; } }
            break;
        } else {
            if (l >= 3) break;
            if (i < 1) { fl_gv(a, l + 1, tid); continue; } i -= 1;
            if (i < N_BIAS_IN) { fl_bias(lds, a, l + 1, 0, i, tid); continue; } i -= N_BIAS_IN;
            if (i < N_BIAS_UP) { fl_bias(lds, a, l + 1, 1, i, tid); continue; }
            break;
        }
    }
}
__device__ __forceinline__ void phase_make_xa(const Args& a, int l, int which, int first) {
    const int tid = opaque_tid(), lane = tid & 63, wave = tid >> 6; unsigned char* ws = a.ws;
    const float* mod = (const float*)(ws + WS_MOD); bf16_t* xa = (bf16_t*)(ws + WS_XA); float* ssq = (float*)(ws + WS_SSQ);
    const float* gsrc = a.in[which ? I_GFFN : I_GATTN] + l * 1024;
    for (int row = blockIdx.x * 8 + wave; row < MTOT; row += gridDim.x * 8) {
        const float* src = first ? (row < MCTX ? a.in[I_XP] + (size_t)row * 1024 : a.in[I_XS] + (size_t)(row - MCTX) * 1024) : a.out + (size_t)row * 1024;
        const float* sc = mod + ((size_t)(l * 5 + row_b5(row)) * 6 + (which ? 4 : 1)) * 1024;
        f32x4 v[4]; float s = 0.f;
#pragma unroll
        for (int j = 0; j < 4; ++j) { v[j] = *(const f32x4*)(src + 256 * j + 4 * lane); s += (v[j][0] * v[j][0] + v[j][1] * v[j][1]) + (v[j][2] * v[j][2] + v[j][3] * v[j][3]); }
        s = wave_sum(s);
#pragma unroll
        for (int j = 0; j < 4; ++j) {
            const f32x4 g = *(const f32x4*)(gsrc + 256 * j + 4 * lane) * (*(const f32x4*)(sc + 256 * j + 4 * lane) + 1.0f);
            const f32x4 y = v[j] * g; u32x2 w; w.x = cvt_pk_bf16(y[0], y[1]); w.y = cvt_pk_bf16(y[2], y[3]); *(u32x2*)(xa + (size_t)row * 1024 + 256 * j + 4 * lane) = w; }
        if (lane < 4) ssq[(size_t)row * 4 + lane] = lane == 0 ? s : 0.f;
    }
}
}
constexpr int LDS_BYTES = 147456;
enum Phase { PH_MAKEXA = 2, PH_IN, PH_ATT, PH_OUT, PH_UP, PH_CONV, PH_DOWN };

constexpr int LDS_DUMMY = 131072 + 12288;
__device__ __forceinline__ void prefetch_panel(LAS unsigned char* lds, const bf16_t* tile, int K, int kbytes  ) {
    const int tid = opaque_tid(), wave = __builtin_amdgcn_readfirstlane(tid >> 6); const int segs = kbytes >> 7, nlines = 256 * segs;
    LAS unsigned* dst = (LAS unsigned*)(lds + LDS_DUMMY + wave * 256);
    for (int line = tid; line < nlines; line += 512) { const int row = line / segs, seg = line % segs;
        __builtin_amdgcn_global_load_lds((const unsigned*)((const char*)tile + (size_t)row * K * 2 + seg * 128), dst, 4, 0, 0); }
}
__device__ __forceinline__ void run_phase(LAS unsigned char* lds, const Args& a, int ph, int l, int p1, int p2) {
    unsigned char* ws = a.ws; const int G = gridDim.x;
    switch (ph) {
    case PH_MAKEXA: misc::phase_make_xa(a, l, p1, p2); break;
    case PH_IN: {
        pg8::Gemm g{(const bf16_t*)(ws + WS_XA), (const bf16_t*)(ws + WS_WIN) + (size_t)l * DIN * 1024 + (size_t)256 * 1024, MTOT, DIN - 256, 1024}; pg8::StaticOrder S; S.init(MTOT, DIN - 256, G, (int)blockIdx.x);
#ifdef TS_GEMM
        if (l == 1 && blockIdx.x == TS_BLOCK && TS_PHASE == ph) g.ts = (volatile unsigned long long*)(ws + WS_CTL + 512 * 1024);
#endif
        pg8::EpiIn E{ws, a.out, l, 1};
        pg8::gemm_phase<pg8::EpiIn, pg8::StaticOrder, true, true>(lds, g, S, E); } break;
    case PH_ATT: {
        att::Ctx C{ws, a.out, l, p1};
        att::attn_phase(lds, C); } break;
    case PH_OUT: {
        pg8::Gemm g{(const bf16_t*)(ws + WS_O), (const bf16_t*)(ws + WS_WOUT) + (size_t)l * 1024 * 1024, MTOT, 1024, 1024}; pg8::StaticOrder S; S.init(MTOT, 1024, G, (int)blockIdx.x);
#ifdef TS_GEMM
        if (l == 1 && blockIdx.x == TS_BLOCK && TS_PHASE == ph) g.ts = (volatile unsigned long long*)(ws + WS_CTL + 512 * 1024);
#endif
        pg8::EpiRes E{ws, a.out, l, 0, l == 0 ? a.in[I_XP] : nullptr, l == 0 ? a.in[I_XS] : nullptr};
#ifdef WARM_OUT
        { pg8::Unit u; if (S.next(0, u)) { prefetch_panel(lds, (const bf16_t*)(ws + WS_WOUT) + (size_t)l * 1024 * 1024 + (size_t)u.pn * 256 * 1024, 1024, 2048); prefetch_panel(lds, (const bf16_t*)(ws + WS_O) + (size_t)u.pm * 256 * 1024, 1024, 2048); }
          asm volatile("s_waitcnt vmcnt(0)" ::: "memory"); __syncthreads(); }
#endif
        pg8::gemm_phase<pg8::EpiRes, pg8::StaticOrder, false, true>(lds, g, S, E); } break;
    case PH_UP: {
        pg8::Gemm g{(const bf16_t*)(ws + WS_XA), (const bf16_t*)(ws + WS_WUP) + (size_t)l * DUP * 1024, MTOT, DUP, 1024}; pg8::UpOrder S; S.init_up(G, (int)blockIdx.x);
#ifdef TS_GEMM
        if (l == 1 && blockIdx.x == TS_BLOCK && TS_PHASE == ph) g.ts = (volatile unsigned long long*)(ws + WS_CTL + 512 * 1024);
#endif
        pg8::EpiUpConv E{ws, l};
        pg8::gemm_phase<pg8::EpiUpConv, pg8::UpOrder, true, true>(lds, g, S, E); } break;
    case PH_DOWN: {
        pg8::Gemm g{(const bf16_t*)(ws + WS_ACT), (const bf16_t*)(ws + WS_WDOWN) + (size_t)l * 1024 * DFF, MTOT, 1024, DFF}; pg8::StaticOrder S; S.init(MTOT, 1024, G, (int)blockIdx.x);
#ifdef TS_GEMM
        if (l == 1 && blockIdx.x == TS_BLOCK && TS_PHASE == ph) g.ts = (volatile unsigned long long*)(ws + WS_CTL + 512 * 1024);
#endif
        pg8::EpiRes E{ws, a.out, l, 1, nullptr, nullptr};
        pg8::gemm_phase<pg8::EpiRes, pg8::StaticOrder, false, true>(lds, g, S, E); } break;
    default: break;
    }
}

#define XB_TMO      128
#define XB_XCNT(j)  (256  + 64 * (j))
#define XB_XSUB(j)  (1280 + 64 * (j))
#define XB_XGEN(j)  (2304 + 64 * (j))
#define XB_TOP      3328
#define XB_TOPGEN   3392
#define XCD_BAR_WORDS 3456
#define XB_SPIN_CAP (1u << 18)
__device__ __forceinline__ unsigned xb_ld(unsigned* p)              { return __hip_atomic_load(p, __ATOMIC_RELAXED, __HIP_MEMORY_SCOPE_AGENT); }
__device__ __forceinline__ unsigned xb_add(unsigned* p, unsigned v) { return __hip_atomic_fetch_add(p, v, __ATOMIC_RELAXED, __HIP_MEMORY_SCOPE_AGENT); }
__device__ __forceinline__ unsigned xb_xcc_id() { return (unsigned)__builtin_amdgcn_s_getreg((3 << 11) | 20) & 0xFu; }
#define XB_SPIN(cond, bar) do { unsigned _sp = 0; while (cond) { __builtin_amdgcn_s_sleep(1); \
    if ((++_sp & 255u) == 0u) { if (xb_ld(&(bar)[XB_TMO])) break; if (_sp > XB_SPIN_CAP) { atomicAdd(&(bar)[XB_TMO], 1u); break; } } } } while (0)
struct XcdBarrier { unsigned* bar; unsigned x; volatile LAS unsigned* st; };
__device__ __forceinline__ XcdBarrier xcd_barrier_post(unsigned* bar, volatile LAS unsigned* st) {
    XcdBarrier b; b.bar = bar; b.x = xb_xcc_id(); b.st = st;
    if (threadIdx.x == 0) (void)xb_add(&bar[XB_XCNT(b.x)], 1u);
    return b;
}
__device__ __forceinline__ void xcd_barrier_complete(unsigned* bar, unsigned x, unsigned& nloc, unsigned& nx) {
    const unsigned G = gridDim.x * gridDim.y * gridDim.z;
    unsigned sum, cnt, mine, sp = 0u;
    for (;;) {
        sum = 0u; cnt = 0u; mine = 0u;
#pragma unroll
        for (unsigned j = 0; j < 16; ++j) { const unsigned c = xb_ld(&bar[XB_XCNT(j)]); sum += c; cnt += (c > 0u) ? 1u : 0u; mine = (j == x) ? c : mine; }
        if (sum == G) break;
        __builtin_amdgcn_s_sleep(1);
        if ((++sp & 255u) == 0u) { if (xb_ld(&bar[XB_TMO])) break; if (sp > XB_SPIN_CAP) { atomicAdd(&bar[XB_TMO], 1u); break; } }
    }
    nloc = mine > 0u ? mine : 1u; nx = cnt > 0u ? cnt : 1u;
}
__device__ __forceinline__ void xcd_barrier(const XcdBarrier& b) {
    asm volatile("s_waitcnt vmcnt(0)" ::: "memory");
    __syncthreads();
    if (threadIdx.x == 0) {
        unsigned* bar = b.bar;
        __builtin_amdgcn_s_waitcnt(0);
        unsigned nloc = b.st[0], nx = b.st[1];
        if (nloc == 0u) { xcd_barrier_complete(bar, b.x, nloc, nx); b.st[0] = nloc; b.st[1] = nx; }
        const unsigned old = xb_add(&bar[XB_XSUB(b.x)], 1u);
        const unsigned gen = old / nloc;
        if (old + 1u == (gen + 1u) * nloc) {
            __builtin_amdgcn_fence(__ATOMIC_RELEASE, "agent");
            asm volatile("s_waitcnt vmcnt(0)" ::: "memory");
            const unsigned og = xb_add(&bar[XB_TOP], 1u);
            const unsigned tg = og / nx;
            if (og + 1u == (tg + 1u) * nx) xb_add(&bar[XB_TOPGEN], 1u);
            else XB_SPIN(xb_ld(&bar[XB_TOPGEN]) == tg, bar);
            __builtin_amdgcn_fence(__ATOMIC_ACQUIRE, "agent");
            xb_add(&bar[XB_XGEN(b.x)], 1u);
            asm volatile("s_waitcnt vmcnt(0)" ::: "memory");
        } else {
            XB_SPIN(xb_ld(&bar[XB_XGEN(b.x)]) == gen, bar);
            __builtin_amdgcn_fence(__ATOMIC_ACQUIRE, "agent");
            asm volatile("s_waitcnt vmcnt(0)" ::: "memory");
        }
    }
    __syncthreads();
}
constexpr int CW_BAR = 4096;
constexpr int LDS_BARST = LDS_BYTES - 64;

__device__ __forceinline__ void prefetch_next(LAS unsigned char* lds, const Args& a, int ph, int l) {
    unsigned char* ws = a.ws; const int G = gridDim.x; pg8::Unit u;
    if (ph == PH_IN) { pg8::StaticOrder S; S.init(MTOT, DIN - 256, G, (int)blockIdx.x); if (S.next(0, u)) prefetch_panel(lds, (const bf16_t*)(ws + WS_WIN) + (size_t)l * DIN * 1024 + (size_t)(u.pn + 1) * 256 * 1024, 1024, 2048); }
    else if (ph == PH_OUT) { pg8::StaticOrder S; S.init(MTOT, 1024, G, (int)blockIdx.x); if (S.next(0, u)) prefetch_panel(lds, (const bf16_t*)(ws + WS_WOUT) + (size_t)l * 1024 * 1024 + (size_t)u.pn * 256 * 1024, 1024, 2048); }
    else if (ph == PH_UP) { pg8::UpOrder S; S.init_up(G, (int)blockIdx.x); if (S.next(0, u)) prefetch_panel(lds, (const bf16_t*)(ws + WS_WUP) + (size_t)l * DUP * 1024 + (size_t)u.pn * 256 * 1024, 1024, 2048); }
    else if (ph == PH_DOWN) { pg8::StaticOrder S; S.init(MTOT, 1024, G, (int)blockIdx.x); if (S.next(0, u)) prefetch_panel(lds, (const bf16_t*)(ws + WS_WDOWN) + (size_t)l * 1024 * DFF + (size_t)u.pn * 256 * DFF, DFF, 2048); }
}
__global__ void __launch_bounds__(512, 2) mk_fwd(Args a) {
    extern __shared__ __attribute__((aligned(16))) unsigned char lds_raw[];
    LAS unsigned char* lds = (LAS unsigned char*)lds_raw;
    cg::grid_group grid = cg::this_grid();
    if (threadIdx.x < 2) ((volatile LAS unsigned*)(lds + LDS_BARST))[threadIdx.x] = 0u;
    __syncthreads();
    const XcdBarrier xbar = xcd_barrier_post((unsigned*)(a.ws + WS_CTL) + CW_BAR, (volatile LAS unsigned*)(lds + LDS_BARST));
#define GSYNC() xcd_barrier(xbar)
#ifdef TS_A
#define TSB ((volatile unsigned long long*)(a.ws + WS_CTL + 512 * 1024))
#define STAMP(k) do { if (blockIdx.x == TS_BLOCK && threadIdx.x == 0) TSB[k] = __builtin_amdgcn_s_memrealtime(); } while (0)
#else
#define STAMP(k) do {} while (0)
#endif
    STAMP(0);
#ifdef TS_XCC
    if (threadIdx.x == 0) ((volatile unsigned*)(a.ws + WS_CTL + 768 * 1024))[blockIdx.x] = xb_xcc_id();
#endif
    grid.sync();
    misc::phase_tables(a); misc::fill_run(lds, a, misc::SLOT_PROA, 0); GSYNC(); STAMP(1);
    misc::fill_run(lds, a, misc::SLOT_PROB, 0);
#pragma unroll 1
    for (int l = 0; l < DEPTH; ++l) misc::fill_run(lds, a, misc::SLOT_IN, l);
    GSYNC();
#pragma unroll 1
    for (int l = 0; l < DEPTH - 1; ++l) misc::fill_run(lds, a, misc::SLOT_UP, l);
    run_phase(lds, a, PH_MAKEXA, 0, 0, 1); GSYNC();
#ifndef REP_IN
#define REP_IN 1
#endif
#ifndef REP_ATT
#define REP_ATT 1
#endif
#ifndef REP_UP
#define REP_UP 1
#endif
    STAMP(2);
#pragma unroll 1
    for (int l = 0; l < DEPTH; ++l) {
        if (l == 1) STAMP(10);
#pragma unroll 1
        for (int rep = 0; rep < REP_IN; ++rep) { run_phase(lds, a, PH_IN, l, 0, 0); if (l == 1) STAMP(11); GSYNC(); }
        if (l == 1) STAMP(12);
#pragma unroll 1
        for (int rep = 0; rep < REP_ATT; ++rep) { run_phase(lds, a, PH_ATT, l, rep, 0); if (l == 1) STAMP(13); GSYNC(); }
        if (l == 1) STAMP(14);
        run_phase(lds, a, PH_OUT, l, 0, 0); if (l == 1) STAMP(15); GSYNC();
        if (l == 1) STAMP(16);
#pragma unroll 1
        for (int rep = 0; rep < REP_UP; ++rep) { run_phase(lds, a, PH_UP, l, 0, 0); if (l == 1) STAMP(17); GSYNC(); }
        if (l == 1) STAMP(18);
        run_phase(lds, a, PH_DOWN, l, 0, 0); if (l == 1) STAMP(19);
        if (l < DEPTH - 1) GSYNC();
        if (l == 1) STAMP(20);
    }
#ifdef TS_A
    GSYNC();
    if (blockIdx.x == TS_BLOCK) {
#ifdef TS_XCC
        volatile unsigned* xc = (volatile unsigned*)(a.ws + WS_CTL + 768 * 1024); int mism = 0;
        for (int b = 0; b < (int)gridDim.x; ++b) { const unsigned ref = (TS_XCC == 1) ? xc[b % 8] : xc[(b / 32) * 32]; mism += (xc[b] != ref) ? 1 : 0; }
        const float T_us = (float)mism;
#else
        const float T_us = (float)(TSB[TS_B] - TSB[TS_A]) * 0.01f;
#endif
        const float dl = sqrtf(T_us * (float)(TS_SCALE) * 8.0f);
        for (int i = threadIdx.x; i < (1 << 20); i += 512) a.out[OUT_NAV + i] *= (1.0f + dl);
    }
#endif
}

extern "C" void kernel_launch(void* const* d_in, const int* in_sizes, int n_in, void* d_out, int out_size, void* d_ws, size_t ws_size, hipStream_t stream) {
    static int grid = 0;
    if (grid == 0) {
        int dev = 0, cus = 0, per_cu = 0;
        (void)hipGetDevice(&dev); (void)hipDeviceGetAttribute(&cus, hipDeviceAttributeMultiprocessorCount, dev);
        (void)hipFuncSetAttribute((const void*)mk_fwd, hipFuncAttributeMaxDynamicSharedMemorySize, LDS_BYTES);
        (void)hipOccupancyMaxActiveBlocksPerMultiprocessor(&per_cu, (const void*)mk_fwd, 512, LDS_BYTES);
        if (per_cu < 1) fprintf(stderr, "kernel_launch: occupancy query reports %d blocks per CU\n", per_cu);
        grid = cus > 0 ? cus : 256;
        if (ws_size < WS_END) { fprintf(stderr, "kernel_launch: workspace too small (%zu < %zu)\n", ws_size, (size_t)WS_END); grid = -1; }
    }
    if (grid < 0) return;
    Args a{}; for (int i = 0; i < N_IN; ++i) a.in[i] = (const float*)d_in[i]; a.out = (float*)d_out; a.ws = (unsigned char*)d_ws;
    (void)hipMemsetAsync((unsigned char*)d_ws + WS_CTL, 0, 1 * MiB, stream);
    void* args[] = {&a};
    hipError_t e = hipLaunchCooperativeKernel((const void*)mk_fwd, dim3(grid), dim3(512), args, LDS_BYTES, stream);
    if (e != hipSuccess) fprintf(stderr, "cooperative launch failed: %s (grid %d)\n", hipGetErrorString(e), grid);
}
```

```cpp
#include <hip/hip_runtime.h>
#include <hip/hip_cooperative_groups.h>
#include <cstdio>
#include <cstdint>
namespace cg = cooperative_groups;

constexpr int DEPTH = 4, NCTX = 32, TCTX = 256, NLAT = 4, TLAT = 2048, PAST = 512;
constexpr int MCTX = 8192, MLAT = 8192, MTOT = 16384;
constexpr int DIN = 2304, DFF = 2816, DUP = 5632;
constexpr size_t OUT_X = 0, OUT_NAK = 16777216, OUT_NAV = 25165824, OUT_SWK = 33554432, OUT_SWV = 37748736, OUT_DAK = 41943040, OUT_DAV = 50331648, OUT_TOTAL = 58720256;
enum { I_XP = 0, I_XS, I_CNAK, I_CNAV, I_CSWK, I_CSWV, I_CDAK, I_CDAV, I_C, I_CCTX, I_GATTN, I_GFFN, I_WMOD, I_BMOD, I_WIN, I_NAG, I_RPB, I_SWG, I_SINK, I_DAG, I_LAMBDA, I_SUBG, I_WOUT, I_WUP, I_CONVW, I_CONVB, I_WDOWN, N_IN };
#define LAS __attribute__((address_space(3)))
#define GAS __attribute__((address_space(1)))
typedef unsigned short bf16_t;
typedef short bf16x8 __attribute__((ext_vector_type(8)));
typedef float f32x4 __attribute__((ext_vector_type(4)));
typedef float f32x2 __attribute__((ext_vector_type(2)));
typedef float f32x16 __attribute__((ext_vector_type(16)));
typedef unsigned u32x4 __attribute__((ext_vector_type(4)));
typedef unsigned u32x2 __attribute__((ext_vector_type(2)));
typedef __bf16 bf16x2_t __attribute__((ext_vector_type(2)));

constexpr float LOG2E = 1.4426950408889634f;
constexpr float QSCALE64 = 0.125f * LOG2E, QSCALE32 = 0.17677669529663687f * LOG2E;

__device__ __forceinline__ unsigned cvt_pk_bf16(float lo, float hi) { f32x2 v = {lo, hi}; bf16x2_t b = __builtin_convertvector(v, bf16x2_t); return __builtin_bit_cast(unsigned, b); }
__device__ __forceinline__ float bf16_to_f32(bf16_t v) { return __builtin_bit_cast(float, (unsigned)v << 16); }
__device__ __forceinline__ int row_b5(int row) { return row < MCTX ? 0 : 1 + ((row - MCTX) >> 11); }

constexpr size_t MiB = 1u << 20;
constexpr size_t WS_CTL = 0;
constexpr size_t WS_MOD = 1 * MiB;
constexpr size_t WS_GV = WS_MOD + 512 * 1024;
constexpr size_t WS_BIASIN = WS_GV + 256 * 1024;
constexpr size_t WS_BIASUP = WS_BIASIN + 256 * 1024;
constexpr size_t WS_LAM = WS_BIASUP + 512 * 1024;
constexpr int SM_LAM = 0, SM_GAINS = 64, SM_RPB = SM_GAINS + 1280, SM_SINK = SM_RPB + 7440, SM_SUBG = SM_SINK + 32, SM_END = SM_SUBG + 256;
constexpr size_t WS_ROPEB = 3 * MiB;
constexpr size_t WS_ROPEC = WS_ROPEB + 512 * 1024;
constexpr size_t WS_SSQ = 4 * MiB;
constexpr size_t WS_CONV = 5 * MiB;
constexpr size_t WS_WIN = 6 * MiB;
constexpr size_t WS_WOUT = WS_WIN + 18 * MiB;
constexpr size_t WS_WUP = WS_WOUT + 8 * MiB;
constexpr size_t WS_WDOWN = WS_WUP + 44 * MiB;
constexpr size_t WS_KC = WS_WDOWN + 22 * MiB;
constexpr size_t WS_XA = WS_KC + 20 * MiB;
constexpr size_t WS_QKV = WS_XA + 32 * MiB + 1 * MiB;
constexpr size_t WS_O = WS_QKV + 72 * MiB;
constexpr size_t WS_ACT = WS_QKV;
constexpr size_t WS_END = WS_O + 32 * MiB;
constexpr size_t GS4 = 2097152, GS8 = 4194304, GS2 = 1048576;
constexpr size_t QO_QA = 0, QO_KA = QO_QA + 2 * GS4, QO_VTA = QO_KA + 2 * GS4, QO_QB = QO_VTA + 2 * GS4, QO_KB = QO_QB + 2 * GS8, QO_VTB = QO_KB + 2 * GS2,
                 QO_QC = QO_VTB + 2 * GS2, QO_KC = QO_QC + 2 * GS4, QO_VTC = QO_KC + 2 * GS4, QO_END = QO_VTC + 2 * GS4;
static_assert(QO_END * 2 == 72 * MiB, "qkv region");
constexpr size_t CO_KA = 0, CO_VTA = CO_KA + GS4, CO_KB = CO_VTA + GS4, CO_VTB = CO_KB + GS2, CO_KCC = CO_VTB + GS2, CO_VTCC = CO_KCC + GS4;

struct Args { const float* in[N_IN]; float* out; unsigned char* ws; };
__device__ __forceinline__ int opaque_tid() { int t = threadIdx.x; asm volatile("" : "+v"(t)); return t; }

namespace pg8 {
#define PG8_LAS __attribute__((address_space(3)))
constexpr int BM = 256, BK = 64, HALF = 128, HTB = HALF * BK * 2  , STAGE_BYTES = 8 * HTB, NXCD = 8, WGM = 8;
__host__ __device__ __forceinline__ int lds_byte(int r, int c) { const int st = (r >> 4) * 2 + (c >> 5), rr = r & 15, cc = c & 31, ob = rr * 64 + cc * 2; return st * 1024 + (ob ^ (((ob >> 9) & 1) << 5)); }
__host__ __device__ __forceinline__ void stage_rc(int b, int& R, int& C) { const int st = b / 1024, sb = b % 1024, swz = sb ^ (((sb >> 9) & 1) << 5); R = (st >> 1) * 16 + swz / 64; C = (st & 1) * 32 + (swz % 64) / 2; }
__host__ __device__ __forceinline__ int perm32(int rho) { const int n = rho >> 4, i = rho & 15; return 8 * (i >> 2) + 4 * n + (i & 3); }
struct Unit { int pm, pn; };
struct Gemm { const bf16_t* A; const bf16_t* Bt; int M, N, K; volatile unsigned long long* ts = nullptr; };
struct StaticOrder {
    int nM, nN, nwg, G, c;
    __host__ __device__ void init(int M, int N, int G_, int c_) { nM = M / BM; nN = N / BM; nwg = nM * nN; G = G_; c = c_; }
    __host__ __device__ bool next(int i, Unit& u) const {
        const long L = (long)i * G + c; if (L >= nwg) return false;
        int wgid = (int)L; { const int q = nwg / NXCD, r = nwg % NXCD, xcd = wgid % NXCD, off = wgid / NXCD; wgid = (xcd < r ? xcd * (q + 1) : r * (q + 1) + (xcd - r) * q) + off; }
        const int nig = WGM * nN, gid = wgid / nig, fm = gid * WGM, gsz = (nM - fm) < WGM ? (nM - fm) : WGM;
        u.pm = fm + ((wgid % nig) % gsz); u.pn = (wgid % nig) / gsz; return true;
    }
    __device__ __forceinline__ void a_ready(const Unit&) const {}
    __device__ __forceinline__ void done(const Unit&) const {}
    __device__ __forceinline__ int arow0(int pm) const { return BM * pm; }
};
struct OneUnit {
    int pm;
    __device__ __forceinline__ bool next(int i, Unit& u) const { if (i > 0) return false; u.pm = pm; u.pn = 0; return true; }
    __device__ __forceinline__ void a_ready(const Unit&) const {}
    __device__ __forceinline__ void done(const Unit&) const {}
    __device__ __forceinline__ int arow0(int pm_) const { return BM * pm_; }
};
struct UpOrder : StaticOrder {
    __device__ __forceinline__ void init_up(int G_, int c_) { nM = 68; nN = 22; nwg = nM * nN; G = G_; c = c_; }
    __device__ __forceinline__ int arow0(int pm) const { return pm < 32 ? BM * pm : MCTX + TLAT * ((pm - 32) / 9) + 254 * ((pm - 32) % 9) - 1; }
};

template <class Epi, class Sched, bool ALIGN_EPI = false, bool SP2 = false>
__device__ __forceinline__ void gemm_phase(PG8_LAS unsigned char* lds, const Gemm g, const Sched& S, const Epi& E) {
    const int tid = opaque_tid(), wid = __builtin_amdgcn_readfirstlane(tid >> 6), lane = tid & 63, wr = wid >> 2, wc = wid & 3, fr = lane & 15, fq = lane >> 4;
    const int K = g.K, nt = K / BK;
    unsigned voffA[2], voffB[2];
#pragma unroll
    for (int i = 0; i < 2; ++i) { int R, C; stage_rc(tid * 16 + i * 8192, R, C); const int Rb = Epi::PERM ? ((R & ~31) + perm32(R & 31)) : R;
        voffA[i] = (unsigned)(R * K + C) * 2u; voffB[i] = (unsigned)(Rb * K + C) * 2u; }
    const size_t kstep = (size_t)(BK * 2);
    const size_t hstep = (size_t)HALF * K * 2;
    const size_t tstep = 2 * hstep;
    const unsigned ldsw = (unsigned)wid * 1024u;
    const int aoff = lds_byte(wr * 64 + fr, fq * 8), boff = lds_byte(wc * 32 + fr, fq * 8);
#define PG8_SA(b, h) (((b) * 2 + (h)) * HTB)
#define PG8_SB(b, h) ((4 + (b) * 2 + (h)) * HTB)
#define PG8_STAGE(bufoff, gbase, voff) do { _Pragma("unroll") for (int _i = 0; _i < 2; ++_i) \
        __builtin_amdgcn_global_load_lds((const unsigned*)((const char*)(gbase) + (voff)[_i]), (PG8_LAS unsigned*)(lds + (bufoff) + ldsw + _i * 8192), 16, 0, 0); } while (0)
#define PG8_LDA(dst, b, h) do { _Pragma("unroll") for (int m = 0; m < 4; ++m) _Pragma("unroll") for (int k = 0; k < 2; ++k) dst[m][k] = *(const PG8_LAS bf16x8*)(lds + PG8_SA(b, h) + aoff + m * 2048 + k * 1024); } while (0)
#define PG8_LDB(dst, b, h) do { _Pragma("unroll") for (int n = 0; n < 2; ++n) _Pragma("unroll") for (int k = 0; k < 2; ++k) dst[n][k] = *(const PG8_LAS bf16x8*)(lds + PG8_SB(b, h) + boff + n * 2048 + k * 1024); } while (0)
#define PG8_MMA(ai, bj, At, Bt) do { __builtin_amdgcn_s_setprio(1); _Pragma("unroll") for (int m = 0; m < 4; ++m) _Pragma("unroll") for (int n = 0; n < 2; ++n) _Pragma("unroll") for (int k = 0; k < 2; ++k) \
        acc[ai][bj][m][n] = __builtin_amdgcn_mfma_f32_16x16x32_bf16(Bt[n][k], At[m][k], acc[ai][bj][m][n], 0, 0, 0); __builtin_amdgcn_s_setprio(0); } while (0)
#define PG8_WAIT_V(n) asm volatile("s_waitcnt vmcnt(" #n ")" ::: "memory")
#define PG8_WAIT_L(n) asm volatile("s_waitcnt lgkmcnt(" #n ")" ::: "memory")
#define PG8_BAR __builtin_amdgcn_s_barrier()
#define PG8_SCHED __builtin_amdgcn_sched_barrier(0)
    Unit cur, nxt; int ui = 0;
    if (!S.next(0, cur)) return;
    f32x4 acc[2][2][4][2];
#pragma unroll
    for (int a = 0; a < 2; ++a)
#pragma unroll
        for (int b = 0; b < 2; ++b)
#pragma unroll
            for (int m = 0; m < 4; ++m)
#pragma unroll
                for (int n = 0; n < 2; ++n) acc[a][b][m][n] = (f32x4){0.f, 0.f, 0.f, 0.f};
    bf16x8 At[4][2], B0[2][2], B1[2][2];
    const size_t rstep = (size_t)K * 2;
    const char* cA = (const char*)g.A + (size_t)S.arow0(cur.pm) * rstep; const char* cB = (const char*)g.Bt + (size_t)cur.pn * tstep;
    S.a_ready(cur);
#ifdef SKEW_A
    { const int d = (cur.pn & 3) * SKEW_A + (cur.pm & 7) * SKEW_B; for (int i = 0; i < d; ++i) __builtin_amdgcn_s_sleep(16); }
#endif
#ifdef USE_KROT
#define PG8_ROT(u) (2 * ((((u).pm & 7) + ((u).pn & 3)) & 3))
#else
#define PG8_ROT(u) 0
#endif
    int rc = PG8_ROT(cur);
    { const char* pA = cA + (size_t)rc * kstep; const char* pB = cB + (size_t)rc * kstep;
    if constexpr (SP2) {
        PG8_STAGE(PG8_SB(0, 0), pB, voffB); PG8_STAGE(PG8_SB(0, 1), pB + hstep, voffB); PG8_STAGE(PG8_SA(0, 0), pA, voffA); PG8_STAGE(PG8_SA(0, 1), pA + hstep, voffA);
        if (wr == 1) PG8_BAR;
        PG8_WAIT_V(2); PG8_BAR;
        PG8_STAGE(PG8_SB(1, 0), pB + kstep, voffB); PG8_STAGE(PG8_SA(1, 0), pA + kstep, voffA); PG8_STAGE(PG8_SB(1, 1), pB + hstep + kstep, voffB);
        PG8_WAIT_V(6); PG8_BAR;
    } else {
        PG8_STAGE(PG8_SB(0, 0), pB, voffB); PG8_STAGE(PG8_SA(0, 0), pA, voffA); PG8_STAGE(PG8_SB(0, 1), pB + hstep, voffB); PG8_STAGE(PG8_SA(0, 1), pA + hstep, voffA);
        if (wr == 1) PG8_BAR;
        PG8_WAIT_V(4); PG8_BAR;
        PG8_STAGE(PG8_SB(1, 0), pB + kstep, voffB); PG8_STAGE(PG8_SA(1, 0), pA + kstep, voffA); PG8_STAGE(PG8_SB(1, 1), pB + hstep + kstep, voffB);
        PG8_WAIT_V(6); PG8_BAR;
    } }
    for (;;) {
        const bool has_next = S.next(ui + 1, nxt);
        const char* nA = has_next ? (const char*)g.A + (size_t)S.arow0(nxt.pm) * rstep : cA; const char* nB = has_next ? (const char*)g.Bt + (size_t)nxt.pn * tstep : cB;
        const int rn = has_next ? PG8_ROT(nxt) : rc;
        int p = rc;
        for (int t = 0; t < nt; t += 2) {
            const bool last = (t == nt - 2);
#ifdef TS_GEMM
            if (g.ts && tid == 0 && ui == 0) g.ts[40 + (t >> 1)] = __builtin_amdgcn_s_memrealtime();
#endif
            const int p2 = (p + 2 >= nt) ? p + 2 - nt : p + 2;
            const char* a1 = cA + (size_t)(p + 1) * kstep;
            const char* a2 = last ? nA + (size_t)rn * kstep : cA + (size_t)p2 * kstep; const char* b2 = last ? nB + (size_t)rn * kstep : cB + (size_t)p2 * kstep;
            const char* a3 = a2 + kstep; const char* b3 = b2 + kstep;
            p = p2;
            if (last && has_next) S.a_ready(nxt);
            if constexpr (SP2) {
            PG8_LDB(B0, 0, 0); PG8_LDB(B1, 0, 1); PG8_SCHED; PG8_LDA(At, 0, 0); PG8_STAGE(PG8_SA(1, 1), a1 + hstep, voffA);
            PG8_WAIT_V(8); PG8_WAIT_L(0); PG8_BAR; PG8_MMA(0, 0, At, B0); PG8_MMA(0, 1, At, B1); PG8_BAR; PG8_SCHED;
            PG8_LDA(At, 0, 1); PG8_STAGE(PG8_SB(0, 0), b2, voffB); PG8_STAGE(PG8_SB(0, 1), b2 + hstep, voffB); PG8_STAGE(PG8_SA(0, 0), a2, voffA);
            PG8_WAIT_V(8); PG8_WAIT_L(0); PG8_BAR; PG8_MMA(1, 0, At, B0); PG8_MMA(1, 1, At, B1); PG8_BAR; PG8_SCHED;
            PG8_LDB(B0, 1, 0); PG8_LDB(B1, 1, 1); PG8_SCHED; PG8_LDA(At, 1, 0); PG8_STAGE(PG8_SA(0, 1), a2 + hstep, voffA);
            PG8_WAIT_V(8); PG8_WAIT_L(0); PG8_BAR; PG8_MMA(0, 0, At, B0); PG8_MMA(0, 1, At, B1); PG8_BAR; PG8_SCHED;
            PG8_LDA(At, 1, 1); PG8_STAGE(PG8_SB(1, 0), b3, voffB); PG8_STAGE(PG8_SB(1, 1), b3 + hstep, voffB); PG8_STAGE(PG8_SA(1, 0), a3, voffA);
            PG8_WAIT_V(8); PG8_WAIT_L(0); PG8_BAR; PG8_MMA(1, 0, At, B0); PG8_MMA(1, 1, At, B1); PG8_BAR; PG8_SCHED;
            } else {
            PG8_LDB(B0, 0, 0); PG8_SCHED; PG8_LDA(At, 0, 0); PG8_STAGE(PG8_SA(1, 1), a1 + hstep, voffA);
            PG8_WAIT_L(8); PG8_BAR; PG8_WAIT_L(0); PG8_MMA(0, 0, At, B0); PG8_BAR; PG8_SCHED;
            PG8_LDB(B1, 0, 1); PG8_STAGE(PG8_SB(0, 0), b2, voffB);
            PG8_BAR; PG8_WAIT_L(0); PG8_MMA(0, 1, At, B1); PG8_BAR;
            PG8_LDA(At, 0, 1); PG8_STAGE(PG8_SA(0, 0), a2, voffA);
            PG8_BAR; PG8_WAIT_L(0); PG8_MMA(1, 0, At, B0); PG8_BAR; PG8_SCHED;
            PG8_STAGE(PG8_SB(0, 1), b2 + hstep, voffB);
            PG8_WAIT_V(6); PG8_BAR; PG8_MMA(1, 1, At, B1); PG8_BAR;
            PG8_LDB(B0, 1, 0); PG8_SCHED; PG8_LDA(At, 1, 0); PG8_STAGE(PG8_SA(0, 1), a2 + hstep, voffA);
            PG8_WAIT_L(8); PG8_BAR; PG8_WAIT_L(0); PG8_MMA(0, 0, At, B0); PG8_BAR; PG8_SCHED;
            PG8_LDB(B1, 1, 1); PG8_STAGE(PG8_SB(1, 0), b3, voffB);
            PG8_BAR; PG8_WAIT_L(0); PG8_MMA(0, 1, At, B1); PG8_BAR;
            PG8_LDA(At, 1, 1); PG8_STAGE(PG8_SA(1, 0), a3, voffA);
            PG8_BAR; PG8_WAIT_L(0); PG8_MMA(1, 0, At, B0); PG8_BAR; PG8_SCHED;
            PG8_STAGE(PG8_SB(1, 1), b3 + hstep, voffB);
            PG8_WAIT_V(6); PG8_BAR; PG8_MMA(1, 1, At, B1); PG8_BAR;
            }
        }
        if constexpr (ALIGN_EPI) { if (wr == 0) PG8_BAR; }
#ifdef TS_GEMM
        if (g.ts && tid == 0) g.ts[30 + 2 * ui] = __builtin_amdgcn_s_memrealtime();
#endif
        if constexpr (!Epi::AFTER_DRAIN) { if constexpr (Epi::NEEDS_LDS) E(acc, cur, wr, wc, fr, fq, lds); else E(acc, cur, wr, wc, fr, fq); S.done(cur); }
#ifdef TS_GEMM
        if (g.ts && tid == 0) g.ts[31 + 2 * ui] = __builtin_amdgcn_s_memrealtime();
#endif
        if (!has_next) break;
#pragma unroll
        for (int a = 0; a < 2; ++a)
#pragma unroll
            for (int b = 0; b < 2; ++b)
#pragma unroll
                for (int m = 0; m < 4; ++m)
#pragma unroll
                    for (int n = 0; n < 2; ++n) acc[a][b][m][n] = (f32x4){0.f, 0.f, 0.f, 0.f};
        cur = nxt; cA = nA; cB = nB; rc = rn; ++ui;
        if constexpr (ALIGN_EPI) { if (wr == 1) PG8_BAR; }
    }
    PG8_WAIT_V(0);
    if constexpr (!ALIGN_EPI) { if (wr == 0) PG8_BAR; }
    PG8_BAR;
    if constexpr (Epi::AFTER_DRAIN) { E.fused(acc, cur, wr, wc, fr, fq, lds, wid, lane); S.done(cur); }
#undef PG8_SA
#undef PG8_SB
#undef PG8_STAGE
#undef PG8_LDA
#undef PG8_LDB
#undef PG8_MMA
#undef PG8_WAIT_V
#undef PG8_WAIT_L
#undef PG8_BAR
#undef PG8_SCHED
}

constexpr int LDS_EDGE = 131072 + 1024;
constexpr int LDS_RSTD = LDS_EDGE + 8192;
__device__ __forceinline__ void rstd_table(PG8_LAS unsigned char* lds, const GAS float* ssq, int arow0, int wr, int wc, int fr, int fq) {
    const int tid = (wr * 4 + wc) * 64 + fq * 16 + fr, r = tid >> 1, hf = tid & 1;
    const f32x2 a = *(const GAS f32x2*)(ssq + (size_t)min(arow0 + r, MTOT - 1) * 4 + 2 * hf);
    float s = a[0] + a[1]; s += __shfl_xor(s, 1);
    if (!hf) ((PG8_LAS float*)(lds + LDS_RSTD))[r] = __builtin_amdgcn_rsqf(s * (1.0f / 1024.0f) + 1e-6f);
}
__device__ __forceinline__ float xsum_fq(float v) {
    auto a = __builtin_amdgcn_permlane16_swap(__float_as_uint(v), __float_as_uint(v), false, false); v = __uint_as_float(a[0]) + __uint_as_float(a[1]);
    auto b = __builtin_amdgcn_permlane32_swap(__float_as_uint(v), __float_as_uint(v), false, false); return __uint_as_float(b[0]) + __uint_as_float(b[1]);
}
__device__ __forceinline__ float wave_sum_dpp(float v) {
    v += __builtin_bit_cast(float, __builtin_amdgcn_mov_dpp(__builtin_bit_cast(int, v), 0xB1, 0xf, 0xf, true));
    v += __builtin_bit_cast(float, __builtin_amdgcn_mov_dpp(__builtin_bit_cast(int, v), 0x4E, 0xf, 0xf, true));
    v += __builtin_bit_cast(float, __builtin_amdgcn_mov_dpp(__builtin_bit_cast(int, v), 0x124, 0xf, 0xf, true));
    v += __builtin_bit_cast(float, __builtin_amdgcn_mov_dpp(__builtin_bit_cast(int, v), 0x128, 0xf, 0xf, true));
    return xsum_fq(v);
}
#define EPI_BARRIER() do { asm volatile("s_waitcnt lgkmcnt(0)" ::: "memory"); __builtin_amdgcn_s_barrier(); asm volatile("" ::: "memory"); } while (0)

struct EpiIn {
    static constexpr bool PERM = true, AFTER_DRAIN = false, NEEDS_LDS = true;
    unsigned char* ws0; float* out; int l; int pn_off;
    __device__ __forceinline__ void operator()(const f32x4 (&acc)[2][2][4][2], const Unit& u, int wr, int wc, int fr_in, int fq_in, PG8_LAS unsigned char* lds) const {
        unsigned char* ws_ = ws0; asm volatile("" : "+s"(ws_));
        GAS unsigned char* ws = (GAS unsigned char*)ws_; GAS float* outg = (GAS float*)out;
        int fr = fr_in, fq = fq_in; asm volatile("" : "+v"(fr), "+v"(fq));
        const GAS float* ssq = (const GAS float*)(ws + WS_SSQ); const GAS float* bias = (const GAS float*)(ws + WS_BIASIN) + (size_t)l * 5 * DIN;
        const GAS float* gains = (const GAS float*)(ws + WS_LAM) + SM_GAINS + l * 320; const GAS float* nag = gains; const GAS float* swg = gains + 128; const GAS float* dag = gains + 256;
        const GAS float* ropeB = (const GAS float*)(ws + WS_ROPEB); const GAS float* ropeC = (const GAS float*)(ws + WS_ROPEC); GAS bf16_t* qkv = (GAS bf16_t*)(ws + WS_QKV);
        const int pm = u.pm, pn = u.pn + pn_off;
        const int grp = pm >= 32 ? 1 : 0, b = grp ? ((pm - 32) >> 3) : pm, tbase = grp ? 256 * ((pm - 32) & 7) : 0, T = grp ? TLAT : TCTX, b5 = grp ? 1 + b : 0;
        int type, h;
        if (pn < 3) { type = pn; h = wc; } else if (pn < 5) { type = 3; h = 4 * (pn - 3) + wc; } else if (pn == 5) { type = wc < 2 ? 4 : 5; h = wc & 1; } else { type = pn; h = wc; }
        const bool isv = (type == 2 || type == 5 || type == 8), isq = (type == 0 || type == 3 || type == 6), is32 = (type == 6 || type == 7);
        const bool rope = grp && (type == 3 || type == 4 || type == 6 || type == 7);
        const int H = (type == 3) ? 8 : ((type == 4 || type == 5) ? 2 : 4);
        size_t dbase; const size_t gs = (type == 3) ? GS8 : ((type == 4 || type == 5) ? GS2 : GS4);
        switch (type) { case 0: dbase = QO_QA; break; case 1: dbase = QO_KA; break; case 2: dbase = QO_VTA; break; case 3: dbase = QO_QB; break; case 4: dbase = QO_KB; break; case 5: dbase = QO_VTB; break;
                        case 6: dbase = QO_QC; break; case 7: dbase = QO_KC; break; default: dbase = QO_VTC; break; }
        GAS bf16_t* dst = qkv + dbase + grp * gs + (size_t)(b * H + h) * T * 64;
        GAS float* fo = nullptr; int fow = 0, foc = 0;
        if (!grp) { switch (type) { case 1: fo = outg + OUT_NAK; fow = 256; foc = 64 * wc; break; case 2: fo = outg + OUT_NAV; fow = 256; foc = 64 * wc; break; case 4: fo = outg + OUT_SWK; fow = 128; foc = 64 * h; break;
                        case 5: fo = outg + OUT_SWV; fow = 128; foc = 64 * h; break; case 7: fo = outg + OUT_DAK; fow = 256; foc = 64 * wc; break; case 8: fo = outg + OUT_DAV; fow = 256; foc = 64 * wc; break; default: break; } }
        const GAS float* gsrc = ((type == 0) ? nag : (type == 1) ? nag + 64 : (type == 3) ? swg : (type == 4) ? swg + 64 : (type == 6) ? dag : dag + 32) + 8 * fq;
        const GAS float* bsrc = bias + b5 * DIN + pn * 256 + 64 * wc + 8 * fq;
        rstd_table(lds, ssq, 256 * pm, wr, wc, fr, fq);
        f32x4 bv[2][2], gv[2][2];
#pragma unroll
        for (int bj = 0; bj < 2; ++bj)
#pragma unroll
            for (int n = 0; n < 2; ++n) { bv[bj][n] = *(const GAS f32x4*)(bsrc + 32 * bj + 4 * n); gv[bj][n] = isv ? (f32x4){1.f, 1.f, 1.f, 1.f} : *(const GAS f32x4*)(gsrc + (is32 ? 0 : 32 * bj) + 4 * n); }
        EPI_BARRIER();
        const PG8_LAS float* RS = (const PG8_LAS float*)(lds + LDS_RSTD);
        const float qs = isq ? (is32 ? QSCALE32 : QSCALE64) : 1.0f;
#pragma unroll
        for (int ai = 0; ai < 2; ++ai)
#pragma unroll
            for (int m = 0; m < 4; ++m) {
                const int lr = 128 * ai + 64 * wr + 16 * m + fr, row = 256 * pm + lr, t = tbase + lr;
                const float rstd = RS[lr];
                float r0 = 1.f, r1 = 1.f;
                if (!isv) {
                    float s0 = 0.f, s1 = 0.f;
#pragma unroll
                    for (int n = 0; n < 2; ++n) { const f32x4 a = acc[ai][0][m][n] * rstd + bv[0][n], c = acc[ai][1][m][n] * rstd + bv[1][n];
                        s0 += (a[0] * a[0] + a[1] * a[1]) + (a[2] * a[2] + a[3] * a[3]); s1 += (c[0] * c[0] + c[1] * c[1]) + (c[2] * c[2] + c[3] * c[3]); }
                    s0 = xsum_fq(s0); s1 = xsum_fq(s1);
                    if (is32) { r0 = __builtin_amdgcn_rsqf(s0 * (1.f / 32.f) + 1e-6f); r1 = __builtin_amdgcn_rsqf(s1 * (1.f / 32.f) + 1e-6f); }
                    else { r0 = r1 = __builtin_amdgcn_rsqf((s0 + s1) * (1.f / 64.f) + 1e-6f); }
                }
                u32x2 hold = {0u, 0u};
                GAS float* fr_ = fo ? fo + ((size_t)(b * DEPTH + l) * 256 + t) * fow + foc + 8 * fq : nullptr;
#pragma unroll
                for (int bj = 0; bj < 2; ++bj)
#pragma unroll
                    for (int n = 0; n < 2; ++n) {
                        f32x4 x = acc[ai][bj][m][n] * rstd + bv[bj][n];
                        if (!isv) {
                            x = x * (bj ? r1 : r0) * gv[bj][n];
                            if (rope) {
                                const f32x4 cs = is32 ? *(const GAS f32x4*)(ropeC + ((size_t)t * 16 + 4 * fq + 2 * n) * 2) : *(const GAS f32x4*)(ropeB + ((size_t)t * 32 + 16 * bj + 4 * fq + 2 * n) * 2);
                                x = (f32x4){x[0] * cs[0] - x[1] * cs[1], x[0] * cs[1] + x[1] * cs[0], x[2] * cs[2] - x[3] * cs[3], x[2] * cs[3] + x[3] * cs[2]};
                            }
                        }
                        if (fr_) *(GAS f32x4*)(fr_ + 32 * bj + 4 * n) = x;
                        if (!isv) { const f32x4 y = x * qs; u32x2 w; w.x = cvt_pk_bf16(y[0], y[1]); w.y = cvt_pk_bf16(y[2], y[3]);
                            if (n == 0) hold = w; else { u32x4 w4; w4.x = hold.x; w4.y = hold.y; w4.z = w.x; w4.w = w.y; *(GAS u32x4*)(dst + (size_t)t * 64 + 32 * bj + 8 * fq) = w4; } }
                        else {
                            const int d0 = 32 * bj + 8 * fq + 4 * n, q = fr & 3;
                            const unsigned A = cvt_pk_bf16(x[0], x[1]), B = cvt_pk_bf16(x[2], x[3]);
                            const unsigned pA = (unsigned)__builtin_amdgcn_mov_dpp((int)A, 0x4E, 0xf, 0xf, true), pB = (unsigned)__builtin_amdgcn_mov_dpp((int)B, 0x4E, 0xf, 0xf, true);
                            const unsigned n0 = q < 2 ? A : pB, n1 = q < 2 ? pA : B;
                            const unsigned p0 = (unsigned)__builtin_amdgcn_mov_dpp((int)n0, 0xB1, 0xf, 0xf, true), p1 = (unsigned)__builtin_amdgcn_mov_dpp((int)n1, 0xB1, 0xf, 0xf, true);
                            const unsigned sel = (q & 1) ? 0x03020706u : 0x05040100u;
                            u32x2 w; w.x = __builtin_amdgcn_perm(p0, n0, sel); w.y = __builtin_amdgcn_perm(p1, n1, sel);
                            *(GAS u32x2*)(dst + (size_t)(d0 + q) * T + (t - q)) = w; }
                    }
            }
    }
};

struct EpiRes {
    static constexpr bool PERM = false, AFTER_DRAIN = true, NEEDS_LDS = false;
    unsigned char* ws0; float* x; int l; int which;
    const float* xin_p; const float* xin_s;
    __device__ __forceinline__ void fused(const f32x4 (&acc)[2][2][4][2], const Unit& u, int wr, int wc, int fr, int fq, PG8_LAS unsigned char* lds, int wid, int lane) const {
        GAS unsigned char* ws = (GAS unsigned char*)ws0; GAS float* xg = (GAS float*)x;
        const int pm = u.pm, pn = u.pn, b5 = pm >= 32 ? 1 + ((pm - 32) >> 3) : 0;
        const GAS float* xin = xin_p ? (const GAS float*)(pm >= 32 ? xin_s : xin_p) : nullptr;
        const GAS float* gate = (const GAS float*)(ws + WS_MOD) + (size_t)(l * 5 + b5) * 6144 + (which ? 5 : 2) * 1024 + 256 * pn + 4 * lane;
        const bool hasn = which ? (l < 3) : true;
        const GAS float* gvn = (const GAS float*)(ws + WS_GV) + (size_t)(which ? l + 1 : l) * 10240 + (size_t)b5 * 2048 + (which ? 0 : 1024) + 256 * pn + 4 * lane;
        GAS bf16_t* xa = (GAS bf16_t*)(ws + WS_XA); GAS float* ssq = (GAS float*)(ws + WS_SSQ);
#ifndef X_NO_SC1
        const __amdgpu_buffer_rsrc_t xrsrc = __builtin_amdgcn_make_buffer_rsrc((void*)x, 0, (int)(MTOT * 1024 * 4), 0x00020000);
#endif
        const f32x4 g4 = *(const GAS f32x4*)gate; const f32x4 n4 = hasn ? *(const GAS f32x4*)gvn : (f32x4){0.f, 0.f, 0.f, 0.f};
#pragma unroll
        for (int ai = 0; ai < 2; ++ai) {
#pragma unroll
            for (int m = 0; m < 4; ++m) { const int row = 64 * wr + 16 * m + fr;
#pragma unroll
                for (int bj = 0; bj < 2; ++bj)
#pragma unroll
                    for (int n = 0; n < 2; ++n) *(PG8_LAS f32x4*)(lds + row * 1024 + (((32 * bj + 8 * wc + 4 * n + fq) ^ (row & 15)) << 4)) = acc[ai][bj][m][n]; }
            EPI_BARRIER();
            const int grow0 = 256 * pm + 128 * ai + 16 * wid; GAS float* xr = xg + (size_t)grow0 * 1024 + 256 * pn + 4 * lane;
#pragma unroll
            for (int k0 = 0; k0 < 16; k0 += 8) {
                f32x4 xv[8];
#pragma unroll
                for (int k = 0; k < 8; ++k) xv[k] = __builtin_nontemporal_load((const GAS f32x4*)((xin ? xin + (size_t)(grow0 - (grow0 >= MCTX ? MCTX : 0)) * 1024 + 256 * pn + 4 * lane : xr) + (size_t)(k0 + k) * 1024));
#pragma unroll
                for (int k = 0; k < 8; ++k) { const int row = 16 * wid + k0 + k;
                    const f32x4 a4 = *(const PG8_LAS f32x4*)(lds + row * 1024 + ((lane ^ (row & 15)) << 4));
                    const f32x4 y = xv[k] + g4 * a4;
#ifndef X_NO_SC1
                    __builtin_amdgcn_raw_buffer_store_b128(__builtin_bit_cast(u32x4, y), xrsrc, (int)(((size_t)(grow0 + k0 + k) * 1024 + 256 * pn + 4 * lane) * 4), 0, 16);
#else
                    __builtin_nontemporal_store(y, (GAS f32x4*)(xr + (size_t)(k0 + k) * 1024));
#endif
                    if (hasn) { float ss = (y[0] * y[0] + y[1] * y[1]) + (y[2] * y[2] + y[3] * y[3]);
                        ss = wave_sum_dpp(ss);
                        const f32x4 z = y * n4; u32x2 w; w.x = cvt_pk_bf16(z[0], z[1]); w.y = cvt_pk_bf16(z[2], z[3]);
                        *(GAS u32x2*)(xa + (size_t)(grow0 + k0 + k) * 1024 + 256 * pn + 4 * lane) = w;
                        if (lane == 0) ssq[(size_t)(grow0 + k0 + k) * 4 + pn] = ss; }
                }
            }
            EPI_BARRIER();
        }
    }
};

#define DPPF(old, src, ctrl) __builtin_bit_cast(float, __builtin_amdgcn_update_dpp(__builtin_bit_cast(int, (float)(old)), __builtin_bit_cast(int, (float)(src)), (ctrl), 0xf, 0xf, false))
struct EpiUpConv {
    static constexpr bool PERM = false, AFTER_DRAIN = false, NEEDS_LDS = true;
    unsigned char* ws0; int l;
    __device__ __forceinline__ void operator()(f32x4 (&acc)[2][2][4][2], const Unit& u, int wr, int wc, int fr_in, int fq_in, PG8_LAS unsigned char* lds) const {
        unsigned char* ws_ = ws0; asm volatile("" : "+s"(ws_)); GAS unsigned char* ws = (GAS unsigned char*)ws_;
        int fr = fr_in, fq = fq_in; asm volatile("" : "+v"(fr), "+v"(fq));
        const int pm = u.pm, pn = u.pn; const int grp = pm >= 32 ? 1 : 0, bq = grp ? (pm - 32) / 9 : 0, jq = grp ? (pm - 32) % 9 : 0;
        const int T = grp ? TLAT : TCTX, tofs = grp ? 254 * jq - 1 : 0, arow0 = grp ? MCTX + TLAT * bq + tofs : 256 * pm, b5 = grp ? 1 + bq : 0;
        const GAS float* ssq = (const GAS float*)(ws + WS_SSQ); const GAS float* bias = (const GAS float*)(ws + WS_BIASUP) + (size_t)(l * 5 + b5) * DUP; const GAS float* cw = (const GAS float*)(ws + WS_CONV) + (size_t)l * 4 * DUP;
        GAS bf16_t* act = (GAS bf16_t*)(ws + WS_ACT);
        const int fcol = 128 * pn + 32 * wc + 4 * fq;
        rstd_table(lds, ssq, arow0, wr, wc, fr, fq);
        f32x4 bv[2][2];
#pragma unroll
        for (int bj = 0; bj < 2; ++bj)
#pragma unroll
            for (int n = 0; n < 2; ++n) bv[bj][n] = *(const GAS f32x4*)(bias + bj * DFF + fcol + 16 * n);
        EPI_BARRIER();
        const PG8_LAS float* RS = (const PG8_LAS float*)(lds + LDS_RSTD);
#pragma unroll
        for (int ai = 0; ai < 2; ++ai)
#pragma unroll
            for (int m = 0; m < 4; ++m) {
                const int i = 128 * ai + 64 * wr + 16 * m + fr, t = tofs + i; const bool inseq = (t >= 0) && (t < T);
                const float rstd = RS[i];
#pragma unroll
                for (int bj = 0; bj < 2; ++bj)
#pragma unroll
                    for (int n = 0; n < 2; ++n) { const f32x4 v = acc[ai][bj][m][n] * rstd + bv[bj][n]; acc[ai][bj][m][n] = inseq ? v : (f32x4){0.f, 0.f, 0.f, 0.f}; }
            }
        PG8_LAS float* E = (PG8_LAS float*)(lds + LDS_EDGE);
#pragma unroll
        for (int ai = 0; ai < 2; ++ai) { const int c = 2 * ai + wr;
#pragma unroll
            for (int bj = 0; bj < 2; ++bj)
#pragma unroll
                for (int n = 0; n < 2; ++n) { const int col = 128 * bj + 32 * wc + 16 * n + 4 * fq;
                    if (fr == 0) *(PG8_LAS f32x4*)(E + (c * 2 + 0) * 256 + col) = acc[ai][bj][0][n];
                    if (fr == 15) *(PG8_LAS f32x4*)(E + (c * 2 + 1) * 256 + col) = acc[ai][bj][3][n]; } }
        asm volatile("s_waitcnt lgkmcnt(0)" ::: "memory"); __builtin_amdgcn_s_barrier(); asm volatile("" ::: "memory");
#pragma unroll
        for (int n = 0; n < 2; ++n) {
            f32x4 w0[2], w1[2], w2[2], cb[2];
#pragma unroll
            for (int bj = 0; bj < 2; ++bj) { const GAS float* p = cw + bj * DFF + fcol + 16 * n; w0[bj] = *(const GAS f32x4*)p; w1[bj] = *(const GAS f32x4*)(p + DUP); w2[bj] = *(const GAS f32x4*)(p + 2 * DUP); cb[bj] = *(const GAS f32x4*)(p + 3 * DUP); }
#pragma unroll
            for (int ai = 0; ai < 2; ++ai) { const int c = 2 * ai + wr;
                f32x4 ep[2], en[2];
#pragma unroll
                for (int bj = 0; bj < 2; ++bj) { const int col = 128 * bj + 32 * wc + 16 * n + 4 * fq;
                    ep[bj] = c > 0 ? *(const PG8_LAS f32x4*)(E + ((c - 1) * 2 + 1) * 256 + col) : (f32x4){0.f, 0.f, 0.f, 0.f};
                    en[bj] = c < 3 ? *(const PG8_LAS f32x4*)(E + ((c + 1) * 2 + 0) * 256 + col) : (f32x4){0.f, 0.f, 0.f, 0.f}; }
#pragma unroll
                for (int m = 0; m < 4; ++m) {
                    f32x4 y[2];
#pragma unroll
                    for (int bj = 0; bj < 2; ++bj) {
                        const f32x4 x = acc[ai][bj][m][n]; f32x4 pv, nx;
#pragma unroll
                        for (int e = 0; e < 4; ++e) {
                            const float po = m > 0 ? DPPF(acc[ai][bj][m > 0 ? m - 1 : 0][n][e], acc[ai][bj][m > 0 ? m - 1 : 0][n][e], 0x121) : ep[bj][e];
                            pv[e] = DPPF(po, x[e], 0x111);
                            const float no = m < 3 ? DPPF(acc[ai][bj][m < 3 ? m + 1 : 3][n][e], acc[ai][bj][m < 3 ? m + 1 : 3][n][e], 0x12F) : en[bj][e];
                            nx[e] = DPPF(no, x[e], 0x101);
                        }
                        y[bj] = cb[bj] + w0[bj] * pv + w1[bj] * x + w2[bj] * nx;
                    }
                    const int i = 128 * ai + 64 * wr + 16 * m + fr, t = tofs + i; const bool ok = grp ? ((i >= 1) && (i <= 254) && (t < T)) : true;
                    if (ok) { f32x4 a;
#pragma unroll
                        for (int e = 0; e < 4; ++e) a[e] = y[0][e] * __builtin_amdgcn_rcpf(1.0f + __expf(-y[0][e])) * y[1][e];
                        u32x2 w; w.x = cvt_pk_bf16(a[0], a[1]); w.y = cvt_pk_bf16(a[2], a[3]);
                        *(GAS u32x2*)(act + (size_t)(arow0 + i) * DFF + fcol + 16 * n) = w; }
                }
            } }
    }
};
}
namespace att {
typedef LAS unsigned char lds_u8;
constexpr int LDS_TILE = 16384;
constexpr int LDS_RPB = 2 * LDS_TILE;
constexpr int LDS_NEXT = LDS_RPB + 2048;
constexpr int NGEMM = 64;
constexpr int NUNITS = 1024 + NGEMM;
constexpr float RESC_THR = 0.0f;

struct Ctx { unsigned char* ws; float* out; int l; int rep; };

__device__ __forceinline__ bf16x8 lds128(const lds_u8* p) { return *(const LAS bf16x8*)p; }
__device__ __forceinline__ float xmax32(float v) { const auto rr = __builtin_amdgcn_permlane32_swap(__float_as_uint(v), __float_as_uint(v), false, false); return fmaxf(__uint_as_float(rr[0]), __uint_as_float(rr[1])); }
__device__ __forceinline__ float xsum32(float v) { const auto rr = __builtin_amdgcn_permlane32_swap(__float_as_uint(v), __float_as_uint(v), false, false); return __uint_as_float(rr[0]) + __uint_as_float(rr[1]); }
__device__ __forceinline__ float max3f(float a, float b, float c) { float r; asm("v_max3_f32 %0, %1, %2, %3" : "=v"(r) : "v"(a), "v"(b), "v"(c)); return r; }
__device__ __forceinline__ int sigma32(int i) { return (i & 19) | ((i & 4) << 1) | ((i & 8) >> 1); }
__device__ __forceinline__ int key_of(int kb, int r, int h) { return 32 * kb + 16 * (r >> 3) + 8 * h + 4 * ((r >> 2) & 1) + (r & 3); }

template <int NDS>
__device__ __forceinline__ void qk_tile(f32x16& s0, f32x16& s1, const lds_u8* Kt, int c0, const bf16x8* qf, const f32x16& negm, int lane) {
    const int k0 = sigma32(lane & 31), h = lane >> 5; const lds_u8* b0 = Kt + k0 * 128; const lds_u8* b1 = b0 + 32 * 128; const int sw = (k0 >> 1) & 7;
    bf16x8 a0[NDS], a1[NDS];
#pragma unroll
    for (int ds = 0; ds < NDS; ++ds) { const int off = ((c0 + 2 * ds + h) ^ sw) << 4; a0[ds] = lds128(b0 + off); a1[ds] = lds128(b1 + off); }
    s0 = __builtin_amdgcn_mfma_f32_32x32x16_bf16(a0[0], qf[0], negm, 0, 0, 0); s1 = __builtin_amdgcn_mfma_f32_32x32x16_bf16(a1[0], qf[0], negm, 0, 0, 0);
#pragma unroll
    for (int ds = 1; ds < NDS; ++ds) { s0 = __builtin_amdgcn_mfma_f32_32x32x16_bf16(a0[ds], qf[ds], s0, 0, 0, 0); s1 = __builtin_amdgcn_mfma_f32_32x32x16_bf16(a1[ds], qf[ds], s1, 0, 0, 0); }
}
__device__ __forceinline__ void softmax_pv(f32x16& s0, f32x16& s1, float& m, float& l, f32x16& negm, f32x16& o0, f32x16& o1, const lds_u8* Vt, int lane) {
    float mx = max3f(s0[0], s1[0], s0[1]), my = max3f(s1[1], s0[2], s1[2]);
#pragma unroll
    for (int r = 3; r < 15; r += 2) { mx = max3f(mx, s0[r], s1[r]); my = max3f(my, s0[r + 1], s1[r + 1]); }
    mx = max3f(mx, s0[15], s1[15]); mx = fmaxf(mx, my);
    mx = xmax32(mx);
    if (__any(mx > 0.f)) {
        const float dl = fmaxf(mx, 0.f); m += dl; const float al = __builtin_amdgcn_exp2f(-dl); l *= al;
#pragma unroll
        for (int r = 0; r < 16; ++r) { o0[r] *= al; o1[r] *= al; s0[r] -= dl; s1[r] -= dl; negm[r] = -m; }
    }
    const int h = lane >> 5, d = lane & 31; const lds_u8* v0 = Vt + d * 128; const lds_u8* v1 = v0 + 32 * 128; const int sw = (d >> 1) & 7;
    bf16x8 va[4], vb[4];
#pragma unroll
    for (int c = 0; c < 4; ++c) { const int off = ((2 * c + h) ^ sw) << 4; va[c] = lds128(v0 + off); vb[c] = lds128(v1 + off); }
    f32x2 ps = {0.f, 0.f}, pt = {0.f, 0.f};
#pragma unroll
    for (int r = 0; r < 16; r += 2) { s0[r] = __builtin_amdgcn_exp2f(s0[r]); s0[r + 1] = __builtin_amdgcn_exp2f(s0[r + 1]); s1[r] = __builtin_amdgcn_exp2f(s1[r]); s1[r + 1] = __builtin_amdgcn_exp2f(s1[r + 1]);
        ps += (f32x2){s0[r], s0[r + 1]}; pt += (f32x2){s1[r], s1[r + 1]}; }
    ps += pt; l += ps[0] + ps[1];
#pragma unroll
    for (int c = 0; c < 4; ++c) {
        const f32x16& s = (c >> 1) ? s1 : s0; const int b = 8 * (c & 1);
        u32x4 pw; pw.x = cvt_pk_bf16(s[b + 0], s[b + 1]); pw.y = cvt_pk_bf16(s[b + 2], s[b + 3]); pw.z = cvt_pk_bf16(s[b + 4], s[b + 5]); pw.w = cvt_pk_bf16(s[b + 6], s[b + 7]);
        const bf16x8 pf = __builtin_bit_cast(bf16x8, pw);
        o0 = __builtin_amdgcn_mfma_f32_32x32x16_bf16(va[c], pf, o0, 0, 0, 0);
        o1 = __builtin_amdgcn_mfma_f32_32x32x16_bf16(vb[c], pf, o1, 0, 0, 0);
    }
}
__device__ __forceinline__ void softmax_pv_abs(f32x16& s0, f32x16& s1, float& m, float& l, f32x16& o0, f32x16& o1, const lds_u8* Vt, int lane) {
    float mx = max3f(s0[0], s1[0], s0[1]), my = max3f(s1[1], s0[2], s1[2]);
#pragma unroll
    for (int r = 3; r < 15; r += 2) { mx = max3f(mx, s0[r], s1[r]); my = max3f(my, s0[r + 1], s1[r + 1]); }
    mx = max3f(mx, s0[15], s1[15]); mx = fmaxf(mx, my);
    mx = xmax32(mx);
    if (__any(mx > m)) { const float mn = fmaxf(m, mx); const float al = __builtin_amdgcn_exp2f(m - mn); l *= al;
#pragma unroll
        for (int r = 0; r < 16; ++r) { o0[r] *= al; o1[r] *= al; }
        m = mn; }
    const int h = lane >> 5, d = lane & 31; const lds_u8* v0 = Vt + d * 128; const lds_u8* v1 = v0 + 32 * 128; const int sw = (d >> 1) & 7;
    bf16x8 va[4], vb[4];
#pragma unroll
    for (int c = 0; c < 4; ++c) { const int off = ((2 * c + h) ^ sw) << 4; va[c] = lds128(v0 + off); vb[c] = lds128(v1 + off); }
    f32x2 ps = {0.f, 0.f}, pt = {0.f, 0.f};
#pragma unroll
    for (int r = 0; r < 16; r += 2) { s0[r] = __builtin_amdgcn_exp2f(s0[r] - m); s0[r + 1] = __builtin_amdgcn_exp2f(s0[r + 1] - m); s1[r] = __builtin_amdgcn_exp2f(s1[r] - m); s1[r + 1] = __builtin_amdgcn_exp2f(s1[r + 1] - m);
        ps += (f32x2){s0[r], s0[r + 1]}; pt += (f32x2){s1[r], s1[r + 1]}; }
    ps += pt; l += ps[0] + ps[1];
#pragma unroll
    for (int c = 0; c < 4; ++c) {
        const f32x16& s = (c >> 1) ? s1 : s0; const int b = 8 * (c & 1);
        u32x4 pw; pw.x = cvt_pk_bf16(s[b + 0], s[b + 1]); pw.y = cvt_pk_bf16(s[b + 2], s[b + 3]); pw.z = cvt_pk_bf16(s[b + 4], s[b + 5]); pw.w = cvt_pk_bf16(s[b + 6], s[b + 7]);
        const bf16x8 pf = __builtin_bit_cast(bf16x8, pw);
        o0 = __builtin_amdgcn_mfma_f32_32x32x16_bf16(va[c], pf, o0, 0, 0, 0);
        o1 = __builtin_amdgcn_mfma_f32_32x32x16_bf16(vb[c], pf, o1, 0, 0, 0);
    }
}
struct UnitGeo {
    const GAS bf16_t* qkv; const GAS bf16_t* kcb; unsigned kso, vso, kco, vco; int T, ta, nself, ntile, q0, grp, fam, b, h;
};
template <int MODE>
__device__ __forceinline__ void unit_loop(lds_u8* lds, const UnitGeo& U, const GAS float* sm, GAS bf16_t* Obase, int orow0, int ocol, int l, int tid) {
    const int lane = tid & 63, w = __builtin_amdgcn_readfirstlane(tid >> 6), h5 = lane >> 5, ql = lane & 31;
    const int T = U.T, q0 = U.q0, nself = U.nself, ntile = U.ntile, ta = U.ta;
    const int Hq = U.fam == 1 ? 8 : 4;
    const size_t qo = U.fam == 0 ? QO_QA : (U.fam == 1 ? QO_QB : QO_QC); const size_t gq = U.fam == 1 ? GS8 : GS4;
    const int qw0 = q0 + 32 * w, qtok = qw0 + ql, qrow = qtok >> 6, qcol = qtok & 63;
    const GAS bf16_t* Qp = U.qkv + qo + U.grp * gq + ((size_t)(U.b * Hq + U.h) * T + qtok) * 64;
    bf16x8 qf[4];
#pragma unroll
    for (int ds = 0; ds < 4; ++ds) qf[ds] = *(const GAS bf16x8*)(Qp + 16 * ds + 8 * h5);
    const int r0w = min(max((qw0 >> 6) - 4, 0), 24), qsl = min(max(qcol - 8, 0), 48);
    constexpr float M_INIT = -1024.0f;
    float m0 = M_INIT, l0 = 0.f, m1 = M_INIT, l1 = 0.f;
    const f32x16 z = {0.f, 0.f, 0.f, 0.f, 0.f, 0.f, 0.f, 0.f, 0.f, 0.f, 0.f, 0.f, 0.f, 0.f, 0.f, 0.f};
    f32x16 oa0 = z, oa1 = z, ob0 = z, ob1 = z;
    f32x16 ng0;
#pragma unroll
    for (int r = 0; r < 16; ++r) ng0[r] = -M_INIT;
    const int lrow = tid >> 3, lch = tid & 7; const int lds_off = lrow * 128 + ((lch ^ ((lrow >> 1) & 7)) << 4);
    u32x4 rA[2], rB[2];
    auto gload = [&](int ti_, u32x4& kr, u32x4& vr) {
        const int ti = min(ti_, ntile - 1);
        const bool self = ti < nself; const int tok0 = self ? 64 * (ta + ti) : 64 * (ti - nself); const int Tkv = self ? T : PAST;
        const GAS bf16_t* kp = (self ? U.qkv : U.kcb) + (self ? U.kso : U.kco); const GAS bf16_t* vp = (self ? U.qkv : U.kcb) + (self ? U.vso : U.vco);
        kr = *(const GAS u32x4*)(kp + (size_t)(tok0 + lrow) * 64 + lch * 8);
        vr = *(const GAS u32x4*)(vp + (size_t)lrow * Tkv + tok0 + lch * 8);
    };
    auto tile = [&](int ti, const lds_u8* Kt) {
        const lds_u8* Vt = Kt + 8192;
        const bool self = ti < nself; const int tok0 = 64 * (ta + ti);
        bool rel = true, msk = false;
        if (MODE == 1 && self) { const int kr = ta + ti; rel = (kr >= r0w) && (kr <= r0w + 7); msk = true; }
        if (MODE == 2 && self) { rel = (tok0 + 63 >= qw0 - 128) && (tok0 <= qw0 + 31 + 128); msk = !((tok0 >= qw0 + 31 - 128) && (tok0 + 63 <= qw0 + 128)); }
        if (rel) {
            if (MODE != 3) {
                f32x16 s0, s1; qk_tile<4>(s0, s1, Kt, 0, qf, ng0, lane);
                if (MODE == 1 && msk) {
                    const int kr = ta + ti; const LAS float* bt = (const LAS float*)(lds + LDS_RPB) + (kr - qrow + 7) * 31 + 15 - qcol;
                    float b0[16], b1[16];
#pragma unroll
                    for (int r = 0; r < 16; ++r) { const int kc0 = key_of(0, r, h5); b0[r] = bt[min(max(kc0, qsl), qsl + 15)]; b1[r] = bt[min(max(kc0 + 32, qsl), qsl + 15)]; }
#pragma unroll
                    for (int r = 0; r < 16; ++r) { const int kc0 = key_of(0, r, h5), kc1 = kc0 + 32;
                        s0[r] = ((kc0 >= qsl) && (kc0 < qsl + 16)) ? s0[r] + b0[r] : -INFINITY; s1[r] = ((kc1 >= qsl) && (kc1 < qsl + 16)) ? s1[r] + b1[r] : -INFINITY; }
                }
                if (MODE == 2 && msk) {
#pragma unroll
                    for (int r = 0; r < 16; ++r) { const int k0 = tok0 + key_of(0, r, h5), k1 = k0 + 32;
                        s0[r] = (abs(k0 - qtok) > 128) ? -INFINITY : s0[r]; s1[r] = (abs(k1 - qtok) > 128) ? -INFINITY : s1[r]; }
                }
                softmax_pv(s0, s1, m0, l0, ng0, oa0, oa1, Vt, lane);
            } else {
                { f32x16 s0, s1; qk_tile<2>(s0, s1, Kt, 0, qf, z, lane); softmax_pv_abs(s0, s1, m0, l0, oa0, oa1, Vt, lane); }
                { f32x16 s0, s1; qk_tile<2>(s0, s1, Kt, 4, qf + 2, z, lane); softmax_pv_abs(s0, s1, m1, l1, ob0, ob1, Vt, lane); }
            }
        }
    };
    auto step = [&](int ti, u32x4 (&W)[2], u32x4 (&L)[2]) {
        gload(ti + 2, L[0], L[1]);
        __builtin_amdgcn_sched_barrier(0);
        tile(ti, lds + (ti & 1) * LDS_TILE);
        if (ti + 1 < ntile) { lds_u8* nb = lds + ((ti + 1) & 1) * LDS_TILE; *(LAS u32x4*)(nb + lds_off) = W[0]; *(LAS u32x4*)(nb + 8192 + lds_off) = W[1]; }
        __syncthreads();
    };
    gload(0, rB[0], rB[1]);
    gload(1, rA[0], rA[1]);
    *(LAS u32x4*)(lds + lds_off) = rB[0]; *(LAS u32x4*)(lds + 8192 + lds_off) = rB[1];
    __syncthreads();
    for (int ti = 0; ti < ntile; ti += 2) {
        step(ti, rA, rB);
        if (ti + 1 < ntile) step(ti + 1, rB, rA);
    }
    float lt0 = xsum32(l0);
    if (U.fam == 1) lt0 += __builtin_amdgcn_exp2f(sm[SM_SINK + l * 8 + U.h] - m0);
    const float i0 = 1.0f / lt0;
    lds_u8* stg = lds + w * 4096 + ql * 128;
    if (MODE != 3) {
#pragma unroll
        for (int g = 0; g < 4; ++g) {
            u32x2 wa, wb; wa.x = cvt_pk_bf16(oa0[4 * g] * i0, oa0[4 * g + 1] * i0); wa.y = cvt_pk_bf16(oa0[4 * g + 2] * i0, oa0[4 * g + 3] * i0);
            wb.x = cvt_pk_bf16(oa1[4 * g] * i0, oa1[4 * g + 1] * i0); wb.y = cvt_pk_bf16(oa1[4 * g + 2] * i0, oa1[4 * g + 3] * i0);
            *(LAS u32x2*)(stg + ((g ^ (ql & 7)) << 4) + 8 * h5) = wa; *(LAS u32x2*)(stg + (((4 + g) ^ (ql & 7)) << 4) + 8 * h5) = wb;
        }
    } else {
        const float lam_init = l == 0 ? 0.2f : (l == 1 ? 0.35550906759f : (l == 2 ? 0.47071301835f : 0.55605820416f));
        const float lt1 = xsum32(l1); const float i1 = 1.0f / lt1; const float lam = sm[SM_LAM + l];
        float ss = 0.f;
#pragma unroll
        for (int r = 0; r < 16; ++r) { oa0[r] = oa0[r] * i0 - lam * (ob0[r] * i1); oa1[r] = oa1[r] * i0 - lam * (ob1[r] * i1); ss += oa0[r] * oa0[r] + oa1[r] * oa1[r]; }
        ss = xsum32(ss);
        const float rn = __builtin_amdgcn_rsqf(ss * (1.f / 64.f) + 1e-6f) * (1.0f - lam_init);
        const GAS float* sg = sm + SM_SUBG + l * 64 + 4 * h5;
#pragma unroll
        for (int g = 0; g < 4; ++g) {
            const f32x4 ga = *(const GAS f32x4*)(sg + 8 * g), gb = *(const GAS f32x4*)(sg + 32 + 8 * g);
            u32x2 wa, wb; wa.x = cvt_pk_bf16(oa0[4 * g] * rn * ga[0], oa0[4 * g + 1] * rn * ga[1]); wa.y = cvt_pk_bf16(oa0[4 * g + 2] * rn * ga[2], oa0[4 * g + 3] * rn * ga[3]);
            wb.x = cvt_pk_bf16(oa1[4 * g] * rn * gb[0], oa1[4 * g + 1] * rn * gb[1]); wb.y = cvt_pk_bf16(oa1[4 * g + 2] * rn * gb[2], oa1[4 * g + 3] * rn * gb[3]);
            *(LAS u32x2*)(stg + ((g ^ (ql & 7)) << 4) + 8 * h5) = wa; *(LAS u32x2*)(stg + (((4 + g) ^ (ql & 7)) << 4) + 8 * h5) = wb;
        }
    }
    asm volatile("s_waitcnt lgkmcnt(0)" ::: "memory");
    {
        const int ch = lane & 7; GAS bf16_t* ob = Obase + (size_t)(orow0 + qw0) * 1024 + ocol + 8 * ch;
#pragma unroll
        for (int j = 0; j < 4; ++j) { const int row = (lane >> 3) + 8 * j;
            const u32x4 v = *(const LAS u32x4*)(lds + w * 4096 + row * 128 + ((ch ^ (row & 7)) << 4));
            *(GAS u32x4*)(ob + (size_t)row * 1024) = v; }
    }
}

__device__ __forceinline__ void attn_phase(lds_u8* lds, const Ctx& C) {
    const int l = C.l;
    for (;;) {
        __syncthreads();
        unsigned char* ws_ = C.ws; asm volatile("" : "+s"(ws_)); GAS unsigned char* ws = (GAS unsigned char*)ws_;
        const int tid = opaque_tid();
        if (tid == 0) *(LAS unsigned*)(lds + LDS_NEXT) = __hip_atomic_fetch_add((GAS unsigned*)(ws + WS_CTL) + 64 * (1 + l) + C.rep, 1u, __ATOMIC_RELAXED, __HIP_MEMORY_SCOPE_AGENT);
        __syncthreads();
        const int idx = (int)*(LAS unsigned*)(lds + LDS_NEXT);
#ifdef ATT_PROBE_LIMIT
        if (idx >= (C.rep ? ATT_PROBE_LIMIT : NUNITS)) break;
#else
        if (idx >= NUNITS) break;
#endif
        const GAS float* sm = (const GAS float*)(ws + WS_LAM);
        GAS unsigned* qa_done = (GAS unsigned*)(ws + WS_CTL) + 64 * (8 + l);
        if (idx < NGEMM) {
            pg8::Gemm g{(const bf16_t*)(ws_ + WS_XA), (const bf16_t*)(ws_ + WS_WIN) + (size_t)l * DIN * 1024, MTOT, 256, 1024}; pg8::OneUnit S1{idx};
            pg8::EpiIn E{ws_, C.out, l, 0};
            pg8::gemm_phase<pg8::EpiIn, pg8::OneUnit, true, true>(lds, g, S1, E);
            asm volatile("s_waitcnt vmcnt(0)" ::: "memory");
            __syncthreads();
            if (tid == 0) { __builtin_amdgcn_fence(__ATOMIC_RELEASE, "agent"); asm volatile("s_waitcnt vmcnt(0)" ::: "memory"); __hip_atomic_fetch_add(qa_done, 1u, __ATOMIC_RELAXED, __HIP_MEMORY_SCOPE_AGENT); }
            continue;
        }
        UnitGeo U; U.qkv = (const GAS bf16_t*)(ws + WS_QKV); U.kcb = (const GAS bf16_t*)(ws + WS_KC);
        int fam, grp, b, h, qb; const int iu = idx - NGEMM;
        if (iu < 128) { fam = 2; grp = 1; b = iu >> 5; h = (iu >> 3) & 3; qb = iu & 7; }
        else if (iu < 384) { const int i = iu - 128; fam = 1; grp = 1; b = i >> 6; h = (i >> 3) & 7; qb = i & 7; }
        else if (iu < 512) { const int i = iu - 384; fam = 2; grp = 0; b = i >> 2; h = i & 3; qb = 0; }
        else if (iu < 768) { const int i = iu - 512; fam = 1; grp = 0; b = i >> 3; h = i & 7; qb = 0; }
        else if (iu < 896) { const int i = iu - 768; fam = 0; grp = 1; b = i >> 5; h = (i >> 3) & 3; qb = i & 7; }
        else { const int i = iu - 896; fam = 0; grp = 0; b = i >> 2; h = i & 3; qb = 0; }
        const int q0 = qb * 256;
        if (fam == 0) {
            if (tid == 0) { unsigned sp = 0; while (__hip_atomic_load(qa_done, __ATOMIC_RELAXED, __HIP_MEMORY_SCOPE_AGENT) < (unsigned)NGEMM * (C.rep + 1) && ++sp < (1u << 22)) __builtin_amdgcn_s_sleep(2);
                __builtin_amdgcn_fence(__ATOMIC_ACQUIRE, "agent"); asm volatile("s_waitcnt vmcnt(0)" ::: "memory"); }
            __syncthreads();
        }
        const int T = grp ? TLAT : TCTX, Hkv = fam == 1 ? 2 : 4, hk = fam == 1 ? (h >> 2) : h;
        const size_t ko = fam == 0 ? QO_KA : (fam == 1 ? QO_KB : QO_KC), vo = fam == 0 ? QO_VTA : (fam == 1 ? QO_VTB : QO_VTC); const size_t gk = fam == 1 ? GS2 : GS4;
        U.kso = (unsigned)(ko + grp * gk + (size_t)(b * Hkv + hk) * T * 64); U.vso = (unsigned)(vo + grp * gk + (size_t)(b * Hkv + hk) * 64 * T);
        const size_t cko = fam == 0 ? CO_KA : (fam == 1 ? CO_KB : CO_KCC), cvo = fam == 0 ? CO_VTA : (fam == 1 ? CO_VTB : CO_VTCC);
        U.kco = (unsigned)(cko + (size_t)((l * 4 + b) * Hkv + hk) * PAST * 64); U.vco = (unsigned)(cvo + (size_t)((l * 4 + b) * Hkv + hk) * 64 * PAST);
        int ta, tb;
        if (!grp) { ta = 0; tb = 4; }
        else if (fam == 0) { ta = max(4 * qb - 4, 0); tb = min(max(4 * qb - 1, 0), 24) + 8; }
        else if (fam == 1) { ta = max(q0 - 128, 0) >> 6; tb = min(q0 + 384, TLAT) >> 6; }
        else { ta = 0; tb = 32; }
        U.T = T; U.ta = ta; U.nself = tb - ta; U.ntile = U.nself + (grp ? 8 : 0); U.q0 = q0; U.grp = grp; U.fam = fam; U.b = b; U.h = h;
        GAS bf16_t* Obase = (GAS bf16_t*)(ws + WS_O); const int orow0 = grp ? MCTX + b * TLAT : b * TCTX, ocol = (fam == 0 ? 0 : (fam == 1 ? 256 : 768)) + 64 * h;
        if (fam == 2) unit_loop<3>(lds, U, sm, Obase, orow0, ocol, l, tid);
        else if (!grp) unit_loop<0>(lds, U, sm, Obase, orow0, ocol, l, tid);
        else if (fam == 0) { if (tid < 465) *(LAS float*)(lds + LDS_RPB + 4 * tid) = sm[SM_RPB + (l * 4 + h) * 465 + tid]; unit_loop<1>(lds, U, sm, Obase, orow0, ocol, l, tid); }
        else unit_loop<2>(lds, U, sm, Obase, orow0, ocol, l, tid);
    }
}
}
namespace misc {
typedef LAS unsigned char lds_u8;
__device__ __forceinline__ float wave_sum(float v) {
#pragma unroll
    for (int o = 1; o < 64; o <<= 1) v += __shfl_xor(v, o);
    return v;
}
__device__ const double INVB[16] = {1.0, 0.5623413251903491, 0.31622776601683794, 0.1778279410038923, 0.1, 0.05623413251903491, 0.03162277660168379, 0.01778279410038923,
                                    0.01, 0.005623413251903491, 0.0031622776601683794, 0.001778279410038923, 0.001, 0.0005623413251903491, 0.00031622776601683794, 0.0001778279410038923};
__device__ const double INVC[8] = {1.0, 0.31622776601683794, 0.1, 0.03162277660168379, 0.01, 0.0031622776601683794, 0.001, 0.00031622776601683794};
__device__ __forceinline__ void sincos_d(double a, float& c, float& s) {
    const double k = rint(a * 0.6366197723675814);
    double r = fma(-k, 1.5707963267948966, a); r = fma(-k, 6.123233995736766e-17, r);
    const double r2 = r * r;
    const double sp = r * (1.0 + r2 * (-1.0 / 6.0 + r2 * (1.0 / 120.0 + r2 * (-1.0 / 5040.0 + r2 * (1.0 / 362880.0 + r2 * (-1.0 / 39916800.0 + r2 * (1.0 / 6227020800.0)))))));
    const double cp = 1.0 + r2 * (-0.5 + r2 * (1.0 / 24.0 + r2 * (-1.0 / 720.0 + r2 * (1.0 / 40320.0 + r2 * (-1.0 / 3628800.0 + r2 * (1.0 / 479001600.0 + r2 * (-1.0 / 87178291200.0)))))));
    const int q = ((int)k) & 3;
    const double cc = (q == 0) ? cp : (q == 1) ? -sp : (q == 2) ? -cp : sp;
    const double ss = (q == 0) ? sp : (q == 1) ? cp : (q == 2) ? -sp : -cp;
    c = (float)cc; s = (float)ss;
}
__device__ __forceinline__ void transpose_item(const float* W, int K, int N, bf16_t* WT, int k0, int n0, int dst0, LAS float* scr, int lane) {
    const int kr = lane >> 3, c4 = (lane & 7) * 4; f32x4 v[8];
#pragma unroll
    for (int i = 0; i < 8; ++i) v[i] = *(const f32x4*)(W + (size_t)(k0 + 8 * i + kr) * N + n0 + c4);
#pragma unroll
    for (int i = 0; i < 8; ++i) { LAS float* d = scr + (8 * i + kr) * 33 + c4; d[0] = v[i][0]; d[1] = v[i][1]; d[2] = v[i][2]; d[3] = v[i][3]; }
    asm volatile("s_waitcnt lgkmcnt(0)" ::: "memory");
    const int c = lane & 7;
#pragma unroll
    for (int j = 0; j < 4; ++j) { const int n = (lane >> 3) + 8 * j; const LAS float* s = scr + (8 * c) * 33 + n;
        u32x4 o; o.x = cvt_pk_bf16(s[0 * 33], s[1 * 33]); o.y = cvt_pk_bf16(s[2 * 33], s[3 * 33]); o.z = cvt_pk_bf16(s[4 * 33], s[5 * 33]); o.w = cvt_pk_bf16(s[6 * 33], s[7 * 33]);
        *(u32x4*)(WT + (size_t)(dst0 + n) * K + k0 + 8 * c) = o; }
    asm volatile("s_waitcnt lgkmcnt(0)" ::: "memory");
}
__device__ __forceinline__ void gemv5_item(const float* W, int N, int n0, const LAS float* vec, LAS float* red, const float* add, float* out, int ostride, int tid) {
    const int c2 = (tid & 31) * 2, kq = tid >> 5; f32x2 a0 = {0.f, 0.f}, a1 = a0, a2 = a0, a3 = a0, a4 = a0;
    const float* wp = W + (size_t)(kq * 64) * N + n0 + c2; const LAS float* vp = vec + kq * 64;
#pragma unroll 16
    for (int k = 0; k < 64; ++k) { const f32x2 w = *(const f32x2*)(wp + (size_t)k * N); a0 += w * vp[k]; a1 += w * vp[1024 + k]; a2 += w * vp[2048 + k]; a3 += w * vp[3072 + k]; a4 += w * vp[4096 + k]; }
    *(LAS f32x2*)(red + (kq * 5 + 0) * 64 + c2) = a0; *(LAS f32x2*)(red + (kq * 5 + 1) * 64 + c2) = a1; *(LAS f32x2*)(red + (kq * 5 + 2) * 64 + c2) = a2; *(LAS f32x2*)(red + (kq * 5 + 3) * 64 + c2) = a3; *(LAS f32x2*)(red + (kq * 5 + 4) * 64 + c2) = a4;
    __syncthreads();
    if (tid < 320) { const int b = tid >> 6, c = tid & 63; float s = add ? add[n0 + c] : 0.f;
#pragma unroll
        for (int q = 0; q < 16; ++q) s += red[(q * 5 + b) * 64 + c];
        out[(size_t)b * ostride + n0 + c] = s; }
    __syncthreads();
}

__device__ __forceinline__ void phase_tables(const Args& a) {
    const int gtid = blockIdx.x * 512 + opaque_tid(), NT = gridDim.x * 512; unsigned char* ws = a.ws;
    float* sm = (float*)(ws + WS_LAM);
    if (gtid < 4) { const int l = gtid; const float* lp = a.in[I_LAMBDA] + l * 128; float s1 = 0.f, s2 = 0.f;
        for (int i = 0; i < 32; ++i) { s1 += lp[i] * lp[32 + i]; s2 += lp[64 + i] * lp[96 + i]; }
        sm[SM_LAM + l] = expf(s1) - expf(s2) + (0.8f - 0.6f * expf(-0.3f * (float)l)); }
    for (int i = gtid; i < 1280; i += NT) { const int l = i / 320, r = i % 320; sm[SM_GAINS + i] = r < 128 ? a.in[I_NAG][l * 128 + r] : (r < 256 ? a.in[I_SWG][l * 128 + r - 128] : a.in[I_DAG][l * 64 + r - 256]); }
    for (int i = gtid; i < 7440; i += NT) sm[SM_RPB + i] = a.in[I_RPB][i] * LOG2E;
    for (int i = gtid; i < 32; i += NT) sm[SM_SINK + i] = a.in[I_SINK][i] * LOG2E;
    for (int i = gtid; i < 256; i += NT) sm[SM_SUBG + i] = a.in[I_SUBG][i];
    float* cv = (float*)(ws + WS_CONV);
    for (int i = gtid; i < 4 * 4 * DUP; i += NT) { const int c = i % DUP, j = (i / DUP) & 3, l = i / (4 * DUP); cv[i] = j < 3 ? a.in[I_CONVW][(size_t)(l * 3 + j) * DUP + c] : a.in[I_CONVB][(size_t)l * DUP + c]; }
    float* rb = (float*)(ws + WS_ROPEB); float* rc = (float*)(ws + WS_ROPEC);
    for (int i = gtid; i < 2048 * 32; i += NT) { const int t = i >> 5, j = i & 31; const double pos = (double)(j < 16 ? (t >> 6) : (t & 63)); float c, s; sincos_d(pos * INVB[j & 15], c, s); rb[2 * i] = c; rb[2 * i + 1] = s; }
    for (int i = gtid; i < 2048 * 16; i += NT) { const int t = i >> 4, j = i & 15; const double pos = (double)(j < 8 ? (t >> 6) : (t & 63)); float c, s; sincos_d(pos * INVC[j & 7], c, s); rc[2 * i] = c; rc[2 * i + 1] = s; }
}
constexpr int N_TR_IN = 144, N_TR_OUT = 64, N_TR_UP = 352, N_TR_DN = 176, N_MOD = 96, N_BIAS_IN = 36, N_BIAS_UP = 88, N_CACHE = 640;
__device__ __forceinline__ void fl_tr(lds_u8* lds, const Args& a, int l, int which, int bi, int tid) {
    const int lane = tid & 63, wave = __builtin_amdgcn_readfirstlane(tid >> 6); LAS float* scr = (LAS float*)(lds + wave * 16384); unsigned char* ws = a.ws; const int r = bi * 8 + wave;
    if (which == 0) { const int kb = r / 72, nb = r % 72, n0 = 32 * nb; const int tile = n0 >> 8, L = n0 & 255, wc = L >> 6, bj = (L >> 5) & 1; const int dst0 = 256 * tile + 128 * bj + 32 * wc;
        transpose_item(a.in[I_WIN] + (size_t)l * 1024 * DIN, 1024, DIN, (bf16_t*)(ws + WS_WIN) + (size_t)l * DIN * 1024, 64 * kb, n0, dst0, scr, lane); }
    else if (which == 1) { const int kb = r / 32, nb = r % 32; transpose_item(a.in[I_WOUT] + (size_t)l * 1024 * 1024, 1024, 1024, (bf16_t*)(ws + WS_WOUT) + (size_t)l * 1024 * 1024, 64 * kb, 32 * nb, 32 * nb, scr, lane); }
    else if (which == 2) { const int kb = r / 176, nb = r % 176, n0 = 32 * nb; const int nn = n0 < DFF ? n0 : n0 - DFF; const int dst0 = 256 * (nn >> 7) + (n0 < DFF ? 0 : 128) + (nn & 127);
        transpose_item(a.in[I_WUP] + (size_t)l * 1024 * DUP, 1024, DUP, (bf16_t*)(ws + WS_WUP) + (size_t)l * DUP * 1024, 64 * kb, n0, dst0, scr, lane); }
    else { const int kb = r / 32, nb = r % 32; transpose_item(a.in[I_WDOWN] + (size_t)l * DFF * 1024, DFF, 1024, (bf16_t*)(ws + WS_WDOWN) + (size_t)l * 1024 * DFF, 64 * kb, 32 * nb, 32 * nb, scr, lane); }
}
__device__ __forceinline__ void fl_mod(lds_u8* lds, const Args& a, int l, int g, int tid) {
    LAS float* vec = (LAS float*)lds; LAS float* red = (LAS float*)(lds + 20480);
    for (int i = tid; i < 5120; i += 512) { const int b5 = i >> 10, k = i & 1023; const float v = b5 == 0 ? a.in[I_CCTX][k] : a.in[I_C][(b5 - 1) * 1024 + k]; vec[i] = v / (1.f + __expf(-v)); }
    __syncthreads();
    gemv5_item(a.in[I_WMOD] + (size_t)l * 1024 * 6144, 6144, 64 * g, vec, red, a.in[I_BMOD] + l * 6144, (float*)(a.ws + WS_MOD) + (size_t)l * 5 * 6144, 6144, tid);
}
__device__ __forceinline__ void fl_bias(lds_u8* lds, const Args& a, int l, int which, int g, int tid) {
    LAS float* vec = (LAS float*)lds; LAS float* red = (LAS float*)(lds + 20480); const float* mod = (const float*)(a.ws + WS_MOD);
    for (int i = tid; i < 5120; i += 512) { const int b5 = i >> 10, k = i & 1023; vec[i] = mod[((size_t)(l * 5 + b5) * 6 + (which ? 3 : 0)) * 1024 + k]; }
    __syncthreads();
    if (!which) gemv5_item(a.in[I_WIN] + (size_t)l * 1024 * DIN, DIN, 64 * g, vec, red, nullptr, (float*)(a.ws + WS_BIASIN) + (size_t)l * 5 * DIN, DIN, tid);
    else gemv5_item(a.in[I_WUP] + (size_t)l * 1024 * DUP, DUP, 64 * g, vec, red, nullptr, (float*)(a.ws + WS_BIASUP) + (size_t)l * 5 * DUP, DUP, tid);
}
__device__ __forceinline__ void fl_gv(const Args& a, int l, int tid) {
    const float* mod = (const float*)(a.ws + WS_MOD); float* gv = (float*)(a.ws + WS_GV) + (size_t)l * 10240;
    for (int i = tid; i < 10240; i += 512) { const int c = i & 1023, which = (i >> 10) & 1, b5 = i >> 11;
        gv[i] = a.in[which ? I_GFFN : I_GATTN][l * 1024 + c] * (1.f + mod[((size_t)(l * 5 + b5) * 6 + (which ? 4 : 1)) * 1024 + c]); }
}
__device__ __forceinline__ void fl_cache(const Args& a, int l, int ci, int tid) {
    bf16_t* kc = (bf16_t*)(a.ws + WS_KC); int i = ci * 512 + tid;
    if (i < 163840) { const int fam = i < 65536 ? 0 : (i < 98304 ? 1 : 2); i -= fam == 0 ? 0 : (fam == 1 ? 65536 : 98304); const int H = fam == 1 ? 2 : 4;
        const float* ck = a.in[fam == 0 ? I_CNAK : (fam == 1 ? I_CSWK : I_CDAK)]; bf16_t* dk = kc + (fam == 0 ? CO_KA : (fam == 1 ? CO_KB : CO_KCC));
        const int d8 = i & 7, hh = (i >> 3) % H, p = (i / (8 * H)) & 511, b = i / (8 * H * 512);
        const float* s = ck + ((((size_t)b * 4 + l) * 512 + p) * H + hh) * 64 + d8 * 8; const f32x4 x = *(const f32x4*)s, y = *(const f32x4*)(s + 4);
        u32x4 o; o.x = cvt_pk_bf16(x[0], x[1]); o.y = cvt_pk_bf16(x[2], x[3]); o.z = cvt_pk_bf16(y[0], y[1]); o.w = cvt_pk_bf16(y[2], y[3]);
        *(u32x4*)(dk + ((((size_t)l * 4 + b) * H + hh) * 512 + p) * 64 + d8 * 8) = o; }
    else { i -= 163840; const int fam = i < 65536 ? 0 : (i < 98304 ? 1 : 2); i -= fam == 0 ? 0 : (fam == 1 ? 65536 : 98304); const int H = fam == 1 ? 2 : 4;
        const float* cv = a.in[fam == 0 ? I_CNAV : (fam == 1 ? I_CSWV : I_CDAV)]; bf16_t* dv = kc + (fam == 0 ? CO_VTA : (fam == 1 ? CO_VTB : CO_VTCC));
        const int d = i & 63, p8 = (i >> 6) & 63, hh = (i >> 12) % H, b = i / (4096 * H);
        const float* s = cv + ((((size_t)b * 4 + l) * 512 + p8 * 8) * H + hh) * 64 + d; float x[8];
#pragma unroll
        for (int j = 0; j < 8; ++j) x[j] = s[(size_t)j * H * 64];
        u32x4 o; o.x = cvt_pk_bf16(x[0], x[1]); o.y = cvt_pk_bf16(x[2], x[3]); o.z = cvt_pk_bf16(x[4], x[5]); o.w = cvt_pk_bf16(x[6], x[7]);
        *(u32x4*)(dv + ((((size_t)l * 4 + b) * H + hh) * 64 + d) * 512 + p8 * 8) = o; }
}
enum { SLOT_A = 0, SLOT_B = 1 };
__device__ __forceinline__ void fill_run(lds_u8* lds, const Args& a, int slot) {
    const int tid = opaque_tid();
    unsigned* counter = (unsigned*)(a.ws + WS_CTL) + 64 * (16 + slot);
    LAS unsigned* nxt = (LAS unsigned*)(lds + 131072 + 512);
    constexpr int N_TR_L = N_TR_IN + N_TR_OUT + N_TR_UP + N_TR_DN;
    for (;;) {
        __syncthreads();
        if (tid == 0) *nxt = __hip_atomic_fetch_add(counter, 1u, __ATOMIC_RELAXED, __HIP_MEMORY_SCOPE_AGENT);
        __syncthreads();
        int i = (int)*nxt;
        if (slot == SLOT_A) {
            if (i < 4 * N_MOD) { fl_mod(lds, a, i / N_MOD, i % N_MOD, tid); continue; } i -= 4 * N_MOD;
            if (i < 4 * N_TR_L) { const int l = i / N_TR_L; int r = i % N_TR_L;
                if (r < N_TR_IN) { fl_tr(lds, a, l, 0, r, tid); continue; } r -= N_TR_IN;
                if (r < N_TR_OUT) { fl_tr(lds, a, l, 1, r, tid); continue; } r -= N_TR_OUT;
                if (r < N_TR_UP) { fl_tr(lds, a, l, 2, r, tid); continue; } r -= N_TR_UP;
                fl_tr(lds, a, l, 3, r, tid); continue; }
            i -= 4 * N_TR_L;
            if (i < 4 * N_CACHE) { fl_cache(a, i / N_CACHE, i % N_CACHE, tid); continue; }
            break;
        } else {
            if (i < 4) { fl_gv(a, i, tid); continue; } i -= 4;
            if (i < 4 * N_BIAS_UP) { fl_bias(lds, a, i / N_BIAS_UP, 1, i % N_BIAS_UP, tid); continue; } i -= 4 * N_BIAS_UP;
            if (i < 4 * N_BIAS_IN) { fl_bias(lds, a, i / N_BIAS_IN, 0, i % N_BIAS_IN, tid); continue; }
            break;
        }
    }
}
__device__ __forceinline__ void phase_make_xa(const Args& a, int l, int which, int first) {
    const int tid = opaque_tid(), lane = tid & 63, wave = tid >> 6; unsigned char* ws = a.ws;
    const float* mod = (const float*)(ws + WS_MOD); bf16_t* xa = (bf16_t*)(ws + WS_XA); float* ssq = (float*)(ws + WS_SSQ);
    const float* gsrc = a.in[which ? I_GFFN : I_GATTN] + l * 1024;
    for (int row = blockIdx.x * 8 + wave; row < MTOT; row += gridDim.x * 8) {
        const float* src = first ? (row < MCTX ? a.in[I_XP] + (size_t)row * 1024 : a.in[I_XS] + (size_t)(row - MCTX) * 1024) : a.out + (size_t)row * 1024;
        const float* sc = mod + ((size_t)(l * 5 + row_b5(row)) * 6 + (which ? 4 : 1)) * 1024;
        f32x4 v[4]; float s = 0.f;
#pragma unroll
        for (int j = 0; j < 4; ++j) { v[j] = *(const f32x4*)(src + 256 * j + 4 * lane); s += (v[j][0] * v[j][0] + v[j][1] * v[j][1]) + (v[j][2] * v[j][2] + v[j][3] * v[j][3]); }
        s = wave_sum(s);
#pragma unroll
        for (int j = 0; j < 4; ++j) {
            const f32x4 g = *(const f32x4*)(gsrc + 256 * j + 4 * lane) * (*(const f32x4*)(sc + 256 * j + 4 * lane) + 1.0f);
            const f32x4 y = v[j] * g; u32x2 w; w.x = cvt_pk_bf16(y[0], y[1]); w.y = cvt_pk_bf16(y[2], y[3]); *(u32x2*)(xa + (size_t)row * 1024 + 256 * j + 4 * lane) = w; }
        if (lane < 4) ssq[(size_t)row * 4 + lane] = lane == 0 ? s : 0.f;
    }
}
}
constexpr int LDS_BYTES = 147456;
enum Phase { PH_MAKEXA = 2, PH_IN, PH_ATT, PH_OUT, PH_UP, PH_CONV, PH_DOWN };

constexpr int LDS_DUMMY = 131072 + 12288;
__device__ __forceinline__ void prefetch_panel(LAS unsigned char* lds, const bf16_t* tile, int K, int kbytes  ) {
    const int tid = opaque_tid(), wave = __builtin_amdgcn_readfirstlane(tid >> 6); const int segs = kbytes >> 7, nlines = 256 * segs;
    LAS unsigned* dst = (LAS unsigned*)(lds + LDS_DUMMY + wave * 256);
    for (int line = tid; line < nlines; line += 512) { const int row = line / segs, seg = line % segs;
        __builtin_amdgcn_global_load_lds((const unsigned*)((const char*)tile + (size_t)row * K * 2 + seg * 128), dst, 4, 0, 0); }
}
__device__ __forceinline__ void run_phase(LAS unsigned char* lds, const Args& a, int ph, int l, int p1, int p2) {
    unsigned char* ws = a.ws; const int G = gridDim.x;
    switch (ph) {
    case PH_MAKEXA: misc::phase_make_xa(a, l, p1, p2); break;
    case PH_IN: {
        pg8::Gemm g{(const bf16_t*)(ws + WS_XA), (const bf16_t*)(ws + WS_WIN) + (size_t)l * DIN * 1024 + (size_t)256 * 1024, MTOT, DIN - 256, 1024}; pg8::StaticOrder S; S.init(MTOT, DIN - 256, G, (int)blockIdx.x);
#ifdef TS_GEMM
        if (l == 1 && blockIdx.x == TS_BLOCK && TS_PHASE == ph) g.ts = (volatile unsigned long long*)(ws + WS_CTL + 512 * 1024);
#endif
        pg8::EpiIn E{ws, a.out, l, 1};
        pg8::gemm_phase<pg8::EpiIn, pg8::StaticOrder, true, true>(lds, g, S, E); } break;
    case PH_ATT: {
        att::Ctx C{ws, a.out, l, p1};
        att::attn_phase(lds, C); } break;
    case PH_OUT: {
        pg8::Gemm g{(const bf16_t*)(ws + WS_O), (const bf16_t*)(ws + WS_WOUT) + (size_t)l * 1024 * 1024, MTOT, 1024, 1024}; pg8::StaticOrder S; S.init(MTOT, 1024, G, (int)blockIdx.x);
#ifdef TS_GEMM
        if (l == 1 && blockIdx.x == TS_BLOCK && TS_PHASE == ph) g.ts = (volatile unsigned long long*)(ws + WS_CTL + 512 * 1024);
#endif
        pg8::EpiRes E{ws, a.out, l, 0, l == 0 ? a.in[I_XP] : nullptr, l == 0 ? a.in[I_XS] : nullptr};
#ifdef WARM_OUT
        { pg8::Unit u; if (S.next(0, u)) { prefetch_panel(lds, (const bf16_t*)(ws + WS_WOUT) + (size_t)l * 1024 * 1024 + (size_t)u.pn * 256 * 1024, 1024, 2048); prefetch_panel(lds, (const bf16_t*)(ws + WS_O) + (size_t)u.pm * 256 * 1024, 1024, 2048); }
          asm volatile("s_waitcnt vmcnt(0)" ::: "memory"); __syncthreads(); }
#endif
        pg8::gemm_phase<pg8::EpiRes, pg8::StaticOrder, false, true>(lds, g, S, E); } break;
    case PH_UP: {
        pg8::Gemm g{(const bf16_t*)(ws + WS_XA), (const bf16_t*)(ws + WS_WUP) + (size_t)l * DUP * 1024, MTOT, DUP, 1024}; pg8::UpOrder S; S.init_up(G, (int)blockIdx.x);
#ifdef TS_GEMM
        if (l == 1 && blockIdx.x == TS_BLOCK && TS_PHASE == ph) g.ts = (volatile unsigned long long*)(ws + WS_CTL + 512 * 1024);
#endif
        pg8::EpiUpConv E{ws, l};
        pg8::gemm_phase<pg8::EpiUpConv, pg8::UpOrder, true, true>(lds, g, S, E); } break;
    case PH_DOWN: {
        pg8::Gemm g{(const bf16_t*)(ws + WS_ACT), (const bf16_t*)(ws + WS_WDOWN) + (size_t)l * 1024 * DFF, MTOT, 1024, DFF}; pg8::StaticOrder S; S.init(MTOT, 1024, G, (int)blockIdx.x);
#ifdef TS_GEMM
        if (l == 1 && blockIdx.x == TS_BLOCK && TS_PHASE == ph) g.ts = (volatile unsigned long long*)(ws + WS_CTL + 512 * 1024);
#endif
        pg8::EpiRes E{ws, a.out, l, 1, nullptr, nullptr};
        pg8::gemm_phase<pg8::EpiRes, pg8::StaticOrder, false, true>(lds, g, S, E); } break;
    default: break;
    }
}

#define XB_TMO      128
#define XB_XCNT(j)  (256  + 64 * (j))
#define XB_XSUB(j)  (1280 + 64 * (j))
#define XB_XGEN(j)  (2304 + 64 * (j))
#define XB_TOP      3328
#define XB_TOPGEN   3392
#define XCD_BAR_WORDS 3456
#define XB_SPIN_CAP (1u << 18)
__device__ __forceinline__ unsigned xb_ld(unsigned* p)              { return __hip_atomic_load(p, __ATOMIC_RELAXED, __HIP_MEMORY_SCOPE_AGENT); }
__device__ __forceinline__ unsigned xb_add(unsigned* p, unsigned v) { return __hip_atomic_fetch_add(p, v, __ATOMIC_RELAXED, __HIP_MEMORY_SCOPE_AGENT); }
__device__ __forceinline__ unsigned xb_xcc_id() { return (unsigned)__builtin_amdgcn_s_getreg((3 << 11) | 20) & 0xFu; }
#define XB_SPIN(cond, bar) do { unsigned _sp = 0; while (cond) { __builtin_amdgcn_s_sleep(1); \
    if ((++_sp & 255u) == 0u) { if (xb_ld(&(bar)[XB_TMO])) break; if (_sp > XB_SPIN_CAP) { atomicAdd(&(bar)[XB_TMO], 1u); break; } } } } while (0)
struct XcdBarrier { unsigned* bar; unsigned x; volatile LAS unsigned* st; };
__device__ __forceinline__ XcdBarrier xcd_barrier_post(unsigned* bar, volatile LAS unsigned* st) {
    XcdBarrier b; b.bar = bar; b.x = xb_xcc_id(); b.st = st;
    if (threadIdx.x == 0) (void)xb_add(&bar[XB_XCNT(b.x)], 1u);
    return b;
}
__device__ __forceinline__ void xcd_barrier_complete(unsigned* bar, unsigned x, unsigned& nloc, unsigned& nx) {
    const unsigned G = gridDim.x * gridDim.y * gridDim.z;
    unsigned sum, cnt, mine, sp = 0u;
    for (;;) {
        sum = 0u; cnt = 0u; mine = 0u;
#pragma unroll
        for (unsigned j = 0; j < 16; ++j) { const unsigned c = xb_ld(&bar[XB_XCNT(j)]); sum += c; cnt += (c > 0u) ? 1u : 0u; mine = (j == x) ? c : mine; }
        if (sum == G) break;
        __builtin_amdgcn_s_sleep(1);
        if ((++sp & 255u) == 0u) { if (xb_ld(&bar[XB_TMO])) break; if (sp > XB_SPIN_CAP) { atomicAdd(&bar[XB_TMO], 1u); break; } }
    }
    nloc = mine > 0u ? mine : 1u; nx = cnt > 0u ? cnt : 1u;
}
__device__ __forceinline__ void xcd_barrier(const XcdBarrier& b) {
    asm volatile("s_waitcnt vmcnt(0)" ::: "memory");
    __syncthreads();
    if (threadIdx.x == 0) {
        unsigned* bar = b.bar;
        __builtin_amdgcn_s_waitcnt(0);
        unsigned nloc = b.st[0], nx = b.st[1];
        if (nloc == 0u) { xcd_barrier_complete(bar, b.x, nloc, nx); b.st[0] = nloc; b.st[1] = nx; }
        const unsigned old = xb_add(&bar[XB_XSUB(b.x)], 1u);
        const unsigned gen = old / nloc;
        if (old + 1u == (gen + 1u) * nloc) {
            __builtin_amdgcn_fence(__ATOMIC_RELEASE, "agent");
            asm volatile("s_waitcnt vmcnt(0)" ::: "memory");
            const unsigned og = xb_add(&bar[XB_TOP], 1u);
            const unsigned tg = og / nx;
            if (og + 1u == (tg + 1u) * nx) xb_add(&bar[XB_TOPGEN], 1u);
            else XB_SPIN(xb_ld(&bar[XB_TOPGEN]) == tg, bar);
            __builtin_amdgcn_fence(__ATOMIC_ACQUIRE, "agent");
            xb_add(&bar[XB_XGEN(b.x)], 1u);
            asm volatile("s_waitcnt vmcnt(0)" ::: "memory");
        } else {
            XB_SPIN(xb_ld(&bar[XB_XGEN(b.x)]) == gen, bar);
            __builtin_amdgcn_fence(__ATOMIC_ACQUIRE, "agent");
            asm volatile("s_waitcnt vmcnt(0)" ::: "memory");
        }
    }
    __syncthreads();
}
constexpr int CW_BAR = 4096;
constexpr int LDS_BARST = LDS_BYTES - 64;

__device__ __forceinline__ void prefetch_next(LAS unsigned char* lds, const Args& a, int ph, int l) {
    unsigned char* ws = a.ws; const int G = gridDim.x; pg8::Unit u;
    if (ph == PH_IN) { pg8::StaticOrder S; S.init(MTOT, DIN - 256, G, (int)blockIdx.x); if (S.next(0, u)) prefetch_panel(lds, (const bf16_t*)(ws + WS_WIN) + (size_t)l * DIN * 1024 + (size_t)(u.pn + 1) * 256 * 1024, 1024, 2048); }
    else if (ph == PH_OUT) { pg8::StaticOrder S; S.init(MTOT, 1024, G, (int)blockIdx.x); if (S.next(0, u)) prefetch_panel(lds, (const bf16_t*)(ws + WS_WOUT) + (size_t)l * 1024 * 1024 + (size_t)u.pn * 256 * 1024, 1024, 2048); }
    else if (ph == PH_UP) { pg8::UpOrder S; S.init_up(G, (int)blockIdx.x); if (S.next(0, u)) prefetch_panel(lds, (const bf16_t*)(ws + WS_WUP) + (size_t)l * DUP * 1024 + (size_t)u.pn * 256 * 1024, 1024, 2048); }
    else if (ph == PH_DOWN) { pg8::StaticOrder S; S.init(MTOT, 1024, G, (int)blockIdx.x); if (S.next(0, u)) prefetch_panel(lds, (const bf16_t*)(ws + WS_WDOWN) + (size_t)l * 1024 * DFF + (size_t)u.pn * 256 * DFF, DFF, 2048); }
}
__global__ void __launch_bounds__(512, 2) mk_fwd(Args a) {
    extern __shared__ __attribute__((aligned(16))) unsigned char lds_raw[];
    LAS unsigned char* lds = (LAS unsigned char*)lds_raw;
    cg::grid_group grid = cg::this_grid();
    if (threadIdx.x < 2) ((volatile LAS unsigned*)(lds + LDS_BARST))[threadIdx.x] = 0u;
    __syncthreads();
    const XcdBarrier xbar = xcd_barrier_post((unsigned*)(a.ws + WS_CTL) + CW_BAR, (volatile LAS unsigned*)(lds + LDS_BARST));
#define GSYNC() xcd_barrier(xbar)
#ifdef TS_A
#define TSB ((volatile unsigned long long*)(a.ws + WS_CTL + 512 * 1024))
#define STAMP(k) do { if (blockIdx.x == TS_BLOCK && threadIdx.x == 0) TSB[k] = __builtin_amdgcn_s_memrealtime(); } while (0)
#else
#define STAMP(k) do {} while (0)
#endif
    STAMP(0);
#ifdef TS_XCC
    if (threadIdx.x == 0) ((volatile unsigned*)(a.ws + WS_CTL + 768 * 1024))[blockIdx.x] = xb_xcc_id();
#endif
    grid.sync();
    misc::phase_tables(a); misc::fill_run(lds, a, misc::SLOT_A); GSYNC(); STAMP(1);
    run_phase(lds, a, PH_MAKEXA, 0, 0, 1); misc::fill_run(lds, a, misc::SLOT_B); GSYNC();
#ifndef REP_IN
#define REP_IN 1
#endif
#ifndef REP_ATT
#define REP_ATT 1
#endif
#ifndef REP_UP
#define REP_UP 1
#endif
    STAMP(2);
#pragma unroll 1
    for (int l = 0; l < DEPTH; ++l) {
        if (l == 1) STAMP(10);
#pragma unroll 1
        for (int rep = 0; rep < REP_IN; ++rep) { run_phase(lds, a, PH_IN, l, 0, 0); if (l == 1) STAMP(11); GSYNC(); }
        if (l == 1) STAMP(12);
#pragma unroll 1
        for (int rep = 0; rep < REP_ATT; ++rep) { run_phase(lds, a, PH_ATT, l, rep, 0); if (l == 1) STAMP(13); GSYNC(); }
        if (l == 1) STAMP(14);
        run_phase(lds, a, PH_OUT, l, 0, 0); if (l == 1) STAMP(15); GSYNC();
        if (l == 1) STAMP(16);
#pragma unroll 1
        for (int rep = 0; rep < REP_UP; ++rep) { run_phase(lds, a, PH_UP, l, 0, 0); if (l == 1) STAMP(17); GSYNC(); }
        if (l == 1) STAMP(18);
        run_phase(lds, a, PH_DOWN, l, 0, 0); if (l == 1) STAMP(19);
        if (l < DEPTH - 1) GSYNC();
        if (l == 1) STAMP(20);
    }
#ifdef TS_A
    GSYNC();
    if (blockIdx.x == TS_BLOCK) {
#ifdef TS_XCC
        volatile unsigned* xc = (volatile unsigned*)(a.ws + WS_CTL + 768 * 1024); int mism = 0;
        for (int b = 0; b < (int)gridDim.x; ++b) { const unsigned ref = (TS_XCC == 1) ? xc[b % 8] : xc[(b / 32) * 32]; mism += (xc[b] != ref) ? 1 : 0; }
        const float T_us = (float)mism;
#else
        const float T_us = (float)(TSB[TS_B] - TSB[TS_A]) * 0.01f;
#endif
        const float dl = sqrtf(T_us * (float)(TS_SCALE) * 8.0f);
        for (int i = threadIdx.x; i < (1 << 20); i += 512) a.out[OUT_NAV + i] *= (1.0f + dl);
    }
#endif
}

extern "C" void kernel_launch(void* const* d_in, const int* in_sizes, int n_in, void* d_out, int out_size, void* d_ws, size_t ws_size, hipStream_t stream) {
    static int grid = 0;
    if (grid == 0) {
        int dev = 0, cus = 0, per_cu = 0;
        (void)hipGetDevice(&dev); (void)hipDeviceGetAttribute(&cus, hipDeviceAttributeMultiprocessorCount, dev);
        (void)hipFuncSetAttribute((const void*)mk_fwd, hipFuncAttributeMaxDynamicSharedMemorySize, LDS_BYTES);
        (void)hipOccupancyMaxActiveBlocksPerMultiprocessor(&per_cu, (const void*)mk_fwd, 512, LDS_BYTES);
        if (per_cu < 1) fprintf(stderr, "kernel_launch: occupancy query reports %d blocks per CU\n", per_cu);
        grid = cus > 0 ? cus : 256;
        if (ws_size < WS_END) { fprintf(stderr, "kernel_launch: workspace too small (%zu < %zu)\n", ws_size, (size_t)WS_END); grid = -1; }
    }
    if (grid < 0) return;
    Args a{}; for (int i = 0; i < N_IN; ++i) a.in[i] = (const float*)d_in[i]; a.out = (float*)d_out; a.ws = (unsigned char*)d_ws;
    (void)hipMemsetAsync((unsigned char*)d_ws + WS_CTL, 0, 1 * MiB, stream);
    void* args[] = {&a};
    hipError_t e = hipLaunchCooperativeKernel((const void*)mk_fwd, dim3(grid), dim3(512), args, LDS_BYTES, stream);
    if (e != hipSuccess) fprintf(stderr, "cooperative launch failed: %s (grid %d)\n", hipGetErrorString(e), grid);
}
```

```cpp
#include <hip/hip_runtime.h>
#include <hip/hip_cooperative_groups.h>
#include <cstdio>
#include <cstdint>
namespace cg = cooperative_groups;

constexpr int DEPTH = 4, NCTX = 32, TCTX = 256, NLAT = 4, TLAT = 2048, PAST = 512;
constexpr int MCTX = 8192, MLAT = 8192, MTOT = 16384;
constexpr int DIN = 2304, DFF = 2816, DUP = 5632;
constexpr size_t OUT_X = 0, OUT_NAK = 16777216, OUT_NAV = 25165824, OUT_SWK = 33554432, OUT_SWV = 37748736, OUT_DAK = 41943040, OUT_DAV = 50331648, OUT_TOTAL = 58720256;
enum { I_XP = 0, I_XS, I_CNAK, I_CNAV, I_CSWK, I_CSWV, I_CDAK, I_CDAV, I_C, I_CCTX, I_GATTN, I_GFFN, I_WMOD, I_BMOD, I_WIN, I_NAG, I_RPB, I_SWG, I_SINK, I_DAG, I_LAMBDA, I_SUBG, I_WOUT, I_WUP, I_CONVW, I_CONVB, I_WDOWN, N_IN };
#define LAS __attribute__((address_space(3)))
#define GAS __attribute__((address_space(1)))
typedef unsigned short bf16_t;
typedef short bf16x8 __attribute__((ext_vector_type(8)));
typedef float f32x4 __attribute__((ext_vector_type(4)));
typedef float f32x2 __attribute__((ext_vector_type(2)));
typedef float f32x16 __attribute__((ext_vector_type(16)));
typedef unsigned u32x4 __attribute__((ext_vector_type(4)));
typedef unsigned u32x2 __attribute__((ext_vector_type(2)));
typedef __bf16 bf16x2_t __attribute__((ext_vector_type(2)));

constexpr float LOG2E = 1.4426950408889634f;
constexpr float QSCALE64 = 0.125f * LOG2E, QSCALE32 = 0.17677669529663687f * LOG2E;

__device__ __forceinline__ unsigned cvt_pk_bf16(float lo, float hi) { f32x2 v = {lo, hi}; bf16x2_t b = __builtin_convertvector(v, bf16x2_t); return __builtin_bit_cast(unsigned, b); }
__device__ __forceinline__ float bf16_to_f32(bf16_t v) { return __builtin_bit_cast(float, (unsigned)v << 16); }
__device__ __forceinline__ int row_b5(int row) { return row < MCTX ? 0 : 1 + ((row - MCTX) >> 11); }

constexpr size_t MiB = 1u << 20;
constexpr size_t WS_CTL = 0;
constexpr size_t WS_MOD = 1 * MiB;
constexpr size_t WS_GV = WS_MOD + 512 * 1024;
constexpr size_t WS_BIASIN = WS_GV + 256 * 1024;
constexpr size_t WS_BIASUP = WS_BIASIN + 256 * 1024;
constexpr size_t WS_LAM = WS_BIASUP + 512 * 1024;
constexpr int SM_LAM = 0, SM_GAINS = 64, SM_RPB = SM_GAINS + 1280, SM_SINK = SM_RPB + 7440, SM_SUBG = SM_SINK + 32, SM_END = SM_SUBG + 256;
constexpr size_t WS_ROPEB = 3 * MiB;
constexpr size_t WS_ROPEC = WS_ROPEB + 512 * 1024;
constexpr size_t WS_SSQ = 4 * MiB;
constexpr size_t WS_CONV = 5 * MiB;
constexpr size_t WS_WIN = 6 * MiB;
constexpr size_t WS_WOUT = WS_WIN + 18 * MiB;
constexpr size_t WS_WUP = WS_WOUT + 8 * MiB;
constexpr size_t WS_WDOWN = WS_WUP + 44 * MiB;
constexpr size_t WS_KC = WS_WDOWN + 22 * MiB;
constexpr size_t WS_XA = WS_KC + 20 * MiB;
constexpr size_t WS_QKV = WS_XA + 32 * MiB + 1 * MiB;
constexpr size_t WS_O = WS_QKV + 72 * MiB;
constexpr size_t WS_ACT = WS_QKV;
constexpr size_t WS_END = WS_O + 32 * MiB;
constexpr size_t GS4 = 2097152, GS8 = 4194304, GS2 = 1048576;
constexpr size_t QO_QA = 0, QO_KA = QO_QA + 2 * GS4, QO_VTA = QO_KA + 2 * GS4, QO_QB = QO_VTA + 2 * GS4, QO_KB = QO_QB + 2 * GS8, QO_VTB = QO_KB + 2 * GS2,
                 QO_QC = QO_VTB + 2 * GS2, QO_KC = QO_QC + 2 * GS4, QO_VTC = QO_KC + 2 * GS4, QO_END = QO_VTC + 2 * GS4;
static_assert(QO_END * 2 == 72 * MiB, "qkv region");
constexpr size_t CO_KA = 0, CO_VTA = CO_KA + GS4, CO_KB = CO_VTA + GS4, CO_VTB = CO_KB + GS2, CO_KCC = CO_VTB + GS2, CO_VTCC = CO_KCC + GS4;

struct Args { const float* in[N_IN]; float* out; unsigned char* ws; };
__device__ __forceinline__ int opaque_tid() { int t = threadIdx.x; asm volatile("" : "+v"(t)); return t; }

namespace pg8 {
#define PG8_LAS __attribute__((address_space(3)))
constexpr int BM = 256, BK = 64, HALF = 128, HTB = HALF * BK * 2  , STAGE_BYTES = 8 * HTB, NXCD = 8, WGM = 8;
__host__ __device__ __forceinline__ int lds_byte(int r, int c) { const int st = (r >> 4) * 2 + (c >> 5), rr = r & 15, cc = c & 31, ob = rr * 64 + cc * 2; return st * 1024 + (ob ^ (((ob >> 9) & 1) << 5)); }
__host__ __device__ __forceinline__ void stage_rc(int b, int& R, int& C) { const int st = b / 1024, sb = b % 1024, swz = sb ^ (((sb >> 9) & 1) << 5); R = (st >> 1) * 16 + swz / 64; C = (st & 1) * 32 + (swz % 64) / 2; }
__host__ __device__ __forceinline__ int perm32(int rho) { const int n = rho >> 4, i = rho & 15; return 8 * (i >> 2) + 4 * n + (i & 3); }
struct Unit { int pm, pn; };
struct Gemm { const bf16_t* A; const bf16_t* Bt; int M, N, K; volatile unsigned long long* ts = nullptr; };
struct StaticOrder {
    int nM, nN, nwg, G, c;
    __host__ __device__ void init(int M, int N, int G_, int c_) { nM = M / BM; nN = N / BM; nwg = nM * nN; G = G_; c = c_; }
    __host__ __device__ bool next(int i, Unit& u) const {
        const long L = (long)i * G + c; if (L >= nwg) return false;
        int wgid = (int)L; { const int q = nwg / NXCD, r = nwg % NXCD, xcd = wgid % NXCD, off = wgid / NXCD; wgid = (xcd < r ? xcd * (q + 1) : r * (q + 1) + (xcd - r) * q) + off; }
        const int nig = WGM * nN, gid = wgid / nig, fm = gid * WGM, gsz = (nM - fm) < WGM ? (nM - fm) : WGM;
        u.pm = fm + ((wgid % nig) % gsz); u.pn = (wgid % nig) / gsz; return true;
    }
    __device__ __forceinline__ void a_ready(const Unit&) const {}
    __device__ __forceinline__ void done(const Unit&) const {}
    __device__ __forceinline__ int arow0(int pm) const { return BM * pm; }
};
struct OneUnit {
    int pm;
    __device__ __forceinline__ bool next(int i, Unit& u) const { if (i > 0) return false; u.pm = pm; u.pn = 0; return true; }
    __device__ __forceinline__ void a_ready(const Unit&) const {}
    __device__ __forceinline__ void done(const Unit&) const {}
    __device__ __forceinline__ int arow0(int pm_) const { return BM * pm_; }
};
struct UpOrder : StaticOrder {
    __device__ __forceinline__ void init_up(int G_, int c_) { nM = 68; nN = 22; nwg = nM * nN; G = G_; c = c_; }
    __device__ __forceinline__ int arow0(int pm) const { return pm < 32 ? BM * pm : MCTX + TLAT * ((pm - 32) / 9) + 254 * ((pm - 32) % 9) - 1; }
};

template <class Epi, class Sched, bool ALIGN_EPI = false, bool SP2 = false>
__device__ __forceinline__ void gemm_phase(PG8_LAS unsigned char* lds, const Gemm g, const Sched& S, const Epi& E) {
    const int tid = opaque_tid(), wid = __builtin_amdgcn_readfirstlane(tid >> 6), lane = tid & 63, wr = wid >> 2, wc = wid & 3, fr = lane & 15, fq = lane >> 4;
    const int K = g.K, nt = K / BK;
    unsigned voffA[2], voffB[2];
#pragma unroll
    for (int i = 0; i < 2; ++i) { int R, C; stage_rc(tid * 16 + i * 8192, R, C); const int Rb = Epi::PERM ? ((R & ~31) + perm32(R & 31)) : R;
        voffA[i] = (unsigned)(R * K + C) * 2u; voffB[i] = (unsigned)(Rb * K + C) * 2u; }
    const size_t kstep = (size_t)(BK * 2);
    const size_t hstep = (size_t)HALF * K * 2;
    const size_t tstep = 2 * hstep;
    const unsigned ldsw = (unsigned)wid * 1024u;
    const int aoff = lds_byte(wr * 64 + fr, fq * 8), boff = lds_byte(wc * 32 + fr, fq * 8);
#define PG8_SA(b, h) (((b) * 2 + (h)) * HTB)
#define PG8_SB(b, h) ((4 + (b) * 2 + (h)) * HTB)
#define PG8_STAGE(bufoff, gbase, voff) do { _Pragma("unroll") for (int _i = 0; _i < 2; ++_i) \
        __builtin_amdgcn_global_load_lds((const unsigned*)((const char*)(gbase) + (voff)[_i]), (PG8_LAS unsigned*)(lds + (bufoff) + ldsw + _i * 8192), 16, 0, 0); } while (0)
#define PG8_LDA(dst, b, h) do { _Pragma("unroll") for (int m = 0; m < 4; ++m) _Pragma("unroll") for (int k = 0; k < 2; ++k) dst[m][k] = *(const PG8_LAS bf16x8*)(lds + PG8_SA(b, h) + aoff + m * 2048 + k * 1024); } while (0)
#define PG8_LDB(dst, b, h) do { _Pragma("unroll") for (int n = 0; n < 2; ++n) _Pragma("unroll") for (int k = 0; k < 2; ++k) dst[n][k] = *(const PG8_LAS bf16x8*)(lds + PG8_SB(b, h) + boff + n * 2048 + k * 1024); } while (0)
#define PG8_MMA(ai, bj, At, Bt) do { __builtin_amdgcn_s_setprio(1); _Pragma("unroll") for (int m = 0; m < 4; ++m) _Pragma("unroll") for (int n = 0; n < 2; ++n) _Pragma("unroll") for (int k = 0; k < 2; ++k) \
        acc[ai][bj][m][n] = __builtin_amdgcn_mfma_f32_16x16x32_bf16(Bt[n][k], At[m][k], acc[ai][bj][m][n], 0, 0, 0); __builtin_amdgcn_s_setprio(0); } while (0)
#define PG8_WAIT_V(n) asm volatile("s_waitcnt vmcnt(" #n ")" ::: "memory")
#define PG8_WAIT_L(n) asm volatile("s_waitcnt lgkmcnt(" #n ")" ::: "memory")
#define PG8_BAR __builtin_amdgcn_s_barrier()
#define PG8_SCHED __builtin_amdgcn_sched_barrier(0)
    Unit cur, nxt; int ui = 0;
    if (!S.next(0, cur)) return;
    f32x4 acc[2][2][4][2];
#pragma unroll
    for (int a = 0; a < 2; ++a)
#pragma unroll
        for (int b = 0; b < 2; ++b)
#pragma unroll
            for (int m = 0; m < 4; ++m)
#pragma unroll
                for (int n = 0; n < 2; ++n) acc[a][b][m][n] = (f32x4){0.f, 0.f, 0.f, 0.f};
    bf16x8 At[4][2], B0[2][2], B1[2][2];
    const size_t rstep = (size_t)K * 2;
    const char* cA = (const char*)g.A + (size_t)S.arow0(cur.pm) * rstep; const char* cB = (const char*)g.Bt + (size_t)cur.pn * tstep;
    S.a_ready(cur);
#ifdef SKEW_A
    { const int d = (cur.pn & 3) * SKEW_A + (cur.pm & 7) * SKEW_B; for (int i = 0; i < d; ++i) __builtin_amdgcn_s_sleep(16); }
#endif
#ifdef USE_KROT
#if USE_KROT == 2
#define PG8_ROT(u) (2 * ((int)blockIdx.x & 7) * (nt >> 4))
#else
#define PG8_ROT(u) (2 * ((((u).pm & 7) + ((u).pn & 3)) & 3))
#endif
#else
#define PG8_ROT(u) 0
#endif
    int rc = PG8_ROT(cur);
    { const char* pA = cA + (size_t)rc * kstep; const char* pB = cB + (size_t)rc * kstep;
    if constexpr (SP2) {
        PG8_STAGE(PG8_SB(0, 0), pB, voffB); PG8_STAGE(PG8_SB(0, 1), pB + hstep, voffB); PG8_STAGE(PG8_SA(0, 0), pA, voffA); PG8_STAGE(PG8_SA(0, 1), pA + hstep, voffA);
        if (wr == 1) PG8_BAR;
        PG8_WAIT_V(2); PG8_BAR;
        PG8_STAGE(PG8_SB(1, 0), pB + kstep, voffB); PG8_STAGE(PG8_SA(1, 0), pA + kstep, voffA); PG8_STAGE(PG8_SB(1, 1), pB + hstep + kstep, voffB);
        PG8_WAIT_V(6); PG8_BAR;
    } else {
        PG8_STAGE(PG8_SB(0, 0), pB, voffB); PG8_STAGE(PG8_SA(0, 0), pA, voffA); PG8_STAGE(PG8_SB(0, 1), pB + hstep, voffB); PG8_STAGE(PG8_SA(0, 1), pA + hstep, voffA);
        if (wr == 1) PG8_BAR;
        PG8_WAIT_V(4); PG8_BAR;
        PG8_STAGE(PG8_SB(1, 0), pB + kstep, voffB); PG8_STAGE(PG8_SA(1, 0), pA + kstep, voffA); PG8_STAGE(PG8_SB(1, 1), pB + hstep + kstep, voffB);
        PG8_WAIT_V(6); PG8_BAR;
    } }
    for (;;) {
        const bool has_next = S.next(ui + 1, nxt);
        const char* nA = has_next ? (const char*)g.A + (size_t)S.arow0(nxt.pm) * rstep : cA; const char* nB = has_next ? (const char*)g.Bt + (size_t)nxt.pn * tstep : cB;
        const int rn = has_next ? PG8_ROT(nxt) : rc;
        int p = rc;
        for (int t = 0; t < nt; t += 2) {
            const bool last = (t == nt - 2);
#ifdef TS_GEMM
            if (g.ts && tid == 0 && ui == 0) g.ts[40 + (t >> 1)] = __builtin_amdgcn_s_memrealtime();
#endif
            const int p2 = (p + 2 >= nt) ? p + 2 - nt : p + 2;
            const char* a1 = cA + (size_t)(p + 1) * kstep;
            const char* a2 = last ? nA + (size_t)rn * kstep : cA + (size_t)p2 * kstep; const char* b2 = last ? nB + (size_t)rn * kstep : cB + (size_t)p2 * kstep;
            const char* a3 = a2 + kstep; const char* b3 = b2 + kstep;
            p = p2;
            if (last && has_next) S.a_ready(nxt);
            if constexpr (SP2) {
            PG8_LDB(B0, 0, 0); PG8_LDB(B1, 0, 1); PG8_SCHED; PG8_LDA(At, 0, 0); PG8_STAGE(PG8_SA(1, 1), a1 + hstep, voffA);
            PG8_WAIT_V(8); PG8_WAIT_L(0); PG8_BAR; PG8_MMA(0, 0, At, B0); PG8_MMA(0, 1, At, B1); PG8_BAR; PG8_SCHED;
            PG8_LDA(At, 0, 1); PG8_STAGE(PG8_SB(0, 0), b2, voffB); PG8_STAGE(PG8_SB(0, 1), b2 + hstep, voffB); PG8_STAGE(PG8_SA(0, 0), a2, voffA);
            PG8_WAIT_V(8); PG8_WAIT_L(0); PG8_BAR; PG8_MMA(1, 0, At, B0); PG8_MMA(1, 1, At, B1); PG8_BAR; PG8_SCHED;
            PG8_LDB(B0, 1, 0); PG8_LDB(B1, 1, 1); PG8_SCHED; PG8_LDA(At, 1, 0); PG8_STAGE(PG8_SA(0, 1), a2 + hstep, voffA);
            PG8_WAIT_V(8); PG8_WAIT_L(0); PG8_BAR; PG8_MMA(0, 0, At, B0); PG8_MMA(0, 1, At, B1); PG8_BAR; PG8_SCHED;
            PG8_LDA(At, 1, 1); PG8_STAGE(PG8_SB(1, 0), b3, voffB); PG8_STAGE(PG8_SB(1, 1), b3 + hstep, voffB); PG8_STAGE(PG8_SA(1, 0), a3, voffA);
            PG8_WAIT_V(8); PG8_WAIT_L(0); PG8_BAR; PG8_MMA(1, 0, At, B0); PG8_MMA(1, 1, At, B1); PG8_BAR; PG8_SCHED;
            } else {
            PG8_LDB(B0, 0, 0); PG8_SCHED; PG8_LDA(At, 0, 0); PG8_STAGE(PG8_SA(1, 1), a1 + hstep, voffA);
            PG8_WAIT_L(8); PG8_BAR; PG8_WAIT_L(0); PG8_MMA(0, 0, At, B0); PG8_BAR; PG8_SCHED;
            PG8_LDB(B1, 0, 1); PG8_STAGE(PG8_SB(0, 0), b2, voffB);
            PG8_BAR; PG8_WAIT_L(0); PG8_MMA(0, 1, At, B1); PG8_BAR;
            PG8_LDA(At, 0, 1); PG8_STAGE(PG8_SA(0, 0), a2, voffA);
            PG8_BAR; PG8_WAIT_L(0); PG8_MMA(1, 0, At, B0); PG8_BAR; PG8_SCHED;
            PG8_STAGE(PG8_SB(0, 1), b2 + hstep, voffB);
            PG8_WAIT_V(6); PG8_BAR; PG8_MMA(1, 1, At, B1); PG8_BAR;
            PG8_LDB(B0, 1, 0); PG8_SCHED; PG8_LDA(At, 1, 0); PG8_STAGE(PG8_SA(0, 1), a2 + hstep, voffA);
            PG8_WAIT_L(8); PG8_BAR; PG8_WAIT_L(0); PG8_MMA(0, 0, At, B0); PG8_BAR; PG8_SCHED;
            PG8_LDB(B1, 1, 1); PG8_STAGE(PG8_SB(1, 0), b3, voffB);
            PG8_BAR; PG8_WAIT_L(0); PG8_MMA(0, 1, At, B1); PG8_BAR;
            PG8_LDA(At, 1, 1); PG8_STAGE(PG8_SA(1, 0), a3, voffA);
            PG8_BAR; PG8_WAIT_L(0); PG8_MMA(1, 0, At, B0); PG8_BAR; PG8_SCHED;
            PG8_STAGE(PG8_SB(1, 1), b3 + hstep, voffB);
            PG8_WAIT_V(6); PG8_BAR; PG8_MMA(1, 1, At, B1); PG8_BAR;
            }
        }
        if constexpr (ALIGN_EPI) { if (wr == 0) PG8_BAR; }
#ifdef TS_GEMM
        if (g.ts && tid == 0) g.ts[30 + 2 * ui] = __builtin_amdgcn_s_memrealtime();
#endif
        if constexpr (!Epi::AFTER_DRAIN) { if constexpr (Epi::NEEDS_LDS) E(acc, cur, wr, wc, fr, fq, lds); else E(acc, cur, wr, wc, fr, fq); S.done(cur); }
#ifdef TS_GEMM
        if (g.ts && tid == 0) g.ts[31 + 2 * ui] = __builtin_amdgcn_s_memrealtime();
#endif
        if (!has_next) break;
#pragma unroll
        for (int a = 0; a < 2; ++a)
#pragma unroll
            for (int b = 0; b < 2; ++b)
#pragma unroll
                for (int m = 0; m < 4; ++m)
#pragma unroll
                    for (int n = 0; n < 2; ++n) acc[a][b][m][n] = (f32x4){0.f, 0.f, 0.f, 0.f};
        cur = nxt; cA = nA; cB = nB; rc = rn; ++ui;
        if constexpr (ALIGN_EPI) { if (wr == 1) PG8_BAR; }
    }
    PG8_WAIT_V(0);
    if constexpr (!ALIGN_EPI) { if (wr == 0) PG8_BAR; }
    PG8_BAR;
    if constexpr (Epi::AFTER_DRAIN) { E.fused(acc, cur, wr, wc, fr, fq, lds, wid, lane); S.done(cur); }
#undef PG8_SA
#undef PG8_SB
#undef PG8_STAGE
#undef PG8_LDA
#undef PG8_LDB
#undef PG8_MMA
#undef PG8_WAIT_V
#undef PG8_WAIT_L
#undef PG8_BAR
#undef PG8_SCHED
}

constexpr int LDS_EDGE = 131072 + 1024;
constexpr int LDS_RSTD = LDS_EDGE + 8192;
__device__ __forceinline__ void rstd_table(PG8_LAS unsigned char* lds, const GAS float* ssq, int arow0, int wr, int wc, int fr, int fq) {
    const int tid = (wr * 4 + wc) * 64 + fq * 16 + fr, r = tid >> 1, hf = tid & 1;
    const f32x2 a = *(const GAS f32x2*)(ssq + (size_t)min(arow0 + r, MTOT - 1) * 4 + 2 * hf);
    float s = a[0] + a[1]; s += __shfl_xor(s, 1);
    if (!hf) ((PG8_LAS float*)(lds + LDS_RSTD))[r] = __builtin_amdgcn_rsqf(s * (1.0f / 1024.0f) + 1e-6f);
}
__device__ __forceinline__ float xsum_fq(float v) {
    auto a = __builtin_amdgcn_permlane16_swap(__float_as_uint(v), __float_as_uint(v), false, false); v = __uint_as_float(a[0]) + __uint_as_float(a[1]);
    auto b = __builtin_amdgcn_permlane32_swap(__float_as_uint(v), __float_as_uint(v), false, false); return __uint_as_float(b[0]) + __uint_as_float(b[1]);
}
__device__ __forceinline__ float wave_sum_dpp(float v) {
    v += __builtin_bit_cast(float, __builtin_amdgcn_mov_dpp(__builtin_bit_cast(int, v), 0xB1, 0xf, 0xf, true));
    v += __builtin_bit_cast(float, __builtin_amdgcn_mov_dpp(__builtin_bit_cast(int, v), 0x4E, 0xf, 0xf, true));
    v += __builtin_bit_cast(float, __builtin_amdgcn_mov_dpp(__builtin_bit_cast(int, v), 0x124, 0xf, 0xf, true));
    v += __builtin_bit_cast(float, __builtin_amdgcn_mov_dpp(__builtin_bit_cast(int, v), 0x128, 0xf, 0xf, true));
    return xsum_fq(v);
}
#define EPI_BARRIER() do { asm volatile("s_waitcnt lgkmcnt(0)" ::: "memory"); __builtin_amdgcn_s_barrier(); asm volatile("" ::: "memory"); } while (0)

struct EpiIn {
    static constexpr bool PERM = true, AFTER_DRAIN = false, NEEDS_LDS = true;
    unsigned char* ws0; float* out; int l; int pn_off;
    __device__ __forceinline__ void operator()(const f32x4 (&acc)[2][2][4][2], const Unit& u, int wr, int wc, int fr_in, int fq_in, PG8_LAS unsigned char* lds) const {
        unsigned char* ws_ = ws0; asm volatile("" : "+s"(ws_));
        GAS unsigned char* ws = (GAS unsigned char*)ws_; GAS float* outg = (GAS float*)out;
        int fr = fr_in, fq = fq_in; asm volatile("" : "+v"(fr), "+v"(fq));
        const GAS float* ssq = (const GAS float*)(ws + WS_SSQ); const GAS float* bias = (const GAS float*)(ws + WS_BIASIN) + (size_t)l * 5 * DIN;
        const GAS float* gains = (const GAS float*)(ws + WS_LAM) + SM_GAINS + l * 320; const GAS float* nag = gains; const GAS float* swg = gains + 128; const GAS float* dag = gains + 256;
        const GAS float* ropeB = (const GAS float*)(ws + WS_ROPEB); const GAS float* ropeC = (const GAS float*)(ws + WS_ROPEC); GAS bf16_t* qkv = (GAS bf16_t*)(ws + WS_QKV);
        const int pm = u.pm, pn = u.pn + pn_off;
        const int grp = pm >= 32 ? 1 : 0, b = grp ? ((pm - 32) >> 3) : pm, tbase = grp ? 256 * ((pm - 32) & 7) : 0, T = grp ? TLAT : TCTX, b5 = grp ? 1 + b : 0;
        int type, h;
        if (pn < 3) { type = pn; h = wc; } else if (pn < 5) { type = 3; h = 4 * (pn - 3) + wc; } else if (pn == 5) { type = wc < 2 ? 4 : 5; h = wc & 1; } else { type = pn; h = wc; }
        const bool isv = (type == 2 || type == 5 || type == 8), isq = (type == 0 || type == 3 || type == 6), is32 = (type == 6 || type == 7);
        const bool rope = grp && (type == 3 || type == 4 || type == 6 || type == 7);
        const int H = (type == 3) ? 8 : ((type == 4 || type == 5) ? 2 : 4);
        size_t dbase; const size_t gs = (type == 3) ? GS8 : ((type == 4 || type == 5) ? GS2 : GS4);
        switch (type) { case 0: dbase = QO_QA; break; case 1: dbase = QO_KA; break; case 2: dbase = QO_VTA; break; case 3: dbase = QO_QB; break; case 4: dbase = QO_KB; break; case 5: dbase = QO_VTB; break;
                        case 6: dbase = QO_QC; break; case 7: dbase = QO_KC; break; default: dbase = QO_VTC; break; }
        GAS bf16_t* dst = qkv + dbase + grp * gs + (size_t)(b * H + h) * T * 64;
        GAS float* fo = nullptr; int fow = 0, foc = 0;
        if (!grp) { switch (type) { case 1: fo = outg + OUT_NAK; fow = 256; foc = 64 * wc; break; case 2: fo = outg + OUT_NAV; fow = 256; foc = 64 * wc; break; case 4: fo = outg + OUT_SWK; fow = 128; foc = 64 * h; break;
                        case 5: fo = outg + OUT_SWV; fow = 128; foc = 64 * h; break; case 7: fo = outg + OUT_DAK; fow = 256; foc = 64 * wc; break; case 8: fo = outg + OUT_DAV; fow = 256; foc = 64 * wc; break; default: break; } }
        const GAS float* gsrc = ((type == 0) ? nag : (type == 1) ? nag + 64 : (type == 3) ? swg : (type == 4) ? swg + 64 : (type == 6) ? dag : dag + 32) + 8 * fq;
        const GAS float* bsrc = bias + b5 * DIN + pn * 256 + 64 * wc + 8 * fq;
        rstd_table(lds, ssq, 256 * pm, wr, wc, fr, fq);
        f32x4 bv[2][2], gv[2][2];
#pragma unroll
        for (int bj = 0; bj < 2; ++bj)
#pragma unroll
            for (int n = 0; n < 2; ++n) { bv[bj][n] = *(const GAS f32x4*)(bsrc + 32 * bj + 4 * n); gv[bj][n] = isv ? (f32x4){1.f, 1.f, 1.f, 1.f} : *(const GAS f32x4*)(gsrc + (is32 ? 0 : 32 * bj) + 4 * n); }
        EPI_BARRIER();
        const PG8_LAS float* RS = (const PG8_LAS float*)(lds + LDS_RSTD);
        const float qs = isq ? (is32 ? QSCALE32 : QSCALE64) : 1.0f;
#pragma unroll
        for (int ai = 0; ai < 2; ++ai)
#pragma unroll
            for (int m = 0; m < 4; ++m) {
                const int lr = 128 * ai + 64 * wr + 16 * m + fr, row = 256 * pm + lr, t = tbase + lr;
                const float rstd = RS[lr];
                float r0 = 1.f, r1 = 1.f;
                if (!isv) {
                    float s0 = 0.f, s1 = 0.f;
#pragma unroll
                    for (int n = 0; n < 2; ++n) { const f32x4 a = acc[ai][0][m][n] * rstd + bv[0][n], c = acc[ai][1][m][n] * rstd + bv[1][n];
                        s0 += (a[0] * a[0] + a[1] * a[1]) + (a[2] * a[2] + a[3] * a[3]); s1 += (c[0] * c[0] + c[1] * c[1]) + (c[2] * c[2] + c[3] * c[3]); }
                    s0 = xsum_fq(s0); s1 = xsum_fq(s1);
                    if (is32) { r0 = __builtin_amdgcn_rsqf(s0 * (1.f / 32.f) + 1e-6f); r1 = __builtin_amdgcn_rsqf(s1 * (1.f / 32.f) + 1e-6f); }
                    else { r0 = r1 = __builtin_amdgcn_rsqf((s0 + s1) * (1.f / 64.f) + 1e-6f); }
                }
                u32x2 hold = {0u, 0u};
                GAS float* fr_ = fo ? fo + ((size_t)(b * DEPTH + l) * 256 + t) * fow + foc + 8 * fq : nullptr;
#pragma unroll
                for (int bj = 0; bj < 2; ++bj)
#pragma unroll
                    for (int n = 0; n < 2; ++n) {
                        f32x4 x = acc[ai][bj][m][n] * rstd + bv[bj][n];
                        if (!isv) {
                            x = x * (bj ? r1 : r0) * gv[bj][n];
                            if (rope) {
                                const f32x4 cs = is32 ? *(const GAS f32x4*)(ropeC + ((size_t)t * 16 + 4 * fq + 2 * n) * 2) : *(const GAS f32x4*)(ropeB + ((size_t)t * 32 + 16 * bj + 4 * fq + 2 * n) * 2);
                                x = (f32x4){x[0] * cs[0] - x[1] * cs[1], x[0] * cs[1] + x[1] * cs[0], x[2] * cs[2] - x[3] * cs[3], x[2] * cs[3] + x[3] * cs[2]};
                            }
                        }
                        if (fr_) *(GAS f32x4*)(fr_ + 32 * bj + 4 * n) = x;
                        if (!isv) { const f32x4 y = x * qs; u32x2 w; w.x = cvt_pk_bf16(y[0], y[1]); w.y = cvt_pk_bf16(y[2], y[3]);
                            if (n == 0) hold = w; else { u32x4 w4; w4.x = hold.x; w4.y = hold.y; w4.z = w.x; w4.w = w.y; *(GAS u32x4*)(dst + (size_t)t * 64 + 32 * bj + 8 * fq) = w4; } }
                        else {
                            const int d0 = 32 * bj + 8 * fq + 4 * n, q = fr & 3;
                            const unsigned A = cvt_pk_bf16(x[0], x[1]), B = cvt_pk_bf16(x[2], x[3]);
                            const unsigned pA = (unsigned)__builtin_amdgcn_mov_dpp((int)A, 0x4E, 0xf, 0xf, true), pB = (unsigned)__builtin_amdgcn_mov_dpp((int)B, 0x4E, 0xf, 0xf, true);
                            const unsigned n0 = q < 2 ? A : pB, n1 = q < 2 ? pA : B;
                            const unsigned p0 = (unsigned)__builtin_amdgcn_mov_dpp((int)n0, 0xB1, 0xf, 0xf, true), p1 = (unsigned)__builtin_amdgcn_mov_dpp((int)n1, 0xB1, 0xf, 0xf, true);
                            const unsigned sel = (q & 1) ? 0x03020706u : 0x05040100u;
                            u32x2 w; w.x = __builtin_amdgcn_perm(p0, n0, sel); w.y = __builtin_amdgcn_perm(p1, n1, sel);
                            *(GAS u32x2*)(dst + (size_t)(d0 + q) * T + (t - q)) = w; }
                    }
            }
    }
};

struct EpiRes {
    static constexpr bool PERM = false, AFTER_DRAIN = true, NEEDS_LDS = false;
    unsigned char* ws0; float* x; int l; int which;
    const float* xin_p; const float* xin_s;
    __device__ __forceinline__ void fused(const f32x4 (&acc)[2][2][4][2], const Unit& u, int wr, int wc, int fr, int fq, PG8_LAS unsigned char* lds, int wid, int lane) const {
        GAS unsigned char* ws = (GAS unsigned char*)ws0; GAS float* xg = (GAS float*)x;
        const int pm = u.pm, pn = u.pn, b5 = pm >= 32 ? 1 + ((pm - 32) >> 3) : 0;
        const GAS float* xin = xin_p ? (const GAS float*)(pm >= 32 ? xin_s : xin_p) : nullptr;
        const GAS float* gate = (const GAS float*)(ws + WS_MOD) + (size_t)(l * 5 + b5) * 6144 + (which ? 5 : 2) * 1024 + 256 * pn + 4 * lane;
        const bool hasn = which ? (l < 3) : true;
        const GAS float* gvn = (const GAS float*)(ws + WS_GV) + (size_t)(which ? l + 1 : l) * 10240 + (size_t)b5 * 2048 + (which ? 0 : 1024) + 256 * pn + 4 * lane;
        GAS bf16_t* xa = (GAS bf16_t*)(ws + WS_XA); GAS float* ssq = (GAS float*)(ws + WS_SSQ);
#ifndef X_NO_SC1
        const __amdgpu_buffer_rsrc_t xrsrc = __builtin_amdgcn_make_buffer_rsrc((void*)x, 0, (int)(MTOT * 1024 * 4), 0x00020000);
#endif
        const f32x4 g4 = *(const GAS f32x4*)gate; const f32x4 n4 = hasn ? *(const GAS f32x4*)gvn : (f32x4){0.f, 0.f, 0.f, 0.f};
#pragma unroll
        for (int ai = 0; ai < 2; ++ai) {
#pragma unroll
            for (int m = 0; m < 4; ++m) { const int row = 64 * wr + 16 * m + fr;
#pragma unroll
                for (int bj = 0; bj < 2; ++bj)
#pragma unroll
                    for (int n = 0; n < 2; ++n) *(PG8_LAS f32x4*)(lds + row * 1024 + (((32 * bj + 8 * wc + 4 * n + fq) ^ (row & 15)) << 4)) = acc[ai][bj][m][n]; }
            EPI_BARRIER();
            const int grow0 = 256 * pm + 128 * ai + 16 * wid; GAS float* xr = xg + (size_t)grow0 * 1024 + 256 * pn + 4 * lane;
#pragma unroll
            for (int k0 = 0; k0 < 16; k0 += 8) {
                f32x4 xv[8];
#pragma unroll
                for (int k = 0; k < 8; ++k) xv[k] = __builtin_nontemporal_load((const GAS f32x4*)((xin ? xin + (size_t)(grow0 - (grow0 >= MCTX ? MCTX : 0)) * 1024 + 256 * pn + 4 * lane : xr) + (size_t)(k0 + k) * 1024));
#pragma unroll
                for (int k = 0; k < 8; ++k) { const int row = 16 * wid + k0 + k;
                    const f32x4 a4 = *(const PG8_LAS f32x4*)(lds + row * 1024 + ((lane ^ (row & 15)) << 4));
                    const f32x4 y = xv[k] + g4 * a4;
#ifndef X_NO_SC1
                    __builtin_amdgcn_raw_buffer_store_b128(__builtin_bit_cast(u32x4, y), xrsrc, (int)(((size_t)(grow0 + k0 + k) * 1024 + 256 * pn + 4 * lane) * 4), 0, 16);
#else
                    __builtin_nontemporal_store(y, (GAS f32x4*)(xr + (size_t)(k0 + k) * 1024));
#endif
                    if (hasn) { float ss = (y[0] * y[0] + y[1] * y[1]) + (y[2] * y[2] + y[3] * y[3]);
                        ss = wave_sum_dpp(ss);
                        const f32x4 z = y * n4; u32x2 w; w.x = cvt_pk_bf16(z[0], z[1]); w.y = cvt_pk_bf16(z[2], z[3]);
                        *(GAS u32x2*)(xa + (size_t)(grow0 + k0 + k) * 1024 + 256 * pn + 4 * lane) = w;
                        if (lane == 0) ssq[(size_t)(grow0 + k0 + k) * 4 + pn] = ss; }
                }
            }
            EPI_BARRIER();
        }
    }
};

#define DPPF(old, src, ctrl) __builtin_bit_cast(float, __builtin_amdgcn_update_dpp(__builtin_bit_cast(int, (float)(old)), __builtin_bit_cast(int, (float)(src)), (ctrl), 0xf, 0xf, false))
struct EpiUpConv {
    static constexpr bool PERM = false, AFTER_DRAIN = false, NEEDS_LDS = true;
    unsigned char* ws0; int l;
    __device__ __forceinline__ void operator()(f32x4 (&acc)[2][2][4][2], const Unit& u, int wr, int wc, int fr_in, int fq_in, PG8_LAS unsigned char* lds) const {
        unsigned char* ws_ = ws0; asm volatile("" : "+s"(ws_)); GAS unsigned char* ws = (GAS unsigned char*)ws_;
        int fr = fr_in, fq = fq_in; asm volatile("" : "+v"(fr), "+v"(fq));
        const int pm = u.pm, pn = u.pn; const int grp = pm >= 32 ? 1 : 0, bq = grp ? (pm - 32) / 9 : 0, jq = grp ? (pm - 32) % 9 : 0;
        const int T = grp ? TLAT : TCTX, tofs = grp ? 254 * jq - 1 : 0, arow0 = grp ? MCTX + TLAT * bq + tofs : 256 * pm, b5 = grp ? 1 + bq : 0;
        const GAS float* ssq = (const GAS float*)(ws + WS_SSQ); const GAS float* bias = (const GAS float*)(ws + WS_BIASUP) + (size_t)(l * 5 + b5) * DUP; const GAS float* cw = (const GAS float*)(ws + WS_CONV) + (size_t)l * 4 * DUP;
        GAS bf16_t* act = (GAS bf16_t*)(ws + WS_ACT);
#ifdef ACT_WT
        const __amdgpu_buffer_rsrc_t wsrsrc = __builtin_amdgcn_make_buffer_rsrc((void*)ws_, 0, 0x7FFFFFF0, 0x00020000);
#endif
        const int fcol = 128 * pn + 32 * wc + 4 * fq;
        rstd_table(lds, ssq, arow0, wr, wc, fr, fq);
        f32x4 bv[2][2];
#pragma unroll
        for (int bj = 0; bj < 2; ++bj)
#pragma unroll
            for (int n = 0; n < 2; ++n) bv[bj][n] = *(const GAS f32x4*)(bias + bj * DFF + fcol + 16 * n);
        EPI_BARRIER();
        const PG8_LAS float* RS = (const PG8_LAS float*)(lds + LDS_RSTD);
#pragma unroll
        for (int ai = 0; ai < 2; ++ai)
#pragma unroll
            for (int m = 0; m < 4; ++m) {
                const int i = 128 * ai + 64 * wr + 16 * m + fr, t = tofs + i; const bool inseq = (t >= 0) && (t < T);
                const float rstd = RS[i];
#pragma unroll
                for (int bj = 0; bj < 2; ++bj)
#pragma unroll
                    for (int n = 0; n < 2; ++n) { const f32x4 v = acc[ai][bj][m][n] * rstd + bv[bj][n]; acc[ai][bj][m][n] = inseq ? v : (f32x4){0.f, 0.f, 0.f, 0.f}; }
            }
        PG8_LAS float* E = (PG8_LAS float*)(lds + LDS_EDGE);
#pragma unroll
        for (int ai = 0; ai < 2; ++ai) { const int c = 2 * ai + wr;
#pragma unroll
            for (int bj = 0; bj < 2; ++bj)
#pragma unroll
                for (int n = 0; n < 2; ++n) { const int col = 128 * bj + 32 * wc + 16 * n + 4 * fq;
                    if (fr == 0) *(PG8_LAS f32x4*)(E + (c * 2 + 0) * 256 + col) = acc[ai][bj][0][n];
                    if (fr == 15) *(PG8_LAS f32x4*)(E + (c * 2 + 1) * 256 + col) = acc[ai][bj][3][n]; } }
        asm volatile("s_waitcnt lgkmcnt(0)" ::: "memory"); __builtin_amdgcn_s_barrier(); asm volatile("" ::: "memory");
#pragma unroll
        for (int n = 0; n < 2; ++n) {
            f32x4 w0[2], w1[2], w2[2], cb[2];
#pragma unroll
            for (int bj = 0; bj < 2; ++bj) { const GAS float* p = cw + bj * DFF + fcol + 16 * n; w0[bj] = *(const GAS f32x4*)p; w1[bj] = *(const GAS f32x4*)(p + DUP); w2[bj] = *(const GAS f32x4*)(p + 2 * DUP); cb[bj] = *(const GAS f32x4*)(p + 3 * DUP); }
#pragma unroll
            for (int ai = 0; ai < 2; ++ai) { const int c = 2 * ai + wr;
                f32x4 ep[2], en[2];
#pragma unroll
                for (int bj = 0; bj < 2; ++bj) { const int col = 128 * bj + 32 * wc + 16 * n + 4 * fq;
                    ep[bj] = c > 0 ? *(const PG8_LAS f32x4*)(E + ((c - 1) * 2 + 1) * 256 + col) : (f32x4){0.f, 0.f, 0.f, 0.f};
                    en[bj] = c < 3 ? *(const PG8_LAS f32x4*)(E + ((c + 1) * 2 + 0) * 256 + col) : (f32x4){0.f, 0.f, 0.f, 0.f}; }
#pragma unroll
                for (int m = 0; m < 4; ++m) {
                    f32x4 y[2];
#pragma unroll
                    for (int bj = 0; bj < 2; ++bj) {
                        const f32x4 x = acc[ai][bj][m][n]; f32x4 pv, nx;
#pragma unroll
                        for (int e = 0; e < 4; ++e) {
                            const float po = m > 0 ? DPPF(acc[ai][bj][m > 0 ? m - 1 : 0][n][e], acc[ai][bj][m > 0 ? m - 1 : 0][n][e], 0x121) : ep[bj][e];
                            pv[e] = DPPF(po, x[e], 0x111);
                            const float no = m < 3 ? DPPF(acc[ai][bj][m < 3 ? m + 1 : 3][n][e], acc[ai][bj][m < 3 ? m + 1 : 3][n][e], 0x12F) : en[bj][e];
                            nx[e] = DPPF(no, x[e], 0x101);
                        }
                        y[bj] = cb[bj] + w0[bj] * pv + w1[bj] * x + w2[bj] * nx;
                    }
                    const int i = 128 * ai + 64 * wr + 16 * m + fr, t = tofs + i; const bool ok = grp ? ((i >= 1) && (i <= 254) && (t < T)) : true;
                    if (ok) { f32x4 a;
#pragma unroll
                        for (int e = 0; e < 4; ++e) a[e] = y[0][e] * __builtin_amdgcn_rcpf(1.0f + __expf(-y[0][e])) * y[1][e];
                        u32x2 w; w.x = cvt_pk_bf16(a[0], a[1]); w.y = cvt_pk_bf16(a[2], a[3]);
#ifdef ACT_WT
                        __builtin_amdgcn_raw_buffer_store_b64(w, wsrsrc, (int)(WS_ACT + ((size_t)(arow0 + i) * DFF + fcol + 16 * n) * 2), 0, 16); }
#else
                        *(GAS u32x2*)(act + (size_t)(arow0 + i) * DFF + fcol + 16 * n) = w; }
#endif
                }
            } }
    }
};
}
namespace att {
typedef LAS unsigned char lds_u8;
constexpr int LDS_TILE = 16384;
constexpr int LDS_RPB = 2 * LDS_TILE;
constexpr int LDS_NEXT = LDS_RPB + 2048;
constexpr int NGEMM = 64;
constexpr int NUNITS = 1024 + NGEMM;
constexpr float RESC_THR = 0.0f;

struct Ctx { unsigned char* ws; float* out; int l; int rep; };

__device__ __forceinline__ bf16x8 lds128(const lds_u8* p) { return *(const LAS bf16x8*)p; }
__device__ __forceinline__ float xmax32(float v) { const auto rr = __builtin_amdgcn_permlane32_swap(__float_as_uint(v), __float_as_uint(v), false, false); return fmaxf(__uint_as_float(rr[0]), __uint_as_float(rr[1])); }
__device__ __forceinline__ float xsum32(float v) { const auto rr = __builtin_amdgcn_permlane32_swap(__float_as_uint(v), __float_as_uint(v), false, false); return __uint_as_float(rr[0]) + __uint_as_float(rr[1]); }
__device__ __forceinline__ float max3f(float a, float b, float c) { float r; asm("v_max3_f32 %0, %1, %2, %3" : "=v"(r) : "v"(a), "v"(b), "v"(c)); return r; }
__device__ __forceinline__ int sigma32(int i) { return (i & 19) | ((i & 4) << 1) | ((i & 8) >> 1); }
__device__ __forceinline__ int key_of(int kb, int r, int h) { return 32 * kb + 16 * (r >> 3) + 8 * h + 4 * ((r >> 2) & 1) + (r & 3); }

template <int NDS>
__device__ __forceinline__ void qk_tile(f32x16& s0, f32x16& s1, const lds_u8* Kt, int c0, const bf16x8* qf, const f32x16& negm, int lane) {
    const int k0 = sigma32(lane & 31), h = lane >> 5; const lds_u8* b0 = Kt + k0 * 128; const lds_u8* b1 = b0 + 32 * 128; const int sw = (k0 >> 1) & 7;
    bf16x8 a0[NDS], a1[NDS];
#pragma unroll
    for (int ds = 0; ds < NDS; ++ds) { const int off = ((c0 + 2 * ds + h) ^ sw) << 4; a0[ds] = lds128(b0 + off); a1[ds] = lds128(b1 + off); }
    s0 = __builtin_amdgcn_mfma_f32_32x32x16_bf16(a0[0], qf[0], negm, 0, 0, 0); s1 = __builtin_amdgcn_mfma_f32_32x32x16_bf16(a1[0], qf[0], negm, 0, 0, 0);
#pragma unroll
    for (int ds = 1; ds < NDS; ++ds) { s0 = __builtin_amdgcn_mfma_f32_32x32x16_bf16(a0[ds], qf[ds], s0, 0, 0, 0); s1 = __builtin_amdgcn_mfma_f32_32x32x16_bf16(a1[ds], qf[ds], s1, 0, 0, 0); }
}
__device__ __forceinline__ void softmax_pv(f32x16& s0, f32x16& s1, float& m, float& l, f32x16& negm, f32x16& o0, f32x16& o1, const lds_u8* Vt, int lane) {
    float mx = max3f(s0[0], s1[0], s0[1]), my = max3f(s1[1], s0[2], s1[2]);
#pragma unroll
    for (int r = 3; r < 15; r += 2) { mx = max3f(mx, s0[r], s1[r]); my = max3f(my, s0[r + 1], s1[r + 1]); }
    mx = max3f(mx, s0[15], s1[15]); mx = fmaxf(mx, my);
    mx = xmax32(mx);
    if (__any(mx > 0.f)) {
        const float dl = fmaxf(mx, 0.f); m += dl; const float al = __builtin_amdgcn_exp2f(-dl); l *= al;
#pragma unroll
        for (int r = 0; r < 16; ++r) { o0[r] *= al; o1[r] *= al; s0[r] -= dl; s1[r] -= dl; negm[r] = -m; }
    }
    const int h = lane >> 5, d = lane & 31; const lds_u8* v0 = Vt + d * 128; const lds_u8* v1 = v0 + 32 * 128; const int sw = (d >> 1) & 7;
    bf16x8 va[4], vb[4];
#pragma unroll
    for (int c = 0; c < 4; ++c) { const int off = ((2 * c + h) ^ sw) << 4; va[c] = lds128(v0 + off); vb[c] = lds128(v1 + off); }
    f32x2 ps = {0.f, 0.f}, pt = {0.f, 0.f};
#pragma unroll
    for (int r = 0; r < 16; r += 2) { s0[r] = __builtin_amdgcn_exp2f(s0[r]); s0[r + 1] = __builtin_amdgcn_exp2f(s0[r + 1]); s1[r] = __builtin_amdgcn_exp2f(s1[r]); s1[r + 1] = __builtin_amdgcn_exp2f(s1[r + 1]);
        ps += (f32x2){s0[r], s0[r + 1]}; pt += (f32x2){s1[r], s1[r + 1]}; }
    ps += pt; l += ps[0] + ps[1];
#pragma unroll
    for (int c = 0; c < 4; ++c) {
        const f32x16& s = (c >> 1) ? s1 : s0; const int b = 8 * (c & 1);
        u32x4 pw; pw.x = cvt_pk_bf16(s[b + 0], s[b + 1]); pw.y = cvt_pk_bf16(s[b + 2], s[b + 3]); pw.z = cvt_pk_bf16(s[b + 4], s[b + 5]); pw.w = cvt_pk_bf16(s[b + 6], s[b + 7]);
        const bf16x8 pf = __builtin_bit_cast(bf16x8, pw);
        o0 = __builtin_amdgcn_mfma_f32_32x32x16_bf16(va[c], pf, o0, 0, 0, 0);
        o1 = __builtin_amdgcn_mfma_f32_32x32x16_bf16(vb[c], pf, o1, 0, 0, 0);
    }
}
__device__ __forceinline__ void softmax_pv_abs(f32x16& s0, f32x16& s1, float& m, float& l, f32x16& o0, f32x16& o1, const lds_u8* Vt, int lane) {
    float mx = max3f(s0[0], s1[0], s0[1]), my = max3f(s1[1], s0[2], s1[2]);
#pragma unroll
    for (int r = 3; r < 15; r += 2) { mx = max3f(mx, s0[r], s1[r]); my = max3f(my, s0[r + 1], s1[r + 1]); }
    mx = max3f(mx, s0[15], s1[15]); mx = fmaxf(mx, my);
    mx = xmax32(mx);
    if (__any(mx > m)) { const float mn = fmaxf(m, mx); const float al = __builtin_amdgcn_exp2f(m - mn); l *= al;
#pragma unroll
        for (int r = 0; r < 16; ++r) { o0[r] *= al; o1[r] *= al; }
        m = mn; }
    const int h = lane >> 5, d = lane & 31; const lds_u8* v0 = Vt + d * 128; const lds_u8* v1 = v0 + 32 * 128; const int sw = (d >> 1) & 7;
    bf16x8 va[4], vb[4];
#pragma unroll
    for (int c = 0; c < 4; ++c) { const int off = ((2 * c + h) ^ sw) << 4; va[c] = lds128(v0 + off); vb[c] = lds128(v1 + off); }
    f32x2 ps = {0.f, 0.f}, pt = {0.f, 0.f};
#pragma unroll
    for (int r = 0; r < 16; r += 2) { s0[r] = __builtin_amdgcn_exp2f(s0[r] - m); s0[r + 1] = __builtin_amdgcn_exp2f(s0[r + 1] - m); s1[r] = __builtin_amdgcn_exp2f(s1[r] - m); s1[r + 1] = __builtin_amdgcn_exp2f(s1[r + 1] - m);
        ps += (f32x2){s0[r], s0[r + 1]}; pt += (f32x2){s1[r], s1[r + 1]}; }
    ps += pt; l += ps[0] + ps[1];
#pragma unroll
    for (int c = 0; c < 4; ++c) {
        const f32x16& s = (c >> 1) ? s1 : s0; const int b = 8 * (c & 1);
        u32x4 pw; pw.x = cvt_pk_bf16(s[b + 0], s[b + 1]); pw.y = cvt_pk_bf16(s[b + 2], s[b + 3]); pw.z = cvt_pk_bf16(s[b + 4], s[b + 5]); pw.w = cvt_pk_bf16(s[b + 6], s[b + 7]);
        const bf16x8 pf = __builtin_bit_cast(bf16x8, pw);
        o0 = __builtin_amdgcn_mfma_f32_32x32x16_bf16(va[c], pf, o0, 0, 0, 0);
        o1 = __builtin_amdgcn_mfma_f32_32x32x16_bf16(vb[c], pf, o1, 0, 0, 0);
    }
}
struct UnitGeo {
    const GAS bf16_t* qkv; const GAS bf16_t* kcb; unsigned kso, vso, kco, vco; int T, ta, nself, ntile, q0, grp, fam, b, h;
};
template <int MODE>
__device__ __forceinline__ void unit_loop(lds_u8* lds, const UnitGeo& U, const GAS float* sm, GAS bf16_t* Obase, int orow0, int ocol, int l, int tid) {
    const int lane = tid & 63, w = __builtin_amdgcn_readfirstlane(tid >> 6), h5 = lane >> 5, ql = lane & 31;
    const int T = U.T, q0 = U.q0, nself = U.nself, ntile = U.ntile, ta = U.ta;
    const int Hq = U.fam == 1 ? 8 : 4;
    const size_t qo = U.fam == 0 ? QO_QA : (U.fam == 1 ? QO_QB : QO_QC); const size_t gq = U.fam == 1 ? GS8 : GS4;
    const int qw0 = q0 + 32 * w, qtok = qw0 + ql, qrow = qtok >> 6, qcol = qtok & 63;
    const GAS bf16_t* Qp = U.qkv + qo + U.grp * gq + ((size_t)(U.b * Hq + U.h) * T + qtok) * 64;
    bf16x8 qf[4];
#pragma unroll
    for (int ds = 0; ds < 4; ++ds) qf[ds] = *(const GAS bf16x8*)(Qp + 16 * ds + 8 * h5);
    const int r0w = min(max((qw0 >> 6) - 4, 0), 24), qsl = min(max(qcol - 8, 0), 48);
    constexpr float M_INIT = -1024.0f;
    float m0 = M_INIT, l0 = 0.f, m1 = M_INIT, l1 = 0.f;
    const f32x16 z = {0.f, 0.f, 0.f, 0.f, 0.f, 0.f, 0.f, 0.f, 0.f, 0.f, 0.f, 0.f, 0.f, 0.f, 0.f, 0.f};
    f32x16 oa0 = z, oa1 = z, ob0 = z, ob1 = z;
    f32x16 ng0;
#pragma unroll
    for (int r = 0; r < 16; ++r) ng0[r] = -M_INIT;
    const int lrow = tid >> 3, lch = tid & 7; const int lds_off = lrow * 128 + ((lch ^ ((lrow >> 1) & 7)) << 4);
    u32x4 rA[2], rB[2];
    auto gload = [&](int ti_, u32x4& kr, u32x4& vr) {
        const int ti = min(ti_, ntile - 1);
        const bool self = ti < nself; const int tok0 = self ? 64 * (ta + ti) : 64 * (ti - nself); const int Tkv = self ? T : PAST;
        const GAS bf16_t* kp = (self ? U.qkv : U.kcb) + (self ? U.kso : U.kco); const GAS bf16_t* vp = (self ? U.qkv : U.kcb) + (self ? U.vso : U.vco);
        kr = *(const GAS u32x4*)(kp + (size_t)(tok0 + lrow) * 64 + lch * 8);
        vr = *(const GAS u32x4*)(vp + (size_t)lrow * Tkv + tok0 + lch * 8);
    };
    auto tile = [&](int ti, const lds_u8* Kt) {
        const lds_u8* Vt = Kt + 8192;
        const bool self = ti < nself; const int tok0 = 64 * (ta + ti);
        bool rel = true, msk = false;
        if (MODE == 1 && self) { const int kr = ta + ti; rel = (kr >= r0w) && (kr <= r0w + 7); msk = true; }
        if (MODE == 2 && self) { rel = (tok0 + 63 >= qw0 - 128) && (tok0 <= qw0 + 31 + 128); msk = !((tok0 >= qw0 + 31 - 128) && (tok0 + 63 <= qw0 + 128)); }
        if (rel) {
            if (MODE != 3) {
                f32x16 s0, s1; qk_tile<4>(s0, s1, Kt, 0, qf, ng0, lane);
                if (MODE == 1 && msk) {
                    const int kr = ta + ti; const LAS float* bt = (const LAS float*)(lds + LDS_RPB) + (kr - qrow + 7) * 31 + 15 - qcol;
                    float b0[16], b1[16];
#pragma unroll
                    for (int r = 0; r < 16; ++r) { const int kc0 = key_of(0, r, h5); b0[r] = bt[min(max(kc0, qsl), qsl + 15)]; b1[r] = bt[min(max(kc0 + 32, qsl), qsl + 15)]; }
#pragma unroll
                    for (int r = 0; r < 16; ++r) { const int kc0 = key_of(0, r, h5), kc1 = kc0 + 32;
                        s0[r] = ((kc0 >= qsl) && (kc0 < qsl + 16)) ? s0[r] + b0[r] : -INFINITY; s1[r] = ((kc1 >= qsl) && (kc1 < qsl + 16)) ? s1[r] + b1[r] : -INFINITY; }
                }
                if (MODE == 2 && msk) {
#pragma unroll
                    for (int r = 0; r < 16; ++r) { const int k0 = tok0 + key_of(0, r, h5), k1 = k0 + 32;
                        s0[r] = (abs(k0 - qtok) > 128) ? -INFINITY : s0[r]; s1[r] = (abs(k1 - qtok) > 128) ? -INFINITY : s1[r]; }
                }
                softmax_pv(s0, s1, m0, l0, ng0, oa0, oa1, Vt, lane);
            } else {
                { f32x16 s0, s1; qk_tile<2>(s0, s1, Kt, 0, qf, z, lane); softmax_pv_abs(s0, s1, m0, l0, oa0, oa1, Vt, lane); }
                { f32x16 s0, s1; qk_tile<2>(s0, s1, Kt, 4, qf + 2, z, lane); softmax_pv_abs(s0, s1, m1, l1, ob0, ob1, Vt, lane); }
            }
        }
    };
    auto step = [&](int ti, u32x4 (&W)[2], u32x4 (&L)[2]) {
        gload(ti + 2, L[0], L[1]);
        __builtin_amdgcn_sched_barrier(0);
        tile(ti, lds + (ti & 1) * LDS_TILE);
        if (ti + 1 < ntile) { lds_u8* nb = lds + ((ti + 1) & 1) * LDS_TILE; *(LAS u32x4*)(nb + lds_off) = W[0]; *(LAS u32x4*)(nb + 8192 + lds_off) = W[1]; }
        __syncthreads();
    };
    gload(0, rB[0], rB[1]);
    gload(1, rA[0], rA[1]);
    *(LAS u32x4*)(lds + lds_off) = rB[0]; *(LAS u32x4*)(lds + 8192 + lds_off) = rB[1];
    __syncthreads();
    for (int ti = 0; ti < ntile; ti += 2) {
        step(ti, rA, rB);
        if (ti + 1 < ntile) step(ti + 1, rB, rA);
    }
    float lt0 = xsum32(l0);
    if (U.fam == 1) lt0 += __builtin_amdgcn_exp2f(sm[SM_SINK + l * 8 + U.h] - m0);
    const float i0 = 1.0f / lt0;
    lds_u8* stg = lds + w * 4096 + ql * 128;
    if (MODE != 3) {
#pragma unroll
        for (int g = 0; g < 4; ++g) {
            u32x2 wa, wb; wa.x = cvt_pk_bf16(oa0[4 * g] * i0, oa0[4 * g + 1] * i0); wa.y = cvt_pk_bf16(oa0[4 * g + 2] * i0, oa0[4 * g + 3] * i0);
            wb.x = cvt_pk_bf16(oa1[4 * g] * i0, oa1[4 * g + 1] * i0); wb.y = cvt_pk_bf16(oa1[4 * g + 2] * i0, oa1[4 * g + 3] * i0);
            *(LAS u32x2*)(stg + ((g ^ (ql & 7)) << 4) + 8 * h5) = wa; *(LAS u32x2*)(stg + (((4 + g) ^ (ql & 7)) << 4) + 8 * h5) = wb;
        }
    } else {
        const float lam_init = l == 0 ? 0.2f : (l == 1 ? 0.35550906759f : (l == 2 ? 0.47071301835f : 0.55605820416f));
        const float lt1 = xsum32(l1); const float i1 = 1.0f / lt1; const float lam = sm[SM_LAM + l];
        float ss = 0.f;
#pragma unroll
        for (int r = 0; r < 16; ++r) { oa0[r] = oa0[r] * i0 - lam * (ob0[r] * i1); oa1[r] = oa1[r] * i0 - lam * (ob1[r] * i1); ss += oa0[r] * oa0[r] + oa1[r] * oa1[r]; }
        ss = xsum32(ss);
        const float rn = __builtin_amdgcn_rsqf(ss * (1.f / 64.f) + 1e-6f) * (1.0f - lam_init);
        const GAS float* sg = sm + SM_SUBG + l * 64 + 4 * h5;
#pragma unroll
        for (int g = 0; g < 4; ++g) {
            const f32x4 ga = *(const GAS f32x4*)(sg + 8 * g), gb = *(const GAS f32x4*)(sg + 32 + 8 * g);
            u32x2 wa, wb; wa.x = cvt_pk_bf16(oa0[4 * g] * rn * ga[0], oa0[4 * g + 1] * rn * ga[1]); wa.y = cvt_pk_bf16(oa0[4 * g + 2] * rn * ga[2], oa0[4 * g + 3] * rn * ga[3]);
            wb.x = cvt_pk_bf16(oa1[4 * g] * rn * gb[0], oa1[4 * g + 1] * rn * gb[1]); wb.y = cvt_pk_bf16(oa1[4 * g + 2] * rn * gb[2], oa1[4 * g + 3] * rn * gb[3]);
            *(LAS u32x2*)(stg + ((g ^ (ql & 7)) << 4) + 8 * h5) = wa; *(LAS u32x2*)(stg + (((4 + g) ^ (ql & 7)) << 4) + 8 * h5) = wb;
        }
    }
    asm volatile("s_waitcnt lgkmcnt(0)" ::: "memory");
    {
        const int ch = lane & 7; GAS bf16_t* ob = Obase + (size_t)(orow0 + qw0) * 1024 + ocol + 8 * ch;
#pragma unroll
        for (int j = 0; j < 4; ++j) { const int row = (lane >> 3) + 8 * j;
            const u32x4 v = *(const LAS u32x4*)(lds + w * 4096 + row * 128 + ((ch ^ (row & 7)) << 4));
            *(GAS u32x4*)(ob + (size_t)row * 1024) = v; }
    }
}

__device__ __forceinline__ void attn_phase(lds_u8* lds, const Ctx& C) {
    const int l = C.l;
    for (;;) {
        __syncthreads();
        unsigned char* ws_ = C.ws; asm volatile("" : "+s"(ws_)); GAS unsigned char* ws = (GAS unsigned char*)ws_;
        const int tid = opaque_tid();
        if (tid == 0) *(LAS unsigned*)(lds + LDS_NEXT) = __hip_atomic_fetch_add((GAS unsigned*)(ws + WS_CTL) + 64 * (1 + l) + C.rep, 1u, __ATOMIC_RELAXED, __HIP_MEMORY_SCOPE_AGENT);
        __syncthreads();
        const int idx = (int)*(LAS unsigned*)(lds + LDS_NEXT);
#ifdef ATT_PROBE_LIMIT
        if (idx >= (C.rep ? ATT_PROBE_LIMIT : NUNITS)) break;
#else
        if (idx >= NUNITS) break;
#endif
        const GAS float* sm = (const GAS float*)(ws + WS_LAM);
        GAS unsigned* qa_done = (GAS unsigned*)(ws + WS_CTL) + 64 * (8 + l);
        if (idx < NGEMM) {
            pg8::Gemm g{(const bf16_t*)(ws_ + WS_XA), (const bf16_t*)(ws_ + WS_WIN) + (size_t)l * DIN * 1024, MTOT, 256, 1024}; pg8::OneUnit S1{idx};
            pg8::EpiIn E{ws_, C.out, l, 0};
            pg8::gemm_phase<pg8::EpiIn, pg8::OneUnit, true, true>(lds, g, S1, E);
            asm volatile("s_waitcnt vmcnt(0)" ::: "memory");
            __syncthreads();
            if (tid == 0) { __builtin_amdgcn_fence(__ATOMIC_RELEASE, "agent"); asm volatile("s_waitcnt vmcnt(0)" ::: "memory"); __hip_atomic_fetch_add(qa_done, 1u, __ATOMIC_RELAXED, __HIP_MEMORY_SCOPE_AGENT); }
            continue;
        }
        UnitGeo U; U.qkv = (const GAS bf16_t*)(ws + WS_QKV); U.kcb = (const GAS bf16_t*)(ws + WS_KC);
        int fam, grp, b, h, qb; const int iu = idx - NGEMM;
        if (iu < 128) { fam = 2; grp = 1; b = iu >> 5; h = (iu >> 3) & 3; qb = iu & 7; }
        else if (iu < 256 || (iu >= 384 && iu < 512)) { const int i = iu < 256 ? iu - 128 : iu - 256; fam = 1; grp = 1; b = i >> 6; h = (i >> 3) & 7; qb = i & 7; }
        else if (iu < 384) { const int i = iu - 256; fam = 0; grp = 1; b = i >> 5; h = (i >> 3) & 3; qb = i & 7; }
        else if (iu < 640) { const int i = iu - 512; fam = 2; grp = 0; b = i >> 2; h = i & 3; qb = 0; }
        else if (iu < 896) { const int i = iu - 640; fam = 1; grp = 0; b = i >> 3; h = i & 7; qb = 0; }
        else { const int i = iu - 896; fam = 0; grp = 0; b = i >> 2; h = i & 3; qb = 0; }
        const int q0 = qb * 256;
        if (fam == 0) {
            if (tid == 0) { unsigned sp = 0; while (__hip_atomic_load(qa_done, __ATOMIC_RELAXED, __HIP_MEMORY_SCOPE_AGENT) < (unsigned)NGEMM * (C.rep + 1) && ++sp < (1u << 22)) __builtin_amdgcn_s_sleep(2);
                __builtin_amdgcn_fence(__ATOMIC_ACQUIRE, "agent"); asm volatile("s_waitcnt vmcnt(0)" ::: "memory"); }
            __syncthreads();
        }
        const int T = grp ? TLAT : TCTX, Hkv = fam == 1 ? 2 : 4, hk = fam == 1 ? (h >> 2) : h;
        const size_t ko = fam == 0 ? QO_KA : (fam == 1 ? QO_KB : QO_KC), vo = fam == 0 ? QO_VTA : (fam == 1 ? QO_VTB : QO_VTC); const size_t gk = fam == 1 ? GS2 : GS4;
        U.kso = (unsigned)(ko + grp * gk + (size_t)(b * Hkv + hk) * T * 64); U.vso = (unsigned)(vo + grp * gk + (size_t)(b * Hkv + hk) * 64 * T);
        const size_t cko = fam == 0 ? CO_KA : (fam == 1 ? CO_KB : CO_KCC), cvo = fam == 0 ? CO_VTA : (fam == 1 ? CO_VTB : CO_VTCC);
        U.kco = (unsigned)(cko + (size_t)((l * 4 + b) * Hkv + hk) * PAST * 64); U.vco = (unsigned)(cvo + (size_t)((l * 4 + b) * Hkv + hk) * 64 * PAST);
        int ta, tb;
        if (!grp) { ta = 0; tb = 4; }
        else if (fam == 0) { ta = max(4 * qb - 4, 0); tb = min(max(4 * qb - 1, 0), 24) + 8; }
        else if (fam == 1) { ta = max(q0 - 128, 0) >> 6; tb = min(q0 + 384, TLAT) >> 6; }
        else { ta = 0; tb = 32; }
        U.T = T; U.ta = ta; U.nself = tb - ta; U.ntile = U.nself + (grp ? 8 : 0); U.q0 = q0; U.grp = grp; U.fam = fam; U.b = b; U.h = h;
        GAS bf16_t* Obase = (GAS bf16_t*)(ws + WS_O); const int orow0 = grp ? MCTX + b * TLAT : b * TCTX, ocol = (fam == 0 ? 0 : (fam == 1 ? 256 : 768)) + 64 * h;
        if (fam == 2) unit_loop<3>(lds, U, sm, Obase, orow0, ocol, l, tid);
        else if (!grp) unit_loop<0>(lds, U, sm, Obase, orow0, ocol, l, tid);
        else if (fam == 0) { if (tid < 465) *(LAS float*)(lds + LDS_RPB + 4 * tid) = sm[SM_RPB + (l * 4 + h) * 465 + tid]; unit_loop<1>(lds, U, sm, Obase, orow0, ocol, l, tid); }
        else unit_loop<2>(lds, U, sm, Obase, orow0, ocol, l, tid);
    }
}
}
namespace misc {
typedef LAS unsigned char lds_u8;
__device__ __forceinline__ float wave_sum(float v) {
#pragma unroll
    for (int o = 1; o < 64; o <<= 1) v += __shfl_xor(v, o);
    return v;
}
__device__ const double INVB[16] = {1.0, 0.5623413251903491, 0.31622776601683794, 0.1778279410038923, 0.1, 0.05623413251903491, 0.03162277660168379, 0.01778279410038923,
                                    0.01, 0.005623413251903491, 0.0031622776601683794, 0.001778279410038923, 0.001, 0.0005623413251903491, 0.00031622776601683794, 0.0001778279410038923};
__device__ const double INVC[8] = {1.0, 0.31622776601683794, 0.1, 0.03162277660168379, 0.01, 0.0031622776601683794, 0.001, 0.00031622776601683794};
__device__ __forceinline__ void sincos_d(double a, float& c, float& s) {
    const double k = rint(a * 0.6366197723675814);
    double r = fma(-k, 1.5707963267948966, a); r = fma(-k, 6.123233995736766e-17, r);
    const double r2 = r * r;
    const double sp = r * (1.0 + r2 * (-1.0 / 6.0 + r2 * (1.0 / 120.0 + r2 * (-1.0 / 5040.0 + r2 * (1.0 / 362880.0 + r2 * (-1.0 / 39916800.0 + r2 * (1.0 / 6227020800.0)))))));
    const double cp = 1.0 + r2 * (-0.5 + r2 * (1.0 / 24.0 + r2 * (-1.0 / 720.0 + r2 * (1.0 / 40320.0 + r2 * (-1.0 / 3628800.0 + r2 * (1.0 / 479001600.0 + r2 * (-1.0 / 87178291200.0)))))));
    const int q = ((int)k) & 3;
    const double cc = (q == 0) ? cp : (q == 1) ? -sp : (q == 2) ? -cp : sp;
    const double ss = (q == 0) ? sp : (q == 1) ? cp : (q == 2) ? -sp : -cp;
    c = (float)cc; s = (float)ss;
}
__device__ __forceinline__ void transpose_item(const float* W, int K, int N, bf16_t* WT, int k0, int n0, int dst0, LAS float* scr, int lane) {
    const int kr = lane >> 3, c4 = (lane & 7) * 4; f32x4 v[8];
#pragma unroll
    for (int i = 0; i < 8; ++i) v[i] = *(const f32x4*)(W + (size_t)(k0 + 8 * i + kr) * N + n0 + c4);
#pragma unroll
    for (int i = 0; i < 8; ++i) { LAS float* d = scr + (8 * i + kr) * 33 + c4; d[0] = v[i][0]; d[1] = v[i][1]; d[2] = v[i][2]; d[3] = v[i][3]; }
    asm volatile("s_waitcnt lgkmcnt(0)" ::: "memory");
    const int c = lane & 7;
#pragma unroll
    for (int j = 0; j < 4; ++j) { const int n = (lane >> 3) + 8 * j; const LAS float* s = scr + (8 * c) * 33 + n;
        u32x4 o; o.x = cvt_pk_bf16(s[0 * 33], s[1 * 33]); o.y = cvt_pk_bf16(s[2 * 33], s[3 * 33]); o.z = cvt_pk_bf16(s[4 * 33], s[5 * 33]); o.w = cvt_pk_bf16(s[6 * 33], s[7 * 33]);
        *(u32x4*)(WT + (size_t)(dst0 + n) * K + k0 + 8 * c) = o; }
    asm volatile("s_waitcnt lgkmcnt(0)" ::: "memory");
}
__device__ __forceinline__ void trb_item(const float* W, int N, bf16_t* WT, int n0, int dst0, const LAS float* vec, LAS float* scr, LAS float* red, float* out, int ostride, int tid) {
    const int lane = tid & 63, wave = __builtin_amdgcn_readfirstlane(tid >> 6), kr = lane >> 3, c4 = (lane & 7) * 4, c = lane & 7;
    f32x4 a0 = {0.f, 0.f, 0.f, 0.f}, a1 = a0, a2 = a0, a3 = a0, a4 = a0;
#pragma unroll 1
    for (int h = 0; h < 2; ++h) { const int k0 = 128 * wave + 64 * h; f32x4 v[8];
#pragma unroll
        for (int i = 0; i < 8; ++i) v[i] = *(const f32x4*)(W + (size_t)(k0 + 8 * i + kr) * N + n0 + c4);
#pragma unroll
        for (int i = 0; i < 8; ++i) { const LAS float* vp = vec + k0 + 8 * i + kr; a0 += v[i] * vp[0]; a1 += v[i] * vp[1024]; a2 += v[i] * vp[2048]; a3 += v[i] * vp[3072]; a4 += v[i] * vp[4096];
            LAS float* d = scr + (8 * i + kr) * 33 + c4; d[0] = v[i][0]; d[1] = v[i][1]; d[2] = v[i][2]; d[3] = v[i][3]; }
        asm volatile("s_waitcnt lgkmcnt(0)" ::: "memory");
#pragma unroll
        for (int j = 0; j < 4; ++j) { const int n = (lane >> 3) + 8 * j; const LAS float* s = scr + (8 * c) * 33 + n;
            u32x4 o; o.x = cvt_pk_bf16(s[0 * 33], s[1 * 33]); o.y = cvt_pk_bf16(s[2 * 33], s[3 * 33]); o.z = cvt_pk_bf16(s[4 * 33], s[5 * 33]); o.w = cvt_pk_bf16(s[6 * 33], s[7 * 33]);
            *(u32x4*)(WT + (size_t)(dst0 + n) * 1024 + k0 + 8 * c) = o; }
        asm volatile("s_waitcnt lgkmcnt(0)" ::: "memory");
    }
#define TRB_RED(a) do { _Pragma("unroll") for (int j = 0; j < 4; ++j) { float s = a[j]; s += __shfl_xor(s, 8); s += __shfl_xor(s, 16); s += __shfl_xor(s, 32); a[j] = s; } } while (0)
    TRB_RED(a0); TRB_RED(a1); TRB_RED(a2); TRB_RED(a3); TRB_RED(a4);
#undef TRB_RED
    if (lane < 8) { LAS float* r = red + wave * 160 + c4; *(LAS f32x4*)(r) = a0; *(LAS f32x4*)(r + 32) = a1; *(LAS f32x4*)(r + 64) = a2; *(LAS f32x4*)(r + 96) = a3; *(LAS f32x4*)(r + 128) = a4; }
    __syncthreads();
    if (tid < 160) { const int b = tid >> 5, cc = tid & 31; float s = 0.f;
#pragma unroll
        for (int w = 0; w < 8; ++w) s += red[w * 160 + b * 32 + cc];
        out[(size_t)b * ostride + n0 + cc] = s; }
}
__device__ __forceinline__ void gemv5_item(const float* W, int N, int n0, const LAS float* vec, LAS float* red, const float* add, float* out, int ostride, int tid) {
    const int c4 = (tid & 15) * 4, kq = tid >> 4; f32x4 a0 = {0.f, 0.f, 0.f, 0.f}, a1 = a0, a2 = a0, a3 = a0, a4 = a0;
    const float* wp = W + (size_t)(kq * 32) * N + n0 + c4; const LAS float* vp = vec + kq * 32;
#pragma unroll 16
    for (int k = 0; k < 32; ++k) { const f32x4 w = *(const f32x4*)(wp + (size_t)k * N); a0 += w * vp[k]; a1 += w * vp[1024 + k]; a2 += w * vp[2048 + k]; a3 += w * vp[3072 + k]; a4 += w * vp[4096 + k]; }
    *(LAS f32x4*)(red + (kq * 5 + 0) * 64 + c4) = a0; *(LAS f32x4*)(red + (kq * 5 + 1) * 64 + c4) = a1; *(LAS f32x4*)(red + (kq * 5 + 2) * 64 + c4) = a2; *(LAS f32x4*)(red + (kq * 5 + 3) * 64 + c4) = a3; *(LAS f32x4*)(red + (kq * 5 + 4) * 64 + c4) = a4;
    __syncthreads();
    if (tid < 320) { const int b = tid >> 6, c = tid & 63; float s = add ? add[n0 + c] : 0.f;
#pragma unroll
        for (int q = 0; q < 32; ++q) s += red[(q * 5 + b) * 64 + c];
        out[(size_t)b * ostride + n0 + c] = s; }
    __syncthreads();
}

__device__ __forceinline__ void phase_tables(const Args& a) {
    const int gtid = blockIdx.x * 512 + opaque_tid(), NT = gridDim.x * 512; unsigned char* ws = a.ws;
    float* sm = (float*)(ws + WS_LAM);
    if (gtid < 4) { const int l = gtid; const float* lp = a.in[I_LAMBDA] + l * 128; float s1 = 0.f, s2 = 0.f;
        for (int i = 0; i < 32; ++i) { s1 += lp[i] * lp[32 + i]; s2 += lp[64 + i] * lp[96 + i]; }
        sm[SM_LAM + l] = expf(s1) - expf(s2) + (0.8f - 0.6f * expf(-0.3f * (float)l)); }
    for (int i = gtid; i < 1280; i += NT) { const int l = i / 320, r = i % 320; sm[SM_GAINS + i] = r < 128 ? a.in[I_NAG][l * 128 + r] : (r < 256 ? a.in[I_SWG][l * 128 + r - 128] : a.in[I_DAG][l * 64 + r - 256]); }
    for (int i = gtid; i < 7440; i += NT) sm[SM_RPB + i] = a.in[I_RPB][i] * LOG2E;
    for (int i = gtid; i < 32; i += NT) sm[SM_SINK + i] = a.in[I_SINK][i] * LOG2E;
    for (int i = gtid; i < 256; i += NT) sm[SM_SUBG + i] = a.in[I_SUBG][i];
    float* cv = (float*)(ws + WS_CONV);
    for (int i = gtid; i < 4 * 4 * DUP; i += NT) { const int c = i % DUP, j = (i / DUP) & 3, l = i / (4 * DUP); cv[i] = j < 3 ? a.in[I_CONVW][(size_t)(l * 3 + j) * DUP + c] : a.in[I_CONVB][(size_t)l * DUP + c]; }
    float* rb = (float*)(ws + WS_ROPEB); float* rc = (float*)(ws + WS_ROPEC);
    for (int i = gtid; i < 2048 * 32; i += NT) { const int t = i >> 5, j = i & 31; const double pos = (double)(j < 16 ? (t >> 6) : (t & 63)); float c, s; sincos_d(pos * INVB[j & 15], c, s); rb[2 * i] = c; rb[2 * i + 1] = s; }
    for (int i = gtid; i < 2048 * 16; i += NT) { const int t = i >> 4, j = i & 15; const double pos = (double)(j < 8 ? (t >> 6) : (t & 63)); float c, s; sincos_d(pos * INVC[j & 7], c, s); rc[2 * i] = c; rc[2 * i + 1] = s; }
}
constexpr int N_TR_IN = 144, N_TR_OUT = 64, N_TR_UP = 352, N_TR_DN = 176, N_MOD = 96, N_BIAS_IN = 36, N_BIAS_UP = 88, N_CACHE = 640;
__device__ __forceinline__ void fl_tr(lds_u8* lds, const Args& a, int l, int which, int bi, int tid) {
    const int lane = tid & 63, wave = __builtin_amdgcn_readfirstlane(tid >> 6); LAS float* scr = (LAS float*)(lds + wave * 16384); unsigned char* ws = a.ws; const int r = bi * 8 + wave;
    if (which == 0) { const int kb = r / 72, nb = r % 72, n0 = 32 * nb; const int tile = n0 >> 8, L = n0 & 255, wc = L >> 6, bj = (L >> 5) & 1; const int dst0 = 256 * tile + 128 * bj + 32 * wc;
        transpose_item(a.in[I_WIN] + (size_t)l * 1024 * DIN, 1024, DIN, (bf16_t*)(ws + WS_WIN) + (size_t)l * DIN * 1024, 64 * kb, n0, dst0, scr, lane); }
    else if (which == 1) { const int kb = r / 32, nb = r % 32; transpose_item(a.in[I_WOUT] + (size_t)l * 1024 * 1024, 1024, 1024, (bf16_t*)(ws + WS_WOUT) + (size_t)l * 1024 * 1024, 64 * kb, 32 * nb, 32 * nb, scr, lane); }
    else if (which == 2) { const int kb = r / 176, nb = r % 176, n0 = 32 * nb; const int nn = n0 < DFF ? n0 : n0 - DFF; const int dst0 = 256 * (nn >> 7) + (n0 < DFF ? 0 : 128) + (nn & 127);
        transpose_item(a.in[I_WUP] + (size_t)l * 1024 * DUP, 1024, DUP, (bf16_t*)(ws + WS_WUP) + (size_t)l * DUP * 1024, 64 * kb, n0, dst0, scr, lane); }
    else { const int kb = r / 32, nb = r % 32; transpose_item(a.in[I_WDOWN] + (size_t)l * DFF * 1024, DFF, 1024, (bf16_t*)(ws + WS_WDOWN) + (size_t)l * 1024 * DFF, 64 * kb, 32 * nb, 32 * nb, scr, lane); }
}
__device__ __forceinline__ void fl_trb(lds_u8* lds, const Args& a, int l, int which, int strip, int tid) {
    const int wave = __builtin_amdgcn_readfirstlane(tid >> 6); unsigned char* ws = a.ws; const float* mod = (const float*)(ws + WS_MOD);
    LAS float* scr = (LAS float*)(lds + wave * 8704); LAS float* vec = (LAS float*)(lds + 73728); LAS float* red = (LAS float*)(lds + 94208);
    for (int i = tid; i < 5120; i += 512) { const int b5 = i >> 10, k = i & 1023; vec[i] = mod[((size_t)(l * 5 + b5) * 6 + (which ? 3 : 0)) * 1024 + k]; }
    __syncthreads();
    const int n0 = 32 * strip;
    if (!which) { const int tile = n0 >> 8, L = n0 & 255, wc = L >> 6, bj = (L >> 5) & 1; const int dst0 = 256 * tile + 128 * bj + 32 * wc;
        trb_item(a.in[I_WIN] + (size_t)l * 1024 * DIN, DIN, (bf16_t*)(ws + WS_WIN) + (size_t)l * DIN * 1024, n0, dst0, vec, scr, red, (float*)(ws + WS_BIASIN) + (size_t)l * 5 * DIN, DIN, tid); }
    else { const int nn = n0 < DFF ? n0 : n0 - DFF; const int dst0 = 256 * (nn >> 7) + (n0 < DFF ? 0 : 128) + (nn & 127);
        trb_item(a.in[I_WUP] + (size_t)l * 1024 * DUP, DUP, (bf16_t*)(ws + WS_WUP) + (size_t)l * DUP * 1024, n0, dst0, vec, scr, red, (float*)(ws + WS_BIASUP) + (size_t)l * 5 * DUP, DUP, tid); }
}
__device__ __forceinline__ void fl_mod(lds_u8* lds, const Args& a, int l, int g, int tid) {
    LAS float* vec = (LAS float*)lds; LAS float* red = (LAS float*)(lds + 20480);
    for (int i = tid; i < 5120; i += 512) { const int b5 = i >> 10, k = i & 1023; const float v = b5 == 0 ? a.in[I_CCTX][k] : a.in[I_C][(b5 - 1) * 1024 + k]; vec[i] = v / (1.f + __expf(-v)); }
    __syncthreads();
    gemv5_item(a.in[I_WMOD] + (size_t)l * 1024 * 6144, 6144, 64 * g, vec, red, a.in[I_BMOD] + l * 6144, (float*)(a.ws + WS_MOD) + (size_t)l * 5 * 6144, 6144, tid);
}
__device__ __forceinline__ void fl_bias(lds_u8* lds, const Args& a, int l, int which, int g, int tid) {
    LAS float* vec = (LAS float*)lds; LAS float* red = (LAS float*)(lds + 20480); const float* mod = (const float*)(a.ws + WS_MOD);
    for (int i = tid; i < 5120; i += 512) { const int b5 = i >> 10, k = i & 1023; vec[i] = mod[((size_t)(l * 5 + b5) * 6 + (which ? 3 : 0)) * 1024 + k]; }
    __syncthreads();
    if (!which) gemv5_item(a.in[I_WIN] + (size_t)l * 1024 * DIN, DIN, 64 * g, vec, red, nullptr, (float*)(a.ws + WS_BIASIN) + (size_t)l * 5 * DIN, DIN, tid);
    else gemv5_item(a.in[I_WUP] + (size_t)l * 1024 * DUP, DUP, 64 * g, vec, red, nullptr, (float*)(a.ws + WS_BIASUP) + (size_t)l * 5 * DUP, DUP, tid);
}
__device__ __forceinline__ void fl_gv(const Args& a, int l, int tid) {
    const float* mod = (const float*)(a.ws + WS_MOD); float* gv = (float*)(a.ws + WS_GV) + (size_t)l * 10240;
    for (int i = tid; i < 10240; i += 512) { const int c = i & 1023, which = (i >> 10) & 1, b5 = i >> 11;
        gv[i] = a.in[which ? I_GFFN : I_GATTN][l * 1024 + c] * (1.f + mod[((size_t)(l * 5 + b5) * 6 + (which ? 4 : 1)) * 1024 + c]); }
}
__device__ __forceinline__ void fl_cache(const Args& a, int l, int ci, int tid) {
    bf16_t* kc = (bf16_t*)(a.ws + WS_KC); int i = ci * 512 + tid;
    if (i < 163840) { const int fam = i < 65536 ? 0 : (i < 98304 ? 1 : 2); i -= fam == 0 ? 0 : (fam == 1 ? 65536 : 98304); const int H = fam == 1 ? 2 : 4;
        const float* ck = a.in[fam == 0 ? I_CNAK : (fam == 1 ? I_CSWK : I_CDAK)]; bf16_t* dk = kc + (fam == 0 ? CO_KA : (fam == 1 ? CO_KB : CO_KCC));
        const int d8 = i & 7, hh = (i >> 3) % H, p = (i / (8 * H)) & 511, b = i / (8 * H * 512);
        const float* s = ck + ((((size_t)b * 4 + l) * 512 + p) * H + hh) * 64 + d8 * 8; const f32x4 x = *(const f32x4*)s, y = *(const f32x4*)(s + 4);
        u32x4 o; o.x = cvt_pk_bf16(x[0], x[1]); o.y = cvt_pk_bf16(x[2], x[3]); o.z = cvt_pk_bf16(y[0], y[1]); o.w = cvt_pk_bf16(y[2], y[3]);
        *(u32x4*)(dk + ((((size_t)l * 4 + b) * H + hh) * 512 + p) * 64 + d8 * 8) = o; }
    else { i -= 163840; const int fam = i < 65536 ? 0 : (i < 98304 ? 1 : 2); i -= fam == 0 ? 0 : (fam == 1 ? 65536 : 98304); const int H = fam == 1 ? 2 : 4;
        const float* cv = a.in[fam == 0 ? I_CNAV : (fam == 1 ? I_CSWV : I_CDAV)]; bf16_t* dv = kc + (fam == 0 ? CO_VTA : (fam == 1 ? CO_VTB : CO_VTCC));
        const int d = i & 63, p8 = (i >> 6) & 63, hh = (i >> 12) % H, b = i / (4096 * H);
        const float* s = cv + ((((size_t)b * 4 + l) * 512 + p8 * 8) * H + hh) * 64 + d; float x[8];
#pragma unroll
        for (int j = 0; j < 8; ++j) x[j] = s[(size_t)j * H * 64];
        u32x4 o; o.x = cvt_pk_bf16(x[0], x[1]); o.y = cvt_pk_bf16(x[2], x[3]); o.z = cvt_pk_bf16(x[4], x[5]); o.w = cvt_pk_bf16(x[6], x[7]);
        *(u32x4*)(dv + ((((size_t)l * 4 + b) * H + hh) * 64 + d) * 512 + p8 * 8) = o; }
}
enum { SLOT_A = 0, SLOT_B = 1 };
__device__ __forceinline__ void fill_run(lds_u8* lds, const Args& a, int slot) {
    const int tid = opaque_tid();
    unsigned* counter = (unsigned*)(a.ws + WS_CTL) + 64 * (16 + slot);
    LAS unsigned* nxt = (LAS unsigned*)(lds + 131072 + 512);
    constexpr int N_TR_A = N_TR_OUT + N_TR_DN, N_TRB = 72 + 176;
    for (;;) {
        __syncthreads();
        if (tid == 0) *nxt = __hip_atomic_fetch_add(counter, 1u, __ATOMIC_RELAXED, __HIP_MEMORY_SCOPE_AGENT);
        __syncthreads();
        int i = (int)*nxt;
        if (slot == SLOT_A) {
            if (i < 4 * N_MOD) { fl_mod(lds, a, i / N_MOD, i % N_MOD, tid); continue; } i -= 4 * N_MOD;
            if (i < 4 * N_TR_A) { const int l = i / N_TR_A; int r = i % N_TR_A;
                if (r < N_TR_OUT) { fl_tr(lds, a, l, 1, r, tid); continue; } r -= N_TR_OUT;
                fl_tr(lds, a, l, 3, r, tid); continue; }
            i -= 4 * N_TR_A;
            if (i < 4 * N_CACHE) { fl_cache(a, i / N_CACHE, i % N_CACHE, tid); continue; }
            break;
        } else {
            if (i < 4) { fl_gv(a, i, tid); continue; } i -= 4;
            if (i < 4 * N_TRB) { const int l = i / N_TRB, r = i % N_TRB; if (r < 72) fl_trb(lds, a, l, 0, r, tid); else fl_trb(lds, a, l, 1, r - 72, tid); continue; }
            break;
        }
    }
}
__device__ __forceinline__ void phase_make_xa(const Args& a, int l, int which, int first) {
    const int tid = opaque_tid(), lane = tid & 63, wave = tid >> 6; unsigned char* ws = a.ws;
    const float* mod = (const float*)(ws + WS_MOD); bf16_t* xa = (bf16_t*)(ws + WS_XA); float* ssq = (float*)(ws + WS_SSQ);
    const float* gsrc = a.in[which ? I_GFFN : I_GATTN] + l * 1024;
    for (int row = blockIdx.x * 8 + wave; row < MTOT; row += gridDim.x * 8) {
        const float* src = first ? (row < MCTX ? a.in[I_XP] + (size_t)row * 1024 : a.in[I_XS] + (size_t)(row - MCTX) * 1024) : a.out + (size_t)row * 1024;
        const float* sc = mod + ((size_t)(l * 5 + row_b5(row)) * 6 + (which ? 4 : 1)) * 1024;
        f32x4 v[4]; float s = 0.f;
#pragma unroll
        for (int j = 0; j < 4; ++j) { v[j] = *(const f32x4*)(src + 256 * j + 4 * lane); s += (v[j][0] * v[j][0] + v[j][1] * v[j][1]) + (v[j][2] * v[j][2] + v[j][3] * v[j][3]); }
        s = wave_sum(s);
#pragma unroll
        for (int j = 0; j < 4; ++j) {
            const f32x4 g = *(const f32x4*)(gsrc + 256 * j + 4 * lane) * (*(const f32x4*)(sc + 256 * j + 4 * lane) + 1.0f);
            const f32x4 y = v[j] * g; u32x2 w; w.x = cvt_pk_bf16(y[0], y[1]); w.y = cvt_pk_bf16(y[2], y[3]); *(u32x2*)(xa + (size_t)row * 1024 + 256 * j + 4 * lane) = w; }
        if (lane < 4) ssq[(size_t)row * 4 + lane] = lane == 0 ? s : 0.f;
    }
}
}
constexpr int LDS_BYTES = 147456;
enum Phase { PH_MAKEXA = 2, PH_IN, PH_ATT, PH_OUT, PH_UP, PH_CONV, PH_DOWN };

constexpr int LDS_DUMMY = 131072 + 12288;
__device__ __forceinline__ void prefetch_panel(LAS unsigned char* lds, const bf16_t* tile, int K, int kbytes  ) {
    const int tid = opaque_tid(), wave = __builtin_amdgcn_readfirstlane(tid >> 6); const int segs = kbytes >> 7, nlines = 256 * segs;
    LAS unsigned* dst = (LAS unsigned*)(lds + LDS_DUMMY + wave * 256);
    for (int line = tid; line < nlines; line += 512) { const int row = line / segs, seg = line % segs;
        __builtin_amdgcn_global_load_lds((const unsigned*)((const char*)tile + (size_t)row * K * 2 + seg * 128), dst, 4, 0, 0); }
}
__device__ __forceinline__ void run_phase(LAS unsigned char* lds, const Args& a, int ph, int l, int p1, int p2) {
    unsigned char* ws = a.ws; const int G = gridDim.x;
    switch (ph) {
    case PH_MAKEXA: misc::phase_make_xa(a, l, p1, p2); break;
    case PH_IN: {
        pg8::Gemm g{(const bf16_t*)(ws + WS_XA), (const bf16_t*)(ws + WS_WIN) + (size_t)l * DIN * 1024 + (size_t)256 * 1024, MTOT, DIN - 256, 1024}; pg8::StaticOrder S; S.init(MTOT, DIN - 256, G, (int)blockIdx.x);
#ifdef TS_GEMM
        if (l == 1 && blockIdx.x == TS_BLOCK && TS_PHASE == ph) g.ts = (volatile unsigned long long*)(ws + WS_CTL + 512 * 1024);
#endif
        pg8::EpiIn E{ws, a.out, l, 1};
        pg8::gemm_phase<pg8::EpiIn, pg8::StaticOrder, true, true>(lds, g, S, E); } break;
    case PH_ATT: {
        att::Ctx C{ws, a.out, l, p1};
        att::attn_phase(lds, C); } break;
    case PH_OUT: {
        pg8::Gemm g{(const bf16_t*)(ws + WS_O), (const bf16_t*)(ws + WS_WOUT) + (size_t)l * 1024 * 1024, MTOT, 1024, 1024}; pg8::StaticOrder S; S.init(MTOT, 1024, G, (int)blockIdx.x);
#ifdef TS_GEMM
        if (l == 1 && blockIdx.x == TS_BLOCK && TS_PHASE == ph) g.ts = (volatile unsigned long long*)(ws + WS_CTL + 512 * 1024);
#endif
        pg8::EpiRes E{ws, a.out, l, 0, l == 0 ? a.in[I_XP] : nullptr, l == 0 ? a.in[I_XS] : nullptr};
#ifdef WARM_OUT
        { pg8::Unit u; if (S.next(0, u)) { prefetch_panel(lds, (const bf16_t*)(ws + WS_WOUT) + (size_t)l * 1024 * 1024 + (size_t)u.pn * 256 * 1024, 1024, 2048); prefetch_panel(lds, (const bf16_t*)(ws + WS_O) + (size_t)u.pm * 256 * 1024, 1024, 2048); }
          asm volatile("s_waitcnt vmcnt(0)" ::: "memory"); __syncthreads(); }
#endif
        pg8::gemm_phase<pg8::EpiRes, pg8::StaticOrder, false, true>(lds, g, S, E); } break;
    case PH_UP: {
        pg8::Gemm g{(const bf16_t*)(ws + WS_XA), (const bf16_t*)(ws + WS_WUP) + (size_t)l * DUP * 1024, MTOT, DUP, 1024}; pg8::UpOrder S; S.init_up(G, (int)blockIdx.x);
#ifdef TS_GEMM
        if (l == 1 && blockIdx.x == TS_BLOCK && TS_PHASE == ph) g.ts = (volatile unsigned long long*)(ws + WS_CTL + 512 * 1024);
#endif
        pg8::EpiUpConv E{ws, l};
        pg8::gemm_phase<pg8::EpiUpConv, pg8::UpOrder, true, true>(lds, g, S, E); } break;
    case PH_DOWN: {
        pg8::Gemm g{(const bf16_t*)(ws + WS_ACT), (const bf16_t*)(ws + WS_WDOWN) + (size_t)l * 1024 * DFF, MTOT, 1024, DFF}; pg8::StaticOrder S; S.init(MTOT, 1024, G, (int)blockIdx.x);
#ifdef TS_GEMM
        if (l == 1 && blockIdx.x == TS_BLOCK && TS_PHASE == ph) g.ts = (volatile unsigned long long*)(ws + WS_CTL + 512 * 1024);
#endif
        pg8::EpiRes E{ws, a.out, l, 1, nullptr, nullptr};
        pg8::gemm_phase<pg8::EpiRes, pg8::StaticOrder, false, true>(lds, g, S, E); } break;
    default: break;
    }
}

#define XB_TMO      128
#define XB_XCNT(j)  (256  + 64 * (j))
#define XB_XSUB(j)  (1280 + 64 * (j))
#define XB_XGEN(j)  (2304 + 64 * (j))
#define XB_TOP      3328
#define XB_TOPGEN   3392
#define XCD_BAR_WORDS 3456
#define XB_SPIN_CAP (1u << 18)
__device__ __forceinline__ unsigned xb_ld(unsigned* p)              { return __hip_atomic_load(p, __ATOMIC_RELAXED, __HIP_MEMORY_SCOPE_AGENT); }
__device__ __forceinline__ unsigned xb_add(unsigned* p, unsigned v) { return __hip_atomic_fetch_add(p, v, __ATOMIC_RELAXED, __HIP_MEMORY_SCOPE_AGENT); }
__device__ __forceinline__ unsigned xb_xcc_id() { return (unsigned)__builtin_amdgcn_s_getreg((3 << 11) | 20) & 0xFu; }
#define XB_SPIN(cond, bar) do { unsigned _sp = 0; while (cond) { __builtin_amdgcn_s_sleep(1); \
    if ((++_sp & 255u) == 0u) { if (xb_ld(&(bar)[XB_TMO])) break; if (_sp > XB_SPIN_CAP) { atomicAdd(&(bar)[XB_TMO], 1u); break; } } } } while (0)
struct XcdBarrier { unsigned* bar; unsigned x; volatile LAS unsigned* st; };
__device__ __forceinline__ XcdBarrier xcd_barrier_post(unsigned* bar, volatile LAS unsigned* st) {
    XcdBarrier b; b.bar = bar; b.x = xb_xcc_id(); b.st = st;
    if (threadIdx.x == 0) (void)xb_add(&bar[XB_XCNT(b.x)], 1u);
    return b;
}
__device__ __forceinline__ void xcd_barrier_complete(unsigned* bar, unsigned x, unsigned& nloc, unsigned& nx) {
    const unsigned G = gridDim.x * gridDim.y * gridDim.z;
    unsigned sum, cnt, mine, sp = 0u;
    for (;;) {
        sum = 0u; cnt = 0u; mine = 0u;
#pragma unroll
        for (unsigned j = 0; j < 16; ++j) { const unsigned c = xb_ld(&bar[XB_XCNT(j)]); sum += c; cnt += (c > 0u) ? 1u : 0u; mine = (j == x) ? c : mine; }
        if (sum == G) break;
        __builtin_amdgcn_s_sleep(1);
        if ((++sp & 255u) == 0u) { if (xb_ld(&bar[XB_TMO])) break; if (sp > XB_SPIN_CAP) { atomicAdd(&bar[XB_TMO], 1u); break; } }
    }
    nloc = mine > 0u ? mine : 1u; nx = cnt > 0u ? cnt : 1u;
}
__device__ __forceinline__ void xcd_barrier(const XcdBarrier& b) {
    asm volatile("s_waitcnt vmcnt(0)" ::: "memory");
    __syncthreads();
    if (threadIdx.x == 0) {
        unsigned* bar = b.bar;
        __builtin_amdgcn_s_waitcnt(0);
        unsigned nloc = b.st[0], nx = b.st[1];
        if (nloc == 0u) { xcd_barrier_complete(bar, b.x, nloc, nx); b.st[0] = nloc; b.st[1] = nx; }
        const unsigned old = xb_add(&bar[XB_XSUB(b.x)], 1u);
        const unsigned gen = old / nloc;
        if (old + 1u == (gen + 1u) * nloc) {
            __builtin_amdgcn_fence(__ATOMIC_RELEASE, "agent");
            asm volatile("s_waitcnt vmcnt(0)" ::: "memory");
            const unsigned og = xb_add(&bar[XB_TOP], 1u);
            const unsigned tg = og / nx;
            if (og + 1u == (tg + 1u) * nx) xb_add(&bar[XB_TOPGEN], 1u);
            else XB_SPIN(xb_ld(&bar[XB_TOPGEN]) == tg, bar);
            __builtin_amdgcn_fence(__ATOMIC_ACQUIRE, "agent");
            xb_add(&bar[XB_XGEN(b.x)], 1u);
            asm volatile("s_waitcnt vmcnt(0)" ::: "memory");
        } else {
            XB_SPIN(xb_ld(&bar[XB_XGEN(b.x)]) == gen, bar);
#ifdef BAR_L1INV
            asm volatile("buffer_inv sc0" ::: "memory");
            __builtin_amdgcn_fence(__ATOMIC_ACQUIRE, "workgroup");
#else
            __builtin_amdgcn_fence(__ATOMIC_ACQUIRE, "agent");
#endif
            asm volatile("s_waitcnt vmcnt(0)" ::: "memory");
        }
    }
    __syncthreads();
}
constexpr int CW_BAR = 4096;
constexpr int LDS_BARST = LDS_BYTES - 64;

__device__ __forceinline__ void prefetch_next(LAS unsigned char* lds, const Args& a, int ph, int l) {
    unsigned char* ws = a.ws; const int G = gridDim.x; pg8::Unit u;
    if (ph == PH_IN) { pg8::StaticOrder S; S.init(MTOT, DIN - 256, G, (int)blockIdx.x); if (S.next(0, u)) prefetch_panel(lds, (const bf16_t*)(ws + WS_WIN) + (size_t)l * DIN * 1024 + (size_t)(u.pn + 1) * 256 * 1024, 1024, 2048); }
    else if (ph == PH_OUT) { pg8::StaticOrder S; S.init(MTOT, 1024, G, (int)blockIdx.x); if (S.next(0, u)) prefetch_panel(lds, (const bf16_t*)(ws + WS_WOUT) + (size_t)l * 1024 * 1024 + (size_t)u.pn * 256 * 1024, 1024, 2048); }
    else if (ph == PH_UP) { pg8::UpOrder S; S.init_up(G, (int)blockIdx.x); if (S.next(0, u)) prefetch_panel(lds, (const bf16_t*)(ws + WS_WUP) + (size_t)l * DUP * 1024 + (size_t)u.pn * 256 * 1024, 1024, 2048); }
    else if (ph == PH_DOWN) { pg8::StaticOrder S; S.init(MTOT, 1024, G, (int)blockIdx.x); if (S.next(0, u)) prefetch_panel(lds, (const bf16_t*)(ws + WS_WDOWN) + (size_t)l * 1024 * DFF + (size_t)u.pn * 256 * DFF, DFF, 2048); }
}
__global__ void __launch_bounds__(512, 2) mk_fwd(Args a) {
    extern __shared__ __attribute__((aligned(16))) unsigned char lds_raw[];
    LAS unsigned char* lds = (LAS unsigned char*)lds_raw;
    cg::grid_group grid = cg::this_grid();
    if (threadIdx.x < 2) ((volatile LAS unsigned*)(lds + LDS_BARST))[threadIdx.x] = 0u;
    __syncthreads();
    const XcdBarrier xbar = xcd_barrier_post((unsigned*)(a.ws + WS_CTL) + CW_BAR, (volatile LAS unsigned*)(lds + LDS_BARST));
#define GSYNC() xcd_barrier(xbar)
#ifdef TS_A
#define TSB ((volatile unsigned long long*)(a.ws + WS_CTL + 512 * 1024))
#define STAMP(k) do { if (blockIdx.x == TS_BLOCK && threadIdx.x == 0) TSB[k] = __builtin_amdgcn_s_memrealtime(); } while (0)
#else
#define STAMP(k) do {} while (0)
#endif
    STAMP(0);
#ifdef TS_XCC
    if (threadIdx.x == 0) ((volatile unsigned*)(a.ws + WS_CTL + 768 * 1024))[blockIdx.x] = xb_xcc_id();
#endif
    misc::phase_tables(a); misc::fill_run(lds, a, misc::SLOT_A);
    grid.sync(); STAMP(1);
    run_phase(lds, a, PH_MAKEXA, 0, 0, 1); misc::fill_run(lds, a, misc::SLOT_B); GSYNC();
#ifndef REP_IN
#define REP_IN 1
#endif
#ifndef REP_ATT
#define REP_ATT 1
#endif
#ifndef REP_UP
#define REP_UP 1
#endif
    STAMP(2);
#pragma unroll 1
    for (int l = 0; l < DEPTH; ++l) {
        if (l == 1) STAMP(10);
#pragma unroll 1
        for (int rep = 0; rep < REP_IN; ++rep) { run_phase(lds, a, PH_IN, l, 0, 0); if (l == 1) STAMP(11); GSYNC(); }
        if (l == 1) STAMP(12);
#pragma unroll 1
        for (int rep = 0; rep < REP_ATT; ++rep) { run_phase(lds, a, PH_ATT, l, rep, 0); if (l == 1) STAMP(13); GSYNC(); }
        if (l == 1) STAMP(14);
        run_phase(lds, a, PH_OUT, l, 0, 0); if (l == 1) STAMP(15); GSYNC();
        if (l == 1) STAMP(16);
#pragma unroll 1
        for (int rep = 0; rep < REP_UP; ++rep) { run_phase(lds, a, PH_UP, l, 0, 0); if (l == 1) STAMP(17); GSYNC(); }
        if (l == 1) STAMP(18);
        run_phase(lds, a, PH_DOWN, l, 0, 0); if (l == 1) STAMP(19);
        if (l < DEPTH - 1) GSYNC();
        if (l == 1) STAMP(20);
    }
#ifdef TS_A
    GSYNC();
    if (blockIdx.x == TS_BLOCK) {
#ifdef TS_XCC
        volatile unsigned* xc = (volatile unsigned*)(a.ws + WS_CTL + 768 * 1024); int mism = 0;
        for (int b = 0; b < (int)gridDim.x; ++b) { const unsigned ref = (TS_XCC == 1) ? xc[b % 8] : xc[(b / 32) * 32]; mism += (xc[b] != ref) ? 1 : 0; }
        const float T_us = (float)mism;
#else
        const float T_us = (float)(TSB[TS_B] - TSB[TS_A]) * 0.01f;
#endif
        const float dl = sqrtf(T_us * (float)(TS_SCALE) * 8.0f);
        for (int i = threadIdx.x; i < (1 << 20); i += 512) a.out[OUT_NAV + i] *= (1.0f + dl);
    }
#endif
}

extern "C" void kernel_launch(void* const* d_in, const int* in_sizes, int n_in, void* d_out, int out_size, void* d_ws, size_t ws_size, hipStream_t stream) {
    static int grid = 0;
    if (grid == 0) {
        int dev = 0, cus = 0, per_cu = 0;
        (void)hipGetDevice(&dev); (void)hipDeviceGetAttribute(&cus, hipDeviceAttributeMultiprocessorCount, dev);
        (void)hipFuncSetAttribute((const void*)mk_fwd, hipFuncAttributeMaxDynamicSharedMemorySize, LDS_BYTES);
        (void)hipOccupancyMaxActiveBlocksPerMultiprocessor(&per_cu, (const void*)mk_fwd, 512, LDS_BYTES);
        if (per_cu < 1) fprintf(stderr, "kernel_launch: occupancy query reports %d blocks per CU\n", per_cu);
        grid = cus > 0 ? cus : 256;
        if (ws_size < WS_END) { fprintf(stderr, "kernel_launch: workspace too small (%zu < %zu)\n", ws_size, (size_t)WS_END); grid = -1; }
    }
    if (grid < 0) return;
    Args a{}; for (int i = 0; i < N_IN; ++i) a.in[i] = (const float*)d_in[i]; a.out = (float*)d_out; a.ws = (unsigned char*)d_ws;
    (void)hipMemsetAsync((unsigned char*)d_ws + WS_CTL, 0, 1 * MiB, stream);
    void* args[] = {&a};
    hipError_t e = hipLaunchCooperativeKernel((const void*)mk_fwd, dim3(grid), dim3(512), args, LDS_BYTES, stream);
    if (e != hipSuccess) fprintf(stderr, "cooperative launch failed: %s (grid %d)\n", hipGetErrorString(e), grid);
}
```

```cpp
#include <hip/hip_runtime.h>
#include <hip/hip_cooperative_groups.h>
#include <cstdio>
#include <cstdint>
namespace cg = cooperative_groups;

constexpr int DEPTH = 4, NCTX = 32, TCTX = 256, NLAT = 4, TLAT = 2048, PAST = 512;
constexpr int MCTX = 8192, MLAT = 8192, MTOT = 16384;
constexpr int DIN = 2304, DFF = 2816, DUP = 5632;
constexpr size_t OUT_X = 0, OUT_NAK = 16777216, OUT_NAV = 25165824, OUT_SWK = 33554432, OUT_SWV = 37748736, OUT_DAK = 41943040, OUT_DAV = 50331648, OUT_TOTAL = 58720256;
enum { I_XP = 0, I_XS, I_CNAK, I_CNAV, I_CSWK, I_CSWV, I_CDAK, I_CDAV, I_C, I_CCTX, I_GATTN, I_GFFN, I_WMOD, I_BMOD, I_WIN, I_NAG, I_RPB, I_SWG, I_SINK, I_DAG, I_LAMBDA, I_SUBG, I_WOUT, I_WUP, I_CONVW, I_CONVB, I_WDOWN, N_IN };
#define LAS __attribute__((address_space(3)))
#define GAS __attribute__((address_space(1)))
typedef unsigned short bf16_t;
typedef short bf16x8 __attribute__((ext_vector_type(8)));
typedef float f32x4 __attribute__((ext_vector_type(4)));
typedef float f32x2 __attribute__((ext_vector_type(2)));
typedef float f32x16 __attribute__((ext_vector_type(16)));
typedef unsigned u32x4 __attribute__((ext_vector_type(4)));
typedef unsigned u32x2 __attribute__((ext_vector_type(2)));
typedef __bf16 bf16x2_t __attribute__((ext_vector_type(2)));

constexpr float LOG2E = 1.4426950408889634f;
constexpr float QSCALE64 = 0.125f * LOG2E, QSCALE32 = 0.17677669529663687f * LOG2E;

__device__ __forceinline__ unsigned cvt_pk_bf16(float lo, float hi) { f32x2 v = {lo, hi}; bf16x2_t b = __builtin_convertvector(v, bf16x2_t); return __builtin_bit_cast(unsigned, b); }
__device__ __forceinline__ float bf16_to_f32(bf16_t v) { return __builtin_bit_cast(float, (unsigned)v << 16); }
__device__ __forceinline__ int row_b5(int row) { return row < MCTX ? 0 : 1 + ((row - MCTX) >> 11); }

constexpr size_t MiB = 1u << 20;
constexpr size_t WS_CTL = 0;
constexpr size_t WS_MOD = 1 * MiB;
constexpr size_t WS_GV = WS_MOD + 512 * 1024;
constexpr size_t WS_BIASIN = WS_GV + 256 * 1024;
constexpr size_t WS_BIASUP = WS_BIASIN + 256 * 1024;
constexpr size_t WS_LAM = WS_BIASUP + 512 * 1024;
constexpr int SM_LAM = 0, SM_GAINS = 64, SM_RPB = SM_GAINS + 1280, SM_SINK = SM_RPB + 7440, SM_SUBG = SM_SINK + 32, SM_END = SM_SUBG + 256;
constexpr size_t WS_ROPEB = 3 * MiB;
constexpr size_t WS_ROPEC = WS_ROPEB + 512 * 1024;
constexpr size_t WS_SSQ = 4 * MiB;
constexpr size_t WS_CONV = 5 * MiB;
constexpr size_t WS_WIN = 6 * MiB;
constexpr size_t WS_WOUT = WS_WIN + 18 * MiB;
constexpr size_t WS_WUP = WS_WOUT + 8 * MiB;
constexpr size_t WS_WDOWN = WS_WUP + 44 * MiB;
constexpr size_t WS_KC = WS_WDOWN + 22 * MiB;
constexpr size_t WS_XA = WS_KC + 20 * MiB;
constexpr size_t WS_QKV = WS_XA + 32 * MiB + 1 * MiB;
constexpr size_t WS_O = WS_QKV + 72 * MiB;
constexpr size_t WS_ACT = WS_O + 32 * MiB;
constexpr size_t WS_END = WS_ACT + 88 * MiB;
constexpr size_t GS4 = 2097152, GS8 = 4194304, GS2 = 1048576;
constexpr size_t QO_QA = 0, QO_KA = QO_QA + 2 * GS4, QO_VTA = QO_KA + 2 * GS4, QO_QB = QO_VTA + 2 * GS4, QO_KB = QO_QB + 2 * GS8, QO_VTB = QO_KB + 2 * GS2,
                 QO_QC = QO_VTB + 2 * GS2, QO_KC = QO_QC + 2 * GS4, QO_VTC = QO_KC + 2 * GS4, QO_END = QO_VTC + 2 * GS4;
static_assert(QO_END * 2 == 72 * MiB, "qkv region");
constexpr size_t CO_KA = 0, CO_VTA = CO_KA + GS4, CO_KB = CO_VTA + GS4, CO_VTB = CO_KB + GS2, CO_KCC = CO_VTB + GS2, CO_VTCC = CO_KCC + GS4;

struct Args { const float* in[N_IN]; float* out; unsigned char* ws; };
__device__ __forceinline__ int opaque_tid() { int t = threadIdx.x; asm volatile("" : "+v"(t)); return t; }

namespace pg8 {
#define PG8_LAS __attribute__((address_space(3)))
constexpr int BM = 256, BK = 64, HALF = 128, HTB = HALF * BK * 2  , STAGE_BYTES = 8 * HTB, NXCD = 8, WGM = 8;
__host__ __device__ __forceinline__ int lds_byte(int r, int c) { const int st = (r >> 4) * 2 + (c >> 5), rr = r & 15, cc = c & 31, ob = rr * 64 + cc * 2; return st * 1024 + (ob ^ (((ob >> 9) & 1) << 5)); }
__host__ __device__ __forceinline__ void stage_rc(int b, int& R, int& C) { const int st = b / 1024, sb = b % 1024, swz = sb ^ (((sb >> 9) & 1) << 5); R = (st >> 1) * 16 + swz / 64; C = (st & 1) * 32 + (swz % 64) / 2; }
__host__ __device__ __forceinline__ int perm32(int rho) { const int n = rho >> 4, i = rho & 15; return 8 * (i >> 2) + 4 * n + (i & 3); }
struct Unit { int pm, pn; };
struct Gemm { const bf16_t* A; const bf16_t* Bt; int M, N, K; volatile unsigned long long* ts = nullptr; };
struct StaticOrder {
    int nM, nN, nwg, G, c;
    __host__ __device__ void init(int M, int N, int G_, int c_) { nM = M / BM; nN = N / BM; nwg = nM * nN; G = G_; c = c_; }
    __host__ __device__ bool next(int i, Unit& u) const {
        const long L = (long)i * G + c; if (L >= nwg) return false;
        int wgid = (int)L; { const int q = nwg / NXCD, r = nwg % NXCD, xcd = wgid % NXCD, off = wgid / NXCD; wgid = (xcd < r ? xcd * (q + 1) : r * (q + 1) + (xcd - r) * q) + off; }
        const int nig = WGM * nN, gid = wgid / nig, fm = gid * WGM, gsz = (nM - fm) < WGM ? (nM - fm) : WGM;
        u.pm = fm + ((wgid % nig) % gsz); u.pn = (wgid % nig) / gsz; return true;
    }
    __device__ __forceinline__ void a_ready(const Unit&) const {}
    __device__ __forceinline__ void done(const Unit&) const {}
    __device__ __forceinline__ int arow0(int pm) const { return BM * pm; }
};
struct OneUnit {
    int pm;
    __device__ __forceinline__ bool next(int i, Unit& u) const { if (i > 0) return false; u.pm = pm; u.pn = 0; return true; }
    __device__ __forceinline__ void a_ready(const Unit&) const {}
    __device__ __forceinline__ void done(const Unit&) const {}
    __device__ __forceinline__ int arow0(int pm_) const { return BM * pm_; }
};
struct UpOrder : StaticOrder {
    __device__ __forceinline__ void init_up(int G_, int c_) { nM = 68; nN = 22; nwg = nM * nN; G = G_; c = c_; }
    __device__ __forceinline__ int arow0(int pm) const { return pm < 32 ? BM * pm : MCTX + TLAT * ((pm - 32) / 9) + 254 * ((pm - 32) % 9) - 1; }
};

template <class Epi, class Sched, bool ALIGN_EPI = false, bool SP2 = false>
__device__ __forceinline__ void gemm_phase(PG8_LAS unsigned char* lds, const Gemm g, const Sched& S, const Epi& E) {
    const int tid = opaque_tid(), wid = __builtin_amdgcn_readfirstlane(tid >> 6), lane = tid & 63, wr = wid >> 2, wc = wid & 3, fr = lane & 15, fq = lane >> 4;
    const int K = g.K, nt = K / BK;
    unsigned voffA[2], voffB[2];
#pragma unroll
    for (int i = 0; i < 2; ++i) { int R, C; stage_rc(tid * 16 + i * 8192, R, C); const int Rb = Epi::PERM ? ((R & ~31) + perm32(R & 31)) : R;
        voffA[i] = (unsigned)(R * K + C) * 2u; voffB[i] = (unsigned)(Rb * K + C) * 2u; }
    const size_t kstep = (size_t)(BK * 2);
    const size_t hstep = (size_t)HALF * K * 2;
    const size_t tstep = 2 * hstep;
    const unsigned ldsw = (unsigned)wid * 1024u;
    const int aoff = lds_byte(wr * 64 + fr, fq * 8), boff = lds_byte(wc * 32 + fr, fq * 8);
#define PG8_SA(b, h) (((b) * 2 + (h)) * HTB)
#define PG8_SB(b, h) ((4 + (b) * 2 + (h)) * HTB)
#define PG8_STAGE(bufoff, gbase, voff) do { _Pragma("unroll") for (int _i = 0; _i < 2; ++_i) \
        __builtin_amdgcn_global_load_lds((const unsigned*)((const char*)(gbase) + (voff)[_i]), (PG8_LAS unsigned*)(lds + (bufoff) + ldsw + _i * 8192), 16, 0, 0); } while (0)
#define PG8_LDA(dst, b, h) do { _Pragma("unroll") for (int m = 0; m < 4; ++m) _Pragma("unroll") for (int k = 0; k < 2; ++k) dst[m][k] = *(const PG8_LAS bf16x8*)(lds + PG8_SA(b, h) + aoff + m * 2048 + k * 1024); } while (0)
#define PG8_LDB(dst, b, h) do { _Pragma("unroll") for (int n = 0; n < 2; ++n) _Pragma("unroll") for (int k = 0; k < 2; ++k) dst[n][k] = *(const PG8_LAS bf16x8*)(lds + PG8_SB(b, h) + boff + n * 2048 + k * 1024); } while (0)
#define PG8_MMA(ai, bj, At, Bt) do { __builtin_amdgcn_s_setprio(1); _Pragma("unroll") for (int m = 0; m < 4; ++m) _Pragma("unroll") for (int n = 0; n < 2; ++n) _Pragma("unroll") for (int k = 0; k < 2; ++k) \
        acc[ai][bj][m][n] = __builtin_amdgcn_mfma_f32_16x16x32_bf16(Bt[n][k], At[m][k], acc[ai][bj][m][n], 0, 0, 0); __builtin_amdgcn_s_setprio(0); } while (0)
#define PG8_WAIT_V(n) asm volatile("s_waitcnt vmcnt(" #n ")" ::: "memory")
#define PG8_WAIT_L(n) asm volatile("s_waitcnt lgkmcnt(" #n ")" ::: "memory")
#define PG8_BAR __builtin_amdgcn_s_barrier()
#define PG8_SCHED __builtin_amdgcn_sched_barrier(0)
    Unit cur, nxt; int ui = 0;
    if (!S.next(0, cur)) return;
    f32x4 acc[2][2][4][2];
#pragma unroll
    for (int a = 0; a < 2; ++a)
#pragma unroll
        for (int b = 0; b < 2; ++b)
#pragma unroll
            for (int m = 0; m < 4; ++m)
#pragma unroll
                for (int n = 0; n < 2; ++n) acc[a][b][m][n] = (f32x4){0.f, 0.f, 0.f, 0.f};
    bf16x8 At[4][2], B0[2][2], B1[2][2];
    const size_t rstep = (size_t)K * 2;
    const char* cA = (const char*)g.A + (size_t)S.arow0(cur.pm) * rstep; const char* cB = (const char*)g.Bt + (size_t)cur.pn * tstep;
    S.a_ready(cur);
#ifdef SKEW_A
    { const int d = (cur.pn & 3) * SKEW_A + (cur.pm & 7) * SKEW_B; for (int i = 0; i < d; ++i) __builtin_amdgcn_s_sleep(16); }
#endif
#ifdef USE_KROT
#if USE_KROT == 2
#define PG8_ROT(u) (2 * ((int)blockIdx.x & 7) * (nt >> 4))
#else
#define PG8_ROT(u) (2 * ((((u).pm & 7) + ((u).pn & 3)) & 3))
#endif
#else
#define PG8_ROT(u) 0
#endif
    int rc = PG8_ROT(cur);
    { const char* pA = cA + (size_t)rc * kstep; const char* pB = cB + (size_t)rc * kstep;
    if constexpr (SP2) {
        PG8_STAGE(PG8_SB(0, 0), pB, voffB); PG8_STAGE(PG8_SB(0, 1), pB + hstep, voffB); PG8_STAGE(PG8_SA(0, 0), pA, voffA); PG8_STAGE(PG8_SA(0, 1), pA + hstep, voffA);
        if (wr == 1) PG8_BAR;
        PG8_WAIT_V(2); PG8_BAR;
        PG8_STAGE(PG8_SB(1, 0), pB + kstep, voffB); PG8_STAGE(PG8_SA(1, 0), pA + kstep, voffA); PG8_STAGE(PG8_SB(1, 1), pB + hstep + kstep, voffB);
        PG8_WAIT_V(6); PG8_BAR;
    } else {
        PG8_STAGE(PG8_SB(0, 0), pB, voffB); PG8_STAGE(PG8_SA(0, 0), pA, voffA); PG8_STAGE(PG8_SB(0, 1), pB + hstep, voffB); PG8_STAGE(PG8_SA(0, 1), pA + hstep, voffA);
        if (wr == 1) PG8_BAR;
        PG8_WAIT_V(4); PG8_BAR;
        PG8_STAGE(PG8_SB(1, 0), pB + kstep, voffB); PG8_STAGE(PG8_SA(1, 0), pA + kstep, voffA); PG8_STAGE(PG8_SB(1, 1), pB + hstep + kstep, voffB);
        PG8_WAIT_V(6); PG8_BAR;
    } }
    for (;;) {
        const bool has_next = S.next(ui + 1, nxt);
        const char* nA = has_next ? (const char*)g.A + (size_t)S.arow0(nxt.pm) * rstep : cA; const char* nB = has_next ? (const char*)g.Bt + (size_t)nxt.pn * tstep : cB;
        const int rn = has_next ? PG8_ROT(nxt) : rc;
        int p = rc;
        for (int t = 0; t < nt; t += 2) {
            const bool last = (t == nt - 2);
#ifdef TS_GEMM
            if (g.ts && tid == 0 && ui == 0) g.ts[40 + (t >> 1)] = __builtin_amdgcn_s_memrealtime();
#endif
            const int p2 = (p + 2 >= nt) ? p + 2 - nt : p + 2;
            const char* a1 = cA + (size_t)(p + 1) * kstep;
            const char* a2 = last ? nA + (size_t)rn * kstep : cA + (size_t)p2 * kstep; const char* b2 = last ? nB + (size_t)rn * kstep : cB + (size_t)p2 * kstep;
            const char* a3 = a2 + kstep; const char* b3 = b2 + kstep;
            p = p2;
            if (last && has_next) S.a_ready(nxt);
            if constexpr (SP2) {
            PG8_LDB(B0, 0, 0); PG8_LDB(B1, 0, 1); PG8_SCHED; PG8_LDA(At, 0, 0); PG8_STAGE(PG8_SA(1, 1), a1 + hstep, voffA);
            PG8_WAIT_V(8); PG8_WAIT_L(0); PG8_BAR; PG8_MMA(0, 0, At, B0); PG8_MMA(0, 1, At, B1); PG8_BAR; PG8_SCHED;
            PG8_LDA(At, 0, 1); PG8_STAGE(PG8_SB(0, 0), b2, voffB); PG8_STAGE(PG8_SB(0, 1), b2 + hstep, voffB); PG8_STAGE(PG8_SA(0, 0), a2, voffA);
            PG8_WAIT_V(8); PG8_WAIT_L(0); PG8_BAR; PG8_MMA(1, 0, At, B0); PG8_MMA(1, 1, At, B1); PG8_BAR; PG8_SCHED;
            PG8_LDB(B0, 1, 0); PG8_LDB(B1, 1, 1); PG8_SCHED; PG8_LDA(At, 1, 0); PG8_STAGE(PG8_SA(0, 1), a2 + hstep, voffA);
            PG8_WAIT_V(8); PG8_WAIT_L(0); PG8_BAR; PG8_MMA(0, 0, At, B0); PG8_MMA(0, 1, At, B1); PG8_BAR; PG8_SCHED;
            PG8_LDA(At, 1, 1); PG8_STAGE(PG8_SB(1, 0), b3, voffB); PG8_STAGE(PG8_SB(1, 1), b3 + hstep, voffB); PG8_STAGE(PG8_SA(1, 0), a3, voffA);
            PG8_WAIT_V(8); PG8_WAIT_L(0); PG8_BAR; PG8_MMA(1, 0, At, B0); PG8_MMA(1, 1, At, B1); PG8_BAR; PG8_SCHED;
            } else {
            PG8_LDB(B0, 0, 0); PG8_SCHED; PG8_LDA(At, 0, 0); PG8_STAGE(PG8_SA(1, 1), a1 + hstep, voffA);
            PG8_WAIT_L(8); PG8_BAR; PG8_WAIT_L(0); PG8_MMA(0, 0, At, B0); PG8_BAR; PG8_SCHED;
            PG8_LDB(B1, 0, 1); PG8_STAGE(PG8_SB(0, 0), b2, voffB);
            PG8_BAR; PG8_WAIT_L(0); PG8_MMA(0, 1, At, B1); PG8_BAR;
            PG8_LDA(At, 0, 1); PG8_STAGE(PG8_SA(0, 0), a2, voffA);
            PG8_BAR; PG8_WAIT_L(0); PG8_MMA(1, 0, At, B0); PG8_BAR; PG8_SCHED;
            PG8_STAGE(PG8_SB(0, 1), b2 + hstep, voffB);
            PG8_WAIT_V(6); PG8_BAR; PG8_MMA(1, 1, At, B1); PG8_BAR;
            PG8_LDB(B0, 1, 0); PG8_SCHED; PG8_LDA(At, 1, 0); PG8_STAGE(PG8_SA(0, 1), a2 + hstep, voffA);
            PG8_WAIT_L(8); PG8_BAR; PG8_WAIT_L(0); PG8_MMA(0, 0, At, B0); PG8_BAR; PG8_SCHED;
            PG8_LDB(B1, 1, 1); PG8_STAGE(PG8_SB(1, 0), b3, voffB);
            PG8_BAR; PG8_WAIT_L(0); PG8_MMA(0, 1, At, B1); PG8_BAR;
            PG8_LDA(At, 1, 1); PG8_STAGE(PG8_SA(1, 0), a3, voffA);
            PG8_BAR; PG8_WAIT_L(0); PG8_MMA(1, 0, At, B0); PG8_BAR; PG8_SCHED;
            PG8_STAGE(PG8_SB(1, 1), b3 + hstep, voffB);
            PG8_WAIT_V(6); PG8_BAR; PG8_MMA(1, 1, At, B1); PG8_BAR;
            }
        }
        if constexpr (ALIGN_EPI) { if (wr == 0) PG8_BAR; }
#ifdef TS_GEMM
        if (g.ts && tid == 0) g.ts[30 + 2 * ui] = __builtin_amdgcn_s_memrealtime();
#endif
        if constexpr (!Epi::AFTER_DRAIN) { if constexpr (Epi::NEEDS_LDS) E(acc, cur, wr, wc, fr, fq, lds); else E(acc, cur, wr, wc, fr, fq); S.done(cur); }
#ifdef TS_GEMM
        if (g.ts && tid == 0) g.ts[31 + 2 * ui] = __builtin_amdgcn_s_memrealtime();
#endif
        if (!has_next) break;
#pragma unroll
        for (int a = 0; a < 2; ++a)
#pragma unroll
            for (int b = 0; b < 2; ++b)
#pragma unroll
                for (int m = 0; m < 4; ++m)
#pragma unroll
                    for (int n = 0; n < 2; ++n) acc[a][b][m][n] = (f32x4){0.f, 0.f, 0.f, 0.f};
        cur = nxt; cA = nA; cB = nB; rc = rn; ++ui;
        if constexpr (ALIGN_EPI) { if (wr == 1) PG8_BAR; }
    }
    PG8_WAIT_V(0);
    if constexpr (!ALIGN_EPI) { if (wr == 0) PG8_BAR; }
    PG8_BAR;
    if constexpr (Epi::AFTER_DRAIN) { E.fused(acc, cur, wr, wc, fr, fq, lds, wid, lane); S.done(cur); }
#undef PG8_SA
#undef PG8_SB
#undef PG8_STAGE
#undef PG8_LDA
#undef PG8_LDB
#undef PG8_MMA
#undef PG8_WAIT_V
#undef PG8_WAIT_L
#undef PG8_BAR
#undef PG8_SCHED
}

constexpr int LDS_EDGE = 131072 + 1024;
constexpr int LDS_RSTD = LDS_EDGE + 8192;
__device__ __forceinline__ void rstd_table(PG8_LAS unsigned char* lds, const GAS float* ssq, int arow0, int wr, int wc, int fr, int fq) {
    const int tid = (wr * 4 + wc) * 64 + fq * 16 + fr, r = tid >> 1, hf = tid & 1;
    const f32x2 a = *(const GAS f32x2*)(ssq + (size_t)min(arow0 + r, MTOT - 1) * 4 + 2 * hf);
    float s = a[0] + a[1]; s += __shfl_xor(s, 1);
    if (!hf) ((PG8_LAS float*)(lds + LDS_RSTD))[r] = __builtin_amdgcn_rsqf(s * (1.0f / 1024.0f) + 1e-6f);
}
__device__ __forceinline__ float xsum_fq(float v) {
    auto a = __builtin_amdgcn_permlane16_swap(__float_as_uint(v), __float_as_uint(v), false, false); v = __uint_as_float(a[0]) + __uint_as_float(a[1]);
    auto b = __builtin_amdgcn_permlane32_swap(__float_as_uint(v), __float_as_uint(v), false, false); return __uint_as_float(b[0]) + __uint_as_float(b[1]);
}
__device__ __forceinline__ float wave_sum_dpp(float v) {
    v += __builtin_bit_cast(float, __builtin_amdgcn_mov_dpp(__builtin_bit_cast(int, v), 0xB1, 0xf, 0xf, true));
    v += __builtin_bit_cast(float, __builtin_amdgcn_mov_dpp(__builtin_bit_cast(int, v), 0x4E, 0xf, 0xf, true));
    v += __builtin_bit_cast(float, __builtin_amdgcn_mov_dpp(__builtin_bit_cast(int, v), 0x124, 0xf, 0xf, true));
    v += __builtin_bit_cast(float, __builtin_amdgcn_mov_dpp(__builtin_bit_cast(int, v), 0x128, 0xf, 0xf, true));
    return xsum_fq(v);
}
#define EPI_BARRIER() do { asm volatile("s_waitcnt lgkmcnt(0)" ::: "memory"); __builtin_amdgcn_s_barrier(); asm volatile("" ::: "memory"); } while (0)

struct EpiIn {
    static constexpr bool PERM = true, AFTER_DRAIN = false, NEEDS_LDS = true;
    unsigned char* ws0; float* out; int l; int pn_off;
    __device__ __forceinline__ void operator()(const f32x4 (&acc)[2][2][4][2], const Unit& u, int wr, int wc, int fr_in, int fq_in, PG8_LAS unsigned char* lds) const {
        unsigned char* ws_ = ws0; asm volatile("" : "+s"(ws_));
        GAS unsigned char* ws = (GAS unsigned char*)ws_; GAS float* outg = (GAS float*)out;
        int fr = fr_in, fq = fq_in; asm volatile("" : "+v"(fr), "+v"(fq));
        const GAS float* ssq = (const GAS float*)(ws + WS_SSQ); const GAS float* bias = (const GAS float*)(ws + WS_BIASIN) + (size_t)l * 5 * DIN;
        const GAS float* gains = (const GAS float*)(ws + WS_LAM) + SM_GAINS + l * 320; const GAS float* nag = gains; const GAS float* swg = gains + 128; const GAS float* dag = gains + 256;
        const GAS float* ropeB = (const GAS float*)(ws + WS_ROPEB); const GAS float* ropeC = (const GAS float*)(ws + WS_ROPEC); GAS bf16_t* qkv = (GAS bf16_t*)(ws + WS_QKV);
        const int pm = u.pm, pn = u.pn + pn_off;
        const int grp = pm >= 32 ? 1 : 0, b = grp ? ((pm - 32) >> 3) : pm, tbase = grp ? 256 * ((pm - 32) & 7) : 0, T = grp ? TLAT : TCTX, b5 = grp ? 1 + b : 0;
        int type, h;
        if (pn < 3) { type = pn; h = wc; } else if (pn < 5) { type = 3; h = 4 * (pn - 3) + wc; } else if (pn == 5) { type = wc < 2 ? 4 : 5; h = wc & 1; } else { type = pn; h = wc; }
        const bool isv = (type == 2 || type == 5 || type == 8), isq = (type == 0 || type == 3 || type == 6), is32 = (type == 6 || type == 7);
        const bool rope = grp && (type == 3 || type == 4 || type == 6 || type == 7);
        const int H = (type == 3) ? 8 : ((type == 4 || type == 5) ? 2 : 4);
        size_t dbase; const size_t gs = (type == 3) ? GS8 : ((type == 4 || type == 5) ? GS2 : GS4);
        switch (type) { case 0: dbase = QO_QA; break; case 1: dbase = QO_KA; break; case 2: dbase = QO_VTA; break; case 3: dbase = QO_QB; break; case 4: dbase = QO_KB; break; case 5: dbase = QO_VTB; break;
                        case 6: dbase = QO_QC; break; case 7: dbase = QO_KC; break; default: dbase = QO_VTC; break; }
        GAS bf16_t* dst = qkv + dbase + grp * gs + (size_t)(b * H + h) * T * 64;
        GAS float* fo = nullptr; int fow = 0, foc = 0;
        if (!grp) { switch (type) { case 1: fo = outg + OUT_NAK; fow = 256; foc = 64 * wc; break; case 2: fo = outg + OUT_NAV; fow = 256; foc = 64 * wc; break; case 4: fo = outg + OUT_SWK; fow = 128; foc = 64 * h; break;
                        case 5: fo = outg + OUT_SWV; fow = 128; foc = 64 * h; break; case 7: fo = outg + OUT_DAK; fow = 256; foc = 64 * wc; break; case 8: fo = outg + OUT_DAV; fow = 256; foc = 64 * wc; break; default: break; } }
        const GAS float* gsrc = ((type == 0) ? nag : (type == 1) ? nag + 64 : (type == 3) ? swg : (type == 4) ? swg + 64 : (type == 6) ? dag : dag + 32) + 8 * fq;
        const GAS float* bsrc = bias + b5 * DIN + pn * 256 + 64 * wc + 8 * fq;
        rstd_table(lds, ssq, 256 * pm, wr, wc, fr, fq);
        f32x4 bv[2][2], gv[2][2];
#pragma unroll
        for (int bj = 0; bj < 2; ++bj)
#pragma unroll
            for (int n = 0; n < 2; ++n) { bv[bj][n] = *(const GAS f32x4*)(bsrc + 32 * bj + 4 * n); gv[bj][n] = isv ? (f32x4){1.f, 1.f, 1.f, 1.f} : *(const GAS f32x4*)(gsrc + (is32 ? 0 : 32 * bj) + 4 * n); }
        EPI_BARRIER();
        const PG8_LAS float* RS = (const PG8_LAS float*)(lds + LDS_RSTD);
        const float qs = isq ? (is32 ? QSCALE32 : QSCALE64) : 1.0f;
#pragma unroll
        for (int ai = 0; ai < 2; ++ai)
#pragma unroll
            for (int m = 0; m < 4; ++m) {
                const int lr = 128 * ai + 64 * wr + 16 * m + fr, row = 256 * pm + lr, t = tbase + lr;
                const float rstd = RS[lr];
                float r0 = 1.f, r1 = 1.f;
                if (!isv) {
                    float s0 = 0.f, s1 = 0.f;
#pragma unroll
                    for (int n = 0; n < 2; ++n) { const f32x4 a = acc[ai][0][m][n] * rstd + bv[0][n], c = acc[ai][1][m][n] * rstd + bv[1][n];
                        s0 += (a[0] * a[0] + a[1] * a[1]) + (a[2] * a[2] + a[3] * a[3]); s1 += (c[0] * c[0] + c[1] * c[1]) + (c[2] * c[2] + c[3] * c[3]); }
                    s0 = xsum_fq(s0); s1 = xsum_fq(s1);
                    if (is32) { r0 = __builtin_amdgcn_rsqf(s0 * (1.f / 32.f) + 1e-6f); r1 = __builtin_amdgcn_rsqf(s1 * (1.f / 32.f) + 1e-6f); }
                    else { r0 = r1 = __builtin_amdgcn_rsqf((s0 + s1) * (1.f / 64.f) + 1e-6f); }
                }
                u32x2 hold = {0u, 0u};
                GAS float* fr_ = fo ? fo + ((size_t)(b * DEPTH + l) * 256 + t) * fow + foc + 8 * fq : nullptr;
#pragma unroll
                for (int bj = 0; bj < 2; ++bj)
#pragma unroll
                    for (int n = 0; n < 2; ++n) {
                        f32x4 x = acc[ai][bj][m][n] * rstd + bv[bj][n];
                        if (!isv) {
                            x = x * (bj ? r1 : r0) * gv[bj][n];
                            if (rope) {
                                const f32x4 cs = is32 ? *(const GAS f32x4*)(ropeC + ((size_t)t * 16 + 4 * fq + 2 * n) * 2) : *(const GAS f32x4*)(ropeB + ((size_t)t * 32 + 16 * bj + 4 * fq + 2 * n) * 2);
                                x = (f32x4){x[0] * cs[0] - x[1] * cs[1], x[0] * cs[1] + x[1] * cs[0], x[2] * cs[2] - x[3] * cs[3], x[2] * cs[3] + x[3] * cs[2]};
                            }
                        }
                        if (fr_) *(GAS f32x4*)(fr_ + 32 * bj + 4 * n) = x;
                        if (!isv) { const f32x4 y = x * qs; u32x2 w; w.x = cvt_pk_bf16(y[0], y[1]); w.y = cvt_pk_bf16(y[2], y[3]);
                            if (n == 0) hold = w; else { u32x4 w4; w4.x = hold.x; w4.y = hold.y; w4.z = w.x; w4.w = w.y; *(GAS u32x4*)(dst + (size_t)t * 64 + 32 * bj + 8 * fq) = w4; } }
                        else {
                            const int d0 = 32 * bj + 8 * fq + 4 * n, q = fr & 3;
                            const unsigned A = cvt_pk_bf16(x[0], x[1]), B = cvt_pk_bf16(x[2], x[3]);
                            const unsigned pA = (unsigned)__builtin_amdgcn_mov_dpp((int)A, 0x4E, 0xf, 0xf, true), pB = (unsigned)__builtin_amdgcn_mov_dpp((int)B, 0x4E, 0xf, 0xf, true);
                            const unsigned n0 = q < 2 ? A : pB, n1 = q < 2 ? pA : B;
                            const unsigned p0 = (unsigned)__builtin_amdgcn_mov_dpp((int)n0, 0xB1, 0xf, 0xf, true), p1 = (unsigned)__builtin_amdgcn_mov_dpp((int)n1, 0xB1, 0xf, 0xf, true);
                            const unsigned sel = (q & 1) ? 0x03020706u : 0x05040100u;
                            u32x2 w; w.x = __builtin_amdgcn_perm(p0, n0, sel); w.y = __builtin_amdgcn_perm(p1, n1, sel);
                            *(GAS u32x2*)(dst + (size_t)(d0 + q) * T + (t - q)) = w; }
                    }
            }
    }
};

struct EpiRes {
    static constexpr bool PERM = false, AFTER_DRAIN = true, NEEDS_LDS = false;
    unsigned char* ws0; float* x; int l; int which;
    const float* xin_p; const float* xin_s;
    __device__ __forceinline__ void fused(const f32x4 (&acc)[2][2][4][2], const Unit& u, int wr, int wc, int fr, int fq, PG8_LAS unsigned char* lds, int wid, int lane) const {
        GAS unsigned char* ws = (GAS unsigned char*)ws0; GAS float* xg = (GAS float*)x;
        const int pm = u.pm, pn = u.pn, b5 = pm >= 32 ? 1 + ((pm - 32) >> 3) : 0;
        const GAS float* xin = xin_p ? (const GAS float*)(pm >= 32 ? xin_s : xin_p) : nullptr;
        const GAS float* gate = (const GAS float*)(ws + WS_MOD) + (size_t)(l * 5 + b5) * 6144 + (which ? 5 : 2) * 1024 + 256 * pn + 4 * lane;
        const bool hasn = which ? (l < 3) : true;
        const GAS float* gvn = (const GAS float*)(ws + WS_GV) + (size_t)(which ? l + 1 : l) * 10240 + (size_t)b5 * 2048 + (which ? 0 : 1024) + 256 * pn + 4 * lane;
        GAS bf16_t* xa = (GAS bf16_t*)(ws + WS_XA); GAS float* ssq = (GAS float*)(ws + WS_SSQ);
#ifndef X_NO_SC1
        const __amdgpu_buffer_rsrc_t xrsrc = __builtin_amdgcn_make_buffer_rsrc((void*)x, 0, (int)(MTOT * 1024 * 4), 0x00020000);
#endif
        const f32x4 g4 = *(const GAS f32x4*)gate; const f32x4 n4 = hasn ? *(const GAS f32x4*)gvn : (f32x4){0.f, 0.f, 0.f, 0.f};
#pragma unroll
        for (int ai = 0; ai < 2; ++ai) {
#pragma unroll
            for (int m = 0; m < 4; ++m) { const int row = 64 * wr + 16 * m + fr;
#pragma unroll
                for (int bj = 0; bj < 2; ++bj)
#pragma unroll
                    for (int n = 0; n < 2; ++n) *(PG8_LAS f32x4*)(lds + row * 1024 + (((32 * bj + 8 * wc + 4 * n + fq) ^ (row & 15)) << 4)) = acc[ai][bj][m][n]; }
            EPI_BARRIER();
            const int grow0 = 256 * pm + 128 * ai + 16 * wid; GAS float* xr = xg + (size_t)grow0 * 1024 + 256 * pn + 4 * lane;
#pragma unroll
            for (int k0 = 0; k0 < 16; k0 += 8) {
                f32x4 xv[8];
#pragma unroll
                for (int k = 0; k < 8; ++k) xv[k] = __builtin_nontemporal_load((const GAS f32x4*)((xin ? xin + (size_t)(grow0 - (grow0 >= MCTX ? MCTX : 0)) * 1024 + 256 * pn + 4 * lane : xr) + (size_t)(k0 + k) * 1024));
#pragma unroll
                for (int k = 0; k < 8; ++k) { const int row = 16 * wid + k0 + k;
                    const f32x4 a4 = *(const PG8_LAS f32x4*)(lds + row * 1024 + ((lane ^ (row & 15)) << 4));
                    const f32x4 y = xv[k] + g4 * a4;
#ifndef X_NO_SC1
                    __builtin_amdgcn_raw_buffer_store_b128(__builtin_bit_cast(u32x4, y), xrsrc, (int)(((size_t)(grow0 + k0 + k) * 1024 + 256 * pn + 4 * lane) * 4), 0, 16);
#else
                    __builtin_nontemporal_store(y, (GAS f32x4*)(xr + (size_t)(k0 + k) * 1024));
#endif
                    if (hasn) { float ss = (y[0] * y[0] + y[1] * y[1]) + (y[2] * y[2] + y[3] * y[3]);
                        ss = wave_sum_dpp(ss);
                        const f32x4 z = y * n4; u32x2 w; w.x = cvt_pk_bf16(z[0], z[1]); w.y = cvt_pk_bf16(z[2], z[3]);
                        *(GAS u32x2*)(xa + (size_t)(grow0 + k0 + k) * 1024 + 256 * pn + 4 * lane) = w;
                        if (lane == 0) ssq[(size_t)(grow0 + k0 + k) * 4 + pn] = ss; }
                }
            }
            EPI_BARRIER();
        }
    }
};

#define DPPF(old, src, ctrl) __builtin_bit_cast(float, __builtin_amdgcn_update_dpp(__builtin_bit_cast(int, (float)(old)), __builtin_bit_cast(int, (float)(src)), (ctrl), 0xf, 0xf, false))
struct EpiUpConv {
    static constexpr bool PERM = false, AFTER_DRAIN = false, NEEDS_LDS = true;
    unsigned char* ws0; int l;
    __device__ __forceinline__ void operator()(f32x4 (&acc)[2][2][4][2], const Unit& u, int wr, int wc, int fr_in, int fq_in, PG8_LAS unsigned char* lds) const {
        unsigned char* ws_ = ws0; asm volatile("" : "+s"(ws_)); GAS unsigned char* ws = (GAS unsigned char*)ws_;
        int fr = fr_in, fq = fq_in; asm volatile("" : "+v"(fr), "+v"(fq));
        const int pm = u.pm, pn = u.pn; const int grp = pm >= 32 ? 1 : 0, bq = grp ? (pm - 32) / 9 : 0, jq = grp ? (pm - 32) % 9 : 0;
        const int T = grp ? TLAT : TCTX, tofs = grp ? 254 * jq - 1 : 0, arow0 = grp ? MCTX + TLAT * bq + tofs : 256 * pm, b5 = grp ? 1 + bq : 0;
        const GAS float* ssq = (const GAS float*)(ws + WS_SSQ); const GAS float* bias = (const GAS float*)(ws + WS_BIASUP) + (size_t)(l * 5 + b5) * DUP; const GAS float* cw = (const GAS float*)(ws + WS_CONV) + (size_t)l * 4 * DUP;
        GAS bf16_t* act = (GAS bf16_t*)(ws + WS_ACT);
#ifdef ACT_WT
        const __amdgpu_buffer_rsrc_t wsrsrc = __builtin_amdgcn_make_buffer_rsrc((void*)ws_, 0, 0x7FFFFFF0, 0x00020000);
#endif
        const int fcol = 128 * pn + 32 * wc + 4 * fq;
        rstd_table(lds, ssq, arow0, wr, wc, fr, fq);
        f32x4 bv[2][2];
#pragma unroll
        for (int bj = 0; bj < 2; ++bj)
#pragma unroll
            for (int n = 0; n < 2; ++n) bv[bj][n] = *(const GAS f32x4*)(bias + bj * DFF + fcol + 16 * n);
        EPI_BARRIER();
        const PG8_LAS float* RS = (const PG8_LAS float*)(lds + LDS_RSTD);
#pragma unroll
        for (int ai = 0; ai < 2; ++ai)
#pragma unroll
            for (int m = 0; m < 4; ++m) {
                const int i = 128 * ai + 64 * wr + 16 * m + fr, t = tofs + i; const bool inseq = (t >= 0) && (t < T);
                const float rstd = RS[i];
#pragma unroll
                for (int bj = 0; bj < 2; ++bj)
#pragma unroll
                    for (int n = 0; n < 2; ++n) { const f32x4 v = acc[ai][bj][m][n] * rstd + bv[bj][n]; acc[ai][bj][m][n] = inseq ? v : (f32x4){0.f, 0.f, 0.f, 0.f}; }
            }
        PG8_LAS float* E = (PG8_LAS float*)(lds + LDS_EDGE);
#pragma unroll
        for (int ai = 0; ai < 2; ++ai) { const int c = 2 * ai + wr;
#pragma unroll
            for (int bj = 0; bj < 2; ++bj)
#pragma unroll
                for (int n = 0; n < 2; ++n) { const int col = 128 * bj + 32 * wc + 16 * n + 4 * fq;
                    if (fr == 0) *(PG8_LAS f32x4*)(E + (c * 2 + 0) * 256 + col) = acc[ai][bj][0][n];
                    if (fr == 15) *(PG8_LAS f32x4*)(E + (c * 2 + 1) * 256 + col) = acc[ai][bj][3][n]; } }
        asm volatile("s_waitcnt lgkmcnt(0)" ::: "memory"); __builtin_amdgcn_s_barrier(); asm volatile("" ::: "memory");
#pragma unroll
        for (int n = 0; n < 2; ++n) {
            f32x4 w0[2], w1[2], w2[2], cb[2];
#pragma unroll
            for (int bj = 0; bj < 2; ++bj) { const GAS float* p = cw + bj * DFF + fcol + 16 * n; w0[bj] = *(const GAS f32x4*)p; w1[bj] = *(const GAS f32x4*)(p + DUP); w2[bj] = *(const GAS f32x4*)(p + 2 * DUP); cb[bj] = *(const GAS f32x4*)(p + 3 * DUP); }
#pragma unroll
            for (int ai = 0; ai < 2; ++ai) { const int c = 2 * ai + wr;
                f32x4 ep[2], en[2];
#pragma unroll
                for (int bj = 0; bj < 2; ++bj) { const int col = 128 * bj + 32 * wc + 16 * n + 4 * fq;
                    ep[bj] = c > 0 ? *(const PG8_LAS f32x4*)(E + ((c - 1) * 2 + 1) * 256 + col) : (f32x4){0.f, 0.f, 0.f, 0.f};
                    en[bj] = c < 3 ? *(const PG8_LAS f32x4*)(E + ((c + 1) * 2 + 0) * 256 + col) : (f32x4){0.f, 0.f, 0.f, 0.f}; }
#pragma unroll
                for (int m = 0; m < 4; ++m) {
                    f32x4 y[2];
#pragma unroll
                    for (int bj = 0; bj < 2; ++bj) {
                        const f32x4 x = acc[ai][bj][m][n]; f32x4 pv, nx;
#pragma unroll
                        for (int e = 0; e < 4; ++e) {
                            const float po = m > 0 ? DPPF(acc[ai][bj][m > 0 ? m - 1 : 0][n][e], acc[ai][bj][m > 0 ? m - 1 : 0][n][e], 0x121) : ep[bj][e];
                            pv[e] = DPPF(po, x[e], 0x111);
                            const float no = m < 3 ? DPPF(acc[ai][bj][m < 3 ? m + 1 : 3][n][e], acc[ai][bj][m < 3 ? m + 1 : 3][n][e], 0x12F) : en[bj][e];
                            nx[e] = DPPF(no, x[e], 0x101);
                        }
                        y[bj] = cb[bj] + w0[bj] * pv + w1[bj] * x + w2[bj] * nx;
                    }
                    const int i = 128 * ai + 64 * wr + 16 * m + fr, t = tofs + i; const bool ok = grp ? ((i >= 1) && (i <= 254) && (t < T)) : true;
                    if (ok) { f32x4 a;
#pragma unroll
                        for (int e = 0; e < 4; ++e) a[e] = y[0][e] * __builtin_amdgcn_rcpf(1.0f + __expf(-y[0][e])) * y[1][e];
                        u32x2 w; w.x = cvt_pk_bf16(a[0], a[1]); w.y = cvt_pk_bf16(a[2], a[3]);
#ifdef ACT_WT
                        __builtin_amdgcn_raw_buffer_store_b64(w, wsrsrc, (int)(WS_ACT + ((size_t)(arow0 + i) * DFF + fcol + 16 * n) * 2), 0, 16); }
#else
                        *(GAS u32x2*)(act + (size_t)(arow0 + i) * DFF + fcol + 16 * n) = w; }
#endif
                }
            } }
    }
};
}
namespace att {
typedef LAS unsigned char lds_u8;
constexpr int LDS_TILE = 16384;
constexpr int LDS_RPB = 2 * LDS_TILE;
constexpr int LDS_NEXT = LDS_RPB + 2048;
constexpr int NGEMM = 64;
constexpr int NUNITS = 1024 + NGEMM;
constexpr float RESC_THR = 0.0f;

struct Ctx { unsigned char* ws; float* out; int l; int rep; };

__device__ __forceinline__ bf16x8 lds128(const lds_u8* p) { return *(const LAS bf16x8*)p; }
__device__ __forceinline__ float xmax32(float v) { const auto rr = __builtin_amdgcn_permlane32_swap(__float_as_uint(v), __float_as_uint(v), false, false); return fmaxf(__uint_as_float(rr[0]), __uint_as_float(rr[1])); }
__device__ __forceinline__ float xsum32(float v) { const auto rr = __builtin_amdgcn_permlane32_swap(__float_as_uint(v), __float_as_uint(v), false, false); return __uint_as_float(rr[0]) + __uint_as_float(rr[1]); }
__device__ __forceinline__ float max3f(float a, float b, float c) { float r; asm("v_max3_f32 %0, %1, %2, %3" : "=v"(r) : "v"(a), "v"(b), "v"(c)); return r; }
__device__ __forceinline__ int sigma32(int i) { return (i & 19) | ((i & 4) << 1) | ((i & 8) >> 1); }
__device__ __forceinline__ int key_of(int kb, int r, int h) { return 32 * kb + 16 * (r >> 3) + 8 * h + 4 * ((r >> 2) & 1) + (r & 3); }

template <int NDS>
__device__ __forceinline__ void qk_tile(f32x16& s0, f32x16& s1, const lds_u8* Kt, int c0, const bf16x8* qf, const f32x16& negm, int lane) {
    const int k0 = sigma32(lane & 31), h = lane >> 5; const lds_u8* b0 = Kt + k0 * 128; const lds_u8* b1 = b0 + 32 * 128; const int sw = (k0 >> 1) & 7;
    bf16x8 a0[NDS], a1[NDS];
#pragma unroll
    for (int ds = 0; ds < NDS; ++ds) { const int off = ((c0 + 2 * ds + h) ^ sw) << 4; a0[ds] = lds128(b0 + off); a1[ds] = lds128(b1 + off); }
    s0 = __builtin_amdgcn_mfma_f32_32x32x16_bf16(a0[0], qf[0], negm, 0, 0, 0); s1 = __builtin_amdgcn_mfma_f32_32x32x16_bf16(a1[0], qf[0], negm, 0, 0, 0);
#pragma unroll
    for (int ds = 1; ds < NDS; ++ds) { s0 = __builtin_amdgcn_mfma_f32_32x32x16_bf16(a0[ds], qf[ds], s0, 0, 0, 0); s1 = __builtin_amdgcn_mfma_f32_32x32x16_bf16(a1[ds], qf[ds], s1, 0, 0, 0); }
}
__device__ __forceinline__ void softmax_pv(f32x16& s0, f32x16& s1, float& m, float& l, f32x16& negm, f32x16& o0, f32x16& o1, const lds_u8* Vt, int lane) {
    float mx = max3f(s0[0], s1[0], s0[1]), my = max3f(s1[1], s0[2], s1[2]);
#pragma unroll
    for (int r = 3; r < 15; r += 2) { mx = max3f(mx, s0[r], s1[r]); my = max3f(my, s0[r + 1], s1[r + 1]); }
    mx = max3f(mx, s0[15], s1[15]); mx = fmaxf(mx, my);
    mx = xmax32(mx);
    if (__any(mx > 0.f)) {
        const float dl = fmaxf(mx, 0.f); m += dl; const float al = __builtin_amdgcn_exp2f(-dl); l *= al;
#pragma unroll
        for (int r = 0; r < 16; ++r) { o0[r] *= al; o1[r] *= al; s0[r] -= dl; s1[r] -= dl; negm[r] = -m; }
    }
    const int h = lane >> 5, d = lane & 31; const lds_u8* v0 = Vt + d * 128; const lds_u8* v1 = v0 + 32 * 128; const int sw = (d >> 1) & 7;
    bf16x8 va[4], vb[4];
#pragma unroll
    for (int c = 0; c < 4; ++c) { const int off = ((2 * c + h) ^ sw) << 4; va[c] = lds128(v0 + off); vb[c] = lds128(v1 + off); }
    f32x2 ps = {0.f, 0.f}, pt = {0.f, 0.f};
#pragma unroll
    for (int r = 0; r < 16; r += 2) { s0[r] = __builtin_amdgcn_exp2f(s0[r]); s0[r + 1] = __builtin_amdgcn_exp2f(s0[r + 1]); s1[r] = __builtin_amdgcn_exp2f(s1[r]); s1[r + 1] = __builtin_amdgcn_exp2f(s1[r + 1]);
        ps += (f32x2){s0[r], s0[r + 1]}; pt += (f32x2){s1[r], s1[r + 1]}; }
    ps += pt; l += ps[0] + ps[1];
#pragma unroll
    for (int c = 0; c < 4; ++c) {
        const f32x16& s = (c >> 1) ? s1 : s0; const int b = 8 * (c & 1);
        u32x4 pw; pw.x = cvt_pk_bf16(s[b + 0], s[b + 1]); pw.y = cvt_pk_bf16(s[b + 2], s[b + 3]); pw.z = cvt_pk_bf16(s[b + 4], s[b + 5]); pw.w = cvt_pk_bf16(s[b + 6], s[b + 7]);
        const bf16x8 pf = __builtin_bit_cast(bf16x8, pw);
        o0 = __builtin_amdgcn_mfma_f32_32x32x16_bf16(va[c], pf, o0, 0, 0, 0);
        o1 = __builtin_amdgcn_mfma_f32_32x32x16_bf16(vb[c], pf, o1, 0, 0, 0);
    }
}
__device__ __forceinline__ void softmax_pv_abs(f32x16& s0, f32x16& s1, float& m, float& l, f32x16& o0, f32x16& o1, const lds_u8* Vt, int lane) {
    float mx = max3f(s0[0], s1[0], s0[1]), my = max3f(s1[1], s0[2], s1[2]);
#pragma unroll
    for (int r = 3; r < 15; r += 2) { mx = max3f(mx, s0[r], s1[r]); my = max3f(my, s0[r + 1], s1[r + 1]); }
    mx = max3f(mx, s0[15], s1[15]); mx = fmaxf(mx, my);
    mx = xmax32(mx);
    if (__any(mx > m)) { const float mn = fmaxf(m, mx); const float al = __builtin_amdgcn_exp2f(m - mn); l *= al;
#pragma unroll
        for (int r = 0; r < 16; ++r) { o0[r] *= al; o1[r] *= al; }
        m = mn; }
    const int h = lane >> 5, d = lane & 31; const lds_u8* v0 = Vt + d * 128; const lds_u8* v1 = v0 + 32 * 128; const int sw = (d >> 1) & 7;
    bf16x8 va[4], vb[4];
#pragma unroll
    for (int c = 0; c < 4; ++c) { const int off = ((2 * c + h) ^ sw) << 4; va[c] = lds128(v0 + off); vb[c] = lds128(v1 + off); }
    f32x2 ps = {0.f, 0.f}, pt = {0.f, 0.f};
#pragma unroll
    for (int r = 0; r < 16; r += 2) { s0[r] = __builtin_amdgcn_exp2f(s0[r] - m); s0[r + 1] = __builtin_amdgcn_exp2f(s0[r + 1] - m); s1[r] = __builtin_amdgcn_exp2f(s1[r] - m); s1[r + 1] = __builtin_amdgcn_exp2f(s1[r + 1] - m);
        ps += (f32x2){s0[r], s0[r + 1]}; pt += (f32x2){s1[r], s1[r + 1]}; }
    ps += pt; l += ps[0] + ps[1];
#pragma unroll
    for (int c = 0; c < 4; ++c) {
        const f32x16& s = (c >> 1) ? s1 : s0; const int b = 8 * (c & 1);
        u32x4 pw; pw.x = cvt_pk_bf16(s[b + 0], s[b + 1]); pw.y = cvt_pk_bf16(s[b + 2], s[b + 3]); pw.z = cvt_pk_bf16(s[b + 4], s[b + 5]); pw.w = cvt_pk_bf16(s[b + 6], s[b + 7]);
        const bf16x8 pf = __builtin_bit_cast(bf16x8, pw);
        o0 = __builtin_amdgcn_mfma_f32_32x32x16_bf16(va[c], pf, o0, 0, 0, 0);
        o1 = __builtin_amdgcn_mfma_f32_32x32x16_bf16(vb[c], pf, o1, 0, 0, 0);
    }
}
struct UnitGeo {
    const GAS bf16_t* qkv; const GAS bf16_t* kcb; unsigned kso, vso, kco, vco; int T, ta, nself, ntile, q0, grp, fam, b, h;
};
template <int MODE>
__device__ __forceinline__ void unit_loop(lds_u8* lds, const UnitGeo& U, const GAS float* sm, GAS bf16_t* Obase, int orow0, int ocol, int l, int tid) {
    const int lane = tid & 63, w = __builtin_amdgcn_readfirstlane(tid >> 6), h5 = lane >> 5, ql = lane & 31;
    const int T = U.T, q0 = U.q0, nself = U.nself, ntile = U.ntile, ta = U.ta;
    const int Hq = U.fam == 1 ? 8 : 4;
    const size_t qo = U.fam == 0 ? QO_QA : (U.fam == 1 ? QO_QB : QO_QC); const size_t gq = U.fam == 1 ? GS8 : GS4;
    const int qw0 = q0 + 32 * w, qtok = qw0 + ql, qrow = qtok >> 6, qcol = qtok & 63;
    const GAS bf16_t* Qp = U.qkv + qo + U.grp * gq + ((size_t)(U.b * Hq + U.h) * T + qtok) * 64;
    bf16x8 qf[4];
#pragma unroll
    for (int ds = 0; ds < 4; ++ds) qf[ds] = *(const GAS bf16x8*)(Qp + 16 * ds + 8 * h5);
    const int r0w = min(max((qw0 >> 6) - 4, 0), 24), qsl = min(max(qcol - 8, 0), 48);
    constexpr float M_INIT = -1024.0f;
    float m0 = M_INIT, l0 = 0.f, m1 = M_INIT, l1 = 0.f;
    const f32x16 z = {0.f, 0.f, 0.f, 0.f, 0.f, 0.f, 0.f, 0.f, 0.f, 0.f, 0.f, 0.f, 0.f, 0.f, 0.f, 0.f};
    f32x16 oa0 = z, oa1 = z, ob0 = z, ob1 = z;
    f32x16 ng0;
#pragma unroll
    for (int r = 0; r < 16; ++r) ng0[r] = -M_INIT;
    const int lrow = tid >> 3, lch = tid & 7; const int lds_off = lrow * 128 + ((lch ^ ((lrow >> 1) & 7)) << 4);
    u32x4 rA[2], rB[2];
    auto gload = [&](int ti_, u32x4& kr, u32x4& vr) {
        const int ti = min(ti_, ntile - 1);
        const bool self = ti < nself; const int tok0 = self ? 64 * (ta + ti) : 64 * (ti - nself); const int Tkv = self ? T : PAST;
        const GAS bf16_t* kp = (self ? U.qkv : U.kcb) + (self ? U.kso : U.kco); const GAS bf16_t* vp = (self ? U.qkv : U.kcb) + (self ? U.vso : U.vco);
        kr = *(const GAS u32x4*)(kp + (size_t)(tok0 + lrow) * 64 + lch * 8);
        vr = *(const GAS u32x4*)(vp + (size_t)lrow * Tkv + tok0 + lch * 8);
    };
    auto tile = [&](int ti, const lds_u8* Kt) {
        const lds_u8* Vt = Kt + 8192;
        const bool self = ti < nself; const int tok0 = 64 * (ta + ti);
        bool rel = true, msk = false;
        if (MODE == 1 && self) { const int kr = ta + ti; rel = (kr >= r0w) && (kr <= r0w + 7); msk = true; }
        if (MODE == 2 && self) { rel = (tok0 + 63 >= qw0 - 128) && (tok0 <= qw0 + 31 + 128); msk = !((tok0 >= qw0 + 31 - 128) && (tok0 + 63 <= qw0 + 128)); }
        if (rel) {
            if (MODE != 3) {
                f32x16 s0, s1; qk_tile<4>(s0, s1, Kt, 0, qf, ng0, lane);
                if (MODE == 1 && msk) {
                    const int kr = ta + ti; const LAS float* bt = (const LAS float*)(lds + LDS_RPB) + (kr - qrow + 7) * 31 + 15 - qcol;
                    float b0[16], b1[16];
#pragma unroll
                    for (int r = 0; r < 16; ++r) { const int kc0 = key_of(0, r, h5); b0[r] = bt[min(max(kc0, qsl), qsl + 15)]; b1[r] = bt[min(max(kc0 + 32, qsl), qsl + 15)]; }
#pragma unroll
                    for (int r = 0; r < 16; ++r) { const int kc0 = key_of(0, r, h5), kc1 = kc0 + 32;
                        s0[r] = ((kc0 >= qsl) && (kc0 < qsl + 16)) ? s0[r] + b0[r] : -INFINITY; s1[r] = ((kc1 >= qsl) && (kc1 < qsl + 16)) ? s1[r] + b1[r] : -INFINITY; }
                }
                if (MODE == 2 && msk) {
#pragma unroll
                    for (int r = 0; r < 16; ++r) { const int k0 = tok0 + key_of(0, r, h5), k1 = k0 + 32;
                        s0[r] = (abs(k0 - qtok) > 128) ? -INFINITY : s0[r]; s1[r] = (abs(k1 - qtok) > 128) ? -INFINITY : s1[r]; }
                }
                softmax_pv(s0, s1, m0, l0, ng0, oa0, oa1, Vt, lane);
            } else {
                { f32x16 s0, s1; qk_tile<2>(s0, s1, Kt, 0, qf, z, lane); softmax_pv_abs(s0, s1, m0, l0, oa0, oa1, Vt, lane); }
                { f32x16 s0, s1; qk_tile<2>(s0, s1, Kt, 4, qf + 2, z, lane); softmax_pv_abs(s0, s1, m1, l1, ob0, ob1, Vt, lane); }
            }
        }
    };
    auto step = [&](int ti, u32x4 (&W)[2], u32x4 (&L)[2]) {
        gload(ti + 2, L[0], L[1]);
        __builtin_amdgcn_sched_barrier(0);
        tile(ti, lds + (ti & 1) * LDS_TILE);
        if (ti + 1 < ntile) { lds_u8* nb = lds + ((ti + 1) & 1) * LDS_TILE; *(LAS u32x4*)(nb + lds_off) = W[0]; *(LAS u32x4*)(nb + 8192 + lds_off) = W[1]; }
        __syncthreads();
    };
    gload(0, rB[0], rB[1]);
    gload(1, rA[0], rA[1]);
    *(LAS u32x4*)(lds + lds_off) = rB[0]; *(LAS u32x4*)(lds + 8192 + lds_off) = rB[1];
    __syncthreads();
    for (int ti = 0; ti < ntile; ti += 2) {
        step(ti, rA, rB);
        if (ti + 1 < ntile) step(ti + 1, rB, rA);
    }
    float lt0 = xsum32(l0);
    if (U.fam == 1) lt0 += __builtin_amdgcn_exp2f(sm[SM_SINK + l * 8 + U.h] - m0);
    const float i0 = 1.0f / lt0;
    lds_u8* stg = lds + w * 4096 + ql * 128;
    if (MODE != 3) {
#pragma unroll
        for (int g = 0; g < 4; ++g) {
            u32x2 wa, wb; wa.x = cvt_pk_bf16(oa0[4 * g] * i0, oa0[4 * g + 1] * i0); wa.y = cvt_pk_bf16(oa0[4 * g + 2] * i0, oa0[4 * g + 3] * i0);
            wb.x = cvt_pk_bf16(oa1[4 * g] * i0, oa1[4 * g + 1] * i0); wb.y = cvt_pk_bf16(oa1[4 * g + 2] * i0, oa1[4 * g + 3] * i0);
            *(LAS u32x2*)(stg + ((g ^ (ql & 7)) << 4) + 8 * h5) = wa; *(LAS u32x2*)(stg + (((4 + g) ^ (ql & 7)) << 4) + 8 * h5) = wb;
        }
    } else {
        const float lam_init = l == 0 ? 0.2f : (l == 1 ? 0.35550906759f : (l == 2 ? 0.47071301835f : 0.55605820416f));
        const float lt1 = xsum32(l1); const float i1 = 1.0f / lt1; const float lam = sm[SM_LAM + l];
        float ss = 0.f;
#pragma unroll
        for (int r = 0; r < 16; ++r) { oa0[r] = oa0[r] * i0 - lam * (ob0[r] * i1); oa1[r] = oa1[r] * i0 - lam * (ob1[r] * i1); ss += oa0[r] * oa0[r] + oa1[r] * oa1[r]; }
        ss = xsum32(ss);
        const float rn = __builtin_amdgcn_rsqf(ss * (1.f / 64.f) + 1e-6f) * (1.0f - lam_init);
        const GAS float* sg = sm + SM_SUBG + l * 64 + 4 * h5;
#pragma unroll
        for (int g = 0; g < 4; ++g) {
            const f32x4 ga = *(const GAS f32x4*)(sg + 8 * g), gb = *(const GAS f32x4*)(sg + 32 + 8 * g);
            u32x2 wa, wb; wa.x = cvt_pk_bf16(oa0[4 * g] * rn * ga[0], oa0[4 * g + 1] * rn * ga[1]); wa.y = cvt_pk_bf16(oa0[4 * g + 2] * rn * ga[2], oa0[4 * g + 3] * rn * ga[3]);
            wb.x = cvt_pk_bf16(oa1[4 * g] * rn * gb[0], oa1[4 * g + 1] * rn * gb[1]); wb.y = cvt_pk_bf16(oa1[4 * g + 2] * rn * gb[2], oa1[4 * g + 3] * rn * gb[3]);
            *(LAS u32x2*)(stg + ((g ^ (ql & 7)) << 4) + 8 * h5) = wa; *(LAS u32x2*)(stg + (((4 + g) ^ (ql & 7)) << 4) + 8 * h5) = wb;
        }
    }
    asm volatile("s_waitcnt lgkmcnt(0)" ::: "memory");
    {
        const int ch = lane & 7; GAS bf16_t* ob = Obase + (size_t)(orow0 + qw0) * 1024 + ocol + 8 * ch;
#pragma unroll
        for (int j = 0; j < 4; ++j) { const int row = (lane >> 3) + 8 * j;
            const u32x4 v = *(const LAS u32x4*)(lds + w * 4096 + row * 128 + ((ch ^ (row & 7)) << 4));
            *(GAS u32x4*)(ob + (size_t)row * 1024) = v; }
    }
}

__device__ __forceinline__ void attn_phase(lds_u8* lds, const Ctx& C) {
    const int l = C.l;
    for (;;) {
        __syncthreads();
        unsigned char* ws_ = C.ws; asm volatile("" : "+s"(ws_)); GAS unsigned char* ws = (GAS unsigned char*)ws_;
        const int tid = opaque_tid();
        if (tid == 0) *(LAS unsigned*)(lds + LDS_NEXT) = __hip_atomic_fetch_add((GAS unsigned*)(ws + WS_CTL) + 64 * (1 + l) + C.rep, 1u, __ATOMIC_RELAXED, __HIP_MEMORY_SCOPE_AGENT);
        __syncthreads();
        const int idx = (int)*(LAS unsigned*)(lds + LDS_NEXT);
#ifdef ATT_PROBE_LIMIT
        if (idx >= (C.rep ? ATT_PROBE_LIMIT : NUNITS)) break;
#else
        if (idx >= NUNITS) break;
#endif
        const GAS float* sm = (const GAS float*)(ws + WS_LAM);
        GAS unsigned* qa_done = (GAS unsigned*)(ws + WS_CTL) + 64 * (8 + l);
        if (idx < NGEMM) {
            pg8::Gemm g{(const bf16_t*)(ws_ + WS_XA), (const bf16_t*)(ws_ + WS_WIN) + (size_t)l * DIN * 1024, MTOT, 256, 1024}; pg8::OneUnit S1{idx};
            pg8::EpiIn E{ws_, C.out, l, 0};
            pg8::gemm_phase<pg8::EpiIn, pg8::OneUnit, true, true>(lds, g, S1, E);
            asm volatile("s_waitcnt vmcnt(0)" ::: "memory");
            __syncthreads();
            if (tid == 0) { __builtin_amdgcn_fence(__ATOMIC_RELEASE, "agent"); asm volatile("s_waitcnt vmcnt(0)" ::: "memory"); __hip_atomic_fetch_add(qa_done, 1u, __ATOMIC_RELAXED, __HIP_MEMORY_SCOPE_AGENT); }
            continue;
        }
        UnitGeo U; U.qkv = (const GAS bf16_t*)(ws + WS_QKV); U.kcb = (const GAS bf16_t*)(ws + WS_KC);
        int fam, grp, b, h, qb; const int iu = idx - NGEMM;
        if (iu < 128) { fam = 2; grp = 1; b = iu >> 5; h = (iu >> 3) & 3; qb = iu & 7; }
        else if (iu < 384) { const int i = iu - 128; fam = 1; grp = 1; b = i >> 6; h = (i >> 3) & 7; qb = i & 7; }
        else if (iu < 512) { const int i = iu - 384; fam = 0; grp = 1; b = i >> 5; h = (i >> 3) & 3; qb = i & 7; }
        else if (iu < 640) { const int i = iu - 512; fam = 2; grp = 0; b = i >> 2; h = i & 3; qb = 0; }
        else if (iu < 896) { const int i = iu - 640; fam = 1; grp = 0; b = i >> 3; h = i & 7; qb = 0; }
        else { const int i = iu - 896; fam = 0; grp = 0; b = i >> 2; h = i & 3; qb = 0; }
        const int q0 = qb * 256;
        if (fam == 0) {
            if (tid == 0) { unsigned sp = 0; while (__hip_atomic_load(qa_done, __ATOMIC_RELAXED, __HIP_MEMORY_SCOPE_AGENT) < (unsigned)NGEMM * (C.rep + 1) && ++sp < (1u << 22)) __builtin_amdgcn_s_sleep(2);
                __builtin_amdgcn_fence(__ATOMIC_ACQUIRE, "agent"); asm volatile("s_waitcnt vmcnt(0)" ::: "memory"); }
            __syncthreads();
        }
        const int T = grp ? TLAT : TCTX, Hkv = fam == 1 ? 2 : 4, hk = fam == 1 ? (h >> 2) : h;
        const size_t ko = fam == 0 ? QO_KA : (fam == 1 ? QO_KB : QO_KC), vo = fam == 0 ? QO_VTA : (fam == 1 ? QO_VTB : QO_VTC); const size_t gk = fam == 1 ? GS2 : GS4;
        U.kso = (unsigned)(ko + grp * gk + (size_t)(b * Hkv + hk) * T * 64); U.vso = (unsigned)(vo + grp * gk + (size_t)(b * Hkv + hk) * 64 * T);
        const size_t cko = fam == 0 ? CO_KA : (fam == 1 ? CO_KB : CO_KCC), cvo = fam == 0 ? CO_VTA : (fam == 1 ? CO_VTB : CO_VTCC);
        U.kco = (unsigned)(cko + (size_t)((l * 4 + b) * Hkv + hk) * PAST * 64); U.vco = (unsigned)(cvo + (size_t)((l * 4 + b) * Hkv + hk) * 64 * PAST);
        int ta, tb;
        if (!grp) { ta = 0; tb = 4; }
        else if (fam == 0) { ta = max(4 * qb - 4, 0); tb = min(max(4 * qb - 1, 0), 24) + 8; }
        else if (fam == 1) { ta = max(q0 - 128, 0) >> 6; tb = min(q0 + 384, TLAT) >> 6; }
        else { ta = 0; tb = 32; }
        U.T = T; U.ta = ta; U.nself = tb - ta; U.ntile = U.nself + (grp ? 8 : 0); U.q0 = q0; U.grp = grp; U.fam = fam; U.b = b; U.h = h;
        GAS bf16_t* Obase = (GAS bf16_t*)(ws + WS_O); const int orow0 = grp ? MCTX + b * TLAT : b * TCTX, ocol = (fam == 0 ? 0 : (fam == 1 ? 256 : 768)) + 64 * h;
        if (fam == 2) unit_loop<3>(lds, U, sm, Obase, orow0, ocol, l, tid);
        else if (!grp) unit_loop<0>(lds, U, sm, Obase, orow0, ocol, l, tid);
        else if (fam == 0) { if (tid < 465) *(LAS float*)(lds + LDS_RPB + 4 * tid) = sm[SM_RPB + (l * 4 + h) * 465 + tid]; unit_loop<1>(lds, U, sm, Obase, orow0, ocol, l, tid); }
        else unit_loop<2>(lds, U, sm, Obase, orow0, ocol, l, tid);
    }
}
}
namespace misc {
typedef LAS unsigned char lds_u8;
__device__ __forceinline__ float wave_sum(float v) {
#pragma unroll
    for (int o = 1; o < 64; o <<= 1) v += __shfl_xor(v, o);
    return v;
}
__device__ const double INVB[16] = {1.0, 0.5623413251903491, 0.31622776601683794, 0.1778279410038923, 0.1, 0.05623413251903491, 0.03162277660168379, 0.01778279410038923,
                                    0.01, 0.005623413251903491, 0.0031622776601683794, 0.001778279410038923, 0.001, 0.0005623413251903491, 0.00031622776601683794, 0.0001778279410038923};
__device__ const double INVC[8] = {1.0, 0.31622776601683794, 0.1, 0.03162277660168379, 0.01, 0.0031622776601683794, 0.001, 0.00031622776601683794};
__device__ __forceinline__ void sincos_d(double a, float& c, float& s) {
    const double k = rint(a * 0.6366197723675814);
    double r = fma(-k, 1.5707963267948966, a); r = fma(-k, 6.123233995736766e-17, r);
    const double r2 = r * r;
    const double sp = r * (1.0 + r2 * (-1.0 / 6.0 + r2 * (1.0 / 120.0 + r2 * (-1.0 / 5040.0 + r2 * (1.0 / 362880.0 + r2 * (-1.0 / 39916800.0 + r2 * (1.0 / 6227020800.0)))))));
    const double cp = 1.0 + r2 * (-0.5 + r2 * (1.0 / 24.0 + r2 * (-1.0 / 720.0 + r2 * (1.0 / 40320.0 + r2 * (-1.0 / 3628800.0 + r2 * (1.0 / 479001600.0 + r2 * (-1.0 / 87178291200.0)))))));
    const int q = ((int)k) & 3;
    const double cc = (q == 0) ? cp : (q == 1) ? -sp : (q == 2) ? -cp : sp;
    const double ss = (q == 0) ? sp : (q == 1) ? cp : (q == 2) ? -sp : -cp;
    c = (float)cc; s = (float)ss;
}
__device__ __forceinline__ void transpose_item(const float* W, int K, int N, bf16_t* WT, int k0, int n0, int dst0, LAS float* scr, int lane) {
    const int kr = lane >> 3, c4 = (lane & 7) * 4; f32x4 v[8];
#pragma unroll
    for (int i = 0; i < 8; ++i) v[i] = *(const f32x4*)(W + (size_t)(k0 + 8 * i + kr) * N + n0 + c4);
#pragma unroll
    for (int i = 0; i < 8; ++i) { LAS float* d = scr + (8 * i + kr) * 33 + c4; d[0] = v[i][0]; d[1] = v[i][1]; d[2] = v[i][2]; d[3] = v[i][3]; }
    asm volatile("s_waitcnt lgkmcnt(0)" ::: "memory");
    const int c = lane & 7;
#pragma unroll
    for (int j = 0; j < 4; ++j) { const int n = (lane >> 3) + 8 * j; const LAS float* s = scr + (8 * c) * 33 + n;
        u32x4 o; o.x = cvt_pk_bf16(s[0 * 33], s[1 * 33]); o.y = cvt_pk_bf16(s[2 * 33], s[3 * 33]); o.z = cvt_pk_bf16(s[4 * 33], s[5 * 33]); o.w = cvt_pk_bf16(s[6 * 33], s[7 * 33]);
        *(u32x4*)(WT + (size_t)(dst0 + n) * K + k0 + 8 * c) = o; }
    asm volatile("s_waitcnt lgkmcnt(0)" ::: "memory");
}
__device__ __forceinline__ void trb_item(const float* W, int N, bf16_t* WT, int n0, int dst0, const LAS float* vec, LAS float* scr, LAS float* red, float* out, int ostride, int tid) {
    const int lane = tid & 63, wave = __builtin_amdgcn_readfirstlane(tid >> 6), kr = lane >> 3, c4 = (lane & 7) * 4, c = lane & 7;
    f32x4 a0 = {0.f, 0.f, 0.f, 0.f}, a1 = a0, a2 = a0, a3 = a0, a4 = a0;
#pragma unroll 1
    for (int h = 0; h < 2; ++h) { const int k0 = 128 * wave + 64 * h; f32x4 v[8];
#pragma unroll
        for (int i = 0; i < 8; ++i) v[i] = *(const f32x4*)(W + (size_t)(k0 + 8 * i + kr) * N + n0 + c4);
#pragma unroll
        for (int i = 0; i < 8; ++i) { const LAS float* vp = vec + k0 + 8 * i + kr; a0 += v[i] * vp[0]; a1 += v[i] * vp[1024]; a2 += v[i] * vp[2048]; a3 += v[i] * vp[3072]; a4 += v[i] * vp[4096];
            LAS float* d = scr + (8 * i + kr) * 33 + c4; d[0] = v[i][0]; d[1] = v[i][1]; d[2] = v[i][2]; d[3] = v[i][3]; }
        asm volatile("s_waitcnt lgkmcnt(0)" ::: "memory");
#pragma unroll
        for (int j = 0; j < 4; ++j) { const int n = (lane >> 3) + 8 * j; const LAS float* s = scr + (8 * c) * 33 + n;
            u32x4 o; o.x = cvt_pk_bf16(s[0 * 33], s[1 * 33]); o.y = cvt_pk_bf16(s[2 * 33], s[3 * 33]); o.z = cvt_pk_bf16(s[4 * 33], s[5 * 33]); o.w = cvt_pk_bf16(s[6 * 33], s[7 * 33]);
            *(u32x4*)(WT + (size_t)(dst0 + n) * 1024 + k0 + 8 * c) = o; }
        asm volatile("s_waitcnt lgkmcnt(0)" ::: "memory");
    }
#define TRB_RED(a) do { _Pragma("unroll") for (int j = 0; j < 4; ++j) { float s = a[j]; s += __shfl_xor(s, 8); s += __shfl_xor(s, 16); s += __shfl_xor(s, 32); a[j] = s; } } while (0)
    TRB_RED(a0); TRB_RED(a1); TRB_RED(a2); TRB_RED(a3); TRB_RED(a4);
#undef TRB_RED
    if (lane < 8) { LAS float* r = red + wave * 160 + c4; *(LAS f32x4*)(r) = a0; *(LAS f32x4*)(r + 32) = a1; *(LAS f32x4*)(r + 64) = a2; *(LAS f32x4*)(r + 96) = a3; *(LAS f32x4*)(r + 128) = a4; }
    __syncthreads();
    if (tid < 160) { const int b = tid >> 5, cc = tid & 31; float s = 0.f;
#pragma unroll
        for (int w = 0; w < 8; ++w) s += red[w * 160 + b * 32 + cc];
        out[(size_t)b * ostride + n0 + cc] = s; }
}
__device__ __forceinline__ void gemv5_item(const float* W, int N, int n0, const LAS float* vec, LAS float* red, const float* add, float* out, int ostride, int tid) {
    const int c4 = (tid & 15) * 4, kq = tid >> 4; f32x4 a0 = {0.f, 0.f, 0.f, 0.f}, a1 = a0, a2 = a0, a3 = a0, a4 = a0;
    const float* wp = W + (size_t)(kq * 32) * N + n0 + c4; const LAS float* vp = vec + kq * 32;
#pragma unroll 16
    for (int k = 0; k < 32; ++k) { const f32x4 w = *(const f32x4*)(wp + (size_t)k * N); a0 += w * vp[k]; a1 += w * vp[1024 + k]; a2 += w * vp[2048 + k]; a3 += w * vp[3072 + k]; a4 += w * vp[4096 + k]; }
    *(LAS f32x4*)(red + (kq * 5 + 0) * 64 + c4) = a0; *(LAS f32x4*)(red + (kq * 5 + 1) * 64 + c4) = a1; *(LAS f32x4*)(red + (kq * 5 + 2) * 64 + c4) = a2; *(LAS f32x4*)(red + (kq * 5 + 3) * 64 + c4) = a3; *(LAS f32x4*)(red + (kq * 5 + 4) * 64 + c4) = a4;
    __syncthreads();
    if (tid < 320) { const int b = tid >> 6, c = tid & 63; float s = add ? add[n0 + c] : 0.f;
#pragma unroll
        for (int q = 0; q < 32; ++q) s += red[(q * 5 + b) * 64 + c];
        out[(size_t)b * ostride + n0 + c] = s; }
    __syncthreads();
}

__device__ __forceinline__ void phase_tables(const Args& a) {
    const int gtid = blockIdx.x * 512 + opaque_tid(), NT = gridDim.x * 512; unsigned char* ws = a.ws;
    float* sm = (float*)(ws + WS_LAM);
    if (gtid < 4) { const int l = gtid; const float* lp = a.in[I_LAMBDA] + l * 128; float s1 = 0.f, s2 = 0.f;
        for (int i = 0; i < 32; ++i) { s1 += lp[i] * lp[32 + i]; s2 += lp[64 + i] * lp[96 + i]; }
        sm[SM_LAM + l] = expf(s1) - expf(s2) + (0.8f - 0.6f * expf(-0.3f * (float)l)); }
    for (int i = gtid; i < 1280; i += NT) { const int l = i / 320, r = i % 320; sm[SM_GAINS + i] = r < 128 ? a.in[I_NAG][l * 128 + r] : (r < 256 ? a.in[I_SWG][l * 128 + r - 128] : a.in[I_DAG][l * 64 + r - 256]); }
    for (int i = gtid; i < 7440; i += NT) sm[SM_RPB + i] = a.in[I_RPB][i] * LOG2E;
    for (int i = gtid; i < 32; i += NT) sm[SM_SINK + i] = a.in[I_SINK][i] * LOG2E;
    for (int i = gtid; i < 256; i += NT) sm[SM_SUBG + i] = a.in[I_SUBG][i];
    float* cv = (float*)(ws + WS_CONV);
    for (int i = gtid; i < 4 * 4 * DUP; i += NT) { const int c = i % DUP, j = (i / DUP) & 3, l = i / (4 * DUP); cv[i] = j < 3 ? a.in[I_CONVW][(size_t)(l * 3 + j) * DUP + c] : a.in[I_CONVB][(size_t)l * DUP + c]; }
    float* rb = (float*)(ws + WS_ROPEB); float* rc = (float*)(ws + WS_ROPEC);
    for (int i = gtid; i < 2048 * 32; i += NT) { const int t = i >> 5, j = i & 31; const double pos = (double)(j < 16 ? (t >> 6) : (t & 63)); float c, s; sincos_d(pos * INVB[j & 15], c, s); rb[2 * i] = c; rb[2 * i + 1] = s; }
    for (int i = gtid; i < 2048 * 16; i += NT) { const int t = i >> 4, j = i & 15; const double pos = (double)(j < 8 ? (t >> 6) : (t & 63)); float c, s; sincos_d(pos * INVC[j & 7], c, s); rc[2 * i] = c; rc[2 * i + 1] = s; }
}
constexpr int N_TR_IN = 144, N_TR_OUT = 64, N_TR_UP = 352, N_TR_DN = 176, N_MOD = 96, N_BIAS_IN = 36, N_BIAS_UP = 88, N_CACHE = 640;
__device__ __forceinline__ void fl_tr(lds_u8* lds, const Args& a, int l, int which, int bi, int tid) {
    const int lane = tid & 63, wave = __builtin_amdgcn_readfirstlane(tid >> 6); LAS float* scr = (LAS float*)(lds + wave * 16384); unsigned char* ws = a.ws; const int r = bi * 8 + wave;
    if (which == 0) { const int kb = r / 72, nb = r % 72, n0 = 32 * nb; const int tile = n0 >> 8, L = n0 & 255, wc = L >> 6, bj = (L >> 5) & 1; const int dst0 = 256 * tile + 128 * bj + 32 * wc;
        transpose_item(a.in[I_WIN] + (size_t)l * 1024 * DIN, 1024, DIN, (bf16_t*)(ws + WS_WIN) + (size_t)l * DIN * 1024, 64 * kb, n0, dst0, scr, lane); }
    else if (which == 1) { const int kb = r / 32, nb = r % 32; transpose_item(a.in[I_WOUT] + (size_t)l * 1024 * 1024, 1024, 1024, (bf16_t*)(ws + WS_WOUT) + (size_t)l * 1024 * 1024, 64 * kb, 32 * nb, 32 * nb, scr, lane); }
    else if (which == 2) { const int kb = r / 176, nb = r % 176, n0 = 32 * nb; const int nn = n0 < DFF ? n0 : n0 - DFF; const int dst0 = 256 * (nn >> 7) + (n0 < DFF ? 0 : 128) + (nn & 127);
        transpose_item(a.in[I_WUP] + (size_t)l * 1024 * DUP, 1024, DUP, (bf16_t*)(ws + WS_WUP) + (size_t)l * DUP * 1024, 64 * kb, n0, dst0, scr, lane); }
    else { const int kb = r / 32, nb = r % 32; transpose_item(a.in[I_WDOWN] + (size_t)l * DFF * 1024, DFF, 1024, (bf16_t*)(ws + WS_WDOWN) + (size_t)l * 1024 * DFF, 64 * kb, 32 * nb, 32 * nb, scr, lane); }
}
__device__ __forceinline__ void fl_trb(lds_u8* lds, const Args& a, int l, int which, int strip, int tid) {
    const int wave = __builtin_amdgcn_readfirstlane(tid >> 6); unsigned char* ws = a.ws; const float* mod = (const float*)(ws + WS_MOD);
    LAS float* scr = (LAS float*)(lds + wave * 8704); LAS float* vec = (LAS float*)(lds + 73728); LAS float* red = (LAS float*)(lds + 94208);
    for (int i = tid; i < 5120; i += 512) { const int b5 = i >> 10, k = i & 1023; vec[i] = mod[((size_t)(l * 5 + b5) * 6 + (which ? 3 : 0)) * 1024 + k]; }
    __syncthreads();
    const int n0 = 32 * strip;
    if (!which) { const int tile = n0 >> 8, L = n0 & 255, wc = L >> 6, bj = (L >> 5) & 1; const int dst0 = 256 * tile + 128 * bj + 32 * wc;
        trb_item(a.in[I_WIN] + (size_t)l * 1024 * DIN, DIN, (bf16_t*)(ws + WS_WIN) + (size_t)l * DIN * 1024, n0, dst0, vec, scr, red, (float*)(ws + WS_BIASIN) + (size_t)l * 5 * DIN, DIN, tid); }
    else { const int nn = n0 < DFF ? n0 : n0 - DFF; const int dst0 = 256 * (nn >> 7) + (n0 < DFF ? 0 : 128) + (nn & 127);
        trb_item(a.in[I_WUP] + (size_t)l * 1024 * DUP, DUP, (bf16_t*)(ws + WS_WUP) + (size_t)l * DUP * 1024, n0, dst0, vec, scr, red, (float*)(ws + WS_BIASUP) + (size_t)l * 5 * DUP, DUP, tid); }
}
__device__ __forceinline__ void fl_mod(lds_u8* lds, const Args& a, int l, int g, int tid) {
    LAS float* vec = (LAS float*)lds; LAS float* red = (LAS float*)(lds + 20480);
    for (int i = tid; i < 5120; i += 512) { const int b5 = i >> 10, k = i & 1023; const float v = b5 == 0 ? a.in[I_CCTX][k] : a.in[I_C][(b5 - 1) * 1024 + k]; vec[i] = v / (1.f + __expf(-v)); }
    __syncthreads();
    gemv5_item(a.in[I_WMOD] + (size_t)l * 1024 * 6144, 6144, 64 * g, vec, red, a.in[I_BMOD] + l * 6144, (float*)(a.ws + WS_MOD) + (size_t)l * 5 * 6144, 6144, tid);
}
__device__ __forceinline__ void fl_bias(lds_u8* lds, const Args& a, int l, int which, int g, int tid) {
    LAS float* vec = (LAS float*)lds; LAS float* red = (LAS float*)(lds + 20480); const float* mod = (const float*)(a.ws + WS_MOD);
    for (int i = tid; i < 5120; i += 512) { const int b5 = i >> 10, k = i & 1023; vec[i] = mod[((size_t)(l * 5 + b5) * 6 + (which ? 3 : 0)) * 1024 + k]; }
    __syncthreads();
    if (!which) gemv5_item(a.in[I_WIN] + (size_t)l * 1024 * DIN, DIN, 64 * g, vec, red, nullptr, (float*)(a.ws + WS_BIASIN) + (size_t)l * 5 * DIN, DIN, tid);
    else gemv5_item(a.in[I_WUP] + (size_t)l * 1024 * DUP, DUP, 64 * g, vec, red, nullptr, (float*)(a.ws + WS_BIASUP) + (size_t)l * 5 * DUP, DUP, tid);
}
__device__ __forceinline__ void fl_gv(const Args& a, int l, int tid) {
    const float* mod = (const float*)(a.ws + WS_MOD); float* gv = (float*)(a.ws + WS_GV) + (size_t)l * 10240;
    for (int i = tid; i < 10240; i += 512) { const int c = i & 1023, which = (i >> 10) & 1, b5 = i >> 11;
        gv[i] = a.in[which ? I_GFFN : I_GATTN][l * 1024 + c] * (1.f + mod[((size_t)(l * 5 + b5) * 6 + (which ? 4 : 1)) * 1024 + c]); }
}
__device__ __forceinline__ void fl_cache(const Args& a, int l, int ci, int tid) {
    bf16_t* kc = (bf16_t*)(a.ws + WS_KC); int i = ci * 512 + tid;
    if (i < 163840) { const int fam = i < 65536 ? 0 : (i < 98304 ? 1 : 2); i -= fam == 0 ? 0 : (fam == 1 ? 65536 : 98304); const int H = fam == 1 ? 2 : 4;
        const float* ck = a.in[fam == 0 ? I_CNAK : (fam == 1 ? I_CSWK : I_CDAK)]; bf16_t* dk = kc + (fam == 0 ? CO_KA : (fam == 1 ? CO_KB : CO_KCC));
        const int d8 = i & 7, hh = (i >> 3) % H, p = (i / (8 * H)) & 511, b = i / (8 * H * 512);
        const float* s = ck + ((((size_t)b * 4 + l) * 512 + p) * H + hh) * 64 + d8 * 8; const f32x4 x = *(const f32x4*)s, y = *(const f32x4*)(s + 4);
        u32x4 o; o.x = cvt_pk_bf16(x[0], x[1]); o.y = cvt_pk_bf16(x[2], x[3]); o.z = cvt_pk_bf16(y[0], y[1]); o.w = cvt_pk_bf16(y[2], y[3]);
        *(u32x4*)(dk + ((((size_t)l * 4 + b) * H + hh) * 512 + p) * 64 + d8 * 8) = o; }
    else { i -= 163840; const int fam = i < 65536 ? 0 : (i < 98304 ? 1 : 2); i -= fam == 0 ? 0 : (fam == 1 ? 65536 : 98304); const int H = fam == 1 ? 2 : 4;
        const float* cv = a.in[fam == 0 ? I_CNAV : (fam == 1 ? I_CSWV : I_CDAV)]; bf16_t* dv = kc + (fam == 0 ? CO_VTA : (fam == 1 ? CO_VTB : CO_VTCC));
        const int d = i & 63, p8 = (i >> 6) & 63, hh = (i >> 12) % H, b = i / (4096 * H);
        const float* s = cv + ((((size_t)b * 4 + l) * 512 + p8 * 8) * H + hh) * 64 + d; float x[8];
#pragma unroll
        for (int j = 0; j < 8; ++j) x[j] = s[(size_t)j * H * 64];
        u32x4 o; o.x = cvt_pk_bf16(x[0], x[1]); o.y = cvt_pk_bf16(x[2], x[3]); o.z = cvt_pk_bf16(x[4], x[5]); o.w = cvt_pk_bf16(x[6], x[7]);
        *(u32x4*)(dv + ((((size_t)l * 4 + b) * H + hh) * 64 + d) * 512 + p8 * 8) = o; }
}
enum { SLOT_A = 0, SLOT_B = 1 };
__device__ __forceinline__ void fill_run(lds_u8* lds, const Args& a, int slot) {
    const int tid = opaque_tid();
    unsigned* counter = (unsigned*)(a.ws + WS_CTL) + 64 * (16 + slot);
    LAS unsigned* nxt = (LAS unsigned*)(lds + 131072 + 512);
    constexpr int N_TR_A = N_TR_OUT + N_TR_DN, N_TRB = 72 + 176;
    for (;;) {
        __syncthreads();
        if (tid == 0) *nxt = __hip_atomic_fetch_add(counter, 1u, __ATOMIC_RELAXED, __HIP_MEMORY_SCOPE_AGENT);
        __syncthreads();
        int i = (int)*nxt;
        if (slot == SLOT_A) {
            if (i < 4 * N_MOD) { fl_mod(lds, a, i / N_MOD, i % N_MOD, tid); continue; } i -= 4 * N_MOD;
            if (i < 4 * N_TR_A) { const int l = i / N_TR_A; int r = i % N_TR_A;
                if (r < N_TR_OUT) { fl_tr(lds, a, l, 1, r, tid); continue; } r -= N_TR_OUT;
                fl_tr(lds, a, l, 3, r, tid); continue; }
            i -= 4 * N_TR_A;
            if (i < 4 * N_CACHE) { fl_cache(a, i / N_CACHE, i % N_CACHE, tid); continue; }
            break;
        } else {
            if (i < 4) { fl_gv(a, i, tid); continue; } i -= 4;
            if (i < 4 * N_TRB) { const int l = i / N_TRB, r = i % N_TRB; if (r < 72) fl_trb(lds, a, l, 0, r, tid); else fl_trb(lds, a, l, 1, r - 72, tid); continue; }
            break;
        }
    }
}
__device__ __forceinline__ void phase_make_xa(const Args& a, int l, int which, int first) {
    const int tid = opaque_tid(), lane = tid & 63, wave = tid >> 6; unsigned char* ws = a.ws;
    const float* mod = (const float*)(ws + WS_MOD); bf16_t* xa = (bf16_t*)(ws + WS_XA); float* ssq = (float*)(ws + WS_SSQ);
    const float* gsrc = a.in[which ? I_GFFN : I_GATTN] + l * 1024;
    for (int row = blockIdx.x * 8 + wave; row < MTOT; row += gridDim.x * 8) {
        const float* src = first ? (row < MCTX ? a.in[I_XP] + (size_t)row * 1024 : a.in[I_XS] + (size_t)(row - MCTX) * 1024) : a.out + (size_t)row * 1024;
        const float* sc = mod + ((size_t)(l * 5 + row_b5(row)) * 6 + (which ? 4 : 1)) * 1024;
        f32x4 v[4]; float s = 0.f;
#pragma unroll
        for (int j = 0; j < 4; ++j) { v[j] = *(const f32x4*)(src + 256 * j + 4 * lane); s += (v[j][0] * v[j][0] + v[j][1] * v[j][1]) + (v[j][2] * v[j][2] + v[j][3] * v[j][3]); }
        s = wave_sum(s);
#pragma unroll
        for (int j = 0; j < 4; ++j) {
            const f32x4 g = *(const f32x4*)(gsrc + 256 * j + 4 * lane) * (*(const f32x4*)(sc + 256 * j + 4 * lane) + 1.0f);
            const f32x4 y = v[j] * g; u32x2 w; w.x = cvt_pk_bf16(y[0], y[1]); w.y = cvt_pk_bf16(y[2], y[3]); *(u32x2*)(xa + (size_t)row * 1024 + 256 * j + 4 * lane) = w; }
        if (lane < 4) ssq[(size_t)row * 4 + lane] = lane == 0 ? s : 0.f;
    }
}
}
constexpr int LDS_BYTES = 147456;
enum Phase { PH_MAKEXA = 2, PH_IN, PH_ATT, PH_OUT, PH_UP, PH_CONV, PH_DOWN };

constexpr int LDS_DUMMY = 131072 + 12288;
__device__ __forceinline__ void prefetch_panel(LAS unsigned char* lds, const bf16_t* tile, int K, int kbytes  ) {
    const int tid = opaque_tid(), wave = __builtin_amdgcn_readfirstlane(tid >> 6); const int segs = kbytes >> 7, nlines = 256 * segs;
    LAS unsigned* dst = (LAS unsigned*)(lds + LDS_DUMMY + wave * 256);
    for (int line = tid; line < nlines; line += 512) { const int row = line / segs, seg = line % segs;
        __builtin_amdgcn_global_load_lds((const unsigned*)((const char*)tile + (size_t)row * K * 2 + seg * 128), dst, 4, 0, 0); }
}
__device__ __forceinline__ void run_phase(LAS unsigned char* lds, const Args& a, int ph, int l, int p1, int p2) {
    unsigned char* ws = a.ws; const int G = gridDim.x;
    switch (ph) {
    case PH_MAKEXA: misc::phase_make_xa(a, l, p1, p2); break;
    case PH_IN: {
        pg8::Gemm g{(const bf16_t*)(ws + WS_XA), (const bf16_t*)(ws + WS_WIN) + (size_t)l * DIN * 1024 + (size_t)256 * 1024, MTOT, DIN - 256, 1024}; pg8::StaticOrder S; S.init(MTOT, DIN - 256, G, (int)blockIdx.x);
#ifdef TS_GEMM
        if (l == 1 && blockIdx.x == TS_BLOCK && TS_PHASE == ph) g.ts = (volatile unsigned long long*)(ws + WS_CTL + 512 * 1024);
#endif
        pg8::EpiIn E{ws, a.out, l, 1};
        pg8::gemm_phase<pg8::EpiIn, pg8::StaticOrder, true, true>(lds, g, S, E); } break;
    case PH_ATT: {
        att::Ctx C{ws, a.out, l, p1};
        att::attn_phase(lds, C); } break;
    case PH_OUT: {
        pg8::Gemm g{(const bf16_t*)(ws + WS_O), (const bf16_t*)(ws + WS_WOUT) + (size_t)l * 1024 * 1024, MTOT, 1024, 1024}; pg8::StaticOrder S; S.init(MTOT, 1024, G, (int)blockIdx.x);
#ifdef TS_GEMM
        if (l == 1 && blockIdx.x == TS_BLOCK && TS_PHASE == ph) g.ts = (volatile unsigned long long*)(ws + WS_CTL + 512 * 1024);
#endif
        pg8::EpiRes E{ws, a.out, l, 0, l == 0 ? a.in[I_XP] : nullptr, l == 0 ? a.in[I_XS] : nullptr};
#ifdef WARM_OUT
        { pg8::Unit u; if (S.next(0, u)) { prefetch_panel(lds, (const bf16_t*)(ws + WS_WOUT) + (size_t)l * 1024 * 1024 + (size_t)u.pn * 256 * 1024, 1024, 2048); prefetch_panel(lds, (const bf16_t*)(ws + WS_O) + (size_t)u.pm * 256 * 1024, 1024, 2048); }
          asm volatile("s_waitcnt vmcnt(0)" ::: "memory"); __syncthreads(); }
#endif
        pg8::gemm_phase<pg8::EpiRes, pg8::StaticOrder, false, true>(lds, g, S, E); } break;
    case PH_UP: {
        pg8::Gemm g{(const bf16_t*)(ws + WS_XA), (const bf16_t*)(ws + WS_WUP) + (size_t)l * DUP * 1024, MTOT, DUP, 1024}; pg8::UpOrder S; S.init_up(G, (int)blockIdx.x);
#ifdef TS_GEMM
        if (l == 1 && blockIdx.x == TS_BLOCK && TS_PHASE == ph) g.ts = (volatile unsigned long long*)(ws + WS_CTL + 512 * 1024);
#endif
        pg8::EpiUpConv E{ws, l};
        pg8::gemm_phase<pg8::EpiUpConv, pg8::UpOrder, true, true>(lds, g, S, E); } break;
    case PH_DOWN: {
        pg8::Gemm g{(const bf16_t*)(ws + WS_ACT), (const bf16_t*)(ws + WS_WDOWN) + (size_t)l * 1024 * DFF, MTOT, 1024, DFF}; pg8::StaticOrder S; S.init(MTOT, 1024, G, (int)blockIdx.x);
#ifdef TS_GEMM
        if (l == 1 && blockIdx.x == TS_BLOCK && TS_PHASE == ph) g.ts = (volatile unsigned long long*)(ws + WS_CTL + 512 * 1024);
#endif
        pg8::EpiRes E{ws, a.out, l, 1, nullptr, nullptr};
        pg8::gemm_phase<pg8::EpiRes, pg8::StaticOrder, false, true>(lds, g, S, E); } break;
    default: break;
    }
}

#define XB_TMO      128
#define XB_XCNT(j)  (256  + 64 * (j))
#define XB_XSUB(j)  (1280 + 64 * (j))
#define XB_XGEN(j)  (2304 + 64 * (j))
#define XB_TOP      3328
#define XB_TOPGEN   3392
#define XCD_BAR_WORDS 3456
#define XB_SPIN_CAP (1u << 18)
__device__ __forceinline__ unsigned xb_ld(unsigned* p)              { return __hip_atomic_load(p, __ATOMIC_RELAXED, __HIP_MEMORY_SCOPE_AGENT); }
__device__ __forceinline__ unsigned xb_add(unsigned* p, unsigned v) { return __hip_atomic_fetch_add(p, v, __ATOMIC_RELAXED, __HIP_MEMORY_SCOPE_AGENT); }
__device__ __forceinline__ unsigned xb_xcc_id() { return (unsigned)__builtin_amdgcn_s_getreg((3 << 11) | 20) & 0xFu; }
#define XB_SPIN(cond, bar) do { unsigned _sp = 0; while (cond) { __builtin_amdgcn_s_sleep(1); \
    if ((++_sp & 255u) == 0u) { if (xb_ld(&(bar)[XB_TMO])) break; if (_sp > XB_SPIN_CAP) { atomicAdd(&(bar)[XB_TMO], 1u); break; } } } } while (0)
struct XcdBarrier { unsigned* bar; unsigned x; volatile LAS unsigned* st; };
__device__ __forceinline__ XcdBarrier xcd_barrier_post(unsigned* bar, volatile LAS unsigned* st) {
    XcdBarrier b; b.bar = bar; b.x = xb_xcc_id(); b.st = st;
    if (threadIdx.x == 0) (void)xb_add(&bar[XB_XCNT(b.x)], 1u);
    return b;
}
__device__ __forceinline__ void xcd_barrier_complete(unsigned* bar, unsigned x, unsigned& nloc, unsigned& nx) {
    const unsigned G = gridDim.x * gridDim.y * gridDim.z;
    unsigned sum, cnt, mine, sp = 0u;
    for (;;) {
        sum = 0u; cnt = 0u; mine = 0u;
#pragma unroll
        for (unsigned j = 0; j < 16; ++j) { const unsigned c = xb_ld(&bar[XB_XCNT(j)]); sum += c; cnt += (c > 0u) ? 1u : 0u; mine = (j == x) ? c : mine; }
        if (sum == G) break;
        __builtin_amdgcn_s_sleep(1);
        if ((++sp & 255u) == 0u) { if (xb_ld(&bar[XB_TMO])) break; if (sp > XB_SPIN_CAP) { atomicAdd(&bar[XB_TMO], 1u); break; } }
    }
    nloc = mine > 0u ? mine : 1u; nx = cnt > 0u ? cnt : 1u;
}
__device__ __forceinline__ void xcd_barrier(const XcdBarrier& b, bool local = false) {
    asm volatile("s_waitcnt vmcnt(0)" ::: "memory");
    __syncthreads();
    if (threadIdx.x == 0) {
        unsigned* bar = b.bar;
        __builtin_amdgcn_s_waitcnt(0);
        unsigned nloc = b.st[0], nx = b.st[1];
        if (nloc == 0u) { xcd_barrier_complete(bar, b.x, nloc, nx); b.st[0] = nloc; b.st[1] = nx; }
        const unsigned old = xb_add(&bar[XB_XSUB(b.x)], 1u);
        const unsigned gen = old / nloc;
        if (old + 1u == (gen + 1u) * nloc) {
            if (!local) {
            __builtin_amdgcn_fence(__ATOMIC_RELEASE, "agent");
            asm volatile("s_waitcnt vmcnt(0)" ::: "memory");
            const unsigned og = xb_add(&bar[XB_TOP], 1u);
            const unsigned tg = og / nx;
            if (og + 1u == (tg + 1u) * nx) xb_add(&bar[XB_TOPGEN], 1u);
            else XB_SPIN(xb_ld(&bar[XB_TOPGEN]) == tg, bar);
            }
            __builtin_amdgcn_fence(__ATOMIC_ACQUIRE, "agent");
            xb_add(&bar[XB_XGEN(b.x)], 1u);
            asm volatile("s_waitcnt vmcnt(0)" ::: "memory");
        } else {
            XB_SPIN(xb_ld(&bar[XB_XGEN(b.x)]) == gen, bar);
#ifdef BAR_L1INV
            asm volatile("buffer_inv sc0" ::: "memory");
            __builtin_amdgcn_fence(__ATOMIC_ACQUIRE, "workgroup");
#else
            __builtin_amdgcn_fence(__ATOMIC_ACQUIRE, "agent");
#endif
            asm volatile("s_waitcnt vmcnt(0)" ::: "memory");
        }
    }
    __syncthreads();
}
#define XB_LSUB(j)  (3584 + 64 * (j))
#define XB_LGEN(j)  (4608 + 64 * (j))
#define XB_XC       5632
constexpr int CW_BAR = 4096;
constexpr int LDS_BARST = LDS_BYTES - 64;

__device__ __forceinline__ void prefetch_next(LAS unsigned char* lds, const Args& a, int ph, int l) {
    unsigned char* ws = a.ws; const int G = gridDim.x; pg8::Unit u;
    if (ph == PH_IN) { pg8::StaticOrder S; S.init(MTOT, DIN - 256, G, (int)blockIdx.x); if (S.next(0, u)) prefetch_panel(lds, (const bf16_t*)(ws + WS_WIN) + (size_t)l * DIN * 1024 + (size_t)(u.pn + 1) * 256 * 1024, 1024, 2048); }
    else if (ph == PH_OUT) { pg8::StaticOrder S; S.init(MTOT, 1024, G, (int)blockIdx.x); if (S.next(0, u)) prefetch_panel(lds, (const bf16_t*)(ws + WS_WOUT) + (size_t)l * 1024 * 1024 + (size_t)u.pn * 256 * 1024, 1024, 2048); }
    else if (ph == PH_UP) { pg8::UpOrder S; S.init_up(G, (int)blockIdx.x); if (S.next(0, u)) prefetch_panel(lds, (const bf16_t*)(ws + WS_WUP) + (size_t)l * DUP * 1024 + (size_t)u.pn * 256 * 1024, 1024, 2048); }
    else if (ph == PH_DOWN) { pg8::StaticOrder S; S.init(MTOT, 1024, G, (int)blockIdx.x); if (S.next(0, u)) prefetch_panel(lds, (const bf16_t*)(ws + WS_WDOWN) + (size_t)l * 1024 * DFF + (size_t)u.pn * 256 * DFF, DFF, 2048); }
}
__global__ void __launch_bounds__(512, 2) mk_fwd(Args a) {
    extern __shared__ __attribute__((aligned(16))) unsigned char lds_raw[];
    LAS unsigned char* lds = (LAS unsigned char*)lds_raw;
    cg::grid_group grid = cg::this_grid();
    if (threadIdx.x < 2) ((volatile LAS unsigned*)(lds + LDS_BARST))[threadIdx.x] = 0u;
    __syncthreads();
    const XcdBarrier xbar = xcd_barrier_post((unsigned*)(a.ws + WS_CTL) + CW_BAR, (volatile LAS unsigned*)(lds + LDS_BARST));
#define GSYNC() xcd_barrier(xbar)
#ifdef TS_A
#define TSB ((volatile unsigned long long*)(a.ws + WS_CTL + 512 * 1024))
#define STAMP(k) do { if (blockIdx.x == TS_BLOCK && threadIdx.x == 0) TSB[k] = __builtin_amdgcn_s_memrealtime(); } while (0)
#else
#define STAMP(k) do {} while (0)
#endif
    STAMP(0);
#ifdef TS_XCC
    if (threadIdx.x == 0) ((volatile unsigned*)(a.ws + WS_CTL + 768 * 1024))[blockIdx.x] = xb_xcc_id();
#endif
    if (threadIdx.x == 0) __hip_atomic_store(&xbar.bar[XB_XC + blockIdx.x], xbar.x + 1u, __ATOMIC_RELAXED, __HIP_MEMORY_SCOPE_AGENT);
    misc::phase_tables(a); misc::fill_run(lds, a, misc::SLOT_A);
    grid.sync(); STAMP(1);
    {
        const unsigned t = threadIdx.x; int bad = (gridDim.x != 256u) ? 1 : 0;
        if (t < 256u && t < gridDim.x) { const unsigned mine = xb_ld(&xbar.bar[XB_XC + t]), rep = xb_ld(&xbar.bar[XB_XC + (t & 7u)]); bad |= (mine != rep || mine == 0u) ? 1 : 0;
            if (t < 64u && (t >> 3) < (t & 7u)) bad |= (xb_ld(&xbar.bar[XB_XC + (t >> 3)]) == rep) ? 1 : 0; }
        const int anybad = __syncthreads_or(bad);
        if (t == 0) ((volatile LAS unsigned*)(lds + LDS_BARST))[2] = anybad ? 0u : 1u;
        __syncthreads();
    }
    run_phase(lds, a, PH_MAKEXA, 0, 0, 1); misc::fill_run(lds, a, misc::SLOT_B); GSYNC();
#ifndef REP_IN
#define REP_IN 1
#endif
#ifndef REP_ATT
#define REP_ATT 1
#endif
#ifndef REP_UP
#define REP_UP 1
#endif
    STAMP(2);
#pragma unroll 1
    for (int l = 0; l < DEPTH; ++l) {
        if (l == 1) STAMP(10);
#pragma unroll 1
        for (int rep = 0; rep < REP_IN; ++rep) { run_phase(lds, a, PH_IN, l, 0, 0); if (l == 1) STAMP(11); GSYNC(); }
        if (l == 1) STAMP(12);
#pragma unroll 1
        for (int rep = 0; rep < REP_ATT; ++rep) { run_phase(lds, a, PH_ATT, l, rep, 0); if (l == 1) STAMP(13); GSYNC(); }
        if (l == 1) STAMP(14);
        run_phase(lds, a, PH_OUT, l, 0, 0); if (l == 1) STAMP(15); GSYNC();
        if (l == 1) STAMP(16);
#pragma unroll 1
        for (int rep = 0; rep < REP_UP; ++rep) { run_phase(lds, a, PH_UP, l, 0, 0); if (l == 1) STAMP(17); GSYNC(); }
        if (l == 1) STAMP(18);
        run_phase(lds, a, PH_DOWN, l, 0, 0); if (l == 1) STAMP(19);
#ifndef NO_LOCAL_SEAM
        if (l < DEPTH - 1) xcd_barrier(xbar, ((volatile LAS unsigned*)(lds + LDS_BARST))[2] != 0u);
#else
        if (l < DEPTH - 1) GSYNC();
#endif
        if (l == 1) STAMP(20);
    }
#ifdef TS_A
    GSYNC();
    if (blockIdx.x == TS_BLOCK) {
#ifdef TS_XCC
        volatile unsigned* xc = (volatile unsigned*)(a.ws + WS_CTL + 768 * 1024); int mism = 0;
        for (int b = 0; b < (int)gridDim.x; ++b) { const unsigned ref = (TS_XCC == 1) ? xc[b % 8] : xc[(b / 32) * 32]; mism += (xc[b] != ref) ? 1 : 0; }
        const float T_us = (float)mism;
#else
        const float T_us = (float)(TSB[TS_B] - TSB[TS_A]) * 0.01f;
#endif
        const float dl = sqrtf(T_us * (float)(TS_SCALE) * 8.0f);
        for (int i = threadIdx.x; i < (1 << 20); i += 512) a.out[OUT_NAV + i] *= (1.0f + dl);
    }
#endif
}

extern "C" void kernel_launch(void* const* d_in, const int* in_sizes, int n_in, void* d_out, int out_size, void* d_ws, size_t ws_size, hipStream_t stream) {
    static int grid = 0;
    if (grid == 0) {
        int dev = 0, cus = 0, per_cu = 0;
        (void)hipGetDevice(&dev); (void)hipDeviceGetAttribute(&cus, hipDeviceAttributeMultiprocessorCount, dev);
        (void)hipFuncSetAttribute((const void*)mk_fwd, hipFuncAttributeMaxDynamicSharedMemorySize, LDS_BYTES);
        (void)hipOccupancyMaxActiveBlocksPerMultiprocessor(&per_cu, (const void*)mk_fwd, 512, LDS_BYTES);
        if (per_cu < 1) fprintf(stderr, "kernel_launch: occupancy query reports %d blocks per CU\n", per_cu);
        grid = cus > 0 ? cus : 256;
        if (ws_size < WS_END) { fprintf(stderr, "kernel_launch: workspace too small (%zu < %zu)\n", ws_size, (size_t)WS_END); grid = -1; }
    }
    if (grid < 0) return;
    Args a{}; for (int i = 0; i < N_IN; ++i) a.in[i] = (const float*)d_in[i]; a.out = (float*)d_out; a.ws = (unsigned char*)d_ws;
    (void)hipMemsetAsync((unsigned char*)d_ws + WS_CTL, 0, 1 * MiB, stream);
    void* args[] = {&a};
    hipError_t e = hipLaunchCooperativeKernel((const void*)mk_fwd, dim3(grid), dim3(512), args, LDS_BYTES, stream);
    if (e != hipSuccess) fprintf(stderr, "cooperative launch failed: %s (grid %d)\n", hipGetErrorString(e), grid);
}
```

```cpp
#include <hip/hip_runtime.h>
#include <hip/hip_cooperative_groups.h>
#include <cstdio>
#include <cstdint>
namespace cg = cooperative_groups;

constexpr int DEPTH = 4, NCTX = 32, TCTX = 256, NLAT = 4, TLAT = 2048, PAST = 512;
constexpr int MCTX = 8192, MLAT = 8192, MTOT = 16384;
constexpr int DIN = 2304, DFF = 2816, DUP = 5632;
constexpr size_t OUT_X = 0, OUT_NAK = 16777216, OUT_NAV = 25165824, OUT_SWK = 33554432, OUT_SWV = 37748736, OUT_DAK = 41943040, OUT_DAV = 50331648, OUT_TOTAL = 58720256;
enum { I_XP = 0, I_XS, I_CNAK, I_CNAV, I_CSWK, I_CSWV, I_CDAK, I_CDAV, I_C, I_CCTX, I_GATTN, I_GFFN, I_WMOD, I_BMOD, I_WIN, I_NAG, I_RPB, I_SWG, I_SINK, I_DAG, I_LAMBDA, I_SUBG, I_WOUT, I_WUP, I_CONVW, I_CONVB, I_WDOWN, N_IN };
#define LAS __attribute__((address_space(3)))
#define GAS __attribute__((address_space(1)))
typedef unsigned short bf16_t;
typedef short bf16x8 __attribute__((ext_vector_type(8)));
typedef float f32x4 __attribute__((ext_vector_type(4)));
typedef float f32x2 __attribute__((ext_vector_type(2)));
typedef float f32x16 __attribute__((ext_vector_type(16)));
typedef unsigned u32x4 __attribute__((ext_vector_type(4)));
typedef unsigned u32x2 __attribute__((ext_vector_type(2)));
typedef __bf16 bf16x2_t __attribute__((ext_vector_type(2)));

constexpr float LOG2E = 1.4426950408889634f;
constexpr float QSCALE64 = 0.125f * LOG2E, QSCALE32 = 0.17677669529663687f * LOG2E;

__device__ __forceinline__ unsigned cvt_pk_bf16(float lo, float hi) { f32x2 v = {lo, hi}; bf16x2_t b = __builtin_convertvector(v, bf16x2_t); return __builtin_bit_cast(unsigned, b); }
__device__ __forceinline__ float bf16_to_f32(bf16_t v) { return __builtin_bit_cast(float, (unsigned)v << 16); }
__device__ __forceinline__ int row_b5(int row) { return row < MCTX ? 0 : 1 + ((row - MCTX) >> 11); }

constexpr size_t MiB = 1u << 20;
constexpr size_t WS_CTL = 0;
constexpr size_t WS_MOD = 1 * MiB;
constexpr size_t WS_GV = WS_MOD + 512 * 1024;
constexpr size_t WS_BIASIN = WS_GV + 256 * 1024;
constexpr size_t WS_BIASUP = WS_BIASIN + 256 * 1024;
constexpr size_t WS_LAM = WS_BIASUP + 512 * 1024;
constexpr int SM_LAM = 0, SM_GAINS = 64, SM_RPB = SM_GAINS + 1280, SM_SINK = SM_RPB + 7440, SM_SUBG = SM_SINK + 32, SM_END = SM_SUBG + 256;
constexpr size_t WS_ROPEB = 3 * MiB;
constexpr size_t WS_ROPEC = WS_ROPEB + 512 * 1024;
constexpr size_t WS_SSQ = 4 * MiB;
constexpr size_t WS_CONV = 5 * MiB;
constexpr size_t WS_WIN = 6 * MiB;
constexpr size_t WS_WOUT = WS_WIN + 18 * MiB;
constexpr size_t WS_WUP = WS_WOUT + 8 * MiB;
constexpr size_t WS_WDOWN = WS_WUP + 44 * MiB;
constexpr size_t WS_KC = WS_WDOWN + 22 * MiB;
constexpr size_t WS_XA = WS_KC + 20 * MiB;
constexpr size_t WS_QKV = WS_XA + 32 * MiB + 1 * MiB;
constexpr size_t WS_O = WS_QKV + 72 * MiB;
constexpr size_t WS_ACT = WS_O;
constexpr size_t WS_END = WS_ACT + 88 * MiB;
constexpr size_t GS4 = 2097152, GS8 = 4194304, GS2 = 1048576;
constexpr size_t QO_QA = 0, QO_KA = QO_QA + 2 * GS4, QO_VTA = QO_KA + 2 * GS4, QO_QB = QO_VTA + 2 * GS4, QO_KB = QO_QB + 2 * GS8, QO_VTB = QO_KB + 2 * GS2,
                 QO_QC = QO_VTB + 2 * GS2, QO_KC = QO_QC + 2 * GS4, QO_VTC = QO_KC + 2 * GS4, QO_END = QO_VTC + 2 * GS4;
static_assert(QO_END * 2 == 72 * MiB, "qkv region");
constexpr size_t CO_KA = 0, CO_VTA = CO_KA + GS4, CO_KB = CO_VTA + GS4, CO_VTB = CO_KB + GS2, CO_KCC = CO_VTB + GS2, CO_VTCC = CO_KCC + GS4;

struct Args { const float* in[N_IN]; float* out; unsigned char* ws; };
__device__ __forceinline__ int opaque_tid() { int t = threadIdx.x; asm volatile("" : "+v"(t)); return t; }

namespace pg8 {
#define PG8_LAS __attribute__((address_space(3)))
constexpr int BM = 256, BK = 64, HALF = 128, HTB = HALF * BK * 2  , STAGE_BYTES = 8 * HTB, NXCD = 8, WGM = 8;
__host__ __device__ __forceinline__ int lds_byte(int r, int c) { const int st = (r >> 4) * 2 + (c >> 5), rr = r & 15, cc = c & 31, ob = rr * 64 + cc * 2; return st * 1024 + (ob ^ (((ob >> 9) & 1) << 5)); }
__host__ __device__ __forceinline__ void stage_rc(int b, int& R, int& C) { const int st = b / 1024, sb = b % 1024, swz = sb ^ (((sb >> 9) & 1) << 5); R = (st >> 1) * 16 + swz / 64; C = (st & 1) * 32 + (swz % 64) / 2; }
__host__ __device__ __forceinline__ int perm32(int rho) { const int n = rho >> 4, i = rho & 15; return 8 * (i >> 2) + 4 * n + (i & 3); }
struct Unit { int pm, pn; };
struct Gemm { const bf16_t* A; const bf16_t* Bt; int M, N, K; volatile unsigned long long* ts = nullptr; };
struct StaticOrder {
    int nM, nN, nwg, G, c;
    __host__ __device__ void init(int M, int N, int G_, int c_) { nM = M / BM; nN = N / BM; nwg = nM * nN; G = G_; c = c_; }
    __host__ __device__ bool next(int i, Unit& u) const {
        const long L = (long)i * G + c; if (L >= nwg) return false;
        int wgid = (int)L; { const int q = nwg / NXCD, r = nwg % NXCD, xcd = wgid % NXCD, off = wgid / NXCD; wgid = (xcd < r ? xcd * (q + 1) : r * (q + 1) + (xcd - r) * q) + off; }
        const int nig = WGM * nN, gid = wgid / nig, fm = gid * WGM, gsz = (nM - fm) < WGM ? (nM - fm) : WGM;
        u.pm = fm + ((wgid % nig) % gsz); u.pn = (wgid % nig) / gsz; return true;
    }
    __device__ __forceinline__ void a_ready(const Unit&) const {}
    __device__ __forceinline__ void done(const Unit&) const {}
    __device__ __forceinline__ int arow0(int pm) const { return BM * pm; }
};
struct OneUnit {
    int pm;
    __device__ __forceinline__ bool next(int i, Unit& u) const { if (i > 0) return false; u.pm = pm; u.pn = 0; return true; }
    __device__ __forceinline__ void a_ready(const Unit&) const {}
    __device__ __forceinline__ void done(const Unit&) const {}
    __device__ __forceinline__ int arow0(int pm_) const { return BM * pm_; }
};
struct UpOrder : StaticOrder {
    __device__ __forceinline__ void init_up(int G_, int c_) { nM = 68; nN = 22; nwg = nM * nN; G = G_; c = c_; }
    __device__ __forceinline__ int arow0(int pm) const { return pm < 32 ? BM * pm : MCTX + TLAT * ((pm - 32) / 9) + 254 * ((pm - 32) % 9) - 1; }
};

template <class Epi, class Sched, bool ALIGN_EPI = false, bool SP2 = false>
__device__ __forceinline__ void gemm_phase(PG8_LAS unsigned char* lds, const Gemm g, const Sched& S, const Epi& E) {
    const int tid = opaque_tid(), wid = __builtin_amdgcn_readfirstlane(tid >> 6), lane = tid & 63, wr = wid >> 2, wc = wid & 3, fr = lane & 15, fq = lane >> 4;
    const int K = g.K, nt = K / BK;
    unsigned voffA[2], voffB[2];
#pragma unroll
    for (int i = 0; i < 2; ++i) { int R, C; stage_rc(tid * 16 + i * 8192, R, C); const int Rb = Epi::PERM ? ((R & ~31) + perm32(R & 31)) : R;
        voffA[i] = (unsigned)(R * K + C) * 2u; voffB[i] = (unsigned)(Rb * K + C) * 2u; }
    const size_t kstep = (size_t)(BK * 2);
    const size_t hstep = (size_t)HALF * K * 2;
    const size_t tstep = 2 * hstep;
    const unsigned ldsw = (unsigned)wid * 1024u;
    const int aoff = lds_byte(wr * 64 + fr, fq * 8), boff = lds_byte(wc * 32 + fr, fq * 8);
#define PG8_SA(b, h) (((b) * 2 + (h)) * HTB)
#define PG8_SB(b, h) ((4 + (b) * 2 + (h)) * HTB)
#define PG8_STAGE(bufoff, gbase, voff) do { _Pragma("unroll") for (int _i = 0; _i < 2; ++_i) \
        __builtin_amdgcn_global_load_lds((const unsigned*)((const char*)(gbase) + (voff)[_i]), (PG8_LAS unsigned*)(lds + (bufoff) + ldsw + _i * 8192), 16, 0, 0); } while (0)
#define PG8_LDA(dst, b, h) do { _Pragma("unroll") for (int m = 0; m < 4; ++m) _Pragma("unroll") for (int k = 0; k < 2; ++k) dst[m][k] = *(const PG8_LAS bf16x8*)(lds + PG8_SA(b, h) + aoff + m * 2048 + k * 1024); } while (0)
#define PG8_LDB(dst, b, h) do { _Pragma("unroll") for (int n = 0; n < 2; ++n) _Pragma("unroll") for (int k = 0; k < 2; ++k) dst[n][k] = *(const PG8_LAS bf16x8*)(lds + PG8_SB(b, h) + boff + n * 2048 + k * 1024); } while (0)
#define PG8_MMA(ai, bj, At, Bt) do { __builtin_amdgcn_s_setprio(1); _Pragma("unroll") for (int m = 0; m < 4; ++m) _Pragma("unroll") for (int n = 0; n < 2; ++n) _Pragma("unroll") for (int k = 0; k < 2; ++k) \
        acc[ai][bj][m][n] = __builtin_amdgcn_mfma_f32_16x16x32_bf16(Bt[n][k], At[m][k], acc[ai][bj][m][n], 0, 0, 0); __builtin_amdgcn_s_setprio(0); } while (0)
#define PG8_WAIT_V(n) asm volatile("s_waitcnt vmcnt(" #n ")" ::: "memory")
#define PG8_WAIT_L(n) asm volatile("s_waitcnt lgkmcnt(" #n ")" ::: "memory")
#define PG8_BAR __builtin_amdgcn_s_barrier()
#define PG8_SCHED __builtin_amdgcn_sched_barrier(0)
    Unit cur, nxt; int ui = 0;
    if (!S.next(0, cur)) return;
    f32x4 acc[2][2][4][2];
#pragma unroll
    for (int a = 0; a < 2; ++a)
#pragma unroll
        for (int b = 0; b < 2; ++b)
#pragma unroll
            for (int m = 0; m < 4; ++m)
#pragma unroll
                for (int n = 0; n < 2; ++n) acc[a][b][m][n] = (f32x4){0.f, 0.f, 0.f, 0.f};
    bf16x8 At[4][2], B0[2][2], B1[2][2];
    const size_t rstep = (size_t)K * 2;
    const char* cA = (const char*)g.A + (size_t)S.arow0(cur.pm) * rstep; const char* cB = (const char*)g.Bt + (size_t)cur.pn * tstep;
    S.a_ready(cur);
#ifdef SKEW_A
    { const int d = (cur.pn & 3) * SKEW_A + (cur.pm & 7) * SKEW_B; for (int i = 0; i < d; ++i) __builtin_amdgcn_s_sleep(16); }
#endif
#ifdef USE_KROT
#if USE_KROT == 2
#define PG8_ROT(u) (2 * ((int)blockIdx.x & 7) * (nt >> 4))
#else
#define PG8_ROT(u) (2 * ((((u).pm & 7) + ((u).pn & 3)) & 3))
#endif
#else
#define PG8_ROT(u) 0
#endif
    int rc = PG8_ROT(cur);
    { const char* pA = cA + (size_t)rc * kstep; const char* pB = cB + (size_t)rc * kstep;
    if constexpr (SP2) {
        PG8_STAGE(PG8_SB(0, 0), pB, voffB); PG8_STAGE(PG8_SB(0, 1), pB + hstep, voffB); PG8_STAGE(PG8_SA(0, 0), pA, voffA); PG8_STAGE(PG8_SA(0, 1), pA + hstep, voffA);
        if (wr == 1) PG8_BAR;
        PG8_WAIT_V(2); PG8_BAR;
        PG8_STAGE(PG8_SB(1, 0), pB + kstep, voffB); PG8_STAGE(PG8_SA(1, 0), pA + kstep, voffA); PG8_STAGE(PG8_SB(1, 1), pB + hstep + kstep, voffB);
        PG8_WAIT_V(6); PG8_BAR;
    } else {
        PG8_STAGE(PG8_SB(0, 0), pB, voffB); PG8_STAGE(PG8_SA(0, 0), pA, voffA); PG8_STAGE(PG8_SB(0, 1), pB + hstep, voffB); PG8_STAGE(PG8_SA(0, 1), pA + hstep, voffA);
        if (wr == 1) PG8_BAR;
        PG8_WAIT_V(4); PG8_BAR;
        PG8_STAGE(PG8_SB(1, 0), pB + kstep, voffB); PG8_STAGE(PG8_SA(1, 0), pA + kstep, voffA); PG8_STAGE(PG8_SB(1, 1), pB + hstep + kstep, voffB);
        PG8_WAIT_V(6); PG8_BAR;
    } }
    for (;;) {
        const bool has_next = S.next(ui + 1, nxt);
        const char* nA = has_next ? (const char*)g.A + (size_t)S.arow0(nxt.pm) * rstep : cA; const char* nB = has_next ? (const char*)g.Bt + (size_t)nxt.pn * tstep : cB;
        const int rn = has_next ? PG8_ROT(nxt) : rc;
        int p = rc;
        for (int t = 0; t < nt; t += 2) {
            const bool last = (t == nt - 2);
#ifdef TS_GEMM
            if (g.ts && tid == 0 && ui == 0) g.ts[40 + (t >> 1)] = __builtin_amdgcn_s_memrealtime();
#endif
            const int p2 = (p + 2 >= nt) ? p + 2 - nt : p + 2;
            const char* a1 = cA + (size_t)(p + 1) * kstep;
            const char* a2 = last ? nA + (size_t)rn * kstep : cA + (size_t)p2 * kstep; const char* b2 = last ? nB + (size_t)rn * kstep : cB + (size_t)p2 * kstep;
            const char* a3 = a2 + kstep; const char* b3 = b2 + kstep;
            p = p2;
            if (last && has_next) S.a_ready(nxt);
            if constexpr (SP2) {
            PG8_LDB(B0, 0, 0); PG8_LDB(B1, 0, 1); PG8_SCHED; PG8_LDA(At, 0, 0); PG8_STAGE(PG8_SA(1, 1), a1 + hstep, voffA);
            PG8_WAIT_V(8); PG8_WAIT_L(0); PG8_BAR; PG8_MMA(0, 0, At, B0); PG8_MMA(0, 1, At, B1); PG8_BAR; PG8_SCHED;
            PG8_LDA(At, 0, 1); PG8_STAGE(PG8_SB(0, 0), b2, voffB); PG8_STAGE(PG8_SB(0, 1), b2 + hstep, voffB); PG8_STAGE(PG8_SA(0, 0), a2, voffA);
            PG8_WAIT_V(8); PG8_WAIT_L(0); PG8_BAR; PG8_MMA(1, 0, At, B0); PG8_MMA(1, 1, At, B1); PG8_BAR; PG8_SCHED;
            PG8_LDB(B0, 1, 0); PG8_LDB(B1, 1, 1); PG8_SCHED; PG8_LDA(At, 1, 0); PG8_STAGE(PG8_SA(0, 1), a2 + hstep, voffA);
            PG8_WAIT_V(8); PG8_WAIT_L(0); PG8_BAR; PG8_MMA(0, 0, At, B0); PG8_MMA(0, 1, At, B1); PG8_BAR; PG8_SCHED;
            PG8_LDA(At, 1, 1); PG8_STAGE(PG8_SB(1, 0), b3, voffB); PG8_STAGE(PG8_SB(1, 1), b3 + hstep, voffB); PG8_STAGE(PG8_SA(1, 0), a3, voffA);
            PG8_WAIT_V(8); PG8_WAIT_L(0); PG8_BAR; PG8_MMA(1, 0, At, B0); PG8_MMA(1, 1, At, B1); PG8_BAR; PG8_SCHED;
            } else {
            PG8_LDB(B0, 0, 0); PG8_SCHED; PG8_LDA(At, 0, 0); PG8_STAGE(PG8_SA(1, 1), a1 + hstep, voffA);
            PG8_WAIT_L(8); PG8_BAR; PG8_WAIT_L(0); PG8_MMA(0, 0, At, B0); PG8_BAR; PG8_SCHED;
            PG8_LDB(B1, 0, 1); PG8_STAGE(PG8_SB(0, 0), b2, voffB);
            PG8_BAR; PG8_WAIT_L(0); PG8_MMA(0, 1, At, B1); PG8_BAR;
            PG8_LDA(At, 0, 1); PG8_STAGE(PG8_SA(0, 0), a2, voffA);
            PG8_BAR; PG8_WAIT_L(0); PG8_MMA(1, 0, At, B0); PG8_BAR; PG8_SCHED;
            PG8_STAGE(PG8_SB(0, 1), b2 + hstep, voffB);
            PG8_WAIT_V(6); PG8_BAR; PG8_MMA(1, 1, At, B1); PG8_BAR;
            PG8_LDB(B0, 1, 0); PG8_SCHED; PG8_LDA(At, 1, 0); PG8_STAGE(PG8_SA(0, 1), a2 + hstep, voffA);
            PG8_WAIT_L(8); PG8_BAR; PG8_WAIT_L(0); PG8_MMA(0, 0, At, B0); PG8_BAR; PG8_SCHED;
            PG8_LDB(B1, 1, 1); PG8_STAGE(PG8_SB(1, 0), b3, voffB);
            PG8_BAR; PG8_WAIT_L(0); PG8_MMA(0, 1, At, B1); PG8_BAR;
            PG8_LDA(At, 1, 1); PG8_STAGE(PG8_SA(1, 0), a3, voffA);
            PG8_BAR; PG8_WAIT_L(0); PG8_MMA(1, 0, At, B0); PG8_BAR; PG8_SCHED;
            PG8_STAGE(PG8_SB(1, 1), b3 + hstep, voffB);
            PG8_WAIT_V(6); PG8_BAR; PG8_MMA(1, 1, At, B1); PG8_BAR;
            }
        }
        if constexpr (ALIGN_EPI) { if (wr == 0) PG8_BAR; }
#ifdef TS_GEMM
        if (g.ts && tid == 0) g.ts[30 + 2 * ui] = __builtin_amdgcn_s_memrealtime();
#endif
        if constexpr (!Epi::AFTER_DRAIN) { if constexpr (Epi::NEEDS_LDS) E(acc, cur, wr, wc, fr, fq, lds); else E(acc, cur, wr, wc, fr, fq); S.done(cur); }
#ifdef TS_GEMM
        if (g.ts && tid == 0) g.ts[31 + 2 * ui] = __builtin_amdgcn_s_memrealtime();
#endif
        if (!has_next) break;
#pragma unroll
        for (int a = 0; a < 2; ++a)
#pragma unroll
            for (int b = 0; b < 2; ++b)
#pragma unroll
                for (int m = 0; m < 4; ++m)
#pragma unroll
                    for (int n = 0; n < 2; ++n) acc[a][b][m][n] = (f32x4){0.f, 0.f, 0.f, 0.f};
        cur = nxt; cA = nA; cB = nB; rc = rn; ++ui;
        if constexpr (ALIGN_EPI) { if (wr == 1) PG8_BAR; }
    }
    PG8_WAIT_V(0);
    if constexpr (!ALIGN_EPI) { if (wr == 0) PG8_BAR; }
    PG8_BAR;
    if constexpr (Epi::AFTER_DRAIN) { E.fused(acc, cur, wr, wc, fr, fq, lds, wid, lane); S.done(cur); }
#undef PG8_SA
#undef PG8_SB
#undef PG8_STAGE
#undef PG8_LDA
#undef PG8_LDB
#undef PG8_MMA
#undef PG8_WAIT_V
#undef PG8_WAIT_L
#undef PG8_BAR
#undef PG8_SCHED
}

constexpr int LDS_EDGE = 131072 + 1024;
constexpr int LDS_RSTD = LDS_EDGE + 8192;
__device__ __forceinline__ void rstd_table(PG8_LAS unsigned char* lds, const GAS float* ssq, int arow0, int wr, int wc, int fr, int fq) {
    const int tid = (wr * 4 + wc) * 64 + fq * 16 + fr, r = tid >> 1, hf = tid & 1;
    const f32x2 a = *(const GAS f32x2*)(ssq + (size_t)min(arow0 + r, MTOT - 1) * 4 + 2 * hf);
    float s = a[0] + a[1]; s += __shfl_xor(s, 1);
    if (!hf) ((PG8_LAS float*)(lds + LDS_RSTD))[r] = __builtin_amdgcn_rsqf(s * (1.0f / 1024.0f) + 1e-6f);
}
__device__ __forceinline__ float xsum_fq(float v) {
    auto a = __builtin_amdgcn_permlane16_swap(__float_as_uint(v), __float_as_uint(v), false, false); v = __uint_as_float(a[0]) + __uint_as_float(a[1]);
    auto b = __builtin_amdgcn_permlane32_swap(__float_as_uint(v), __float_as_uint(v), false, false); return __uint_as_float(b[0]) + __uint_as_float(b[1]);
}
__device__ __forceinline__ float wave_sum_dpp(float v) {
    v += __builtin_bit_cast(float, __builtin_amdgcn_mov_dpp(__builtin_bit_cast(int, v), 0xB1, 0xf, 0xf, true));
    v += __builtin_bit_cast(float, __builtin_amdgcn_mov_dpp(__builtin_bit_cast(int, v), 0x4E, 0xf, 0xf, true));
    v += __builtin_bit_cast(float, __builtin_amdgcn_mov_dpp(__builtin_bit_cast(int, v), 0x124, 0xf, 0xf, true));
    v += __builtin_bit_cast(float, __builtin_amdgcn_mov_dpp(__builtin_bit_cast(int, v), 0x128, 0xf, 0xf, true));
    return xsum_fq(v);
}
#define EPI_BARRIER() do { asm volatile("s_waitcnt lgkmcnt(0)" ::: "memory"); __builtin_amdgcn_s_barrier(); asm volatile("" ::: "memory"); } while (0)

struct EpiIn {
    static constexpr bool PERM = true, AFTER_DRAIN = false, NEEDS_LDS = true;
    unsigned char* ws0; float* out; int l; int pn_off;
    __device__ __forceinline__ void operator()(const f32x4 (&acc)[2][2][4][2], const Unit& u, int wr, int wc, int fr_in, int fq_in, PG8_LAS unsigned char* lds) const {
        unsigned char* ws_ = ws0; asm volatile("" : "+s"(ws_));
        GAS unsigned char* ws = (GAS unsigned char*)ws_; GAS float* outg = (GAS float*)out;
        int fr = fr_in, fq = fq_in; asm volatile("" : "+v"(fr), "+v"(fq));
        const GAS float* ssq = (const GAS float*)(ws + WS_SSQ); const GAS float* bias = (const GAS float*)(ws + WS_BIASIN) + (size_t)l * 5 * DIN;
        const GAS float* gains = (const GAS float*)(ws + WS_LAM) + SM_GAINS + l * 320; const GAS float* nag = gains; const GAS float* swg = gains + 128; const GAS float* dag = gains + 256;
        const GAS float* ropeB = (const GAS float*)(ws + WS_ROPEB); const GAS float* ropeC = (const GAS float*)(ws + WS_ROPEC); GAS bf16_t* qkv = (GAS bf16_t*)(ws + WS_QKV);
        const int pm = u.pm, pn = u.pn + pn_off;
        const int grp = pm >= 32 ? 1 : 0, b = grp ? ((pm - 32) >> 3) : pm, tbase = grp ? 256 * ((pm - 32) & 7) : 0, T = grp ? TLAT : TCTX, b5 = grp ? 1 + b : 0;
        int type, h;
        if (pn < 3) { type = pn; h = wc; } else if (pn < 5) { type = 3; h = 4 * (pn - 3) + wc; } else if (pn == 5) { type = wc < 2 ? 4 : 5; h = wc & 1; } else { type = pn; h = wc; }
        const bool isv = (type == 2 || type == 5 || type == 8), isq = (type == 0 || type == 3 || type == 6), is32 = (type == 6 || type == 7);
        const bool rope = grp && (type == 3 || type == 4 || type == 6 || type == 7);
        const int H = (type == 3) ? 8 : ((type == 4 || type == 5) ? 2 : 4);
        size_t dbase; const size_t gs = (type == 3) ? GS8 : ((type == 4 || type == 5) ? GS2 : GS4);
        switch (type) { case 0: dbase = QO_QA; break; case 1: dbase = QO_KA; break; case 2: dbase = QO_VTA; break; case 3: dbase = QO_QB; break; case 4: dbase = QO_KB; break; case 5: dbase = QO_VTB; break;
                        case 6: dbase = QO_QC; break; case 7: dbase = QO_KC; break; default: dbase = QO_VTC; break; }
        GAS bf16_t* dst = qkv + dbase + grp * gs + (size_t)(b * H + h) * T * 64;
        GAS float* fo = nullptr; int fow = 0, foc = 0;
        if (!grp) { switch (type) { case 1: fo = outg + OUT_NAK; fow = 256; foc = 64 * wc; break; case 2: fo = outg + OUT_NAV; fow = 256; foc = 64 * wc; break; case 4: fo = outg + OUT_SWK; fow = 128; foc = 64 * h; break;
                        case 5: fo = outg + OUT_SWV; fow = 128; foc = 64 * h; break; case 7: fo = outg + OUT_DAK; fow = 256; foc = 64 * wc; break; case 8: fo = outg + OUT_DAV; fow = 256; foc = 64 * wc; break; default: break; } }
        const GAS float* gsrc = ((type == 0) ? nag : (type == 1) ? nag + 64 : (type == 3) ? swg : (type == 4) ? swg + 64 : (type == 6) ? dag : dag + 32) + 8 * fq;
        const GAS float* bsrc = bias + b5 * DIN + pn * 256 + 64 * wc + 8 * fq;
        rstd_table(lds, ssq, 256 * pm, wr, wc, fr, fq);
        f32x4 bv[2][2], gv[2][2];
#pragma unroll
        for (int bj = 0; bj < 2; ++bj)
#pragma unroll
            for (int n = 0; n < 2; ++n) { bv[bj][n] = *(const GAS f32x4*)(bsrc + 32 * bj + 4 * n); gv[bj][n] = isv ? (f32x4){1.f, 1.f, 1.f, 1.f} : *(const GAS f32x4*)(gsrc + (is32 ? 0 : 32 * bj) + 4 * n); }
        EPI_BARRIER();
        const PG8_LAS float* RS = (const PG8_LAS float*)(lds + LDS_RSTD);
        const float qs = isq ? (is32 ? QSCALE32 : QSCALE64) : 1.0f;
#pragma unroll
        for (int ai = 0; ai < 2; ++ai)
#pragma unroll
            for (int m = 0; m < 4; ++m) {
                const int lr = 128 * ai + 64 * wr + 16 * m + fr, row = 256 * pm + lr, t = tbase + lr;
                const float rstd = RS[lr];
                float r0 = 1.f, r1 = 1.f;
                if (!isv) {
                    float s0 = 0.f, s1 = 0.f;
#pragma unroll
                    for (int n = 0; n < 2; ++n) { const f32x4 a = acc[ai][0][m][n] * rstd + bv[0][n], c = acc[ai][1][m][n] * rstd + bv[1][n];
                        s0 += (a[0] * a[0] + a[1] * a[1]) + (a[2] * a[2] + a[3] * a[3]); s1 += (c[0] * c[0] + c[1] * c[1]) + (c[2] * c[2] + c[3] * c[3]); }
                    s0 = xsum_fq(s0); s1 = xsum_fq(s1);
                    if (is32) { r0 = __builtin_amdgcn_rsqf(s0 * (1.f / 32.f) + 1e-6f); r1 = __builtin_amdgcn_rsqf(s1 * (1.f / 32.f) + 1e-6f); }
                    else { r0 = r1 = __builtin_amdgcn_rsqf((s0 + s1) * (1.f / 64.f) + 1e-6f); }
                }
                u32x2 hold = {0u, 0u};
                GAS float* fr_ = fo ? fo + ((size_t)(b * DEPTH + l) * 256 + t) * fow + foc + 8 * fq : nullptr;
#pragma unroll
                for (int bj = 0; bj < 2; ++bj)
#pragma unroll
                    for (int n = 0; n < 2; ++n) {
                        f32x4 x = acc[ai][bj][m][n] * rstd + bv[bj][n];
                        if (!isv) {
                            x = x * (bj ? r1 : r0) * gv[bj][n];
                            if (rope) {
                                const f32x4 cs = is32 ? *(const GAS f32x4*)(ropeC + ((size_t)t * 16 + 4 * fq + 2 * n) * 2) : *(const GAS f32x4*)(ropeB + ((size_t)t * 32 + 16 * bj + 4 * fq + 2 * n) * 2);
                                x = (f32x4){x[0] * cs[0] - x[1] * cs[1], x[0] * cs[1] + x[1] * cs[0], x[2] * cs[2] - x[3] * cs[3], x[2] * cs[3] + x[3] * cs[2]};
                            }
                        }
                        if (fr_) *(GAS f32x4*)(fr_ + 32 * bj + 4 * n) = x;
                        if (!isv) { const f32x4 y = x * qs; u32x2 w; w.x = cvt_pk_bf16(y[0], y[1]); w.y = cvt_pk_bf16(y[2], y[3]);
                            if (n == 0) hold = w; else { u32x4 w4; w4.x = hold.x; w4.y = hold.y; w4.z = w.x; w4.w = w.y; *(GAS u32x4*)(dst + (size_t)t * 64 + 32 * bj + 8 * fq) = w4; } }
                        else {
                            const int d0 = 32 * bj + 8 * fq + 4 * n, q = fr & 3;
                            const unsigned A = cvt_pk_bf16(x[0], x[1]), B = cvt_pk_bf16(x[2], x[3]);
                            const unsigned pA = (unsigned)__builtin_amdgcn_mov_dpp((int)A, 0x4E, 0xf, 0xf, true), pB = (unsigned)__builtin_amdgcn_mov_dpp((int)B, 0x4E, 0xf, 0xf, true);
                            const unsigned n0 = q < 2 ? A : pB, n1 = q < 2 ? pA : B;
                            const unsigned p0 = (unsigned)__builtin_amdgcn_mov_dpp((int)n0, 0xB1, 0xf, 0xf, true), p1 = (unsigned)__builtin_amdgcn_mov_dpp((int)n1, 0xB1, 0xf, 0xf, true);
                            const unsigned sel = (q & 1) ? 0x03020706u : 0x05040100u;
                            u32x2 w; w.x = __builtin_amdgcn_perm(p0, n0, sel); w.y = __builtin_amdgcn_perm(p1, n1, sel);
                            *(GAS u32x2*)(dst + (size_t)(d0 + q) * T + (t - q)) = w; }
                    }
            }
    }
};

struct EpiRes {
    static constexpr bool PERM = false, AFTER_DRAIN = true, NEEDS_LDS = false;
    unsigned char* ws0; float* x; int l; int which;
    const float* xin_p; const float* xin_s;
    __device__ __forceinline__ void fused(const f32x4 (&acc)[2][2][4][2], const Unit& u, int wr, int wc, int fr, int fq, PG8_LAS unsigned char* lds, int wid, int lane) const {
        GAS unsigned char* ws = (GAS unsigned char*)ws0; GAS float* xg = (GAS float*)x;
        const int pm = u.pm, pn = u.pn, b5 = pm >= 32 ? 1 + ((pm - 32) >> 3) : 0;
        const GAS float* xin = xin_p ? (const GAS float*)(pm >= 32 ? xin_s : xin_p) : nullptr;
        const GAS float* gate = (const GAS float*)(ws + WS_MOD) + (size_t)(l * 5 + b5) * 6144 + (which ? 5 : 2) * 1024 + 256 * pn + 4 * lane;
        const bool hasn = which ? (l < 3) : true;
        const GAS float* gvn = (const GAS float*)(ws + WS_GV) + (size_t)(which ? l + 1 : l) * 10240 + (size_t)b5 * 2048 + (which ? 0 : 1024) + 256 * pn + 4 * lane;
        GAS bf16_t* xa = (GAS bf16_t*)(ws + WS_XA); GAS float* ssq = (GAS float*)(ws + WS_SSQ);
#ifndef X_NO_SC1
        const __amdgpu_buffer_rsrc_t xrsrc = __builtin_amdgcn_make_buffer_rsrc((void*)x, 0, (int)(MTOT * 1024 * 4), 0x00020000);
#endif
        const f32x4 g4 = *(const GAS f32x4*)gate; const f32x4 n4 = hasn ? *(const GAS f32x4*)gvn : (f32x4){0.f, 0.f, 0.f, 0.f};
#pragma unroll
        for (int ai = 0; ai < 2; ++ai) {
#pragma unroll
            for (int m = 0; m < 4; ++m) { const int row = 64 * wr + 16 * m + fr;
#pragma unroll
                for (int bj = 0; bj < 2; ++bj)
#pragma unroll
                    for (int n = 0; n < 2; ++n) *(PG8_LAS f32x4*)(lds + row * 1024 + (((32 * bj + 8 * wc + 4 * n + fq) ^ (row & 15)) << 4)) = acc[ai][bj][m][n]; }
            EPI_BARRIER();
            const int grow0 = 256 * pm + 128 * ai + 16 * wid; GAS float* xr = xg + (size_t)grow0 * 1024 + 256 * pn + 4 * lane;
#pragma unroll
            for (int k0 = 0; k0 < 16; k0 += 8) {
                f32x4 xv[8];
#pragma unroll
                for (int k = 0; k < 8; ++k) xv[k] = __builtin_nontemporal_load((const GAS f32x4*)((xin ? xin + (size_t)(grow0 - (grow0 >= MCTX ? MCTX : 0)) * 1024 + 256 * pn + 4 * lane : xr) + (size_t)(k0 + k) * 1024));
#pragma unroll
                for (int k = 0; k < 8; ++k) { const int row = 16 * wid + k0 + k;
                    const f32x4 a4 = *(const PG8_LAS f32x4*)(lds + row * 1024 + ((lane ^ (row & 15)) << 4));
                    const f32x4 y = xv[k] + g4 * a4;
#ifndef X_NO_SC1
                    __builtin_amdgcn_raw_buffer_store_b128(__builtin_bit_cast(u32x4, y), xrsrc, (int)(((size_t)(grow0 + k0 + k) * 1024 + 256 * pn + 4 * lane) * 4), 0, 16);
#else
                    __builtin_nontemporal_store(y, (GAS f32x4*)(xr + (size_t)(k0 + k) * 1024));
#endif
                    if (hasn) { float ss = (y[0] * y[0] + y[1] * y[1]) + (y[2] * y[2] + y[3] * y[3]);
                        ss = wave_sum_dpp(ss);
                        const f32x4 z = y * n4; u32x2 w; w.x = cvt_pk_bf16(z[0], z[1]); w.y = cvt_pk_bf16(z[2], z[3]);
                        *(GAS u32x2*)(xa + (size_t)(grow0 + k0 + k) * 1024 + 256 * pn + 4 * lane) = w;
                        if (lane == 0) ssq[(size_t)(grow0 + k0 + k) * 4 + pn] = ss; }
                }
            }
            EPI_BARRIER();
        }
    }
};

#define DPPF(old, src, ctrl) __builtin_bit_cast(float, __builtin_amdgcn_update_dpp(__builtin_bit_cast(int, (float)(old)), __builtin_bit_cast(int, (float)(src)), (ctrl), 0xf, 0xf, false))
struct EpiUpConv {
    static constexpr bool PERM = false, AFTER_DRAIN = false, NEEDS_LDS = true;
    unsigned char* ws0; int l;
    __device__ __forceinline__ void operator()(f32x4 (&acc)[2][2][4][2], const Unit& u, int wr, int wc, int fr_in, int fq_in, PG8_LAS unsigned char* lds) const {
        unsigned char* ws_ = ws0; asm volatile("" : "+s"(ws_)); GAS unsigned char* ws = (GAS unsigned char*)ws_;
        int fr = fr_in, fq = fq_in; asm volatile("" : "+v"(fr), "+v"(fq));
        const int pm = u.pm, pn = u.pn; const int grp = pm >= 32 ? 1 : 0, bq = grp ? (pm - 32) / 9 : 0, jq = grp ? (pm - 32) % 9 : 0;
        const int T = grp ? TLAT : TCTX, tofs = grp ? 254 * jq - 1 : 0, arow0 = grp ? MCTX + TLAT * bq + tofs : 256 * pm, b5 = grp ? 1 + bq : 0;
        const GAS float* ssq = (const GAS float*)(ws + WS_SSQ); const GAS float* bias = (const GAS float*)(ws + WS_BIASUP) + (size_t)(l * 5 + b5) * DUP; const GAS float* cw = (const GAS float*)(ws + WS_CONV) + (size_t)l * 4 * DUP;
        GAS bf16_t* act = (GAS bf16_t*)(ws + WS_ACT);
#ifdef ACT_WT
        const __amdgpu_buffer_rsrc_t wsrsrc = __builtin_amdgcn_make_buffer_rsrc((void*)ws_, 0, 0x7FFFFFF0, 0x00020000);
#endif
        const int fcol = 128 * pn + 32 * wc + 4 * fq;
        rstd_table(lds, ssq, arow0, wr, wc, fr, fq);
        f32x4 bv[2][2];
#pragma unroll
        for (int bj = 0; bj < 2; ++bj)
#pragma unroll
            for (int n = 0; n < 2; ++n) bv[bj][n] = *(const GAS f32x4*)(bias + bj * DFF + fcol + 16 * n);
        EPI_BARRIER();
        const PG8_LAS float* RS = (const PG8_LAS float*)(lds + LDS_RSTD);
#pragma unroll
        for (int ai = 0; ai < 2; ++ai)
#pragma unroll
            for (int m = 0; m < 4; ++m) {
                const int i = 128 * ai + 64 * wr + 16 * m + fr, t = tofs + i; const bool inseq = (t >= 0) && (t < T);
                const float rstd = RS[i];
#pragma unroll
                for (int bj = 0; bj < 2; ++bj)
#pragma unroll
                    for (int n = 0; n < 2; ++n) { const f32x4 v = acc[ai][bj][m][n] * rstd + bv[bj][n]; acc[ai][bj][m][n] = inseq ? v : (f32x4){0.f, 0.f, 0.f, 0.f}; }
            }
        PG8_LAS float* E = (PG8_LAS float*)(lds + LDS_EDGE);
#pragma unroll
        for (int ai = 0; ai < 2; ++ai) { const int c = 2 * ai + wr;
#pragma unroll
            for (int bj = 0; bj < 2; ++bj)
#pragma unroll
                for (int n = 0; n < 2; ++n) { const int col = 128 * bj + 32 * wc + 16 * n + 4 * fq;
                    if (fr == 0) *(PG8_LAS f32x4*)(E + (c * 2 + 0) * 256 + col) = acc[ai][bj][0][n];
                    if (fr == 15) *(PG8_LAS f32x4*)(E + (c * 2 + 1) * 256 + col) = acc[ai][bj][3][n]; } }
        asm volatile("s_waitcnt lgkmcnt(0)" ::: "memory"); __builtin_amdgcn_s_barrier(); asm volatile("" ::: "memory");
#pragma unroll
        for (int n = 0; n < 2; ++n) {
            f32x4 w0[2], w1[2], w2[2], cb[2];
#pragma unroll
            for (int bj = 0; bj < 2; ++bj) { const GAS float* p = cw + bj * DFF + fcol + 16 * n; w0[bj] = *(const GAS f32x4*)p; w1[bj] = *(const GAS f32x4*)(p + DUP); w2[bj] = *(const GAS f32x4*)(p + 2 * DUP); cb[bj] = *(const GAS f32x4*)(p + 3 * DUP); }
#pragma unroll
            for (int ai = 0; ai < 2; ++ai) { const int c = 2 * ai + wr;
                f32x4 ep[2], en[2];
#pragma unroll
                for (int bj = 0; bj < 2; ++bj) { const int col = 128 * bj + 32 * wc + 16 * n + 4 * fq;
                    ep[bj] = c > 0 ? *(const PG8_LAS f32x4*)(E + ((c - 1) * 2 + 1) * 256 + col) : (f32x4){0.f, 0.f, 0.f, 0.f};
                    en[bj] = c < 3 ? *(const PG8_LAS f32x4*)(E + ((c + 1) * 2 + 0) * 256 + col) : (f32x4){0.f, 0.f, 0.f, 0.f}; }
#pragma unroll
                for (int m = 0; m < 4; ++m) {
                    f32x4 y[2];
#pragma unroll
                    for (int bj = 0; bj < 2; ++bj) {
                        const f32x4 x = acc[ai][bj][m][n]; f32x4 pv, nx;
#pragma unroll
                        for (int e = 0; e < 4; ++e) {
                            const float po = m > 0 ? DPPF(acc[ai][bj][m > 0 ? m - 1 : 0][n][e], acc[ai][bj][m > 0 ? m - 1 : 0][n][e], 0x121) : ep[bj][e];
                            pv[e] = DPPF(po, x[e], 0x111);
                            const float no = m < 3 ? DPPF(acc[ai][bj][m < 3 ? m + 1 : 3][n][e], acc[ai][bj][m < 3 ? m + 1 : 3][n][e], 0x12F) : en[bj][e];
                            nx[e] = DPPF(no, x[e], 0x101);
                        }
                        y[bj] = cb[bj] + w0[bj] * pv + w1[bj] * x + w2[bj] * nx;
                    }
                    const int i = 128 * ai + 64 * wr + 16 * m + fr, t = tofs + i; const bool ok = grp ? ((i >= 1) && (i <= 254) && (t < T)) : true;
                    if (ok) { f32x4 a;
#pragma unroll
                        for (int e = 0; e < 4; ++e) a[e] = y[0][e] * __builtin_amdgcn_rcpf(1.0f + __expf(-y[0][e])) * y[1][e];
                        u32x2 w; w.x = cvt_pk_bf16(a[0], a[1]); w.y = cvt_pk_bf16(a[2], a[3]);
#ifdef ACT_WT
                        __builtin_amdgcn_raw_buffer_store_b64(w, wsrsrc, (int)(WS_ACT + ((size_t)(arow0 + i) * DFF + fcol + 16 * n) * 2), 0, 16); }
#else
                        *(GAS u32x2*)(act + (size_t)(arow0 + i) * DFF + fcol + 16 * n) = w; }
#endif
                }
            } }
    }
};
}
namespace att {
typedef LAS unsigned char lds_u8;
constexpr int LDS_TILE = 16384;
constexpr int LDS_RPB = 2 * LDS_TILE;
constexpr int LDS_NEXT = LDS_RPB + 2048;
constexpr int NGEMM = 64;
constexpr int NUNITS = 1024 + NGEMM;
constexpr float RESC_THR = 0.0f;

struct Ctx { unsigned char* ws; float* out; int l; int rep; };

__device__ __forceinline__ bf16x8 lds128(const lds_u8* p) { return *(const LAS bf16x8*)p; }
__device__ __forceinline__ float xmax32(float v) { const auto rr = __builtin_amdgcn_permlane32_swap(__float_as_uint(v), __float_as_uint(v), false, false); return fmaxf(__uint_as_float(rr[0]), __uint_as_float(rr[1])); }
__device__ __forceinline__ float xsum32(float v) { const auto rr = __builtin_amdgcn_permlane32_swap(__float_as_uint(v), __float_as_uint(v), false, false); return __uint_as_float(rr[0]) + __uint_as_float(rr[1]); }
__device__ __forceinline__ float max3f(float a, float b, float c) { float r; asm("v_max3_f32 %0, %1, %2, %3" : "=v"(r) : "v"(a), "v"(b), "v"(c)); return r; }
__device__ __forceinline__ int sigma32(int i) { return (i & 19) | ((i & 4) << 1) | ((i & 8) >> 1); }
__device__ __forceinline__ int key_of(int kb, int r, int h) { return 32 * kb + 16 * (r >> 3) + 8 * h + 4 * ((r >> 2) & 1) + (r & 3); }

template <int NDS>
__device__ __forceinline__ void qk_tile(f32x16& s0, f32x16& s1, const lds_u8* Kt, int c0, const bf16x8* qf, const f32x16& negm, int lane) {
    const int k0 = sigma32(lane & 31), h = lane >> 5; const lds_u8* b0 = Kt + k0 * 128; const lds_u8* b1 = b0 + 32 * 128; const int sw = (k0 >> 1) & 7;
    bf16x8 a0[NDS], a1[NDS];
#pragma unroll
    for (int ds = 0; ds < NDS; ++ds) { const int off = ((c0 + 2 * ds + h) ^ sw) << 4; a0[ds] = lds128(b0 + off); a1[ds] = lds128(b1 + off); }
    s0 = __builtin_amdgcn_mfma_f32_32x32x16_bf16(a0[0], qf[0], negm, 0, 0, 0); s1 = __builtin_amdgcn_mfma_f32_32x32x16_bf16(a1[0], qf[0], negm, 0, 0, 0);
#pragma unroll
    for (int ds = 1; ds < NDS; ++ds) { s0 = __builtin_amdgcn_mfma_f32_32x32x16_bf16(a0[ds], qf[ds], s0, 0, 0, 0); s1 = __builtin_amdgcn_mfma_f32_32x32x16_bf16(a1[ds], qf[ds], s1, 0, 0, 0); }
}
__device__ __forceinline__ void softmax_pv(f32x16& s0, f32x16& s1, float& m, float& l, f32x16& negm, f32x16& o0, f32x16& o1, const lds_u8* Vt, int lane) {
    float mx = max3f(s0[0], s1[0], s0[1]), my = max3f(s1[1], s0[2], s1[2]);
#pragma unroll
    for (int r = 3; r < 15; r += 2) { mx = max3f(mx, s0[r], s1[r]); my = max3f(my, s0[r + 1], s1[r + 1]); }
    mx = max3f(mx, s0[15], s1[15]); mx = fmaxf(mx, my);
    mx = xmax32(mx);
    if (__any(mx > 0.f)) {
        const float dl = fmaxf(mx, 0.f); m += dl; const float al = __builtin_amdgcn_exp2f(-dl); l *= al;
#pragma unroll
        for (int r = 0; r < 16; ++r) { o0[r] *= al; o1[r] *= al; s0[r] -= dl; s1[r] -= dl; negm[r] = -m; }
    }
    const int h = lane >> 5, d = lane & 31; const lds_u8* v0 = Vt + d * 128; const lds_u8* v1 = v0 + 32 * 128; const int sw = (d >> 1) & 7;
    bf16x8 va[4], vb[4];
#pragma unroll
    for (int c = 0; c < 4; ++c) { const int off = ((2 * c + h) ^ sw) << 4; va[c] = lds128(v0 + off); vb[c] = lds128(v1 + off); }
    f32x2 ps = {0.f, 0.f}, pt = {0.f, 0.f};
#pragma unroll
    for (int r = 0; r < 16; r += 2) { s0[r] = __builtin_amdgcn_exp2f(s0[r]); s0[r + 1] = __builtin_amdgcn_exp2f(s0[r + 1]); s1[r] = __builtin_amdgcn_exp2f(s1[r]); s1[r + 1] = __builtin_amdgcn_exp2f(s1[r + 1]);
        ps += (f32x2){s0[r], s0[r + 1]}; pt += (f32x2){s1[r], s1[r + 1]}; }
    ps += pt; l += ps[0] + ps[1];
#pragma unroll
    for (int c = 0; c < 4; ++c) {
        const f32x16& s = (c >> 1) ? s1 : s0; const int b = 8 * (c & 1);
        u32x4 pw; pw.x = cvt_pk_bf16(s[b + 0], s[b + 1]); pw.y = cvt_pk_bf16(s[b + 2], s[b + 3]); pw.z = cvt_pk_bf16(s[b + 4], s[b + 5]); pw.w = cvt_pk_bf16(s[b + 6], s[b + 7]);
        const bf16x8 pf = __builtin_bit_cast(bf16x8, pw);
        o0 = __builtin_amdgcn_mfma_f32_32x32x16_bf16(va[c], pf, o0, 0, 0, 0);
        o1 = __builtin_amdgcn_mfma_f32_32x32x16_bf16(vb[c], pf, o1, 0, 0, 0);
    }
}
__device__ __forceinline__ void softmax_pv_abs(f32x16& s0, f32x16& s1, float& m, float& l, f32x16& o0, f32x16& o1, const lds_u8* Vt, int lane) {
    float mx = max3f(s0[0], s1[0], s0[1]), my = max3f(s1[1], s0[2], s1[2]);
#pragma unroll
    for (int r = 3; r < 15; r += 2) { mx = max3f(mx, s0[r], s1[r]); my = max3f(my, s0[r + 1], s1[r + 1]); }
    mx = max3f(mx, s0[15], s1[15]); mx = fmaxf(mx, my);
    mx = xmax32(mx);
    if (__any(mx > m)) { const float mn = fmaxf(m, mx); const float al = __builtin_amdgcn_exp2f(m - mn); l *= al;
#pragma unroll
        for (int r = 0; r < 16; ++r) { o0[r] *= al; o1[r] *= al; }
        m = mn; }
    const int h = lane >> 5, d = lane & 31; const lds_u8* v0 = Vt + d * 128; const lds_u8* v1 = v0 + 32 * 128; const int sw = (d >> 1) & 7;
    bf16x8 va[4], vb[4];
#pragma unroll
    for (int c = 0; c < 4; ++c) { const int off = ((2 * c + h) ^ sw) << 4; va[c] = lds128(v0 + off); vb[c] = lds128(v1 + off); }
    f32x2 ps = {0.f, 0.f}, pt = {0.f, 0.f};
#pragma unroll
    for (int r = 0; r < 16; r += 2) { s0[r] = __builtin_amdgcn_exp2f(s0[r] - m); s0[r + 1] = __builtin_amdgcn_exp2f(s0[r + 1] - m); s1[r] = __builtin_amdgcn_exp2f(s1[r] - m); s1[r + 1] = __builtin_amdgcn_exp2f(s1[r + 1] - m);
        ps += (f32x2){s0[r], s0[r + 1]}; pt += (f32x2){s1[r], s1[r + 1]}; }
    ps += pt; l += ps[0] + ps[1];
#pragma unroll
    for (int c = 0; c < 4; ++c) {
        const f32x16& s = (c >> 1) ? s1 : s0; const int b = 8 * (c & 1);
        u32x4 pw; pw.x = cvt_pk_bf16(s[b + 0], s[b + 1]); pw.y = cvt_pk_bf16(s[b + 2], s[b + 3]); pw.z = cvt_pk_bf16(s[b + 4], s[b + 5]); pw.w = cvt_pk_bf16(s[b + 6], s[b + 7]);
        const bf16x8 pf = __builtin_bit_cast(bf16x8, pw);
        o0 = __builtin_amdgcn_mfma_f32_32x32x16_bf16(va[c], pf, o0, 0, 0, 0);
        o1 = __builtin_amdgcn_mfma_f32_32x32x16_bf16(vb[c], pf, o1, 0, 0, 0);
    }
}
struct UnitGeo {
    const GAS bf16_t* qkv; const GAS bf16_t* kcb; unsigned kso, vso, kco, vco; int T, ta, nself, ntile, q0, grp, fam, b, h;
};
template <int MODE>
__device__ __forceinline__ void unit_loop(lds_u8* lds, const UnitGeo& U, const GAS float* sm, GAS bf16_t* Obase, int orow0, int ocol, int l, int tid) {
    const int lane = tid & 63, w = __builtin_amdgcn_readfirstlane(tid >> 6), h5 = lane >> 5, ql = lane & 31;
    const int T = U.T, q0 = U.q0, nself = U.nself, ntile = U.ntile, ta = U.ta;
    const int Hq = U.fam == 1 ? 8 : 4;
    const size_t qo = U.fam == 0 ? QO_QA : (U.fam == 1 ? QO_QB : QO_QC); const size_t gq = U.fam == 1 ? GS8 : GS4;
    const int qw0 = q0 + 32 * w, qtok = qw0 + ql, qrow = qtok >> 6, qcol = qtok & 63;
    const GAS bf16_t* Qp = U.qkv + qo + U.grp * gq + ((size_t)(U.b * Hq + U.h) * T + qtok) * 64;
    bf16x8 qf[4];
#pragma unroll
    for (int ds = 0; ds < 4; ++ds) qf[ds] = *(const GAS bf16x8*)(Qp + 16 * ds + 8 * h5);
    const int r0w = min(max((qw0 >> 6) - 4, 0), 24), qsl = min(max(qcol - 8, 0), 48);
    constexpr float M_INIT = -1024.0f;
    float m0 = M_INIT, l0 = 0.f, m1 = M_INIT, l1 = 0.f;
    const f32x16 z = {0.f, 0.f, 0.f, 0.f, 0.f, 0.f, 0.f, 0.f, 0.f, 0.f, 0.f, 0.f, 0.f, 0.f, 0.f, 0.f};
    f32x16 oa0 = z, oa1 = z, ob0 = z, ob1 = z;
    f32x16 ng0;
#pragma unroll
    for (int r = 0; r < 16; ++r) ng0[r] = -M_INIT;
    const int lrow = tid >> 3, lch = tid & 7; const int lds_off = lrow * 128 + ((lch ^ ((lrow >> 1) & 7)) << 4);
    u32x4 rA[2], rB[2];
    auto gload = [&](int ti_, u32x4& kr, u32x4& vr) {
        const int ti = min(ti_, ntile - 1);
        const bool self = ti < nself; const int tok0 = self ? 64 * (ta + ti) : 64 * (ti - nself); const int Tkv = self ? T : PAST;
        const GAS bf16_t* kp = (self ? U.qkv : U.kcb) + (self ? U.kso : U.kco); const GAS bf16_t* vp = (self ? U.qkv : U.kcb) + (self ? U.vso : U.vco);
        kr = *(const GAS u32x4*)(kp + (size_t)(tok0 + lrow) * 64 + lch * 8);
        vr = *(const GAS u32x4*)(vp + (size_t)lrow * Tkv + tok0 + lch * 8);
    };
    auto tile = [&](int ti, const lds_u8* Kt) {
        const lds_u8* Vt = Kt + 8192;
        const bool self = ti < nself; const int tok0 = 64 * (ta + ti);
        bool rel = true, msk = false;
        if (MODE == 1 && self) { const int kr = ta + ti; rel = (kr >= r0w) && (kr <= r0w + 7); msk = true; }
        if (MODE == 2 && self) { rel = (tok0 + 63 >= qw0 - 128) && (tok0 <= qw0 + 31 + 128); msk = !((tok0 >= qw0 + 31 - 128) && (tok0 + 63 <= qw0 + 128)); }
        if (rel) {
            if (MODE != 3) {
                f32x16 s0, s1; qk_tile<4>(s0, s1, Kt, 0, qf, ng0, lane);
                if (MODE == 1 && msk) {
                    const int kr = ta + ti; const LAS float* bt = (const LAS float*)(lds + LDS_RPB) + (kr - qrow + 7) * 31 + 15 - qcol;
                    float b0[16], b1[16];
#pragma unroll
                    for (int r = 0; r < 16; ++r) { const int kc0 = key_of(0, r, h5); b0[r] = bt[min(max(kc0, qsl), qsl + 15)]; b1[r] = bt[min(max(kc0 + 32, qsl), qsl + 15)]; }
#pragma unroll
                    for (int r = 0; r < 16; ++r) { const int kc0 = key_of(0, r, h5), kc1 = kc0 + 32;
                        s0[r] = ((kc0 >= qsl) && (kc0 < qsl + 16)) ? s0[r] + b0[r] : -INFINITY; s1[r] = ((kc1 >= qsl) && (kc1 < qsl + 16)) ? s1[r] + b1[r] : -INFINITY; }
                }
                if (MODE == 2 && msk) {
#pragma unroll
                    for (int r = 0; r < 16; ++r) { const int k0 = tok0 + key_of(0, r, h5), k1 = k0 + 32;
                        s0[r] = (abs(k0 - qtok) > 128) ? -INFINITY : s0[r]; s1[r] = (abs(k1 - qtok) > 128) ? -INFINITY : s1[r]; }
                }
                softmax_pv(s0, s1, m0, l0, ng0, oa0, oa1, Vt, lane);
            } else {
                { f32x16 s0, s1; qk_tile<2>(s0, s1, Kt, 0, qf, z, lane); softmax_pv_abs(s0, s1, m0, l0, oa0, oa1, Vt, lane); }
                { f32x16 s0, s1; qk_tile<2>(s0, s1, Kt, 4, qf + 2, z, lane); softmax_pv_abs(s0, s1, m1, l1, ob0, ob1, Vt, lane); }
            }
        }
    };
    auto step = [&](int ti, u32x4 (&W)[2], u32x4 (&L)[2]) {
        gload(ti + 2, L[0], L[1]);
        __builtin_amdgcn_sched_barrier(0);
        tile(ti, lds + (ti & 1) * LDS_TILE);
        if (ti + 1 < ntile) { lds_u8* nb = lds + ((ti + 1) & 1) * LDS_TILE; *(LAS u32x4*)(nb + lds_off) = W[0]; *(LAS u32x4*)(nb + 8192 + lds_off) = W[1]; }
        __syncthreads();
    };
    gload(0, rB[0], rB[1]);
    gload(1, rA[0], rA[1]);
    *(LAS u32x4*)(lds + lds_off) = rB[0]; *(LAS u32x4*)(lds + 8192 + lds_off) = rB[1];
    __syncthreads();
    for (int ti = 0; ti < ntile; ti += 2) {
        step(ti, rA, rB);
        if (ti + 1 < ntile) step(ti + 1, rB, rA);
    }
    float lt0 = xsum32(l0);
    if (U.fam == 1) lt0 += __builtin_amdgcn_exp2f(sm[SM_SINK + l * 8 + U.h] - m0);
    const float i0 = 1.0f / lt0;
    lds_u8* stg = lds + w * 4096 + ql * 128;
    if (MODE != 3) {
#pragma unroll
        for (int g = 0; g < 4; ++g) {
            u32x2 wa, wb; wa.x = cvt_pk_bf16(oa0[4 * g] * i0, oa0[4 * g + 1] * i0); wa.y = cvt_pk_bf16(oa0[4 * g + 2] * i0, oa0[4 * g + 3] * i0);
            wb.x = cvt_pk_bf16(oa1[4 * g] * i0, oa1[4 * g + 1] * i0); wb.y = cvt_pk_bf16(oa1[4 * g + 2] * i0, oa1[4 * g + 3] * i0);
            *(LAS u32x2*)(stg + ((g ^ (ql & 7)) << 4) + 8 * h5) = wa; *(LAS u32x2*)(stg + (((4 + g) ^ (ql & 7)) << 4) + 8 * h5) = wb;
        }
    } else {
        const float lam_init = l == 0 ? 0.2f : (l == 1 ? 0.35550906759f : (l == 2 ? 0.47071301835f : 0.55605820416f));
        const float lt1 = xsum32(l1); const float i1 = 1.0f / lt1; const float lam = sm[SM_LAM + l];
        float ss = 0.f;
#pragma unroll
        for (int r = 0; r < 16; ++r) { oa0[r] = oa0[r] * i0 - lam * (ob0[r] * i1); oa1[r] = oa1[r] * i0 - lam * (ob1[r] * i1); ss += oa0[r] * oa0[r] + oa1[r] * oa1[r]; }
        ss = xsum32(ss);
        const float rn = __builtin_amdgcn_rsqf(ss * (1.f / 64.f) + 1e-6f) * (1.0f - lam_init);
        const GAS float* sg = sm + SM_SUBG + l * 64 + 4 * h5;
#pragma unroll
        for (int g = 0; g < 4; ++g) {
            const f32x4 ga = *(const GAS f32x4*)(sg + 8 * g), gb = *(const GAS f32x4*)(sg + 32 + 8 * g);
            u32x2 wa, wb; wa.x = cvt_pk_bf16(oa0[4 * g] * rn * ga[0], oa0[4 * g + 1] * rn * ga[1]); wa.y = cvt_pk_bf16(oa0[4 * g + 2] * rn * ga[2], oa0[4 * g + 3] * rn * ga[3]);
            wb.x = cvt_pk_bf16(oa1[4 * g] * rn * gb[0], oa1[4 * g + 1] * rn * gb[1]); wb.y = cvt_pk_bf16(oa1[4 * g + 2] * rn * gb[2], oa1[4 * g + 3] * rn * gb[3]);
            *(LAS u32x2*)(stg + ((g ^ (ql & 7)) << 4) + 8 * h5) = wa; *(LAS u32x2*)(stg + (((4 + g) ^ (ql & 7)) << 4) + 8 * h5) = wb;
        }
    }
    asm volatile("s_waitcnt lgkmcnt(0)" ::: "memory");
    {
        const int ch = lane & 7; GAS bf16_t* ob = Obase + (size_t)(orow0 + qw0) * 1024 + ocol + 8 * ch;
#pragma unroll
        for (int j = 0; j < 4; ++j) { const int row = (lane >> 3) + 8 * j;
            const u32x4 v = *(const LAS u32x4*)(lds + w * 4096 + row * 128 + ((ch ^ (row & 7)) << 4));
            *(GAS u32x4*)(ob + (size_t)row * 1024) = v; }
    }
}

__device__ __forceinline__ void attn_phase(lds_u8* lds, const Ctx& C) {
    const int l = C.l;
    for (;;) {
        __syncthreads();
        unsigned char* ws_ = C.ws; asm volatile("" : "+s"(ws_)); GAS unsigned char* ws = (GAS unsigned char*)ws_;
        const int tid = opaque_tid();
        if (tid == 0) *(LAS unsigned*)(lds + LDS_NEXT) = __hip_atomic_fetch_add((GAS unsigned*)(ws + WS_CTL) + 64 * (1 + l) + C.rep, 1u, __ATOMIC_RELAXED, __HIP_MEMORY_SCOPE_AGENT);
        __syncthreads();
        const int idx = (int)*(LAS unsigned*)(lds + LDS_NEXT);
#ifdef ATT_PROBE_LIMIT
        if (idx >= (C.rep ? ATT_PROBE_LIMIT : NUNITS)) break;
#else
        if (idx >= NUNITS) break;
#endif
        const GAS float* sm = (const GAS float*)(ws + WS_LAM);
        GAS unsigned* qa_done = (GAS unsigned*)(ws + WS_CTL) + 64 * (8 + l);
        if (idx < NGEMM) {
            pg8::Gemm g{(const bf16_t*)(ws_ + WS_XA), (const bf16_t*)(ws_ + WS_WIN) + (size_t)l * DIN * 1024, MTOT, 256, 1024}; pg8::OneUnit S1{idx};
            pg8::EpiIn E{ws_, C.out, l, 0};
            pg8::gemm_phase<pg8::EpiIn, pg8::OneUnit, true, true>(lds, g, S1, E);
            asm volatile("s_waitcnt vmcnt(0)" ::: "memory");
            __syncthreads();
            if (tid == 0) { __builtin_amdgcn_fence(__ATOMIC_RELEASE, "agent"); asm volatile("s_waitcnt vmcnt(0)" ::: "memory"); __hip_atomic_fetch_add(qa_done, 1u, __ATOMIC_RELAXED, __HIP_MEMORY_SCOPE_AGENT); }
            continue;
        }
        UnitGeo U; U.qkv = (const GAS bf16_t*)(ws + WS_QKV); U.kcb = (const GAS bf16_t*)(ws + WS_KC);
        int fam, grp, b, h, qb; const int iu = idx - NGEMM;
        if (iu < 128) { fam = 2; grp = 1; b = iu >> 5; h = (iu >> 3) & 3; qb = iu & 7; }
        else if (iu < 384) { const int i = iu - 128; fam = 1; grp = 1; b = i >> 6; h = (i >> 3) & 7; qb = i & 7; }
        else if (iu < 512) { const int i = iu - 384; fam = 0; grp = 1; b = i >> 5; h = (i >> 3) & 3; qb = i & 7; }
        else if (iu < 640) { const int i = iu - 512; fam = 2; grp = 0; b = i >> 2; h = i & 3; qb = 0; }
        else if (iu < 896) { const int i = iu - 640; fam = 1; grp = 0; b = i >> 3; h = i & 7; qb = 0; }
        else { const int i = iu - 896; fam = 0; grp = 0; b = i >> 2; h = i & 3; qb = 0; }
        const int q0 = qb * 256;
        if (fam == 0) {
            if (tid == 0) { unsigned sp = 0; while (__hip_atomic_load(qa_done, __ATOMIC_RELAXED, __HIP_MEMORY_SCOPE_AGENT) < (unsigned)NGEMM * (C.rep + 1) && ++sp < (1u << 22)) __builtin_amdgcn_s_sleep(2);
                __builtin_amdgcn_fence(__ATOMIC_ACQUIRE, "agent"); asm volatile("s_waitcnt vmcnt(0)" ::: "memory"); }
            __syncthreads();
        }
        const int T = grp ? TLAT : TCTX, Hkv = fam == 1 ? 2 : 4, hk = fam == 1 ? (h >> 2) : h;
        const size_t ko = fam == 0 ? QO_KA : (fam == 1 ? QO_KB : QO_KC), vo = fam == 0 ? QO_VTA : (fam == 1 ? QO_VTB : QO_VTC); const size_t gk = fam == 1 ? GS2 : GS4;
        U.kso = (unsigned)(ko + grp * gk + (size_t)(b * Hkv + hk) * T * 64); U.vso = (unsigned)(vo + grp * gk + (size_t)(b * Hkv + hk) * 64 * T);
        const size_t cko = fam == 0 ? CO_KA : (fam == 1 ? CO_KB : CO_KCC), cvo = fam == 0 ? CO_VTA : (fam == 1 ? CO_VTB : CO_VTCC);
        U.kco = (unsigned)(cko + (size_t)((l * 4 + b) * Hkv + hk) * PAST * 64); U.vco = (unsigned)(cvo + (size_t)((l * 4 + b) * Hkv + hk) * 64 * PAST);
        int ta, tb;
        if (!grp) { ta = 0; tb = 4; }
        else if (fam == 0) { ta = max(4 * qb - 4, 0); tb = min(max(4 * qb - 1, 0), 24) + 8; }
        else if (fam == 1) { ta = max(q0 - 128, 0) >> 6; tb = min(q0 + 384, TLAT) >> 6; }
        else { ta = 0; tb = 32; }
        U.T = T; U.ta = ta; U.nself = tb - ta; U.ntile = U.nself + (grp ? 8 : 0); U.q0 = q0; U.grp = grp; U.fam = fam; U.b = b; U.h = h;
        GAS bf16_t* Obase = (GAS bf16_t*)(ws + WS_O); const int orow0 = grp ? MCTX + b * TLAT : b * TCTX, ocol = (fam == 0 ? 0 : (fam == 1 ? 256 : 768)) + 64 * h;
        if (fam == 2) unit_loop<3>(lds, U, sm, Obase, orow0, ocol, l, tid);
        else if (!grp) unit_loop<0>(lds, U, sm, Obase, orow0, ocol, l, tid);
        else if (fam == 0) { if (tid < 465) *(LAS float*)(lds + LDS_RPB + 4 * tid) = sm[SM_RPB + (l * 4 + h) * 465 + tid]; unit_loop<1>(lds, U, sm, Obase, orow0, ocol, l, tid); }
        else unit_loop<2>(lds, U, sm, Obase, orow0, ocol, l, tid);
    }
}
}
namespace misc {
typedef LAS unsigned char lds_u8;
__device__ __forceinline__ float wave_sum(float v) {
#pragma unroll
    for (int o = 1; o < 64; o <<= 1) v += __shfl_xor(v, o);
    return v;
}
__device__ const double INVB[16] = {1.0, 0.5623413251903491, 0.31622776601683794, 0.1778279410038923, 0.1, 0.05623413251903491, 0.03162277660168379, 0.01778279410038923,
                                    0.01, 0.005623413251903491, 0.0031622776601683794, 0.001778279410038923, 0.001, 0.0005623413251903491, 0.00031622776601683794, 0.0001778279410038923};
__device__ const double INVC[8] = {1.0, 0.31622776601683794, 0.1, 0.03162277660168379, 0.01, 0.0031622776601683794, 0.001, 0.00031622776601683794};
__device__ __forceinline__ void sincos_d(double a, float& c, float& s) {
    const double k = rint(a * 0.6366197723675814);
    double r = fma(-k, 1.5707963267948966, a); r = fma(-k, 6.123233995736766e-17, r);
    const double r2 = r * r;
    const double sp = r * (1.0 + r2 * (-1.0 / 6.0 + r2 * (1.0 / 120.0 + r2 * (-1.0 / 5040.0 + r2 * (1.0 / 362880.0 + r2 * (-1.0 / 39916800.0 + r2 * (1.0 / 6227020800.0)))))));
    const double cp = 1.0 + r2 * (-0.5 + r2 * (1.0 / 24.0 + r2 * (-1.0 / 720.0 + r2 * (1.0 / 40320.0 + r2 * (-1.0 / 3628800.0 + r2 * (1.0 / 479001600.0 + r2 * (-1.0 / 87178291200.0)))))));
    const int q = ((int)k) & 3;
    const double cc = (q == 0) ? cp : (q == 1) ? -sp : (q == 2) ? -cp : sp;
    const double ss = (q == 0) ? sp : (q == 1) ? cp : (q == 2) ? -sp : -cp;
    c = (float)cc; s = (float)ss;
}
__device__ __forceinline__ void transpose_item(const float* W, int K, int N, bf16_t* WT, int k0, int n0, int dst0, LAS float* scr, int lane) {
    const int kr = lane >> 3, c4 = (lane & 7) * 4; f32x4 v[8];
#pragma unroll
    for (int i = 0; i < 8; ++i) v[i] = *(const f32x4*)(W + (size_t)(k0 + 8 * i + kr) * N + n0 + c4);
#pragma unroll
    for (int i = 0; i < 8; ++i) { LAS float* d = scr + (8 * i + kr) * 33 + c4; d[0] = v[i][0]; d[1] = v[i][1]; d[2] = v[i][2]; d[3] = v[i][3]; }
    asm volatile("s_waitcnt lgkmcnt(0)" ::: "memory");
    const int c = lane & 7;
#pragma unroll
    for (int j = 0; j < 4; ++j) { const int n = (lane >> 3) + 8 * j; const LAS float* s = scr + (8 * c) * 33 + n;
        u32x4 o; o.x = cvt_pk_bf16(s[0 * 33], s[1 * 33]); o.y = cvt_pk_bf16(s[2 * 33], s[3 * 33]); o.z = cvt_pk_bf16(s[4 * 33], s[5 * 33]); o.w = cvt_pk_bf16(s[6 * 33], s[7 * 33]);
        *(u32x4*)(WT + (size_t)(dst0 + n) * K + k0 + 8 * c) = o; }
    asm volatile("s_waitcnt lgkmcnt(0)" ::: "memory");
}
__device__ __forceinline__ void trb_item(const float* W, int N, bf16_t* WT, int n0, int dst0, const LAS float* vec, LAS float* scr, LAS float* red, float* out, int ostride, int tid) {
    const int lane = tid & 63, wave = __builtin_amdgcn_readfirstlane(tid >> 6), kr = lane >> 3, c4 = (lane & 7) * 4, c = lane & 7;
    f32x4 a0 = {0.f, 0.f, 0.f, 0.f}, a1 = a0, a2 = a0, a3 = a0, a4 = a0;
#pragma unroll 1
    for (int h = 0; h < 2; ++h) { const int k0 = 128 * wave + 64 * h; f32x4 v[8];
#pragma unroll
        for (int i = 0; i < 8; ++i) v[i] = *(const f32x4*)(W + (size_t)(k0 + 8 * i + kr) * N + n0 + c4);
#pragma unroll
        for (int i = 0; i < 8; ++i) { const LAS float* vp = vec + k0 + 8 * i + kr; a0 += v[i] * vp[0]; a1 += v[i] * vp[1024]; a2 += v[i] * vp[2048]; a3 += v[i] * vp[3072]; a4 += v[i] * vp[4096];
            LAS float* d = scr + (8 * i + kr) * 33 + c4; d[0] = v[i][0]; d[1] = v[i][1]; d[2] = v[i][2]; d[3] = v[i][3]; }
        asm volatile("s_waitcnt lgkmcnt(0)" ::: "memory");
#pragma unroll
        for (int j = 0; j < 4; ++j) { const int n = (lane >> 3) + 8 * j; const LAS float* s = scr + (8 * c) * 33 + n;
            u32x4 o; o.x = cvt_pk_bf16(s[0 * 33], s[1 * 33]); o.y = cvt_pk_bf16(s[2 * 33], s[3 * 33]); o.z = cvt_pk_bf16(s[4 * 33], s[5 * 33]); o.w = cvt_pk_bf16(s[6 * 33], s[7 * 33]);
            *(u32x4*)(WT + (size_t)(dst0 + n) * 1024 + k0 + 8 * c) = o; }
        asm volatile("s_waitcnt lgkmcnt(0)" ::: "memory");
    }
#define TRB_RED(a) do { _Pragma("unroll") for (int j = 0; j < 4; ++j) { float s = a[j]; s += __shfl_xor(s, 8); s += __shfl_xor(s, 16); s += __shfl_xor(s, 32); a[j] = s; } } while (0)
    TRB_RED(a0); TRB_RED(a1); TRB_RED(a2); TRB_RED(a3); TRB_RED(a4);
#undef TRB_RED
    if (lane < 8) { LAS float* r = red + wave * 160 + c4; *(LAS f32x4*)(r) = a0; *(LAS f32x4*)(r + 32) = a1; *(LAS f32x4*)(r + 64) = a2; *(LAS f32x4*)(r + 96) = a3; *(LAS f32x4*)(r + 128) = a4; }
    __syncthreads();
    if (tid < 160) { const int b = tid >> 5, cc = tid & 31; float s = 0.f;
#pragma unroll
        for (int w = 0; w < 8; ++w) s += red[w * 160 + b * 32 + cc];
        out[(size_t)b * ostride + n0 + cc] = s; }
}
__device__ __forceinline__ void gemv5_item(const float* W, int N, int n0, const LAS float* vec, LAS float* red, const float* add, float* out, int ostride, int tid) {
    const int c4 = (tid & 15) * 4, kq = tid >> 4; f32x4 a0 = {0.f, 0.f, 0.f, 0.f}, a1 = a0, a2 = a0, a3 = a0, a4 = a0;
    const float* wp = W + (size_t)(kq * 32) * N + n0 + c4; const LAS float* vp = vec + kq * 32;
#pragma unroll 16
    for (int k = 0; k < 32; ++k) { const f32x4 w = *(const f32x4*)(wp + (size_t)k * N); a0 += w * vp[k]; a1 += w * vp[1024 + k]; a2 += w * vp[2048 + k]; a3 += w * vp[3072 + k]; a4 += w * vp[4096 + k]; }
    *(LAS f32x4*)(red + (kq * 5 + 0) * 64 + c4) = a0; *(LAS f32x4*)(red + (kq * 5 + 1) * 64 + c4) = a1; *(LAS f32x4*)(red + (kq * 5 + 2) * 64 + c4) = a2; *(LAS f32x4*)(red + (kq * 5 + 3) * 64 + c4) = a3; *(LAS f32x4*)(red + (kq * 5 + 4) * 64 + c4) = a4;
    __syncthreads();
    if (tid < 320) { const int b = tid >> 6, c = tid & 63; float s = add ? add[n0 + c] : 0.f;
#pragma unroll
        for (int q = 0; q < 32; ++q) s += red[(q * 5 + b) * 64 + c];
        out[(size_t)b * ostride + n0 + c] = s; }
    __syncthreads();
}

__device__ __forceinline__ void phase_tables(const Args& a) {
    const int gtid = blockIdx.x * 512 + opaque_tid(), NT = gridDim.x * 512; unsigned char* ws = a.ws;
    float* sm = (float*)(ws + WS_LAM);
    if (gtid < 4) { const int l = gtid; const float* lp = a.in[I_LAMBDA] + l * 128; float s1 = 0.f, s2 = 0.f;
        for (int i = 0; i < 32; ++i) { s1 += lp[i] * lp[32 + i]; s2 += lp[64 + i] * lp[96 + i]; }
        sm[SM_LAM + l] = expf(s1) - expf(s2) + (0.8f - 0.6f * expf(-0.3f * (float)l)); }
    for (int i = gtid; i < 1280; i += NT) { const int l = i / 320, r = i % 320; sm[SM_GAINS + i] = r < 128 ? a.in[I_NAG][l * 128 + r] : (r < 256 ? a.in[I_SWG][l * 128 + r - 128] : a.in[I_DAG][l * 64 + r - 256]); }
    for (int i = gtid; i < 7440; i += NT) sm[SM_RPB + i] = a.in[I_RPB][i] * LOG2E;
    for (int i = gtid; i < 32; i += NT) sm[SM_SINK + i] = a.in[I_SINK][i] * LOG2E;
    for (int i = gtid; i < 256; i += NT) sm[SM_SUBG + i] = a.in[I_SUBG][i];
    float* cv = (float*)(ws + WS_CONV);
    for (int i = gtid; i < 4 * 4 * DUP; i += NT) { const int c = i % DUP, j = (i / DUP) & 3, l = i / (4 * DUP); cv[i] = j < 3 ? a.in[I_CONVW][(size_t)(l * 3 + j) * DUP + c] : a.in[I_CONVB][(size_t)l * DUP + c]; }
    float* rb = (float*)(ws + WS_ROPEB); float* rc = (float*)(ws + WS_ROPEC);
    for (int i = gtid; i < 2048 * 32; i += NT) { const int t = i >> 5, j = i & 31; const double pos = (double)(j < 16 ? (t >> 6) : (t & 63)); float c, s; sincos_d(pos * INVB[j & 15], c, s); rb[2 * i] = c; rb[2 * i + 1] = s; }
    for (int i = gtid; i < 2048 * 16; i += NT) { const int t = i >> 4, j = i & 15; const double pos = (double)(j < 8 ? (t >> 6) : (t & 63)); float c, s; sincos_d(pos * INVC[j & 7], c, s); rc[2 * i] = c; rc[2 * i + 1] = s; }
}
constexpr int N_TR_IN = 144, N_TR_OUT = 64, N_TR_UP = 352, N_TR_DN = 176, N_MOD = 96, N_BIAS_IN = 36, N_BIAS_UP = 88, N_CACHE = 640;
__device__ __forceinline__ void fl_tr(lds_u8* lds, const Args& a, int l, int which, int bi, int tid) {
    const int lane = tid & 63, wave = __builtin_amdgcn_readfirstlane(tid >> 6); LAS float* scr = (LAS float*)(lds + wave * 16384); unsigned char* ws = a.ws; const int r = bi * 8 + wave;
    if (which == 0) { const int kb = r / 72, nb = r % 72, n0 = 32 * nb; const int tile = n0 >> 8, L = n0 & 255, wc = L >> 6, bj = (L >> 5) & 1; const int dst0 = 256 * tile + 128 * bj + 32 * wc;
        transpose_item(a.in[I_WIN] + (size_t)l * 1024 * DIN, 1024, DIN, (bf16_t*)(ws + WS_WIN) + (size_t)l * DIN * 1024, 64 * kb, n0, dst0, scr, lane); }
    else if (which == 1) { const int kb = r / 32, nb = r % 32; transpose_item(a.in[I_WOUT] + (size_t)l * 1024 * 1024, 1024, 1024, (bf16_t*)(ws + WS_WOUT) + (size_t)l * 1024 * 1024, 64 * kb, 32 * nb, 32 * nb, scr, lane); }
    else if (which == 2) { const int kb = r / 176, nb = r % 176, n0 = 32 * nb; const int nn = n0 < DFF ? n0 : n0 - DFF; const int dst0 = 256 * (nn >> 7) + (n0 < DFF ? 0 : 128) + (nn & 127);
        transpose_item(a.in[I_WUP] + (size_t)l * 1024 * DUP, 1024, DUP, (bf16_t*)(ws + WS_WUP) + (size_t)l * DUP * 1024, 64 * kb, n0, dst0, scr, lane); }
    else { const int kb = r / 32, nb = r % 32; transpose_item(a.in[I_WDOWN] + (size_t)l * DFF * 1024, DFF, 1024, (bf16_t*)(ws + WS_WDOWN) + (size_t)l * 1024 * DFF, 64 * kb, 32 * nb, 32 * nb, scr, lane); }
}
__device__ __forceinline__ void fl_trb(lds_u8* lds, const Args& a, int l, int which, int strip, int tid) {
    const int wave = __builtin_amdgcn_readfirstlane(tid >> 6); unsigned char* ws = a.ws; const float* mod = (const float*)(ws + WS_MOD);
    LAS float* scr = (LAS float*)(lds + wave * 8704); LAS float* vec = (LAS float*)(lds + 73728); LAS float* red = (LAS float*)(lds + 94208);
    for (int i = tid; i < 5120; i += 512) { const int b5 = i >> 10, k = i & 1023; vec[i] = mod[((size_t)(l * 5 + b5) * 6 + (which ? 3 : 0)) * 1024 + k]; }
    __syncthreads();
    const int n0 = 32 * strip;
    if (!which) { const int tile = n0 >> 8, L = n0 & 255, wc = L >> 6, bj = (L >> 5) & 1; const int dst0 = 256 * tile + 128 * bj + 32 * wc;
        trb_item(a.in[I_WIN] + (size_t)l * 1024 * DIN, DIN, (bf16_t*)(ws + WS_WIN) + (size_t)l * DIN * 1024, n0, dst0, vec, scr, red, (float*)(ws + WS_BIASIN) + (size_t)l * 5 * DIN, DIN, tid); }
    else { const int nn = n0 < DFF ? n0 : n0 - DFF; const int dst0 = 256 * (nn >> 7) + (n0 < DFF ? 0 : 128) + (nn & 127);
        trb_item(a.in[I_WUP] + (size_t)l * 1024 * DUP, DUP, (bf16_t*)(ws + WS_WUP) + (size_t)l * DUP * 1024, n0, dst0, vec, scr, red, (float*)(ws + WS_BIASUP) + (size_t)l * 5 * DUP, DUP, tid); }
}
__device__ __forceinline__ void fl_mod(lds_u8* lds, const Args& a, int l, int g, int tid) {
    LAS float* vec = (LAS float*)lds; LAS float* red = (LAS float*)(lds + 20480);
    for (int i = tid; i < 5120; i += 512) { const int b5 = i >> 10, k = i & 1023; const float v = b5 == 0 ? a.in[I_CCTX][k] : a.in[I_C][(b5 - 1) * 1024 + k]; vec[i] = v / (1.f + __expf(-v)); }
    __syncthreads();
    gemv5_item(a.in[I_WMOD] + (size_t)l * 1024 * 6144, 6144, 64 * g, vec, red, a.in[I_BMOD] + l * 6144, (float*)(a.ws + WS_MOD) + (size_t)l * 5 * 6144, 6144, tid);
}
__device__ __forceinline__ void fl_bias(lds_u8* lds, const Args& a, int l, int which, int g, int tid) {
    LAS float* vec = (LAS float*)lds; LAS float* red = (LAS float*)(lds + 20480); const float* mod = (const float*)(a.ws + WS_MOD);
    for (int i = tid; i < 5120; i += 512) { const int b5 = i >> 10, k = i & 1023; vec[i] = mod[((size_t)(l * 5 + b5) * 6 + (which ? 3 : 0)) * 1024 + k]; }
    __syncthreads();
    if (!which) gemv5_item(a.in[I_WIN] + (size_t)l * 1024 * DIN, DIN, 64 * g, vec, red, nullptr, (float*)(a.ws + WS_BIASIN) + (size_t)l * 5 * DIN, DIN, tid);
    else gemv5_item(a.in[I_WUP] + (size_t)l * 1024 * DUP, DUP, 64 * g, vec, red, nullptr, (float*)(a.ws + WS_BIASUP) + (size_t)l * 5 * DUP, DUP, tid);
}
__device__ __forceinline__ void fl_gv(const Args& a, int l, int tid) {
    const float* mod = (const float*)(a.ws + WS_MOD); float* gv = (float*)(a.ws + WS_GV) + (size_t)l * 10240;
    for (int i = tid; i < 10240; i += 512) { const int c = i & 1023, which = (i >> 10) & 1, b5 = i >> 11;
        gv[i] = a.in[which ? I_GFFN : I_GATTN][l * 1024 + c] * (1.f + mod[((size_t)(l * 5 + b5) * 6 + (which ? 4 : 1)) * 1024 + c]); }
}
__device__ __forceinline__ void fl_cache(const Args& a, int l, int ci, int tid) {
    bf16_t* kc = (bf16_t*)(a.ws + WS_KC); int i = ci * 512 + tid;
    if (i < 163840) { const int fam = i < 65536 ? 0 : (i < 98304 ? 1 : 2); i -= fam == 0 ? 0 : (fam == 1 ? 65536 : 98304); const int H = fam == 1 ? 2 : 4;
        const float* ck = a.in[fam == 0 ? I_CNAK : (fam == 1 ? I_CSWK : I_CDAK)]; bf16_t* dk = kc + (fam == 0 ? CO_KA : (fam == 1 ? CO_KB : CO_KCC));
        const int d8 = i & 7, hh = (i >> 3) % H, p = (i / (8 * H)) & 511, b = i / (8 * H * 512);
        const float* s = ck + ((((size_t)b * 4 + l) * 512 + p) * H + hh) * 64 + d8 * 8; const f32x4 x = *(const f32x4*)s, y = *(const f32x4*)(s + 4);
        u32x4 o; o.x = cvt_pk_bf16(x[0], x[1]); o.y = cvt_pk_bf16(x[2], x[3]); o.z = cvt_pk_bf16(y[0], y[1]); o.w = cvt_pk_bf16(y[2], y[3]);
        *(u32x4*)(dk + ((((size_t)l * 4 + b) * H + hh) * 512 + p) * 64 + d8 * 8) = o; }
    else { i -= 163840; const int fam = i < 65536 ? 0 : (i < 98304 ? 1 : 2); i -= fam == 0 ? 0 : (fam == 1 ? 65536 : 98304); const int H = fam == 1 ? 2 : 4;
        const float* cv = a.in[fam == 0 ? I_CNAV : (fam == 1 ? I_CSWV : I_CDAV)]; bf16_t* dv = kc + (fam == 0 ? CO_VTA : (fam == 1 ? CO_VTB : CO_VTCC));
        const int d = i & 63, p8 = (i >> 6) & 63, hh = (i >> 12) % H, b = i / (4096 * H);
        const float* s = cv + ((((size_t)b * 4 + l) * 512 + p8 * 8) * H + hh) * 64 + d; float x[8];
#pragma unroll
        for (int j = 0; j < 8; ++j) x[j] = s[(size_t)j * H * 64];
        u32x4 o; o.x = cvt_pk_bf16(x[0], x[1]); o.y = cvt_pk_bf16(x[2], x[3]); o.z = cvt_pk_bf16(x[4], x[5]); o.w = cvt_pk_bf16(x[6], x[7]);
        *(u32x4*)(dv + ((((size_t)l * 4 + b) * H + hh) * 64 + d) * 512 + p8 * 8) = o; }
}
enum { SLOT_A = 0, SLOT_B = 1 };
__device__ __forceinline__ void fill_run(lds_u8* lds, const Args& a, int slot) {
    const int tid = opaque_tid();
    unsigned* counter = (unsigned*)(a.ws + WS_CTL) + 64 * (16 + slot);
    LAS unsigned* nxt = (LAS unsigned*)(lds + 131072 + 512);
    constexpr int N_TR_A = N_TR_OUT + N_TR_DN, N_TRB = 72 + 176;
    for (;;) {
        __syncthreads();
        if (tid == 0) *nxt = __hip_atomic_fetch_add(counter, 1u, __ATOMIC_RELAXED, __HIP_MEMORY_SCOPE_AGENT);
        __syncthreads();
        int i = (int)*nxt;
        if (slot == SLOT_A) {
            if (i < 4 * N_MOD) { fl_mod(lds, a, i / N_MOD, i % N_MOD, tid); continue; } i -= 4 * N_MOD;
            if (i < 4 * N_TR_A) { const int l = i / N_TR_A; int r = i % N_TR_A;
                if (r < N_TR_OUT) { fl_tr(lds, a, l, 1, r, tid); continue; } r -= N_TR_OUT;
                fl_tr(lds, a, l, 3, r, tid); continue; }
            i -= 4 * N_TR_A;
            if (i < 4 * N_CACHE) { fl_cache(a, i / N_CACHE, i % N_CACHE, tid); continue; }
            break;
        } else {
            if (i < 4) { fl_gv(a, i, tid); continue; } i -= 4;
            if (i < 4 * N_TRB) { const int l = i / N_TRB, r = i % N_TRB; if (r < 72) fl_trb(lds, a, l, 0, r, tid); else fl_trb(lds, a, l, 1, r - 72, tid); continue; }
            break;
        }
    }
}
__device__ __forceinline__ void phase_make_xa(const Args& a, int l, int which, int first) {
    const int tid = opaque_tid(), lane = tid & 63, wave = tid >> 6; unsigned char* ws = a.ws;
    const float* mod = (const float*)(ws + WS_MOD); bf16_t* xa = (bf16_t*)(ws + WS_XA); float* ssq = (float*)(ws + WS_SSQ);
    const float* gsrc = a.in[which ? I_GFFN : I_GATTN] + l * 1024;
    for (int row = blockIdx.x * 8 + wave; row < MTOT; row += gridDim.x * 8) {
        const float* src = first ? (row < MCTX ? a.in[I_XP] + (size_t)row * 1024 : a.in[I_XS] + (size_t)(row - MCTX) * 1024) : a.out + (size_t)row * 1024;
        const float* sc = mod + ((size_t)(l * 5 + row_b5(row)) * 6 + (which ? 4 : 1)) * 1024;
        f32x4 v[4]; float s = 0.f;
#pragma unroll
        for (int j = 0; j < 4; ++j) { v[j] = *(const f32x4*)(src + 256 * j + 4 * lane); s += (v[j][0] * v[j][0] + v[j][1] * v[j][1]) + (v[j][2] * v[j][2] + v[j][3] * v[j][3]); }
        s = wave_sum(s);
#pragma unroll
        for (int j = 0; j < 4; ++j) {
            const f32x4 g = *(const f32x4*)(gsrc + 256 * j + 4 * lane) * (*(const f32x4*)(sc + 256 * j + 4 * lane) + 1.0f);
            const f32x4 y = v[j] * g; u32x2 w; w.x = cvt_pk_bf16(y[0], y[1]); w.y = cvt_pk_bf16(y[2], y[3]); *(u32x2*)(xa + (size_t)row * 1024 + 256 * j + 4 * lane) = w; }
        if (lane < 4) ssq[(size_t)row * 4 + lane] = lane == 0 ? s : 0.f;
    }
}
}
constexpr int LDS_BYTES = 147456;
enum Phase { PH_MAKEXA = 2, PH_IN, PH_ATT, PH_OUT, PH_UP, PH_CONV, PH_DOWN };

constexpr int LDS_DUMMY = 131072 + 12288;
__device__ __forceinline__ void prefetch_panel(LAS unsigned char* lds, const bf16_t* tile, int K, int kbytes  ) {
    const int tid = opaque_tid(), wave = __builtin_amdgcn_readfirstlane(tid >> 6); const int segs = kbytes >> 7, nlines = 256 * segs;
    LAS unsigned* dst = (LAS unsigned*)(lds + LDS_DUMMY + wave * 256);
    for (int line = tid; line < nlines; line += 512) { const int row = line / segs, seg = line % segs;
        __builtin_amdgcn_global_load_lds((const unsigned*)((const char*)tile + (size_t)row * K * 2 + seg * 128), dst, 4, 0, 0); }
}
__device__ __forceinline__ void run_phase(LAS unsigned char* lds, const Args& a, int ph, int l, int p1, int p2) {
    unsigned char* ws = a.ws; const int G = gridDim.x;
    switch (ph) {
    case PH_MAKEXA: misc::phase_make_xa(a, l, p1, p2); break;
    case PH_IN: {
        pg8::Gemm g{(const bf16_t*)(ws + WS_XA), (const bf16_t*)(ws + WS_WIN) + (size_t)l * DIN * 1024 + (size_t)256 * 1024, MTOT, DIN - 256, 1024}; pg8::StaticOrder S; S.init(MTOT, DIN - 256, G, (int)blockIdx.x);
#ifdef TS_GEMM
        if (l == 1 && blockIdx.x == TS_BLOCK && TS_PHASE == ph) g.ts = (volatile unsigned long long*)(ws + WS_CTL + 512 * 1024);
#endif
        pg8::EpiIn E{ws, a.out, l, 1};
        pg8::gemm_phase<pg8::EpiIn, pg8::StaticOrder, true, true>(lds, g, S, E); } break;
    case PH_ATT: {
        att::Ctx C{ws, a.out, l, p1};
        att::attn_phase(lds, C); } break;
    case PH_OUT: {
        pg8::Gemm g{(const bf16_t*)(ws + WS_O), (const bf16_t*)(ws + WS_WOUT) + (size_t)l * 1024 * 1024, MTOT, 1024, 1024}; pg8::StaticOrder S; S.init(MTOT, 1024, G, (int)blockIdx.x);
#ifdef TS_GEMM
        if (l == 1 && blockIdx.x == TS_BLOCK && TS_PHASE == ph) g.ts = (volatile unsigned long long*)(ws + WS_CTL + 512 * 1024);
#endif
        pg8::EpiRes E{ws, a.out, l, 0, l == 0 ? a.in[I_XP] : nullptr, l == 0 ? a.in[I_XS] : nullptr};
#ifdef WARM_OUT
        { pg8::Unit u; if (S.next(0, u)) { prefetch_panel(lds, (const bf16_t*)(ws + WS_WOUT) + (size_t)l * 1024 * 1024 + (size_t)u.pn * 256 * 1024, 1024, 2048); prefetch_panel(lds, (const bf16_t*)(ws + WS_O) + (size_t)u.pm * 256 * 1024, 1024, 2048); }
          asm volatile("s_waitcnt vmcnt(0)" ::: "memory"); __syncthreads(); }
#endif
        pg8::gemm_phase<pg8::EpiRes, pg8::StaticOrder, false, true>(lds, g, S, E); } break;
    case PH_UP: {
        pg8::Gemm g{(const bf16_t*)(ws + WS_XA), (const bf16_t*)(ws + WS_WUP) + (size_t)l * DUP * 1024, MTOT, DUP, 1024}; pg8::UpOrder S; S.init_up(G, (int)blockIdx.x);
#ifdef TS_GEMM
        if (l == 1 && blockIdx.x == TS_BLOCK && TS_PHASE == ph) g.ts = (volatile unsigned long long*)(ws + WS_CTL + 512 * 1024);
#endif
        pg8::EpiUpConv E{ws, l};
        pg8::gemm_phase<pg8::EpiUpConv, pg8::UpOrder, true, true>(lds, g, S, E); } break;
    case PH_DOWN: {
        pg8::Gemm g{(const bf16_t*)(ws + WS_ACT), (const bf16_t*)(ws + WS_WDOWN) + (size_t)l * 1024 * DFF, MTOT, 1024, DFF}; pg8::StaticOrder S; S.init(MTOT, 1024, G, (int)blockIdx.x);
#ifdef TS_GEMM
        if (l == 1 && blockIdx.x == TS_BLOCK && TS_PHASE == ph) g.ts = (volatile unsigned long long*)(ws + WS_CTL + 512 * 1024);
#endif
        pg8::EpiRes E{ws, a.out, l, 1, nullptr, nullptr};
        pg8::gemm_phase<pg8::EpiRes, pg8::StaticOrder, false, true>(lds, g, S, E); } break;
    default: break;
    }
}

#define XB_TMO      128
#define XB_XCNT(j)  (256  + 64 * (j))
#define XB_XSUB(j)  (1280 + 64 * (j))
#define XB_XGEN(j)  (2304 + 64 * (j))
#define XB_TOP      3328
#define XB_TOPGEN   3392
#define XCD_BAR_WORDS 3456
#define XB_SPIN_CAP (1u << 18)
__device__ __forceinline__ unsigned xb_ld(unsigned* p)              { return __hip_atomic_load(p, __ATOMIC_RELAXED, __HIP_MEMORY_SCOPE_AGENT); }
__device__ __forceinline__ unsigned xb_add(unsigned* p, unsigned v) { return __hip_atomic_fetch_add(p, v, __ATOMIC_RELAXED, __HIP_MEMORY_SCOPE_AGENT); }
__device__ __forceinline__ unsigned xb_xcc_id() { return (unsigned)__builtin_amdgcn_s_getreg((3 << 11) | 20) & 0xFu; }
#define XB_SPIN(cond, bar) do { unsigned _sp = 0; while (cond) { __builtin_amdgcn_s_sleep(1); \
    if ((++_sp & 255u) == 0u) { if (xb_ld(&(bar)[XB_TMO])) break; if (_sp > XB_SPIN_CAP) { atomicAdd(&(bar)[XB_TMO], 1u); break; } } } } while (0)
struct XcdBarrier { unsigned* bar; unsigned x; volatile LAS unsigned* st; };
__device__ __forceinline__ XcdBarrier xcd_barrier_post(unsigned* bar, volatile LAS unsigned* st) {
    XcdBarrier b; b.bar = bar; b.x = xb_xcc_id(); b.st = st;
    if (threadIdx.x == 0) (void)xb_add(&bar[XB_XCNT(b.x)], 1u);
    return b;
}
__device__ __forceinline__ void xcd_barrier_complete(unsigned* bar, unsigned x, unsigned& nloc, unsigned& nx) {
    const unsigned G = gridDim.x * gridDim.y * gridDim.z;
    unsigned sum, cnt, mine, sp = 0u;
    for (;;) {
        sum = 0u; cnt = 0u; mine = 0u;
#pragma unroll
        for (unsigned j = 0; j < 16; ++j) { const unsigned c = xb_ld(&bar[XB_XCNT(j)]); sum += c; cnt += (c > 0u) ? 1u : 0u; mine = (j == x) ? c : mine; }
        if (sum == G) break;
        __builtin_amdgcn_s_sleep(1);
        if ((++sp & 255u) == 0u) { if (xb_ld(&bar[XB_TMO])) break; if (sp > XB_SPIN_CAP) { atomicAdd(&bar[XB_TMO], 1u); break; } }
    }
    nloc = mine > 0u ? mine : 1u; nx = cnt > 0u ? cnt : 1u;
}
__device__ __forceinline__ void xcd_barrier(const XcdBarrier& b, bool local = false) {
    asm volatile("s_waitcnt vmcnt(0)" ::: "memory");
    __syncthreads();
    if (threadIdx.x == 0) {
        unsigned* bar = b.bar;
        __builtin_amdgcn_s_waitcnt(0);
        unsigned nloc = b.st[0], nx = b.st[1];
        if (nloc == 0u) { xcd_barrier_complete(bar, b.x, nloc, nx); b.st[0] = nloc; b.st[1] = nx; }
        const unsigned old = xb_add(&bar[XB_XSUB(b.x)], 1u);
        const unsigned gen = old / nloc;
        if (old + 1u == (gen + 1u) * nloc) {
            if (!local) {
            __builtin_amdgcn_fence(__ATOMIC_RELEASE, "agent");
            asm volatile("s_waitcnt vmcnt(0)" ::: "memory");
            const unsigned og = xb_add(&bar[XB_TOP], 1u);
            const unsigned tg = og / nx;
            if (og + 1u == (tg + 1u) * nx) xb_add(&bar[XB_TOPGEN], 1u);
            else XB_SPIN(xb_ld(&bar[XB_TOPGEN]) == tg, bar);
            }
            __builtin_amdgcn_fence(__ATOMIC_ACQUIRE, "agent");
            xb_add(&bar[XB_XGEN(b.x)], 1u);
            asm volatile("s_waitcnt vmcnt(0)" ::: "memory");
        } else {
            XB_SPIN(xb_ld(&bar[XB_XGEN(b.x)]) == gen, bar);
#ifdef BAR_L1INV
            asm volatile("buffer_inv sc0" ::: "memory");
            __builtin_amdgcn_fence(__ATOMIC_ACQUIRE, "workgroup");
#else
            __builtin_amdgcn_fence(__ATOMIC_ACQUIRE, "agent");
#endif
            asm volatile("s_waitcnt vmcnt(0)" ::: "memory");
        }
    }
    __syncthreads();
}
#define XB_LSUB(j)  (3584 + 64 * (j))
#define XB_LGEN(j)  (4608 + 64 * (j))
#define XB_XC       5632
constexpr int CW_BAR = 4096;
constexpr int LDS_BARST = LDS_BYTES - 64;

__device__ __forceinline__ void prefetch_next(LAS unsigned char* lds, const Args& a, int ph, int l) {
    unsigned char* ws = a.ws; const int G = gridDim.x; pg8::Unit u;
    if (ph == PH_IN) { pg8::StaticOrder S; S.init(MTOT, DIN - 256, G, (int)blockIdx.x); if (S.next(0, u)) prefetch_panel(lds, (const bf16_t*)(ws + WS_WIN) + (size_t)l * DIN * 1024 + (size_t)(u.pn + 1) * 256 * 1024, 1024, 2048); }
    else if (ph == PH_OUT) { pg8::StaticOrder S; S.init(MTOT, 1024, G, (int)blockIdx.x); if (S.next(0, u)) prefetch_panel(lds, (const bf16_t*)(ws + WS_WOUT) + (size_t)l * 1024 * 1024 + (size_t)u.pn * 256 * 1024, 1024, 2048); }
    else if (ph == PH_UP) { pg8::UpOrder S; S.init_up(G, (int)blockIdx.x); if (S.next(0, u)) prefetch_panel(lds, (const bf16_t*)(ws + WS_WUP) + (size_t)l * DUP * 1024 + (size_t)u.pn * 256 * 1024, 1024, 2048); }
    else if (ph == PH_DOWN) { pg8::StaticOrder S; S.init(MTOT, 1024, G, (int)blockIdx.x); if (S.next(0, u)) prefetch_panel(lds, (const bf16_t*)(ws + WS_WDOWN) + (size_t)l * 1024 * DFF + (size_t)u.pn * 256 * DFF, DFF, 2048); }
}
__global__ void __launch_bounds__(512, 2) mk_fwd(Args a) {
    extern __shared__ __attribute__((aligned(16))) unsigned char lds_raw[];
    LAS unsigned char* lds = (LAS unsigned char*)lds_raw;
    cg::grid_group grid = cg::this_grid();
    if (threadIdx.x < 2) ((volatile LAS unsigned*)(lds + LDS_BARST))[threadIdx.x] = 0u;
    __syncthreads();
    const XcdBarrier xbar = xcd_barrier_post((unsigned*)(a.ws + WS_CTL) + CW_BAR, (volatile LAS unsigned*)(lds + LDS_BARST));
#define GSYNC() xcd_barrier(xbar)
#ifdef TS_A
#define TSB ((volatile unsigned long long*)(a.ws + WS_CTL + 512 * 1024))
#define STAMP(k) do { if (blockIdx.x == TS_BLOCK && threadIdx.x == 0) TSB[k] = __builtin_amdgcn_s_memrealtime(); } while (0)
#else
#define STAMP(k) do {} while (0)
#endif
    STAMP(0);
#ifdef TS_XCC
    if (threadIdx.x == 0) ((volatile unsigned*)(a.ws + WS_CTL + 768 * 1024))[blockIdx.x] = xb_xcc_id();
#endif
    if (threadIdx.x == 0) __hip_atomic_store(&xbar.bar[XB_XC + blockIdx.x], xbar.x + 1u, __ATOMIC_RELAXED, __HIP_MEMORY_SCOPE_AGENT);
    misc::phase_tables(a); misc::fill_run(lds, a, misc::SLOT_A);
    grid.sync(); STAMP(1);
    {
        const unsigned t = threadIdx.x; int bad = (gridDim.x != 256u) ? 1 : 0;
        if (t < 256u && t < gridDim.x) { const unsigned mine = xb_ld(&xbar.bar[XB_XC + t]), rep = xb_ld(&xbar.bar[XB_XC + (t & 7u)]); bad |= (mine != rep || mine == 0u) ? 1 : 0;
            if (t < 64u && (t >> 3) < (t & 7u)) bad |= (xb_ld(&xbar.bar[XB_XC + (t >> 3)]) == rep) ? 1 : 0; }
        const int anybad = __syncthreads_or(bad);
        if (t == 0) ((volatile LAS unsigned*)(lds + LDS_BARST))[2] = anybad ? 0u : 1u;
        __syncthreads();
    }
    run_phase(lds, a, PH_MAKEXA, 0, 0, 1); misc::fill_run(lds, a, misc::SLOT_B); GSYNC();
#ifndef REP_IN
#define REP_IN 1
#endif
#ifndef REP_ATT
#define REP_ATT 1
#endif
#ifndef REP_UP
#define REP_UP 1
#endif
    STAMP(2);
#pragma unroll 1
    for (int l = 0; l < DEPTH; ++l) {
        if (l == 1) STAMP(10);
#pragma unroll 1
        for (int rep = 0; rep < REP_IN; ++rep) { run_phase(lds, a, PH_IN, l, 0, 0); if (l == 1) STAMP(11); GSYNC(); }
        if (l == 1) STAMP(12);
#pragma unroll 1
        for (int rep = 0; rep < REP_ATT; ++rep) { run_phase(lds, a, PH_ATT, l, rep, 0); if (l == 1) STAMP(13); GSYNC(); }
        if (l == 1) STAMP(14);
        run_phase(lds, a, PH_OUT, l, 0, 0); if (l == 1) STAMP(15); GSYNC();
        if (l == 1) STAMP(16);
#pragma unroll 1
        for (int rep = 0; rep < REP_UP; ++rep) { run_phase(lds, a, PH_UP, l, 0, 0); if (l == 1) STAMP(17); GSYNC(); }
        if (l == 1) STAMP(18);
        run_phase(lds, a, PH_DOWN, l, 0, 0); if (l == 1) STAMP(19);
#ifndef NO_LOCAL_SEAM
        if (l < DEPTH - 1) xcd_barrier(xbar, ((volatile LAS unsigned*)(lds + LDS_BARST))[2] != 0u);
#else
        if (l < DEPTH - 1) GSYNC();
#endif
        if (l == 1) STAMP(20);
    }
#ifdef TS_A
    GSYNC();
    if (blockIdx.x == TS_BLOCK) {
#ifdef TS_XCC
        volatile unsigned* xc = (volatile unsigned*)(a.ws + WS_CTL + 768 * 1024); int mism = 0;
        for (int b = 0; b < (int)gridDim.x; ++b) { const unsigned ref = (TS_XCC == 1) ? xc[b % 8] : xc[(b / 32) * 32]; mism += (xc[b] != ref) ? 1 : 0; }
        const float T_us = (float)mism;
#else
        const float T_us = (float)(TSB[TS_B] - TSB[TS_A]) * 0.01f;
#endif
        const float dl = sqrtf(T_us * (float)(TS_SCALE) * 8.0f);
        for (int i = threadIdx.x; i < (1 << 20); i += 512) a.out[OUT_NAV + i] *= (1.0f + dl);
    }
#endif
}

extern "C" void kernel_launch(void* const* d_in, const int* in_sizes, int n_in, void* d_out, int out_size, void* d_ws, size_t ws_size, hipStream_t stream) {
    static int grid = 0;
    if (grid == 0) {
        int dev = 0, cus = 0, per_cu = 0;
        (void)hipGetDevice(&dev); (void)hipDeviceGetAttribute(&cus, hipDeviceAttributeMultiprocessorCount, dev);
        (void)hipFuncSetAttribute((const void*)mk_fwd, hipFuncAttributeMaxDynamicSharedMemorySize, LDS_BYTES);
        (void)hipOccupancyMaxActiveBlocksPerMultiprocessor(&per_cu, (const void*)mk_fwd, 512, LDS_BYTES);
        if (per_cu < 1) fprintf(stderr, "kernel_launch: occupancy query reports %d blocks per CU\n", per_cu);
        grid = cus > 0 ? cus : 256;
        if (ws_size < WS_END) { fprintf(stderr, "kernel_launch: workspace too small (%zu < %zu)\n", ws_size, (size_t)WS_END); grid = -1; }
    }
    if (grid < 0) return;
    Args a{}; for (int i = 0; i < N_IN; ++i) a.in[i] = (const float*)d_in[i]; a.out = (float*)d_out; a.ws = (unsigned char*)d_ws;
    (void)hipMemsetAsync((unsigned char*)d_ws + WS_CTL, 0, 1 * MiB, stream);
    void* args[] = {&a};
    hipError_t e = hipLaunchCooperativeKernel((const void*)mk_fwd, dim3(grid), dim3(512), args, LDS_BYTES, stream);
    if (e != hipSuccess) fprintf(stderr, "cooperative launch failed: %s (grid %d)\n", hipGetErrorString(e), grid);
}
```

```cpp
#include <hip/hip_runtime.h>
#include <hip/hip_cooperative_groups.h>
#include <cstdio>
#include <cstdint>
namespace cg = cooperative_groups;

constexpr int DEPTH = 4, NCTX = 32, TCTX = 256, NLAT = 4, TLAT = 2048, PAST = 512;
constexpr int MCTX = 8192, MLAT = 8192, MTOT = 16384;
constexpr int DIN = 2304, DFF = 2816, DUP = 5632;
constexpr size_t OUT_X = 0, OUT_NAK = 16777216, OUT_NAV = 25165824, OUT_SWK = 33554432, OUT_SWV = 37748736, OUT_DAK = 41943040, OUT_DAV = 50331648, OUT_TOTAL = 58720256;
enum { I_XP = 0, I_XS, I_CNAK, I_CNAV, I_CSWK, I_CSWV, I_CDAK, I_CDAV, I_C, I_CCTX, I_GATTN, I_GFFN, I_WMOD, I_BMOD, I_WIN, I_NAG, I_RPB, I_SWG, I_SINK, I_DAG, I_LAMBDA, I_SUBG, I_WOUT, I_WUP, I_CONVW, I_CONVB, I_WDOWN, N_IN };
#define LAS __attribute__((address_space(3)))
#define GAS __attribute__((address_space(1)))
typedef unsigned short bf16_t;
typedef short bf16x8 __attribute__((ext_vector_type(8)));
typedef float f32x4 __attribute__((ext_vector_type(4)));
typedef float f32x2 __attribute__((ext_vector_type(2)));
typedef float f32x16 __attribute__((ext_vector_type(16)));
typedef unsigned u32x4 __attribute__((ext_vector_type(4)));
typedef unsigned u32x2 __attribute__((ext_vector_type(2)));
typedef __bf16 bf16x2_t __attribute__((ext_vector_type(2)));

constexpr float LOG2E = 1.4426950408889634f;
constexpr float QSCALE64 = 0.125f * LOG2E, QSCALE32 = 0.17677669529663687f * LOG2E;

__device__ __forceinline__ unsigned cvt_pk_bf16(float lo, float hi) { f32x2 v = {lo, hi}; bf16x2_t b = __builtin_convertvector(v, bf16x2_t); return __builtin_bit_cast(unsigned, b); }
__device__ __forceinline__ float bf16_to_f32(bf16_t v) { return __builtin_bit_cast(float, (unsigned)v << 16); }
__device__ __forceinline__ int row_b5(int row) { return row < MCTX ? 0 : 1 + ((row - MCTX) >> 11); }

constexpr size_t MiB = 1u << 20;
constexpr size_t WS_CTL = 0;
constexpr size_t WS_MOD = 1 * MiB;
constexpr size_t WS_GV = WS_MOD + 512 * 1024;
constexpr size_t WS_BIASIN = WS_GV + 256 * 1024;
constexpr size_t WS_BIASUP = WS_BIASIN + 256 * 1024;
constexpr size_t WS_LAM = WS_BIASUP + 512 * 1024;
constexpr int SM_LAM = 0, SM_GAINS = 64, SM_RPB = SM_GAINS + 1280, SM_SINK = SM_RPB + 7440, SM_SUBG = SM_SINK + 32, SM_END = SM_SUBG + 256;
constexpr size_t WS_ROPEB = 3 * MiB;
constexpr size_t WS_ROPEC = WS_ROPEB + 512 * 1024;
constexpr size_t WS_SSQ = 4 * MiB;
constexpr size_t WS_CONV = 5 * MiB;
constexpr size_t WS_WIN = 6 * MiB;
constexpr size_t WS_WOUT = WS_WIN + 18 * MiB;
constexpr size_t WS_WUP = WS_WOUT + 8 * MiB;
constexpr size_t WS_WDOWN = WS_WUP + 44 * MiB;
constexpr size_t WS_KC = WS_WDOWN + 22 * MiB;
constexpr size_t WS_XA = WS_KC + 20 * MiB;
constexpr size_t WS_QKV = WS_XA + 32 * MiB + 1 * MiB;
constexpr size_t WS_O = WS_QKV + 72 * MiB;
constexpr size_t WS_ACT = WS_QKV;
constexpr size_t WS_XB = WS_O + 32 * MiB;
constexpr size_t WS_END = WS_XB + 32 * MiB;
constexpr size_t GS4 = 2097152, GS8 = 4194304, GS2 = 1048576;
constexpr size_t QO_QA = 0, QO_KA = QO_QA + 2 * GS4, QO_VTA = QO_KA + 2 * GS4, QO_QB = QO_VTA + 2 * GS4, QO_KB = QO_QB + 2 * GS8, QO_VTB = QO_KB + 2 * GS2,
                 QO_QC = QO_VTB + 2 * GS2, QO_KC = QO_QC + 2 * GS4, QO_VTC = QO_KC + 2 * GS4, QO_END = QO_VTC + 2 * GS4;
static_assert(QO_END * 2 == 72 * MiB, "qkv region");
constexpr size_t CO_KA = 0, CO_VTA = CO_KA + GS4, CO_KB = CO_VTA + GS4, CO_VTB = CO_KB + GS2, CO_KCC = CO_VTB + GS2, CO_VTCC = CO_KCC + GS4;

struct Args { const float* in[N_IN]; float* out; unsigned char* ws; };
__device__ __forceinline__ int opaque_tid() { int t = threadIdx.x; asm volatile("" : "+v"(t)); return t; }

namespace pg8 {
#define PG8_LAS __attribute__((address_space(3)))
constexpr int BM = 256, BK = 64, HALF = 128, HTB = HALF * BK * 2  , STAGE_BYTES = 8 * HTB, NXCD = 8, WGM = 8;
__host__ __device__ __forceinline__ int lds_byte(int r, int c) { const int st = (r >> 4) * 2 + (c >> 5), rr = r & 15, cc = c & 31, ob = rr * 64 + cc * 2; return st * 1024 + (ob ^ (((ob >> 9) & 1) << 5)); }
__host__ __device__ __forceinline__ void stage_rc(int b, int& R, int& C) { const int st = b / 1024, sb = b % 1024, swz = sb ^ (((sb >> 9) & 1) << 5); R = (st >> 1) * 16 + swz / 64; C = (st & 1) * 32 + (swz % 64) / 2; }
__host__ __device__ __forceinline__ int perm32(int rho) { const int n = rho >> 4, i = rho & 15; return 8 * (i >> 2) + 4 * n + (i & 3); }
struct Unit { int pm, pn; };
struct Gemm { const bf16_t* A; const bf16_t* Bt; int M, N, K; volatile unsigned long long* ts = nullptr; };
struct StaticOrder {
    int nM, nN, nwg, G, c;
    __host__ __device__ void init(int M, int N, int G_, int c_) { nM = M / BM; nN = N / BM; nwg = nM * nN; G = G_; c = c_; }
    __host__ __device__ bool next(int i, Unit& u) const {
        const long L = (long)i * G + c; if (L >= nwg) return false;
        int wgid = (int)L; { const int q = nwg / NXCD, r = nwg % NXCD, xcd = wgid % NXCD, off = wgid / NXCD; wgid = (xcd < r ? xcd * (q + 1) : r * (q + 1) + (xcd - r) * q) + off; }
        const int nig = WGM * nN, gid = wgid / nig, fm = gid * WGM, gsz = (nM - fm) < WGM ? (nM - fm) : WGM;
        u.pm = fm + ((wgid % nig) % gsz); u.pn = (wgid % nig) / gsz; return true;
    }
    __device__ __forceinline__ void a_ready(const Unit&) const {}
    __device__ __forceinline__ void done(const Unit&) const {}
    __device__ __forceinline__ int arow0(int pm) const { return BM * pm; }
};
struct OneUnit {
    int pm;
    __device__ __forceinline__ bool next(int i, Unit& u) const { if (i > 0) return false; u.pm = pm; u.pn = 0; return true; }
    __device__ __forceinline__ void a_ready(const Unit&) const {}
    __device__ __forceinline__ void done(const Unit&) const {}
    __device__ __forceinline__ int arow0(int pm_) const { return BM * pm_; }
};
struct UpOrder : StaticOrder {
    __device__ __forceinline__ void init_up(int G_, int c_) { nM = 68; nN = 22; nwg = nM * nN; G = G_; c = c_; }
    __device__ __forceinline__ int arow0(int pm) const { return pm < 32 ? BM * pm : MCTX + TLAT * ((pm - 32) / 9) + 254 * ((pm - 32) % 9) - 1; }
};

template <class Epi, class Sched, bool ALIGN_EPI = false, bool SP2 = false>
__device__ __forceinline__ void gemm_phase(PG8_LAS unsigned char* lds, const Gemm g, const Sched& S, const Epi& E) {
    const int tid = opaque_tid(), wid = __builtin_amdgcn_readfirstlane(tid >> 6), lane = tid & 63, wr = wid >> 2, wc = wid & 3, fr = lane & 15, fq = lane >> 4;
    const int K = g.K, nt = K / BK;
    unsigned voffA[2], voffB[2];
#pragma unroll
    for (int i = 0; i < 2; ++i) { int R, C; stage_rc(tid * 16 + i * 8192, R, C); const int Rb = Epi::PERM ? ((R & ~31) + perm32(R & 31)) : R;
        voffA[i] = (unsigned)(R * K + C) * 2u; voffB[i] = (unsigned)(Rb * K + C) * 2u; }
    const size_t kstep = (size_t)(BK * 2);
    const size_t hstep = (size_t)HALF * K * 2;
    const size_t tstep = 2 * hstep;
    const unsigned ldsw = (unsigned)wid * 1024u;
    const int aoff = lds_byte(wr * 64 + fr, fq * 8), boff = lds_byte(wc * 32 + fr, fq * 8);
#define PG8_SA(b, h) (((b) * 2 + (h)) * HTB)
#define PG8_SB(b, h) ((4 + (b) * 2 + (h)) * HTB)
#define PG8_STAGE(bufoff, gbase, voff) do { _Pragma("unroll") for (int _i = 0; _i < 2; ++_i) \
        __builtin_amdgcn_global_load_lds((const unsigned*)((const char*)(gbase) + (voff)[_i]), (PG8_LAS unsigned*)(lds + (bufoff) + ldsw + _i * 8192), 16, 0, 0); } while (0)
#define PG8_LDA(dst, b, h) do { _Pragma("unroll") for (int m = 0; m < 4; ++m) _Pragma("unroll") for (int k = 0; k < 2; ++k) dst[m][k] = *(const PG8_LAS bf16x8*)(lds + PG8_SA(b, h) + aoff + m * 2048 + k * 1024); } while (0)
#define PG8_LDB(dst, b, h) do { _Pragma("unroll") for (int n = 0; n < 2; ++n) _Pragma("unroll") for (int k = 0; k < 2; ++k) dst[n][k] = *(const PG8_LAS bf16x8*)(lds + PG8_SB(b, h) + boff + n * 2048 + k * 1024); } while (0)
#define PG8_MMA(ai, bj, At, Bt) do { __builtin_amdgcn_s_setprio(1); _Pragma("unroll") for (int m = 0; m < 4; ++m) _Pragma("unroll") for (int n = 0; n < 2; ++n) _Pragma("unroll") for (int k = 0; k < 2; ++k) \
        acc[ai][bj][m][n] = __builtin_amdgcn_mfma_f32_16x16x32_bf16(Bt[n][k], At[m][k], acc[ai][bj][m][n], 0, 0, 0); __builtin_amdgcn_s_setprio(0); } while (0)
#define PG8_WAIT_V(n) asm volatile("s_waitcnt vmcnt(" #n ")" ::: "memory")
#define PG8_WAIT_L(n) asm volatile("s_waitcnt lgkmcnt(" #n ")" ::: "memory")
#define PG8_BAR __builtin_amdgcn_s_barrier()
#define PG8_SCHED __builtin_amdgcn_sched_barrier(0)
    Unit cur, nxt; int ui = 0;
    if (!S.next(0, cur)) return;
    f32x4 acc[2][2][4][2];
#pragma unroll
    for (int a = 0; a < 2; ++a)
#pragma unroll
        for (int b = 0; b < 2; ++b)
#pragma unroll
            for (int m = 0; m < 4; ++m)
#pragma unroll
                for (int n = 0; n < 2; ++n) acc[a][b][m][n] = (f32x4){0.f, 0.f, 0.f, 0.f};
    bf16x8 At[4][2], B0[2][2], B1[2][2];
    const size_t rstep = (size_t)K * 2;
    const char* cA = (const char*)g.A + (size_t)S.arow0(cur.pm) * rstep; const char* cB = (const char*)g.Bt + (size_t)cur.pn * tstep;
    S.a_ready(cur);
#ifdef SKEW_A
    { const int d = (cur.pn & 3) * SKEW_A + (cur.pm & 7) * SKEW_B; for (int i = 0; i < d; ++i) __builtin_amdgcn_s_sleep(16); }
#endif
#ifdef USE_KROT
#if USE_KROT == 2
#define PG8_ROT(u) (2 * ((int)blockIdx.x & 7) * (nt >> 4))
#else
#define PG8_ROT(u) (2 * ((((u).pm & 7) + ((u).pn & 3)) & 3))
#endif
#else
#define PG8_ROT(u) 0
#endif
    int rc = PG8_ROT(cur);
    { const char* pA = cA + (size_t)rc * kstep; const char* pB = cB + (size_t)rc * kstep;
    if constexpr (SP2) {
        PG8_STAGE(PG8_SB(0, 0), pB, voffB); PG8_STAGE(PG8_SB(0, 1), pB + hstep, voffB); PG8_STAGE(PG8_SA(0, 0), pA, voffA); PG8_STAGE(PG8_SA(0, 1), pA + hstep, voffA);
        if (wr == 1) PG8_BAR;
        PG8_WAIT_V(2); PG8_BAR;
        PG8_STAGE(PG8_SB(1, 0), pB + kstep, voffB); PG8_STAGE(PG8_SA(1, 0), pA + kstep, voffA); PG8_STAGE(PG8_SB(1, 1), pB + hstep + kstep, voffB);
        PG8_WAIT_V(6); PG8_BAR;
    } else {
        PG8_STAGE(PG8_SB(0, 0), pB, voffB); PG8_STAGE(PG8_SA(0, 0), pA, voffA); PG8_STAGE(PG8_SB(0, 1), pB + hstep, voffB); PG8_STAGE(PG8_SA(0, 1), pA + hstep, voffA);
        if (wr == 1) PG8_BAR;
        PG8_WAIT_V(4); PG8_BAR;
        PG8_STAGE(PG8_SB(1, 0), pB + kstep, voffB); PG8_STAGE(PG8_SA(1, 0), pA + kstep, voffA); PG8_STAGE(PG8_SB(1, 1), pB + hstep + kstep, voffB);
        PG8_WAIT_V(6); PG8_BAR;
    } }
    for (;;) {
        const bool has_next = S.next(ui + 1, nxt);
        const char* nA = has_next ? (const char*)g.A + (size_t)S.arow0(nxt.pm) * rstep : cA; const char* nB = has_next ? (const char*)g.Bt + (size_t)nxt.pn * tstep : cB;
        const int rn = has_next ? PG8_ROT(nxt) : rc;
        int p = rc;
        for (int t = 0; t < nt; t += 2) {
            const bool last = (t == nt - 2);
#ifdef TS_GEMM
            if (g.ts && tid == 0 && ui == 0) g.ts[40 + (t >> 1)] = __builtin_amdgcn_s_memrealtime();
#endif
            const int p2 = (p + 2 >= nt) ? p + 2 - nt : p + 2;
            const char* a1 = cA + (size_t)(p + 1) * kstep;
            const char* a2 = last ? nA + (size_t)rn * kstep : cA + (size_t)p2 * kstep; const char* b2 = last ? nB + (size_t)rn * kstep : cB + (size_t)p2 * kstep;
            const char* a3 = a2 + kstep; const char* b3 = b2 + kstep;
            p = p2;
            if (last && has_next) S.a_ready(nxt);
            if constexpr (SP2) {
            PG8_LDB(B0, 0, 0); PG8_LDB(B1, 0, 1); PG8_SCHED; PG8_LDA(At, 0, 0); PG8_STAGE(PG8_SA(1, 1), a1 + hstep, voffA);
            PG8_WAIT_V(8); PG8_WAIT_L(0); PG8_BAR; PG8_MMA(0, 0, At, B0); PG8_MMA(0, 1, At, B1); PG8_BAR; PG8_SCHED;
            PG8_LDA(At, 0, 1); PG8_STAGE(PG8_SB(0, 0), b2, voffB); PG8_STAGE(PG8_SB(0, 1), b2 + hstep, voffB); PG8_STAGE(PG8_SA(0, 0), a2, voffA);
            PG8_WAIT_V(8); PG8_WAIT_L(0); PG8_BAR; PG8_MMA(1, 0, At, B0); PG8_MMA(1, 1, At, B1); PG8_BAR; PG8_SCHED;
            PG8_LDB(B0, 1, 0); PG8_LDB(B1, 1, 1); PG8_SCHED; PG8_LDA(At, 1, 0); PG8_STAGE(PG8_SA(0, 1), a2 + hstep, voffA);
            PG8_WAIT_V(8); PG8_WAIT_L(0); PG8_BAR; PG8_MMA(0, 0, At, B0); PG8_MMA(0, 1, At, B1); PG8_BAR; PG8_SCHED;
            PG8_LDA(At, 1, 1); PG8_STAGE(PG8_SB(1, 0), b3, voffB); PG8_STAGE(PG8_SB(1, 1), b3 + hstep, voffB); PG8_STAGE(PG8_SA(1, 0), a3, voffA);
            PG8_WAIT_V(8); PG8_WAIT_L(0); PG8_BAR; PG8_MMA(1, 0, At, B0); PG8_MMA(1, 1, At, B1); PG8_BAR; PG8_SCHED;
            } else {
            PG8_LDB(B0, 0, 0); PG8_SCHED; PG8_LDA(At, 0, 0); PG8_STAGE(PG8_SA(1, 1), a1 + hstep, voffA);
            PG8_WAIT_L(8); PG8_BAR; PG8_WAIT_L(0); PG8_MMA(0, 0, At, B0); PG8_BAR; PG8_SCHED;
            PG8_LDB(B1, 0, 1); PG8_STAGE(PG8_SB(0, 0), b2, voffB);
            PG8_BAR; PG8_WAIT_L(0); PG8_MMA(0, 1, At, B1); PG8_BAR;
            PG8_LDA(At, 0, 1); PG8_STAGE(PG8_SA(0, 0), a2, voffA);
            PG8_BAR; PG8_WAIT_L(0); PG8_MMA(1, 0, At, B0); PG8_BAR; PG8_SCHED;
            PG8_STAGE(PG8_SB(0, 1), b2 + hstep, voffB);
            PG8_WAIT_V(6); PG8_BAR; PG8_MMA(1, 1, At, B1); PG8_BAR;
            PG8_LDB(B0, 1, 0); PG8_SCHED; PG8_LDA(At, 1, 0); PG8_STAGE(PG8_SA(0, 1), a2 + hstep, voffA);
            PG8_WAIT_L(8); PG8_BAR; PG8_WAIT_L(0); PG8_MMA(0, 0, At, B0); PG8_BAR; PG8_SCHED;
            PG8_LDB(B1, 1, 1); PG8_STAGE(PG8_SB(1, 0), b3, voffB);
            PG8_BAR; PG8_WAIT_L(0); PG8_MMA(0, 1, At, B1); PG8_BAR;
            PG8_LDA(At, 1, 1); PG8_STAGE(PG8_SA(1, 0), a3, voffA);
            PG8_BAR; PG8_WAIT_L(0); PG8_MMA(1, 0, At, B0); PG8_BAR; PG8_SCHED;
            PG8_STAGE(PG8_SB(1, 1), b3 + hstep, voffB);
            PG8_WAIT_V(6); PG8_BAR; PG8_MMA(1, 1, At, B1); PG8_BAR;
            }
        }
        if constexpr (ALIGN_EPI) { if (wr == 0) PG8_BAR; }
#ifdef TS_GEMM
        if (g.ts && tid == 0) g.ts[30 + 2 * ui] = __builtin_amdgcn_s_memrealtime();
#endif
        if constexpr (!Epi::AFTER_DRAIN) { if constexpr (Epi::NEEDS_LDS) E(acc, cur, wr, wc, fr, fq, lds); else E(acc, cur, wr, wc, fr, fq); S.done(cur); }
#ifdef TS_GEMM
        if (g.ts && tid == 0) g.ts[31 + 2 * ui] = __builtin_amdgcn_s_memrealtime();
#endif
        if (!has_next) break;
#pragma unroll
        for (int a = 0; a < 2; ++a)
#pragma unroll
            for (int b = 0; b < 2; ++b)
#pragma unroll
                for (int m = 0; m < 4; ++m)
#pragma unroll
                    for (int n = 0; n < 2; ++n) acc[a][b][m][n] = (f32x4){0.f, 0.f, 0.f, 0.f};
        cur = nxt; cA = nA; cB = nB; rc = rn; ++ui;
        if constexpr (ALIGN_EPI) { if (wr == 1) PG8_BAR; }
    }
    PG8_WAIT_V(0);
    if constexpr (!ALIGN_EPI) { if (wr == 0) PG8_BAR; }
    PG8_BAR;
    if constexpr (Epi::AFTER_DRAIN) { E.fused(acc, cur, wr, wc, fr, fq, lds, wid, lane); S.done(cur); }
#undef PG8_SA
#undef PG8_SB
#undef PG8_STAGE
#undef PG8_LDA
#undef PG8_LDB
#undef PG8_MMA
#undef PG8_WAIT_V
#undef PG8_WAIT_L
#undef PG8_BAR
#undef PG8_SCHED
}

constexpr int LDS_EDGE = 131072 + 1024;
constexpr int LDS_RSTD = LDS_EDGE + 8192;
__device__ __forceinline__ void rstd_table(PG8_LAS unsigned char* lds, const GAS float* ssq, int arow0, int wr, int wc, int fr, int fq) {
    const int tid = (wr * 4 + wc) * 64 + fq * 16 + fr, r = tid >> 1, hf = tid & 1;
    const f32x2 a = *(const GAS f32x2*)(ssq + (size_t)min(arow0 + r, MTOT - 1) * 4 + 2 * hf);
    float s = a[0] + a[1]; s += __shfl_xor(s, 1);
    if (!hf) ((PG8_LAS float*)(lds + LDS_RSTD))[r] = __builtin_amdgcn_rsqf(s * (1.0f / 1024.0f) + 1e-6f);
}
__device__ __forceinline__ float xsum_fq(float v) {
    auto a = __builtin_amdgcn_permlane16_swap(__float_as_uint(v), __float_as_uint(v), false, false); v = __uint_as_float(a[0]) + __uint_as_float(a[1]);
    auto b = __builtin_amdgcn_permlane32_swap(__float_as_uint(v), __float_as_uint(v), false, false); return __uint_as_float(b[0]) + __uint_as_float(b[1]);
}
__device__ __forceinline__ float wave_sum_dpp(float v) {
    v += __builtin_bit_cast(float, __builtin_amdgcn_mov_dpp(__builtin_bit_cast(int, v), 0xB1, 0xf, 0xf, true));
    v += __builtin_bit_cast(float, __builtin_amdgcn_mov_dpp(__builtin_bit_cast(int, v), 0x4E, 0xf, 0xf, true));
    v += __builtin_bit_cast(float, __builtin_amdgcn_mov_dpp(__builtin_bit_cast(int, v), 0x124, 0xf, 0xf, true));
    v += __builtin_bit_cast(float, __builtin_amdgcn_mov_dpp(__builtin_bit_cast(int, v), 0x128, 0xf, 0xf, true));
    return xsum_fq(v);
}
__device__ __forceinline__ float half_sum_dpp(float v) {
    v += __builtin_bit_cast(float, __builtin_amdgcn_mov_dpp(__builtin_bit_cast(int, v), 0xB1, 0xf, 0xf, true));
    v += __builtin_bit_cast(float, __builtin_amdgcn_mov_dpp(__builtin_bit_cast(int, v), 0x4E, 0xf, 0xf, true));
    v += __builtin_bit_cast(float, __builtin_amdgcn_mov_dpp(__builtin_bit_cast(int, v), 0x124, 0xf, 0xf, true));
    v += __builtin_bit_cast(float, __builtin_amdgcn_mov_dpp(__builtin_bit_cast(int, v), 0x128, 0xf, 0xf, true));
    auto a = __builtin_amdgcn_permlane16_swap(__float_as_uint(v), __float_as_uint(v), false, false); return __uint_as_float(a[0]) + __uint_as_float(a[1]);
}
#define EPI_BARRIER() do { asm volatile("s_waitcnt lgkmcnt(0)" ::: "memory"); __builtin_amdgcn_s_barrier(); asm volatile("" ::: "memory"); } while (0)

struct EpiIn {
    static constexpr bool PERM = true, AFTER_DRAIN = false, NEEDS_LDS = true;
    unsigned char* ws0; float* out; int l; int pn_off;
    __device__ __forceinline__ void operator()(const f32x4 (&acc)[2][2][4][2], const Unit& u, int wr, int wc, int fr_in, int fq_in, PG8_LAS unsigned char* lds) const {
        unsigned char* ws_ = ws0; asm volatile("" : "+s"(ws_));
        GAS unsigned char* ws = (GAS unsigned char*)ws_; GAS float* outg = (GAS float*)out;
        int fr = fr_in, fq = fq_in; asm volatile("" : "+v"(fr), "+v"(fq));
        const GAS float* ssq = (const GAS float*)(ws + WS_SSQ); const GAS float* bias = (const GAS float*)(ws + WS_BIASIN) + (size_t)l * 5 * DIN;
        const GAS float* gains = (const GAS float*)(ws + WS_LAM) + SM_GAINS + l * 320; const GAS float* nag = gains; const GAS float* swg = gains + 128; const GAS float* dag = gains + 256;
        const GAS float* ropeB = (const GAS float*)(ws + WS_ROPEB); const GAS float* ropeC = (const GAS float*)(ws + WS_ROPEC); GAS bf16_t* qkv = (GAS bf16_t*)(ws + WS_QKV);
        const int pm = u.pm, pn = u.pn + pn_off;
        const int grp = pm >= 32 ? 1 : 0, b = grp ? ((pm - 32) >> 3) : pm, tbase = grp ? 256 * ((pm - 32) & 7) : 0, T = grp ? TLAT : TCTX, b5 = grp ? 1 + b : 0;
        int type, h;
        if (pn < 3) { type = pn; h = wc; } else if (pn < 5) { type = 3; h = 4 * (pn - 3) + wc; } else if (pn == 5) { type = wc < 2 ? 4 : 5; h = wc & 1; } else { type = pn; h = wc; }
        const bool isv = (type == 2 || type == 5 || type == 8), isq = (type == 0 || type == 3 || type == 6), is32 = (type == 6 || type == 7);
        const bool rope = grp && (type == 3 || type == 4 || type == 6 || type == 7);
        const int H = (type == 3) ? 8 : ((type == 4 || type == 5) ? 2 : 4);
        size_t dbase; const size_t gs = (type == 3) ? GS8 : ((type == 4 || type == 5) ? GS2 : GS4);
        switch (type) { case 0: dbase = QO_QA; break; case 1: dbase = QO_KA; break; case 2: dbase = QO_VTA; break; case 3: dbase = QO_QB; break; case 4: dbase = QO_KB; break; case 5: dbase = QO_VTB; break;
                        case 6: dbase = QO_QC; break; case 7: dbase = QO_KC; break; default: dbase = QO_VTC; break; }
        GAS bf16_t* dst = qkv + dbase + grp * gs + (size_t)(b * H + h) * T * 64;
        GAS float* fo = nullptr; int fow = 0, foc = 0;
        if (!grp) { switch (type) { case 1: fo = outg + OUT_NAK; fow = 256; foc = 64 * wc; break; case 2: fo = outg + OUT_NAV; fow = 256; foc = 64 * wc; break; case 4: fo = outg + OUT_SWK; fow = 128; foc = 64 * h; break;
                        case 5: fo = outg + OUT_SWV; fow = 128; foc = 64 * h; break; case 7: fo = outg + OUT_DAK; fow = 256; foc = 64 * wc; break; case 8: fo = outg + OUT_DAV; fow = 256; foc = 64 * wc; break; default: break; } }
        const GAS float* gsrc = ((type == 0) ? nag : (type == 1) ? nag + 64 : (type == 3) ? swg : (type == 4) ? swg + 64 : (type == 6) ? dag : dag + 32) + 8 * fq;
        const GAS float* bsrc = bias + b5 * DIN + pn * 256 + 64 * wc + 8 * fq;
        rstd_table(lds, ssq, 256 * pm, wr, wc, fr, fq);
        if (grp && pn >= 3 && pn <= 7) {
            const int tid_ = (wr * 4 + wc) * 64 + fq * 16 + fr, tok = tid_ >> 3, pc = tid_ & 7; const bool c32 = pn >= 6;
            if (!c32 || pc < 4) {
                const f32x4 vcol = c32 ? *(const GAS f32x4*)(ropeC + ((size_t)tok * 16 + 8 + 2 * pc) * 2) : *(const GAS f32x4*)(ropeB + ((size_t)tok * 32 + 16 + 2 * pc) * 2);
                *(PG8_LAS f32x4*)(lds + LDS_EDGE + tok * 128 + ((pc ^ (tok & 7)) << 4)) = vcol;
                if (tid_ < 32) { const size_t trow = (size_t)(tbase + 64 * tok);
                    const f32x4 vrow = c32 ? *(const GAS f32x4*)(ropeC + (trow * 16 + 2 * pc) * 2) : *(const GAS f32x4*)(ropeB + (trow * 32 + 2 * pc) * 2);
                    *(PG8_LAS f32x4*)(lds + LDS_RSTD + 1024 + tok * 128 + (pc << 4)) = vrow; }
            }
        }
        f32x4 bv[2][2], gv[2][2];
#pragma unroll
        for (int bj = 0; bj < 2; ++bj)
#pragma unroll
            for (int n = 0; n < 2; ++n) { bv[bj][n] = *(const GAS f32x4*)(bsrc + 32 * bj + 4 * n); gv[bj][n] = isv ? (f32x4){1.f, 1.f, 1.f, 1.f} : *(const GAS f32x4*)(gsrc + (is32 ? 0 : 32 * bj) + 4 * n); }
        EPI_BARRIER();
        const PG8_LAS float* RS = (const PG8_LAS float*)(lds + LDS_RSTD);
        const float qs = isq ? (is32 ? QSCALE32 : QSCALE64) : 1.0f;
#pragma unroll
        for (int ai = 0; ai < 2; ++ai)
#pragma unroll
            for (int m = 0; m < 4; ++m) {
                const int lr = 128 * ai + 64 * wr + 16 * m + fr, row = 256 * pm + lr, t = tbase + lr;
                const float rstd = RS[lr];
                float r0 = 1.f, r1 = 1.f;
                if (!isv) {
                    float s0 = 0.f, s1 = 0.f;
#pragma unroll
                    for (int n = 0; n < 2; ++n) { const f32x4 a = acc[ai][0][m][n] * rstd + bv[0][n], c = acc[ai][1][m][n] * rstd + bv[1][n];
                        s0 += (a[0] * a[0] + a[1] * a[1]) + (a[2] * a[2] + a[3] * a[3]); s1 += (c[0] * c[0] + c[1] * c[1]) + (c[2] * c[2] + c[3] * c[3]); }
                    s0 = xsum_fq(s0); s1 = xsum_fq(s1);
                    if (is32) { r0 = __builtin_amdgcn_rsqf(s0 * (1.f / 32.f) + 1e-6f); r1 = __builtin_amdgcn_rsqf(s1 * (1.f / 32.f) + 1e-6f); }
                    else { r0 = r1 = __builtin_amdgcn_rsqf((s0 + s1) * (1.f / 64.f) + 1e-6f); }
                }
                u32x2 hold = {0u, 0u};
                GAS float* fr_ = fo ? fo + ((size_t)(b * DEPTH + l) * 256 + t) * fow + foc + 8 * fq : nullptr;
#pragma unroll
                for (int bj = 0; bj < 2; ++bj)
#pragma unroll
                    for (int n = 0; n < 2; ++n) {
                        f32x4 x = acc[ai][bj][m][n] * rstd + bv[bj][n];
                        if (!isv) {
                            x = x * (bj ? r1 : r0) * gv[bj][n];
                            if (rope) {
                                const int ch = is32 ? ((2 * fq + n) & 3) : (2 * fq + n); const bool isrow = is32 ? (fq < 2) : (bj == 0); const int col = lr & 63;
                                const f32x4 cs = *(const PG8_LAS f32x4*)(lds + (isrow ? LDS_RSTD + 1024 + (lr >> 6) * 128 + (ch << 4) : LDS_EDGE + col * 128 + ((ch ^ (col & 7)) << 4)));
                                x = (f32x4){x[0] * cs[0] - x[1] * cs[1], x[0] * cs[1] + x[1] * cs[0], x[2] * cs[2] - x[3] * cs[3], x[2] * cs[3] + x[3] * cs[2]};
                            }
                        }
                        if (fr_) *(GAS f32x4*)(fr_ + 32 * bj + 4 * n) = x;
                        if (!isv) { const f32x4 y = x * qs; u32x2 w; w.x = cvt_pk_bf16(y[0], y[1]); w.y = cvt_pk_bf16(y[2], y[3]);
                            if (n == 0) hold = w; else { u32x4 w4; w4.x = hold.x; w4.y = hold.y; w4.z = w.x; w4.w = w.y; *(GAS u32x4*)(dst + (size_t)t * 64 + 32 * bj + 8 * fq) = w4; } }
                        else {
                            const int d0 = 32 * bj + 8 * fq + 4 * n, q = fr & 3;
                            const unsigned A = cvt_pk_bf16(x[0], x[1]), B = cvt_pk_bf16(x[2], x[3]);
                            const unsigned pA = (unsigned)__builtin_amdgcn_mov_dpp((int)A, 0x4E, 0xf, 0xf, true), pB = (unsigned)__builtin_amdgcn_mov_dpp((int)B, 0x4E, 0xf, 0xf, true);
                            const unsigned n0 = q < 2 ? A : pB, n1 = q < 2 ? pA : B;
                            const unsigned p0 = (unsigned)__builtin_amdgcn_mov_dpp((int)n0, 0xB1, 0xf, 0xf, true), p1 = (unsigned)__builtin_amdgcn_mov_dpp((int)n1, 0xB1, 0xf, 0xf, true);
                            const unsigned sel = (q & 1) ? 0x03020706u : 0x05040100u;
                            u32x2 w; w.x = __builtin_amdgcn_perm(p0, n0, sel); w.y = __builtin_amdgcn_perm(p1, n1, sel);
                            *(GAS u32x2*)(dst + (size_t)(d0 + q) * T + (t - q)) = w; }
                    }
            }
    }
};

struct EpiRes {
    static constexpr bool PERM = false, AFTER_DRAIN = true, NEEDS_LDS = false;
    unsigned char* ws0; float* x; int l; int which;
    const float* xin_p; const float* xin_s;
    __device__ __forceinline__ void fused(const f32x4 (&acc)[2][2][4][2], const Unit& u, int wr, int wc, int fr, int fq, PG8_LAS unsigned char* lds, int wid, int lane) const {
        GAS unsigned char* ws = (GAS unsigned char*)ws0; GAS float* xg = (GAS float*)x;
        const int pm = u.pm, pn = u.pn, b5 = pm >= 32 ? 1 + ((pm - 32) >> 3) : 0;
        const GAS float* xin = xin_p ? (const GAS float*)(pm >= 32 ? xin_s : xin_p) : nullptr;
        const GAS float* gate = (const GAS float*)(ws + WS_MOD) + (size_t)(l * 5 + b5) * 6144 + (which ? 5 : 2) * 1024 + 256 * pn + 8 * (lane & 31);
        const bool hasn = which ? (l < 3) : true;
        const GAS float* gvn = (const GAS float*)(ws + WS_GV) + (size_t)(which ? l + 1 : l) * 10240 + (size_t)b5 * 2048 + (which ? 0 : 1024) + 256 * pn + 8 * (lane & 31);
        GAS bf16_t* xa = (GAS bf16_t*)(ws + WS_XA); GAS float* ssq = (GAS float*)(ws + WS_SSQ); GAS bf16_t* xb = (GAS bf16_t*)(ws + WS_XB);
#ifndef X_NO_SC1
        const __amdgpu_buffer_rsrc_t xrsrc = __builtin_amdgcn_make_buffer_rsrc((void*)x, 0, (int)(MTOT * 1024 * 4), 0x00020000);
#endif
        const f32x4 g4a = *(const GAS f32x4*)gate, g4b = *(const GAS f32x4*)(gate + 4); const f32x4 zz = {0.f, 0.f, 0.f, 0.f}; const f32x4 n4a = hasn ? *(const GAS f32x4*)gvn : zz, n4b = hasn ? *(const GAS f32x4*)(gvn + 4) : zz;
        const int rsub = lane >> 5, c8 = lane & 31;
        u32x4 raw[2][8];
#define EPIRES_LDX(AI) do { _Pragma("unroll") for (int k_ = 0; k_ < 8; ++k_) raw[AI][k_] = __builtin_nontemporal_load((const GAS u32x4*)(xb + (size_t)(256 * pm + 128 * (AI) + 16 * wid + rsub + 2 * k_) * 1024 + 256 * pn + 8 * c8)); } while (0)
        if (!xin) EPIRES_LDX(0);
#pragma unroll
        for (int ai = 0; ai < 2; ++ai) {
#pragma unroll
            for (int m = 0; m < 4; ++m) { const int row = 64 * wr + 16 * m + fr;
#pragma unroll
                for (int bj = 0; bj < 2; ++bj)
#pragma unroll
                    for (int n = 0; n < 2; ++n) *(PG8_LAS f32x4*)(lds + row * 1024 + (((32 * bj + 8 * wc + 4 * n + fq) ^ (row & 15)) << 4)) = acc[ai][bj][m][n]; }
            EPI_BARRIER();
            const int grow0 = 256 * pm + 128 * ai + 16 * wid + rsub; const size_t colo = (size_t)(256 * pn + 8 * c8);
            f32x4 xlo[8], xhi[8];
            if (xin) {
#pragma unroll
                for (int k = 0; k < 8; ++k) { const GAS float* p = xin + (size_t)(grow0 + 2 * k - (pm >= 32 ? MCTX : 0)) * 1024 + colo; xlo[k] = __builtin_nontemporal_load((const GAS f32x4*)p); xhi[k] = __builtin_nontemporal_load((const GAS f32x4*)(p + 4)); }
            } else {
                if (ai == 0) EPIRES_LDX(1);
#pragma unroll
                for (int k = 0; k < 8; ++k) { const u32x4 r = raw[ai][k];
                    xlo[k] = (f32x4){__uint_as_float(r.x << 16), __uint_as_float(r.x & 0xffff0000u), __uint_as_float(r.y << 16), __uint_as_float(r.y & 0xffff0000u)};
                    xhi[k] = (f32x4){__uint_as_float(r.z << 16), __uint_as_float(r.z & 0xffff0000u), __uint_as_float(r.w << 16), __uint_as_float(r.w & 0xffff0000u)}; }
            }
#pragma unroll
            for (int k = 0; k < 8; ++k) { const int row = 16 * wid + 2 * k + rsub; const size_t go = (size_t)(grow0 + 2 * k) * 1024 + colo;
                const f32x4 a0 = *(const PG8_LAS f32x4*)(lds + row * 1024 + (((2 * c8) ^ (row & 15)) << 4)), a1 = *(const PG8_LAS f32x4*)(lds + row * 1024 + (((2 * c8 + 1) ^ (row & 15)) << 4));
                const f32x4 y0 = xlo[k] + g4a * a0, y1 = xhi[k] + g4b * a1;
                if (!hasn) {
                    __builtin_amdgcn_raw_buffer_store_b128(__builtin_bit_cast(u32x4, y0), xrsrc, (int)(go * 4), 0, 16); __builtin_amdgcn_raw_buffer_store_b128(__builtin_bit_cast(u32x4, y1), xrsrc, (int)(go * 4 + 16), 0, 16);
                } else {
                    u32x4 wx; wx.x = cvt_pk_bf16(y0[0], y0[1]); wx.y = cvt_pk_bf16(y0[2], y0[3]); wx.z = cvt_pk_bf16(y1[0], y1[1]); wx.w = cvt_pk_bf16(y1[2], y1[3]);
                    *(GAS u32x4*)(xb + go) = wx;
                    float ss = ((y0[0] * y0[0] + y0[1] * y0[1]) + (y0[2] * y0[2] + y0[3] * y0[3])) + ((y1[0] * y1[0] + y1[1] * y1[1]) + (y1[2] * y1[2] + y1[3] * y1[3]));
                    ss = half_sum_dpp(ss);
                    const f32x4 z0 = y0 * n4a, z1 = y1 * n4b; u32x4 w; w.x = cvt_pk_bf16(z0[0], z0[1]); w.y = cvt_pk_bf16(z0[2], z0[3]); w.z = cvt_pk_bf16(z1[0], z1[1]); w.w = cvt_pk_bf16(z1[2], z1[3]);
                    *(GAS u32x4*)(xa + go) = w;
                    if (c8 == 0) ssq[(size_t)(grow0 + 2 * k) * 4 + pn] = ss; }
            }
            EPI_BARRIER();
        }
    }
};

#define DPPF(old, src, ctrl) __builtin_bit_cast(float, __builtin_amdgcn_update_dpp(__builtin_bit_cast(int, (float)(old)), __builtin_bit_cast(int, (float)(src)), (ctrl), 0xf, 0xf, false))
struct EpiUpConv {
    static constexpr bool PERM = false, AFTER_DRAIN = false, NEEDS_LDS = true;
    unsigned char* ws0; int l;
    __device__ __forceinline__ void operator()(f32x4 (&acc)[2][2][4][2], const Unit& u, int wr, int wc, int fr_in, int fq_in, PG8_LAS unsigned char* lds) const {
        unsigned char* ws_ = ws0; asm volatile("" : "+s"(ws_)); GAS unsigned char* ws = (GAS unsigned char*)ws_;
        int fr = fr_in, fq = fq_in; asm volatile("" : "+v"(fr), "+v"(fq));
        const int pm = u.pm, pn = u.pn; const int grp = pm >= 32 ? 1 : 0, bq = grp ? (pm - 32) / 9 : 0, jq = grp ? (pm - 32) % 9 : 0;
        const int T = grp ? TLAT : TCTX, tofs = grp ? 254 * jq - 1 : 0, arow0 = grp ? MCTX + TLAT * bq + tofs : 256 * pm, b5 = grp ? 1 + bq : 0;
        const GAS float* ssq = (const GAS float*)(ws + WS_SSQ); const GAS float* bias = (const GAS float*)(ws + WS_BIASUP) + (size_t)(l * 5 + b5) * DUP; const GAS float* cw = (const GAS float*)(ws + WS_CONV) + (size_t)l * 4 * DUP;
        GAS bf16_t* act = (GAS bf16_t*)(ws + WS_ACT);
#ifdef ACT_WT
        const __amdgpu_buffer_rsrc_t wsrsrc = __builtin_amdgcn_make_buffer_rsrc((void*)ws_, 0, 0x7FFFFFF0, 0x00020000);
#endif
        const int fcol = 128 * pn + 32 * wc + 4 * fq;
        rstd_table(lds, ssq, arow0, wr, wc, fr, fq);
        { const int tid_ = (wr * 4 + wc) * 64 + fq * 16 + fr;
          if (tid_ < 256) { const int tap = tid_ >> 6, c4 = (tid_ & 63) * 4;
              *(PG8_LAS f32x4*)(lds + LDS_RSTD + 1024 + (tap * 256 + c4) * 4) = *(const GAS f32x4*)(cw + (size_t)tap * DUP + (c4 >> 7) * DFF + 128 * pn + (c4 & 127)); } }
        const PG8_LAS float* CW = (const PG8_LAS float*)(lds + LDS_RSTD + 1024);
        f32x4 bv[2][2];
#pragma unroll
        for (int bj = 0; bj < 2; ++bj)
#pragma unroll
            for (int n = 0; n < 2; ++n) bv[bj][n] = *(const GAS f32x4*)(bias + bj * DFF + fcol + 16 * n);
        EPI_BARRIER();
        const PG8_LAS float* RS = (const PG8_LAS float*)(lds + LDS_RSTD);
#pragma unroll
        for (int ai = 0; ai < 2; ++ai)
#pragma unroll
            for (int m = 0; m < 4; ++m) {
                const int i = 128 * ai + 64 * wr + 16 * m + fr, t = tofs + i; const bool inseq = (t >= 0) && (t < T);
                const float rstd = RS[i];
#pragma unroll
                for (int bj = 0; bj < 2; ++bj)
#pragma unroll
                    for (int n = 0; n < 2; ++n) { const f32x4 v = acc[ai][bj][m][n] * rstd + bv[bj][n]; acc[ai][bj][m][n] = inseq ? v : (f32x4){0.f, 0.f, 0.f, 0.f}; }
            }
        PG8_LAS float* E = (PG8_LAS float*)(lds + LDS_EDGE);
#pragma unroll
        for (int ai = 0; ai < 2; ++ai) { const int c = 2 * ai + wr;
#pragma unroll
            for (int bj = 0; bj < 2; ++bj)
#pragma unroll
                for (int n = 0; n < 2; ++n) { const int col = 128 * bj + 32 * wc + 16 * n + 4 * fq;
                    if (fr == 0) *(PG8_LAS f32x4*)(E + (c * 2 + 0) * 256 + col) = acc[ai][bj][0][n];
                    if (fr == 15) *(PG8_LAS f32x4*)(E + (c * 2 + 1) * 256 + col) = acc[ai][bj][3][n]; } }
        asm volatile("s_waitcnt lgkmcnt(0)" ::: "memory"); __builtin_amdgcn_s_barrier(); asm volatile("" ::: "memory");
        u32x2 hold = {0u, 0u};
#pragma unroll
        for (int n = 0; n < 2; ++n) {
            f32x4 w0[2], w1[2], w2[2], cb[2];
#pragma unroll
            for (int bj = 0; bj < 2; ++bj) { const PG8_LAS float* p = CW + 128 * bj + 32 * wc + 16 * n + 4 * fq; w0[bj] = *(const PG8_LAS f32x4*)p; w1[bj] = *(const PG8_LAS f32x4*)(p + 256); w2[bj] = *(const PG8_LAS f32x4*)(p + 512); cb[bj] = *(const PG8_LAS f32x4*)(p + 768); }
#pragma unroll
            for (int ai = 0; ai < 2; ++ai) { const int c = 2 * ai + wr;
                f32x4 ep[2], en[2];
#pragma unroll
                for (int bj = 0; bj < 2; ++bj) { const int col = 128 * bj + 32 * wc + 16 * n + 4 * fq;
                    ep[bj] = c > 0 ? *(const PG8_LAS f32x4*)(E + ((c - 1) * 2 + 1) * 256 + col) : (f32x4){0.f, 0.f, 0.f, 0.f};
                    en[bj] = c < 3 ? *(const PG8_LAS f32x4*)(E + ((c + 1) * 2 + 0) * 256 + col) : (f32x4){0.f, 0.f, 0.f, 0.f}; }
#pragma unroll
                for (int m = 0; m < 4; ++m) {
                    f32x4 y[2];
#pragma unroll
                    for (int bj = 0; bj < 2; ++bj) {
                        const f32x4 x = acc[ai][bj][m][n]; f32x4 pv, nx;
#pragma unroll
                        for (int e = 0; e < 4; ++e) {
                            const float po = m > 0 ? DPPF(acc[ai][bj][m > 0 ? m - 1 : 0][n][e], acc[ai][bj][m > 0 ? m - 1 : 0][n][e], 0x121) : ep[bj][e];
                            pv[e] = DPPF(po, x[e], 0x111);
                            const float no = m < 3 ? DPPF(acc[ai][bj][m < 3 ? m + 1 : 3][n][e], acc[ai][bj][m < 3 ? m + 1 : 3][n][e], 0x12F) : en[bj][e];
                            nx[e] = DPPF(no, x[e], 0x101);
                        }
                        y[bj] = cb[bj] + w0[bj] * pv + w1[bj] * x + w2[bj] * nx;
                    }
                    f32x4 a;
#pragma unroll
                    for (int e = 0; e < 4; ++e) a[e] = y[0][e] * __builtin_amdgcn_rcpf(1.0f + __expf(-y[0][e])) * y[1][e];
                    u32x2 w; w.x = cvt_pk_bf16(a[0], a[1]); w.y = cvt_pk_bf16(a[2], a[3]);
                    if ((m & 1) == 0) hold = w;
                    else {
                        const auto sx = __builtin_amdgcn_permlane16_swap(hold.x, w.x, false, false), sy = __builtin_amdgcn_permlane16_swap(hold.y, w.y, false, false);
                        u32x4 w4; w4.x = sx[0]; w4.y = sy[0]; w4.z = sx[1]; w4.w = sy[1];
                        const int i = 128 * ai + 64 * wr + 16 * (m - 1 + (fq & 1)) + fr, t = tofs + i; const bool ok = grp ? ((i >= 1) && (i <= 254) && (t < T)) : true;
                        if (ok) *(GAS u32x4*)(act + (size_t)(arow0 + i) * DFF + 128 * pn + 32 * wc + 16 * n + 8 * (fq >> 1)) = w4; }
                }
            } }
    }
};
}
namespace att {
typedef LAS unsigned char lds_u8;
constexpr int LDS_TILE = 16384;
constexpr int LDS_RPB = 2 * LDS_TILE;
constexpr int LDS_NEXT = LDS_RPB + 2048;
constexpr int NGEMM = 64;
constexpr int NUNITS = 1024 + NGEMM;
constexpr float RESC_THR = 6.0f;

struct Ctx { unsigned char* ws; float* out; int l; int rep; };

__device__ __forceinline__ bf16x8 lds128(const lds_u8* p) { return *(const LAS bf16x8*)p; }
__device__ __forceinline__ float xmax32(float v) { const auto rr = __builtin_amdgcn_permlane32_swap(__float_as_uint(v), __float_as_uint(v), false, false); return fmaxf(__uint_as_float(rr[0]), __uint_as_float(rr[1])); }
__device__ __forceinline__ float xsum32(float v) { const auto rr = __builtin_amdgcn_permlane32_swap(__float_as_uint(v), __float_as_uint(v), false, false); return __uint_as_float(rr[0]) + __uint_as_float(rr[1]); }
__device__ __forceinline__ float max3f(float a, float b, float c) { float r; asm("v_max3_f32 %0, %1, %2, %3" : "=v"(r) : "v"(a), "v"(b), "v"(c)); return r; }
__device__ __forceinline__ int sigma32(int i) { return (i & 19) | ((i & 4) << 1) | ((i & 8) >> 1); }
__device__ __forceinline__ int key_of(int kb, int r, int h) { return 32 * kb + 16 * (r >> 3) + 8 * h + 4 * ((r >> 2) & 1) + (r & 3); }

template <int NDS>
__device__ __forceinline__ void qk_tile(f32x16& s0, f32x16& s1, const lds_u8* Kt, int c0, const bf16x8* qf, const f32x16& negm, int lane) {
    const int k0 = sigma32(lane & 31), h = lane >> 5; const lds_u8* b0 = Kt + k0 * 128; const lds_u8* b1 = b0 + 32 * 128; const int sw = (k0 >> 1) & 7;
    bf16x8 a0[NDS], a1[NDS];
#pragma unroll
    for (int ds = 0; ds < NDS; ++ds) { const int off = ((c0 + 2 * ds + h) ^ sw) << 4; a0[ds] = lds128(b0 + off); a1[ds] = lds128(b1 + off); }
    s0 = __builtin_amdgcn_mfma_f32_32x32x16_bf16(a0[0], qf[0], negm, 0, 0, 0); s1 = __builtin_amdgcn_mfma_f32_32x32x16_bf16(a1[0], qf[0], negm, 0, 0, 0);
#pragma unroll
    for (int ds = 1; ds < NDS; ++ds) { s0 = __builtin_amdgcn_mfma_f32_32x32x16_bf16(a0[ds], qf[ds], s0, 0, 0, 0); s1 = __builtin_amdgcn_mfma_f32_32x32x16_bf16(a1[ds], qf[ds], s1, 0, 0, 0); }
}
__device__ __forceinline__ void softmax_pv(f32x16& s0, f32x16& s1, float& m, float& l, f32x16& negm, f32x16& o0, f32x16& o1, const lds_u8* Vt, int lane) {
    float mx = max3f(s0[0], s1[0], s0[1]), my = max3f(s1[1], s0[2], s1[2]);
#pragma unroll
    for (int r = 3; r < 15; r += 2) { mx = max3f(mx, s0[r], s1[r]); my = max3f(my, s0[r + 1], s1[r + 1]); }
    mx = max3f(mx, s0[15], s1[15]); mx = fmaxf(mx, my);
    mx = xmax32(mx);
    if (__any(mx > RESC_THR)) {
        const float dl = fmaxf(mx, 0.f); m += dl; const float al = __builtin_amdgcn_exp2f(-dl); l *= al;
#pragma unroll
        for (int r = 0; r < 16; ++r) { o0[r] *= al; o1[r] *= al; s0[r] -= dl; s1[r] -= dl; negm[r] = -m; }
    }
    const int h = lane >> 5, d = lane & 31; const lds_u8* v0 = Vt + d * 128; const lds_u8* v1 = v0 + 32 * 128; const int sw = (d >> 1) & 7;
    bf16x8 va[4], vb[4];
#pragma unroll
    for (int c = 0; c < 4; ++c) { const int off = ((2 * c + h) ^ sw) << 4; va[c] = lds128(v0 + off); vb[c] = lds128(v1 + off); }
    f32x2 ps = {0.f, 0.f}, pt = {0.f, 0.f};
#pragma unroll
    for (int r = 0; r < 16; r += 2) { s0[r] = __builtin_amdgcn_exp2f(s0[r]); s0[r + 1] = __builtin_amdgcn_exp2f(s0[r + 1]); s1[r] = __builtin_amdgcn_exp2f(s1[r]); s1[r + 1] = __builtin_amdgcn_exp2f(s1[r + 1]);
        ps += (f32x2){s0[r], s0[r + 1]}; pt += (f32x2){s1[r], s1[r + 1]}; }
    ps += pt; l += ps[0] + ps[1];
#pragma unroll
    for (int c = 0; c < 4; ++c) {
        const f32x16& s = (c >> 1) ? s1 : s0; const int b = 8 * (c & 1);
        u32x4 pw; pw.x = cvt_pk_bf16(s[b + 0], s[b + 1]); pw.y = cvt_pk_bf16(s[b + 2], s[b + 3]); pw.z = cvt_pk_bf16(s[b + 4], s[b + 5]); pw.w = cvt_pk_bf16(s[b + 6], s[b + 7]);
        const bf16x8 pf = __builtin_bit_cast(bf16x8, pw);
        o0 = __builtin_amdgcn_mfma_f32_32x32x16_bf16(va[c], pf, o0, 0, 0, 0);
        o1 = __builtin_amdgcn_mfma_f32_32x32x16_bf16(vb[c], pf, o1, 0, 0, 0);
    }
}
__device__ __forceinline__ void softmax_pv_abs(f32x16& s0, f32x16& s1, float& m, float& l, f32x16& o0, f32x16& o1, const lds_u8* Vt, int lane) {
    float mx = max3f(s0[0], s1[0], s0[1]), my = max3f(s1[1], s0[2], s1[2]);
#pragma unroll
    for (int r = 3; r < 15; r += 2) { mx = max3f(mx, s0[r], s1[r]); my = max3f(my, s0[r + 1], s1[r + 1]); }
    mx = max3f(mx, s0[15], s1[15]); mx = fmaxf(mx, my);
    mx = xmax32(mx);
    if (__any(mx > m + RESC_THR)) { const float mn = fmaxf(m, mx); const float al = __builtin_amdgcn_exp2f(m - mn); l *= al;
#pragma unroll
        for (int r = 0; r < 16; ++r) { o0[r] *= al; o1[r] *= al; }
        m = mn; }
    const int h = lane >> 5, d = lane & 31; const lds_u8* v0 = Vt + d * 128; const lds_u8* v1 = v0 + 32 * 128; const int sw = (d >> 1) & 7;
    bf16x8 va[4], vb[4];
#pragma unroll
    for (int c = 0; c < 4; ++c) { const int off = ((2 * c + h) ^ sw) << 4; va[c] = lds128(v0 + off); vb[c] = lds128(v1 + off); }
    f32x2 ps = {0.f, 0.f}, pt = {0.f, 0.f};
#pragma unroll
    for (int r = 0; r < 16; r += 2) { s0[r] = __builtin_amdgcn_exp2f(s0[r] - m); s0[r + 1] = __builtin_amdgcn_exp2f(s0[r + 1] - m); s1[r] = __builtin_amdgcn_exp2f(s1[r] - m); s1[r + 1] = __builtin_amdgcn_exp2f(s1[r + 1] - m);
        ps += (f32x2){s0[r], s0[r + 1]}; pt += (f32x2){s1[r], s1[r + 1]}; }
    ps += pt; l += ps[0] + ps[1];
#pragma unroll
    for (int c = 0; c < 4; ++c) {
        const f32x16& s = (c >> 1) ? s1 : s0; const int b = 8 * (c & 1);
        u32x4 pw; pw.x = cvt_pk_bf16(s[b + 0], s[b + 1]); pw.y = cvt_pk_bf16(s[b + 2], s[b + 3]); pw.z = cvt_pk_bf16(s[b + 4], s[b + 5]); pw.w = cvt_pk_bf16(s[b + 6], s[b + 7]);
        const bf16x8 pf = __builtin_bit_cast(bf16x8, pw);
        o0 = __builtin_amdgcn_mfma_f32_32x32x16_bf16(va[c], pf, o0, 0, 0, 0);
        o1 = __builtin_amdgcn_mfma_f32_32x32x16_bf16(vb[c], pf, o1, 0, 0, 0);
    }
}
struct UnitGeo {
    const GAS bf16_t* qkv; const GAS bf16_t* kcb; unsigned kso, vso, kco, vco; int T, ta, nself, ntile, q0, grp, fam, b, h;
};
template <int MODE>
__device__ __forceinline__ void unit_loop(lds_u8* lds, const UnitGeo& U, const GAS float* sm, GAS bf16_t* Obase, int orow0, int ocol, int l, int tid, GAS unsigned* qctr) {
    const int lane = tid & 63, w = __builtin_amdgcn_readfirstlane(tid >> 6), h5 = lane >> 5, ql = lane & 31;
    const int T = U.T, q0 = U.q0, nself = U.nself, ntile = U.ntile, ta = U.ta;
    const int Hq = U.fam == 1 ? 8 : 4;
    const size_t qo = U.fam == 0 ? QO_QA : (U.fam == 1 ? QO_QB : QO_QC); const size_t gq = U.fam == 1 ? GS8 : GS4;
    const int qw0 = q0 + 32 * w, qtok = qw0 + ql, qrow = qtok >> 6, qcol = qtok & 63;
    const GAS bf16_t* Qp = U.qkv + qo + U.grp * gq + ((size_t)(U.b * Hq + U.h) * T + qtok) * 64;
    bf16x8 qf[4];
#pragma unroll
    for (int ds = 0; ds < 4; ++ds) qf[ds] = *(const GAS bf16x8*)(Qp + 16 * ds + 8 * h5);
    const int r0w = min(max((qw0 >> 6) - 4, 0), 24), qsl = min(max(qcol - 8, 0), 48);
    constexpr float M_INIT = -1024.0f;
    float m0 = M_INIT, l0 = 0.f, m1 = M_INIT, l1 = 0.f;
    const f32x16 z = {0.f, 0.f, 0.f, 0.f, 0.f, 0.f, 0.f, 0.f, 0.f, 0.f, 0.f, 0.f, 0.f, 0.f, 0.f, 0.f};
    f32x16 oa0 = z, oa1 = z, ob0 = z, ob1 = z;
    f32x16 ng0;
#pragma unroll
    for (int r = 0; r < 16; ++r) ng0[r] = -M_INIT;
    const int lrow = tid >> 3, lch = tid & 7; const int lds_off = lrow * 128 + ((lch ^ ((lrow >> 1) & 7)) << 4);
    u32x4 rA[2], rB[2];
    auto gload = [&](int ti_, u32x4& kr, u32x4& vr) {
        const int ti = min(ti_, ntile - 1);
        const bool self = ti < nself; const int tok0 = self ? 64 * (ta + ti) : 64 * (ti - nself); const int Tkv = self ? T : PAST;
        const GAS bf16_t* kp = (self ? U.qkv : U.kcb) + (self ? U.kso : U.kco); const GAS bf16_t* vp = (self ? U.qkv : U.kcb) + (self ? U.vso : U.vco);
        kr = *(const GAS u32x4*)(kp + (size_t)(tok0 + lrow) * 64 + lch * 8);
        vr = *(const GAS u32x4*)(vp + (size_t)lrow * Tkv + tok0 + lch * 8);
    };
    auto tile = [&](int ti, const lds_u8* Kt) {
        const lds_u8* Vt = Kt + 8192;
        const bool self = ti < nself; const int tok0 = 64 * (ta + ti);
        bool rel = true, msk = false;
        if (MODE == 1 && self) { const int kr = ta + ti; rel = (kr >= r0w) && (kr <= r0w + 7); msk = true; }
        if (MODE == 2 && self) { rel = (tok0 + 63 >= qw0 - 128) && (tok0 <= qw0 + 31 + 128); msk = !((tok0 >= qw0 + 31 - 128) && (tok0 + 63 <= qw0 + 128)); }
        if (rel) {
            if (MODE != 3) {
                f32x16 s0, s1; qk_tile<4>(s0, s1, Kt, 0, qf, ng0, lane);
                if (MODE == 1 && msk) {
                    const int kr = ta + ti; const LAS float* bt = (const LAS float*)(lds + LDS_RPB) + (kr - qrow + 7) * 31 + 15 - qcol;
                    float b0[16], b1[16];
#pragma unroll
                    for (int r = 0; r < 16; ++r) { const int kc0 = key_of(0, r, h5); b0[r] = bt[min(max(kc0, qsl), qsl + 15)]; b1[r] = bt[min(max(kc0 + 32, qsl), qsl + 15)]; }
#pragma unroll
                    for (int r = 0; r < 16; ++r) { const int kc0 = key_of(0, r, h5), kc1 = kc0 + 32;
                        s0[r] = ((kc0 >= qsl) && (kc0 < qsl + 16)) ? s0[r] + b0[r] : -INFINITY; s1[r] = ((kc1 >= qsl) && (kc1 < qsl + 16)) ? s1[r] + b1[r] : -INFINITY; }
                }
                if (MODE == 2 && msk) {
#pragma unroll
                    for (int r = 0; r < 16; ++r) { const int k0 = tok0 + key_of(0, r, h5), k1 = k0 + 32;
                        s0[r] = (abs(k0 - qtok) > 128) ? -INFINITY : s0[r]; s1[r] = (abs(k1 - qtok) > 128) ? -INFINITY : s1[r]; }
                }
                softmax_pv(s0, s1, m0, l0, ng0, oa0, oa1, Vt, lane);
            } else {
                { f32x16 s0, s1; qk_tile<2>(s0, s1, Kt, 0, qf, z, lane); softmax_pv_abs(s0, s1, m0, l0, oa0, oa1, Vt, lane); }
                { f32x16 s0, s1; qk_tile<2>(s0, s1, Kt, 4, qf + 2, z, lane); softmax_pv_abs(s0, s1, m1, l1, ob0, ob1, Vt, lane); }
            }
        }
    };
    auto step = [&](int ti, u32x4 (&W)[2], u32x4 (&L)[2]) {
        gload(ti + 2, L[0], L[1]);
        __builtin_amdgcn_sched_barrier(0);
        tile(ti, lds + (ti & 1) * LDS_TILE);
        if (ti + 1 < ntile) { lds_u8* nb = lds + ((ti + 1) & 1) * LDS_TILE; *(LAS u32x4*)(nb + lds_off) = W[0]; *(LAS u32x4*)(nb + 8192 + lds_off) = W[1]; }
        __syncthreads();
    };
    gload(0, rB[0], rB[1]);
    gload(1, rA[0], rA[1]);
    *(LAS u32x4*)(lds + lds_off) = rB[0]; *(LAS u32x4*)(lds + 8192 + lds_off) = rB[1];
    __syncthreads();
    for (int ti = 0; ti < ntile; ti += 2) {
        step(ti, rA, rB);
        if (ti + 1 < ntile) step(ti + 1, rB, rA);
    }
    unsigned nx = 0u; if (tid == 0) nx = __hip_atomic_fetch_add(qctr, 1u, __ATOMIC_RELAXED, __HIP_MEMORY_SCOPE_AGENT);
    float lt0 = xsum32(l0);
    if (U.fam == 1) lt0 += __builtin_amdgcn_exp2f(sm[SM_SINK + l * 8 + U.h] - m0);
    const float i0 = 1.0f / lt0;
    lds_u8* stg = lds + w * 4096 + ql * 128;
    if (MODE != 3) {
#pragma unroll
        for (int g = 0; g < 4; ++g) {
            u32x2 wa, wb; wa.x = cvt_pk_bf16(oa0[4 * g] * i0, oa0[4 * g + 1] * i0); wa.y = cvt_pk_bf16(oa0[4 * g + 2] * i0, oa0[4 * g + 3] * i0);
            wb.x = cvt_pk_bf16(oa1[4 * g] * i0, oa1[4 * g + 1] * i0); wb.y = cvt_pk_bf16(oa1[4 * g + 2] * i0, oa1[4 * g + 3] * i0);
            *(LAS u32x2*)(stg + ((g ^ (ql & 7)) << 4) + 8 * h5) = wa; *(LAS u32x2*)(stg + (((4 + g) ^ (ql & 7)) << 4) + 8 * h5) = wb;
        }
    } else {
        const float lam_init = l == 0 ? 0.2f : (l == 1 ? 0.35550906759f : (l == 2 ? 0.47071301835f : 0.55605820416f));
        const float lt1 = xsum32(l1); const float i1 = 1.0f / lt1; const float lam = sm[SM_LAM + l];
        float ss = 0.f;
#pragma unroll
        for (int r = 0; r < 16; ++r) { oa0[r] = oa0[r] * i0 - lam * (ob0[r] * i1); oa1[r] = oa1[r] * i0 - lam * (ob1[r] * i1); ss += oa0[r] * oa0[r] + oa1[r] * oa1[r]; }
        ss = xsum32(ss);
        const float rn = __builtin_amdgcn_rsqf(ss * (1.f / 64.f) + 1e-6f) * (1.0f - lam_init);
        const GAS float* sg = sm + SM_SUBG + l * 64 + 4 * h5;
#pragma unroll
        for (int g = 0; g < 4; ++g) {
            const f32x4 ga = *(const GAS f32x4*)(sg + 8 * g), gb = *(const GAS f32x4*)(sg + 32 + 8 * g);
            u32x2 wa, wb; wa.x = cvt_pk_bf16(oa0[4 * g] * rn * ga[0], oa0[4 * g + 1] * rn * ga[1]); wa.y = cvt_pk_bf16(oa0[4 * g + 2] * rn * ga[2], oa0[4 * g + 3] * rn * ga[3]);
            wb.x = cvt_pk_bf16(oa1[4 * g] * rn * gb[0], oa1[4 * g + 1] * rn * gb[1]); wb.y = cvt_pk_bf16(oa1[4 * g + 2] * rn * gb[2], oa1[4 * g + 3] * rn * gb[3]);
            *(LAS u32x2*)(stg + ((g ^ (ql & 7)) << 4) + 8 * h5) = wa; *(LAS u32x2*)(stg + (((4 + g) ^ (ql & 7)) << 4) + 8 * h5) = wb;
        }
    }
    asm volatile("s_waitcnt lgkmcnt(0)" ::: "memory");
    {
        const int ch = lane & 7; GAS bf16_t* ob = Obase + (size_t)(orow0 + qw0) * 1024 + ocol + 8 * ch;
#pragma unroll
        for (int j = 0; j < 4; ++j) { const int row = (lane >> 3) + 8 * j;
            const u32x4 v = *(const LAS u32x4*)(lds + w * 4096 + row * 128 + ((ch ^ (row & 7)) << 4));
            *(GAS u32x4*)(ob + (size_t)row * 1024) = v; }
    }
    if (tid == 0) *(LAS unsigned*)(lds + LDS_NEXT) = nx;
}

__device__ __forceinline__ void attn_phase(lds_u8* lds, const Ctx& C) {
    const int l = C.l;
    bool have = false;
    for (;;) {
        __syncthreads();
        unsigned char* ws_ = C.ws; asm volatile("" : "+s"(ws_)); GAS unsigned char* ws = (GAS unsigned char*)ws_;
        const int tid = opaque_tid();
        GAS unsigned* qctr = (GAS unsigned*)(ws + WS_CTL) + 64 * (1 + l) + C.rep;
        if (!have) {
            if (tid == 0) *(LAS unsigned*)(lds + LDS_NEXT) = __hip_atomic_fetch_add(qctr, 1u, __ATOMIC_RELAXED, __HIP_MEMORY_SCOPE_AGENT);
            __syncthreads(); }
        const int idx = (int)*(LAS unsigned*)(lds + LDS_NEXT);
#ifdef ATT_PROBE_LIMIT
        if (idx >= (C.rep ? ATT_PROBE_LIMIT : NUNITS)) break;
#else
        if (idx >= NUNITS) break;
#endif
        const GAS float* sm = (const GAS float*)(ws + WS_LAM);
        GAS unsigned* qa_done = (GAS unsigned*)(ws + WS_CTL) + 64 * (8 + l);
        if (idx < NGEMM) {
            pg8::Gemm g{(const bf16_t*)(ws_ + WS_XA), (const bf16_t*)(ws_ + WS_WIN) + (size_t)l * DIN * 1024, MTOT, 256, 1024}; pg8::OneUnit S1{idx};
            pg8::EpiIn E{ws_, C.out, l, 0};
            pg8::gemm_phase<pg8::EpiIn, pg8::OneUnit, true, true>(lds, g, S1, E);
            asm volatile("s_waitcnt vmcnt(0)" ::: "memory");
            __syncthreads();
            if (tid == 0) { __builtin_amdgcn_fence(__ATOMIC_RELEASE, "agent"); asm volatile("s_waitcnt vmcnt(0)" ::: "memory"); __hip_atomic_fetch_add(qa_done, 1u, __ATOMIC_RELAXED, __HIP_MEMORY_SCOPE_AGENT); }
            have = false;
            continue;
        }
        UnitGeo U; U.qkv = (const GAS bf16_t*)(ws + WS_QKV); U.kcb = (const GAS bf16_t*)(ws + WS_KC);
        int fam, grp, b, h, qb; const int iu = idx - NGEMM;
        if (iu < 128) { fam = 2; grp = 1; b = iu >> 5; h = (iu >> 3) & 3; qb = iu & 7; }
        else if (iu < 384) { const int i = iu - 128; fam = 1; grp = 1; b = i >> 6; h = (i >> 3) & 7; qb = i & 7; }
        else if (iu < 512) { const int i = iu - 384; fam = 0; grp = 1; b = i >> 5; h = (i >> 3) & 3; qb = i & 7; }
        else if (iu < 640) { const int i = iu - 512; fam = 2; grp = 0; b = i >> 2; h = i & 3; qb = 0; }
        else if (iu < 896) { const int i = iu - 640; fam = 1; grp = 0; b = i >> 3; h = i & 7; qb = 0; }
        else { const int i = iu - 896; fam = 0; grp = 0; b = i >> 2; h = i & 3; qb = 0; }
        const int q0 = qb * 256;
        if (fam == 0) {
            if (tid == 0) { unsigned sp = 0; while (__hip_atomic_load(qa_done, __ATOMIC_RELAXED, __HIP_MEMORY_SCOPE_AGENT) < (unsigned)NGEMM * (C.rep + 1) && ++sp < (1u << 22)) __builtin_amdgcn_s_sleep(2);
                __builtin_amdgcn_fence(__ATOMIC_ACQUIRE, "agent"); asm volatile("s_waitcnt vmcnt(0)" ::: "memory"); }
            __syncthreads();
        }
        const int T = grp ? TLAT : TCTX, Hkv = fam == 1 ? 2 : 4, hk = fam == 1 ? (h >> 2) : h;
        const size_t ko = fam == 0 ? QO_KA : (fam == 1 ? QO_KB : QO_KC), vo = fam == 0 ? QO_VTA : (fam == 1 ? QO_VTB : QO_VTC); const size_t gk = fam == 1 ? GS2 : GS4;
        U.kso = (unsigned)(ko + grp * gk + (size_t)(b * Hkv + hk) * T * 64); U.vso = (unsigned)(vo + grp * gk + (size_t)(b * Hkv + hk) * 64 * T);
        const size_t cko = fam == 0 ? CO_KA : (fam == 1 ? CO_KB : CO_KCC), cvo = fam == 0 ? CO_VTA : (fam == 1 ? CO_VTB : CO_VTCC);
        U.kco = (unsigned)(cko + (size_t)((l * 4 + b) * Hkv + hk) * PAST * 64); U.vco = (unsigned)(cvo + (size_t)((l * 4 + b) * Hkv + hk) * 64 * PAST);
        int ta, tb;
        if (!grp) { ta = 0; tb = 4; }
        else if (fam == 0) { ta = max(4 * qb - 4, 0); tb = min(max(4 * qb - 1, 0), 24) + 8; }
        else if (fam == 1) { ta = max(q0 - 128, 0) >> 6; tb = min(q0 + 384, TLAT) >> 6; }
        else { ta = 0; tb = 32; }
        U.T = T; U.ta = ta; U.nself = tb - ta; U.ntile = U.nself + (grp ? 8 : 0); U.q0 = q0; U.grp = grp; U.fam = fam; U.b = b; U.h = h;
        GAS bf16_t* Obase = (GAS bf16_t*)(ws + WS_O); const int orow0 = grp ? MCTX + b * TLAT : b * TCTX, ocol = (fam == 0 ? 0 : (fam == 1 ? 256 : 768)) + 64 * h;
        if (fam == 2) unit_loop<3>(lds, U, sm, Obase, orow0, ocol, l, tid, qctr);
        else if (!grp) unit_loop<0>(lds, U, sm, Obase, orow0, ocol, l, tid, qctr);
        else if (fam == 0) { if (tid < 465) *(LAS float*)(lds + LDS_RPB + 4 * tid) = sm[SM_RPB + (l * 4 + h) * 465 + tid]; unit_loop<1>(lds, U, sm, Obase, orow0, ocol, l, tid, qctr); }
        else unit_loop<2>(lds, U, sm, Obase, orow0, ocol, l, tid, qctr);
        have = true;
    }
}
}
namespace misc {
typedef LAS unsigned char lds_u8;
__device__ __forceinline__ float wave_sum(float v) {
#pragma unroll
    for (int o = 1; o < 64; o <<= 1) v += __shfl_xor(v, o);
    return v;
}
__device__ const double INVB[16] = {1.0, 0.5623413251903491, 0.31622776601683794, 0.1778279410038923, 0.1, 0.05623413251903491, 0.03162277660168379, 0.01778279410038923,
                                    0.01, 0.005623413251903491, 0.0031622776601683794, 0.001778279410038923, 0.001, 0.0005623413251903491, 0.00031622776601683794, 0.0001778279410038923};
__device__ const double INVC[8] = {1.0, 0.31622776601683794, 0.1, 0.03162277660168379, 0.01, 0.0031622776601683794, 0.001, 0.00031622776601683794};
__device__ __forceinline__ void sincos_d(double a, float& c, float& s) {
    const double k = rint(a * 0.6366197723675814);
    double r = fma(-k, 1.5707963267948966, a); r = fma(-k, 6.123233995736766e-17, r);
    const double r2 = r * r;
    const double sp = r * (1.0 + r2 * (-1.0 / 6.0 + r2 * (1.0 / 120.0 + r2 * (-1.0 / 5040.0 + r2 * (1.0 / 362880.0 + r2 * (-1.0 / 39916800.0 + r2 * (1.0 / 6227020800.0)))))));
    const double cp = 1.0 + r2 * (-0.5 + r2 * (1.0 / 24.0 + r2 * (-1.0 / 720.0 + r2 * (1.0 / 40320.0 + r2 * (-1.0 / 3628800.0 + r2 * (1.0 / 479001600.0 + r2 * (-1.0 / 87178291200.0)))))));
    const int q = ((int)k) & 3;
    const double cc = (q == 0) ? cp : (q == 1) ? -sp : (q == 2) ? -cp : sp;
    const double ss = (q == 0) ? sp : (q == 1) ? cp : (q == 2) ? -sp : -cp;
    c = (float)cc; s = (float)ss;
}
__device__ __forceinline__ void transpose_item(const float* W, int K, int N, bf16_t* WT, int k0, int n0, int dst0, LAS float* scr, int lane) {
    const int kr = lane >> 3, c4 = (lane & 7) * 4; f32x4 v[8];
#pragma unroll
    for (int i = 0; i < 8; ++i) v[i] = *(const f32x4*)(W + (size_t)(k0 + 8 * i + kr) * N + n0 + c4);
#pragma unroll
    for (int i = 0; i < 8; ++i) { LAS float* d = scr + (8 * i + kr) * 33 + c4; d[0] = v[i][0]; d[1] = v[i][1]; d[2] = v[i][2]; d[3] = v[i][3]; }
    asm volatile("s_waitcnt lgkmcnt(0)" ::: "memory");
    const int c = lane & 7;
#pragma unroll
    for (int j = 0; j < 4; ++j) { const int n = (lane >> 3) + 8 * j; const LAS float* s = scr + (8 * c) * 33 + n;
        u32x4 o; o.x = cvt_pk_bf16(s[0 * 33], s[1 * 33]); o.y = cvt_pk_bf16(s[2 * 33], s[3 * 33]); o.z = cvt_pk_bf16(s[4 * 33], s[5 * 33]); o.w = cvt_pk_bf16(s[6 * 33], s[7 * 33]);
        *(u32x4*)(WT + (size_t)(dst0 + n) * K + k0 + 8 * c) = o; }
    asm volatile("s_waitcnt lgkmcnt(0)" ::: "memory");
}
__device__ __forceinline__ void trb_item(const float* W, int N, bf16_t* WT, int n0, int dst0, const LAS float* vec, LAS float* scr, LAS float* red, float* out, int ostride, int tid) {
    const int lane = tid & 63, wave = __builtin_amdgcn_readfirstlane(tid >> 6), kr = lane >> 3, c4 = (lane & 7) * 4, c = lane & 7;
    f32x4 a0 = {0.f, 0.f, 0.f, 0.f}, a1 = a0, a2 = a0, a3 = a0, a4 = a0;
#pragma unroll 1
    for (int h = 0; h < 2; ++h) { const int k0 = 128 * wave + 64 * h; f32x4 v[8];
#pragma unroll
        for (int i = 0; i < 8; ++i) v[i] = *(const f32x4*)(W + (size_t)(k0 + 8 * i + kr) * N + n0 + c4);
#pragma unroll
        for (int i = 0; i < 8; ++i) { const LAS float* vp = vec + k0 + 8 * i + kr; a0 += v[i] * vp[0]; a1 += v[i] * vp[1024]; a2 += v[i] * vp[2048]; a3 += v[i] * vp[3072]; a4 += v[i] * vp[4096];
            LAS float* d = scr + (8 * i + kr) * 33 + c4; d[0] = v[i][0]; d[1] = v[i][1]; d[2] = v[i][2]; d[3] = v[i][3]; }
        asm volatile("s_waitcnt lgkmcnt(0)" ::: "memory");
#pragma unroll
        for (int j = 0; j < 4; ++j) { const int n = (lane >> 3) + 8 * j; const LAS float* s = scr + (8 * c) * 33 + n;
            u32x4 o; o.x = cvt_pk_bf16(s[0 * 33], s[1 * 33]); o.y = cvt_pk_bf16(s[2 * 33], s[3 * 33]); o.z = cvt_pk_bf16(s[4 * 33], s[5 * 33]); o.w = cvt_pk_bf16(s[6 * 33], s[7 * 33]);
            *(u32x4*)(WT + (size_t)(dst0 + n) * 1024 + k0 + 8 * c) = o; }
        asm volatile("s_waitcnt lgkmcnt(0)" ::: "memory");
    }
#define TRB_RED(a) do { _Pragma("unroll") for (int j = 0; j < 4; ++j) { float s = a[j]; s += __shfl_xor(s, 8); s += __shfl_xor(s, 16); s += __shfl_xor(s, 32); a[j] = s; } } while (0)
    TRB_RED(a0); TRB_RED(a1); TRB_RED(a2); TRB_RED(a3); TRB_RED(a4);
#undef TRB_RED
    if (lane < 8) { LAS float* r = red + wave * 160 + c4; *(LAS f32x4*)(r) = a0; *(LAS f32x4*)(r + 32) = a1; *(LAS f32x4*)(r + 64) = a2; *(LAS f32x4*)(r + 96) = a3; *(LAS f32x4*)(r + 128) = a4; }
    __syncthreads();
    if (tid < 160) { const int b = tid >> 5, cc = tid & 31; float s = 0.f;
#pragma unroll
        for (int w = 0; w < 8; ++w) s += red[w * 160 + b * 32 + cc];
        out[(size_t)b * ostride + n0 + cc] = s; }
}
__device__ __forceinline__ void gemv5_item(const float* W, int N, int n0, const LAS float* vec, LAS float* red, const float* add, float* out, int ostride, int tid) {
    const int c4 = (tid & 15) * 4, kq = tid >> 4; f32x4 a0 = {0.f, 0.f, 0.f, 0.f}, a1 = a0, a2 = a0, a3 = a0, a4 = a0;
    const float* wp = W + (size_t)(kq * 32) * N + n0 + c4; const LAS float* vp = vec + kq * 32;
#pragma unroll 16
    for (int k = 0; k < 32; ++k) { const f32x4 w = *(const f32x4*)(wp + (size_t)k * N); a0 += w * vp[k]; a1 += w * vp[1024 + k]; a2 += w * vp[2048 + k]; a3 += w * vp[3072 + k]; a4 += w * vp[4096 + k]; }
    *(LAS f32x4*)(red + (kq * 5 + 0) * 64 + c4) = a0; *(LAS f32x4*)(red + (kq * 5 + 1) * 64 + c4) = a1; *(LAS f32x4*)(red + (kq * 5 + 2) * 64 + c4) = a2; *(LAS f32x4*)(red + (kq * 5 + 3) * 64 + c4) = a3; *(LAS f32x4*)(red + (kq * 5 + 4) * 64 + c4) = a4;
    __syncthreads();
    if (tid < 320) { const int b = tid >> 6, c = tid & 63; float s = add ? add[n0 + c] : 0.f;
#pragma unroll
        for (int q = 0; q < 32; ++q) s += red[(q * 5 + b) * 64 + c];
        out[(size_t)b * ostride + n0 + c] = s; }
    __syncthreads();
}

__device__ __forceinline__ void phase_tables(const Args& a) {
    const int gtid = blockIdx.x * 512 + opaque_tid(), NT = gridDim.x * 512; unsigned char* ws = a.ws;
    float* sm = (float*)(ws + WS_LAM);
    if (gtid < 4) { const int l = gtid; const float* lp = a.in[I_LAMBDA] + l * 128; float s1 = 0.f, s2 = 0.f;
        for (int i = 0; i < 32; ++i) { s1 += lp[i] * lp[32 + i]; s2 += lp[64 + i] * lp[96 + i]; }
        sm[SM_LAM + l] = expf(s1) - expf(s2) + (0.8f - 0.6f * expf(-0.3f * (float)l)); }
    for (int i = gtid; i < 1280; i += NT) { const int l = i / 320, r = i % 320; sm[SM_GAINS + i] = r < 128 ? a.in[I_NAG][l * 128 + r] : (r < 256 ? a.in[I_SWG][l * 128 + r - 128] : a.in[I_DAG][l * 64 + r - 256]); }
    for (int i = gtid; i < 7440; i += NT) sm[SM_RPB + i] = a.in[I_RPB][i] * LOG2E;
    for (int i = gtid; i < 32; i += NT) sm[SM_SINK + i] = a.in[I_SINK][i] * LOG2E;
    for (int i = gtid; i < 256; i += NT) sm[SM_SUBG + i] = a.in[I_SUBG][i];
    float* cv = (float*)(ws + WS_CONV);
    for (int i = gtid; i < 4 * 4 * DUP; i += NT) { const int c = i % DUP, j = (i / DUP) & 3, l = i / (4 * DUP); cv[i] = j < 3 ? a.in[I_CONVW][(size_t)(l * 3 + j) * DUP + c] : a.in[I_CONVB][(size_t)l * DUP + c]; }
    float* rb = (float*)(ws + WS_ROPEB); float* rc = (float*)(ws + WS_ROPEC);
    for (int i = gtid; i < 2048 * 32; i += NT) { const int t = i >> 5, j = i & 31; if (t >= 64 && (t & 63) != 0) continue; const double pos = (double)(j < 16 ? (t >> 6) : (t & 63)); float c, s; sincos_d(pos * INVB[j & 15], c, s); rb[2 * i] = c; rb[2 * i + 1] = s; }
    for (int i = gtid; i < 2048 * 16; i += NT) { const int t = i >> 4, j = i & 15; if (t >= 64 && (t & 63) != 0) continue; const double pos = (double)(j < 8 ? (t >> 6) : (t & 63)); float c, s; sincos_d(pos * INVC[j & 7], c, s); rc[2 * i] = c; rc[2 * i + 1] = s; }
}
constexpr int N_TR_IN = 144, N_TR_OUT = 64, N_TR_UP = 352, N_TR_DN = 176, N_MOD = 96, N_BIAS_IN = 36, N_BIAS_UP = 88, N_CACHE = 640;
__device__ __forceinline__ void fl_tr(lds_u8* lds, const Args& a, int l, int which, int bi, int tid) {
    const int lane = tid & 63, wave = __builtin_amdgcn_readfirstlane(tid >> 6); LAS float* scr = (LAS float*)(lds + wave * 16384); unsigned char* ws = a.ws; const int r = bi * 8 + wave;
    if (which == 0) { const int kb = r / 72, nb = r % 72, n0 = 32 * nb; const int tile = n0 >> 8, L = n0 & 255, wc = L >> 6, bj = (L >> 5) & 1; const int dst0 = 256 * tile + 128 * bj + 32 * wc;
        transpose_item(a.in[I_WIN] + (size_t)l * 1024 * DIN, 1024, DIN, (bf16_t*)(ws + WS_WIN) + (size_t)l * DIN * 1024, 64 * kb, n0, dst0, scr, lane); }
    else if (which == 1) { const int kb = r / 32, nb = r % 32; transpose_item(a.in[I_WOUT] + (size_t)l * 1024 * 1024, 1024, 1024, (bf16_t*)(ws + WS_WOUT) + (size_t)l * 1024 * 1024, 64 * kb, 32 * nb, 32 * nb, scr, lane); }
    else if (which == 2) { const int kb = r / 176, nb = r % 176, n0 = 32 * nb; const int nn = n0 < DFF ? n0 : n0 - DFF; const int dst0 = 256 * (nn >> 7) + (n0 < DFF ? 0 : 128) + (nn & 127);
        transpose_item(a.in[I_WUP] + (size_t)l * 1024 * DUP, 1024, DUP, (bf16_t*)(ws + WS_WUP) + (size_t)l * DUP * 1024, 64 * kb, n0, dst0, scr, lane); }
    else { const int kb = r / 32, nb = r % 32; transpose_item(a.in[I_WDOWN] + (size_t)l * DFF * 1024, DFF, 1024, (bf16_t*)(ws + WS_WDOWN) + (size_t)l * 1024 * DFF, 64 * kb, 32 * nb, 32 * nb, scr, lane); }
}
__device__ __forceinline__ void fl_trb(lds_u8* lds, const Args& a, int l, int which, int strip, int tid) {
    const int wave = __builtin_amdgcn_readfirstlane(tid >> 6); unsigned char* ws = a.ws; const float* mod = (const float*)(ws + WS_MOD);
    LAS float* scr = (LAS float*)(lds + wave * 8704); LAS float* vec = (LAS float*)(lds + 73728); LAS float* red = (LAS float*)(lds + 94208);
    for (int i = tid; i < 5120; i += 512) { const int b5 = i >> 10, k = i & 1023; vec[i] = mod[((size_t)(l * 5 + b5) * 6 + (which ? 3 : 0)) * 1024 + k]; }
    __syncthreads();
    const int n0 = 32 * strip;
    if (!which) { const int tile = n0 >> 8, L = n0 & 255, wc = L >> 6, bj = (L >> 5) & 1; const int dst0 = 256 * tile + 128 * bj + 32 * wc;
        trb_item(a.in[I_WIN] + (size_t)l * 1024 * DIN, DIN, (bf16_t*)(ws + WS_WIN) + (size_t)l * DIN * 1024, n0, dst0, vec, scr, red, (float*)(ws + WS_BIASIN) + (size_t)l * 5 * DIN, DIN, tid); }
    else { const int nn = n0 < DFF ? n0 : n0 - DFF; const int dst0 = 256 * (nn >> 7) + (n0 < DFF ? 0 : 128) + (nn & 127);
        trb_item(a.in[I_WUP] + (size_t)l * 1024 * DUP, DUP, (bf16_t*)(ws + WS_WUP) + (size_t)l * DUP * 1024, n0, dst0, vec, scr, red, (float*)(ws + WS_BIASUP) + (size_t)l * 5 * DUP, DUP, tid); }
}
__device__ __forceinline__ void fl_mod(lds_u8* lds, const Args& a, int l, int g, int tid) {
    LAS float* vec = (LAS float*)lds; LAS float* red = (LAS float*)(lds + 20480);
    for (int i = tid; i < 5120; i += 512) { const int b5 = i >> 10, k = i & 1023; const float v = b5 == 0 ? a.in[I_CCTX][k] : a.in[I_C][(b5 - 1) * 1024 + k]; vec[i] = v / (1.f + __expf(-v)); }
    __syncthreads();
    gemv5_item(a.in[I_WMOD] + (size_t)l * 1024 * 6144, 6144, 64 * g, vec, red, a.in[I_BMOD] + l * 6144, (float*)(a.ws + WS_MOD) + (size_t)l * 5 * 6144, 6144, tid);
}
__device__ __forceinline__ void fl_bias(lds_u8* lds, const Args& a, int l, int which, int g, int tid) {
    LAS float* vec = (LAS float*)lds; LAS float* red = (LAS float*)(lds + 20480); const float* mod = (const float*)(a.ws + WS_MOD);
    for (int i = tid; i < 5120; i += 512) { const int b5 = i >> 10, k = i & 1023; vec[i] = mod[((size_t)(l * 5 + b5) * 6 + (which ? 3 : 0)) * 1024 + k]; }
    __syncthreads();
    if (!which) gemv5_item(a.in[I_WIN] + (size_t)l * 1024 * DIN, DIN, 64 * g, vec, red, nullptr, (float*)(a.ws + WS_BIASIN) + (size_t)l * 5 * DIN, DIN, tid);
    else gemv5_item(a.in[I_WUP] + (size_t)l * 1024 * DUP, DUP, 64 * g, vec, red, nullptr, (float*)(a.ws + WS_BIASUP) + (size_t)l * 5 * DUP, DUP, tid);
}
__device__ __forceinline__ void fl_gv(const Args& a, int l, int tid) {
    const float* mod = (const float*)(a.ws + WS_MOD); float* gv = (float*)(a.ws + WS_GV) + (size_t)l * 10240;
    for (int i = tid; i < 10240; i += 512) { const int c = i & 1023, which = (i >> 10) & 1, b5 = i >> 11;
        gv[i] = a.in[which ? I_GFFN : I_GATTN][l * 1024 + c] * (1.f + mod[((size_t)(l * 5 + b5) * 6 + (which ? 4 : 1)) * 1024 + c]); }
}
__device__ __forceinline__ void fl_cache(const Args& a, int l, int ci, int tid) {
    bf16_t* kc = (bf16_t*)(a.ws + WS_KC); int i = ci * 512 + tid;
    if (i < 163840) { const int fam = i < 65536 ? 0 : (i < 98304 ? 1 : 2); i -= fam == 0 ? 0 : (fam == 1 ? 65536 : 98304); const int H = fam == 1 ? 2 : 4;
        const float* ck = a.in[fam == 0 ? I_CNAK : (fam == 1 ? I_CSWK : I_CDAK)]; bf16_t* dk = kc + (fam == 0 ? CO_KA : (fam == 1 ? CO_KB : CO_KCC));
        const int d8 = i & 7, hh = (i >> 3) % H, p = (i / (8 * H)) & 511, b = i / (8 * H * 512);
        const float* s = ck + ((((size_t)b * 4 + l) * 512 + p) * H + hh) * 64 + d8 * 8; const f32x4 x = *(const f32x4*)s, y = *(const f32x4*)(s + 4);
        u32x4 o; o.x = cvt_pk_bf16(x[0], x[1]); o.y = cvt_pk_bf16(x[2], x[3]); o.z = cvt_pk_bf16(y[0], y[1]); o.w = cvt_pk_bf16(y[2], y[3]);
        *(u32x4*)(dk + ((((size_t)l * 4 + b) * H + hh) * 512 + p) * 64 + d8 * 8) = o; }
    else { i -= 163840; const int fam = i < 65536 ? 0 : (i < 98304 ? 1 : 2); i -= fam == 0 ? 0 : (fam == 1 ? 65536 : 98304); const int H = fam == 1 ? 2 : 4;
        const float* cv = a.in[fam == 0 ? I_CNAV : (fam == 1 ? I_CSWV : I_CDAV)]; bf16_t* dv = kc + (fam == 0 ? CO_VTA : (fam == 1 ? CO_VTB : CO_VTCC));
        const int d = i & 63, p8 = (i >> 6) & 63, hh = (i >> 12) % H, b = i / (4096 * H);
        const float* s = cv + ((((size_t)b * 4 + l) * 512 + p8 * 8) * H + hh) * 64 + d; float x[8];
#pragma unroll
        for (int j = 0; j < 8; ++j) x[j] = s[(size_t)j * H * 64];
        u32x4 o; o.x = cvt_pk_bf16(x[0], x[1]); o.y = cvt_pk_bf16(x[2], x[3]); o.z = cvt_pk_bf16(x[4], x[5]); o.w = cvt_pk_bf16(x[6], x[7]);
        *(u32x4*)(dv + ((((size_t)l * 4 + b) * H + hh) * 64 + d) * 512 + p8 * 8) = o; }
}
enum { SLOT_A = 0, SLOT_B = 1 };
__device__ __forceinline__ void fill_run(lds_u8* lds, const Args& a, int slot) {
    const int tid = opaque_tid();
    unsigned* counter = (unsigned*)(a.ws + WS_CTL) + 64 * (16 + slot);
    LAS unsigned* nxt = (LAS unsigned*)(lds + 131072 + 512);
    constexpr int N_TR_A = N_TR_OUT + N_TR_DN, N_TRB = 72 + 176;
    for (;;) {
        __syncthreads();
        if (tid == 0) *nxt = __hip_atomic_fetch_add(counter, 1u, __ATOMIC_RELAXED, __HIP_MEMORY_SCOPE_AGENT);
        __syncthreads();
        int i = (int)*nxt;
        if (slot == SLOT_A) {
            if (i < 4 * N_MOD) { fl_mod(lds, a, i / N_MOD, i % N_MOD, tid); continue; } i -= 4 * N_MOD;
            if (i < 4 * N_TR_A) { const int l = i / N_TR_A; int r = i % N_TR_A;
                if (r < N_TR_OUT) { fl_tr(lds, a, l, 1, r, tid); continue; } r -= N_TR_OUT;
                fl_tr(lds, a, l, 3, r, tid); continue; }
            i -= 4 * N_TR_A;
            if (i < 4 * N_CACHE) { fl_cache(a, i / N_CACHE, i % N_CACHE, tid); continue; }
            break;
        } else {
            if (i < 4) { fl_gv(a, i, tid); continue; } i -= 4;
            if (i < 4 * N_TRB) { const int l = i / N_TRB, r = i % N_TRB; if (r < 72) fl_trb(lds, a, l, 0, r, tid); else fl_trb(lds, a, l, 1, r - 72, tid); continue; }
            break;
        }
    }
}
__device__ __forceinline__ void phase_make_xa(const Args& a, int l, int which, int first) {
    const int tid = opaque_tid(), lane = tid & 63, wave = tid >> 6; unsigned char* ws = a.ws;
    const float* mod = (const float*)(ws + WS_MOD); bf16_t* xa = (bf16_t*)(ws + WS_XA); float* ssq = (float*)(ws + WS_SSQ);
    const float* gsrc = a.in[which ? I_GFFN : I_GATTN] + l * 1024;
    const int stride = (int)gridDim.x * 8;
    for (int row0 = blockIdx.x * 8 + wave; row0 < MTOT; row0 += 2 * stride) {
        f32x4 v[2][4]; float s[2] = {0.f, 0.f};
#pragma unroll
        for (int r = 0; r < 2; ++r) { const int row = min(row0 + r * stride, MTOT - 1);
            const float* src = first ? (row < MCTX ? a.in[I_XP] + (size_t)row * 1024 : a.in[I_XS] + (size_t)(row - MCTX) * 1024) : a.out + (size_t)row * 1024;
#pragma unroll
            for (int j = 0; j < 4; ++j) v[r][j] = *(const f32x4*)(src + 256 * j + 4 * lane); }
#pragma unroll
        for (int r = 0; r < 2; ++r) {
#pragma unroll
            for (int j = 0; j < 4; ++j) s[r] += (v[r][j][0] * v[r][j][0] + v[r][j][1] * v[r][j][1]) + (v[r][j][2] * v[r][j][2] + v[r][j][3] * v[r][j][3]);
            s[r] = pg8::wave_sum_dpp(s[r]); }
#pragma unroll
        for (int r = 0; r < 2; ++r) { const int row = row0 + r * stride;
            if (row < MTOT) {
                const float* sc = mod + ((size_t)(l * 5 + row_b5(row)) * 6 + (which ? 4 : 1)) * 1024;
#pragma unroll
                for (int j = 0; j < 4; ++j) {
                    const f32x4 g = *(const f32x4*)(gsrc + 256 * j + 4 * lane) * (*(const f32x4*)(sc + 256 * j + 4 * lane) + 1.0f);
                    const f32x4 y = v[r][j] * g; u32x2 w; w.x = cvt_pk_bf16(y[0], y[1]); w.y = cvt_pk_bf16(y[2], y[3]); *(u32x2*)(xa + (size_t)row * 1024 + 256 * j + 4 * lane) = w; }
                if (lane < 4) ssq[(size_t)row * 4 + lane] = lane == 0 ? s[r] : 0.f; } }
    }
}
}
constexpr int LDS_BYTES = 147456;
enum Phase { PH_MAKEXA = 2, PH_IN, PH_ATT, PH_OUT, PH_UP, PH_CONV, PH_DOWN };

constexpr int LDS_DUMMY = 131072 + 12288;
__device__ __forceinline__ void prefetch_panel(LAS unsigned char* lds, const bf16_t* tile, int K, int kbytes  ) {
    const int tid = opaque_tid(), wave = __builtin_amdgcn_readfirstlane(tid >> 6); const int segs = kbytes >> 7, nlines = 256 * segs;
    LAS unsigned* dst = (LAS unsigned*)(lds + LDS_DUMMY + wave * 256);
    for (int line = tid; line < nlines; line += 512) { const int row = line / segs, seg = line % segs;
        __builtin_amdgcn_global_load_lds((const unsigned*)((const char*)tile + (size_t)row * K * 2 + seg * 128), dst, 4, 0, 0); }
}
__device__ __forceinline__ void run_phase(LAS unsigned char* lds, const Args& a, int ph, int l, int p1, int p2) {
    unsigned char* ws = a.ws; const int G = gridDim.x;
    switch (ph) {
    case PH_MAKEXA: misc::phase_make_xa(a, l, p1, p2); break;
    case PH_IN: {
        pg8::Gemm g{(const bf16_t*)(ws + WS_XA), (const bf16_t*)(ws + WS_WIN) + (size_t)l * DIN * 1024 + (size_t)256 * 1024, MTOT, DIN - 256, 1024}; pg8::StaticOrder S; S.init(MTOT, DIN - 256, G, (int)blockIdx.x);
#ifdef TS_GEMM
        if (l == 1 && blockIdx.x == TS_BLOCK && TS_PHASE == ph) g.ts = (volatile unsigned long long*)(ws + WS_CTL + 512 * 1024);
#endif
        pg8::EpiIn E{ws, a.out, l, 1};
        pg8::gemm_phase<pg8::EpiIn, pg8::StaticOrder, true, true>(lds, g, S, E); } break;
    case PH_ATT: {
        att::Ctx C{ws, a.out, l, p1};
        att::attn_phase(lds, C); } break;
    case PH_OUT: {
        pg8::Gemm g{(const bf16_t*)(ws + WS_O), (const bf16_t*)(ws + WS_WOUT) + (size_t)l * 1024 * 1024, MTOT, 1024, 1024}; pg8::StaticOrder S; S.init(MTOT, 1024, G, (int)blockIdx.x);
#ifdef TS_GEMM
        if (l == 1 && blockIdx.x == TS_BLOCK && TS_PHASE == ph) g.ts = (volatile unsigned long long*)(ws + WS_CTL + 512 * 1024);
#endif
        pg8::EpiRes E{ws, a.out, l, 0, l == 0 ? a.in[I_XP] : nullptr, l == 0 ? a.in[I_XS] : nullptr};
#ifdef WARM_OUT
        { pg8::Unit u; if (S.next(0, u)) { prefetch_panel(lds, (const bf16_t*)(ws + WS_WOUT) + (size_t)l * 1024 * 1024 + (size_t)u.pn * 256 * 1024, 1024, 2048); prefetch_panel(lds, (const bf16_t*)(ws + WS_O) + (size_t)u.pm * 256 * 1024, 1024, 2048); }
          asm volatile("s_waitcnt vmcnt(0)" ::: "memory"); __syncthreads(); }
#endif
        pg8::gemm_phase<pg8::EpiRes, pg8::StaticOrder, false, true>(lds, g, S, E); } break;
    case PH_UP: {
        pg8::Gemm g{(const bf16_t*)(ws + WS_XA), (const bf16_t*)(ws + WS_WUP) + (size_t)l * DUP * 1024, MTOT, DUP, 1024}; pg8::UpOrder S; S.init_up(G, (int)blockIdx.x);
#ifdef TS_GEMM
        if (l == 1 && blockIdx.x == TS_BLOCK && TS_PHASE == ph) g.ts = (volatile unsigned long long*)(ws + WS_CTL + 512 * 1024);
#endif
        pg8::EpiUpConv E{ws, l};
        pg8::gemm_phase<pg8::EpiUpConv, pg8::UpOrder, true, true>(lds, g, S, E); } break;
    case PH_DOWN: {
        pg8::Gemm g{(const bf16_t*)(ws + WS_ACT), (const bf16_t*)(ws + WS_WDOWN) + (size_t)l * 1024 * DFF, MTOT, 1024, DFF}; pg8::StaticOrder S; S.init(MTOT, 1024, G, (int)blockIdx.x);
#ifdef TS_GEMM
        if (l == 1 && blockIdx.x == TS_BLOCK && TS_PHASE == ph) g.ts = (volatile unsigned long long*)(ws + WS_CTL + 512 * 1024);
#endif
        pg8::EpiRes E{ws, a.out, l, 1, nullptr, nullptr};
        pg8::gemm_phase<pg8::EpiRes, pg8::StaticOrder, false, true>(lds, g, S, E); } break;
    default: break;
    }
}

#define XB_TMO      128
#define XB_XCNT(j)  (256  + 64 * (j))
#define XB_XSUB(j)  (1280 + 64 * (j))
#define XB_XGEN(j)  (2304 + 64 * (j))
#define XB_TOP      3328
#define XB_TOPGEN   3392
#define XCD_BAR_WORDS 3456
#define XB_SPIN_CAP (1u << 18)
__device__ __forceinline__ unsigned xb_ld(unsigned* p)              { return __hip_atomic_load(p, __ATOMIC_RELAXED, __HIP_MEMORY_SCOPE_AGENT); }
__device__ __forceinline__ unsigned xb_add(unsigned* p, unsigned v) { return __hip_atomic_fetch_add(p, v, __ATOMIC_RELAXED, __HIP_MEMORY_SCOPE_AGENT); }
__device__ __forceinline__ unsigned xb_xcc_id() { return (unsigned)__builtin_amdgcn_s_getreg((3 << 11) | 20) & 0xFu; }
#define XB_SPIN(cond, bar) do { unsigned _sp = 0; while (cond) { __builtin_amdgcn_s_sleep(1); \
    if ((++_sp & 255u) == 0u) { if (xb_ld(&(bar)[XB_TMO])) break; if (_sp > XB_SPIN_CAP) { atomicAdd(&(bar)[XB_TMO], 1u); break; } } } } while (0)
struct XcdBarrier { unsigned* bar; unsigned x; volatile LAS unsigned* st; };
__device__ __forceinline__ XcdBarrier xcd_barrier_post(unsigned* bar, volatile LAS unsigned* st) {
    XcdBarrier b; b.bar = bar; b.x = xb_xcc_id(); b.st = st;
    if (threadIdx.x == 0) (void)xb_add(&bar[XB_XCNT(b.x)], 1u);
    return b;
}
__device__ __forceinline__ void xcd_barrier_complete(unsigned* bar, unsigned x, unsigned& nloc, unsigned& nx) {
    const unsigned G = gridDim.x * gridDim.y * gridDim.z;
    unsigned sum, cnt, mine, sp = 0u;
    for (;;) {
        sum = 0u; cnt = 0u; mine = 0u;
#pragma unroll
        for (unsigned j = 0; j < 16; ++j) { const unsigned c = xb_ld(&bar[XB_XCNT(j)]); sum += c; cnt += (c > 0u) ? 1u : 0u; mine = (j == x) ? c : mine; }
        if (sum == G) break;
        __builtin_amdgcn_s_sleep(1);
        if ((++sp & 255u) == 0u) { if (xb_ld(&bar[XB_TMO])) break; if (sp > XB_SPIN_CAP) { atomicAdd(&bar[XB_TMO], 1u); break; } }
    }
    nloc = mine > 0u ? mine : 1u; nx = cnt > 0u ? cnt : 1u;
}
__device__ __forceinline__ void xcd_barrier(const XcdBarrier& b) {
    asm volatile("s_waitcnt vmcnt(0)" ::: "memory");
    __syncthreads();
    if (threadIdx.x == 0) {
        const unsigned bx = xb_xcc_id();
        unsigned* bar = b.bar; asm volatile("" : "+s"(bar));
        __builtin_amdgcn_s_waitcnt(0);
        unsigned nloc = b.st[0], nx = b.st[1];
        if (nloc == 0u) { xcd_barrier_complete(bar, bx, nloc, nx); b.st[0] = nloc; b.st[1] = nx; }
        const unsigned old = xb_add(&bar[XB_XSUB(bx)], 1u);
        const unsigned gen = old / nloc;
        if (old + 1u == (gen + 1u) * nloc) {
            __builtin_amdgcn_fence(__ATOMIC_RELEASE, "agent");
            asm volatile("s_waitcnt vmcnt(0)" ::: "memory");
            asm volatile("buffer_inv sc1" ::: "memory");
            const unsigned og = xb_add(&bar[XB_TOP], 1u);
            const unsigned tg = og / nx;
            if (og + 1u == (tg + 1u) * nx) xb_add(&bar[XB_TOPGEN], 1u);
            else XB_SPIN(xb_ld(&bar[XB_TOPGEN]) == tg, bar);
            asm volatile("s_waitcnt vmcnt(0)" ::: "memory");
            xb_add(&bar[XB_XGEN(bx)], 1u);
            asm volatile("s_waitcnt vmcnt(0)" ::: "memory");
        } else {
            asm volatile("buffer_inv sc1" ::: "memory");
            XB_SPIN(xb_ld(&bar[XB_XGEN(bx)]) == gen, bar);
            asm volatile("s_waitcnt vmcnt(0)" ::: "memory");
        }
    }
    __syncthreads();
}
constexpr int CW_BAR = 4096;
constexpr int LDS_BARST = LDS_BYTES - 64;

__device__ __forceinline__ void prefetch_next(LAS unsigned char* lds, const Args& a, int ph, int l) {
    unsigned char* ws = a.ws; const int G = gridDim.x; pg8::Unit u;
    if (ph == PH_IN) { pg8::StaticOrder S; S.init(MTOT, DIN - 256, G, (int)blockIdx.x); if (S.next(0, u)) prefetch_panel(lds, (const bf16_t*)(ws + WS_WIN) + (size_t)l * DIN * 1024 + (size_t)(u.pn + 1) * 256 * 1024, 1024, 2048); }
    else if (ph == PH_OUT) { pg8::StaticOrder S; S.init(MTOT, 1024, G, (int)blockIdx.x); if (S.next(0, u)) prefetch_panel(lds, (const bf16_t*)(ws + WS_WOUT) + (size_t)l * 1024 * 1024 + (size_t)u.pn * 256 * 1024, 1024, 2048); }
    else if (ph == PH_UP) { pg8::UpOrder S; S.init_up(G, (int)blockIdx.x); if (S.next(0, u)) prefetch_panel(lds, (const bf16_t*)(ws + WS_WUP) + (size_t)l * DUP * 1024 + (size_t)u.pn * 256 * 1024, 1024, 2048); }
    else if (ph == PH_DOWN) { pg8::StaticOrder S; S.init(MTOT, 1024, G, (int)blockIdx.x); if (S.next(0, u)) prefetch_panel(lds, (const bf16_t*)(ws + WS_WDOWN) + (size_t)l * 1024 * DFF + (size_t)u.pn * 256 * DFF, DFF, 2048); }
}
__global__ void __launch_bounds__(512, 2) mk_fwd(Args a) {
    extern __shared__ __attribute__((aligned(16))) unsigned char lds_raw[];
    LAS unsigned char* lds = (LAS unsigned char*)lds_raw;
    cg::grid_group grid = cg::this_grid();
    if (threadIdx.x < 2) ((volatile LAS unsigned*)(lds + LDS_BARST))[threadIdx.x] = 0u;
    __syncthreads();
    const XcdBarrier xbar = xcd_barrier_post((unsigned*)(a.ws + WS_CTL) + CW_BAR, (volatile LAS unsigned*)(lds + LDS_BARST));
#define GSYNC() xcd_barrier(xbar)
#ifdef TS_A
#define TSB ((volatile unsigned long long*)(a.ws + WS_CTL + 512 * 1024))
#define STAMP(k) do { if (blockIdx.x == TS_BLOCK && threadIdx.x == 0) TSB[k] = __builtin_amdgcn_s_memrealtime(); } while (0)
#else
#define STAMP(k) do {} while (0)
#endif
    STAMP(0);
#ifdef TS_XCC
    if (threadIdx.x == 0) ((volatile unsigned*)(a.ws + WS_CTL + 768 * 1024))[blockIdx.x] = xb_xcc_id();
#endif
    misc::phase_tables(a); misc::fill_run(lds, a, misc::SLOT_A);
    grid.sync(); STAMP(1);
    run_phase(lds, a, PH_MAKEXA, 0, 0, 1); misc::fill_run(lds, a, misc::SLOT_B); GSYNC();
#ifndef REP_IN
#define REP_IN 1
#endif
#ifndef REP_ATT
#define REP_ATT 1
#endif
#ifndef REP_UP
#define REP_UP 1
#endif
    STAMP(2);
#pragma unroll 1
    for (int l = 0; l < DEPTH; ++l) {
        if (l == 1) STAMP(10);
#pragma unroll 1
        for (int rep = 0; rep < REP_IN; ++rep) { run_phase(lds, a, PH_IN, l, 0, 0); if (l == 1) STAMP(11); GSYNC(); }
        if (l == 1) STAMP(12);
#pragma unroll 1
        for (int rep = 0; rep < REP_ATT; ++rep) { run_phase(lds, a, PH_ATT, l, rep, 0); if (l == 1) STAMP(13); GSYNC(); }
        if (l == 1) STAMP(14);
        run_phase(lds, a, PH_OUT, l, 0, 0); if (l == 1) STAMP(15); GSYNC();
        if (l == 1) STAMP(16);
#pragma unroll 1
        for (int rep = 0; rep < REP_UP; ++rep) { run_phase(lds, a, PH_UP, l, 0, 0); if (l == 1) STAMP(17); GSYNC(); }
        if (l == 1) STAMP(18);
        run_phase(lds, a, PH_DOWN, l, 0, 0); if (l == 1) STAMP(19);
        if (l < DEPTH - 1) GSYNC();
        if (l == 1) STAMP(20);
    }
#ifdef TS_A
    GSYNC();
    if (blockIdx.x == TS_BLOCK) {
#ifdef TS_XCC
        volatile unsigned* xc = (volatile unsigned*)(a.ws + WS_CTL + 768 * 1024); int mism = 0;
        for (int b = 0; b < (int)gridDim.x; ++b) { const unsigned ref = (TS_XCC == 1) ? xc[b % 8] : xc[(b / 32) * 32]; mism += (xc[b] != ref) ? 1 : 0; }
        const float T_us = (float)mism;
#else
        const float T_us = (float)(TSB[TS_B] - TSB[TS_A]) * 0.01f;
#endif
        const float dl = sqrtf(T_us * (float)(TS_SCALE) * 8.0f);
        for (int i = threadIdx.x; i < (1 << 20); i += 512) a.out[OUT_NAV + i] *= (1.0f + dl);
    }
#endif
}

extern "C" void kernel_launch(void* const* d_in, const int* in_sizes, int n_in, void* d_out, int out_size, void* d_ws, size_t ws_size, hipStream_t stream) {
    static int grid = 0;
    if (grid == 0) {
        int dev = 0, cus = 0, per_cu = 0;
        (void)hipGetDevice(&dev); (void)hipDeviceGetAttribute(&cus, hipDeviceAttributeMultiprocessorCount, dev);
        (void)hipFuncSetAttribute((const void*)mk_fwd, hipFuncAttributeMaxDynamicSharedMemorySize, LDS_BYTES);
        (void)hipOccupancyMaxActiveBlocksPerMultiprocessor(&per_cu, (const void*)mk_fwd, 512, LDS_BYTES);
        if (per_cu < 1) fprintf(stderr, "kernel_launch: occupancy query reports %d blocks per CU\n", per_cu);
        grid = cus > 0 ? cus : 256;
        if (ws_size < WS_END) { fprintf(stderr, "kernel_launch: workspace too small (%zu < %zu)\n", ws_size, (size_t)WS_END); grid = -1; }
    }
    if (grid < 0) return;
    Args a{}; for (int i = 0; i < N_IN; ++i) a.in[i] = (const float*)d_in[i]; a.out = (float*)d_out; a.ws = (unsigned char*)d_ws;
    (void)hipMemsetAsync((unsigned char*)d_ws + WS_CTL, 0, 1 * MiB, stream);
    void* args[] = {&a};
    hipError_t e = hipLaunchCooperativeKernel((const void*)mk_fwd, dim3(grid), dim3(512), args, LDS_BYTES, stream);
    if (e != hipSuccess) fprintf(stderr, "cooperative launch failed: %s (grid %d)\n", hipGetErrorString(e), grid);
}
```
